# Optimizing an MI355X kernel written in HIP

```python
import math
import jax, jax.numpy as jnp
from jax import lax
import numpy as np

D_MODEL = 1024
BATCH = 4
SEQ = 8192
DEPTH = 4

GRID_W = 64
CTX_LEN = 256
HEAD_DIM = 64
MIX_WIDTH = D_MODEL
N_GROUPS = 4
GROUP_WIDTH = MIX_WIDTH // N_GROUPS
DIFF_HEADS = GROUP_WIDTH // HEAD_DIM
DIFF_QK_DIM = HEAD_DIM // 2
SWA_HEADS = GROUP_WIDTH // HEAD_DIM
SWA_KV_HEADS = 2
SWA_GROUP = SWA_HEADS // SWA_KV_HEADS
SWA_WINDOW = 128
SWA_BLOCK = 128
NA_HEADS = GROUP_WIDTH // HEAD_DIM
NA_ROWS_MAX = 8
NA_COLS = 16
SCONV_CH = GROUP_WIDTH
SCONV_WIDTH = 3
D_FF = 2816
FFN_CONV_WIDTH = 3
Q_BLOCK = 128
ROPE_THETA = 10000.0
EPS = 1e-6
NEG_INF = -1e30

A_Q = DIFF_HEADS * 2 * DIFF_QK_DIM
A_K = A_Q
A_V = DIFF_HEADS * HEAD_DIM
A_COLS = A_Q + A_K + A_V
B_Q = SWA_HEADS * HEAD_DIM
B_KV = SWA_KV_HEADS * HEAD_DIM
B_COLS = B_Q + 2 * B_KV
C_W = NA_HEADS * HEAD_DIM
C_COLS = 3 * C_W
D_COLS = 3 * SCONV_CH
IN_COLS = A_COLS + B_COLS + C_COLS + D_COLS

kernel_name = "hybrid_parallel_heads_diffusion_trunk"


def rmsnorm(x, w):
    xf = x.astype(jnp.float32)
    y = xf * lax.rsqrt(jnp.mean(xf * xf, axis=-1, keepdims=True) + EPS)
    return (y * w.astype(jnp.float32)).astype(x.dtype)


def modulate(x, shift, scale):
    return x * (1.0 + scale) + shift


def dwconv3(x, w):
    xp = jnp.pad(x, ((0, 0), (1, 1), (0, 0)))
    return xp[:, :-2] * w[0] + xp[:, 1:-1] * w[1] + xp[:, 2:] * w[2]


def axial_rope_angles(n_tokens, dim):
    t = jnp.arange(n_tokens)
    rows = (t // GRID_W).astype(jnp.float32)
    cols = (t % GRID_W).astype(jnp.float32)
    quarter = dim // 4
    freqs = ROPE_THETA ** (-(jnp.arange(quarter, dtype=jnp.float32) / quarter))
    return rows[:, None] * freqs[None], cols[:, None] * freqs[None]


def _rot_half(x, ang):
    cos = jnp.cos(ang).astype(x.dtype)
    sin = jnp.sin(ang).astype(x.dtype)
    x1, x2 = jnp.split(x, 2, axis=-1)
    return jnp.concatenate([x1 * cos - x2 * sin, x2 * cos + x1 * sin], axis=-1)


def apply_axial_rope(x, ang_row, ang_col):
    half = x.shape[-1] // 2
    return jnp.concatenate([_rot_half(x[..., :half], ang_row), _rot_half(x[..., half:], ang_col)], axis=-1)


def merge_heads(o):
    b, h, s, d = o.shape
    return o.transpose(0, 2, 1, 3).reshape(b, s, h * d)


def diff_attention(h_l, h_c, lam_q1, lam_k1, lam_q2, lam_k2, subln_w, layer_idx, ang_row, ang_col, need_ctx):
    f32 = jnp.float32
    lambda_init = 0.8 - 0.6 * math.exp(-0.3 * layer_idx)
    lam = (jnp.exp(jnp.sum(lam_q1.astype(f32) * lam_k1.astype(f32)))
           - jnp.exp(jnp.sum(lam_q2.astype(f32) * lam_k2.astype(f32))) + lambda_init)
    scale = DIFF_QK_DIM ** -0.5

    def qkv(h):
        b, s, _ = h.shape
        q = h[..., :A_Q].reshape(b, s, DIFF_HEADS, 2, DIFF_QK_DIM).transpose(0, 2, 3, 1, 4)
        k = h[..., A_Q:A_Q + A_K].reshape(b, s, DIFF_HEADS, 2, DIFF_QK_DIM).transpose(0, 2, 3, 1, 4)
        v = h[..., A_Q + A_K:].reshape(b, s, DIFF_HEADS, HEAD_DIM).transpose(0, 2, 1, 3)
        return q, k, v

    def attend(q, k, v):
        s = jnp.einsum('bhiqd,bhikd->bhiqk', q, k).astype(f32) * scale
        p = jax.nn.softmax(s, axis=-1)
        w = (p[:, :, 0] - lam * p[:, :, 1]).astype(v.dtype)
        o = jnp.einsum('bhqk,bhkd->bhqd', w, v)
        return rmsnorm(o, subln_w) * (1.0 - lambda_init)

    ql, kl, vl = qkv(h_l)
    qc, kc, vc = qkv(h_c)
    ql = apply_axial_rope(ql, ang_row, ang_col)
    kl = apply_axial_rope(kl, ang_row, ang_col)
    k_all = jnp.concatenate([kl, kc], axis=3)
    v_all = jnp.concatenate([vl, vc], axis=2)
    b, h, _, s, d = ql.shape
    nb = s // Q_BLOCK
    qb = ql.reshape(b, h, 2, nb, Q_BLOCK, d).transpose(3, 0, 1, 2, 4, 5)
    ob = lax.map(lambda q: attend(q, k_all, v_all), qb)
    o_l = merge_heads(ob.transpose(1, 2, 0, 3, 4).reshape(b, h, s, HEAD_DIM))
    o_c = merge_heads(attend(qc, kc, vc)) if need_ctx else None
    return o_l, o_c


def window_gqa(h_l, h_c, sink, ang_row, ang_col, need_ctx):
    f32 = jnp.float32
    scale = HEAD_DIM ** -0.5
    sink_f = sink.astype(f32).reshape(SWA_KV_HEADS, SWA_GROUP)

    def qkv(h):
        b, s, _ = h.shape
        q = h[..., :B_Q].reshape(b, s, SWA_KV_HEADS, SWA_GROUP, HEAD_DIM).transpose(0, 2, 3, 1, 4)
        k = h[..., B_Q:B_Q + B_KV].reshape(b, s, SWA_KV_HEADS, HEAD_DIM).transpose(0, 2, 1, 3)
        v = h[..., B_Q + B_KV:].reshape(b, s, SWA_KV_HEADS, HEAD_DIM).transpose(0, 2, 1, 3)
        return q, k, v

    ql, kl, vl = qkv(h_l)
    qc, kc, vc = qkv(h_c)
    ql = apply_axial_rope(ql, ang_row, ang_col)
    kl = apply_axial_rope(kl, ang_row, ang_col)
    b, _, _, s, d = ql.shape
    n_ctx = kc.shape[2]
    nb = s // SWA_BLOCK
    pad = ((0, 0), (0, 0), (SWA_BLOCK, SWA_BLOCK), (0, 0))
    kp = jnp.pad(kl, pad).reshape(b, SWA_KV_HEADS, nb + 2, SWA_BLOCK, d)
    vp = jnp.pad(vl, pad).reshape(b, SWA_KV_HEADS, nb + 2, SWA_BLOCK, d)
    kband = jnp.concatenate([kp[:, :, 0:nb], kp[:, :, 1:nb + 1], kp[:, :, 2:nb + 2]], axis=3)
    vband = jnp.concatenate([vp[:, :, 0:nb], vp[:, :, 1:nb + 1], vp[:, :, 2:nb + 2]], axis=3)
    qb = ql.reshape(b, SWA_KV_HEADS, SWA_GROUP, nb, SWA_BLOCK, d)
    s_loc = jnp.einsum('bkgnqd,bknjd->bkgnqj', qb, kband).astype(f32) * scale
    blk = jnp.arange(nb)[:, None, None]
    qpos = blk * SWA_BLOCK + jnp.arange(SWA_BLOCK)[None, :, None]
    kpos = blk * SWA_BLOCK - SWA_BLOCK + jnp.arange(3 * SWA_BLOCK)[None, None, :]
    band = (jnp.abs(kpos - qpos) <= SWA_WINDOW) & (kpos >= 0) & (kpos < s)
    s_loc = jnp.where(band, s_loc, NEG_INF)
    s_ctx = jnp.einsum('bkgnqd,bkld->bkgnql', qb, kc).astype(f32) * scale
    s_snk = jnp.broadcast_to(sink_f[None, :, :, None, None, None], s_loc.shape[:-1] + (1,))
    p = jax.nn.softmax(jnp.concatenate([s_loc, s_ctx, s_snk], axis=-1), axis=-1)
    nk = 3 * SWA_BLOCK
    o = (jnp.einsum('bkgnqj,bknjd->bkgnqd', p[..., :nk].astype(vl.dtype), vband)
         + jnp.einsum('bkgnql,bkld->bkgnqd', p[..., nk:nk + n_ctx].astype(vl.dtype), vc))
    o_l = merge_heads(o.reshape(b, SWA_HEADS, s, d))
    o_c = None
    if need_ctx:
        sc = jnp.einsum('bkgqd,bkld->bkgql', qc, kc).astype(f32) * scale
        sc_snk = jnp.broadcast_to(sink_f[None, :, :, None, None], sc.shape[:-1] + (1,))
        pc = jax.nn.softmax(jnp.concatenate([sc, sc_snk], axis=-1), axis=-1)
        oc = jnp.einsum('bkgql,bkld->bkgqd', pc[..., :n_ctx].astype(vc.dtype), vc)
        o_c = merge_heads(oc.reshape(b, SWA_HEADS, n_ctx, d))
    return o_l, o_c


def neighborhood_attention(h_l, h_c, rpb, need_ctx):
    f32 = jnp.float32
    scale = HEAD_DIM ** -0.5

    def qkv(h):
        b, s, _ = h.shape
        q = h[..., :C_W].reshape(b, s, NA_HEADS, HEAD_DIM).transpose(0, 2, 1, 3)
        k = h[..., C_W:2 * C_W].reshape(b, s, NA_HEADS, HEAD_DIM).transpose(0, 2, 1, 3)
        v = h[..., 2 * C_W:].reshape(b, s, NA_HEADS, HEAD_DIM).transpose(0, 2, 1, 3)
        return q, k, v

    ql, kl, vl = qkv(h_l)
    qc, kc, vc = qkv(h_c)
    b, h, s, d = ql.shape
    n_ctx = kc.shape[2]
    rows = s // GRID_W
    kr = min(NA_ROWS_MAX, rows)
    qg = ql.reshape(b, h, rows, GRID_W, d)
    kg = kl.reshape(b, h, rows, GRID_W, d)
    vg = vl.reshape(b, h, rows, GRID_W, d)
    r = jnp.arange(rows)
    row_start = jnp.clip(r - kr // 2, 0, rows - kr)
    key_rows = row_start[:, None] + jnp.arange(kr)[None, :]
    krows = jnp.take(kg, key_rows, axis=2)
    vrows = jnp.take(vg, key_rows, axis=2)
    s_loc = jnp.einsum('bhrqd,bhrjcd->bhrqjc', qg, krows).astype(f32) * scale
    cq = jnp.arange(GRID_W)
    col_start = jnp.clip(cq - NA_COLS // 2, 0, GRID_W - NA_COLS)
    ck = jnp.arange(GRID_W)
    col_mask = (ck[None, :] >= col_start[:, None]) & (ck[None, :] < col_start[:, None] + NA_COLS)
    dr = key_rows - r[:, None]
    dc = jnp.clip(ck[None, :] - cq[:, None], -(NA_COLS - 1), NA_COLS - 1)
    bias = rpb[:, (dr + NA_ROWS_MAX - 1)[:, None, :, None], (dc + NA_COLS - 1)[None, :, None, :]]
    s_loc = jnp.where(col_mask[None, None, None, :, None, :], s_loc + bias[None].astype(f32), NEG_INF)
    s_loc = s_loc.reshape(b, h, rows, GRID_W, kr * GRID_W)
    s_ctx = jnp.einsum('bhrqd,bhld->bhrql', qg, kc).astype(f32) * scale
    p = jax.nn.softmax(jnp.concatenate([s_loc, s_ctx], axis=-1), axis=-1)
    nk = kr * GRID_W
    p_loc = p[..., :nk].reshape(b, h, rows, GRID_W, kr, GRID_W).astype(vl.dtype)
    o = (jnp.einsum('bhrqjc,bhrjcd->bhrqd', p_loc, vrows)
         + jnp.einsum('bhrql,bhld->bhrqd', p[..., nk:].astype(vl.dtype), vc))
    o_l = merge_heads(o.reshape(b, h, s, d))
    o_c = None
    if need_ctx:
        sc = jnp.einsum('bhqd,bhkd->bhqk', qc, kc).astype(f32) * scale
        pc = jax.nn.softmax(sc, axis=-1).astype(vc.dtype)
        o_c = merge_heads(jnp.einsum('bhqk,bhkd->bhqd', pc, vc))
    return o_l, o_c


def short_conv_mixer(h_l, h_c, conv_w, need_ctx):
    def run(h):
        bg = h[..., :SCONV_CH]
        cg = h[..., SCONV_CH:2 * SCONV_CH]
        xi = h[..., 2 * SCONV_CH:]
        return bg * dwconv3(cg * xi, conv_w)
    o_l = run(h_l)
    o_c = run(h_c) if need_ctx else None
    return o_l, o_c


def conv_ffn(h, w_up, conv_w, conv_b, w_down):
    u = dwconv3(h @ w_up, conv_w) + conv_b
    g, v = jnp.split(u, 2, axis=-1)
    return (jax.nn.silu(g) * v) @ w_down


def setup_inputs(seed: int = 0) -> dict:
    key = jax.random.key(seed)
    ks = jax.random.split(key, 24)
    f32 = jnp.float32
    nrm = lambda k, shape, s: jax.random.normal(k, shape, f32) * s
    return {
        "x": nrm(ks[0], (BATCH, SEQ, D_MODEL), 1.0),
        "c": nrm(ks[1], (BATCH, D_MODEL), 1.0),
        "ctx": nrm(ks[2], (BATCH, CTX_LEN, D_MODEL), 1.0),
        "c_ctx": nrm(ks[3], (D_MODEL,), 1.0),
        "norm_mix_w": 1.0 + nrm(ks[4], (DEPTH, D_MODEL), 0.01),
        "norm_ffn_w": 1.0 + nrm(ks[5], (DEPTH, D_MODEL), 0.01),
        "w_mod": nrm(ks[6], (DEPTH, D_MODEL, 6 * D_MODEL), 0.5 * D_MODEL ** -0.5),
        "b_mod": nrm(ks[7], (DEPTH, 6 * D_MODEL), 0.02),
        "w_in": nrm(ks[8], (DEPTH, D_MODEL, IN_COLS), D_MODEL ** -0.5),
        "w_out": nrm(ks[9], (DEPTH, MIX_WIDTH, D_MODEL), MIX_WIDTH ** -0.5),
        "diff_lambda_q1": nrm(ks[10], (DEPTH, DIFF_QK_DIM), 0.1),
        "diff_lambda_k1": nrm(ks[11], (DEPTH, DIFF_QK_DIM), 0.1),
        "diff_lambda_q2": nrm(ks[12], (DEPTH, DIFF_QK_DIM), 0.1),
        "diff_lambda_k2": nrm(ks[13], (DEPTH, DIFF_QK_DIM), 0.1),
        "diff_subln_w": 1.0 + nrm(ks[14], (DEPTH, HEAD_DIM), 0.01),
        "swa_sink": nrm(ks[15], (DEPTH, SWA_HEADS), 0.5),
        "na_rpb": nrm(ks[16], (DEPTH, NA_HEADS, 2 * NA_ROWS_MAX - 1, 2 * NA_COLS - 1), 0.02),
        "sconv_w": nrm(ks[17], (DEPTH, SCONV_WIDTH, SCONV_CH), SCONV_WIDTH ** -0.5),
        "ffn_w_up": nrm(ks[18], (DEPTH, D_MODEL, 2 * D_FF), D_MODEL ** -0.5),
        "ffn_conv_w": nrm(ks[19], (DEPTH, FFN_CONV_WIDTH, 2 * D_FF), FFN_CONV_WIDTH ** -0.5),
        "ffn_conv_b": nrm(ks[20], (DEPTH, 2 * D_FF), 0.02),
        "ffn_w_down": nrm(ks[21], (DEPTH, D_FF, D_MODEL), D_FF ** -0.5),
        "final_norm_w": 1.0 + nrm(ks[22], (D_MODEL,), 0.01),
    }


def reference(x, c, ctx, c_ctx, norm_mix_w, norm_ffn_w, w_mod, b_mod, w_in, w_out,
              diff_lambda_q1, diff_lambda_k1, diff_lambda_q2, diff_lambda_k2, diff_subln_w,
              swa_sink, na_rpb, sconv_w, ffn_w_up, ffn_conv_w, ffn_conv_b, ffn_w_down, final_norm_w):
    s = x.shape[1]
    ang_a_row, ang_a_col = axial_rope_angles(s, DIFF_QK_DIM)
    ang_b_row, ang_b_col = axial_rope_angles(s, HEAD_DIM)
    c_act = jax.nn.silu(c)
    cc_act = jax.nn.silu(c_ctx)
    o1 = A_COLS
    o2 = o1 + B_COLS
    o3 = o2 + C_COLS
    xl, xc = x, ctx
    for l in range(DEPTH):
        need_ctx = l < DEPTH - 1
        mod_l = (c_act @ w_mod[l] + b_mod[l])[:, None, :]
        mod_c = (cc_act @ w_mod[l] + b_mod[l])[None, None, :]
        sh1, sc1, g1, sh2, sc2, g2 = jnp.split(mod_l, 6, axis=-1)
        csh1, csc1, cg1, csh2, csc2, cg2 = jnp.split(mod_c, 6, axis=-1)
        hl = modulate(rmsnorm(xl, norm_mix_w[l]), sh1, sc1) @ w_in[l]
        hc = modulate(rmsnorm(xc, norm_mix_w[l]), csh1, csc1) @ w_in[l]
        oa_l, oa_c = diff_attention(hl[..., :o1], hc[..., :o1], diff_lambda_q1[l], diff_lambda_k1[l],
                                    diff_lambda_q2[l], diff_lambda_k2[l], diff_subln_w[l], l,
                                    ang_a_row, ang_a_col, need_ctx)
        ob_l, ob_c = window_gqa(hl[..., o1:o2], hc[..., o1:o2], swa_sink[l], ang_b_row, ang_b_col, need_ctx)
        oc_l, oc_c = neighborhood_attention(hl[..., o2:o3], hc[..., o2:o3], na_rpb[l], need_ctx)
        od_l, od_c = short_conv_mixer(hl[..., o3:], hc[..., o3:], sconv_w[l], need_ctx)
        yl = jnp.concatenate([oa_l, ob_l, oc_l, od_l], axis=-1) @ w_out[l]
        xl = xl + g1 * yl
        fl = modulate(rmsnorm(xl, norm_ffn_w[l]), sh2, sc2)
        xl = xl + g2 * conv_ffn(fl, ffn_w_up[l], ffn_conv_w[l], ffn_conv_b[l], ffn_w_down[l])
        if need_ctx:
            yc = jnp.concatenate([oa_c, ob_c, oc_c, od_c], axis=-1) @ w_out[l]
            xc = xc + cg1 * yc
            fc = modulate(rmsnorm(xc, norm_ffn_w[l]), csh2, csc2)
            xc = xc + cg2 * conv_ffn(fc, ffn_w_up[l], ffn_conv_w[l], ffn_conv_b[l], ffn_w_down[l])
    return rmsnorm(xl, final_norm_w)
```

```cpp
#include <hip/hip_runtime.h>
#include <hip/hip_cooperative_groups.h>
#include <cstdio>
#include <cstdint>
namespace cg = cooperative_groups;

#ifndef MK_MULTI
#define MK_MULTI 0
#endif

__device__ __forceinline__ int pg8_ltid() { int t = threadIdx.x; asm volatile("" : "+v"(t)); return t; }
namespace pg8 {
#define PG8_LAS __attribute__((address_space(3)))
typedef unsigned short bf16_t;
typedef short bf16x8 __attribute__((ext_vector_type(8)));
typedef float f32x4 __attribute__((ext_vector_type(4)));
typedef unsigned u32x4 __attribute__((ext_vector_type(4)));
constexpr int BM = 256, BK = 64, HALF = 128, HTB = HALF * BK * 2  , STAGE_BYTES = 8 * HTB, NXCD = 8, WGM = 8;

__host__ __device__ __forceinline__ int lds_byte(int r, int c) { const int st = (r >> 4) * 2 + (c >> 5), rr = r & 15, cc = c & 31, ob = rr * 64 + cc * 2; return st * 1024 + (ob ^ (((ob >> 9) & 1) << 5)); }
__host__ __device__ __forceinline__ void stage_rc(int b, int& R, int& C) { const int st = b / 1024, sb = b % 1024, swz = sb ^ (((sb >> 9) & 1) << 5); R = (st >> 1) * 16 + swz / 64; C = (st & 1) * 32 + (swz % 64) / 2; }
__host__ __device__ __forceinline__ int perm32(int rho) { const int n = rho >> 4, i = rho & 15; return 8 * (i >> 2) + 4 * n + (i & 3); }

struct Unit { int pm, pn; };
struct Gemm { const bf16_t* A; const bf16_t* Bt; int M, N, K; };

struct StaticOrder {
    int nM, nN, nwg, G, c;
    __host__ __device__ void init(int M, int N, int G_, int c_) { nM = M / BM; nN = N / BM; nwg = nM * nN; G = G_; c = c_; }
    __host__ __device__ bool next(int i, Unit& u) const {
        const long L = (long)i * G + c; if (L >= nwg) return false;
        int wgid = (int)L; { const int q = nwg / NXCD, r = nwg % NXCD, xcd = wgid % NXCD, off = wgid / NXCD; wgid = (xcd < r ? xcd * (q + 1) : r * (q + 1) + (xcd - r) * q) + off; }
        const int nig = WGM * nN, gid = wgid / nig, fm = gid * WGM, gsz = (nM - fm) < WGM ? (nM - fm) : WGM;
        u.pm = fm + ((wgid % nig) % gsz); u.pn = (wgid % nig) / gsz; return true;
    }
    __device__ __forceinline__ void a_ready(const Unit&) const {}
    __device__ __forceinline__ void done(const Unit&) const {}
};

__device__ __forceinline__ unsigned cvt_pk_bf16(float lo, float hi) { unsigned r; asm volatile("v_cvt_pk_bf16_f32 %0, %1, %2" : "=v"(r) : "v"(lo), "v"(hi)); return r; }
typedef unsigned u32x2 __attribute__((ext_vector_type(2)));

struct OneUnit {
    Unit u;
    __device__ __forceinline__ bool next(int i, Unit& o) const { if (i != 0) return false; o = u; return true; }
    __device__ __forceinline__ void a_ready(const Unit&) const {}
    __device__ __forceinline__ void done(const Unit&) const {}
};

struct EpiInProj {
    static constexpr bool PERM = false, AFTER_DRAIN = false;
    bf16_t* H; const float* tabA; const float* tabB;
    __device__ __forceinline__ void operator()(const f32x4 (&acc)[2][2][4][2], const Unit& u, int wr, int wc, int fr, int fq) const {
        const int pn = u.pn; const bool latent = u.pm < 128;
        const float scale = (pn == 0) ? 0.17677669529663687f * 1.4426950408889634f : ((pn == 3 || pn == 5) ? 0.125f * 1.4426950408889634f : 1.0f);
#pragma unroll
        for (int bj = 0; bj < 2; ++bj) {
            int mode = (pn == 0 || pn == 1) ? 1 : ((pn == 3 || (pn == 4 && bj == 0)) ? 2 : 0);
            if (!latent) mode = 0;
#ifdef TEST_NOROPE
            mode = 0;
#endif
#pragma unroll
            for (int ai = 0; ai < 2; ++ai)
#pragma unroll
                for (int m = 0; m < 4; ++m) {
                    const int r = u.pm * BM + ai * HALF + wr * 64 + m * 16 + fr;
                    f32x4 v0 = acc[ai][bj][m][0], v1 = acc[ai][bj][m][1];
                    if (mode != 0) {
                        const int t = r & 8191, trow = t >> 6, tcol = t & 63;
                        const float* tp;
                        if (mode == 1) { const int pos = (fq < 2) ? trow : tcol; tp = tabA + (pos * 8 + 4 * (fq & 1)) * 2; }
                        else { const int pos = (wc & 1) ? tcol : trow; tp = tabB + (pos * 16 + 4 * fq) * 2; }
                        const f32x4 cs0 = *(const f32x4*)tp, cs1 = *(const f32x4*)(tp + 4);
                        const float c0 = cs0[0], s0 = cs0[1], c1 = cs0[2], s1 = cs0[3], c2 = cs1[0], s2 = cs1[1], c3 = cs1[2], s3 = cs1[3];
                        f32x4 a = v0, b = v1;
                        v0[0] = a[0] * c0 - b[0] * s0; v1[0] = b[0] * c0 + a[0] * s0;
                        v0[1] = a[1] * c1 - b[1] * s1; v1[1] = b[1] * c1 + a[1] * s1;
                        v0[2] = a[2] * c2 - b[2] * s2; v1[2] = b[2] * c2 + a[2] * s2;
                        v0[3] = a[3] * c3 - b[3] * s3; v1[3] = b[3] * c3 + a[3] * s3;
                    }
                    v0 = v0 * scale; v1 = v1 * scale;
                    bf16_t* rowp = H + (size_t)r * 2816 + pn * BM + bj * HALF + wc * 32 + 4 * fq;
                    u32x2 w0, w1; w0.x = cvt_pk_bf16(v0[0], v0[1]); w0.y = cvt_pk_bf16(v0[2], v0[3]); w1.x = cvt_pk_bf16(v1[0], v1[1]); w1.y = cvt_pk_bf16(v1[2], v1[3]);
                    *(u32x2*)rowp = w0; *(u32x2*)(rowp + 16) = w1;
                }
        }
    }
};

struct EpiRes {
    static constexpr bool PERM = false, AFTER_DRAIN = false;
    const float* baseL; const float* baseC; float* outL; float* outC; const float* modl; int goff;
    __device__ __forceinline__ void operator()(const f32x4 (&acc)[2][2][4][2], const Unit& u, int wr, int wc, int fr, int fq) const {
        const bool ctx = u.pm >= 128; const int slot = ctx ? 4 : (u.pm >> 5);
        const int row0 = (ctx ? (u.pm - 128) : u.pm) * BM + wr * 64 + fr;
        const float* bp = ctx ? baseC : baseL; float* op = ctx ? outC : outL;
        const int col0 = u.pn * BM + wc * 32 + 4 * fq;
        f32x4 gv[2][2];
#pragma unroll
        for (int bj = 0; bj < 2; ++bj)
#pragma unroll
            for (int n = 0; n < 2; ++n) gv[bj][n] = *(const f32x4*)(modl + slot * 6144 + goff + col0 + bj * HALF + n * 16);
#pragma unroll
        for (int ai = 0; ai < 2; ++ai)
#pragma unroll
            for (int m = 0; m < 4; ++m) {
                const size_t off = (size_t)(row0 + ai * HALF + m * 16) * 1024 + col0;
#pragma unroll
                for (int bj = 0; bj < 2; ++bj)
#pragma unroll
                    for (int n = 0; n < 2; ++n) {
                        const f32x4 bs = *(const f32x4*)(bp + off + bj * HALF + n * 16);
                        *(f32x4*)(op + off + bj * HALF + n * 16) = bs + gv[bj][n] * acc[ai][bj][m][n];
                    }
                asm volatile("" ::: "memory");
            }
    }
};

struct EpiUpConv {
    static constexpr bool PERM = false, AFTER_DRAIN = true;
    bf16_t* ACT; const float* cw; const float* cb;
    static constexpr int TP = 520;
    __device__ __forceinline__ void fused(f32x4 (&acc)[2][2][4][2], const Unit& u, int wr, int wc, int fr, int fq, PG8_LAS unsigned char* lds, int wid, int lane) const {
#pragma unroll
        for (int ai = 0; ai < 2; ++ai)
#pragma unroll
            for (int m = 0; m < 4; ++m) {
                const int row = ai * HALF + wr * 64 + m * 16 + fr;
#pragma unroll
                for (int bj = 0; bj < 2; ++bj)
#pragma unroll
                    for (int n = 0; n < 2; ++n) {
                        const f32x4 v = acc[ai][bj][m][n]; u32x2 w; w.x = cvt_pk_bf16(v[0], v[1]); w.y = cvt_pk_bf16(v[2], v[3]);
                        *(PG8_LAS u32x2*)(lds + row * TP + (bj * HALF + wc * 32 + n * 16 + 4 * fq) * 2) = w;
                    }
            }
        const int tid = wid * 64 + lane, ch = tid & 15;
        const int gcol = u.pn * 128 + ch * 8;
        float wg[3][8], wv[3][8], bg[8], bv[8];
#pragma unroll
        for (int k = 0; k < 3; ++k) {
            const f32x4 a0 = *(const f32x4*)(cw + k * 5632 + gcol), a1 = *(const f32x4*)(cw + k * 5632 + gcol + 4);
            const f32x4 b0 = *(const f32x4*)(cw + k * 5632 + 2816 + gcol), b1 = *(const f32x4*)(cw + k * 5632 + 2816 + gcol + 4);
#pragma unroll
            for (int e = 0; e < 4; ++e) { wg[k][e] = a0[e]; wg[k][4 + e] = a1[e]; wv[k][e] = b0[e]; wv[k][4 + e] = b1[e]; }
        }
        {
            const f32x4 a0 = *(const f32x4*)(cb + gcol), a1 = *(const f32x4*)(cb + gcol + 4), b0 = *(const f32x4*)(cb + 2816 + gcol), b1 = *(const f32x4*)(cb + 2816 + gcol + 4);
#pragma unroll
            for (int e = 0; e < 4; ++e) { bg[e] = a0[e]; bg[4 + e] = a1[e]; bv[e] = b0[e]; bv[4 + e] = b1[e]; }
        }
        int seqlen, rowbase, ti;
        if (u.pm < 132) { const int s = u.pm / 33; ti = u.pm - s * 33; seqlen = 8192; rowbase = s * 8192; }
        else { const int q = u.pm - 132; const int s = q >> 1; ti = q & 1; seqlen = 256; rowbase = 32768 + s * 256; }
        asm volatile("s_waitcnt lgkmcnt(0)" ::: "memory"); __builtin_amdgcn_s_barrier(); asm volatile("" ::: "memory");
        for (int it = tid; it < 254 * 16; it += 512) {
            const int j = 1 + (it >> 4); const int t = 254 * ti - 1 + j;
            if (t < seqlen) {
                float g[8], v[8];
#pragma unroll
                for (int e = 0; e < 8; ++e) { g[e] = bg[e]; v[e] = bv[e]; }
#pragma unroll
                for (int k = 0; k < 3; ++k) {
                    const PG8_LAS unsigned char* rp = lds + (j - 1 + k) * TP + ch * 16;
                    const u32x2 g0 = *(const PG8_LAS u32x2*)rp, g1 = *(const PG8_LAS u32x2*)(rp + 8);
                    const u32x2 v0 = *(const PG8_LAS u32x2*)(rp + 256), v1 = *(const PG8_LAS u32x2*)(rp + 264);
                    const unsigned gw[4] = {g0.x, g0.y, g1.x, g1.y}, vw[4] = {v0.x, v0.y, v1.x, v1.y};
#pragma unroll
                    for (int e = 0; e < 4; ++e) {
                        g[2 * e] += wg[k][2 * e] * __uint_as_float(gw[e] << 16); g[2 * e + 1] += wg[k][2 * e + 1] * __uint_as_float(gw[e] & 0xffff0000u);
                        v[2 * e] += wv[k][2 * e] * __uint_as_float(vw[e] << 16); v[2 * e + 1] += wv[k][2 * e + 1] * __uint_as_float(vw[e] & 0xffff0000u);
                    }
                }
                float o[8];
#pragma unroll
                for (int e = 0; e < 8; ++e) o[e] = g[e] / (1.f + __expf(-g[e])) * v[e];
                u32x4 w; w.x = cvt_pk_bf16(o[0], o[1]); w.y = cvt_pk_bf16(o[2], o[3]); w.z = cvt_pk_bf16(o[4], o[5]); w.w = cvt_pk_bf16(o[6], o[7]);
                *(u32x4*)(ACT + (size_t)(rowbase + t) * 2816 + gcol) = w;
            }
        }
        asm volatile("s_waitcnt lgkmcnt(0)" ::: "memory"); __builtin_amdgcn_s_barrier(); asm volatile("" ::: "memory");
    }
};
template <class Epi, class Sched, bool ALIGN_EPI = false, bool SP2 = false>
__device__ __forceinline__ void gemm_phase(PG8_LAS unsigned char* lds, const Gemm g, const Sched& S, const Epi& E) {
    const int tid = pg8_ltid(), wid = __builtin_amdgcn_readfirstlane(tid >> 6), lane = tid & 63, wr = wid >> 2, wc = wid & 3, fr = lane & 15, fq = lane >> 4;
    const int K = g.K, nt = K / BK;
    unsigned voffA[2], voffB[2];
#pragma unroll
    for (int i = 0; i < 2; ++i) { int R, C; stage_rc(tid * 16 + i * 8192, R, C); const int Rb = Epi::PERM ? ((R & ~31) + perm32(R & 31)) : R;
        voffA[i] = (unsigned)(R * K + C) * 2u; voffB[i] = (unsigned)(Rb * K + C) * 2u; }
    const size_t kstep = (size_t)(BK * 2);
    const size_t hstep = (size_t)HALF * K * 2;
    const size_t tstep = 2 * hstep;
    const unsigned ldsw = (unsigned)wid * 1024u;
    const int aoff = lds_byte(wr * 64 + fr, fq * 8), boff = lds_byte(wc * 32 + fr, fq * 8);
#define PG8_SA(b, h) (((b) * 2 + (h)) * HTB)
#define PG8_SB(b, h) ((4 + (b) * 2 + (h)) * HTB)
#define PG8_STAGE(bufoff, gbase, voff) do { _Pragma("unroll") for (int _i = 0; _i < 2; ++_i) \
        __builtin_amdgcn_global_load_lds((const unsigned*)((const char*)(gbase) + (voff)[_i]), (PG8_LAS unsigned*)(lds + (bufoff) + ldsw + _i * 8192), 16, 0, 0); } while (0)
#define PG8_LDA(dst, b, h) do { _Pragma("unroll") for (int m = 0; m < 4; ++m) _Pragma("unroll") for (int k = 0; k < 2; ++k) dst[m][k] = *(const PG8_LAS bf16x8*)(lds + PG8_SA(b, h) + aoff + m * 2048 + k * 1024); } while (0)
#define PG8_LDB(dst, b, h) do { _Pragma("unroll") for (int n = 0; n < 2; ++n) _Pragma("unroll") for (int k = 0; k < 2; ++k) dst[n][k] = *(const PG8_LAS bf16x8*)(lds + PG8_SB(b, h) + boff + n * 2048 + k * 1024); } while (0)
#define PG8_MMA(ai, bj, At, Bt) do { __builtin_amdgcn_s_setprio(1); _Pragma("unroll") for (int m = 0; m < 4; ++m) _Pragma("unroll") for (int n = 0; n < 2; ++n) _Pragma("unroll") for (int k = 0; k < 2; ++k) \
        acc[ai][bj][m][n] = __builtin_amdgcn_mfma_f32_16x16x32_bf16(Bt[n][k], At[m][k], acc[ai][bj][m][n], 0, 0, 0); __builtin_amdgcn_s_setprio(0); } while (0)
#define PG8_WAIT_V(n) asm volatile("s_waitcnt vmcnt(" #n ")" ::: "memory")
#define PG8_WAIT_L(n) asm volatile("s_waitcnt lgkmcnt(" #n ")" ::: "memory")
#define PG8_BAR __builtin_amdgcn_s_barrier()
#define PG8_SCHED __builtin_amdgcn_sched_barrier(0)
    Unit cur, nxt; int ui = 0;
    if (!S.next(0, cur)) return;
    f32x4 acc[2][2][4][2];
#pragma unroll
    for (int a = 0; a < 2; ++a)
#pragma unroll
        for (int b = 0; b < 2; ++b)
#pragma unroll
            for (int m = 0; m < 4; ++m)
#pragma unroll
                for (int n = 0; n < 2; ++n) acc[a][b][m][n] = (f32x4){0.f, 0.f, 0.f, 0.f};
    bf16x8 At[4][2], B0[2][2], B1[2][2];
    const char* cA = (const char*)g.A + (size_t)cur.pm * tstep; const char* cB = (const char*)g.Bt + (size_t)cur.pn * tstep;
    S.a_ready(cur);
    if constexpr (SP2) {
        PG8_STAGE(PG8_SB(0, 0), cB, voffB); PG8_STAGE(PG8_SB(0, 1), cB + hstep, voffB); PG8_STAGE(PG8_SA(0, 0), cA, voffA); PG8_STAGE(PG8_SA(0, 1), cA + hstep, voffA);
        if (wr == 1) PG8_BAR;
        PG8_WAIT_V(2); PG8_BAR;
        PG8_STAGE(PG8_SB(1, 0), cB + kstep, voffB); PG8_STAGE(PG8_SA(1, 0), cA + kstep, voffA); PG8_STAGE(PG8_SB(1, 1), cB + hstep + kstep, voffB);
        PG8_WAIT_V(6); PG8_BAR;
    } else {
        PG8_STAGE(PG8_SB(0, 0), cB, voffB); PG8_STAGE(PG8_SA(0, 0), cA, voffA); PG8_STAGE(PG8_SB(0, 1), cB + hstep, voffB); PG8_STAGE(PG8_SA(0, 1), cA + hstep, voffA);
        if (wr == 1) PG8_BAR;
        PG8_WAIT_V(4); PG8_BAR;
        PG8_STAGE(PG8_SB(1, 0), cB + kstep, voffB); PG8_STAGE(PG8_SA(1, 0), cA + kstep, voffA); PG8_STAGE(PG8_SB(1, 1), cB + hstep + kstep, voffB);
        PG8_WAIT_V(6); PG8_BAR;
    }
    for (;;) {
        const bool has_next = S.next(ui + 1, nxt);
        const char* nA = has_next ? (const char*)g.A + (size_t)nxt.pm * tstep : cA; const char* nB = has_next ? (const char*)g.Bt + (size_t)nxt.pn * tstep : cB;
        for (int t = 0; t < nt; t += 2) {
            const bool last = (t == nt - 2);
            const char* a1 = cA + (size_t)(t + 1) * kstep;
            const char* a2 = last ? nA : cA + (size_t)(t + 2) * kstep; const char* b2 = last ? nB : cB + (size_t)(t + 2) * kstep;
            const char* a3 = a2 + kstep; const char* b3 = b2 + kstep;
            if (last && has_next) S.a_ready(nxt);
            if constexpr (SP2) {
            PG8_LDB(B0, 0, 0); PG8_LDB(B1, 0, 1); PG8_SCHED; PG8_LDA(At, 0, 0); PG8_STAGE(PG8_SA(1, 1), a1 + hstep, voffA);
            PG8_WAIT_V(8); PG8_WAIT_L(0); PG8_BAR; PG8_MMA(0, 0, At, B0); PG8_MMA(0, 1, At, B1); PG8_BAR; PG8_SCHED;
            PG8_LDA(At, 0, 1); PG8_STAGE(PG8_SB(0, 0), b2, voffB); PG8_STAGE(PG8_SB(0, 1), b2 + hstep, voffB); PG8_STAGE(PG8_SA(0, 0), a2, voffA);
            PG8_WAIT_V(8); PG8_WAIT_L(0); PG8_BAR; PG8_MMA(1, 0, At, B0); PG8_MMA(1, 1, At, B1); PG8_BAR; PG8_SCHED;
            PG8_LDB(B0, 1, 0); PG8_LDB(B1, 1, 1); PG8_SCHED; PG8_LDA(At, 1, 0); PG8_STAGE(PG8_SA(0, 1), a2 + hstep, voffA);
            PG8_WAIT_V(8); PG8_WAIT_L(0); PG8_BAR; PG8_MMA(0, 0, At, B0); PG8_MMA(0, 1, At, B1); PG8_BAR; PG8_SCHED;
            PG8_LDA(At, 1, 1); PG8_STAGE(PG8_SB(1, 0), b3, voffB); PG8_STAGE(PG8_SB(1, 1), b3 + hstep, voffB); PG8_STAGE(PG8_SA(1, 0), a3, voffA);
            PG8_WAIT_V(8); PG8_WAIT_L(0); PG8_BAR; PG8_MMA(1, 0, At, B0); PG8_MMA(1, 1, At, B1); PG8_BAR; PG8_SCHED;
            } else {
            PG8_LDB(B0, 0, 0); PG8_SCHED; PG8_LDA(At, 0, 0); PG8_STAGE(PG8_SA(1, 1), a1 + hstep, voffA);
            PG8_WAIT_L(8); PG8_BAR; PG8_WAIT_L(0); PG8_MMA(0, 0, At, B0); PG8_BAR; PG8_SCHED;
            PG8_LDB(B1, 0, 1); PG8_STAGE(PG8_SB(0, 0), b2, voffB);
            PG8_BAR; PG8_WAIT_L(0); PG8_MMA(0, 1, At, B1); PG8_BAR;
            PG8_LDA(At, 0, 1); PG8_STAGE(PG8_SA(0, 0), a2, voffA);
            PG8_BAR; PG8_WAIT_L(0); PG8_MMA(1, 0, At, B0); PG8_BAR; PG8_SCHED;
            PG8_STAGE(PG8_SB(0, 1), b2 + hstep, voffB);
            PG8_WAIT_V(6); PG8_BAR; PG8_MMA(1, 1, At, B1); PG8_BAR;
            PG8_LDB(B0, 1, 0); PG8_SCHED; PG8_LDA(At, 1, 0); PG8_STAGE(PG8_SA(0, 1), a2 + hstep, voffA);
            PG8_WAIT_L(8); PG8_BAR; PG8_WAIT_L(0); PG8_MMA(0, 0, At, B0); PG8_BAR; PG8_SCHED;
            PG8_LDB(B1, 1, 1); PG8_STAGE(PG8_SB(1, 0), b3, voffB);
            PG8_BAR; PG8_WAIT_L(0); PG8_MMA(0, 1, At, B1); PG8_BAR;
            PG8_LDA(At, 1, 1); PG8_STAGE(PG8_SA(1, 0), a3, voffA);
            PG8_BAR; PG8_WAIT_L(0); PG8_MMA(1, 0, At, B0); PG8_BAR; PG8_SCHED;
            PG8_STAGE(PG8_SB(1, 1), b3 + hstep, voffB);
            PG8_WAIT_V(6); PG8_BAR; PG8_MMA(1, 1, At, B1); PG8_BAR;
            }
        }
        if constexpr (ALIGN_EPI) { if (wr == 0) PG8_BAR; }
        if constexpr (!Epi::AFTER_DRAIN) { E(acc, cur, wr, wc, fr, fq); S.done(cur); }
        if (!has_next) break;
#pragma unroll
        for (int a = 0; a < 2; ++a)
#pragma unroll
            for (int b = 0; b < 2; ++b)
#pragma unroll
                for (int m = 0; m < 4; ++m)
#pragma unroll
                    for (int n = 0; n < 2; ++n) acc[a][b][m][n] = (f32x4){0.f, 0.f, 0.f, 0.f};
        cur = nxt; cA = nA; cB = nB; ++ui;
        if constexpr (ALIGN_EPI) { if (wr == 1) PG8_BAR; }
    }
    PG8_WAIT_V(0);
    if constexpr (!ALIGN_EPI) { if (wr == 0) PG8_BAR; }
    PG8_BAR;
    if constexpr (Epi::AFTER_DRAIN) { E.fused(acc, cur, wr, wc, fr, fq, lds, wid, lane); S.done(cur); }
#undef PG8_SA
#undef PG8_SB
#undef PG8_STAGE
#undef PG8_LDA
#undef PG8_LDB
#undef PG8_MMA
#undef PG8_WAIT_V
#undef PG8_WAIT_L
#undef PG8_BAR
#undef PG8_SCHED
}
}
#define LAS __attribute__((address_space(3)))
typedef unsigned short bf16_t;
typedef short bf16x8 __attribute__((ext_vector_type(8)));
typedef short s16x4 __attribute__((ext_vector_type(4)));
typedef float f32x4 __attribute__((ext_vector_type(4)));
typedef float f32x16 __attribute__((ext_vector_type(16)));
typedef unsigned u32x4 __attribute__((ext_vector_type(4)));
typedef unsigned u32x2 __attribute__((ext_vector_type(2)));

constexpr int DM = 1024, NB = 4, SEQ = 8192, DEPTH = 4, CTXL = 256;
constexpr int ML = NB * SEQ, MC = NB * CTXL, MT = ML + MC;
constexpr int INC = 2816, DFF = 2816, UPC = 5632;
constexpr int NMX_L = NB * 33, NMX_ALL = NB * 33 + NB * 2;
constexpr float LOG2E = 1.4426950408889634f;

constexpr size_t MiB = 1u << 20;
constexpr size_t WS_MOD = 1 * MiB;
constexpr size_t WS_MODP = 2 * MiB;
constexpr size_t WS_TAB = 10 * MiB;
constexpr size_t WS_XC = 11 * MiB;
constexpr size_t WS_W = 16 * MiB;
constexpr size_t W_LAYER = 24 * MiB, W_OUT_OFF = (size_t)2816 * 1024 * 2, W_UP_OFF = W_OUT_OFF + (size_t)1024 * 1024 * 2, W_DN_OFF = W_UP_OFF + (size_t)5632 * 1024 * 2;
constexpr size_t WS_XN = 112 * MiB;
constexpr size_t WS_O = 182 * MiB;
constexpr size_t WS_H = 248 * MiB;
constexpr size_t WS_END = WS_H + (size_t)MT * 2816 * 2;
static_assert(W_DN_OFF + (size_t)1024 * 2816 * 2 <= W_LAYER, "weights per layer");
static_assert(WS_XN + (size_t)NMX_ALL * 256 * 1024 * 2 <= WS_O && WS_O + (size_t)MT * 1024 * 2 <= WS_H && WS_END <= 512 * MiB, "ws map");

constexpr int RING_BYTES = 135168;
constexpr int LDS_BYTES = 147456;

__device__ __forceinline__ unsigned pkbf(float lo, float hi) { unsigned r; asm volatile("v_cvt_pk_bf16_f32 %0, %1, %2" : "=v"(r) : "v"(lo), "v"(hi)); return r; }
__device__ __forceinline__ float bflo(unsigned w) { return __uint_as_float(w << 16); }
__device__ __forceinline__ float bfhi(unsigned w) { return __uint_as_float(w & 0xffff0000u); }
__device__ __forceinline__ float wave_sum(float v, int lane) {
#pragma unroll
    for (int o = 1; o < 64; o <<= 1) v += __int_as_float(__builtin_amdgcn_ds_bpermute((lane ^ o) << 2, __float_as_int(v)));
    return v;
}
__device__ __forceinline__ float xhalf_max(float v) { auto rr = __builtin_amdgcn_permlane32_swap(__float_as_uint(v), __float_as_uint(v), false, false); return fmaxf(__uint_as_float(rr[0]), __uint_as_float(rr[1])); }
__device__ __forceinline__ float xhalf_sum(float v) { auto rr = __builtin_amdgcn_permlane32_swap(__float_as_uint(v), __float_as_uint(v), false, false); return __uint_as_float(rr[0]) + __uint_as_float(rr[1]); }

namespace att {
constexpr int KP = 144, VP = 136;
constexpr int L_KS = 0, L_VT = 64 * KP, L_RPB = L_VT + 64 * VP, L_END = L_RPB + 2048;
__device__ __forceinline__ int crow(int r, int h) { return (r & 3) + 8 * (r >> 2) + 4 * h; }

struct TileRegs { u32x4 k, v; };
__device__ __forceinline__ void tile_gload(TileRegs& R, const bf16_t* H, int krow, int kcol, int vcol, int tid) {
    const int key = tid >> 3, ch = tid & 7;
    const bf16_t* p = H + (size_t)(krow + key) * INC;
    R.k = *(const u32x4*)(p + kcol + 8 * ch); R.v = *(const u32x4*)(p + vcol + 8 * ch);
}
__device__ __forceinline__ void tile_swrite(const TileRegs& R, LAS unsigned char* lds, int tid) {
    const int key = tid >> 3, ch = tid & 7;
    *(LAS u32x4*)(lds + L_KS + key * KP + ch * 16) = R.k;
    LAS unsigned short* vt = (LAS unsigned short*)(lds + L_VT);
#pragma unroll
    for (int j = 0; j < 4; ++j) { const unsigned w = R.v[j]; vt[(8 * ch + 2 * j) * (VP / 2) + key] = (unsigned short)(w & 0xffffu); vt[(8 * ch + 2 * j + 1) * (VP / 2) + key] = (unsigned short)(w >> 16); }
}
template <int KS0, int NKS>
__device__ __forceinline__ f32x16 qk_block(const LAS unsigned char* lds, int kb, int r32, int hh, const bf16x8 (&qf)[4]) {
    f32x16 s = {0.f, 0.f, 0.f, 0.f, 0.f, 0.f, 0.f, 0.f, 0.f, 0.f, 0.f, 0.f, 0.f, 0.f, 0.f, 0.f};
#pragma unroll
    for (int ks = KS0; ks < KS0 + NKS; ++ks) {
        const bf16x8 kf = *(const LAS bf16x8*)(lds + L_KS + (kb * 32 + r32) * KP + ks * 32 + hh * 16);
        s = __builtin_amdgcn_mfma_f32_32x32x16_bf16(kf, qf[ks], s, 0, 0, 0);
    }
    return s;
}
__device__ __forceinline__ void softmax_pv(f32x16 (&s)[2], float& m, float& l, f32x16 (&O)[2], const LAS unsigned char* lds, int r32, int hh) {
    float mx = s[0][0];
#pragma unroll
    for (int r = 1; r < 16; ++r) mx = fmaxf(mx, s[0][r]);
#pragma unroll
    for (int r = 0; r < 16; ++r) mx = fmaxf(mx, s[1][r]);
    mx = xhalf_max(mx);
    __builtin_amdgcn_sched_barrier(0);
    const float mn = fmaxf(m, mx);
    const float alpha = __builtin_amdgcn_exp2f(m - mn);
    m = mn; l *= alpha;
#pragma unroll
    for (int r = 0; r < 16; ++r) { O[0][r] *= alpha; O[1][r] *= alpha; }
    float ps = 0.f;
#pragma unroll
    for (int kb = 0; kb < 2; ++kb)
#pragma unroll
        for (int r = 0; r < 16; ++r) { const float p = __builtin_amdgcn_exp2f(s[kb][r] - mn); s[kb][r] = p; ps += p; }
    l += ps;
    __builtin_amdgcn_sched_barrier(0);
#pragma unroll
    for (int kb = 0; kb < 2; ++kb)
#pragma unroll
        for (int sk = 0; sk < 2; ++sk) {
            __builtin_amdgcn_sched_barrier(0);
            u32x4 pw; pw.x = pkbf(s[kb][8 * sk + 0], s[kb][8 * sk + 1]); pw.y = pkbf(s[kb][8 * sk + 2], s[kb][8 * sk + 3]);
            pw.z = pkbf(s[kb][8 * sk + 4], s[kb][8 * sk + 5]); pw.w = pkbf(s[kb][8 * sk + 6], s[kb][8 * sk + 7]);
            const bf16x8 pf = __builtin_bit_cast(bf16x8, pw);
#pragma unroll
            for (int dvb = 0; dvb < 2; ++dvb) {
                const LAS unsigned char* a = lds + L_VT + (dvb * 32 + r32) * VP + (kb * 32 + 16 * sk + 4 * hh) * 2;
                const s16x4 lo = *(const LAS s16x4*)a, hi = *(const LAS s16x4*)(a + 16);
                const bf16x8 vf = {lo[0], lo[1], lo[2], lo[3], hi[0], hi[1], hi[2], hi[3]};
                O[dvb] = __builtin_amdgcn_mfma_f32_32x32x16_bf16(vf, pf, O[dvb], 0, 0, 0);
            }
        }
}
__device__ __forceinline__ void store_o(const f32x16 (&o)[2], bf16_t* orow, int hh) {
#pragma unroll
    for (int dvb = 0; dvb < 2; ++dvb)
#pragma unroll
        for (int g = 0; g < 4; ++g) {
            u32x2 w; w.x = pkbf(o[dvb][4 * g], o[dvb][4 * g + 1]); w.y = pkbf(o[dvb][4 * g + 2], o[dvb][4 * g + 3]);
            *(u32x2*)(orow + dvb * 32 + 8 * g + 4 * hh) = w;
        }
}

template <bool CTXQ>
__device__ __forceinline__ void unit_A(LAS unsigned char* lds, const bf16_t* H, bf16_t* Ob, int b, int h, int qb, float lam, float ofac, const float* subw) {
    const int tid = pg8_ltid(), lane = tid & 63, r32 = lane & 31, hh = lane >> 5, wid = tid >> 6;
    const int qrow = CTXQ ? (ML + b * CTXL + wid * 32 + r32) : (b * SEQ + qb * 256 + wid * 32 + r32);
    const int qcol = h * 64, kcol = 256 + h * 64, vcol = 512 + h * 64;
    bf16x8 qf[4];
#pragma unroll
    for (int ks = 0; ks < 4; ++ks) qf[ks] = *(const bf16x8*)(H + (size_t)qrow * INC + qcol + 16 * ks + 8 * hh);
    const int NT = CTXQ ? 4 : 132;
    f32x16 O1[2], O2[2];
#pragma unroll
    for (int r = 0; r < 16; ++r) { O1[0][r] = 0.f; O1[1][r] = 0.f; O2[0][r] = 0.f; O2[1][r] = 0.f; }
    float m1 = -INFINITY, m2 = -INFINITY, l1 = 0.f, l2 = 0.f;
    TileRegs R;
    tile_gload(R, H, CTXQ ? (ML + b * CTXL) : (b * SEQ), kcol, vcol, tid);
    for (int t = 0; t < NT; ++t) {
        __syncthreads();
        tile_swrite(R, lds, tid);
        __syncthreads();
        if (t + 1 < NT) { const int tn = t + 1; const int krow = CTXQ ? (ML + b * CTXL + 64 * tn) : (tn < 128 ? b * SEQ + 64 * tn : ML + b * CTXL + 64 * (tn - 128)); tile_gload(R, H, krow, kcol, vcol, tid); }
        { f32x16 s[2]; s[0] = qk_block<0, 2>(lds, 0, r32, hh, qf); s[1] = qk_block<0, 2>(lds, 1, r32, hh, qf); softmax_pv(s, m1, l1, O1, lds, r32, hh); }
        __builtin_amdgcn_sched_barrier(0);
        { f32x16 s[2]; s[0] = qk_block<2, 2>(lds, 0, r32, hh, qf); s[1] = qk_block<2, 2>(lds, 1, r32, hh, qf); softmax_pv(s, m2, l2, O2, lds, r32, hh); }
        __builtin_amdgcn_sched_barrier(0);
    }
    l1 = xhalf_sum(l1); l2 = xhalf_sum(l2);
    const float i1 = 1.f / l1, i2 = lam / l2;
    float ss = 0.f;
#pragma unroll
    for (int dvb = 0; dvb < 2; ++dvb)
#pragma unroll
        for (int r = 0; r < 16; ++r) { const float o = O1[dvb][r] * i1 - O2[dvb][r] * i2; O1[dvb][r] = o; ss += o * o; }
    ss = xhalf_sum(ss);
    const float rn = rsqrtf(ss * (1.f / 64.f) + 1e-6f) * ofac;
#pragma unroll
    for (int dvb = 0; dvb < 2; ++dvb)
#pragma unroll
        for (int g = 0; g < 4; ++g) {
            const f32x4 w = *(const f32x4*)(subw + dvb * 32 + 8 * g + 4 * hh);
#pragma unroll
            for (int e = 0; e < 4; ++e) O1[dvb][4 * g + e] *= rn * w[e];
        }
    store_o(O1, Ob + (size_t)qrow * DM + h * 64, hh);
}

template <int MODE> __device__ __forceinline__ int tile_row_f(int t, int b, int lo, int nloc) {
    if (MODE == 1) return (t < nloc) ? (b * SEQ + 64 * (lo + t)) : (ML + b * CTXL + 64 * (t - nloc));
    if (MODE == 2) return (t < 4) ? (ML + b * CTXL + 64 * t) : (b * SEQ + 64 * (lo + t - 4));
    return ML + b * CTXL + 64 * t;
}
template <int MODE>
__device__ __forceinline__ void unit_BC(LAS unsigned char* lds, const bf16_t* H, bf16_t* Ob, int b, int hd, int blk, const float* sink_l, const float* rpb_l) {
    const int tid = pg8_ltid(), lane = tid & 63, r32 = lane & 31, hh = lane >> 5, wid = tid >> 6;
    int qrow, qcol, kcol, vcol, ocol, qpos = 0, r_w = 0, qc = 0, lo = 0, nloc = 0;
    float m = -INFINITY, l = 0.f;
    if (MODE == 1) {
        const int g = wid >> 2, head = hd * 2 + g; qpos = 128 * blk + 32 * (wid & 3) + r32; qrow = b * SEQ + qpos;
        qcol = 768 + head * 64; kcol = 1024 + hd * 64; vcol = 1152 + hd * 64; ocol = 256 + head * 64;
        lo = 2 * blk - 2; if (lo < 0) lo = 0; int hi = 2 * blk + 3; if (hi > 127) hi = 127; nloc = hi - lo + 1;
        m = sink_l[head] * LOG2E; l = (hh == 0) ? 1.f : 0.f;
    } else if (MODE == 3) {
        const int head = hd * 2 + blk; qrow = ML + b * CTXL + wid * 32 + r32;
        qcol = 768 + head * 64; kcol = 1024 + hd * 64; vcol = 1152 + hd * 64; ocol = 256 + head * 64;
        m = sink_l[head] * LOG2E; l = (hh == 0) ? 1.f : 0.f;
    } else if (MODE == 2) {
        r_w = 4 * blk + (wid >> 1); qc = 32 * (wid & 1) + r32; qrow = b * SEQ + r_w * 64 + qc;
        qcol = 1280 + hd * 64; kcol = 1536 + hd * 64; vcol = 1792 + hd * 64; ocol = 512 + hd * 64;
        int a0 = 4 * blk - 4; if (a0 < 0) a0 = 0; if (a0 > 120) a0 = 120; int a3 = 4 * blk + 3 - 4; if (a3 < 0) a3 = 0; if (a3 > 120) a3 = 120;
        lo = a0; nloc = a3 + 7 - a0 + 1;
    } else {
        qrow = ML + b * CTXL + wid * 32 + r32;
        qcol = 1280 + hd * 64; kcol = 1536 + hd * 64; vcol = 1792 + hd * 64; ocol = 512 + hd * 64;
    }
    bf16x8 qf[4];
#pragma unroll
    for (int ks = 0; ks < 4; ++ks) qf[ks] = *(const bf16x8*)(H + (size_t)qrow * INC + qcol + 16 * ks + 8 * hh);
    f32x16 O[2];
#pragma unroll
    for (int r = 0; r < 16; ++r) { O[0][r] = 0.f; O[1][r] = 0.f; }
    const int NT = 4 + nloc;
    int rs = 0;
    if (MODE == 2) { rs = r_w - 4; if (rs < 0) rs = 0; if (rs > 120) rs = 120; }
    const LAS float* rpbs = (const LAS float*)(lds + L_RPB);
    TileRegs R;
    tile_gload(R, H, tile_row_f<MODE>(0, b, lo, nloc), kcol, vcol, tid);
    for (int t = 0; t < NT; ++t) {
        __syncthreads();
        tile_swrite(R, lds, tid);
        if (MODE == 2 && t == 0) { for (int i = tid; i < 465; i += 512) ((LAS float*)(lds + L_RPB))[i] = rpb_l[hd * 465 + i] * LOG2E; }
        __syncthreads();
        if (t + 1 < NT) tile_gload(R, H, tile_row_f<MODE>(t + 1, b, lo, nloc), kcol, vcol, tid);
        bool active = true; int kr = 0;
        if (MODE == 2 && t >= 4) { kr = lo + t - 4; active = (kr >= rs) && (kr < rs + 8); }
        if (active) {
            f32x16 s[2]; s[0] = qk_block<0, 4>(lds, 0, r32, hh, qf); s[1] = qk_block<0, 4>(lds, 1, r32, hh, qf);
            if (MODE == 1 && t < nloc) {
                const int kbase = 64 * (lo + t) - qpos;
#pragma unroll
                for (int kb = 0; kb < 2; ++kb)
#pragma unroll
                    for (int r = 0; r < 16; ++r) { const int d = kbase + kb * 32 + crow(r, hh); if (d > 128 || d < -128) s[kb][r] = -INFINITY; }
            }
            if (MODE == 2 && t >= 4) {
                int cs = qc - 8; if (cs < 0) cs = 0; if (cs > 48) cs = 48;
                const int bbase = (kr - r_w + 7) * 31 + 15 - qc;
#pragma unroll
                for (int kb = 0; kb < 2; ++kb)
#pragma unroll
                    for (int r = 0; r < 16; ++r) {
                        const int kc = kb * 32 + crow(r, hh);
                        const bool ok = (kc >= cs) && (kc < cs + 16);
                        int bi = bbase + kc; bi = ok ? bi : 0;
                        const float bias = rpbs[bi];
                        s[kb][r] = ok ? (s[kb][r] + bias) : -INFINITY;
                    }
            }
            softmax_pv(s, m, l, O, lds, r32, hh);
        }
    }
    l = xhalf_sum(l);
    const float il = 1.f / l;
#pragma unroll
    for (int r = 0; r < 16; ++r) { O[0][r] *= il; O[1][r] *= il; }
    store_o(O, Ob + (size_t)qrow * DM + ocol, hh);
}
}
__device__ __forceinline__ float silu_f(float v) { return v / (1.f + __expf(-v)); }

__device__ __forceinline__ int wrow_map(int type, int n) {
    if (type == 1) { if (n < 512) { const int p = n & 31, blk = p >> 3; const int np = (blk == 1) ? p + 8 : ((blk == 2) ? p - 8 : p); return (n & ~31) + np; } return n; }
    if (type == 2) { const int half = (n >= 2816) ? 1 : 0; const int j = n - half * 2816; return (j >> 7) * 256 + half * 128 + (j & 127); }
    return n;
}
__device__ __forceinline__ void transpose_item(const float* W, int K, int N, bf16_t* WT, int type, LAS float* scr, int item, int lane) {
    const int nblk = N / 32, kb = item / nblk, nb = item - kb * nblk, k0 = 64 * kb, n0 = 32 * nb;
#pragma unroll 8
    for (int i = 0; i < 32; ++i) { const int kk = 2 * i + (lane >> 5); scr[kk * 33 + (lane & 31)] = W[(size_t)(k0 + kk) * N + n0 + (lane & 31)]; }
    asm volatile("s_waitcnt lgkmcnt(0)" ::: "memory");
    const int c = lane & 7;
#pragma unroll
    for (int j = 0; j < 4; ++j) {
        const int n = (lane >> 3) + 8 * j; const LAS float* s = scr + (8 * c) * 33 + n;
        u32x4 o; o.x = pkbf(s[0 * 33], s[1 * 33]); o.y = pkbf(s[2 * 33], s[3 * 33]); o.z = pkbf(s[4 * 33], s[5 * 33]); o.w = pkbf(s[6 * 33], s[7 * 33]);
        *(u32x4*)(WT + (size_t)wrow_map(type, n0 + n) * K + k0 + 8 * c) = o;
    }
    asm volatile("s_waitcnt lgkmcnt(0)" ::: "memory");
}

__device__ __forceinline__ void sincos_f(float x, float& c, float& s) {
    const float k = rintf(x * 0.636619772f);
    float r = fmaf(-k, 1.57079625129699707031f, x); r = fmaf(-k, 7.54978941586159635335e-08f, r);
    const float r2 = r * r;
    const float sr = r * (1.f + r2 * (-1.f / 6 + r2 * (1.f / 120 + r2 * (-1.f / 5040 + r2 * (1.f / 362880)))));
    const float cr = 1.f + r2 * (-0.5f + r2 * (1.f / 24 + r2 * (-1.f / 720 + r2 * (1.f / 40320 + r2 * (-1.f / 3628800)))));
    const int q = ((int)k) & 3;
    s = (q == 0) ? sr : (q == 1) ? cr : (q == 2) ? -sr : -cr;
    c = (q == 0) ? cr : (q == 1) ? -sr : (q == 2) ? -cr : sr;
}

__device__ __forceinline__ void norm_mod_row(const float* src, const float* nw, const float* sh, const float* sc, bf16_t* dst, int lane) {
    u32x2* o8 = (u32x2*)dst + lane;
    if (src == nullptr) {
#pragma unroll
        for (int j = 0; j < 4; ++j) o8[64 * j] = (u32x2){0u, 0u};
        return;
    }
    const f32x4* xr = (const f32x4*)src + lane;
    f32x4 v[4]; float s = 0.f;
#pragma unroll
    for (int j = 0; j < 4; ++j) { v[j] = xr[64 * j]; s += (v[j][0] * v[j][0] + v[j][1] * v[j][1]) + (v[j][2] * v[j][2] + v[j][3] * v[j][3]); }
    const float rstd = rsqrtf(wave_sum(s, lane) * (1.f / 1024.f) + 1e-6f);
#pragma unroll
    for (int j = 0; j < 4; ++j) {
        const int k = 4 * (64 * j + lane);
        const f32x4 w = *(const f32x4*)(nw + k), a = *(const f32x4*)(sc + k), d = *(const f32x4*)(sh + k);
        f32x4 y;
#pragma unroll
        for (int e = 0; e < 4; ++e) y[e] = (v[j][e] * rstd * w[e]) * (1.f + a[e]) + d[e];
        u32x2 p; p.x = pkbf(y[0], y[1]); p.y = pkbf(y[2], y[3]);
        o8[64 * j] = p;
    }
}

struct Args { const float* in[23]; float* out; unsigned char* ws; int ph_lo, ph_hi, coop, pad; };
typedef const __attribute__((address_space(4))) Args* KArgs;
__device__ __forceinline__ KArgs kargs() { KArgs p = (KArgs)__builtin_amdgcn_kernarg_segment_ptr(); asm volatile("" : "+s"(p)); return p; }
constexpr int N_PHASES = 2 + 7 * DEPTH + 1;

__global__ void __launch_bounds__(512, 2) fwd_kernel(Args a) {
    extern __shared__ __attribute__((aligned(16))) unsigned char lds_raw[];
    LAS unsigned char* lds = (LAS unsigned char*)lds_raw;
    const int ph_lo = kargs()->ph_lo, ph_hi = kargs()->ph_hi;
    for (int ph = ph_lo; ph < ph_hi; ++ph) {
        KArgs ka = kargs();
        const int tid = pg8_ltid(), lane = tid & 63, wave = __builtin_amdgcn_readfirstlane(tid >> 6);
        int G = gridDim.x, bx = blockIdx.x; asm volatile("" : "+s"(G), "+s"(bx));
        const int vcu = (G % 8 == 0) ? (bx % 8) * (G / 8) + bx / 8 : bx;
        const int gw = vcu * 8 + wave, NGW = G * 8;
        unsigned char* ws = ka->ws;
        float* MOD = (float*)(ws + WS_MOD); float* MODP = (float*)(ws + WS_MODP);
        float* tabA = (float*)(ws + WS_TAB); float* tabB = tabA + 128 * 8 * 2;
        float* XC = (float*)(ws + WS_XC);
        bf16_t* XN = (bf16_t*)(ws + WS_XN); bf16_t* Ob = (bf16_t*)(ws + WS_O); bf16_t* Hb = (bf16_t*)(ws + WS_H); bf16_t* ACT = Hb;
        float* XL = ka->out;
        if (ph == 0) {
            const float* w_mod = ka->in[6]; const float* c_in = ka->in[1]; const float* cctx_in = ka->in[3];
            for (int it = gw; it < 1536; it += NGW) {
                const int ks = it & 15, cgp = (it >> 4) % 24, l = it / 384;
                const int n0 = cgp * 256 + lane * 4;
                f32x4 acc[5];
#pragma unroll
                for (int s = 0; s < 5; ++s) acc[s] = (f32x4){0.f, 0.f, 0.f, 0.f};
                const float* wp = w_mod + ((size_t)l * 1024 + ks * 64) * 6144 + n0;
                for (int kk = 0; kk < 64; ++kk) {
                    const int k = ks * 64 + kk;
                    const f32x4 w = *(const f32x4*)(wp + (size_t)kk * 6144);
#pragma unroll
                    for (int s = 0; s < 4; ++s) acc[s] += silu_f(c_in[s * 1024 + k]) * w;
                    acc[4] += silu_f(cctx_in[k]) * w;
                }
#pragma unroll
                for (int s = 0; s < 5; ++s) *(f32x4*)(MODP + ((size_t)(ks * 4 + l) * 5 + s) * 6144 + n0) = acc[s];
            }
            LAS float* scr = (LAS float*)(lds + wave * 16384);
            for (int it = gw; it < 4 * 6144; it += NGW) {
                const int l = it / 6144; int r = it - l * 6144;
                unsigned char* wl = ws + WS_W + (size_t)l * W_LAYER;
                if (r < 1408) { transpose_item(ka->in[8] + (size_t)l * 1024 * 2816, 1024, 2816, (bf16_t*)wl, 1, scr, r, lane); continue; } r -= 1408;
                if (r < 512) { transpose_item(ka->in[9] + (size_t)l * 1024 * 1024, 1024, 1024, (bf16_t*)(wl + W_OUT_OFF), 0, scr, r, lane); continue; } r -= 512;
                if (r < 2816) { transpose_item(ka->in[18] + (size_t)l * 1024 * 5632, 1024, 5632, (bf16_t*)(wl + W_UP_OFF), 2, scr, r, lane); continue; } r -= 2816;
                transpose_item(ka->in[21] + (size_t)l * 2816 * 1024, 2816, 1024, (bf16_t*)(wl + W_DN_OFF), 0, scr, r, lane);
            }
            for (int idx = vcu * 512 + tid; idx < 3072; idx += G * 512) {
                int pos, i; float e;
                if (idx < 1024) { pos = idx >> 3; i = idx & 7; e = (float)i * 0.125f; } else { const int j = idx - 1024; pos = j >> 4; i = j & 15; e = (float)i * 0.0625f; }
                const float freq = exp2f(-e * 13.287712379549449f);
                const float ang = (float)pos * freq;
                float cc, ss; sincos_f(ang, cc, ss);
                float* tp = (idx < 1024) ? (tabA + idx * 2) : (tabB + (idx - 1024) * 2);
                tp[0] = cc; tp[1] = ss;
            }
        } else if (ph == 1) {
            const float* b_mod = ka->in[7];
            for (int idx = vcu * 512 + tid; idx < 4 * 5 * 6144; idx += G * 512) {
                const int l = idx / 30720, n = idx % 6144;
                float s = b_mod[l * 6144 + n];
#pragma unroll
                for (int ks = 0; ks < 16; ++ks) s += MODP[(size_t)ks * 122880 + idx];
                MOD[idx] = s;
            }
        } else if (ph == N_PHASES - 1) {
            const float* fw = ka->in[22];
            for (int m = gw; m < ML; m += NGW) {
                f32x4* xr = (f32x4*)(XL + (size_t)m * DM) + lane;
                f32x4 v[4]; float s = 0.f;
#pragma unroll
                for (int j = 0; j < 4; ++j) { v[j] = xr[64 * j]; s += (v[j][0] * v[j][0] + v[j][1] * v[j][1]) + (v[j][2] * v[j][2] + v[j][3] * v[j][3]); }
                const float rstd = rsqrtf(wave_sum(s, lane) * (1.f / 1024.f) + 1e-6f);
#pragma unroll
                for (int j = 0; j < 4; ++j) { const f32x4 w = *(const f32x4*)(fw + 4 * (64 * j + lane)); xr[64 * j] = v[j] * rstd * w; }
            }
        } else {
            const int l = (ph - 2) / 7, k = (ph - 2) % 7;
            const bool need_ctx = l < DEPTH - 1;
            const float* modl = MOD + (size_t)l * 5 * 6144;
            unsigned char* wl = ws + WS_W + (size_t)l * W_LAYER;
            const float* srcL = (l == 0) ? ka->in[0] : XL;
            const float* srcC = (l == 0) ? ka->in[2] : XC;
            if (k == 0) {
                const float* nw = ka->in[4] + l * 1024;
                for (int m = gw; m < MT; m += NGW) {
                    const bool lat = m < ML; const int slot = lat ? (m >> 13) : 4;
                    const float* src = lat ? (srcL + (size_t)m * DM) : (srcC + (size_t)(m - ML) * DM);
                    norm_mod_row(src, nw, modl + slot * 6144, modl + slot * 6144 + 1024, XN + (size_t)m * DM, lane);
                }
            } else if (k == 1) {
                pg8::Gemm g{XN, (const bf16_t*)wl, MT, INC, DM}; pg8::StaticOrder S; S.init(MT, INC, G, bx);
                pg8::EpiInProj E{Hb, tabA, tabB};
#ifndef DIS_IN
                pg8::gemm_phase<pg8::EpiInProj, pg8::StaticOrder, true, true>(lds, g, S, E);
#endif
            } else if (k == 2) {
                float lam, ofac;
                {
                    float d1 = 0.f, d2 = 0.f;
                    for (int i = 0; i < 32; ++i) { d1 += ka->in[10][l * 32 + i] * ka->in[11][l * 32 + i]; d2 += ka->in[12][l * 32 + i] * ka->in[13][l * 32 + i]; }
                    const float li = 0.8f - 0.6f * expf(-0.3f * (float)l);
                    lam = expf(d1) - expf(d2) + li; ofac = 1.f - li;
                }
                const float* subw = ka->in[14] + l * 64; const float* sink_l = ka->in[15] + l * 4; const float* rpb_l = ka->in[16] + (size_t)l * 4 * 465;
#ifndef DIS_A
                for (int u = vcu; u < 512; u += G) att::unit_A<false>(lds, Hb, Ob, u >> 7, (u >> 5) & 3, u & 31, lam, ofac, subw);
#endif
#ifndef DIS_B
                for (int u = vcu; u < 512; u += G) att::unit_BC<1>(lds, Hb, Ob, u >> 7, (u >> 6) & 1, u & 63, sink_l, rpb_l);
#endif
#ifndef DIS_C
                for (int u = vcu; u < 512; u += G) att::unit_BC<2>(lds, Hb, Ob, u >> 7, (u >> 5) & 3, u & 31, sink_l, rpb_l);
#endif
#ifndef DIS_CTX
                if (need_ctx) {
                    for (int u = vcu; u < 48; u += G) {
                        const int kind = u >> 4, bh = u & 15;
                        if (kind == 0) att::unit_A<true>(lds, Hb, Ob, bh >> 2, bh & 3, 0, lam, ofac, subw);
                        else if (kind == 1) att::unit_BC<3>(lds, Hb, Ob, bh >> 2, (bh >> 1) & 1, bh & 1, sink_l, rpb_l);
                        else att::unit_BC<4>(lds, Hb, Ob, bh >> 2, bh & 3, 0, sink_l, rpb_l);
                    }
                }
#endif
                {
                    const float* cwl = ka->in[17] + (size_t)l * 3 * 256;
                    const int rows = need_ctx ? MT : ML;
                    for (int idx = vcu * 512 + tid; idx < rows * 32; idx += G * 512) {
                        const int row = idx >> 5, c0 = (idx & 31) * 8;
                        int t, len; if (row < ML) { t = row & 8191; len = SEQ; } else { t = (row - ML) & 255; len = CTXL; }
                        const bf16_t* hp = Hb + (size_t)row * INC + 2048 + c0;
                        const u32x4 bg = *(const u32x4*)hp, cg1 = *(const u32x4*)(hp + 256), xi1 = *(const u32x4*)(hp + 512);
                        u32x4 cg0 = {0u, 0u, 0u, 0u}, xi0 = cg0, cg2 = cg0, xi2 = cg0;
                        if (t > 0) { cg0 = *(const u32x4*)(hp - INC + 256); xi0 = *(const u32x4*)(hp - INC + 512); }
                        if (t < len - 1) { cg2 = *(const u32x4*)(hp + INC + 256); xi2 = *(const u32x4*)(hp + INC + 512); }
                        float w0[8], w1[8], w2[8];
#pragma unroll
                        for (int e = 0; e < 8; ++e) { w0[e] = cwl[c0 + e]; w1[e] = cwl[256 + c0 + e]; w2[e] = cwl[512 + c0 + e]; }
                        u32x4 ow;
#pragma unroll
                        for (int e = 0; e < 4; ++e) {
                            const float ylo = w0[2 * e] * bflo(cg0[e]) * bflo(xi0[e]) + w1[2 * e] * bflo(cg1[e]) * bflo(xi1[e]) + w2[2 * e] * bflo(cg2[e]) * bflo(xi2[e]);
                            const float yhi = w0[2 * e + 1] * bfhi(cg0[e]) * bfhi(xi0[e]) + w1[2 * e + 1] * bfhi(cg1[e]) * bfhi(xi1[e]) + w2[2 * e + 1] * bfhi(cg2[e]) * bfhi(xi2[e]);
                            ow[e] = pkbf(bflo(bg[e]) * ylo, bfhi(bg[e]) * yhi);
                        }
                        *(u32x4*)(Ob + (size_t)row * DM + 768 + c0) = ow;
                    }
                }
                __syncthreads();
            } else if (k == 3) {
                const int M = need_ctx ? MT : ML;
                pg8::Gemm g{Ob, (const bf16_t*)(wl + W_OUT_OFF), M, DM, DM}; pg8::StaticOrder S; S.init(M, DM, G, bx);
                pg8::EpiRes E{srcL, srcC, XL, XC, modl, 2048};
#ifndef DIS_OUT
                pg8::gemm_phase<pg8::EpiRes, pg8::StaticOrder, true, true>(lds, g, S, E);
#endif
            } else if (k == 4) {
                const float* nw = ka->in[5] + l * 1024;
                const int nrows = (need_ctx ? NMX_ALL : NMX_L) * 256;
                for (int e = gw; e < nrows; e += NGW) {
                    const int pm = e >> 8, j = e & 255;
                    int t, slot; const float* base; int len;
                    if (pm < NMX_L) { const int s = pm / 33, ti = pm - s * 33; t = 254 * ti - 1 + j; len = SEQ; slot = s; base = XL + (size_t)s * SEQ * DM; }
                    else { const int q = pm - NMX_L; const int s = q >> 1, ti = q & 1; t = 254 * ti - 1 + j; len = CTXL; slot = 4; base = XC + (size_t)s * CTXL * DM; }
                    const float* src = (t >= 0 && t < len) ? (base + (size_t)t * DM) : nullptr;
                    norm_mod_row(src, nw, modl + slot * 6144 + 3072, modl + slot * 6144 + 4096, XN + (size_t)e * DM, lane);
                }
            } else if (k == 5) {
                const int nM = need_ctx ? NMX_ALL : NMX_L;
                pg8::Gemm g{XN, (const bf16_t*)(wl + W_UP_OFF), nM * 256, UPC, DM}; pg8::StaticOrder S; S.init(nM * 256, UPC, G, bx);
                pg8::EpiUpConv E{ACT, ka->in[19] + (size_t)l * 3 * UPC, ka->in[20] + (size_t)l * UPC};
                pg8::OneUnit one;
#ifndef DIS_UP
                for (int i = 0; S.next(i, one.u); ++i) pg8::gemm_phase<pg8::EpiUpConv, pg8::OneUnit, false, true>(lds, g, one, E);
#endif
            } else {
                const int M = need_ctx ? MT : ML;
                pg8::Gemm g{ACT, (const bf16_t*)(wl + W_DN_OFF), M, DM, DFF}; pg8::StaticOrder S; S.init(M, DM, G, bx);
                pg8::EpiRes E{XL, XC, XL, XC, modl, 5120};
#ifndef DIS_DN
                pg8::gemm_phase<pg8::EpiRes, pg8::StaticOrder, true, true>(lds, g, S, E);
#endif
            }
        }
        if (ph + 1 < ph_hi && kargs()->coop) cg::this_grid().sync();
    }
}

extern "C" void kernel_launch(void* const* d_in, const int* in_sizes, int n_in, void* d_out, int out_size, void* d_ws, size_t ws_size, hipStream_t stream) {
    static int grid = 0;
    if (grid == 0) {
        if (n_in != 23 || out_size != ML * DM || ws_size < WS_END) { fprintf(stderr, "kernel_launch: unexpected shapes (n_in %d out %d ws %zu need %zu)\n", n_in, out_size, ws_size, (size_t)WS_END); grid = -1; return; }
        int dev = 0, cus = 0, per_cu = 0;
        if (hipGetDevice(&dev) != hipSuccess || hipDeviceGetAttribute(&cus, hipDeviceAttributeMultiprocessorCount, dev) != hipSuccess) { grid = -1; return; }
        if (hipFuncSetAttribute((const void*)fwd_kernel, hipFuncAttributeMaxDynamicSharedMemorySize, LDS_BYTES) != hipSuccess) { fprintf(stderr, "kernel_launch: hipFuncSetAttribute failed\n"); grid = -1; return; }
        if (hipOccupancyMaxActiveBlocksPerMultiprocessor(&per_cu, (const void*)fwd_kernel, 512, LDS_BYTES) != hipSuccess || per_cu < 1) fprintf(stderr, "kernel_launch: occupancy query says %d\n", per_cu);
        (void)hipGetLastError();
        grid = cus;
    }
    if (grid < 0) return;
    Args a{};
    for (int i = 0; i < 23; ++i) a.in[i] = (const float*)d_in[i];
    a.out = (float*)d_out; a.ws = (unsigned char*)d_ws;
#if MK_MULTI
    for (int ph = 0; ph < N_PHASES; ++ph) {
        a.ph_lo = ph; a.ph_hi = ph + 1; a.coop = 0;
        hipLaunchKernelGGL(fwd_kernel, dim3(grid), dim3(512), LDS_BYTES, stream, a);
    }
#else
    a.ph_lo = 0; a.ph_hi = N_PHASES; a.coop = 1;
    void* args[] = {&a};
    hipError_t e = hipLaunchCooperativeKernel((const void*)fwd_kernel, dim3(grid), dim3(512), args, LDS_BYTES, stream);
    if (e != hipSuccess) fprintf(stderr, "cooperative launch failed: %s (grid %d)\n", hipGetErrorString(e), grid);
#endif
}
```

```cpp
#include <hip/hip_runtime.h>
#include <hip/hip_cooperative_groups.h>
#include <cstdio>
#include <cstdint>
namespace cg = cooperative_groups;

#ifndef MK_MULTI
#define MK_MULTI 0
#endif

#ifndef REP_IN
#define REP_IN 1
#endif
#ifndef REP_UP
#define REP_UP 1
#endif
#ifndef REP_A
#define REP_A 1
#endif
#ifndef REP_OD
#define REP_OD 1
#endif
#ifndef REP_P
#define REP_P 1
#endif
#ifndef REP_M
#define REP_M 1
#endif

__device__ __forceinline__ int pg8_ltid() { int t = threadIdx.x; asm volatile("" : "+v"(t)); return t; }
namespace pg8 {
#define PG8_LAS __attribute__((address_space(3)))
typedef unsigned short bf16_t;
typedef short bf16x8 __attribute__((ext_vector_type(8)));
typedef float f32x4 __attribute__((ext_vector_type(4)));
typedef unsigned u32x4 __attribute__((ext_vector_type(4)));
constexpr int BM = 256, BK = 64, HALF = 128, HTB = HALF * BK * 2  , STAGE_BYTES = 8 * HTB, NXCD = 8, WGM = 8;

__host__ __device__ __forceinline__ int lds_byte(int r, int c) { const int st = (r >> 4) * 2 + (c >> 5), rr = r & 15, cc = c & 31, ob = rr * 64 + cc * 2; return st * 1024 + (ob ^ (((ob >> 9) & 1) << 5)); }
__host__ __device__ __forceinline__ void stage_rc(int b, int& R, int& C) { const int st = b / 1024, sb = b % 1024, swz = sb ^ (((sb >> 9) & 1) << 5); R = (st >> 1) * 16 + swz / 64; C = (st & 1) * 32 + (swz % 64) / 2; }
__host__ __device__ __forceinline__ int perm32(int rho) { const int n = rho >> 4, i = rho & 15; return 8 * (i >> 2) + 4 * n + (i & 3); }

struct Unit { int pm, pn; };
struct Gemm { const bf16_t* A; const bf16_t* Bt; int M, N, K; };

struct StaticOrder {
    int nM, nN, nwg, G, c;
    __host__ __device__ void init(int M, int N, int G_, int c_) { nM = M / BM; nN = N / BM; nwg = nM * nN; G = G_; c = c_; }
    __host__ __device__ bool next(int i, Unit& u) const {
        const long L = (long)i * G + c; if (L >= nwg) return false;
        int wgid = (int)L; { const int q = nwg / NXCD, r = nwg % NXCD, xcd = wgid % NXCD, off = wgid / NXCD; wgid = (xcd < r ? xcd * (q + 1) : r * (q + 1) + (xcd - r) * q) + off; }
        const int nig = WGM * nN, gid = wgid / nig, fm = gid * WGM, gsz = (nM - fm) < WGM ? (nM - fm) : WGM;
        u.pm = fm + ((wgid % nig) % gsz); u.pn = (wgid % nig) / gsz; return true;
    }
    __device__ __forceinline__ void a_ready(const Unit&) const {}
    __device__ __forceinline__ void done(const Unit&) const {}
};

__device__ __forceinline__ unsigned cvt_pk_bf16(float lo, float hi) { unsigned r; asm volatile("v_cvt_pk_bf16_f32 %0, %1, %2" : "=v"(r) : "v"(lo), "v"(hi)); return r; }
typedef unsigned u32x2 __attribute__((ext_vector_type(2)));

struct OneUnit {
    Unit u;
    __device__ __forceinline__ bool next(int i, Unit& o) const { if (i != 0) return false; o = u; return true; }
    __device__ __forceinline__ void a_ready(const Unit&) const {}
    __device__ __forceinline__ void done(const Unit&) const {}
};

struct EpiInProj {
    static constexpr bool PERM = false, AFTER_DRAIN = false;
    bf16_t* H; const float* tabA; const float* tabB;
    __device__ __forceinline__ void operator()(const f32x4 (&acc)[2][2][4][2], const Unit& u, int wr, int wc, int fr, int fq) const {
        const int pn = u.pn; const bool latent = u.pm < 128;
        const float scale = (pn == 0) ? 0.17677669529663687f * 1.4426950408889634f : ((pn == 3 || pn == 5) ? 0.125f * 1.4426950408889634f : 1.0f);
#pragma unroll
        for (int bj = 0; bj < 2; ++bj) {
            int mode = (pn == 0 || pn == 1) ? 1 : ((pn == 3 || (pn == 4 && bj == 0)) ? 2 : 0);
            if (!latent) mode = 0;
#ifdef TEST_NOROPE
            mode = 0;
#endif
#pragma unroll
            for (int ai = 0; ai < 2; ++ai)
#pragma unroll
                for (int m = 0; m < 4; ++m) {
                    const int r = u.pm * BM + ai * HALF + wr * 64 + m * 16 + fr;
                    f32x4 v0 = acc[ai][bj][m][0], v1 = acc[ai][bj][m][1];
                    if (mode != 0) {
                        const int t = r & 8191, trow = t >> 6, tcol = t & 63;
                        const float* tp;
                        if (mode == 1) { const int pos = (fq < 2) ? trow : tcol; tp = tabA + (pos * 8 + 4 * (fq & 1)) * 2; }
                        else { const int pos = (wc & 1) ? tcol : trow; tp = tabB + (pos * 16 + 4 * fq) * 2; }
                        const f32x4 cs0 = *(const f32x4*)tp, cs1 = *(const f32x4*)(tp + 4);
                        const float c0 = cs0[0], s0 = cs0[1], c1 = cs0[2], s1 = cs0[3], c2 = cs1[0], s2 = cs1[1], c3 = cs1[2], s3 = cs1[3];
                        f32x4 a = v0, b = v1;
                        v0[0] = a[0] * c0 - b[0] * s0; v1[0] = b[0] * c0 + a[0] * s0;
                        v0[1] = a[1] * c1 - b[1] * s1; v1[1] = b[1] * c1 + a[1] * s1;
                        v0[2] = a[2] * c2 - b[2] * s2; v1[2] = b[2] * c2 + a[2] * s2;
                        v0[3] = a[3] * c3 - b[3] * s3; v1[3] = b[3] * c3 + a[3] * s3;
                    }
                    v0 = v0 * scale; v1 = v1 * scale;
                    bf16_t* rowp = H + (size_t)r * 2816 + pn * BM + bj * HALF + wc * 32 + 4 * fq;
                    u32x2 w0, w1; w0.x = cvt_pk_bf16(v0[0], v0[1]); w0.y = cvt_pk_bf16(v0[2], v0[3]); w1.x = cvt_pk_bf16(v1[0], v1[1]); w1.y = cvt_pk_bf16(v1[2], v1[3]);
                    *(u32x2*)rowp = w0; *(u32x2*)(rowp + 16) = w1;
                }
        }
    }
};

struct EpiRes {
    static constexpr bool PERM = false, AFTER_DRAIN = false;
    const float* baseL; const float* baseC; float* outL; float* outC; const float* modl; int goff;
    __device__ __forceinline__ void operator()(const f32x4 (&acc)[2][2][4][2], const Unit& u, int wr, int wc, int fr, int fq) const {
        const bool ctx = u.pm >= 128; const int slot = ctx ? 4 : (u.pm >> 5);
        const int row0 = (ctx ? (u.pm - 128) : u.pm) * BM + wr * 64 + fr;
        const float* bp = ctx ? baseC : baseL; float* op = ctx ? outC : outL;
        const int col0 = u.pn * BM + wc * 32 + 4 * fq;
        f32x4 gv[2][2];
#pragma unroll
        for (int bj = 0; bj < 2; ++bj)
#pragma unroll
            for (int n = 0; n < 2; ++n) gv[bj][n] = *(const f32x4*)(modl + slot * 6144 + goff + col0 + bj * HALF + n * 16);
#pragma unroll
        for (int ai = 0; ai < 2; ++ai)
#pragma unroll
            for (int m = 0; m < 4; ++m) {
                const size_t off = (size_t)(row0 + ai * HALF + m * 16) * 1024 + col0;
#pragma unroll
                for (int bj = 0; bj < 2; ++bj)
#pragma unroll
                    for (int n = 0; n < 2; ++n) {
                        const f32x4 bs = *(const f32x4*)(bp + off + bj * HALF + n * 16);
                        *(f32x4*)(op + off + bj * HALF + n * 16) = bs + gv[bj][n] * acc[ai][bj][m][n];
                    }
                asm volatile("" ::: "memory");
            }
    }
};

struct EpiUpConv {
    static constexpr bool PERM = false, AFTER_DRAIN = true;
    bf16_t* ACT; const float* cw; const float* cb;
    static constexpr int TP = 520;
    __device__ __forceinline__ void fused(f32x4 (&acc)[2][2][4][2], const Unit& u, int wr, int wc, int fr, int fq, PG8_LAS unsigned char* lds, int wid, int lane) const {
#pragma unroll
        for (int ai = 0; ai < 2; ++ai)
#pragma unroll
            for (int m = 0; m < 4; ++m) {
                const int row = ai * HALF + wr * 64 + m * 16 + fr;
#pragma unroll
                for (int bj = 0; bj < 2; ++bj)
#pragma unroll
                    for (int n = 0; n < 2; ++n) {
                        const f32x4 v = acc[ai][bj][m][n]; u32x2 w; w.x = cvt_pk_bf16(v[0], v[1]); w.y = cvt_pk_bf16(v[2], v[3]);
                        *(PG8_LAS u32x2*)(lds + row * TP + (bj * HALF + wc * 32 + n * 16 + 4 * fq) * 2) = w;
                    }
            }
        const int tid = wid * 64 + lane, ch = tid & 15;
        const int gcol = u.pn * 128 + ch * 8;
        float wg[3][8], wv[3][8], bg[8], bv[8];
#pragma unroll
        for (int k = 0; k < 3; ++k) {
            const f32x4 a0 = *(const f32x4*)(cw + k * 5632 + gcol), a1 = *(const f32x4*)(cw + k * 5632 + gcol + 4);
            const f32x4 b0 = *(const f32x4*)(cw + k * 5632 + 2816 + gcol), b1 = *(const f32x4*)(cw + k * 5632 + 2816 + gcol + 4);
#pragma unroll
            for (int e = 0; e < 4; ++e) { wg[k][e] = a0[e]; wg[k][4 + e] = a1[e]; wv[k][e] = b0[e]; wv[k][4 + e] = b1[e]; }
        }
        {
            const f32x4 a0 = *(const f32x4*)(cb + gcol), a1 = *(const f32x4*)(cb + gcol + 4), b0 = *(const f32x4*)(cb + 2816 + gcol), b1 = *(const f32x4*)(cb + 2816 + gcol + 4);
#pragma unroll
            for (int e = 0; e < 4; ++e) { bg[e] = a0[e]; bg[4 + e] = a1[e]; bv[e] = b0[e]; bv[4 + e] = b1[e]; }
        }
        int seqlen, rowbase, ti;
        if (u.pm < 132) { const int s = u.pm / 33; ti = u.pm - s * 33; seqlen = 8192; rowbase = s * 8192; }
        else { const int q = u.pm - 132; const int s = q >> 1; ti = q & 1; seqlen = 256; rowbase = 32768 + s * 256; }
        asm volatile("s_waitcnt lgkmcnt(0)" ::: "memory"); __builtin_amdgcn_s_barrier(); asm volatile("" ::: "memory");
        for (int it = tid; it < 254 * 16; it += 512) {
            const int j = 1 + (it >> 4); const int t = 254 * ti - 1 + j;
            if (t < seqlen) {
                float g[8], v[8];
#pragma unroll
                for (int e = 0; e < 8; ++e) { g[e] = bg[e]; v[e] = bv[e]; }
#pragma unroll
                for (int k = 0; k < 3; ++k) {
                    const PG8_LAS unsigned char* rp = lds + (j - 1 + k) * TP + ch * 16;
                    const u32x2 g0 = *(const PG8_LAS u32x2*)rp, g1 = *(const PG8_LAS u32x2*)(rp + 8);
                    const u32x2 v0 = *(const PG8_LAS u32x2*)(rp + 256), v1 = *(const PG8_LAS u32x2*)(rp + 264);
                    const unsigned gw[4] = {g0.x, g0.y, g1.x, g1.y}, vw[4] = {v0.x, v0.y, v1.x, v1.y};
#pragma unroll
                    for (int e = 0; e < 4; ++e) {
                        g[2 * e] += wg[k][2 * e] * __uint_as_float(gw[e] << 16); g[2 * e + 1] += wg[k][2 * e + 1] * __uint_as_float(gw[e] & 0xffff0000u);
                        v[2 * e] += wv[k][2 * e] * __uint_as_float(vw[e] << 16); v[2 * e + 1] += wv[k][2 * e + 1] * __uint_as_float(vw[e] & 0xffff0000u);
                    }
                }
                float o[8];
#pragma unroll
                for (int e = 0; e < 8; ++e) o[e] = g[e] / (1.f + __expf(-g[e])) * v[e];
                u32x4 w; w.x = cvt_pk_bf16(o[0], o[1]); w.y = cvt_pk_bf16(o[2], o[3]); w.z = cvt_pk_bf16(o[4], o[5]); w.w = cvt_pk_bf16(o[6], o[7]);
                *(u32x4*)(ACT + (size_t)(rowbase + t) * 2816 + gcol) = w;
            }
        }
        asm volatile("s_waitcnt lgkmcnt(0)" ::: "memory"); __builtin_amdgcn_s_barrier(); asm volatile("" ::: "memory");
    }
};
template <class Epi, class Sched, bool ALIGN_EPI = false, bool SP2 = false>
__device__ __forceinline__ void gemm_phase(PG8_LAS unsigned char* lds, const Gemm g, const Sched& S, const Epi& E) {
    const int tid = pg8_ltid(), wid = __builtin_amdgcn_readfirstlane(tid >> 6), lane = tid & 63, wr = wid >> 2, wc = wid & 3, fr = lane & 15, fq = lane >> 4;
    const int K = g.K, nt = K / BK;
    unsigned voffA[2], voffB[2];
#pragma unroll
    for (int i = 0; i < 2; ++i) { int R, C; stage_rc(tid * 16 + i * 8192, R, C); const int Rb = Epi::PERM ? ((R & ~31) + perm32(R & 31)) : R;
        voffA[i] = (unsigned)(R * K + C) * 2u; voffB[i] = (unsigned)(Rb * K + C) * 2u; }
    const size_t kstep = (size_t)(BK * 2);
    const size_t hstep = (size_t)HALF * K * 2;
    const size_t tstep = 2 * hstep;
    const unsigned ldsw = (unsigned)wid * 1024u;
    const int aoff = lds_byte(wr * 64 + fr, fq * 8), boff = lds_byte(wc * 32 + fr, fq * 8);
#define PG8_SA(b, h) (((b) * 2 + (h)) * HTB)
#define PG8_SB(b, h) ((4 + (b) * 2 + (h)) * HTB)
#define PG8_STAGE(bufoff, gbase, voff) do { _Pragma("unroll") for (int _i = 0; _i < 2; ++_i) \
        __builtin_amdgcn_global_load_lds((const unsigned*)((const char*)(gbase) + (voff)[_i]), (PG8_LAS unsigned*)(lds + (bufoff) + ldsw + _i * 8192), 16, 0, 0); } while (0)
#define PG8_LDA(dst, b, h) do { _Pragma("unroll") for (int m = 0; m < 4; ++m) _Pragma("unroll") for (int k = 0; k < 2; ++k) dst[m][k] = *(const PG8_LAS bf16x8*)(lds + PG8_SA(b, h) + aoff + m * 2048 + k * 1024); } while (0)
#define PG8_LDB(dst, b, h) do { _Pragma("unroll") for (int n = 0; n < 2; ++n) _Pragma("unroll") for (int k = 0; k < 2; ++k) dst[n][k] = *(const PG8_LAS bf16x8*)(lds + PG8_SB(b, h) + boff + n * 2048 + k * 1024); } while (0)
#define PG8_MMA(ai, bj, At, Bt) do { __builtin_amdgcn_s_setprio(1); _Pragma("unroll") for (int m = 0; m < 4; ++m) _Pragma("unroll") for (int n = 0; n < 2; ++n) _Pragma("unroll") for (int k = 0; k < 2; ++k) \
        acc[ai][bj][m][n] = __builtin_amdgcn_mfma_f32_16x16x32_bf16(Bt[n][k], At[m][k], acc[ai][bj][m][n], 0, 0, 0); __builtin_amdgcn_s_setprio(0); } while (0)
#define PG8_WAIT_V(n) asm volatile("s_waitcnt vmcnt(" #n ")" ::: "memory")
#define PG8_WAIT_L(n) asm volatile("s_waitcnt lgkmcnt(" #n ")" ::: "memory")
#define PG8_BAR __builtin_amdgcn_s_barrier()
#define PG8_SCHED __builtin_amdgcn_sched_barrier(0)
    Unit cur, nxt; int ui = 0;
    if (!S.next(0, cur)) return;
    f32x4 acc[2][2][4][2];
#pragma unroll
    for (int a = 0; a < 2; ++a)
#pragma unroll
        for (int b = 0; b < 2; ++b)
#pragma unroll
            for (int m = 0; m < 4; ++m)
#pragma unroll
                for (int n = 0; n < 2; ++n) acc[a][b][m][n] = (f32x4){0.f, 0.f, 0.f, 0.f};
    bf16x8 At[4][2], B0[2][2], B1[2][2];
    const char* cA = (const char*)g.A + (size_t)cur.pm * tstep; const char* cB = (const char*)g.Bt + (size_t)cur.pn * tstep;
    S.a_ready(cur);
    if constexpr (SP2) {
        PG8_STAGE(PG8_SB(0, 0), cB, voffB); PG8_STAGE(PG8_SB(0, 1), cB + hstep, voffB); PG8_STAGE(PG8_SA(0, 0), cA, voffA); PG8_STAGE(PG8_SA(0, 1), cA + hstep, voffA);
        if (wr == 1) PG8_BAR;
        PG8_WAIT_V(2); PG8_BAR;
        PG8_STAGE(PG8_SB(1, 0), cB + kstep, voffB); PG8_STAGE(PG8_SA(1, 0), cA + kstep, voffA); PG8_STAGE(PG8_SB(1, 1), cB + hstep + kstep, voffB);
        PG8_WAIT_V(6); PG8_BAR;
    } else {
        PG8_STAGE(PG8_SB(0, 0), cB, voffB); PG8_STAGE(PG8_SA(0, 0), cA, voffA); PG8_STAGE(PG8_SB(0, 1), cB + hstep, voffB); PG8_STAGE(PG8_SA(0, 1), cA + hstep, voffA);
        if (wr == 1) PG8_BAR;
        PG8_WAIT_V(4); PG8_BAR;
        PG8_STAGE(PG8_SB(1, 0), cB + kstep, voffB); PG8_STAGE(PG8_SA(1, 0), cA + kstep, voffA); PG8_STAGE(PG8_SB(1, 1), cB + hstep + kstep, voffB);
        PG8_WAIT_V(6); PG8_BAR;
    }
    for (;;) {
        const bool has_next = S.next(ui + 1, nxt);
        const char* nA = has_next ? (const char*)g.A + (size_t)nxt.pm * tstep : cA; const char* nB = has_next ? (const char*)g.Bt + (size_t)nxt.pn * tstep : cB;
        for (int t = 0; t < nt; t += 2) {
            const bool last = (t == nt - 2);
            const char* a1 = cA + (size_t)(t + 1) * kstep;
            const char* a2 = last ? nA : cA + (size_t)(t + 2) * kstep; const char* b2 = last ? nB : cB + (size_t)(t + 2) * kstep;
            const char* a3 = a2 + kstep; const char* b3 = b2 + kstep;
            if (last && has_next) S.a_ready(nxt);
            if constexpr (SP2) {
            PG8_LDB(B0, 0, 0); PG8_LDB(B1, 0, 1); PG8_SCHED; PG8_LDA(At, 0, 0); PG8_STAGE(PG8_SA(1, 1), a1 + hstep, voffA);
            PG8_WAIT_V(8); PG8_WAIT_L(0); PG8_BAR; PG8_MMA(0, 0, At, B0); PG8_MMA(0, 1, At, B1); PG8_BAR; PG8_SCHED;
            PG8_LDA(At, 0, 1); PG8_STAGE(PG8_SB(0, 0), b2, voffB); PG8_STAGE(PG8_SB(0, 1), b2 + hstep, voffB); PG8_STAGE(PG8_SA(0, 0), a2, voffA);
            PG8_WAIT_V(8); PG8_WAIT_L(0); PG8_BAR; PG8_MMA(1, 0, At, B0); PG8_MMA(1, 1, At, B1); PG8_BAR; PG8_SCHED;
            PG8_LDB(B0, 1, 0); PG8_LDB(B1, 1, 1); PG8_SCHED; PG8_LDA(At, 1, 0); PG8_STAGE(PG8_SA(0, 1), a2 + hstep, voffA);
            PG8_WAIT_V(8); PG8_WAIT_L(0); PG8_BAR; PG8_MMA(0, 0, At, B0); PG8_MMA(0, 1, At, B1); PG8_BAR; PG8_SCHED;
            PG8_LDA(At, 1, 1); PG8_STAGE(PG8_SB(1, 0), b3, voffB); PG8_STAGE(PG8_SB(1, 1), b3 + hstep, voffB); PG8_STAGE(PG8_SA(1, 0), a3, voffA);
            PG8_WAIT_V(8); PG8_WAIT_L(0); PG8_BAR; PG8_MMA(1, 0, At, B0); PG8_MMA(1, 1, At, B1); PG8_BAR; PG8_SCHED;
            } else {
            PG8_LDB(B0, 0, 0); PG8_SCHED; PG8_LDA(At, 0, 0); PG8_STAGE(PG8_SA(1, 1), a1 + hstep, voffA);
            PG8_WAIT_L(8); PG8_BAR; PG8_WAIT_L(0); PG8_MMA(0, 0, At, B0); PG8_BAR; PG8_SCHED;
            PG8_LDB(B1, 0, 1); PG8_STAGE(PG8_SB(0, 0), b2, voffB);
            PG8_BAR; PG8_WAIT_L(0); PG8_MMA(0, 1, At, B1); PG8_BAR;
            PG8_LDA(At, 0, 1); PG8_STAGE(PG8_SA(0, 0), a2, voffA);
            PG8_BAR; PG8_WAIT_L(0); PG8_MMA(1, 0, At, B0); PG8_BAR; PG8_SCHED;
            PG8_STAGE(PG8_SB(0, 1), b2 + hstep, voffB);
            PG8_WAIT_V(6); PG8_BAR; PG8_MMA(1, 1, At, B1); PG8_BAR;
            PG8_LDB(B0, 1, 0); PG8_SCHED; PG8_LDA(At, 1, 0); PG8_STAGE(PG8_SA(0, 1), a2 + hstep, voffA);
            PG8_WAIT_L(8); PG8_BAR; PG8_WAIT_L(0); PG8_MMA(0, 0, At, B0); PG8_BAR; PG8_SCHED;
            PG8_LDB(B1, 1, 1); PG8_STAGE(PG8_SB(1, 0), b3, voffB);
            PG8_BAR; PG8_WAIT_L(0); PG8_MMA(0, 1, At, B1); PG8_BAR;
            PG8_LDA(At, 1, 1); PG8_STAGE(PG8_SA(1, 0), a3, voffA);
            PG8_BAR; PG8_WAIT_L(0); PG8_MMA(1, 0, At, B0); PG8_BAR; PG8_SCHED;
            PG8_STAGE(PG8_SB(1, 1), b3 + hstep, voffB);
            PG8_WAIT_V(6); PG8_BAR; PG8_MMA(1, 1, At, B1); PG8_BAR;
            }
        }
        if constexpr (ALIGN_EPI) { if (wr == 0) PG8_BAR; }
        if constexpr (!Epi::AFTER_DRAIN) { E(acc, cur, wr, wc, fr, fq); S.done(cur); }
        if (!has_next) break;
#pragma unroll
        for (int a = 0; a < 2; ++a)
#pragma unroll
            for (int b = 0; b < 2; ++b)
#pragma unroll
                for (int m = 0; m < 4; ++m)
#pragma unroll
                    for (int n = 0; n < 2; ++n) acc[a][b][m][n] = (f32x4){0.f, 0.f, 0.f, 0.f};
        cur = nxt; cA = nA; cB = nB; ++ui;
        if constexpr (ALIGN_EPI) { if (wr == 1) PG8_BAR; }
    }
    PG8_WAIT_V(0);
    if constexpr (!ALIGN_EPI) { if (wr == 0) PG8_BAR; }
    PG8_BAR;
    if constexpr (Epi::AFTER_DRAIN) { E.fused(acc, cur, wr, wc, fr, fq, lds, wid, lane); S.done(cur); }
#undef PG8_SA
#undef PG8_SB
#undef PG8_STAGE
#undef PG8_LDA
#undef PG8_LDB
#undef PG8_MMA
#undef PG8_WAIT_V
#undef PG8_WAIT_L
#undef PG8_BAR
#undef PG8_SCHED
}
}
#define LAS __attribute__((address_space(3)))
typedef unsigned short bf16_t;
typedef short bf16x8 __attribute__((ext_vector_type(8)));
typedef short s16x4 __attribute__((ext_vector_type(4)));
typedef float f32x4 __attribute__((ext_vector_type(4)));
typedef float f32x16 __attribute__((ext_vector_type(16)));
typedef unsigned u32x4 __attribute__((ext_vector_type(4)));
typedef unsigned u32x2 __attribute__((ext_vector_type(2)));

constexpr int DM = 1024, NB = 4, SEQ = 8192, DEPTH = 4, CTXL = 256;
constexpr int ML = NB * SEQ, MC = NB * CTXL, MT = ML + MC;
constexpr int INC = 2816, DFF = 2816, UPC = 5632;
constexpr int NMX_L = NB * 33, NMX_ALL = NB * 33 + NB * 2;
constexpr float LOG2E = 1.4426950408889634f;

constexpr size_t MiB = 1u << 20;
constexpr size_t WS_MOD = 1 * MiB;
constexpr size_t WS_MODP = 2 * MiB;
constexpr size_t WS_TAB = 10 * MiB;
constexpr size_t WS_XC = 11 * MiB;
constexpr size_t WS_W = 16 * MiB;
constexpr size_t W_LAYER = 24 * MiB, W_OUT_OFF = (size_t)2816 * 1024 * 2, W_UP_OFF = W_OUT_OFF + (size_t)1024 * 1024 * 2, W_DN_OFF = W_UP_OFF + (size_t)5632 * 1024 * 2;
constexpr size_t WS_XN = 112 * MiB;
constexpr size_t WS_O = 182 * MiB;
constexpr size_t WS_H = 248 * MiB;
constexpr size_t WS_END = WS_H + (size_t)MT * 2816 * 2;
static_assert(W_DN_OFF + (size_t)1024 * 2816 * 2 <= W_LAYER, "weights per layer");
static_assert(WS_XN + (size_t)NMX_ALL * 256 * 1024 * 2 <= WS_O && WS_O + (size_t)MT * 1024 * 2 <= WS_H && WS_END <= 512 * MiB, "ws map");

constexpr int RING_BYTES = 135168;
constexpr int LDS_BYTES = 147456;

__device__ __forceinline__ unsigned pkbf(float lo, float hi) { unsigned r; asm volatile("v_cvt_pk_bf16_f32 %0, %1, %2" : "=v"(r) : "v"(lo), "v"(hi)); return r; }
__device__ __forceinline__ float bflo(unsigned w) { return __uint_as_float(w << 16); }
__device__ __forceinline__ float bfhi(unsigned w) { return __uint_as_float(w & 0xffff0000u); }
__device__ __forceinline__ float wave_sum(float v, int lane) {
#pragma unroll
    for (int o = 1; o < 64; o <<= 1) v += __int_as_float(__builtin_amdgcn_ds_bpermute((lane ^ o) << 2, __float_as_int(v)));
    return v;
}
__device__ __forceinline__ float xhalf_max(float v) { auto rr = __builtin_amdgcn_permlane32_swap(__float_as_uint(v), __float_as_uint(v), false, false); return fmaxf(__uint_as_float(rr[0]), __uint_as_float(rr[1])); }
__device__ __forceinline__ float xhalf_sum(float v) { auto rr = __builtin_amdgcn_permlane32_swap(__float_as_uint(v), __float_as_uint(v), false, false); return __uint_as_float(rr[0]) + __uint_as_float(rr[1]); }

namespace att {
constexpr int KP = 144, VP = 136;
constexpr int L_KS = 0, L_VT = 64 * KP, L_RPB = L_VT + 64 * VP, L_END = L_RPB + 2048;
__device__ __forceinline__ int crow(int r, int h) { return (r & 3) + 8 * (r >> 2) + 4 * h; }

struct TileRegs { u32x4 k, v; };
__device__ __forceinline__ void tile_gload(TileRegs& R, const bf16_t* H, int krow, int kcol, int vcol, int tid) {
    const int key = tid >> 3, ch = tid & 7;
    const bf16_t* p = H + (size_t)(krow + key) * INC;
    R.k = *(const u32x4*)(p + kcol + 8 * ch); R.v = *(const u32x4*)(p + vcol + 8 * ch);
}
__device__ __forceinline__ void tile_swrite(const TileRegs& R, LAS unsigned char* lds, int tid) {
    const int key = tid >> 3, ch = tid & 7;
    *(LAS u32x4*)(lds + L_KS + key * KP + ch * 16) = R.k;
    LAS unsigned short* vt = (LAS unsigned short*)(lds + L_VT);
#pragma unroll
    for (int j = 0; j < 4; ++j) { const unsigned w = R.v[j]; vt[(8 * ch + 2 * j) * (VP / 2) + key] = (unsigned short)(w & 0xffffu); vt[(8 * ch + 2 * j + 1) * (VP / 2) + key] = (unsigned short)(w >> 16); }
}
template <int KS0, int NKS>
__device__ __forceinline__ f32x16 qk_block(const LAS unsigned char* lds, int kb, int r32, int hh, const bf16x8 (&qf)[4]) {
    f32x16 s = {0.f, 0.f, 0.f, 0.f, 0.f, 0.f, 0.f, 0.f, 0.f, 0.f, 0.f, 0.f, 0.f, 0.f, 0.f, 0.f};
#pragma unroll
    for (int ks = KS0; ks < KS0 + NKS; ++ks) {
        const bf16x8 kf = *(const LAS bf16x8*)(lds + L_KS + (kb * 32 + r32) * KP + ks * 32 + hh * 16);
        s = __builtin_amdgcn_mfma_f32_32x32x16_bf16(kf, qf[ks], s, 0, 0, 0);
    }
    return s;
}
__device__ __forceinline__ void softmax_pv(f32x16 (&s)[2], float& m, float& l, f32x16 (&O)[2], const LAS unsigned char* lds, int r32, int hh) {
    float mx = s[0][0];
#pragma unroll
    for (int r = 1; r < 16; ++r) mx = fmaxf(mx, s[0][r]);
#pragma unroll
    for (int r = 0; r < 16; ++r) mx = fmaxf(mx, s[1][r]);
    mx = xhalf_max(mx);
    __builtin_amdgcn_sched_barrier(0);
    const float mn = fmaxf(m, mx);
    const float alpha = __builtin_amdgcn_exp2f(m - mn);
    m = mn; l *= alpha;
#pragma unroll
    for (int r = 0; r < 16; ++r) { O[0][r] *= alpha; O[1][r] *= alpha; }
    float ps = 0.f;
#pragma unroll
    for (int kb = 0; kb < 2; ++kb)
#pragma unroll
        for (int r = 0; r < 16; ++r) { const float p = __builtin_amdgcn_exp2f(s[kb][r] - mn); s[kb][r] = p; ps += p; }
    l += ps;
    __builtin_amdgcn_sched_barrier(0);
#pragma unroll
    for (int kb = 0; kb < 2; ++kb)
#pragma unroll
        for (int sk = 0; sk < 2; ++sk) {
            __builtin_amdgcn_sched_barrier(0);
            u32x4 pw; pw.x = pkbf(s[kb][8 * sk + 0], s[kb][8 * sk + 1]); pw.y = pkbf(s[kb][8 * sk + 2], s[kb][8 * sk + 3]);
            pw.z = pkbf(s[kb][8 * sk + 4], s[kb][8 * sk + 5]); pw.w = pkbf(s[kb][8 * sk + 6], s[kb][8 * sk + 7]);
            const bf16x8 pf = __builtin_bit_cast(bf16x8, pw);
#pragma unroll
            for (int dvb = 0; dvb < 2; ++dvb) {
                const LAS unsigned char* a = lds + L_VT + (dvb * 32 + r32) * VP + (kb * 32 + 16 * sk + 4 * hh) * 2;
                const s16x4 lo = *(const LAS s16x4*)a, hi = *(const LAS s16x4*)(a + 16);
                const bf16x8 vf = {lo[0], lo[1], lo[2], lo[3], hi[0], hi[1], hi[2], hi[3]};
                O[dvb] = __builtin_amdgcn_mfma_f32_32x32x16_bf16(vf, pf, O[dvb], 0, 0, 0);
            }
        }
}
__device__ __forceinline__ void store_o(const f32x16 (&o)[2], bf16_t* orow, int hh) {
#pragma unroll
    for (int dvb = 0; dvb < 2; ++dvb)
#pragma unroll
        for (int g = 0; g < 4; ++g) {
            u32x2 w; w.x = pkbf(o[dvb][4 * g], o[dvb][4 * g + 1]); w.y = pkbf(o[dvb][4 * g + 2], o[dvb][4 * g + 3]);
            *(u32x2*)(orow + dvb * 32 + 8 * g + 4 * hh) = w;
        }
}

template <bool CTXQ>
__device__ __forceinline__ void unit_A(LAS unsigned char* lds, const bf16_t* H, bf16_t* Ob, int b, int h, int qb, float lam, float ofac, const float* subw) {
    const int tid = pg8_ltid(), lane = tid & 63, r32 = lane & 31, hh = lane >> 5, wid = tid >> 6;
    const int qrow = CTXQ ? (ML + b * CTXL + wid * 32 + r32) : (b * SEQ + qb * 256 + wid * 32 + r32);
    const int qcol = h * 64, kcol = 256 + h * 64, vcol = 512 + h * 64;
    bf16x8 qf[4];
#pragma unroll
    for (int ks = 0; ks < 4; ++ks) qf[ks] = *(const bf16x8*)(H + (size_t)qrow * INC + qcol + 16 * ks + 8 * hh);
    const int NT = CTXQ ? 4 : 132;
    f32x16 O1[2], O2[2];
#pragma unroll
    for (int r = 0; r < 16; ++r) { O1[0][r] = 0.f; O1[1][r] = 0.f; O2[0][r] = 0.f; O2[1][r] = 0.f; }
    float m1 = -INFINITY, m2 = -INFINITY, l1 = 0.f, l2 = 0.f;
    TileRegs R;
    tile_gload(R, H, CTXQ ? (ML + b * CTXL) : (b * SEQ), kcol, vcol, tid);
    for (int t = 0; t < NT; ++t) {
        __syncthreads();
        tile_swrite(R, lds, tid);
        __syncthreads();
        if (t + 1 < NT) { const int tn = t + 1; const int krow = CTXQ ? (ML + b * CTXL + 64 * tn) : (tn < 128 ? b * SEQ + 64 * tn : ML + b * CTXL + 64 * (tn - 128)); tile_gload(R, H, krow, kcol, vcol, tid); }
        { f32x16 s[2]; s[0] = qk_block<0, 2>(lds, 0, r32, hh, qf); s[1] = qk_block<0, 2>(lds, 1, r32, hh, qf); softmax_pv(s, m1, l1, O1, lds, r32, hh); }
        __builtin_amdgcn_sched_barrier(0);
        { f32x16 s[2]; s[0] = qk_block<2, 2>(lds, 0, r32, hh, qf); s[1] = qk_block<2, 2>(lds, 1, r32, hh, qf); softmax_pv(s, m2, l2, O2, lds, r32, hh); }
        __builtin_amdgcn_sched_barrier(0);
    }
    l1 = xhalf_sum(l1); l2 = xhalf_sum(l2);
    const float i1 = 1.f / l1, i2 = lam / l2;
    float ss = 0.f;
#pragma unroll
    for (int dvb = 0; dvb < 2; ++dvb)
#pragma unroll
        for (int r = 0; r < 16; ++r) { const float o = O1[dvb][r] * i1 - O2[dvb][r] * i2; O1[dvb][r] = o; ss += o * o; }
    ss = xhalf_sum(ss);
    const float rn = rsqrtf(ss * (1.f / 64.f) + 1e-6f) * ofac;
#pragma unroll
    for (int dvb = 0; dvb < 2; ++dvb)
#pragma unroll
        for (int g = 0; g < 4; ++g) {
            const f32x4 w = *(const f32x4*)(subw + dvb * 32 + 8 * g + 4 * hh);
#pragma unroll
            for (int e = 0; e < 4; ++e) O1[dvb][4 * g + e] *= rn * w[e];
        }
    store_o(O1, Ob + (size_t)qrow * DM + h * 64, hh);
}

template <int MODE> __device__ __forceinline__ int tile_row_f(int t, int b, int lo, int nloc) {
    if (MODE == 1) return (t < nloc) ? (b * SEQ + 64 * (lo + t)) : (ML + b * CTXL + 64 * (t - nloc));
    if (MODE == 2) return (t < 4) ? (ML + b * CTXL + 64 * t) : (b * SEQ + 64 * (lo + t - 4));
    return ML + b * CTXL + 64 * t;
}
template <int MODE>
__device__ __forceinline__ void unit_BC(LAS unsigned char* lds, const bf16_t* H, bf16_t* Ob, int b, int hd, int blk, const float* sink_l, const float* rpb_l) {
    const int tid = pg8_ltid(), lane = tid & 63, r32 = lane & 31, hh = lane >> 5, wid = tid >> 6;
    int qrow, qcol, kcol, vcol, ocol, qpos = 0, r_w = 0, qc = 0, lo = 0, nloc = 0;
    float m = -INFINITY, l = 0.f;
    if (MODE == 1) {
        const int g = wid >> 2, head = hd * 2 + g; qpos = 128 * blk + 32 * (wid & 3) + r32; qrow = b * SEQ + qpos;
        qcol = 768 + head * 64; kcol = 1024 + hd * 64; vcol = 1152 + hd * 64; ocol = 256 + head * 64;
        lo = 2 * blk - 2; if (lo < 0) lo = 0; int hi = 2 * blk + 3; if (hi > 127) hi = 127; nloc = hi - lo + 1;
        m = sink_l[head] * LOG2E; l = (hh == 0) ? 1.f : 0.f;
    } else if (MODE == 3) {
        const int head = hd * 2 + blk; qrow = ML + b * CTXL + wid * 32 + r32;
        qcol = 768 + head * 64; kcol = 1024 + hd * 64; vcol = 1152 + hd * 64; ocol = 256 + head * 64;
        m = sink_l[head] * LOG2E; l = (hh == 0) ? 1.f : 0.f;
    } else if (MODE == 2) {
        r_w = 4 * blk + (wid >> 1); qc = 32 * (wid & 1) + r32; qrow = b * SEQ + r_w * 64 + qc;
        qcol = 1280 + hd * 64; kcol = 1536 + hd * 64; vcol = 1792 + hd * 64; ocol = 512 + hd * 64;
        int a0 = 4 * blk - 4; if (a0 < 0) a0 = 0; if (a0 > 120) a0 = 120; int a3 = 4 * blk + 3 - 4; if (a3 < 0) a3 = 0; if (a3 > 120) a3 = 120;
        lo = a0; nloc = a3 + 7 - a0 + 1;
    } else {
        qrow = ML + b * CTXL + wid * 32 + r32;
        qcol = 1280 + hd * 64; kcol = 1536 + hd * 64; vcol = 1792 + hd * 64; ocol = 512 + hd * 64;
    }
    bf16x8 qf[4];
#pragma unroll
    for (int ks = 0; ks < 4; ++ks) qf[ks] = *(const bf16x8*)(H + (size_t)qrow * INC + qcol + 16 * ks + 8 * hh);
    f32x16 O[2];
#pragma unroll
    for (int r = 0; r < 16; ++r) { O[0][r] = 0.f; O[1][r] = 0.f; }
    const int NT = 4 + nloc;
    int rs = 0;
    if (MODE == 2) { rs = r_w - 4; if (rs < 0) rs = 0; if (rs > 120) rs = 120; }
    const LAS float* rpbs = (const LAS float*)(lds + L_RPB);
    TileRegs R;
    tile_gload(R, H, tile_row_f<MODE>(0, b, lo, nloc), kcol, vcol, tid);
    for (int t = 0; t < NT; ++t) {
        __syncthreads();
        tile_swrite(R, lds, tid);
        if (MODE == 2 && t == 0) { for (int i = tid; i < 465; i += 512) ((LAS float*)(lds + L_RPB))[i] = rpb_l[hd * 465 + i] * LOG2E; }
        __syncthreads();
        if (t + 1 < NT) tile_gload(R, H, tile_row_f<MODE>(t + 1, b, lo, nloc), kcol, vcol, tid);
        bool active = true; int kr = 0;
        if (MODE == 2 && t >= 4) { kr = lo + t - 4; active = (kr >= rs) && (kr < rs + 8); }
        if (active) {
            f32x16 s[2]; s[0] = qk_block<0, 4>(lds, 0, r32, hh, qf); s[1] = qk_block<0, 4>(lds, 1, r32, hh, qf);
            if (MODE == 1 && t < nloc) {
                const int kbase = 64 * (lo + t) - qpos;
#pragma unroll
                for (int kb = 0; kb < 2; ++kb)
#pragma unroll
                    for (int r = 0; r < 16; ++r) { const int d = kbase + kb * 32 + crow(r, hh); if (d > 128 || d < -128) s[kb][r] = -INFINITY; }
            }
            if (MODE == 2 && t >= 4) {
                int cs = qc - 8; if (cs < 0) cs = 0; if (cs > 48) cs = 48;
                const int bbase = (kr - r_w + 7) * 31 + 15 - qc;
#pragma unroll
                for (int kb = 0; kb < 2; ++kb)
#pragma unroll
                    for (int r = 0; r < 16; ++r) {
                        const int kc = kb * 32 + crow(r, hh);
                        const bool ok = (kc >= cs) && (kc < cs + 16);
                        int bi = bbase + kc; bi = ok ? bi : 0;
                        const float bias = rpbs[bi];
                        s[kb][r] = ok ? (s[kb][r] + bias) : -INFINITY;
                    }
            }
            softmax_pv(s, m, l, O, lds, r32, hh);
        }
    }
    l = xhalf_sum(l);
    const float il = 1.f / l;
#pragma unroll
    for (int r = 0; r < 16; ++r) { O[0][r] *= il; O[1][r] *= il; }
    store_o(O, Ob + (size_t)qrow * DM + ocol, hh);
}
}
__device__ __forceinline__ float silu_f(float v) { return v / (1.f + __expf(-v)); }

__device__ __forceinline__ int wrow_map(int type, int n) {
    if (type == 1) { if (n < 512) { const int p = n & 31, blk = p >> 3; const int np = (blk == 1) ? p + 8 : ((blk == 2) ? p - 8 : p); return (n & ~31) + np; } return n; }
    if (type == 2) { const int half = (n >= 2816) ? 1 : 0; const int j = n - half * 2816; return (j >> 7) * 256 + half * 128 + (j & 127); }
    return n;
}
__device__ __forceinline__ void transpose_item(const float* W, int K, int N, bf16_t* WT, int type, LAS float* scr, int item, int lane) {
    const int nblk = N / 32, kb = item / nblk, nb = item - kb * nblk, k0 = 64 * kb, n0 = 32 * nb;
#pragma unroll 8
    for (int i = 0; i < 32; ++i) { const int kk = 2 * i + (lane >> 5); scr[kk * 33 + (lane & 31)] = W[(size_t)(k0 + kk) * N + n0 + (lane & 31)]; }
    asm volatile("s_waitcnt lgkmcnt(0)" ::: "memory");
    const int c = lane & 7;
#pragma unroll
    for (int j = 0; j < 4; ++j) {
        const int n = (lane >> 3) + 8 * j; const LAS float* s = scr + (8 * c) * 33 + n;
        u32x4 o; o.x = pkbf(s[0 * 33], s[1 * 33]); o.y = pkbf(s[2 * 33], s[3 * 33]); o.z = pkbf(s[4 * 33], s[5 * 33]); o.w = pkbf(s[6 * 33], s[7 * 33]);
        *(u32x4*)(WT + (size_t)wrow_map(type, n0 + n) * K + k0 + 8 * c) = o;
    }
    asm volatile("s_waitcnt lgkmcnt(0)" ::: "memory");
}

__device__ __forceinline__ void sincos_f(float x, float& c, float& s) {
    const float k = rintf(x * 0.636619772f);
    float r = fmaf(-k, 1.57079625129699707031f, x); r = fmaf(-k, 7.54978941586159635335e-08f, r);
    const float r2 = r * r;
    const float sr = r * (1.f + r2 * (-1.f / 6 + r2 * (1.f / 120 + r2 * (-1.f / 5040 + r2 * (1.f / 362880)))));
    const float cr = 1.f + r2 * (-0.5f + r2 * (1.f / 24 + r2 * (-1.f / 720 + r2 * (1.f / 40320 + r2 * (-1.f / 3628800)))));
    const int q = ((int)k) & 3;
    s = (q == 0) ? sr : (q == 1) ? cr : (q == 2) ? -sr : -cr;
    c = (q == 0) ? cr : (q == 1) ? -sr : (q == 2) ? -cr : sr;
}

__device__ __forceinline__ void norm_mod_row(const float* src, const float* nw, const float* sh, const float* sc, bf16_t* dst, int lane) {
    u32x2* o8 = (u32x2*)dst + lane;
    if (src == nullptr) {
#pragma unroll
        for (int j = 0; j < 4; ++j) o8[64 * j] = (u32x2){0u, 0u};
        return;
    }
    const f32x4* xr = (const f32x4*)src + lane;
    f32x4 v[4]; float s = 0.f;
#pragma unroll
    for (int j = 0; j < 4; ++j) { v[j] = xr[64 * j]; s += (v[j][0] * v[j][0] + v[j][1] * v[j][1]) + (v[j][2] * v[j][2] + v[j][3] * v[j][3]); }
    const float rstd = rsqrtf(wave_sum(s, lane) * (1.f / 1024.f) + 1e-6f);
#pragma unroll
    for (int j = 0; j < 4; ++j) {
        const int k = 4 * (64 * j + lane);
        const f32x4 w = *(const f32x4*)(nw + k), a = *(const f32x4*)(sc + k), d = *(const f32x4*)(sh + k);
        f32x4 y;
#pragma unroll
        for (int e = 0; e < 4; ++e) y[e] = (v[j][e] * rstd * w[e]) * (1.f + a[e]) + d[e];
        u32x2 p; p.x = pkbf(y[0], y[1]); p.y = pkbf(y[2], y[3]);
        o8[64 * j] = p;
    }
}

#define XB_TMO      128
#define XB_XCNT(j)  (256  + 64 * (j))
#define XB_XSUB(j)  (1280 + 64 * (j))
#define XB_XGEN(j)  (2304 + 64 * (j))
#define XB_TOP      3328
#define XB_TOPGEN   3392
#define XCD_BAR_WORDS 3456
#define XB_SPIN_CAP (1u << 18)

__device__ __forceinline__ unsigned xb_ld(unsigned* p)              { return __hip_atomic_load(p, __ATOMIC_RELAXED, __HIP_MEMORY_SCOPE_AGENT); }
__device__ __forceinline__ unsigned xb_add(unsigned* p, unsigned v) { return __hip_atomic_fetch_add(p, v, __ATOMIC_RELAXED, __HIP_MEMORY_SCOPE_AGENT); }
__device__ __forceinline__ unsigned xb_xcc_id() { return (unsigned)__builtin_amdgcn_s_getreg((3 << 11) | 20) & 0xFu; }
#define XB_SPIN(cond, bar) do { unsigned _sp = 0; while (cond) { __builtin_amdgcn_s_sleep(1); \
    if ((++_sp & 255u) == 0u) { if (xb_ld(&(bar)[XB_TMO])) break; if (_sp > XB_SPIN_CAP) { atomicAdd(&(bar)[XB_TMO], 1u); break; } } } } while (0)

struct XcdBarrier {
    unsigned* bar; unsigned x;
    volatile LAS unsigned* st;
};

__device__ __forceinline__ XcdBarrier xcd_barrier_post(unsigned* bar, volatile LAS unsigned* st) {
    XcdBarrier b; b.bar = bar; b.x = xb_xcc_id(); b.st = st;
    if (threadIdx.x == 0) (void)xb_add(&bar[XB_XCNT(b.x)], 1u);
    return b;
}
__device__ __forceinline__ void xcd_barrier_complete(unsigned* bar, unsigned x, unsigned& nloc, unsigned& nx) {
    const unsigned G = gridDim.x * gridDim.y * gridDim.z;
    unsigned sum, cnt, mine, sp = 0u;
    for (;;) {
        sum = 0u; cnt = 0u; mine = 0u;
#pragma unroll
        for (unsigned j = 0; j < 16; ++j) { const unsigned c = xb_ld(&bar[XB_XCNT(j)]); sum += c; cnt += (c > 0u) ? 1u : 0u; mine = (j == x) ? c : mine; }
        if (sum == G) break;
        __builtin_amdgcn_s_sleep(1);
        if ((++sp & 255u) == 0u) { if (xb_ld(&bar[XB_TMO])) break; if (sp > XB_SPIN_CAP) { atomicAdd(&bar[XB_TMO], 1u); break; } }
    }
    nloc = mine > 0u ? mine : 1u; nx = cnt > 0u ? cnt : 1u;
}

__device__ __forceinline__ void xcd_barrier(const XcdBarrier& b) {
    asm volatile("s_waitcnt vmcnt(0)" ::: "memory");
    __syncthreads();
    if (threadIdx.x == 0) {
        unsigned* bar = b.bar;
        __builtin_amdgcn_s_waitcnt(0);
        unsigned nloc = b.st[0], nx = b.st[1];
        if (nloc == 0u) { xcd_barrier_complete(bar, b.x, nloc, nx); b.st[0] = nloc; b.st[1] = nx; }
        const unsigned old = xb_add(&bar[XB_XSUB(b.x)], 1u);
        const unsigned gen = old / nloc;
        if (old + 1u == (gen + 1u) * nloc) {
            __builtin_amdgcn_fence(__ATOMIC_RELEASE, "agent");
            asm volatile("s_waitcnt vmcnt(0)" ::: "memory");
            const unsigned og = xb_add(&bar[XB_TOP], 1u);
            const unsigned tg = og / nx;
            if (og + 1u == (tg + 1u) * nx) xb_add(&bar[XB_TOPGEN], 1u);
            else XB_SPIN(xb_ld(&bar[XB_TOPGEN]) == tg, bar);
            __builtin_amdgcn_fence(__ATOMIC_ACQUIRE, "agent");
            xb_add(&bar[XB_XGEN(b.x)], 1u);
            asm volatile("s_waitcnt vmcnt(0)" ::: "memory");
        } else {
            XB_SPIN(xb_ld(&bar[XB_XGEN(b.x)]) == gen, bar);
            __builtin_amdgcn_fence(__ATOMIC_ACQUIRE, "agent");
            asm volatile("s_waitcnt vmcnt(0)" ::: "memory");
        }
    }
    __syncthreads();
}

struct Args { const float* in[23]; float* out; unsigned char* ws; int ph_lo, ph_hi, coop, pad; };
typedef const __attribute__((address_space(4))) Args* KArgs;
__device__ __forceinline__ KArgs kargs() { KArgs p = (KArgs)__builtin_amdgcn_kernarg_segment_ptr(); asm volatile("" : "+s"(p)); return p; }
constexpr int N_PHASES = 2 + 7 * DEPTH + 1;

__global__ void __launch_bounds__(512, 2) fwd_kernel(Args a) {
    extern __shared__ __attribute__((aligned(16))) unsigned char lds_raw[];
    LAS unsigned char* lds = (LAS unsigned char*)lds_raw;
    volatile LAS unsigned* bar_st = (volatile LAS unsigned*)(lds + RING_BYTES + 64);
    if (threadIdx.x < 2) bar_st[threadIdx.x] = 0u;
    __syncthreads();
    if (kargs()->coop) (void)xcd_barrier_post((unsigned*)kargs()->ws, bar_st);
    const int ph_lo = kargs()->ph_lo, ph_hi = kargs()->ph_hi;
    for (int ph = ph_lo; ph < ph_hi; ++ph) {
        KArgs ka = kargs();
        const int tid = pg8_ltid(), lane = tid & 63, wave = __builtin_amdgcn_readfirstlane(tid >> 6);
        int G = gridDim.x, bx = blockIdx.x; asm volatile("" : "+s"(G), "+s"(bx));
        const int vcu = (G % 8 == 0) ? (bx % 8) * (G / 8) + bx / 8 : bx;
        const int gw = vcu * 8 + wave, NGW = G * 8;
        unsigned char* ws = ka->ws;
        float* MOD = (float*)(ws + WS_MOD); float* MODP = (float*)(ws + WS_MODP);
        float* tabA = (float*)(ws + WS_TAB); float* tabB = tabA + 128 * 8 * 2;
        float* XC = (float*)(ws + WS_XC);
        bf16_t* XN = (bf16_t*)(ws + WS_XN); bf16_t* Ob = (bf16_t*)(ws + WS_O); bf16_t* Hb = (bf16_t*)(ws + WS_H); bf16_t* ACT = Hb;
        float* XL = ka->out;
        if (ph == 0) {
          for (int rep = 0; rep < REP_P; ++rep) {
            const float* w_mod = ka->in[6]; const float* c_in = ka->in[1]; const float* cctx_in = ka->in[3];
            for (int it = gw; it < 1536; it += NGW) {
                const int ks = it & 15, cgp = (it >> 4) % 24, l = it / 384;
                const int n0 = cgp * 256 + lane * 4;
                f32x4 acc[5];
#pragma unroll
                for (int s = 0; s < 5; ++s) acc[s] = (f32x4){0.f, 0.f, 0.f, 0.f};
                const float* wp = w_mod + ((size_t)l * 1024 + ks * 64) * 6144 + n0;
                for (int kk = 0; kk < 64; ++kk) {
                    const int k = ks * 64 + kk;
                    const f32x4 w = *(const f32x4*)(wp + (size_t)kk * 6144);
#pragma unroll
                    for (int s = 0; s < 4; ++s) acc[s] += silu_f(c_in[s * 1024 + k]) * w;
                    acc[4] += silu_f(cctx_in[k]) * w;
                }
#pragma unroll
                for (int s = 0; s < 5; ++s) *(f32x4*)(MODP + ((size_t)(ks * 4 + l) * 5 + s) * 6144 + n0) = acc[s];
            }
            LAS float* scr = (LAS float*)(lds + wave * 16384);
            for (int it = gw; it < 4 * 6144; it += NGW) {
                const int l = it / 6144; int r = it - l * 6144;
                unsigned char* wl = ws + WS_W + (size_t)l * W_LAYER;
                if (r < 1408) { transpose_item(ka->in[8] + (size_t)l * 1024 * 2816, 1024, 2816, (bf16_t*)wl, 1, scr, r, lane); continue; } r -= 1408;
                if (r < 512) { transpose_item(ka->in[9] + (size_t)l * 1024 * 1024, 1024, 1024, (bf16_t*)(wl + W_OUT_OFF), 0, scr, r, lane); continue; } r -= 512;
                if (r < 2816) { transpose_item(ka->in[18] + (size_t)l * 1024 * 5632, 1024, 5632, (bf16_t*)(wl + W_UP_OFF), 2, scr, r, lane); continue; } r -= 2816;
                transpose_item(ka->in[21] + (size_t)l * 2816 * 1024, 2816, 1024, (bf16_t*)(wl + W_DN_OFF), 0, scr, r, lane);
            }
            for (int idx = vcu * 512 + tid; idx < 3072; idx += G * 512) {
                int pos, i; float e;
                if (idx < 1024) { pos = idx >> 3; i = idx & 7; e = (float)i * 0.125f; } else { const int j = idx - 1024; pos = j >> 4; i = j & 15; e = (float)i * 0.0625f; }
                const float freq = exp2f(-e * 13.287712379549449f);
                const float ang = (float)pos * freq;
                float cc, ss; sincos_f(ang, cc, ss);
                float* tp = (idx < 1024) ? (tabA + idx * 2) : (tabB + (idx - 1024) * 2);
                tp[0] = cc; tp[1] = ss;
            }
          }
        } else if (ph == 1) {
            const float* b_mod = ka->in[7];
            for (int idx = vcu * 512 + tid; idx < 4 * 5 * 6144; idx += G * 512) {
                const int l = idx / 30720, n = idx % 6144;
                float s = b_mod[l * 6144 + n];
#pragma unroll
                for (int ks = 0; ks < 16; ++ks) s += MODP[(size_t)ks * 122880 + idx];
                MOD[idx] = s;
            }
        } else if (ph == N_PHASES - 1) {
            const float* fw = ka->in[22];
            for (int m = gw; m < ML; m += NGW) {
                f32x4* xr = (f32x4*)(XL + (size_t)m * DM) + lane;
                f32x4 v[4]; float s = 0.f;
#pragma unroll
                for (int j = 0; j < 4; ++j) { v[j] = xr[64 * j]; s += (v[j][0] * v[j][0] + v[j][1] * v[j][1]) + (v[j][2] * v[j][2] + v[j][3] * v[j][3]); }
                const float rstd = rsqrtf(wave_sum(s, lane) * (1.f / 1024.f) + 1e-6f);
#pragma unroll
                for (int j = 0; j < 4; ++j) { const f32x4 w = *(const f32x4*)(fw + 4 * (64 * j + lane)); xr[64 * j] = v[j] * rstd * w; }
            }
        } else {
            const int l = (ph - 2) / 7, k = (ph - 2) % 7;
            const bool need_ctx = l < DEPTH - 1;
            const float* modl = MOD + (size_t)l * 5 * 6144;
            unsigned char* wl = ws + WS_W + (size_t)l * W_LAYER;
            const float* srcL = (l == 0) ? ka->in[0] : XL;
            const float* srcC = (l == 0) ? ka->in[2] : XC;
            if (k == 0) {
                const float* nw = ka->in[4] + l * 1024;
                for (int rep = 0; rep < REP_M; ++rep) for (int m = gw; m < MT; m += NGW) {
                    const bool lat = m < ML; const int slot = lat ? (m >> 13) : 4;
                    const float* src = lat ? (srcL + (size_t)m * DM) : (srcC + (size_t)(m - ML) * DM);
                    norm_mod_row(src, nw, modl + slot * 6144, modl + slot * 6144 + 1024, XN + (size_t)m * DM, lane);
                }
            } else if (k == 1) {
                pg8::Gemm g{XN, (const bf16_t*)wl, MT, INC, DM}; pg8::StaticOrder S; S.init(MT, INC, G, bx);
                pg8::EpiInProj E{Hb, tabA, tabB};
#ifndef DIS_IN
                for (int rep = 0; rep < REP_IN; ++rep) pg8::gemm_phase<pg8::EpiInProj, pg8::StaticOrder, true, true>(lds, g, S, E);
#endif
            } else if (k == 2) {
                float lam, ofac;
                {
                    float d1 = 0.f, d2 = 0.f;
                    for (int i = 0; i < 32; ++i) { d1 += ka->in[10][l * 32 + i] * ka->in[11][l * 32 + i]; d2 += ka->in[12][l * 32 + i] * ka->in[13][l * 32 + i]; }
                    const float li = 0.8f - 0.6f * expf(-0.3f * (float)l);
                    lam = expf(d1) - expf(d2) + li; ofac = 1.f - li;
                }
                const float* subw = ka->in[14] + l * 64; const float* sink_l = ka->in[15] + l * 4; const float* rpb_l = ka->in[16] + (size_t)l * 4 * 465;
#ifndef DIS_A
                for (int rep = 0; rep < REP_A; ++rep) for (int u = vcu; u < 512; u += G) att::unit_A<false>(lds, Hb, Ob, u >> 7, (u >> 5) & 3, u & 31, lam, ofac, subw);
#endif
#ifndef DIS_B
                for (int rep = 0; rep < REP_M; ++rep) for (int u = vcu; u < 512; u += G) att::unit_BC<1>(lds, Hb, Ob, u >> 7, (u >> 6) & 1, u & 63, sink_l, rpb_l);
#endif
#ifndef DIS_C
                for (int rep = 0; rep < REP_M; ++rep) for (int u = vcu; u < 512; u += G) att::unit_BC<2>(lds, Hb, Ob, u >> 7, (u >> 5) & 3, u & 31, sink_l, rpb_l);
#endif
#ifndef DIS_CTX
                if (need_ctx) {
                    for (int rep = 0; rep < REP_M; ++rep) for (int u = vcu; u < 48; u += G) {
                        const int kind = u >> 4, bh = u & 15;
                        if (kind == 0) att::unit_A<true>(lds, Hb, Ob, bh >> 2, bh & 3, 0, lam, ofac, subw);
                        else if (kind == 1) att::unit_BC<3>(lds, Hb, Ob, bh >> 2, (bh >> 1) & 1, bh & 1, sink_l, rpb_l);
                        else att::unit_BC<4>(lds, Hb, Ob, bh >> 2, bh & 3, 0, sink_l, rpb_l);
                    }
                }
#endif
                {
                    const float* cwl = ka->in[17] + (size_t)l * 3 * 256;
                    const int rows = need_ctx ? MT : ML;
                    for (int rep = 0; rep < REP_M; ++rep) for (int idx = vcu * 512 + tid; idx < rows * 32; idx += G * 512) {
                        const int row = idx >> 5, c0 = (idx & 31) * 8;
                        int t, len; if (row < ML) { t = row & 8191; len = SEQ; } else { t = (row - ML) & 255; len = CTXL; }
                        const bf16_t* hp = Hb + (size_t)row * INC + 2048 + c0;
                        const u32x4 bg = *(const u32x4*)hp, cg1 = *(const u32x4*)(hp + 256), xi1 = *(const u32x4*)(hp + 512);
                        u32x4 cg0 = {0u, 0u, 0u, 0u}, xi0 = cg0, cg2 = cg0, xi2 = cg0;
                        if (t > 0) { cg0 = *(const u32x4*)(hp - INC + 256); xi0 = *(const u32x4*)(hp - INC + 512); }
                        if (t < len - 1) { cg2 = *(const u32x4*)(hp + INC + 256); xi2 = *(const u32x4*)(hp + INC + 512); }
                        float w0[8], w1[8], w2[8];
#pragma unroll
                        for (int e = 0; e < 8; ++e) { w0[e] = cwl[c0 + e]; w1[e] = cwl[256 + c0 + e]; w2[e] = cwl[512 + c0 + e]; }
                        u32x4 ow;
#pragma unroll
                        for (int e = 0; e < 4; ++e) {
                            const float ylo = w0[2 * e] * bflo(cg0[e]) * bflo(xi0[e]) + w1[2 * e] * bflo(cg1[e]) * bflo(xi1[e]) + w2[2 * e] * bflo(cg2[e]) * bflo(xi2[e]);
                            const float yhi = w0[2 * e + 1] * bfhi(cg0[e]) * bfhi(xi0[e]) + w1[2 * e + 1] * bfhi(cg1[e]) * bfhi(xi1[e]) + w2[2 * e + 1] * bfhi(cg2[e]) * bfhi(xi2[e]);
                            ow[e] = pkbf(bflo(bg[e]) * ylo, bfhi(bg[e]) * yhi);
                        }
                        *(u32x4*)(Ob + (size_t)row * DM + 768 + c0) = ow;
                    }
                }
                __syncthreads();
            } else if (k == 3) {
                const int M = need_ctx ? MT : ML;
                pg8::Gemm g{Ob, (const bf16_t*)(wl + W_OUT_OFF), M, DM, DM}; pg8::StaticOrder S; S.init(M, DM, G, bx);
                pg8::EpiRes E{srcL, srcC, XL, XC, modl, 2048};
#ifndef DIS_OUT
#if REP_OD > 1
                { pg8::EpiRes E2{srcL, srcC, (float*)Hb, (float*)Hb + (size_t)ML * DM, modl, 2048}; pg8::gemm_phase<pg8::EpiRes, pg8::StaticOrder, true, true>(lds, g, S, E2); }
#endif
                pg8::gemm_phase<pg8::EpiRes, pg8::StaticOrder, true, true>(lds, g, S, E);
#endif
            } else if (k == 4) {
                const float* nw = ka->in[5] + l * 1024;
                const int nrows = (need_ctx ? NMX_ALL : NMX_L) * 256;
                for (int rep = 0; rep < REP_M; ++rep) for (int e = gw; e < nrows; e += NGW) {
                    const int pm = e >> 8, j = e & 255;
                    int t, slot; const float* base; int len;
                    if (pm < NMX_L) { const int s = pm / 33, ti = pm - s * 33; t = 254 * ti - 1 + j; len = SEQ; slot = s; base = XL + (size_t)s * SEQ * DM; }
                    else { const int q = pm - NMX_L; const int s = q >> 1, ti = q & 1; t = 254 * ti - 1 + j; len = CTXL; slot = 4; base = XC + (size_t)s * CTXL * DM; }
                    const float* src = (t >= 0 && t < len) ? (base + (size_t)t * DM) : nullptr;
                    norm_mod_row(src, nw, modl + slot * 6144 + 3072, modl + slot * 6144 + 4096, XN + (size_t)e * DM, lane);
                }
            } else if (k == 5) {
                const int nM = need_ctx ? NMX_ALL : NMX_L;
                pg8::Gemm g{XN, (const bf16_t*)(wl + W_UP_OFF), nM * 256, UPC, DM}; pg8::StaticOrder S; S.init(nM * 256, UPC, G, bx);
                pg8::EpiUpConv E{ACT, ka->in[19] + (size_t)l * 3 * UPC, ka->in[20] + (size_t)l * UPC};
                pg8::OneUnit one;
#ifndef DIS_UP
                for (int rep = 0; rep < REP_UP; ++rep) for (int i = 0; S.next(i, one.u); ++i) pg8::gemm_phase<pg8::EpiUpConv, pg8::OneUnit, false, true>(lds, g, one, E);
#endif
            } else {
                const int M = need_ctx ? MT : ML;
                pg8::Gemm g{ACT, (const bf16_t*)(wl + W_DN_OFF), M, DM, DFF}; pg8::StaticOrder S; S.init(M, DM, G, bx);
                pg8::EpiRes E{XL, XC, XL, XC, modl, 5120};
#ifndef DIS_DN
#if REP_OD > 1
                { pg8::EpiRes E2{XL, XC, (float*)XN, (float*)XN + (size_t)ML * DM, modl, 5120}; pg8::gemm_phase<pg8::EpiRes, pg8::StaticOrder, true, true>(lds, g, S, E2); }
#endif
                pg8::gemm_phase<pg8::EpiRes, pg8::StaticOrder, true, true>(lds, g, S, E);
#endif
            }
        }
        if (ph + 1 < ph_hi && kargs()->coop) {
            if (ph == 0) cg::this_grid().sync();
            else { XcdBarrier b; b.bar = (unsigned*)kargs()->ws; b.x = xb_xcc_id(); b.st = bar_st; xcd_barrier(b); }
        }
    }
}

extern "C" void kernel_launch(void* const* d_in, const int* in_sizes, int n_in, void* d_out, int out_size, void* d_ws, size_t ws_size, hipStream_t stream) {
    static int grid = 0;
    if (grid == 0) {
        if (n_in != 23 || out_size != ML * DM || ws_size < WS_END) { fprintf(stderr, "kernel_launch: unexpected shapes (n_in %d out %d ws %zu need %zu)\n", n_in, out_size, ws_size, (size_t)WS_END); grid = -1; return; }
        int dev = 0, cus = 0, per_cu = 0;
        if (hipGetDevice(&dev) != hipSuccess || hipDeviceGetAttribute(&cus, hipDeviceAttributeMultiprocessorCount, dev) != hipSuccess) { grid = -1; return; }
        if (hipFuncSetAttribute((const void*)fwd_kernel, hipFuncAttributeMaxDynamicSharedMemorySize, LDS_BYTES) != hipSuccess) { fprintf(stderr, "kernel_launch: hipFuncSetAttribute failed\n"); grid = -1; return; }
        if (hipOccupancyMaxActiveBlocksPerMultiprocessor(&per_cu, (const void*)fwd_kernel, 512, LDS_BYTES) != hipSuccess || per_cu < 1) fprintf(stderr, "kernel_launch: occupancy query says %d\n", per_cu);
        (void)hipGetLastError();
        grid = cus;
    }
    if (grid < 0) return;
    Args a{};
    for (int i = 0; i < 23; ++i) a.in[i] = (const float*)d_in[i];
    a.out = (float*)d_out; a.ws = (unsigned char*)d_ws;
#if MK_MULTI
    for (int ph = 0; ph < N_PHASES; ++ph) {
        a.ph_lo = ph; a.ph_hi = ph + 1; a.coop = 0;
        hipLaunchKernelGGL(fwd_kernel, dim3(grid), dim3(512), LDS_BYTES, stream, a);
    }
#else
    a.ph_lo = 0; a.ph_hi = N_PHASES; a.coop = 1;
    if (hipMemsetAsync(d_ws, 0, 16384, stream) != hipSuccess) { fprintf(stderr, "kernel_launch: memset failed\n"); return; }
    void* args[] = {&a};
    hipError_t e = hipLaunchCooperativeKernel((const void*)fwd_kernel, dim3(grid), dim3(512), args, LDS_BYTES, stream);
    if (e != hipSuccess) fprintf(stderr, "cooperative launch failed: %s (grid %d)\n", hipGetErrorString(e), grid);
#endif
}
```

```cpp
#include <hip/hip_runtime.h>
#include <hip/hip_cooperative_groups.h>
#include <cstdio>
#include <cstdint>
namespace cg = cooperative_groups;

#ifndef MK_MULTI
#define MK_MULTI 0
#endif

#ifndef REP_IN
#define REP_IN 1
#endif
#ifndef REP_UP
#define REP_UP 1
#endif
#ifndef REP_A
#define REP_A 1
#endif
#ifndef REP_OD
#define REP_OD 1
#endif
#ifndef REP_P
#define REP_P 1
#endif
#ifndef REP_M
#define REP_M 1
#endif

__device__ __forceinline__ int pg8_ltid() { int t = threadIdx.x; asm volatile("" : "+v"(t)); return t; }
namespace pg8 {
#define PG8_LAS __attribute__((address_space(3)))
typedef unsigned short bf16_t;
typedef short bf16x8 __attribute__((ext_vector_type(8)));
typedef float f32x4 __attribute__((ext_vector_type(4)));
typedef unsigned u32x4 __attribute__((ext_vector_type(4)));
constexpr int BM = 256, BK = 64, HALF = 128, HTB = HALF * BK * 2  , STAGE_BYTES = 8 * HTB, NXCD = 8, WGM = 8;

__host__ __device__ __forceinline__ int lds_byte(int r, int c) { const int st = (r >> 4) * 2 + (c >> 5), rr = r & 15, cc = c & 31, ob = rr * 64 + cc * 2; return st * 1024 + (ob ^ (((ob >> 9) & 1) << 5)); }
__host__ __device__ __forceinline__ void stage_rc(int b, int& R, int& C) { const int st = b / 1024, sb = b % 1024, swz = sb ^ (((sb >> 9) & 1) << 5); R = (st >> 1) * 16 + swz / 64; C = (st & 1) * 32 + (swz % 64) / 2; }
__host__ __device__ __forceinline__ int perm32(int rho) { const int n = rho >> 4, i = rho & 15; return 8 * (i >> 2) + 4 * n + (i & 3); }

struct Unit { int pm, pn; };
struct Gemm { const bf16_t* A; const bf16_t* Bt; int M, N, K; };

struct StaticOrder {
    int nM, nN, nwg, G, c;
    __host__ __device__ void init(int M, int N, int G_, int c_) { nM = M / BM; nN = N / BM; nwg = nM * nN; G = G_; c = c_; }
    __host__ __device__ bool next(int i, Unit& u) const {
        const long L = (long)i * G + c; if (L >= nwg) return false;
        int wgid = (int)L; { const int q = nwg / NXCD, r = nwg % NXCD, xcd = wgid % NXCD, off = wgid / NXCD; wgid = (xcd < r ? xcd * (q + 1) : r * (q + 1) + (xcd - r) * q) + off; }
        const int nig = WGM * nN, gid = wgid / nig, fm = gid * WGM, gsz = (nM - fm) < WGM ? (nM - fm) : WGM;
        u.pm = fm + ((wgid % nig) % gsz); u.pn = (wgid % nig) / gsz; return true;
    }
    __device__ __forceinline__ void a_ready(const Unit&) const {}
    __device__ __forceinline__ void done(const Unit&) const {}
};

__device__ __forceinline__ unsigned cvt_pk_bf16(float lo, float hi) { unsigned r; asm volatile("v_cvt_pk_bf16_f32 %0, %1, %2" : "=v"(r) : "v"(lo), "v"(hi)); return r; }
typedef unsigned u32x2 __attribute__((ext_vector_type(2)));

struct OneUnit {
    Unit u;
    __device__ __forceinline__ bool next(int i, Unit& o) const { if (i != 0) return false; o = u; return true; }
    __device__ __forceinline__ void a_ready(const Unit&) const {}
    __device__ __forceinline__ void done(const Unit&) const {}
};

struct EpiInProj {
    static constexpr bool PERM = false, AFTER_DRAIN = false;
    bf16_t* H; const float* tabA; const float* tabB;
    __device__ __forceinline__ void operator()(const f32x4 (&acc)[2][2][4][2], const Unit& u, int wr, int wc, int fr, int fq) const {
        const int pn = u.pn; const bool latent = u.pm < 128;
        const float scale = (pn == 0) ? 0.17677669529663687f * 1.4426950408889634f : ((pn == 3 || pn == 5) ? 0.125f * 1.4426950408889634f : 1.0f);
#pragma unroll
        for (int bj = 0; bj < 2; ++bj) {
            int mode = (pn == 0 || pn == 1) ? 1 : ((pn == 3 || (pn == 4 && bj == 0)) ? 2 : 0);
            if (!latent) mode = 0;
#ifdef TEST_NOROPE
            mode = 0;
#endif
#pragma unroll
            for (int ai = 0; ai < 2; ++ai)
#pragma unroll
                for (int m = 0; m < 4; ++m) {
                    const int r = u.pm * BM + ai * HALF + wr * 64 + m * 16 + fr;
                    f32x4 v0 = acc[ai][bj][m][0], v1 = acc[ai][bj][m][1];
                    if (mode != 0) {
                        const int t = r & 8191, trow = t >> 6, tcol = t & 63;
                        const float* tp;
                        if (mode == 1) { const int pos = (fq < 2) ? trow : tcol; tp = tabA + (pos * 8 + 4 * (fq & 1)) * 2; }
                        else { const int pos = (wc & 1) ? tcol : trow; tp = tabB + (pos * 16 + 4 * fq) * 2; }
                        const f32x4 cs0 = *(const f32x4*)tp, cs1 = *(const f32x4*)(tp + 4);
                        const float c0 = cs0[0], s0 = cs0[1], c1 = cs0[2], s1 = cs0[3], c2 = cs1[0], s2 = cs1[1], c3 = cs1[2], s3 = cs1[3];
                        f32x4 a = v0, b = v1;
                        v0[0] = a[0] * c0 - b[0] * s0; v1[0] = b[0] * c0 + a[0] * s0;
                        v0[1] = a[1] * c1 - b[1] * s1; v1[1] = b[1] * c1 + a[1] * s1;
                        v0[2] = a[2] * c2 - b[2] * s2; v1[2] = b[2] * c2 + a[2] * s2;
                        v0[3] = a[3] * c3 - b[3] * s3; v1[3] = b[3] * c3 + a[3] * s3;
                    }
                    v0 = v0 * scale; v1 = v1 * scale;
                    bf16_t* rowp = H + (size_t)r * 2816 + pn * BM + bj * HALF + wc * 32 + 4 * fq;
                    u32x2 w0, w1; w0.x = cvt_pk_bf16(v0[0], v0[1]); w0.y = cvt_pk_bf16(v0[2], v0[3]); w1.x = cvt_pk_bf16(v1[0], v1[1]); w1.y = cvt_pk_bf16(v1[2], v1[3]);
                    *(u32x2*)rowp = w0; *(u32x2*)(rowp + 16) = w1;
                }
        }
    }
};

struct EpiRes {
    static constexpr bool PERM = false, AFTER_DRAIN = false;
    const float* baseL; const float* baseC; float* outL; float* outC; const float* modl; int goff;
    __device__ __forceinline__ void operator()(const f32x4 (&acc)[2][2][4][2], const Unit& u, int wr, int wc, int fr, int fq) const {
        const bool ctx = u.pm >= 128; const int slot = ctx ? 4 : (u.pm >> 5);
        const int row0 = (ctx ? (u.pm - 128) : u.pm) * BM + wr * 64 + fr;
        const float* bp = ctx ? baseC : baseL; float* op = ctx ? outC : outL;
        const int col0 = u.pn * BM + wc * 32 + 4 * fq;
        f32x4 gv[2][2];
#pragma unroll
        for (int bj = 0; bj < 2; ++bj)
#pragma unroll
            for (int n = 0; n < 2; ++n) gv[bj][n] = *(const f32x4*)(modl + slot * 6144 + goff + col0 + bj * HALF + n * 16);
#pragma unroll
        for (int ai = 0; ai < 2; ++ai)
#pragma unroll
            for (int m = 0; m < 4; ++m) {
                const size_t off = (size_t)(row0 + ai * HALF + m * 16) * 1024 + col0;
#pragma unroll
                for (int bj = 0; bj < 2; ++bj)
#pragma unroll
                    for (int n = 0; n < 2; ++n) {
                        const f32x4 bs = *(const f32x4*)(bp + off + bj * HALF + n * 16);
                        *(f32x4*)(op + off + bj * HALF + n * 16) = bs + gv[bj][n] * acc[ai][bj][m][n];
                    }
                asm volatile("" ::: "memory");
            }
    }
};

struct EpiUpConv {
    static constexpr bool PERM = false, AFTER_DRAIN = true;
    bf16_t* ACT; const float* cw; const float* cb;
    static constexpr int TP = 520;
    __device__ __forceinline__ void fused(f32x4 (&acc)[2][2][4][2], const Unit& u, int wr, int wc, int fr, int fq, PG8_LAS unsigned char* lds, int wid, int lane) const {
#pragma unroll
        for (int ai = 0; ai < 2; ++ai)
#pragma unroll
            for (int m = 0; m < 4; ++m) {
                const int row = ai * HALF + wr * 64 + m * 16 + fr;
#pragma unroll
                for (int bj = 0; bj < 2; ++bj)
#pragma unroll
                    for (int n = 0; n < 2; ++n) {
                        const f32x4 v = acc[ai][bj][m][n]; u32x2 w; w.x = cvt_pk_bf16(v[0], v[1]); w.y = cvt_pk_bf16(v[2], v[3]);
                        *(PG8_LAS u32x2*)(lds + row * TP + (bj * HALF + wc * 32 + n * 16 + 4 * fq) * 2) = w;
                    }
            }
        const int tid = wid * 64 + lane, ch = tid & 15;
        const int gcol = u.pn * 128 + ch * 8;
        float wg[3][8], wv[3][8], bg[8], bv[8];
#pragma unroll
        for (int k = 0; k < 3; ++k) {
            const f32x4 a0 = *(const f32x4*)(cw + k * 5632 + gcol), a1 = *(const f32x4*)(cw + k * 5632 + gcol + 4);
            const f32x4 b0 = *(const f32x4*)(cw + k * 5632 + 2816 + gcol), b1 = *(const f32x4*)(cw + k * 5632 + 2816 + gcol + 4);
#pragma unroll
            for (int e = 0; e < 4; ++e) { wg[k][e] = a0[e]; wg[k][4 + e] = a1[e]; wv[k][e] = b0[e]; wv[k][4 + e] = b1[e]; }
        }
        {
            const f32x4 a0 = *(const f32x4*)(cb + gcol), a1 = *(const f32x4*)(cb + gcol + 4), b0 = *(const f32x4*)(cb + 2816 + gcol), b1 = *(const f32x4*)(cb + 2816 + gcol + 4);
#pragma unroll
            for (int e = 0; e < 4; ++e) { bg[e] = a0[e]; bg[4 + e] = a1[e]; bv[e] = b0[e]; bv[4 + e] = b1[e]; }
        }
        int seqlen, rowbase, ti;
        if (u.pm < 132) { const int s = u.pm / 33; ti = u.pm - s * 33; seqlen = 8192; rowbase = s * 8192; }
        else { const int q = u.pm - 132; const int s = q >> 1; ti = q & 1; seqlen = 256; rowbase = 32768 + s * 256; }
        asm volatile("s_waitcnt lgkmcnt(0)" ::: "memory"); __builtin_amdgcn_s_barrier(); asm volatile("" ::: "memory");
        for (int it = tid; it < 254 * 16; it += 512) {
            const int j = 1 + (it >> 4); const int t = 254 * ti - 1 + j;
            if (t < seqlen) {
                float g[8], v[8];
#pragma unroll
                for (int e = 0; e < 8; ++e) { g[e] = bg[e]; v[e] = bv[e]; }
#pragma unroll
                for (int k = 0; k < 3; ++k) {
                    const PG8_LAS unsigned char* rp = lds + (j - 1 + k) * TP + ch * 16;
                    const u32x2 g0 = *(const PG8_LAS u32x2*)rp, g1 = *(const PG8_LAS u32x2*)(rp + 8);
                    const u32x2 v0 = *(const PG8_LAS u32x2*)(rp + 256), v1 = *(const PG8_LAS u32x2*)(rp + 264);
                    const unsigned gw[4] = {g0.x, g0.y, g1.x, g1.y}, vw[4] = {v0.x, v0.y, v1.x, v1.y};
#pragma unroll
                    for (int e = 0; e < 4; ++e) {
                        g[2 * e] += wg[k][2 * e] * __uint_as_float(gw[e] << 16); g[2 * e + 1] += wg[k][2 * e + 1] * __uint_as_float(gw[e] & 0xffff0000u);
                        v[2 * e] += wv[k][2 * e] * __uint_as_float(vw[e] << 16); v[2 * e + 1] += wv[k][2 * e + 1] * __uint_as_float(vw[e] & 0xffff0000u);
                    }
                }
                float o[8];
#pragma unroll
                for (int e = 0; e < 8; ++e) o[e] = g[e] / (1.f + __expf(-g[e])) * v[e];
                u32x4 w; w.x = cvt_pk_bf16(o[0], o[1]); w.y = cvt_pk_bf16(o[2], o[3]); w.z = cvt_pk_bf16(o[4], o[5]); w.w = cvt_pk_bf16(o[6], o[7]);
                *(u32x4*)(ACT + (size_t)(rowbase + t) * 2816 + gcol) = w;
            }
        }
        asm volatile("s_waitcnt lgkmcnt(0)" ::: "memory"); __builtin_amdgcn_s_barrier(); asm volatile("" ::: "memory");
    }
};
template <class Epi, class Sched, bool ALIGN_EPI = false, bool SP2 = false>
__device__ __forceinline__ void gemm_phase(PG8_LAS unsigned char* lds, const Gemm g, const Sched& S, const Epi& E) {
    const int tid = pg8_ltid(), wid = __builtin_amdgcn_readfirstlane(tid >> 6), lane = tid & 63, wr = wid >> 2, wc = wid & 3, fr = lane & 15, fq = lane >> 4;
    const int K = g.K, nt = K / BK;
    unsigned voffA[2], voffB[2];
#pragma unroll
    for (int i = 0; i < 2; ++i) { int R, C; stage_rc(tid * 16 + i * 8192, R, C); const int Rb = Epi::PERM ? ((R & ~31) + perm32(R & 31)) : R;
        voffA[i] = (unsigned)(R * K + C) * 2u; voffB[i] = (unsigned)(Rb * K + C) * 2u; }
    const size_t kstep = (size_t)(BK * 2);
    const size_t hstep = (size_t)HALF * K * 2;
    const size_t tstep = 2 * hstep;
    const unsigned ldsw = (unsigned)wid * 1024u;
    const int aoff = lds_byte(wr * 64 + fr, fq * 8), boff = lds_byte(wc * 32 + fr, fq * 8);
#define PG8_SA(b, h) (((b) * 2 + (h)) * HTB)
#define PG8_SB(b, h) ((4 + (b) * 2 + (h)) * HTB)
#define PG8_STAGE(bufoff, gbase, voff) do { _Pragma("unroll") for (int _i = 0; _i < 2; ++_i) \
        __builtin_amdgcn_global_load_lds((const unsigned*)((const char*)(gbase) + (voff)[_i]), (PG8_LAS unsigned*)(lds + (bufoff) + ldsw + _i * 8192), 16, 0, 0); } while (0)
#define PG8_LDA(dst, b, h) do { _Pragma("unroll") for (int m = 0; m < 4; ++m) _Pragma("unroll") for (int k = 0; k < 2; ++k) dst[m][k] = *(const PG8_LAS bf16x8*)(lds + PG8_SA(b, h) + aoff + m * 2048 + k * 1024); } while (0)
#define PG8_LDB(dst, b, h) do { _Pragma("unroll") for (int n = 0; n < 2; ++n) _Pragma("unroll") for (int k = 0; k < 2; ++k) dst[n][k] = *(const PG8_LAS bf16x8*)(lds + PG8_SB(b, h) + boff + n * 2048 + k * 1024); } while (0)
#define PG8_MMA(ai, bj, At, Bt) do { __builtin_amdgcn_s_setprio(1); _Pragma("unroll") for (int m = 0; m < 4; ++m) _Pragma("unroll") for (int n = 0; n < 2; ++n) _Pragma("unroll") for (int k = 0; k < 2; ++k) \
        acc[ai][bj][m][n] = __builtin_amdgcn_mfma_f32_16x16x32_bf16(Bt[n][k], At[m][k], acc[ai][bj][m][n], 0, 0, 0); __builtin_amdgcn_s_setprio(0); } while (0)
#define PG8_WAIT_V(n) asm volatile("s_waitcnt vmcnt(" #n ")" ::: "memory")
#define PG8_WAIT_L(n) asm volatile("s_waitcnt lgkmcnt(" #n ")" ::: "memory")
#define PG8_BAR __builtin_amdgcn_s_barrier()
#define PG8_SCHED __builtin_amdgcn_sched_barrier(0)
    Unit cur, nxt; int ui = 0;
    if (!S.next(0, cur)) return;
    f32x4 acc[2][2][4][2];
#pragma unroll
    for (int a = 0; a < 2; ++a)
#pragma unroll
        for (int b = 0; b < 2; ++b)
#pragma unroll
            for (int m = 0; m < 4; ++m)
#pragma unroll
                for (int n = 0; n < 2; ++n) acc[a][b][m][n] = (f32x4){0.f, 0.f, 0.f, 0.f};
    bf16x8 At[4][2], B0[2][2], B1[2][2];
    const char* cA = (const char*)g.A + (size_t)cur.pm * tstep; const char* cB = (const char*)g.Bt + (size_t)cur.pn * tstep;
    S.a_ready(cur);
    if constexpr (SP2) {
        PG8_STAGE(PG8_SB(0, 0), cB, voffB); PG8_STAGE(PG8_SB(0, 1), cB + hstep, voffB); PG8_STAGE(PG8_SA(0, 0), cA, voffA); PG8_STAGE(PG8_SA(0, 1), cA + hstep, voffA);
        if (wr == 1) PG8_BAR;
        PG8_WAIT_V(2); PG8_BAR;
        PG8_STAGE(PG8_SB(1, 0), cB + kstep, voffB); PG8_STAGE(PG8_SA(1, 0), cA + kstep, voffA); PG8_STAGE(PG8_SB(1, 1), cB + hstep + kstep, voffB);
        PG8_WAIT_V(6); PG8_BAR;
    } else {
        PG8_STAGE(PG8_SB(0, 0), cB, voffB); PG8_STAGE(PG8_SA(0, 0), cA, voffA); PG8_STAGE(PG8_SB(0, 1), cB + hstep, voffB); PG8_STAGE(PG8_SA(0, 1), cA + hstep, voffA);
        if (wr == 1) PG8_BAR;
        PG8_WAIT_V(4); PG8_BAR;
        PG8_STAGE(PG8_SB(1, 0), cB + kstep, voffB); PG8_STAGE(PG8_SA(1, 0), cA + kstep, voffA); PG8_STAGE(PG8_SB(1, 1), cB + hstep + kstep, voffB);
        PG8_WAIT_V(6); PG8_BAR;
    }
    for (;;) {
        const bool has_next = S.next(ui + 1, nxt);
        const char* nA = has_next ? (const char*)g.A + (size_t)nxt.pm * tstep : cA; const char* nB = has_next ? (const char*)g.Bt + (size_t)nxt.pn * tstep : cB;
        for (int t = 0; t < nt; t += 2) {
            const bool last = (t == nt - 2);
            const char* a1 = cA + (size_t)(t + 1) * kstep;
            const char* a2 = last ? nA : cA + (size_t)(t + 2) * kstep; const char* b2 = last ? nB : cB + (size_t)(t + 2) * kstep;
            const char* a3 = a2 + kstep; const char* b3 = b2 + kstep;
            if (last && has_next) S.a_ready(nxt);
            if constexpr (SP2) {
            PG8_LDB(B0, 0, 0); PG8_LDB(B1, 0, 1); PG8_SCHED; PG8_LDA(At, 0, 0); PG8_STAGE(PG8_SA(1, 1), a1 + hstep, voffA);
            PG8_WAIT_V(8); PG8_WAIT_L(0); PG8_BAR; PG8_MMA(0, 0, At, B0); PG8_MMA(0, 1, At, B1); PG8_BAR; PG8_SCHED;
            PG8_LDA(At, 0, 1); PG8_STAGE(PG8_SB(0, 0), b2, voffB); PG8_STAGE(PG8_SB(0, 1), b2 + hstep, voffB); PG8_STAGE(PG8_SA(0, 0), a2, voffA);
            PG8_WAIT_V(8); PG8_WAIT_L(0); PG8_BAR; PG8_MMA(1, 0, At, B0); PG8_MMA(1, 1, At, B1); PG8_BAR; PG8_SCHED;
            PG8_LDB(B0, 1, 0); PG8_LDB(B1, 1, 1); PG8_SCHED; PG8_LDA(At, 1, 0); PG8_STAGE(PG8_SA(0, 1), a2 + hstep, voffA);
            PG8_WAIT_V(8); PG8_WAIT_L(0); PG8_BAR; PG8_MMA(0, 0, At, B0); PG8_MMA(0, 1, At, B1); PG8_BAR; PG8_SCHED;
            PG8_LDA(At, 1, 1); PG8_STAGE(PG8_SB(1, 0), b3, voffB); PG8_STAGE(PG8_SB(1, 1), b3 + hstep, voffB); PG8_STAGE(PG8_SA(1, 0), a3, voffA);
            PG8_WAIT_V(8); PG8_WAIT_L(0); PG8_BAR; PG8_MMA(1, 0, At, B0); PG8_MMA(1, 1, At, B1); PG8_BAR; PG8_SCHED;
            } else {
            PG8_LDB(B0, 0, 0); PG8_SCHED; PG8_LDA(At, 0, 0); PG8_STAGE(PG8_SA(1, 1), a1 + hstep, voffA);
            PG8_WAIT_L(8); PG8_BAR; PG8_WAIT_L(0); PG8_MMA(0, 0, At, B0); PG8_BAR; PG8_SCHED;
            PG8_LDB(B1, 0, 1); PG8_STAGE(PG8_SB(0, 0), b2, voffB);
            PG8_BAR; PG8_WAIT_L(0); PG8_MMA(0, 1, At, B1); PG8_BAR;
            PG8_LDA(At, 0, 1); PG8_STAGE(PG8_SA(0, 0), a2, voffA);
            PG8_BAR; PG8_WAIT_L(0); PG8_MMA(1, 0, At, B0); PG8_BAR; PG8_SCHED;
            PG8_STAGE(PG8_SB(0, 1), b2 + hstep, voffB);
            PG8_WAIT_V(6); PG8_BAR; PG8_MMA(1, 1, At, B1); PG8_BAR;
            PG8_LDB(B0, 1, 0); PG8_SCHED; PG8_LDA(At, 1, 0); PG8_STAGE(PG8_SA(0, 1), a2 + hstep, voffA);
            PG8_WAIT_L(8); PG8_BAR; PG8_WAIT_L(0); PG8_MMA(0, 0, At, B0); PG8_BAR; PG8_SCHED;
            PG8_LDB(B1, 1, 1); PG8_STAGE(PG8_SB(1, 0), b3, voffB);
            PG8_BAR; PG8_WAIT_L(0); PG8_MMA(0, 1, At, B1); PG8_BAR;
            PG8_LDA(At, 1, 1); PG8_STAGE(PG8_SA(1, 0), a3, voffA);
            PG8_BAR; PG8_WAIT_L(0); PG8_MMA(1, 0, At, B0); PG8_BAR; PG8_SCHED;
            PG8_STAGE(PG8_SB(1, 1), b3 + hstep, voffB);
            PG8_WAIT_V(6); PG8_BAR; PG8_MMA(1, 1, At, B1); PG8_BAR;
            }
        }
        if constexpr (ALIGN_EPI) { if (wr == 0) PG8_BAR; }
        if constexpr (!Epi::AFTER_DRAIN) { E(acc, cur, wr, wc, fr, fq); S.done(cur); }
        if (!has_next) break;
#pragma unroll
        for (int a = 0; a < 2; ++a)
#pragma unroll
            for (int b = 0; b < 2; ++b)
#pragma unroll
                for (int m = 0; m < 4; ++m)
#pragma unroll
                    for (int n = 0; n < 2; ++n) acc[a][b][m][n] = (f32x4){0.f, 0.f, 0.f, 0.f};
        cur = nxt; cA = nA; cB = nB; ++ui;
        if constexpr (ALIGN_EPI) { if (wr == 1) PG8_BAR; }
    }
    PG8_WAIT_V(0);
    if constexpr (!ALIGN_EPI) { if (wr == 0) PG8_BAR; }
    PG8_BAR;
    if constexpr (Epi::AFTER_DRAIN) { E.fused(acc, cur, wr, wc, fr, fq, lds, wid, lane); S.done(cur); }
#undef PG8_SA
#undef PG8_SB
#undef PG8_STAGE
#undef PG8_LDA
#undef PG8_LDB
#undef PG8_MMA
#undef PG8_WAIT_V
#undef PG8_WAIT_L
#undef PG8_BAR
#undef PG8_SCHED
}
}
#define LAS __attribute__((address_space(3)))
typedef unsigned short bf16_t;
typedef short bf16x8 __attribute__((ext_vector_type(8)));
typedef short s16x4 __attribute__((ext_vector_type(4)));
typedef float f32x4 __attribute__((ext_vector_type(4)));
typedef float f32x16 __attribute__((ext_vector_type(16)));
typedef unsigned u32x4 __attribute__((ext_vector_type(4)));
typedef unsigned u32x2 __attribute__((ext_vector_type(2)));

constexpr int DM = 1024, NB = 4, SEQ = 8192, DEPTH = 4, CTXL = 256;
constexpr int ML = NB * SEQ, MC = NB * CTXL, MT = ML + MC;
constexpr int INC = 2816, DFF = 2816, UPC = 5632;
constexpr int NMX_L = NB * 33, NMX_ALL = NB * 33 + NB * 2;
constexpr float LOG2E = 1.4426950408889634f;

constexpr size_t MiB = 1u << 20;
constexpr size_t WS_MOD = 1 * MiB;
constexpr size_t WS_MODP = 2 * MiB;
constexpr size_t WS_TAB = 10 * MiB;
constexpr size_t WS_XC = 11 * MiB;
constexpr size_t WS_W = 16 * MiB;
constexpr size_t W_LAYER = 24 * MiB, W_OUT_OFF = (size_t)2816 * 1024 * 2, W_UP_OFF = W_OUT_OFF + (size_t)1024 * 1024 * 2, W_DN_OFF = W_UP_OFF + (size_t)5632 * 1024 * 2;
constexpr size_t WS_XN = 112 * MiB;
constexpr size_t WS_O = 182 * MiB;
constexpr size_t WS_H = 248 * MiB;
constexpr size_t WS_END = WS_H + (size_t)MT * 2816 * 2;
static_assert(W_DN_OFF + (size_t)1024 * 2816 * 2 <= W_LAYER, "weights per layer");
static_assert(WS_XN + (size_t)NMX_ALL * 256 * 1024 * 2 <= WS_O && WS_O + (size_t)MT * 1024 * 2 <= WS_H && WS_END <= 512 * MiB, "ws map");

constexpr int RING_BYTES = 135168;
constexpr int LDS_BYTES = 147456;

__device__ __forceinline__ unsigned pkbf(float lo, float hi) { unsigned r; asm volatile("v_cvt_pk_bf16_f32 %0, %1, %2" : "=v"(r) : "v"(lo), "v"(hi)); return r; }
__device__ __forceinline__ float bflo(unsigned w) { return __uint_as_float(w << 16); }
__device__ __forceinline__ float bfhi(unsigned w) { return __uint_as_float(w & 0xffff0000u); }
__device__ __forceinline__ float wave_sum(float v, int lane) {
#pragma unroll
    for (int o = 1; o < 64; o <<= 1) v += __int_as_float(__builtin_amdgcn_ds_bpermute((lane ^ o) << 2, __float_as_int(v)));
    return v;
}
__device__ __forceinline__ float xhalf_max(float v) { auto rr = __builtin_amdgcn_permlane32_swap(__float_as_uint(v), __float_as_uint(v), false, false); return fmaxf(__uint_as_float(rr[0]), __uint_as_float(rr[1])); }
__device__ __forceinline__ float xhalf_sum(float v) { auto rr = __builtin_amdgcn_permlane32_swap(__float_as_uint(v), __float_as_uint(v), false, false); return __uint_as_float(rr[0]) + __uint_as_float(rr[1]); }

namespace att {
constexpr int KP = 144, VP = 136;
constexpr int L_KS = 0, L_VT = 64 * KP, L_RPB = L_VT + 64 * VP, L_END = L_RPB + 2048;
__device__ __forceinline__ int crow(int r, int h) { return (r & 3) + 8 * (r >> 2) + 4 * h; }

struct TileRegs { u32x4 k, v; };
__device__ __forceinline__ void tile_gload(TileRegs& R, const bf16_t* H, int krow, int kcol, int vcol, int tid) {
    const int key = tid >> 3, ch = tid & 7;
    const bf16_t* p = H + (size_t)(krow + key) * INC;
    R.k = *(const u32x4*)(p + kcol + 8 * ch); R.v = *(const u32x4*)(p + vcol + 8 * ch);
}
__device__ __forceinline__ void tile_swrite(const TileRegs& R, LAS unsigned char* lds, int tid) {
    const int key = tid >> 3, ch = tid & 7;
    *(LAS u32x4*)(lds + L_KS + key * KP + ch * 16) = R.k;
    LAS unsigned short* vt = (LAS unsigned short*)(lds + L_VT);
#pragma unroll
    for (int j = 0; j < 4; ++j) { const unsigned w = R.v[j]; vt[(8 * ch + 2 * j) * (VP / 2) + key] = (unsigned short)(w & 0xffffu); vt[(8 * ch + 2 * j + 1) * (VP / 2) + key] = (unsigned short)(w >> 16); }
}
template <int KS0, int NKS>
__device__ __forceinline__ f32x16 qk_block(const LAS unsigned char* lds, int kb, int r32, int hh, const bf16x8 (&qf)[4]) {
    f32x16 s = {0.f, 0.f, 0.f, 0.f, 0.f, 0.f, 0.f, 0.f, 0.f, 0.f, 0.f, 0.f, 0.f, 0.f, 0.f, 0.f};
#pragma unroll
    for (int ks = KS0; ks < KS0 + NKS; ++ks) {
        const bf16x8 kf = *(const LAS bf16x8*)(lds + L_KS + (kb * 32 + r32) * KP + ks * 32 + hh * 16);
        s = __builtin_amdgcn_mfma_f32_32x32x16_bf16(kf, qf[ks], s, 0, 0, 0);
    }
    return s;
}
__device__ __forceinline__ void softmax_pv(f32x16 (&s)[2], float& m, float& l, f32x16 (&O)[2], const LAS unsigned char* lds, int r32, int hh) {
    float mx = s[0][0];
#pragma unroll
    for (int r = 1; r < 16; ++r) mx = fmaxf(mx, s[0][r]);
#pragma unroll
    for (int r = 0; r < 16; ++r) mx = fmaxf(mx, s[1][r]);
    mx = xhalf_max(mx);
    __builtin_amdgcn_sched_barrier(0);
    const float mn = fmaxf(m, mx);
    const float alpha = __builtin_amdgcn_exp2f(m - mn);
    m = mn; l *= alpha;
#pragma unroll
    for (int r = 0; r < 16; ++r) { O[0][r] *= alpha; O[1][r] *= alpha; }
    float ps = 0.f;
#pragma unroll
    for (int kb = 0; kb < 2; ++kb)
#pragma unroll
        for (int r = 0; r < 16; ++r) { const float p = __builtin_amdgcn_exp2f(s[kb][r] - mn); s[kb][r] = p; ps += p; }
    l += ps;
    __builtin_amdgcn_sched_barrier(0);
#pragma unroll
    for (int kb = 0; kb < 2; ++kb)
#pragma unroll
        for (int sk = 0; sk < 2; ++sk) {
            __builtin_amdgcn_sched_barrier(0);
            u32x4 pw; pw.x = pkbf(s[kb][8 * sk + 0], s[kb][8 * sk + 1]); pw.y = pkbf(s[kb][8 * sk + 2], s[kb][8 * sk + 3]);
            pw.z = pkbf(s[kb][8 * sk + 4], s[kb][8 * sk + 5]); pw.w = pkbf(s[kb][8 * sk + 6], s[kb][8 * sk + 7]);
            const bf16x8 pf = __builtin_bit_cast(bf16x8, pw);
#pragma unroll
            for (int dvb = 0; dvb < 2; ++dvb) {
                const LAS unsigned char* a = lds + L_VT + (dvb * 32 + r32) * VP + (kb * 32 + 16 * sk + 4 * hh) * 2;
                const s16x4 lo = *(const LAS s16x4*)a, hi = *(const LAS s16x4*)(a + 16);
                const bf16x8 vf = {lo[0], lo[1], lo[2], lo[3], hi[0], hi[1], hi[2], hi[3]};
                O[dvb] = __builtin_amdgcn_mfma_f32_32x32x16_bf16(vf, pf, O[dvb], 0, 0, 0);
            }
        }
}
__device__ __forceinline__ void store_o(const f32x16 (&o)[2], bf16_t* orow, int hh) {
#pragma unroll
    for (int dvb = 0; dvb < 2; ++dvb)
#pragma unroll
        for (int g = 0; g < 4; ++g) {
            u32x2 w; w.x = pkbf(o[dvb][4 * g], o[dvb][4 * g + 1]); w.y = pkbf(o[dvb][4 * g + 2], o[dvb][4 * g + 3]);
            *(u32x2*)(orow + dvb * 32 + 8 * g + 4 * hh) = w;
        }
}

constexpr int A_KP = 144, A_VP = 192, A_VOFF = 64 * A_KP, A_BUF = A_VOFF + 64 * A_VP;
constexpr float ATHR = 10.f;
typedef short v4i16_t __attribute__((ext_vector_type(4)));
__device__ __forceinline__ s16x4 vtr(const LAS unsigned char* p) { return __builtin_bit_cast(s16x4, __builtin_amdgcn_ds_read_tr16_b64_v4i16((LAS v4i16_t*)p)); }
__device__ __forceinline__ void tileA_swrite(const TileRegs& R, LAS unsigned char* buf, int tid) {
    const int key = tid >> 3, ch = tid & 7;
    *(LAS u32x4*)(buf + key * A_KP + ch * 16) = R.k;
    *(LAS u32x4*)(buf + A_VOFF + key * A_VP + ch * 16) = R.v;
}
__device__ __forceinline__ float max16(const f32x16& s) {
    float a = fmaxf(fmaxf(s[0], s[1]), s[2]), b = fmaxf(fmaxf(s[3], s[4]), s[5]), c = fmaxf(fmaxf(s[6], s[7]), s[8]), d = fmaxf(fmaxf(s[9], s[10]), s[11]);
    a = fmaxf(fmaxf(a, s[12]), s[13]); b = fmaxf(fmaxf(b, s[14]), s[15]);
    return fmaxf(fmaxf(a, b), fmaxf(c, d));
}
__device__ __forceinline__ float expsum16(f32x16& s) {
    float a = 0.f, b = 0.f, c = 0.f, d = 0.f;
#pragma unroll
    for (int r = 0; r < 16; r += 4) {
        s[r] = __builtin_amdgcn_exp2f(s[r]); s[r + 1] = __builtin_amdgcn_exp2f(s[r + 1]); s[r + 2] = __builtin_amdgcn_exp2f(s[r + 2]); s[r + 3] = __builtin_amdgcn_exp2f(s[r + 3]);
        a += s[r]; b += s[r + 1]; c += s[r + 2]; d += s[r + 3];
    }
    return (a + b) + (c + d);
}
__device__ __forceinline__ bf16x8 packp(const f32x16& s, int sk) {
    u32x4 pw; pw.x = pkbf(s[8 * sk + 0], s[8 * sk + 1]); pw.y = pkbf(s[8 * sk + 2], s[8 * sk + 3]); pw.z = pkbf(s[8 * sk + 4], s[8 * sk + 5]); pw.w = pkbf(s[8 * sk + 6], s[8 * sk + 7]);
    return __builtin_bit_cast(bf16x8, pw);
}
struct AState { float mref, l; bool have; };
__device__ __forceinline__ void slowA(f32x16 (&S)[2], float mxc, AState& st, f32x16 (&O)[2], bool first) {
    const bool trig = first ? (__any((mxc > ATHR) || (mxc < -ATHR)) != 0) : (__any(mxc - st.mref > ATHR) != 0);
    if (trig) {
        const float dl = first ? mxc : fmaxf(mxc - st.mref, 0.f);
        const float alpha = __builtin_amdgcn_exp2f(-dl);
        st.mref += dl; st.l *= alpha; st.have = true;
#pragma unroll
        for (int r = 0; r < 16; ++r) { O[0][r] *= alpha; O[1][r] *= alpha; }
    }
    if (st.have) {
#pragma unroll
        for (int r = 0; r < 16; ++r) { S[0][r] -= st.mref; S[1][r] -= st.mref; }
    }
}
template <bool CTXQ>
__device__ __forceinline__ void unit_A(LAS unsigned char* lds, const bf16_t* H, bf16_t* Ob, int b, int h, int qb, float lam, float ofac, const float* subw) {
    const int tid = pg8_ltid(), lane = tid & 63, r32 = lane & 31, hh = lane >> 5, wid = tid >> 6;
    const int qrow = CTXQ ? (ML + b * CTXL + wid * 32 + r32) : (b * SEQ + qb * 256 + wid * 32 + r32);
    const int qcol = h * 64, kcol = 256 + h * 64, vcol = 512 + h * 64;
    const int NT = CTXQ ? 4 : 132;
    f32x16 O1[2], O2[2];
#pragma unroll
    for (int r = 0; r < 16; ++r) { O1[0][r] = 0.f; O1[1][r] = 0.f; O2[0][r] = 0.f; O2[1][r] = 0.f; }
    AState st1{0.f, 0.f, false}, st2{0.f, 0.f, false};
    const int voff = A_VOFF + (4 * hh + ((lane & 15) >> 2)) * A_VP + (((lane >> 4) & 1) * 16 + (lane & 3) * 4) * 2;
    const int krow0 = CTXQ ? (ML + b * CTXL) : (b * SEQ);
    LAS unsigned char* qs = lds + 2 * A_BUF + (wid * 32 + r32) * A_KP + hh * 16;
    TileRegs R;
    __syncthreads();
#pragma unroll
    for (int ks = 0; ks < 4; ++ks) *(LAS bf16x8*)(qs + ks * 32) = *(const bf16x8*)(H + (size_t)qrow * INC + qcol + 16 * ks + 8 * hh);
    tile_gload(R, H, krow0, kcol, vcol, tid);
    tileA_swrite(R, lds, tid);
    tile_gload(R, H, krow0 + 64, kcol, vcol, tid);
    __syncthreads();
    for (int t = 0; t < NT; ++t) {
        LAS unsigned char* cur = lds + (t & 1) * A_BUF;
        if (t + 1 < NT) tileA_swrite(R, lds + ((t + 1) & 1) * A_BUF, tid);
        f32x16 S1[2], S2[2];
        {
            const bf16x8 q0 = *(const LAS bf16x8*)(qs), q1 = *(const LAS bf16x8*)(qs + 32), q2 = *(const LAS bf16x8*)(qs + 64), q3 = *(const LAS bf16x8*)(qs + 96);
            const f32x16 z = {0.f, 0.f, 0.f, 0.f, 0.f, 0.f, 0.f, 0.f, 0.f, 0.f, 0.f, 0.f, 0.f, 0.f, 0.f, 0.f};
#pragma unroll
            for (int kb = 0; kb < 2; ++kb) {
                const LAS unsigned char* kp = cur + (kb * 32 + r32) * A_KP + hh * 16;
                const bf16x8 k0 = *(const LAS bf16x8*)(kp), k1 = *(const LAS bf16x8*)(kp + 32), k2 = *(const LAS bf16x8*)(kp + 64), k3 = *(const LAS bf16x8*)(kp + 96);
                S1[kb] = __builtin_amdgcn_mfma_f32_32x32x16_bf16(k0, q0, z, 0, 0, 0);
                S2[kb] = __builtin_amdgcn_mfma_f32_32x32x16_bf16(k2, q2, z, 0, 0, 0);
                S1[kb] = __builtin_amdgcn_mfma_f32_32x32x16_bf16(k1, q1, S1[kb], 0, 0, 0);
                S2[kb] = __builtin_amdgcn_mfma_f32_32x32x16_bf16(k3, q3, S2[kb], 0, 0, 0);
            }
        }
        const float mx1 = xhalf_max(fmaxf(max16(S1[0]), max16(S1[1]))), mx2 = xhalf_max(fmaxf(max16(S2[0]), max16(S2[1])));
        const bool first = (t == 0);
        const bool quiet = first ? (__any((fabsf(mx1) > ATHR) || (fabsf(mx2) > ATHR)) == 0) : (__any((mx1 - st1.mref > ATHR) || (mx2 - st2.mref > ATHR)) == 0);
        if (__builtin_expect(!(quiet && !st1.have && !st2.have), 0)) { slowA(S1, mx1, st1, O1, first); slowA(S2, mx2, st2, O2, first); }
        if (t + 2 < NT) { const int tn = t + 2; const int krow = CTXQ ? (krow0 + 64 * tn) : (tn < 128 ? b * SEQ + 64 * tn : ML + b * CTXL + 64 * (tn - 128)); tile_gload(R, H, krow, kcol, vcol, tid); }
#pragma unroll
        for (int kb = 0; kb < 2; ++kb) {
            st1.l += expsum16(S1[kb]); st2.l += expsum16(S2[kb]);
#pragma unroll
            for (int sk = 0; sk < 2; ++sk) {
                const bf16x8 p1 = packp(S1[kb], sk), p2 = packp(S2[kb], sk);
#pragma unroll
                for (int dvb = 0; dvb < 2; ++dvb) {
                    const LAS unsigned char* a = cur + voff + (kb * 32 + 16 * sk) * A_VP + dvb * 64;
                    const s16x4 lo = vtr(a), hi = vtr(a + 8 * A_VP);
                    const bf16x8 vf = {lo[0], lo[1], lo[2], lo[3], hi[0], hi[1], hi[2], hi[3]};
                    O1[dvb] = __builtin_amdgcn_mfma_f32_32x32x16_bf16(vf, p1, O1[dvb], 0, 0, 0);
                    O2[dvb] = __builtin_amdgcn_mfma_f32_32x32x16_bf16(vf, p2, O2[dvb], 0, 0, 0);
                }
            }
        }
        __syncthreads();
    }
    const float l1 = xhalf_sum(st1.l), l2 = xhalf_sum(st2.l);
    const float i1 = 1.f / l1, i2 = lam / l2;
    float ss = 0.f;
#pragma unroll
    for (int dvb = 0; dvb < 2; ++dvb)
#pragma unroll
        for (int r = 0; r < 16; ++r) { const float o = O1[dvb][r] * i1 - O2[dvb][r] * i2; O1[dvb][r] = o; ss += o * o; }
    ss = xhalf_sum(ss);
    const float rn = rsqrtf(ss * (1.f / 64.f) + 1e-6f) * ofac;
#pragma unroll
    for (int dvb = 0; dvb < 2; ++dvb)
#pragma unroll
        for (int g = 0; g < 4; ++g) {
            const f32x4 w = *(const f32x4*)(subw + dvb * 32 + 8 * g + 4 * hh);
#pragma unroll
            for (int e = 0; e < 4; ++e) O1[dvb][4 * g + e] *= rn * w[e];
        }
    store_o(O1, Ob + (size_t)qrow * DM + h * 64, hh);
}

template <int MODE> __device__ __forceinline__ int tile_row_f(int t, int b, int lo, int nloc) {
    if (MODE == 1) return (t < nloc) ? (b * SEQ + 64 * (lo + t)) : (ML + b * CTXL + 64 * (t - nloc));
    if (MODE == 2) return (t < 4) ? (ML + b * CTXL + 64 * t) : (b * SEQ + 64 * (lo + t - 4));
    return ML + b * CTXL + 64 * t;
}
template <int MODE>
__device__ __forceinline__ void unit_BC(LAS unsigned char* lds, const bf16_t* H, bf16_t* Ob, int b, int hd, int blk, const float* sink_l, const float* rpb_l) {
    const int tid = pg8_ltid(), lane = tid & 63, r32 = lane & 31, hh = lane >> 5, wid = tid >> 6;
    int qrow, qcol, kcol, vcol, ocol, qpos = 0, r_w = 0, qc = 0, lo = 0, nloc = 0;
    float m = -INFINITY, l = 0.f;
    if (MODE == 1) {
        const int g = wid >> 2, head = hd * 2 + g; qpos = 128 * blk + 32 * (wid & 3) + r32; qrow = b * SEQ + qpos;
        qcol = 768 + head * 64; kcol = 1024 + hd * 64; vcol = 1152 + hd * 64; ocol = 256 + head * 64;
        lo = 2 * blk - 2; if (lo < 0) lo = 0; int hi = 2 * blk + 3; if (hi > 127) hi = 127; nloc = hi - lo + 1;
        m = sink_l[head] * LOG2E; l = (hh == 0) ? 1.f : 0.f;
    } else if (MODE == 3) {
        const int head = hd * 2 + blk; qrow = ML + b * CTXL + wid * 32 + r32;
        qcol = 768 + head * 64; kcol = 1024 + hd * 64; vcol = 1152 + hd * 64; ocol = 256 + head * 64;
        m = sink_l[head] * LOG2E; l = (hh == 0) ? 1.f : 0.f;
    } else if (MODE == 2) {
        r_w = 4 * blk + (wid >> 1); qc = 32 * (wid & 1) + r32; qrow = b * SEQ + r_w * 64 + qc;
        qcol = 1280 + hd * 64; kcol = 1536 + hd * 64; vcol = 1792 + hd * 64; ocol = 512 + hd * 64;
        int a0 = 4 * blk - 4; if (a0 < 0) a0 = 0; if (a0 > 120) a0 = 120; int a3 = 4 * blk + 3 - 4; if (a3 < 0) a3 = 0; if (a3 > 120) a3 = 120;
        lo = a0; nloc = a3 + 7 - a0 + 1;
    } else {
        qrow = ML + b * CTXL + wid * 32 + r32;
        qcol = 1280 + hd * 64; kcol = 1536 + hd * 64; vcol = 1792 + hd * 64; ocol = 512 + hd * 64;
    }
    bf16x8 qf[4];
#pragma unroll
    for (int ks = 0; ks < 4; ++ks) qf[ks] = *(const bf16x8*)(H + (size_t)qrow * INC + qcol + 16 * ks + 8 * hh);
    f32x16 O[2];
#pragma unroll
    for (int r = 0; r < 16; ++r) { O[0][r] = 0.f; O[1][r] = 0.f; }
    const int NT = 4 + nloc;
    int rs = 0;
    if (MODE == 2) { rs = r_w - 4; if (rs < 0) rs = 0; if (rs > 120) rs = 120; }
    const LAS float* rpbs = (const LAS float*)(lds + L_RPB);
    TileRegs R;
    tile_gload(R, H, tile_row_f<MODE>(0, b, lo, nloc), kcol, vcol, tid);
    for (int t = 0; t < NT; ++t) {
        __syncthreads();
        tile_swrite(R, lds, tid);
        if (MODE == 2 && t == 0) { for (int i = tid; i < 465; i += 512) ((LAS float*)(lds + L_RPB))[i] = rpb_l[hd * 465 + i] * LOG2E; }
        __syncthreads();
        if (t + 1 < NT) tile_gload(R, H, tile_row_f<MODE>(t + 1, b, lo, nloc), kcol, vcol, tid);
        bool active = true; int kr = 0;
        if (MODE == 2 && t >= 4) { kr = lo + t - 4; active = (kr >= rs) && (kr < rs + 8); }
        if (active) {
            f32x16 s[2]; s[0] = qk_block<0, 4>(lds, 0, r32, hh, qf); s[1] = qk_block<0, 4>(lds, 1, r32, hh, qf);
            if (MODE == 1 && t < nloc) {
                const int kbase = 64 * (lo + t) - qpos;
#pragma unroll
                for (int kb = 0; kb < 2; ++kb)
#pragma unroll
                    for (int r = 0; r < 16; ++r) { const int d = kbase + kb * 32 + crow(r, hh); if (d > 128 || d < -128) s[kb][r] = -INFINITY; }
            }
            if (MODE == 2 && t >= 4) {
                int cs = qc - 8; if (cs < 0) cs = 0; if (cs > 48) cs = 48;
                const int bbase = (kr - r_w + 7) * 31 + 15 - qc;
#pragma unroll
                for (int kb = 0; kb < 2; ++kb)
#pragma unroll
                    for (int r = 0; r < 16; ++r) {
                        const int kc = kb * 32 + crow(r, hh);
                        const bool ok = (kc >= cs) && (kc < cs + 16);
                        int bi = bbase + kc; bi = ok ? bi : 0;
                        const float bias = rpbs[bi];
                        s[kb][r] = ok ? (s[kb][r] + bias) : -INFINITY;
                    }
            }
            softmax_pv(s, m, l, O, lds, r32, hh);
        }
    }
    l = xhalf_sum(l);
    const float il = 1.f / l;
#pragma unroll
    for (int r = 0; r < 16; ++r) { O[0][r] *= il; O[1][r] *= il; }
    store_o(O, Ob + (size_t)qrow * DM + ocol, hh);
}
}
__device__ __forceinline__ float silu_f(float v) { return v / (1.f + __expf(-v)); }

__device__ __forceinline__ int wrow_map(int type, int n) {
    if (type == 1) { if (n < 512) { const int p = n & 31, blk = p >> 3; const int np = (blk == 1) ? p + 8 : ((blk == 2) ? p - 8 : p); return (n & ~31) + np; } return n; }
    if (type == 2) { const int half = (n >= 2816) ? 1 : 0; const int j = n - half * 2816; return (j >> 7) * 256 + half * 128 + (j & 127); }
    return n;
}
__device__ __forceinline__ void transpose_item(const float* W, int K, int N, bf16_t* WT, int type, LAS float* scr, int item, int lane) {
    const int nblk = N / 32, kb = item / nblk, nb = item - kb * nblk, k0 = 64 * kb, n0 = 32 * nb;
#pragma unroll 8
    for (int i = 0; i < 32; ++i) { const int kk = 2 * i + (lane >> 5); scr[kk * 33 + (lane & 31)] = W[(size_t)(k0 + kk) * N + n0 + (lane & 31)]; }
    asm volatile("s_waitcnt lgkmcnt(0)" ::: "memory");
    const int c = lane & 7;
#pragma unroll
    for (int j = 0; j < 4; ++j) {
        const int n = (lane >> 3) + 8 * j; const LAS float* s = scr + (8 * c) * 33 + n;
        u32x4 o; o.x = pkbf(s[0 * 33], s[1 * 33]); o.y = pkbf(s[2 * 33], s[3 * 33]); o.z = pkbf(s[4 * 33], s[5 * 33]); o.w = pkbf(s[6 * 33], s[7 * 33]);
        *(u32x4*)(WT + (size_t)wrow_map(type, n0 + n) * K + k0 + 8 * c) = o;
    }
    asm volatile("s_waitcnt lgkmcnt(0)" ::: "memory");
}

__device__ __forceinline__ void sincos_f(float x, float& c, float& s) {
    const float k = rintf(x * 0.636619772f);
    float r = fmaf(-k, 1.57079625129699707031f, x); r = fmaf(-k, 7.54978941586159635335e-08f, r);
    const float r2 = r * r;
    const float sr = r * (1.f + r2 * (-1.f / 6 + r2 * (1.f / 120 + r2 * (-1.f / 5040 + r2 * (1.f / 362880)))));
    const float cr = 1.f + r2 * (-0.5f + r2 * (1.f / 24 + r2 * (-1.f / 720 + r2 * (1.f / 40320 + r2 * (-1.f / 3628800)))));
    const int q = ((int)k) & 3;
    s = (q == 0) ? sr : (q == 1) ? cr : (q == 2) ? -sr : -cr;
    c = (q == 0) ? cr : (q == 1) ? -sr : (q == 2) ? -cr : sr;
}

__device__ __forceinline__ void norm_mod_row(const float* src, const float* nw, const float* sh, const float* sc, bf16_t* dst, int lane) {
    u32x2* o8 = (u32x2*)dst + lane;
    if (src == nullptr) {
#pragma unroll
        for (int j = 0; j < 4; ++j) o8[64 * j] = (u32x2){0u, 0u};
        return;
    }
    const f32x4* xr = (const f32x4*)src + lane;
    f32x4 v[4]; float s = 0.f;
#pragma unroll
    for (int j = 0; j < 4; ++j) { v[j] = xr[64 * j]; s += (v[j][0] * v[j][0] + v[j][1] * v[j][1]) + (v[j][2] * v[j][2] + v[j][3] * v[j][3]); }
    const float rstd = rsqrtf(wave_sum(s, lane) * (1.f / 1024.f) + 1e-6f);
#pragma unroll
    for (int j = 0; j < 4; ++j) {
        const int k = 4 * (64 * j + lane);
        const f32x4 w = *(const f32x4*)(nw + k), a = *(const f32x4*)(sc + k), d = *(const f32x4*)(sh + k);
        f32x4 y;
#pragma unroll
        for (int e = 0; e < 4; ++e) y[e] = (v[j][e] * rstd * w[e]) * (1.f + a[e]) + d[e];
        u32x2 p; p.x = pkbf(y[0], y[1]); p.y = pkbf(y[2], y[3]);
        o8[64 * j] = p;
    }
}

#define XB_TMO      128
#define XB_XCNT(j)  (256  + 64 * (j))
#define XB_XSUB(j)  (1280 + 64 * (j))
#define XB_XGEN(j)  (2304 + 64 * (j))
#define XB_TOP      3328
#define XB_TOPGEN   3392
#define XCD_BAR_WORDS 3456
#define XB_SPIN_CAP (1u << 18)

__device__ __forceinline__ unsigned xb_ld(unsigned* p)              { return __hip_atomic_load(p, __ATOMIC_RELAXED, __HIP_MEMORY_SCOPE_AGENT); }
__device__ __forceinline__ unsigned xb_add(unsigned* p, unsigned v) { return __hip_atomic_fetch_add(p, v, __ATOMIC_RELAXED, __HIP_MEMORY_SCOPE_AGENT); }
__device__ __forceinline__ unsigned xb_xcc_id() { return (unsigned)__builtin_amdgcn_s_getreg((3 << 11) | 20) & 0xFu; }
#define XB_SPIN(cond, bar) do { unsigned _sp = 0; while (cond) { __builtin_amdgcn_s_sleep(1); \
    if ((++_sp & 255u) == 0u) { if (xb_ld(&(bar)[XB_TMO])) break; if (_sp > XB_SPIN_CAP) { atomicAdd(&(bar)[XB_TMO], 1u); break; } } } } while (0)

struct XcdBarrier {
    unsigned* bar; unsigned x;
    volatile LAS unsigned* st;
};

__device__ __forceinline__ XcdBarrier xcd_barrier_post(unsigned* bar, volatile LAS unsigned* st) {
    XcdBarrier b; b.bar = bar; b.x = xb_xcc_id(); b.st = st;
    if (threadIdx.x == 0) (void)xb_add(&bar[XB_XCNT(b.x)], 1u);
    return b;
}
__device__ __forceinline__ void xcd_barrier_complete(unsigned* bar, unsigned x, unsigned& nloc, unsigned& nx) {
    const unsigned G = gridDim.x * gridDim.y * gridDim.z;
    unsigned sum, cnt, mine, sp = 0u;
    for (;;) {
        sum = 0u; cnt = 0u; mine = 0u;
#pragma unroll
        for (unsigned j = 0; j < 16; ++j) { const unsigned c = xb_ld(&bar[XB_XCNT(j)]); sum += c; cnt += (c > 0u) ? 1u : 0u; mine = (j == x) ? c : mine; }
        if (sum == G) break;
        __builtin_amdgcn_s_sleep(1);
        if ((++sp & 255u) == 0u) { if (xb_ld(&bar[XB_TMO])) break; if (sp > XB_SPIN_CAP) { atomicAdd(&bar[XB_TMO], 1u); break; } }
    }
    nloc = mine > 0u ? mine : 1u; nx = cnt > 0u ? cnt : 1u;
}

__device__ __forceinline__ void xcd_barrier(const XcdBarrier& b) {
    asm volatile("s_waitcnt vmcnt(0)" ::: "memory");
    __syncthreads();
    if (threadIdx.x == 0) {
        unsigned* bar = b.bar;
        __builtin_amdgcn_s_waitcnt(0);
        unsigned nloc = b.st[0], nx = b.st[1];
        if (nloc == 0u) { xcd_barrier_complete(bar, b.x, nloc, nx); b.st[0] = nloc; b.st[1] = nx; }
        const unsigned old = xb_add(&bar[XB_XSUB(b.x)], 1u);
        const unsigned gen = old / nloc;
        if (old + 1u == (gen + 1u) * nloc) {
            __builtin_amdgcn_fence(__ATOMIC_RELEASE, "agent");
            asm volatile("s_waitcnt vmcnt(0)" ::: "memory");
            const unsigned og = xb_add(&bar[XB_TOP], 1u);
            const unsigned tg = og / nx;
            if (og + 1u == (tg + 1u) * nx) xb_add(&bar[XB_TOPGEN], 1u);
            else XB_SPIN(xb_ld(&bar[XB_TOPGEN]) == tg, bar);
            __builtin_amdgcn_fence(__ATOMIC_ACQUIRE, "agent");
            xb_add(&bar[XB_XGEN(b.x)], 1u);
            asm volatile("s_waitcnt vmcnt(0)" ::: "memory");
        } else {
            XB_SPIN(xb_ld(&bar[XB_XGEN(b.x)]) == gen, bar);
            __builtin_amdgcn_fence(__ATOMIC_ACQUIRE, "agent");
            asm volatile("s_waitcnt vmcnt(0)" ::: "memory");
        }
    }
    __syncthreads();
}

struct Args { const float* in[23]; float* out; unsigned char* ws; int ph_lo, ph_hi, coop, pad; };
typedef const __attribute__((address_space(4))) Args* KArgs;
__device__ __forceinline__ KArgs kargs() { KArgs p = (KArgs)__builtin_amdgcn_kernarg_segment_ptr(); asm volatile("" : "+s"(p)); return p; }
constexpr int N_PHASES = 2 + 7 * DEPTH + 1;

__global__ void __launch_bounds__(512, 2) fwd_kernel(Args a) {
    extern __shared__ __attribute__((aligned(16))) unsigned char lds_raw[];
    LAS unsigned char* lds = (LAS unsigned char*)lds_raw;
    volatile LAS unsigned* bar_st = (volatile LAS unsigned*)(lds + RING_BYTES + 64);
    if (threadIdx.x < 2) bar_st[threadIdx.x] = 0u;
    __syncthreads();
    if (kargs()->coop) (void)xcd_barrier_post((unsigned*)kargs()->ws, bar_st);
    const int ph_lo = kargs()->ph_lo, ph_hi = kargs()->ph_hi;
    for (int ph = ph_lo; ph < ph_hi; ++ph) {
        KArgs ka = kargs();
        const int tid = pg8_ltid(), lane = tid & 63, wave = __builtin_amdgcn_readfirstlane(tid >> 6);
        int G = gridDim.x, bx = blockIdx.x; asm volatile("" : "+s"(G), "+s"(bx));
        const int vcu = (G % 8 == 0) ? (bx % 8) * (G / 8) + bx / 8 : bx;
        const int gw = vcu * 8 + wave, NGW = G * 8;
        unsigned char* ws = ka->ws;
        float* MOD = (float*)(ws + WS_MOD); float* MODP = (float*)(ws + WS_MODP);
        float* tabA = (float*)(ws + WS_TAB); float* tabB = tabA + 128 * 8 * 2;
        float* XC = (float*)(ws + WS_XC);
        bf16_t* XN = (bf16_t*)(ws + WS_XN); bf16_t* Ob = (bf16_t*)(ws + WS_O); bf16_t* Hb = (bf16_t*)(ws + WS_H); bf16_t* ACT = Hb;
        float* XL = ka->out;
        if (ph == 0) {
          for (int rep = 0; rep < REP_P; ++rep) {
            const float* w_mod = ka->in[6]; const float* c_in = ka->in[1]; const float* cctx_in = ka->in[3];
            for (int it = gw; it < 1536; it += NGW) {
                const int ks = it & 15, cgp = (it >> 4) % 24, l = it / 384;
                const int n0 = cgp * 256 + lane * 4;
                f32x4 acc[5];
#pragma unroll
                for (int s = 0; s < 5; ++s) acc[s] = (f32x4){0.f, 0.f, 0.f, 0.f};
                const float* wp = w_mod + ((size_t)l * 1024 + ks * 64) * 6144 + n0;
                for (int kk = 0; kk < 64; ++kk) {
                    const int k = ks * 64 + kk;
                    const f32x4 w = *(const f32x4*)(wp + (size_t)kk * 6144);
#pragma unroll
                    for (int s = 0; s < 4; ++s) acc[s] += silu_f(c_in[s * 1024 + k]) * w;
                    acc[4] += silu_f(cctx_in[k]) * w;
                }
#pragma unroll
                for (int s = 0; s < 5; ++s) *(f32x4*)(MODP + ((size_t)(ks * 4 + l) * 5 + s) * 6144 + n0) = acc[s];
            }
            LAS float* scr = (LAS float*)(lds + wave * 16384);
            for (int it = gw; it < 4 * 6144; it += NGW) {
                const int l = it / 6144; int r = it - l * 6144;
                unsigned char* wl = ws + WS_W + (size_t)l * W_LAYER;
                if (r < 1408) { transpose_item(ka->in[8] + (size_t)l * 1024 * 2816, 1024, 2816, (bf16_t*)wl, 1, scr, r, lane); continue; } r -= 1408;
                if (r < 512) { transpose_item(ka->in[9] + (size_t)l * 1024 * 1024, 1024, 1024, (bf16_t*)(wl + W_OUT_OFF), 0, scr, r, lane); continue; } r -= 512;
                if (r < 2816) { transpose_item(ka->in[18] + (size_t)l * 1024 * 5632, 1024, 5632, (bf16_t*)(wl + W_UP_OFF), 2, scr, r, lane); continue; } r -= 2816;
                transpose_item(ka->in[21] + (size_t)l * 2816 * 1024, 2816, 1024, (bf16_t*)(wl + W_DN_OFF), 0, scr, r, lane);
            }
            for (int idx = vcu * 512 + tid; idx < 3072; idx += G * 512) {
                int pos, i; float e;
                if (idx < 1024) { pos = idx >> 3; i = idx & 7; e = (float)i * 0.125f; } else { const int j = idx - 1024; pos = j >> 4; i = j & 15; e = (float)i * 0.0625f; }
                const float freq = exp2f(-e * 13.287712379549449f);
                const float ang = (float)pos * freq;
                float cc, ss; sincos_f(ang, cc, ss);
                float* tp = (idx < 1024) ? (tabA + idx * 2) : (tabB + (idx - 1024) * 2);
                tp[0] = cc; tp[1] = ss;
            }
          }
        } else if (ph == 1) {
            const float* b_mod = ka->in[7];
            for (int idx = vcu * 512 + tid; idx < 4 * 5 * 6144; idx += G * 512) {
                const int l = idx / 30720, n = idx % 6144;
                float s = b_mod[l * 6144 + n];
#pragma unroll
                for (int ks = 0; ks < 16; ++ks) s += MODP[(size_t)ks * 122880 + idx];
                MOD[idx] = s;
            }
        } else if (ph == N_PHASES - 1) {
            const float* fw = ka->in[22];
            for (int m = gw; m < ML; m += NGW) {
                f32x4* xr = (f32x4*)(XL + (size_t)m * DM) + lane;
                f32x4 v[4]; float s = 0.f;
#pragma unroll
                for (int j = 0; j < 4; ++j) { v[j] = xr[64 * j]; s += (v[j][0] * v[j][0] + v[j][1] * v[j][1]) + (v[j][2] * v[j][2] + v[j][3] * v[j][3]); }
                const float rstd = rsqrtf(wave_sum(s, lane) * (1.f / 1024.f) + 1e-6f);
#pragma unroll
                for (int j = 0; j < 4; ++j) { const f32x4 w = *(const f32x4*)(fw + 4 * (64 * j + lane)); xr[64 * j] = v[j] * rstd * w; }
            }
        } else {
            const int l = (ph - 2) / 7, k = (ph - 2) % 7;
            const bool need_ctx = l < DEPTH - 1;
            const float* modl = MOD + (size_t)l * 5 * 6144;
            unsigned char* wl = ws + WS_W + (size_t)l * W_LAYER;
            const float* srcL = (l == 0) ? ka->in[0] : XL;
            const float* srcC = (l == 0) ? ka->in[2] : XC;
            if (k == 0) {
                const float* nw = ka->in[4] + l * 1024;
                for (int rep = 0; rep < REP_M; ++rep) for (int m = gw; m < MT; m += NGW) {
                    const bool lat = m < ML; const int slot = lat ? (m >> 13) : 4;
                    const float* src = lat ? (srcL + (size_t)m * DM) : (srcC + (size_t)(m - ML) * DM);
                    norm_mod_row(src, nw, modl + slot * 6144, modl + slot * 6144 + 1024, XN + (size_t)m * DM, lane);
                }
            } else if (k == 1) {
                pg8::Gemm g{XN, (const bf16_t*)wl, MT, INC, DM}; pg8::StaticOrder S; S.init(MT, INC, G, bx);
                pg8::EpiInProj E{Hb, tabA, tabB};
#ifndef DIS_IN
                for (int rep = 0; rep < REP_IN; ++rep) pg8::gemm_phase<pg8::EpiInProj, pg8::StaticOrder, true, true>(lds, g, S, E);
#endif
            } else if (k == 2) {
                float lam, ofac;
                {
                    float d1 = 0.f, d2 = 0.f;
                    for (int i = 0; i < 32; ++i) { d1 += ka->in[10][l * 32 + i] * ka->in[11][l * 32 + i]; d2 += ka->in[12][l * 32 + i] * ka->in[13][l * 32 + i]; }
                    const float li = 0.8f - 0.6f * expf(-0.3f * (float)l);
                    lam = expf(d1) - expf(d2) + li; ofac = 1.f - li;
                }
                const float* subw = ka->in[14] + l * 64; const float* sink_l = ka->in[15] + l * 4; const float* rpb_l = ka->in[16] + (size_t)l * 4 * 465;
#ifndef DIS_A
                for (int rep = 0; rep < REP_A; ++rep) for (int u = vcu; u < 512; u += G) att::unit_A<false>(lds, Hb, Ob, u >> 7, (u >> 5) & 3, u & 31, lam, ofac, subw);
#endif
#ifndef DIS_B
                for (int rep = 0; rep < REP_M; ++rep) for (int u = vcu; u < 512; u += G) att::unit_BC<1>(lds, Hb, Ob, u >> 7, (u >> 6) & 1, u & 63, sink_l, rpb_l);
#endif
#ifndef DIS_C
                for (int rep = 0; rep < REP_M; ++rep) for (int u = vcu; u < 512; u += G) att::unit_BC<2>(lds, Hb, Ob, u >> 7, (u >> 5) & 3, u & 31, sink_l, rpb_l);
#endif
#ifndef DIS_CTX
                if (need_ctx) {
                    for (int rep = 0; rep < REP_M; ++rep) for (int u = vcu; u < 48; u += G) {
                        const int kind = u >> 4, bh = u & 15;
                        if (kind == 0) att::unit_A<true>(lds, Hb, Ob, bh >> 2, bh & 3, 0, lam, ofac, subw);
                        else if (kind == 1) att::unit_BC<3>(lds, Hb, Ob, bh >> 2, (bh >> 1) & 1, bh & 1, sink_l, rpb_l);
                        else att::unit_BC<4>(lds, Hb, Ob, bh >> 2, bh & 3, 0, sink_l, rpb_l);
                    }
                }
#endif
                {
                    const float* cwl = ka->in[17] + (size_t)l * 3 * 256;
                    const int rows = need_ctx ? MT : ML;
                    for (int rep = 0; rep < REP_M; ++rep) for (int idx = vcu * 512 + tid; idx < rows * 32; idx += G * 512) {
                        const int row = idx >> 5, c0 = (idx & 31) * 8;
                        int t, len; if (row < ML) { t = row & 8191; len = SEQ; } else { t = (row - ML) & 255; len = CTXL; }
                        const bf16_t* hp = Hb + (size_t)row * INC + 2048 + c0;
                        const u32x4 bg = *(const u32x4*)hp, cg1 = *(const u32x4*)(hp + 256), xi1 = *(const u32x4*)(hp + 512);
                        u32x4 cg0 = {0u, 0u, 0u, 0u}, xi0 = cg0, cg2 = cg0, xi2 = cg0;
                        if (t > 0) { cg0 = *(const u32x4*)(hp - INC + 256); xi0 = *(const u32x4*)(hp - INC + 512); }
                        if (t < len - 1) { cg2 = *(const u32x4*)(hp + INC + 256); xi2 = *(const u32x4*)(hp + INC + 512); }
                        float w0[8], w1[8], w2[8];
#pragma unroll
                        for (int e = 0; e < 8; ++e) { w0[e] = cwl[c0 + e]; w1[e] = cwl[256 + c0 + e]; w2[e] = cwl[512 + c0 + e]; }
                        u32x4 ow;
#pragma unroll
                        for (int e = 0; e < 4; ++e) {
                            const float ylo = w0[2 * e] * bflo(cg0[e]) * bflo(xi0[e]) + w1[2 * e] * bflo(cg1[e]) * bflo(xi1[e]) + w2[2 * e] * bflo(cg2[e]) * bflo(xi2[e]);
                            const float yhi = w0[2 * e + 1] * bfhi(cg0[e]) * bfhi(xi0[e]) + w1[2 * e + 1] * bfhi(cg1[e]) * bfhi(xi1[e]) + w2[2 * e + 1] * bfhi(cg2[e]) * bfhi(xi2[e]);
                            ow[e] = pkbf(bflo(bg[e]) * ylo, bfhi(bg[e]) * yhi);
                        }
                        *(u32x4*)(Ob + (size_t)row * DM + 768 + c0) = ow;
                    }
                }
                __syncthreads();
            } else if (k == 4) {
                const float* nw = ka->in[5] + l * 1024;
                const int nrows = (need_ctx ? NMX_ALL : NMX_L) * 256;
                for (int rep = 0; rep < REP_M; ++rep) for (int e = gw; e < nrows; e += NGW) {
                    const int pm = e >> 8, j = e & 255;
                    int t, slot; const float* base; int len;
                    if (pm < NMX_L) { const int s = pm / 33, ti = pm - s * 33; t = 254 * ti - 1 + j; len = SEQ; slot = s; base = XL + (size_t)s * SEQ * DM; }
                    else { const int q = pm - NMX_L; const int s = q >> 1, ti = q & 1; t = 254 * ti - 1 + j; len = CTXL; slot = 4; base = XC + (size_t)s * CTXL * DM; }
                    const float* src = (t >= 0 && t < len) ? (base + (size_t)t * DM) : nullptr;
                    norm_mod_row(src, nw, modl + slot * 6144 + 3072, modl + slot * 6144 + 4096, XN + (size_t)e * DM, lane);
                }
            } else if (k == 5) {
                const int nM = need_ctx ? NMX_ALL : NMX_L;
                pg8::Gemm g{XN, (const bf16_t*)(wl + W_UP_OFF), nM * 256, UPC, DM}; pg8::StaticOrder S; S.init(nM * 256, UPC, G, bx);
                pg8::EpiUpConv E{ACT, ka->in[19] + (size_t)l * 3 * UPC, ka->in[20] + (size_t)l * UPC};
                pg8::OneUnit one;
#ifndef DIS_UP
                for (int rep = 0; rep < REP_UP; ++rep) for (int i = 0; S.next(i, one.u); ++i) pg8::gemm_phase<pg8::EpiUpConv, pg8::OneUnit, false, true>(lds, g, one, E);
#endif
            } else {
                const int M = need_ctx ? MT : ML; const bool isout = (k == 3);
                pg8::Gemm g{isout ? (const bf16_t*)Ob : (const bf16_t*)ACT, (const bf16_t*)(wl + (isout ? W_OUT_OFF : W_DN_OFF)), M, DM, isout ? DM : DFF}; pg8::StaticOrder S; S.init(M, DM, G, bx);
                pg8::EpiRes E{isout ? srcL : (const float*)XL, isout ? srcC : (const float*)XC, XL, XC, modl, isout ? 2048 : 5120};
#ifndef DIS_OUT
#if REP_OD > 1
                { pg8::EpiRes E2 = E; E2.outL = isout ? (float*)Hb : (float*)XN; E2.outC = E2.outL + (size_t)ML * DM; pg8::gemm_phase<pg8::EpiRes, pg8::StaticOrder, true, true>(lds, g, S, E2); }
#endif
                pg8::gemm_phase<pg8::EpiRes, pg8::StaticOrder, true, true>(lds, g, S, E);
#endif
            }
        }
        if (ph + 1 < ph_hi && kargs()->coop) {
            if (ph == 0) cg::this_grid().sync();
            else { XcdBarrier b; b.bar = (unsigned*)kargs()->ws; b.x = xb_xcc_id(); b.st = bar_st; xcd_barrier(b); }
        }
    }
}

extern "C" void kernel_launch(void* const* d_in, const int* in_sizes, int n_in, void* d_out, int out_size, void* d_ws, size_t ws_size, hipStream_t stream) {
    static int grid = 0;
    if (grid == 0) {
        if (n_in != 23 || out_size != ML * DM || ws_size < WS_END) { fprintf(stderr, "kernel_launch: unexpected shapes (n_in %d out %d ws %zu need %zu)\n", n_in, out_size, ws_size, (size_t)WS_END); grid = -1; return; }
        int dev = 0, cus = 0, per_cu = 0;
        if (hipGetDevice(&dev) != hipSuccess || hipDeviceGetAttribute(&cus, hipDeviceAttributeMultiprocessorCount, dev) != hipSuccess) { grid = -1; return; }
        if (hipFuncSetAttribute((const void*)fwd_kernel, hipFuncAttributeMaxDynamicSharedMemorySize, LDS_BYTES) != hipSuccess) { fprintf(stderr, "kernel_launch: hipFuncSetAttribute failed\n"); grid = -1; return; }
        if (hipOccupancyMaxActiveBlocksPerMultiprocessor(&per_cu, (const void*)fwd_kernel, 512, LDS_BYTES) != hipSuccess || per_cu < 1) fprintf(stderr, "kernel_launch: occupancy query says %d\n", per_cu);
        (void)hipGetLastError();
        grid = cus;
    }
    if (grid < 0) return;
    Args a{};
    for (int i = 0; i < 23; ++i) a.in[i] = (const float*)d_in[i];
    a.out = (float*)d_out; a.ws = (unsigned char*)d_ws;
#if MK_MULTI
    for (int ph = 0; ph < N_PHASES; ++ph) {
        a.ph_lo = ph; a.ph_hi = ph + 1; a.coop = 0;
        hipLaunchKernelGGL(fwd_kernel, dim3(grid), dim3(512), LDS_BYTES, stream, a);
    }
#else
    a.ph_lo = 0; a.ph_hi = N_PHASES; a.coop = 1;
    if (hipMemsetAsync(d_ws, 0, 16384, stream) != hipSuccess) { fprintf(stderr, "kernel_launch: memset failed\n"); return; }
    void* args[] = {&a};
    hipError_t e = hipLaunchCooperativeKernel((const void*)fwd_kernel, dim3(grid), dim3(512), args, LDS_BYTES, stream);
    if (e != hipSuccess) fprintf(stderr, "cooperative launch failed: %s (grid %d)\n", hipGetErrorString(e), grid);
#endif
}
```

```cpp
#include <hip/hip_runtime.h>
#include <hip/hip_cooperative_groups.h>
#include <cstdio>
#include <cstdint>
namespace cg = cooperative_groups;

#ifndef MK_MULTI
#define MK_MULTI 0
#endif

#ifndef REP_IN
#define REP_IN 1
#endif
#ifndef REP_UP
#define REP_UP 1
#endif
#ifndef REP_A
#define REP_A 1
#endif
#ifndef REP_OD
#define REP_OD 1
#endif
#ifndef REP_P
#define REP_P 1
#endif
#ifndef REP_M
#define REP_M 1
#endif

__device__ __forceinline__ int pg8_ltid() { int t = threadIdx.x; asm volatile("" : "+v"(t)); return t; }
namespace pg8 {
#define PG8_LAS __attribute__((address_space(3)))
typedef unsigned short bf16_t;
typedef short bf16x8 __attribute__((ext_vector_type(8)));
typedef float f32x4 __attribute__((ext_vector_type(4)));
typedef unsigned u32x4 __attribute__((ext_vector_type(4)));
constexpr int BM = 256, BK = 64, HALF = 128, HTB = HALF * BK * 2  , STAGE_BYTES = 8 * HTB, NXCD = 8, WGM = 8;

__host__ __device__ __forceinline__ int lds_byte(int r, int c) { const int st = (r >> 4) * 2 + (c >> 5), rr = r & 15, cc = c & 31, ob = rr * 64 + cc * 2; return st * 1024 + (ob ^ (((ob >> 9) & 1) << 5)); }
__host__ __device__ __forceinline__ void stage_rc(int b, int& R, int& C) { const int st = b / 1024, sb = b % 1024, swz = sb ^ (((sb >> 9) & 1) << 5); R = (st >> 1) * 16 + swz / 64; C = (st & 1) * 32 + (swz % 64) / 2; }
__host__ __device__ __forceinline__ int perm32(int rho) { const int n = rho >> 4, i = rho & 15; return 8 * (i >> 2) + 4 * n + (i & 3); }

struct Unit { int pm, pn; };
struct Gemm { const bf16_t* A; const bf16_t* Bt; int M, N, K, ldk; };

struct StaticOrder {
    int nM, nN, nwg, G, c;
    __host__ __device__ void init(int M, int N, int G_, int c_) { nM = M / BM; nN = N / BM; nwg = nM * nN; G = G_; c = c_; }
    __host__ __device__ bool next(int i, Unit& u) const {
        const long L = (long)i * G + c; if (L >= nwg) return false;
        int wgid = (int)L; { const int q = nwg / NXCD, r = nwg % NXCD, xcd = wgid % NXCD, off = wgid / NXCD; wgid = (xcd < r ? xcd * (q + 1) : r * (q + 1) + (xcd - r) * q) + off; }
        const int nig = WGM * nN, gid = wgid / nig, fm = gid * WGM, gsz = (nM - fm) < WGM ? (nM - fm) : WGM;
        u.pm = fm + ((wgid % nig) % gsz); u.pn = (wgid % nig) / gsz; return true;
    }
    __device__ __forceinline__ void a_ready(const Unit&) const {}
    __device__ __forceinline__ void done(const Unit&) const {}
};

__device__ __forceinline__ unsigned cvt_pk_bf16(float lo, float hi) { unsigned r; asm volatile("v_cvt_pk_bf16_f32 %0, %1, %2" : "=v"(r) : "v"(lo), "v"(hi)); return r; }
typedef unsigned u32x2 __attribute__((ext_vector_type(2)));

struct OneUnit {
    Unit u;
    __device__ __forceinline__ bool next(int i, Unit& o) const { if (i != 0) return false; o = u; return true; }
    __device__ __forceinline__ void a_ready(const Unit&) const {}
    __device__ __forceinline__ void done(const Unit&) const {}
};

struct EpiInProj {
    static constexpr bool PERM = false, AFTER_DRAIN = false;
    bf16_t* H; const float* tabA; const float* tabB;
    __device__ __forceinline__ void operator()(const f32x4 (&acc)[2][2][4][2], const Unit& u, int wr, int wc, int fr, int fq) const {
        const int pn = u.pn; const bool latent = u.pm < 128;
        const float scale = (pn == 0) ? 0.17677669529663687f * 1.4426950408889634f : ((pn == 3 || pn == 5) ? 0.125f * 1.4426950408889634f : 1.0f);
#pragma unroll
        for (int bj = 0; bj < 2; ++bj) {
            int mode = (pn == 0 || pn == 1) ? 1 : ((pn == 3 || (pn == 4 && bj == 0)) ? 2 : 0);
            if (!latent) mode = 0;
#ifdef TEST_NOROPE
            mode = 0;
#endif
#pragma unroll
            for (int ai = 0; ai < 2; ++ai)
#pragma unroll
                for (int m = 0; m < 4; ++m) {
                    const int r = u.pm * BM + ai * HALF + wr * 64 + m * 16 + fr;
                    f32x4 v0 = acc[ai][bj][m][0], v1 = acc[ai][bj][m][1];
                    if (mode != 0) {
                        const int t = r & 8191, trow = t >> 6, tcol = t & 63;
                        const float* tp;
                        if (mode == 1) { const int pos = (fq < 2) ? trow : tcol; tp = tabA + (pos * 8 + 4 * (fq & 1)) * 2; }
                        else { const int pos = (wc & 1) ? tcol : trow; tp = tabB + (pos * 16 + 4 * fq) * 2; }
                        const f32x4 cs0 = *(const f32x4*)tp, cs1 = *(const f32x4*)(tp + 4);
                        const float c0 = cs0[0], s0 = cs0[1], c1 = cs0[2], s1 = cs0[3], c2 = cs1[0], s2 = cs1[1], c3 = cs1[2], s3 = cs1[3];
                        f32x4 a = v0, b = v1;
                        v0[0] = a[0] * c0 - b[0] * s0; v1[0] = b[0] * c0 + a[0] * s0;
                        v0[1] = a[1] * c1 - b[1] * s1; v1[1] = b[1] * c1 + a[1] * s1;
                        v0[2] = a[2] * c2 - b[2] * s2; v1[2] = b[2] * c2 + a[2] * s2;
                        v0[3] = a[3] * c3 - b[3] * s3; v1[3] = b[3] * c3 + a[3] * s3;
                    }
                    v0 = v0 * scale; v1 = v1 * scale;
                    bf16_t* rowp = H + (size_t)r * 2816 + pn * BM + bj * HALF + wc * 32 + 4 * fq;
                    u32x2 w0, w1; w0.x = cvt_pk_bf16(v0[0], v0[1]); w0.y = cvt_pk_bf16(v0[2], v0[3]); w1.x = cvt_pk_bf16(v1[0], v1[1]); w1.y = cvt_pk_bf16(v1[2], v1[3]);
                    *(u32x2*)rowp = w0; *(u32x2*)(rowp + 16) = w1;
                }
        }
    }
};

struct EpiRes {
    static constexpr bool PERM = false, AFTER_DRAIN = false;
    const float* baseL; const float* baseC; float* outL; float* outC; const float* modl; int goff;
    __device__ __forceinline__ void operator()(const f32x4 (&acc)[2][2][4][2], const Unit& u, int wr, int wc, int fr, int fq) const {
        const bool ctx = u.pm >= 128; const int slot = ctx ? 4 : (u.pm >> 5);
        const int row0 = (ctx ? (u.pm - 128) : u.pm) * BM + wr * 64 + fr;
        const float* bp = ctx ? baseC : baseL; float* op = ctx ? outC : outL;
        const int col0 = u.pn * BM + wc * 32 + 4 * fq;
        f32x4 gv[2][2];
#pragma unroll
        for (int bj = 0; bj < 2; ++bj)
#pragma unroll
            for (int n = 0; n < 2; ++n) gv[bj][n] = *(const f32x4*)(modl + slot * 6144 + goff + col0 + bj * HALF + n * 16);
#pragma unroll
        for (int ai = 0; ai < 2; ++ai)
#pragma unroll
            for (int m = 0; m < 4; ++m) {
                const size_t off = (size_t)(row0 + ai * HALF + m * 16) * 1024 + col0;
#pragma unroll
                for (int bj = 0; bj < 2; ++bj)
#pragma unroll
                    for (int n = 0; n < 2; ++n) {
                        const f32x4 bs = *(const f32x4*)(bp + off + bj * HALF + n * 16);
                        *(f32x4*)(op + off + bj * HALF + n * 16) = bs + gv[bj][n] * acc[ai][bj][m][n];
                    }
                asm volatile("" ::: "memory");
            }
    }
};

struct EpiSlab {
    static constexpr bool PERM = false, AFTER_DRAIN = false;
    float* slab; const float* gate;
    __device__ __forceinline__ void operator()(const f32x4 (&acc)[2][2][4][2], const Unit& u, int wr, int wc, int fr, int fq) const {
        const int row0 = u.pm * BM + wr * 64 + fr, col0 = u.pn * BM + wc * 32 + 4 * fq;
#pragma unroll
        for (int bj = 0; bj < 2; ++bj)
#pragma unroll
            for (int n = 0; n < 2; ++n) {
                const f32x4 gv = *(const f32x4*)(gate + col0 + bj * HALF + n * 16);
#pragma unroll
                for (int ai = 0; ai < 2; ++ai)
#pragma unroll
                    for (int m = 0; m < 4; ++m)
                        *(f32x4*)(slab + (size_t)(row0 + ai * HALF + m * 16) * 1024 + col0 + bj * HALF + n * 16) = gv * acc[ai][bj][m][n];
            }
    }
};

struct EpiUpConv {
    static constexpr bool PERM = false, AFTER_DRAIN = true;
    bf16_t* ACT; const float* cw; const float* cb;
    static constexpr int TP = 520;
    __device__ __forceinline__ void fused(f32x4 (&acc)[2][2][4][2], const Unit& u, int wr, int wc, int fr, int fq, PG8_LAS unsigned char* lds, int wid, int lane) const {
#pragma unroll
        for (int ai = 0; ai < 2; ++ai)
#pragma unroll
            for (int m = 0; m < 4; ++m) {
                const int row = ai * HALF + wr * 64 + m * 16 + fr;
#pragma unroll
                for (int bj = 0; bj < 2; ++bj)
#pragma unroll
                    for (int n = 0; n < 2; ++n) {
                        const f32x4 v = acc[ai][bj][m][n]; u32x2 w; w.x = cvt_pk_bf16(v[0], v[1]); w.y = cvt_pk_bf16(v[2], v[3]);
                        *(PG8_LAS u32x2*)(lds + row * TP + (bj * HALF + wc * 32 + n * 16 + 4 * fq) * 2) = w;
                    }
            }
        const int tid = wid * 64 + lane, ch = tid & 15;
        const int gcol = u.pn * 128 + ch * 8;
        float wg[3][8], wv[3][8], bg[8], bv[8];
#pragma unroll
        for (int k = 0; k < 3; ++k) {
            const f32x4 a0 = *(const f32x4*)(cw + k * 5632 + gcol), a1 = *(const f32x4*)(cw + k * 5632 + gcol + 4);
            const f32x4 b0 = *(const f32x4*)(cw + k * 5632 + 2816 + gcol), b1 = *(const f32x4*)(cw + k * 5632 + 2816 + gcol + 4);
#pragma unroll
            for (int e = 0; e < 4; ++e) { wg[k][e] = a0[e]; wg[k][4 + e] = a1[e]; wv[k][e] = b0[e]; wv[k][4 + e] = b1[e]; }
        }
        {
            const f32x4 a0 = *(const f32x4*)(cb + gcol), a1 = *(const f32x4*)(cb + gcol + 4), b0 = *(const f32x4*)(cb + 2816 + gcol), b1 = *(const f32x4*)(cb + 2816 + gcol + 4);
#pragma unroll
            for (int e = 0; e < 4; ++e) { bg[e] = a0[e]; bg[4 + e] = a1[e]; bv[e] = b0[e]; bv[4 + e] = b1[e]; }
        }
        int seqlen, rowbase, ti;
        if (u.pm < 132) { const int s = u.pm / 33; ti = u.pm - s * 33; seqlen = 8192; rowbase = s * 8192; }
        else { const int q = u.pm - 132; const int s = q >> 1; ti = q & 1; seqlen = 256; rowbase = 32768 + s * 256; }
        asm volatile("s_waitcnt lgkmcnt(0)" ::: "memory"); __builtin_amdgcn_s_barrier(); asm volatile("" ::: "memory");
        for (int it = tid; it < 254 * 16; it += 512) {
            const int j = 1 + (it >> 4); const int t = 254 * ti - 1 + j;
            if (t < seqlen) {
                float g[8], v[8];
#pragma unroll
                for (int e = 0; e < 8; ++e) { g[e] = bg[e]; v[e] = bv[e]; }
#pragma unroll
                for (int k = 0; k < 3; ++k) {
                    const PG8_LAS unsigned char* rp = lds + (j - 1 + k) * TP + ch * 16;
                    const u32x2 g0 = *(const PG8_LAS u32x2*)rp, g1 = *(const PG8_LAS u32x2*)(rp + 8);
                    const u32x2 v0 = *(const PG8_LAS u32x2*)(rp + 256), v1 = *(const PG8_LAS u32x2*)(rp + 264);
                    const unsigned gw[4] = {g0.x, g0.y, g1.x, g1.y}, vw[4] = {v0.x, v0.y, v1.x, v1.y};
#pragma unroll
                    for (int e = 0; e < 4; ++e) {
                        g[2 * e] += wg[k][2 * e] * __uint_as_float(gw[e] << 16); g[2 * e + 1] += wg[k][2 * e + 1] * __uint_as_float(gw[e] & 0xffff0000u);
                        v[2 * e] += wv[k][2 * e] * __uint_as_float(vw[e] << 16); v[2 * e + 1] += wv[k][2 * e + 1] * __uint_as_float(vw[e] & 0xffff0000u);
                    }
                }
                float o[8];
#pragma unroll
                for (int e = 0; e < 8; ++e) o[e] = g[e] / (1.f + __expf(-g[e])) * v[e];
                u32x4 w; w.x = cvt_pk_bf16(o[0], o[1]); w.y = cvt_pk_bf16(o[2], o[3]); w.z = cvt_pk_bf16(o[4], o[5]); w.w = cvt_pk_bf16(o[6], o[7]);
                *(u32x4*)(ACT + (size_t)(rowbase + t) * 2816 + gcol) = w;
            }
        }
        asm volatile("s_waitcnt lgkmcnt(0)" ::: "memory"); __builtin_amdgcn_s_barrier(); asm volatile("" ::: "memory");
    }
};
template <class Epi, class Sched, bool ALIGN_EPI = false, bool SP2 = false>
__device__ __forceinline__ void gemm_phase(PG8_LAS unsigned char* lds, const Gemm g, const Sched& S, const Epi& E) {
    const int tid = pg8_ltid(), wid = __builtin_amdgcn_readfirstlane(tid >> 6), lane = tid & 63, wr = wid >> 2, wc = wid & 3, fr = lane & 15, fq = lane >> 4;
    const int K = g.ldk, nt = g.K / BK;
    unsigned voffA[2], voffB[2];
#pragma unroll
    for (int i = 0; i < 2; ++i) { int R, C; stage_rc(tid * 16 + i * 8192, R, C); const int Rb = Epi::PERM ? ((R & ~31) + perm32(R & 31)) : R;
        voffA[i] = (unsigned)(R * K + C) * 2u; voffB[i] = (unsigned)(Rb * K + C) * 2u; }
    const size_t kstep = (size_t)(BK * 2);
    const size_t hstep = (size_t)HALF * K * 2;
    const size_t tstep = 2 * hstep;
    const unsigned ldsw = (unsigned)wid * 1024u;
    const int aoff = lds_byte(wr * 64 + fr, fq * 8), boff = lds_byte(wc * 32 + fr, fq * 8);
#define PG8_SA(b, h) (((b) * 2 + (h)) * HTB)
#define PG8_SB(b, h) ((4 + (b) * 2 + (h)) * HTB)
#define PG8_STAGE(bufoff, gbase, voff) do { _Pragma("unroll") for (int _i = 0; _i < 2; ++_i) \
        __builtin_amdgcn_global_load_lds((const unsigned*)((const char*)(gbase) + (voff)[_i]), (PG8_LAS unsigned*)(lds + (bufoff) + ldsw + _i * 8192), 16, 0, 0); } while (0)
#define PG8_LDA(dst, b, h) do { _Pragma("unroll") for (int m = 0; m < 4; ++m) _Pragma("unroll") for (int k = 0; k < 2; ++k) dst[m][k] = *(const PG8_LAS bf16x8*)(lds + PG8_SA(b, h) + aoff + m * 2048 + k * 1024); } while (0)
#define PG8_LDB(dst, b, h) do { _Pragma("unroll") for (int n = 0; n < 2; ++n) _Pragma("unroll") for (int k = 0; k < 2; ++k) dst[n][k] = *(const PG8_LAS bf16x8*)(lds + PG8_SB(b, h) + boff + n * 2048 + k * 1024); } while (0)
#define PG8_MMA(ai, bj, At, Bt) do { __builtin_amdgcn_s_setprio(1); _Pragma("unroll") for (int m = 0; m < 4; ++m) _Pragma("unroll") for (int n = 0; n < 2; ++n) _Pragma("unroll") for (int k = 0; k < 2; ++k) \
        acc[ai][bj][m][n] = __builtin_amdgcn_mfma_f32_16x16x32_bf16(Bt[n][k], At[m][k], acc[ai][bj][m][n], 0, 0, 0); __builtin_amdgcn_s_setprio(0); } while (0)
#define PG8_WAIT_V(n) asm volatile("s_waitcnt vmcnt(" #n ")" ::: "memory")
#define PG8_WAIT_L(n) asm volatile("s_waitcnt lgkmcnt(" #n ")" ::: "memory")
#define PG8_BAR __builtin_amdgcn_s_barrier()
#define PG8_SCHED __builtin_amdgcn_sched_barrier(0)
    Unit cur, nxt; int ui = 0;
    if (!S.next(0, cur)) return;
    f32x4 acc[2][2][4][2];
#pragma unroll
    for (int a = 0; a < 2; ++a)
#pragma unroll
        for (int b = 0; b < 2; ++b)
#pragma unroll
            for (int m = 0; m < 4; ++m)
#pragma unroll
                for (int n = 0; n < 2; ++n) acc[a][b][m][n] = (f32x4){0.f, 0.f, 0.f, 0.f};
    bf16x8 At[4][2], B0[2][2], B1[2][2];
    const char* cA = (const char*)g.A + (size_t)cur.pm * tstep; const char* cB = (const char*)g.Bt + (size_t)cur.pn * tstep;
    S.a_ready(cur);
    if constexpr (SP2) {
        PG8_STAGE(PG8_SB(0, 0), cB, voffB); PG8_STAGE(PG8_SB(0, 1), cB + hstep, voffB); PG8_STAGE(PG8_SA(0, 0), cA, voffA); PG8_STAGE(PG8_SA(0, 1), cA + hstep, voffA);
        if (wr == 1) PG8_BAR;
        PG8_WAIT_V(2); PG8_BAR;
        PG8_STAGE(PG8_SB(1, 0), cB + kstep, voffB); PG8_STAGE(PG8_SA(1, 0), cA + kstep, voffA); PG8_STAGE(PG8_SB(1, 1), cB + hstep + kstep, voffB);
        PG8_WAIT_V(6); PG8_BAR;
    } else {
        PG8_STAGE(PG8_SB(0, 0), cB, voffB); PG8_STAGE(PG8_SA(0, 0), cA, voffA); PG8_STAGE(PG8_SB(0, 1), cB + hstep, voffB); PG8_STAGE(PG8_SA(0, 1), cA + hstep, voffA);
        if (wr == 1) PG8_BAR;
        PG8_WAIT_V(4); PG8_BAR;
        PG8_STAGE(PG8_SB(1, 0), cB + kstep, voffB); PG8_STAGE(PG8_SA(1, 0), cA + kstep, voffA); PG8_STAGE(PG8_SB(1, 1), cB + hstep + kstep, voffB);
        PG8_WAIT_V(6); PG8_BAR;
    }
    for (;;) {
        const bool has_next = S.next(ui + 1, nxt);
        const char* nA = has_next ? (const char*)g.A + (size_t)nxt.pm * tstep : cA; const char* nB = has_next ? (const char*)g.Bt + (size_t)nxt.pn * tstep : cB;
        for (int t = 0; t < nt; t += 2) {
            const bool last = (t == nt - 2);
            const char* a1 = cA + (size_t)(t + 1) * kstep;
            const char* a2 = last ? nA : cA + (size_t)(t + 2) * kstep; const char* b2 = last ? nB : cB + (size_t)(t + 2) * kstep;
            const char* a3 = a2 + kstep; const char* b3 = b2 + kstep;
            if (last && has_next) S.a_ready(nxt);
            if constexpr (SP2) {
            PG8_LDB(B0, 0, 0); PG8_LDB(B1, 0, 1); PG8_SCHED; PG8_LDA(At, 0, 0); PG8_STAGE(PG8_SA(1, 1), a1 + hstep, voffA);
            PG8_WAIT_V(8); PG8_WAIT_L(0); PG8_BAR; PG8_MMA(0, 0, At, B0); PG8_MMA(0, 1, At, B1); PG8_BAR; PG8_SCHED;
            PG8_LDA(At, 0, 1); PG8_STAGE(PG8_SB(0, 0), b2, voffB); PG8_STAGE(PG8_SB(0, 1), b2 + hstep, voffB); PG8_STAGE(PG8_SA(0, 0), a2, voffA);
            PG8_WAIT_V(8); PG8_WAIT_L(0); PG8_BAR; PG8_MMA(1, 0, At, B0); PG8_MMA(1, 1, At, B1); PG8_BAR; PG8_SCHED;
            PG8_LDB(B0, 1, 0); PG8_LDB(B1, 1, 1); PG8_SCHED; PG8_LDA(At, 1, 0); PG8_STAGE(PG8_SA(0, 1), a2 + hstep, voffA);
            PG8_WAIT_V(8); PG8_WAIT_L(0); PG8_BAR; PG8_MMA(0, 0, At, B0); PG8_MMA(0, 1, At, B1); PG8_BAR; PG8_SCHED;
            PG8_LDA(At, 1, 1); PG8_STAGE(PG8_SB(1, 0), b3, voffB); PG8_STAGE(PG8_SB(1, 1), b3 + hstep, voffB); PG8_STAGE(PG8_SA(1, 0), a3, voffA);
            PG8_WAIT_V(8); PG8_WAIT_L(0); PG8_BAR; PG8_MMA(1, 0, At, B0); PG8_MMA(1, 1, At, B1); PG8_BAR; PG8_SCHED;
            } else {
            PG8_LDB(B0, 0, 0); PG8_SCHED; PG8_LDA(At, 0, 0); PG8_STAGE(PG8_SA(1, 1), a1 + hstep, voffA);
            PG8_WAIT_L(8); PG8_BAR; PG8_WAIT_L(0); PG8_MMA(0, 0, At, B0); PG8_BAR; PG8_SCHED;
            PG8_LDB(B1, 0, 1); PG8_STAGE(PG8_SB(0, 0), b2, voffB);
            PG8_BAR; PG8_WAIT_L(0); PG8_MMA(0, 1, At, B1); PG8_BAR;
            PG8_LDA(At, 0, 1); PG8_STAGE(PG8_SA(0, 0), a2, voffA);
            PG8_BAR; PG8_WAIT_L(0); PG8_MMA(1, 0, At, B0); PG8_BAR; PG8_SCHED;
            PG8_STAGE(PG8_SB(0, 1), b2 + hstep, voffB);
            PG8_WAIT_V(6); PG8_BAR; PG8_MMA(1, 1, At, B1); PG8_BAR;
            PG8_LDB(B0, 1, 0); PG8_SCHED; PG8_LDA(At, 1, 0); PG8_STAGE(PG8_SA(0, 1), a2 + hstep, voffA);
            PG8_WAIT_L(8); PG8_BAR; PG8_WAIT_L(0); PG8_MMA(0, 0, At, B0); PG8_BAR; PG8_SCHED;
            PG8_LDB(B1, 1, 1); PG8_STAGE(PG8_SB(1, 0), b3, voffB);
            PG8_BAR; PG8_WAIT_L(0); PG8_MMA(0, 1, At, B1); PG8_BAR;
            PG8_LDA(At, 1, 1); PG8_STAGE(PG8_SA(1, 0), a3, voffA);
            PG8_BAR; PG8_WAIT_L(0); PG8_MMA(1, 0, At, B0); PG8_BAR; PG8_SCHED;
            PG8_STAGE(PG8_SB(1, 1), b3 + hstep, voffB);
            PG8_WAIT_V(6); PG8_BAR; PG8_MMA(1, 1, At, B1); PG8_BAR;
            }
        }
        if constexpr (ALIGN_EPI) { if (wr == 0) PG8_BAR; }
        if constexpr (!Epi::AFTER_DRAIN) { E(acc, cur, wr, wc, fr, fq); S.done(cur); }
        if (!has_next) break;
#pragma unroll
        for (int a = 0; a < 2; ++a)
#pragma unroll
            for (int b = 0; b < 2; ++b)
#pragma unroll
                for (int m = 0; m < 4; ++m)
#pragma unroll
                    for (int n = 0; n < 2; ++n) acc[a][b][m][n] = (f32x4){0.f, 0.f, 0.f, 0.f};
        cur = nxt; cA = nA; cB = nB; ++ui;
        if constexpr (ALIGN_EPI) { if (wr == 1) PG8_BAR; }
    }
    PG8_WAIT_V(0);
    if constexpr (!ALIGN_EPI) { if (wr == 0) PG8_BAR; }
    PG8_BAR;
    if constexpr (Epi::AFTER_DRAIN) { E.fused(acc, cur, wr, wc, fr, fq, lds, wid, lane); S.done(cur); }
#undef PG8_SA
#undef PG8_SB
#undef PG8_STAGE
#undef PG8_LDA
#undef PG8_LDB
#undef PG8_MMA
#undef PG8_WAIT_V
#undef PG8_WAIT_L
#undef PG8_BAR
#undef PG8_SCHED
}
}
#define LAS __attribute__((address_space(3)))
typedef unsigned short bf16_t;
typedef short bf16x8 __attribute__((ext_vector_type(8)));
typedef short s16x4 __attribute__((ext_vector_type(4)));
typedef float f32x4 __attribute__((ext_vector_type(4)));
typedef float f32x16 __attribute__((ext_vector_type(16)));
typedef unsigned u32x4 __attribute__((ext_vector_type(4)));
typedef unsigned u32x2 __attribute__((ext_vector_type(2)));

constexpr int DM = 1024, NB = 4, SEQ = 8192, DEPTH = 4, CTXL = 256;
constexpr int ML = NB * SEQ, MC = NB * CTXL, MT = ML + MC;
constexpr int INC = 2816, DFF = 2816, UPC = 5632;
constexpr int NMX_L = NB * 33, NMX_ALL = NB * 33 + NB * 2;
constexpr float LOG2E = 1.4426950408889634f;

constexpr size_t MiB = 1u << 20;
constexpr size_t WS_MOD = 1 * MiB;
constexpr size_t WS_MODP = 2 * MiB;
constexpr size_t WS_TAB = 10 * MiB;
constexpr size_t WS_XC = 11 * MiB;
constexpr size_t WS_W = 16 * MiB;
constexpr size_t W_LAYER = 24 * MiB, W_OUT_OFF = (size_t)2816 * 1024 * 2, W_UP_OFF = W_OUT_OFF + (size_t)1024 * 1024 * 2, W_DN_OFF = W_UP_OFF + (size_t)5632 * 1024 * 2;
constexpr size_t WS_XN = 112 * MiB;
constexpr size_t WS_O = 182 * MiB;
constexpr size_t WS_H = 248 * MiB;
constexpr size_t WS_END = WS_H + (size_t)MT * 2816 * 2;
static_assert(W_DN_OFF + (size_t)1024 * 2816 * 2 <= W_LAYER, "weights per layer");
static_assert(WS_XN + (size_t)NMX_ALL * 256 * 1024 * 2 <= WS_O && WS_O + (size_t)MT * 1024 * 2 <= WS_H && WS_END <= 512 * MiB, "ws map");

constexpr int RING_BYTES = 135168;
constexpr int LDS_BYTES = 147456;

__device__ __forceinline__ unsigned pkbf(float lo, float hi) { unsigned r; asm volatile("v_cvt_pk_bf16_f32 %0, %1, %2" : "=v"(r) : "v"(lo), "v"(hi)); return r; }
__device__ __forceinline__ float bflo(unsigned w) { return __uint_as_float(w << 16); }
__device__ __forceinline__ float bfhi(unsigned w) { return __uint_as_float(w & 0xffff0000u); }
__device__ __forceinline__ float wave_sum(float v, int lane) {
#pragma unroll
    for (int o = 1; o < 64; o <<= 1) v += __int_as_float(__builtin_amdgcn_ds_bpermute((lane ^ o) << 2, __float_as_int(v)));
    return v;
}
__device__ __forceinline__ float xhalf_max(float v) { auto rr = __builtin_amdgcn_permlane32_swap(__float_as_uint(v), __float_as_uint(v), false, false); return fmaxf(__uint_as_float(rr[0]), __uint_as_float(rr[1])); }
__device__ __forceinline__ float xhalf_sum(float v) { auto rr = __builtin_amdgcn_permlane32_swap(__float_as_uint(v), __float_as_uint(v), false, false); return __uint_as_float(rr[0]) + __uint_as_float(rr[1]); }

namespace att {
constexpr int KP = 144, VP = 136;
constexpr int L_KS = 0, L_VT = 64 * KP, L_RPB = L_VT + 64 * VP, L_END = L_RPB + 2048;
__device__ __forceinline__ int crow(int r, int h) { return (r & 3) + 8 * (r >> 2) + 4 * h; }

struct TileRegs { u32x4 k, v; };
__device__ __forceinline__ void tile_gload(TileRegs& R, const bf16_t* H, int krow, int kcol, int vcol, int tid) {
    const int key = tid >> 3, ch = tid & 7;
    const bf16_t* p = H + (size_t)(krow + key) * INC;
    R.k = *(const u32x4*)(p + kcol + 8 * ch); R.v = *(const u32x4*)(p + vcol + 8 * ch);
}
__device__ __forceinline__ void tile_swrite(const TileRegs& R, LAS unsigned char* lds, int tid) {
    const int key = tid >> 3, ch = tid & 7;
    *(LAS u32x4*)(lds + L_KS + key * KP + ch * 16) = R.k;
    LAS unsigned short* vt = (LAS unsigned short*)(lds + L_VT);
#pragma unroll
    for (int j = 0; j < 4; ++j) { const unsigned w = R.v[j]; vt[(8 * ch + 2 * j) * (VP / 2) + key] = (unsigned short)(w & 0xffffu); vt[(8 * ch + 2 * j + 1) * (VP / 2) + key] = (unsigned short)(w >> 16); }
}
template <int KS0, int NKS>
__device__ __forceinline__ f32x16 qk_block(const LAS unsigned char* lds, int kb, int r32, int hh, const bf16x8 (&qf)[4]) {
    f32x16 s = {0.f, 0.f, 0.f, 0.f, 0.f, 0.f, 0.f, 0.f, 0.f, 0.f, 0.f, 0.f, 0.f, 0.f, 0.f, 0.f};
#pragma unroll
    for (int ks = KS0; ks < KS0 + NKS; ++ks) {
        const bf16x8 kf = *(const LAS bf16x8*)(lds + L_KS + (kb * 32 + r32) * KP + ks * 32 + hh * 16);
        s = __builtin_amdgcn_mfma_f32_32x32x16_bf16(kf, qf[ks], s, 0, 0, 0);
    }
    return s;
}
__device__ __forceinline__ void softmax_pv(f32x16 (&s)[2], float& m, float& l, f32x16 (&O)[2], const LAS unsigned char* lds, int r32, int hh) {
    float mx = s[0][0];
#pragma unroll
    for (int r = 1; r < 16; ++r) mx = fmaxf(mx, s[0][r]);
#pragma unroll
    for (int r = 0; r < 16; ++r) mx = fmaxf(mx, s[1][r]);
    mx = xhalf_max(mx);
    __builtin_amdgcn_sched_barrier(0);
    const float mn = fmaxf(m, mx);
    const float alpha = __builtin_amdgcn_exp2f(m - mn);
    m = mn; l *= alpha;
#pragma unroll
    for (int r = 0; r < 16; ++r) { O[0][r] *= alpha; O[1][r] *= alpha; }
    float ps = 0.f;
#pragma unroll
    for (int kb = 0; kb < 2; ++kb)
#pragma unroll
        for (int r = 0; r < 16; ++r) { const float p = __builtin_amdgcn_exp2f(s[kb][r] - mn); s[kb][r] = p; ps += p; }
    l += ps;
    __builtin_amdgcn_sched_barrier(0);
#pragma unroll
    for (int kb = 0; kb < 2; ++kb)
#pragma unroll
        for (int sk = 0; sk < 2; ++sk) {
            __builtin_amdgcn_sched_barrier(0);
            u32x4 pw; pw.x = pkbf(s[kb][8 * sk + 0], s[kb][8 * sk + 1]); pw.y = pkbf(s[kb][8 * sk + 2], s[kb][8 * sk + 3]);
            pw.z = pkbf(s[kb][8 * sk + 4], s[kb][8 * sk + 5]); pw.w = pkbf(s[kb][8 * sk + 6], s[kb][8 * sk + 7]);
            const bf16x8 pf = __builtin_bit_cast(bf16x8, pw);
#pragma unroll
            for (int dvb = 0; dvb < 2; ++dvb) {
                const LAS unsigned char* a = lds + L_VT + (dvb * 32 + r32) * VP + (kb * 32 + 16 * sk + 4 * hh) * 2;
                const s16x4 lo = *(const LAS s16x4*)a, hi = *(const LAS s16x4*)(a + 16);
                const bf16x8 vf = {lo[0], lo[1], lo[2], lo[3], hi[0], hi[1], hi[2], hi[3]};
                O[dvb] = __builtin_amdgcn_mfma_f32_32x32x16_bf16(vf, pf, O[dvb], 0, 0, 0);
            }
        }
}
__device__ __forceinline__ void store_o(const f32x16 (&o)[2], bf16_t* orow, int hh) {
#pragma unroll
    for (int dvb = 0; dvb < 2; ++dvb)
#pragma unroll
        for (int g = 0; g < 4; ++g) {
            u32x2 w; w.x = pkbf(o[dvb][4 * g], o[dvb][4 * g + 1]); w.y = pkbf(o[dvb][4 * g + 2], o[dvb][4 * g + 3]);
            *(u32x2*)(orow + dvb * 32 + 8 * g + 4 * hh) = w;
        }
}

constexpr int A_KP = 144, A_VP = 192, A_VOFF = 64 * A_KP, A_BUF = A_VOFF + 64 * A_VP;
constexpr float ATHR = 10.f;
typedef short v4i16_t __attribute__((ext_vector_type(4)));
__device__ __forceinline__ s16x4 vtr(const LAS unsigned char* p) { return __builtin_bit_cast(s16x4, __builtin_amdgcn_ds_read_tr16_b64_v4i16((LAS v4i16_t*)p)); }
__device__ __forceinline__ void tileA_swrite(const TileRegs& R, LAS unsigned char* buf, int tid) {
    const int key = tid >> 3, ch = tid & 7;
    *(LAS u32x4*)(buf + key * A_KP + ch * 16) = R.k;
    *(LAS u32x4*)(buf + A_VOFF + key * A_VP + ch * 16) = R.v;
}
__device__ __forceinline__ float max16(const f32x16& s) {
    float a = fmaxf(fmaxf(s[0], s[1]), s[2]), b = fmaxf(fmaxf(s[3], s[4]), s[5]), c = fmaxf(fmaxf(s[6], s[7]), s[8]), d = fmaxf(fmaxf(s[9], s[10]), s[11]);
    a = fmaxf(fmaxf(a, s[12]), s[13]); b = fmaxf(fmaxf(b, s[14]), s[15]);
    return fmaxf(fmaxf(a, b), fmaxf(c, d));
}
__device__ __forceinline__ float expsum16(f32x16& s) {
    float a = 0.f, b = 0.f, c = 0.f, d = 0.f;
#pragma unroll
    for (int r = 0; r < 16; r += 4) {
        s[r] = __builtin_amdgcn_exp2f(s[r]); s[r + 1] = __builtin_amdgcn_exp2f(s[r + 1]); s[r + 2] = __builtin_amdgcn_exp2f(s[r + 2]); s[r + 3] = __builtin_amdgcn_exp2f(s[r + 3]);
        a += s[r]; b += s[r + 1]; c += s[r + 2]; d += s[r + 3];
    }
    return (a + b) + (c + d);
}
__device__ __forceinline__ bf16x8 packp(const f32x16& s, int sk) {
    u32x4 pw; pw.x = pkbf(s[8 * sk + 0], s[8 * sk + 1]); pw.y = pkbf(s[8 * sk + 2], s[8 * sk + 3]); pw.z = pkbf(s[8 * sk + 4], s[8 * sk + 5]); pw.w = pkbf(s[8 * sk + 6], s[8 * sk + 7]);
    return __builtin_bit_cast(bf16x8, pw);
}
__device__ __forceinline__ void exp16(f32x16& s) {
#pragma unroll
    for (int r = 0; r < 16; ++r) s[r] = __builtin_amdgcn_exp2f(s[r]);
}
constexpr float AREF = 20.f, AGUARD = 60.f;
template <bool CTXQ>
__device__ __forceinline__ void unit_A(LAS unsigned char* lds, const bf16_t* H, bf16_t* Ob, int b, int h, int qb, float lam, float ofac, const float* subw) {
    const int tid = pg8_ltid(), lane = tid & 63, r32 = lane & 31, hh = lane >> 5, wid = tid >> 6;
    const int qrow = CTXQ ? (ML + b * CTXL + wid * 32 + r32) : (b * SEQ + qb * 256 + wid * 32 + r32);
    const int qcol = h * 64, kcol = 256 + h * 64, vcol = 512 + h * 64;
    const int NT = CTXQ ? 4 : 132;
    f32x16 O1[2], O2[2], L1, L2;
#pragma unroll
    for (int r = 0; r < 16; ++r) { O1[0][r] = 0.f; O1[1][r] = 0.f; O2[0][r] = 0.f; O2[1][r] = 0.f; L1[r] = 0.f; L2[r] = 0.f; }
    float mref1 = 0.f, mref2 = 0.f; bool have = false;
    const bf16x8 ones = {0x3F80, 0x3F80, 0x3F80, 0x3F80, 0x3F80, 0x3F80, 0x3F80, 0x3F80};
    const int voff = A_VOFF + (4 * hh + ((lane & 15) >> 2)) * A_VP + (((lane >> 4) & 1) * 16 + (lane & 3) * 4) * 2;
    const int krow0 = CTXQ ? (ML + b * CTXL) : (b * SEQ);
    LAS unsigned char* qs = lds + 2 * A_BUF + (wid * 32 + r32) * A_KP + hh * 16;
    TileRegs R;
    __syncthreads();
#pragma unroll
    for (int ks = 0; ks < 4; ++ks) *(LAS bf16x8*)(qs + ks * 32) = *(const bf16x8*)(H + (size_t)qrow * INC + qcol + 16 * ks + 8 * hh);
    tile_gload(R, H, krow0, kcol, vcol, tid);
    tileA_swrite(R, lds, tid);
    tile_gload(R, H, krow0 + 64, kcol, vcol, tid);
    __syncthreads();
    for (int t = 0; t < NT; ++t) {
        LAS unsigned char* cur = lds + (t & 1) * A_BUF;
        if (t + 1 < NT) tileA_swrite(R, lds + ((t + 1) & 1) * A_BUF, tid);
        if (__builtin_expect(__any((L1[0] > 1.152921504606846976e18f) || (L2[0] > 1.152921504606846976e18f)) != 0, 0)) {
            const float sc = 8.673617379884035e-19f;
#pragma unroll
            for (int r = 0; r < 16; ++r) { O1[0][r] *= sc; O1[1][r] *= sc; O2[0][r] *= sc; O2[1][r] *= sc; L1[r] *= sc; L2[r] *= sc; }
            mref1 += AGUARD; mref2 += AGUARD; have = true;
        }
        f32x16 S1[2], S2[2];
        {
            const bf16x8 q0 = *(const LAS bf16x8*)(qs), q1 = *(const LAS bf16x8*)(qs + 32), q2 = *(const LAS bf16x8*)(qs + 64), q3 = *(const LAS bf16x8*)(qs + 96);
            const f32x16 z = {0.f, 0.f, 0.f, 0.f, 0.f, 0.f, 0.f, 0.f, 0.f, 0.f, 0.f, 0.f, 0.f, 0.f, 0.f, 0.f};
#pragma unroll
            for (int kb = 0; kb < 2; ++kb) {
                const LAS unsigned char* kp = cur + (kb * 32 + r32) * A_KP + hh * 16;
                const bf16x8 k0 = *(const LAS bf16x8*)(kp), k1 = *(const LAS bf16x8*)(kp + 32), k2 = *(const LAS bf16x8*)(kp + 64), k3 = *(const LAS bf16x8*)(kp + 96);
                S1[kb] = __builtin_amdgcn_mfma_f32_32x32x16_bf16(k0, q0, z, 0, 0, 0);
                S2[kb] = __builtin_amdgcn_mfma_f32_32x32x16_bf16(k2, q2, z, 0, 0, 0);
                S1[kb] = __builtin_amdgcn_mfma_f32_32x32x16_bf16(k1, q1, S1[kb], 0, 0, 0);
                S2[kb] = __builtin_amdgcn_mfma_f32_32x32x16_bf16(k3, q3, S2[kb], 0, 0, 0);
            }
        }
        if (t == 0) {
            const float mx1 = xhalf_max(fmaxf(max16(S1[0]), max16(S1[1]))), mx2 = xhalf_max(fmaxf(max16(S2[0]), max16(S2[1])));
            if (__any((fabsf(mx1) > AREF) || (fabsf(mx2) > AREF)) != 0) { mref1 = mx1; mref2 = mx2; have = true; }
        }
        if (__builtin_expect(have, 0)) {
#pragma unroll
            for (int r = 0; r < 16; ++r) { S1[0][r] -= mref1; S1[1][r] -= mref1; S2[0][r] -= mref2; S2[1][r] -= mref2; }
        }
        if (t + 2 < NT) { const int tn = t + 2; const int krow = CTXQ ? (krow0 + 64 * tn) : (tn < 128 ? b * SEQ + 64 * tn : ML + b * CTXL + 64 * (tn - 128)); tile_gload(R, H, krow, kcol, vcol, tid); }
#pragma unroll
        for (int kb = 0; kb < 2; ++kb) {
            exp16(S1[kb]); exp16(S2[kb]);
#pragma unroll
            for (int sk = 0; sk < 2; ++sk) {
                const bf16x8 p1 = packp(S1[kb], sk), p2 = packp(S2[kb], sk);
                L1 = __builtin_amdgcn_mfma_f32_32x32x16_bf16(ones, p1, L1, 0, 0, 0);
                L2 = __builtin_amdgcn_mfma_f32_32x32x16_bf16(ones, p2, L2, 0, 0, 0);
#pragma unroll
                for (int dvb = 0; dvb < 2; ++dvb) {
                    const LAS unsigned char* a = cur + voff + (kb * 32 + 16 * sk) * A_VP + dvb * 64;
                    const s16x4 lo = vtr(a), hi = vtr(a + 8 * A_VP);
                    const bf16x8 vf = {lo[0], lo[1], lo[2], lo[3], hi[0], hi[1], hi[2], hi[3]};
                    O1[dvb] = __builtin_amdgcn_mfma_f32_32x32x16_bf16(vf, p1, O1[dvb], 0, 0, 0);
                    O2[dvb] = __builtin_amdgcn_mfma_f32_32x32x16_bf16(vf, p2, O2[dvb], 0, 0, 0);
                }
            }
        }
        __syncthreads();
    }
    const float i1 = 1.f / L1[0], i2 = lam / L2[0];
    float ss = 0.f;
#pragma unroll
    for (int dvb = 0; dvb < 2; ++dvb)
#pragma unroll
        for (int r = 0; r < 16; ++r) { const float o = O1[dvb][r] * i1 - O2[dvb][r] * i2; O1[dvb][r] = o; ss += o * o; }
    ss = xhalf_sum(ss);
    const float rn = rsqrtf(ss * (1.f / 64.f) + 1e-6f) * ofac;
#pragma unroll
    for (int dvb = 0; dvb < 2; ++dvb)
#pragma unroll
        for (int g = 0; g < 4; ++g) {
            const f32x4 w = *(const f32x4*)(subw + dvb * 32 + 8 * g + 4 * hh);
#pragma unroll
            for (int e = 0; e < 4; ++e) O1[dvb][4 * g + e] *= rn * w[e];
        }
    store_o(O1, Ob + (size_t)qrow * DM + h * 64, hh);
}

template <int MODE> __device__ __forceinline__ int tile_row_f(int t, int b, int lo, int nloc) {
    if (MODE == 1) return (t < nloc) ? (b * SEQ + 64 * (lo + t)) : (ML + b * CTXL + 64 * (t - nloc));
    if (MODE == 2) return (t < 4) ? (ML + b * CTXL + 64 * t) : (b * SEQ + 64 * (lo + t - 4));
    return ML + b * CTXL + 64 * t;
}
template <int MODE>
__device__ __forceinline__ void unit_BC(LAS unsigned char* lds, const bf16_t* H, bf16_t* Ob, int b, int hd, int blk, const float* sink_l, const float* rpb_l) {
    const int tid = pg8_ltid(), lane = tid & 63, r32 = lane & 31, hh = lane >> 5, wid = tid >> 6;
    int qrow, qcol, kcol, vcol, ocol, qpos = 0, r_w = 0, qc = 0, lo = 0, nloc = 0;
    float m = -INFINITY, l = 0.f;
    if (MODE == 1) {
        const int g = wid >> 2, head = hd * 2 + g; qpos = 128 * blk + 32 * (wid & 3) + r32; qrow = b * SEQ + qpos;
        qcol = 768 + head * 64; kcol = 1024 + hd * 64; vcol = 1152 + hd * 64; ocol = 256 + head * 64;
        lo = 2 * blk - 2; if (lo < 0) lo = 0; int hi = 2 * blk + 3; if (hi > 127) hi = 127; nloc = hi - lo + 1;
        m = sink_l[head] * LOG2E; l = (hh == 0) ? 1.f : 0.f;
    } else if (MODE == 3) {
        const int head = hd * 2 + blk; qrow = ML + b * CTXL + wid * 32 + r32;
        qcol = 768 + head * 64; kcol = 1024 + hd * 64; vcol = 1152 + hd * 64; ocol = 256 + head * 64;
        m = sink_l[head] * LOG2E; l = (hh == 0) ? 1.f : 0.f;
    } else if (MODE == 2) {
        r_w = 4 * blk + (wid >> 1); qc = 32 * (wid & 1) + r32; qrow = b * SEQ + r_w * 64 + qc;
        qcol = 1280 + hd * 64; kcol = 1536 + hd * 64; vcol = 1792 + hd * 64; ocol = 512 + hd * 64;
        int a0 = 4 * blk - 4; if (a0 < 0) a0 = 0; if (a0 > 120) a0 = 120; int a3 = 4 * blk + 3 - 4; if (a3 < 0) a3 = 0; if (a3 > 120) a3 = 120;
        lo = a0; nloc = a3 + 7 - a0 + 1;
    } else {
        qrow = ML + b * CTXL + wid * 32 + r32;
        qcol = 1280 + hd * 64; kcol = 1536 + hd * 64; vcol = 1792 + hd * 64; ocol = 512 + hd * 64;
    }
    bf16x8 qf[4];
#pragma unroll
    for (int ks = 0; ks < 4; ++ks) qf[ks] = *(const bf16x8*)(H + (size_t)qrow * INC + qcol + 16 * ks + 8 * hh);
    f32x16 O[2];
#pragma unroll
    for (int r = 0; r < 16; ++r) { O[0][r] = 0.f; O[1][r] = 0.f; }
    const int NT = 4 + nloc;
    int rs = 0;
    if (MODE == 2) { rs = r_w - 4; if (rs < 0) rs = 0; if (rs > 120) rs = 120; }
    const LAS float* rpbs = (const LAS float*)(lds + L_RPB);
    TileRegs R;
    tile_gload(R, H, tile_row_f<MODE>(0, b, lo, nloc), kcol, vcol, tid);
    for (int t = 0; t < NT; ++t) {
        __syncthreads();
        tile_swrite(R, lds, tid);
        if (MODE == 2 && t == 0) { for (int i = tid; i < 465; i += 512) ((LAS float*)(lds + L_RPB))[i] = rpb_l[hd * 465 + i] * LOG2E; }
        __syncthreads();
        if (t + 1 < NT) tile_gload(R, H, tile_row_f<MODE>(t + 1, b, lo, nloc), kcol, vcol, tid);
        bool active = true; int kr = 0;
        if (MODE == 2 && t >= 4) { kr = lo + t - 4; active = (kr >= rs) && (kr < rs + 8); }
        if (active) {
            f32x16 s[2]; s[0] = qk_block<0, 4>(lds, 0, r32, hh, qf); s[1] = qk_block<0, 4>(lds, 1, r32, hh, qf);
            if (MODE == 1 && t < nloc) {
                const int kbase = 64 * (lo + t) - qpos;
#pragma unroll
                for (int kb = 0; kb < 2; ++kb)
#pragma unroll
                    for (int r = 0; r < 16; ++r) { const int d = kbase + kb * 32 + crow(r, hh); if (d > 128 || d < -128) s[kb][r] = -INFINITY; }
            }
            if (MODE == 2 && t >= 4) {
                int cs = qc - 8; if (cs < 0) cs = 0; if (cs > 48) cs = 48;
                const int bbase = (kr - r_w + 7) * 31 + 15 - qc;
#pragma unroll
                for (int kb = 0; kb < 2; ++kb)
#pragma unroll
                    for (int r = 0; r < 16; ++r) {
                        const int kc = kb * 32 + crow(r, hh);
                        const bool ok = (kc >= cs) && (kc < cs + 16);
                        int bi = bbase + kc; bi = ok ? bi : 0;
                        const float bias = rpbs[bi];
                        s[kb][r] = ok ? (s[kb][r] + bias) : -INFINITY;
                    }
            }
            softmax_pv(s, m, l, O, lds, r32, hh);
        }
    }
    l = xhalf_sum(l);
    const float il = 1.f / l;
#pragma unroll
    for (int r = 0; r < 16; ++r) { O[0][r] *= il; O[1][r] *= il; }
    store_o(O, Ob + (size_t)qrow * DM + ocol, hh);
}
}
__device__ __forceinline__ float silu_f(float v) { return v / (1.f + __expf(-v)); }

__device__ __forceinline__ int wrow_map(int type, int n) {
    if (type == 1) { if (n < 512) { const int p = n & 31, blk = p >> 3; const int np = (blk == 1) ? p + 8 : ((blk == 2) ? p - 8 : p); return (n & ~31) + np; } return n; }
    if (type == 2) { const int half = (n >= 2816) ? 1 : 0; const int j = n - half * 2816; return (j >> 7) * 256 + half * 128 + (j & 127); }
    return n;
}
__device__ __forceinline__ void transpose_item(const float* W, int K, int N, bf16_t* WT, int type, LAS float* scr, int item, int lane) {
    const int nblk = N / 32, kb = item / nblk, nb = item - kb * nblk, k0 = 64 * kb, n0 = 32 * nb;
#pragma unroll 8
    for (int i = 0; i < 32; ++i) { const int kk = 2 * i + (lane >> 5); scr[kk * 33 + (lane & 31)] = W[(size_t)(k0 + kk) * N + n0 + (lane & 31)]; }
    asm volatile("s_waitcnt lgkmcnt(0)" ::: "memory");
    const int c = lane & 7;
#pragma unroll
    for (int j = 0; j < 4; ++j) {
        const int n = (lane >> 3) + 8 * j; const LAS float* s = scr + (8 * c) * 33 + n;
        u32x4 o; o.x = pkbf(s[0 * 33], s[1 * 33]); o.y = pkbf(s[2 * 33], s[3 * 33]); o.z = pkbf(s[4 * 33], s[5 * 33]); o.w = pkbf(s[6 * 33], s[7 * 33]);
        *(u32x4*)(WT + (size_t)wrow_map(type, n0 + n) * K + k0 + 8 * c) = o;
    }
    asm volatile("s_waitcnt lgkmcnt(0)" ::: "memory");
}

__device__ __forceinline__ void sincos_f(float x, float& c, float& s) {
    const float k = rintf(x * 0.636619772f);
    float r = fmaf(-k, 1.57079625129699707031f, x); r = fmaf(-k, 7.54978941586159635335e-08f, r);
    const float r2 = r * r;
    const float sr = r * (1.f + r2 * (-1.f / 6 + r2 * (1.f / 120 + r2 * (-1.f / 5040 + r2 * (1.f / 362880)))));
    const float cr = 1.f + r2 * (-0.5f + r2 * (1.f / 24 + r2 * (-1.f / 720 + r2 * (1.f / 40320 + r2 * (-1.f / 3628800)))));
    const int q = ((int)k) & 3;
    s = (q == 0) ? sr : (q == 1) ? cr : (q == 2) ? -sr : -cr;
    c = (q == 0) ? cr : (q == 1) ? -sr : (q == 2) ? -cr : sr;
}

__device__ __forceinline__ void norm_mod_row(const float* src, const float* nw, const float* sh, const float* sc, bf16_t* dst, int lane, const float* slab = nullptr, int nslab = 0, float* xout = nullptr) {
    u32x2* o8 = (u32x2*)dst + lane;
    if (src == nullptr) {
#pragma unroll
        for (int j = 0; j < 4; ++j) o8[64 * j] = (u32x2){0u, 0u};
        return;
    }
    const f32x4* xr = (const f32x4*)src + lane;
    f32x4 v[4]; float s = 0.f;
#pragma unroll
    for (int j = 0; j < 4; ++j) v[j] = xr[64 * j];
    for (int p = 0; p < nslab; ++p) {
        const f32x4* sr = (const f32x4*)(slab + (size_t)p * 1024 * 1024) + lane;
#pragma unroll
        for (int j = 0; j < 4; ++j) v[j] += sr[64 * j];
    }
    if (xout != nullptr) {
#pragma unroll
        for (int j = 0; j < 4; ++j) ((f32x4*)xout + lane)[64 * j] = v[j];
    }
#pragma unroll
    for (int j = 0; j < 4; ++j) s += (v[j][0] * v[j][0] + v[j][1] * v[j][1]) + (v[j][2] * v[j][2] + v[j][3] * v[j][3]);
    const float rstd = rsqrtf(wave_sum(s, lane) * (1.f / 1024.f) + 1e-6f);
#pragma unroll
    for (int j = 0; j < 4; ++j) {
        const int k = 4 * (64 * j + lane);
        const f32x4 w = *(const f32x4*)(nw + k), a = *(const f32x4*)(sc + k), d = *(const f32x4*)(sh + k);
        f32x4 y;
#pragma unroll
        for (int e = 0; e < 4; ++e) y[e] = (v[j][e] * rstd * w[e]) * (1.f + a[e]) + d[e];
        u32x2 p; p.x = pkbf(y[0], y[1]); p.y = pkbf(y[2], y[3]);
        o8[64 * j] = p;
    }
}

#define XB_TMO      128
#define XB_XCNT(j)  (256  + 64 * (j))
#define XB_XSUB(j)  (1280 + 64 * (j))
#define XB_XGEN(j)  (2304 + 64 * (j))
#define XB_TOP      3328
#define XB_TOPGEN   3392
#define XCD_BAR_WORDS 3456
#define XB_SPIN_CAP (1u << 18)

__device__ __forceinline__ unsigned xb_ld(unsigned* p)              { return __hip_atomic_load(p, __ATOMIC_RELAXED, __HIP_MEMORY_SCOPE_AGENT); }
__device__ __forceinline__ unsigned xb_add(unsigned* p, unsigned v) { return __hip_atomic_fetch_add(p, v, __ATOMIC_RELAXED, __HIP_MEMORY_SCOPE_AGENT); }
__device__ __forceinline__ unsigned xb_xcc_id() { return (unsigned)__builtin_amdgcn_s_getreg((3 << 11) | 20) & 0xFu; }
#define XB_SPIN(cond, bar) do { unsigned _sp = 0; while (cond) { __builtin_amdgcn_s_sleep(1); \
    if ((++_sp & 255u) == 0u) { if (xb_ld(&(bar)[XB_TMO])) break; if (_sp > XB_SPIN_CAP) { atomicAdd(&(bar)[XB_TMO], 1u); break; } } } } while (0)

struct XcdBarrier {
    unsigned* bar; unsigned x;
    volatile LAS unsigned* st;
};

__device__ __forceinline__ XcdBarrier xcd_barrier_post(unsigned* bar, volatile LAS unsigned* st) {
    XcdBarrier b; b.bar = bar; b.x = xb_xcc_id(); b.st = st;
    if (threadIdx.x == 0) (void)xb_add(&bar[XB_XCNT(b.x)], 1u);
    return b;
}
__device__ __forceinline__ void xcd_barrier_complete(unsigned* bar, unsigned x, unsigned& nloc, unsigned& nx) {
    const unsigned G = gridDim.x * gridDim.y * gridDim.z;
    unsigned sum, cnt, mine, sp = 0u;
    for (;;) {
        sum = 0u; cnt = 0u; mine = 0u;
#pragma unroll
        for (unsigned j = 0; j < 16; ++j) { const unsigned c = xb_ld(&bar[XB_XCNT(j)]); sum += c; cnt += (c > 0u) ? 1u : 0u; mine = (j == x) ? c : mine; }
        if (sum == G) break;
        __builtin_amdgcn_s_sleep(1);
        if ((++sp & 255u) == 0u) { if (xb_ld(&bar[XB_TMO])) break; if (sp > XB_SPIN_CAP) { atomicAdd(&bar[XB_TMO], 1u); break; } }
    }
    nloc = mine > 0u ? mine : 1u; nx = cnt > 0u ? cnt : 1u;
}

__device__ __forceinline__ void xcd_barrier(const XcdBarrier& b) {
    asm volatile("s_waitcnt vmcnt(0)" ::: "memory");
    __syncthreads();
    if (threadIdx.x == 0) {
        unsigned* bar = b.bar;
        __builtin_amdgcn_s_waitcnt(0);
        unsigned nloc = b.st[0], nx = b.st[1];
        if (nloc == 0u) { xcd_barrier_complete(bar, b.x, nloc, nx); b.st[0] = nloc; b.st[1] = nx; }
        const unsigned old = xb_add(&bar[XB_XSUB(b.x)], 1u);
        const unsigned gen = old / nloc;
        if (old + 1u == (gen + 1u) * nloc) {
            __builtin_amdgcn_fence(__ATOMIC_RELEASE, "agent");
            asm volatile("s_waitcnt vmcnt(0)" ::: "memory");
            const unsigned og = xb_add(&bar[XB_TOP], 1u);
            const unsigned tg = og / nx;
            if (og + 1u == (tg + 1u) * nx) xb_add(&bar[XB_TOPGEN], 1u);
            else XB_SPIN(xb_ld(&bar[XB_TOPGEN]) == tg, bar);
            __builtin_amdgcn_fence(__ATOMIC_ACQUIRE, "agent");
            xb_add(&bar[XB_XGEN(b.x)], 1u);
            asm volatile("s_waitcnt vmcnt(0)" ::: "memory");
        } else {
            XB_SPIN(xb_ld(&bar[XB_XGEN(b.x)]) == gen, bar);
            __builtin_amdgcn_fence(__ATOMIC_ACQUIRE, "agent");
            asm volatile("s_waitcnt vmcnt(0)" ::: "memory");
        }
    }
    __syncthreads();
}

struct Args { const float* in[23]; float* out; unsigned char* ws; int ph_lo, ph_hi, coop, pad; };
typedef const __attribute__((address_space(4))) Args* KArgs;
__device__ __forceinline__ KArgs kargs() { KArgs p = (KArgs)__builtin_amdgcn_kernarg_segment_ptr(); asm volatile("" : "+s"(p)); return p; }
constexpr int N_PHASES = 2 + 7 * DEPTH + 1;

__global__ void __launch_bounds__(512, 2) fwd_kernel(Args a) {
    extern __shared__ __attribute__((aligned(16))) unsigned char lds_raw[];
    LAS unsigned char* lds = (LAS unsigned char*)lds_raw;
    volatile LAS unsigned* bar_st = (volatile LAS unsigned*)(lds + RING_BYTES + 64);
    if (threadIdx.x < 2) bar_st[threadIdx.x] = 0u;
    __syncthreads();
    if (kargs()->coop) (void)xcd_barrier_post((unsigned*)kargs()->ws, bar_st);
    const int ph_lo = kargs()->ph_lo, ph_hi = kargs()->ph_hi;
    for (int ph = ph_lo; ph < ph_hi; ++ph) {
        KArgs ka = kargs();
        const int tid = pg8_ltid(), lane = tid & 63, wave = __builtin_amdgcn_readfirstlane(tid >> 6);
        int G = gridDim.x, bx = blockIdx.x; asm volatile("" : "+s"(G), "+s"(bx));
        const int vcu = (G % 8 == 0) ? (bx % 8) * (G / 8) + bx / 8 : bx;
        const int gw = vcu * 8 + wave, NGW = G * 8;
        unsigned char* ws = ka->ws;
        float* MOD = (float*)(ws + WS_MOD); float* MODP = (float*)(ws + WS_MODP);
        float* tabA = (float*)(ws + WS_TAB); float* tabB = tabA + 128 * 8 * 2;
        float* XCA = (float*)(ws + WS_XC); float* XCB = (float*)(ws + WS_MODP);
        bf16_t* XN = (bf16_t*)(ws + WS_XN); bf16_t* Ob = (bf16_t*)(ws + WS_O); bf16_t* Hb = (bf16_t*)(ws + WS_H); bf16_t* ACT = Hb;
        float* XL = ka->out;
        if (ph == 0) {
          for (int rep = 0; rep < REP_P; ++rep) {
            const float* w_mod = ka->in[6]; const float* c_in = ka->in[1]; const float* cctx_in = ka->in[3];
            for (int it = gw; it < 1536; it += NGW) {
                const int ks = it & 15, cgp = (it >> 4) % 24, l = it / 384;
                const int n0 = cgp * 256 + lane * 4;
                f32x4 acc[5];
#pragma unroll
                for (int s = 0; s < 5; ++s) acc[s] = (f32x4){0.f, 0.f, 0.f, 0.f};
                const float* wp = w_mod + ((size_t)l * 1024 + ks * 64) * 6144 + n0;
                for (int kk = 0; kk < 64; ++kk) {
                    const int k = ks * 64 + kk;
                    const f32x4 w = *(const f32x4*)(wp + (size_t)kk * 6144);
#pragma unroll
                    for (int s = 0; s < 4; ++s) acc[s] += silu_f(c_in[s * 1024 + k]) * w;
                    acc[4] += silu_f(cctx_in[k]) * w;
                }
#pragma unroll
                for (int s = 0; s < 5; ++s) *(f32x4*)(MODP + ((size_t)(ks * 4 + l) * 5 + s) * 6144 + n0) = acc[s];
            }
            LAS float* scr = (LAS float*)(lds + wave * 16384);
            for (int it = gw; it < 4 * 6144; it += NGW) {
                const int l = it / 6144; int r = it - l * 6144;
                unsigned char* wl = ws + WS_W + (size_t)l * W_LAYER;
                if (r < 1408) { transpose_item(ka->in[8] + (size_t)l * 1024 * 2816, 1024, 2816, (bf16_t*)wl, 1, scr, r, lane); continue; } r -= 1408;
                if (r < 512) { transpose_item(ka->in[9] + (size_t)l * 1024 * 1024, 1024, 1024, (bf16_t*)(wl + W_OUT_OFF), 0, scr, r, lane); continue; } r -= 512;
                if (r < 2816) { transpose_item(ka->in[18] + (size_t)l * 1024 * 5632, 1024, 5632, (bf16_t*)(wl + W_UP_OFF), 2, scr, r, lane); continue; } r -= 2816;
                transpose_item(ka->in[21] + (size_t)l * 2816 * 1024, 2816, 1024, (bf16_t*)(wl + W_DN_OFF), 0, scr, r, lane);
            }
            for (int idx = vcu * 512 + tid; idx < 3072; idx += G * 512) {
                int pos, i; float e;
                if (idx < 1024) { pos = idx >> 3; i = idx & 7; e = (float)i * 0.125f; } else { const int j = idx - 1024; pos = j >> 4; i = j & 15; e = (float)i * 0.0625f; }
                const float freq = exp2f(-e * 13.287712379549449f);
                const float ang = (float)pos * freq;
                float cc, ss; sincos_f(ang, cc, ss);
                float* tp = (idx < 1024) ? (tabA + idx * 2) : (tabB + (idx - 1024) * 2);
                tp[0] = cc; tp[1] = ss;
            }
          }
        } else if (ph == 1) {
            const float* b_mod = ka->in[7];
            for (int idx = vcu * 512 + tid; idx < 4 * 5 * 6144; idx += G * 512) {
                const int l = idx / 30720, n = idx % 6144;
                float s = b_mod[l * 6144 + n];
#pragma unroll
                for (int ks = 0; ks < 16; ++ks) s += MODP[(size_t)ks * 122880 + idx];
                MOD[idx] = s;
            }
        } else if (ph == N_PHASES - 1) {
            const float* fw = ka->in[22];
            for (int m = gw; m < ML; m += NGW) {
                f32x4* xr = (f32x4*)(XL + (size_t)m * DM) + lane;
                f32x4 v[4]; float s = 0.f;
#pragma unroll
                for (int j = 0; j < 4; ++j) { v[j] = xr[64 * j]; s += (v[j][0] * v[j][0] + v[j][1] * v[j][1]) + (v[j][2] * v[j][2] + v[j][3] * v[j][3]); }
                const float rstd = rsqrtf(wave_sum(s, lane) * (1.f / 1024.f) + 1e-6f);
#pragma unroll
                for (int j = 0; j < 4; ++j) { const f32x4 w = *(const f32x4*)(fw + 4 * (64 * j + lane)); xr[64 * j] = v[j] * rstd * w; }
            }
        } else {
            const int l = (ph - 2) / 7, k = (ph - 2) % 7;
            const bool need_ctx = l < DEPTH - 1;
            const float* modl = MOD + (size_t)l * 5 * 6144;
            unsigned char* wl = ws + WS_W + (size_t)l * W_LAYER;
            const float* srcL = (l == 0) ? ka->in[0] : XL;
            if (k == 0) {
                const float* nw = ka->in[4] + l * 1024;
                for (int rep = 0; rep < REP_M; ++rep) for (int m = gw; m < MT; m += NGW) {
                    const bool lat = m < ML; const int slot = lat ? (m >> 13) : 4;
                    if (lat) norm_mod_row(srcL + (size_t)m * DM, nw, modl + slot * 6144, modl + slot * 6144 + 1024, XN + (size_t)m * DM, lane);
                    else {
                        const size_t ro = (size_t)(m - ML) * DM;
                        norm_mod_row((l == 0 ? ka->in[2] : (const float*)XCB) + ro, nw, modl + slot * 6144, modl + slot * 6144 + 1024, XN + (size_t)m * DM, lane,
                                     (const float*)Ob + ro, (l == 0) ? 0 : 11, XCA + ro);
                    }
                }
            } else if (k == 1) {
                pg8::Gemm g{XN, (const bf16_t*)wl, MT, INC, DM, DM}; pg8::StaticOrder S; S.init(MT, INC, G, bx);
                pg8::EpiInProj E{Hb, tabA, tabB};
#ifndef DIS_IN
                for (int rep = 0; rep < REP_IN; ++rep) pg8::gemm_phase<pg8::EpiInProj, pg8::StaticOrder, true, true>(lds, g, S, E);
#endif
            } else if (k == 2) {
                float lam, ofac;
                {
                    float d1 = 0.f, d2 = 0.f;
                    for (int i = 0; i < 32; ++i) { d1 += ka->in[10][l * 32 + i] * ka->in[11][l * 32 + i]; d2 += ka->in[12][l * 32 + i] * ka->in[13][l * 32 + i]; }
                    const float li = 0.8f - 0.6f * expf(-0.3f * (float)l);
                    lam = expf(d1) - expf(d2) + li; ofac = 1.f - li;
                }
                const float* subw = ka->in[14] + l * 64; const float* sink_l = ka->in[15] + l * 4; const float* rpb_l = ka->in[16] + (size_t)l * 4 * 465;
#ifndef DIS_A
                for (int rep = 0; rep < REP_A; ++rep) for (int u = vcu; u < 512; u += G) att::unit_A<false>(lds, Hb, Ob, u >> 7, (u >> 5) & 3, u & 31, lam, ofac, subw);
#endif
#ifndef DIS_B
                for (int rep = 0; rep < REP_M; ++rep) for (int u = vcu; u < 512; u += G) att::unit_BC<1>(lds, Hb, Ob, u >> 7, (u >> 6) & 1, u & 63, sink_l, rpb_l);
#endif
#ifndef DIS_C
                for (int rep = 0; rep < REP_M; ++rep) for (int u = vcu; u < 512; u += G) att::unit_BC<2>(lds, Hb, Ob, u >> 7, (u >> 5) & 3, u & 31, sink_l, rpb_l);
#endif
#ifndef DIS_CTX
                if (need_ctx) {
                    for (int rep = 0; rep < REP_M; ++rep) for (int u = vcu; u < 48; u += G) {
                        const int kind = u >> 4, bh = u & 15;
                        if (kind == 0) att::unit_A<true>(lds, Hb, Ob, bh >> 2, bh & 3, 0, lam, ofac, subw);
                        else if (kind == 1) att::unit_BC<3>(lds, Hb, Ob, bh >> 2, (bh >> 1) & 1, bh & 1, sink_l, rpb_l);
                        else att::unit_BC<4>(lds, Hb, Ob, bh >> 2, bh & 3, 0, sink_l, rpb_l);
                    }
                }
#endif
                {
                    const float* cwl = ka->in[17] + (size_t)l * 3 * 256;
                    const int rows = need_ctx ? MT : ML;
                    for (int rep = 0; rep < REP_M; ++rep) for (int idx = vcu * 512 + tid; idx < rows * 32; idx += G * 512) {
                        const int row = idx >> 5, c0 = (idx & 31) * 8;
                        int t, len; if (row < ML) { t = row & 8191; len = SEQ; } else { t = (row - ML) & 255; len = CTXL; }
                        const bf16_t* hp = Hb + (size_t)row * INC + 2048 + c0;
                        const u32x4 bg = *(const u32x4*)hp, cg1 = *(const u32x4*)(hp + 256), xi1 = *(const u32x4*)(hp + 512);
                        u32x4 cg0 = {0u, 0u, 0u, 0u}, xi0 = cg0, cg2 = cg0, xi2 = cg0;
                        if (t > 0) { cg0 = *(const u32x4*)(hp - INC + 256); xi0 = *(const u32x4*)(hp - INC + 512); }
                        if (t < len - 1) { cg2 = *(const u32x4*)(hp + INC + 256); xi2 = *(const u32x4*)(hp + INC + 512); }
                        float w0[8], w1[8], w2[8];
#pragma unroll
                        for (int e = 0; e < 8; ++e) { w0[e] = cwl[c0 + e]; w1[e] = cwl[256 + c0 + e]; w2[e] = cwl[512 + c0 + e]; }
                        u32x4 ow;
#pragma unroll
                        for (int e = 0; e < 4; ++e) {
                            const float ylo = w0[2 * e] * bflo(cg0[e]) * bflo(xi0[e]) + w1[2 * e] * bflo(cg1[e]) * bflo(xi1[e]) + w2[2 * e] * bflo(cg2[e]) * bflo(xi2[e]);
                            const float yhi = w0[2 * e + 1] * bfhi(cg0[e]) * bfhi(xi0[e]) + w1[2 * e + 1] * bfhi(cg1[e]) * bfhi(xi1[e]) + w2[2 * e + 1] * bfhi(cg2[e]) * bfhi(xi2[e]);
                            ow[e] = pkbf(bflo(bg[e]) * ylo, bfhi(bg[e]) * yhi);
                        }
                        *(u32x4*)(Ob + (size_t)row * DM + 768 + c0) = ow;
                    }
                }
                __syncthreads();
            } else if (k == 4) {
                const float* nw = ka->in[5] + l * 1024;
                const int nrows = (need_ctx ? NMX_ALL : NMX_L) * 256;
                for (int rep = 0; rep < REP_M; ++rep) for (int e = gw; e < nrows; e += NGW) {
                    const int pm = e >> 8, j = e & 255;
                    int t, slot; const float* base; int len;
                    if (pm < NMX_L) { const int s = pm / 33, ti = pm - s * 33; t = 254 * ti - 1 + j; len = SEQ; slot = s; base = XL + (size_t)s * SEQ * DM; }
                    else { const int q = pm - NMX_L; const int s = q >> 1, ti = q & 1; t = 254 * ti - 1 + j; len = CTXL; slot = 4; base = XCA + (size_t)s * CTXL * DM; }
                    const bool ok = (t >= 0 && t < len);
                    const float* src = ok ? (base + (size_t)t * DM) : nullptr;
                    if (pm < NMX_L || !ok) norm_mod_row(src, nw, modl + slot * 6144 + 3072, modl + slot * 6144 + 4096, XN + (size_t)e * DM, lane);
                    else {
                        const size_t ro = (size_t)(src - XCA);
                        norm_mod_row(src, nw, modl + slot * 6144 + 3072, modl + slot * 6144 + 4096, XN + (size_t)e * DM, lane, (const float*)Hb + ro, 4, XCB + ro);
                    }
                }
            } else if (k == 5) {
                const int nM = need_ctx ? NMX_ALL : NMX_L;
                pg8::Gemm g{XN, (const bf16_t*)(wl + W_UP_OFF), nM * 256, UPC, DM, DM}; pg8::StaticOrder S; S.init(nM * 256, UPC, G, bx);
                pg8::EpiUpConv E{ACT, ka->in[19] + (size_t)l * 3 * UPC, ka->in[20] + (size_t)l * UPC};
                pg8::OneUnit one;
#ifndef DIS_UP
                for (int rep = 0; rep < REP_UP; ++rep) for (int i = 0; S.next(i, one.u); ++i) pg8::gemm_phase<pg8::EpiUpConv, pg8::OneUnit, false, true>(lds, g, one, E);
#endif
            } else {
                const bool isout = (k == 3); const int KK = isout ? DM : DFF;
                const bf16_t* Ap = isout ? (const bf16_t*)Ob : (const bf16_t*)ACT; const bf16_t* Bp = (const bf16_t*)(wl + (isout ? W_OUT_OFF : W_DN_OFF));
                {
                    pg8::Gemm g{Ap, Bp, ML, DM, KK, KK}; pg8::StaticOrder S; S.init(ML, DM, G, bx);
                    pg8::EpiRes E{isout ? srcL : (const float*)XL, nullptr, XL, nullptr, modl, isout ? 2048 : 5120};
#ifndef DIS_OUT
#if REP_OD > 1
                    { pg8::EpiRes E2 = E; E2.outL = isout ? (float*)Hb : (float*)XN; pg8::gemm_phase<pg8::EpiRes, pg8::StaticOrder, true, true>(lds, g, S, E2); }
#endif
                    pg8::gemm_phase<pg8::EpiRes, pg8::StaticOrder, true, true>(lds, g, S, E);
#endif
                }
                if (need_ctx) {
                    const int P = isout ? 4 : 11, klen = KK / P;
                    for (int su = bx; su < 16 * P; su += G) {
                        const int tile = su / P, part = su - tile * P;
                        pg8::Gemm gs{Ap + (size_t)ML * KK + part * klen, Bp + part * klen, MC, DM, klen, KK};
                        pg8::OneUnit one; one.u.pm = tile >> 2; one.u.pn = tile & 3;
                        pg8::EpiSlab EA{(isout ? (float*)Hb : (float*)Ob) + (size_t)part * 1024 * 1024, modl + 4 * 6144 + (isout ? 2048 : 5120)};
                        pg8::gemm_phase<pg8::EpiSlab, pg8::OneUnit, false, true>(lds, gs, one, EA);
                    }
                }
            }
        }
        if (ph + 1 < ph_hi && kargs()->coop) {
            if (ph == 0) cg::this_grid().sync();
            else { XcdBarrier b; b.bar = (unsigned*)kargs()->ws; b.x = xb_xcc_id(); b.st = bar_st; xcd_barrier(b); }
        }
    }
}

extern "C" void kernel_launch(void* const* d_in, const int* in_sizes, int n_in, void* d_out, int out_size, void* d_ws, size_t ws_size, hipStream_t stream) {
    static int grid = 0;
    if (grid == 0) {
        if (n_in != 23 || out_size != ML * DM || ws_size < WS_END) { fprintf(stderr, "kernel_launch: unexpected shapes (n_in %d out %d ws %zu need %zu)\n", n_in, out_size, ws_size, (size_t)WS_END); grid = -1; return; }
        int dev = 0, cus = 0, per_cu = 0;
        if (hipGetDevice(&dev) != hipSuccess || hipDeviceGetAttribute(&cus, hipDeviceAttributeMultiprocessorCount, dev) != hipSuccess) { grid = -1; return; }
        if (hipFuncSetAttribute((const void*)fwd_kernel, hipFuncAttributeMaxDynamicSharedMemorySize, LDS_BYTES) != hipSuccess) { fprintf(stderr, "kernel_launch: hipFuncSetAttribute failed\n"); grid = -1; return; }
        if (hipOccupancyMaxActiveBlocksPerMultiprocessor(&per_cu, (const void*)fwd_kernel, 512, LDS_BYTES) != hipSuccess || per_cu < 1) fprintf(stderr, "kernel_launch: occupancy query says %d\n", per_cu);
        (void)hipGetLastError();
        grid = cus;
    }
    if (grid < 0) return;
    Args a{};
    for (int i = 0; i < 23; ++i) a.in[i] = (const float*)d_in[i];
    a.out = (float*)d_out; a.ws = (unsigned char*)d_ws;
#if MK_MULTI
    for (int ph = 0; ph < N_PHASES; ++ph) {
        a.ph_lo = ph; a.ph_hi = ph + 1; a.coop = 0;
        hipLaunchKernelGGL(fwd_kernel, dim3(grid), dim3(512), LDS_BYTES, stream, a);
    }
#else
    a.ph_lo = 0; a.ph_hi = N_PHASES; a.coop = 1;
    if (hipMemsetAsync(d_ws, 0, 16384, stream) != hipSuccess) { fprintf(stderr, "kernel_launch: memset failed\n"); return; }
    void* args[] = {&a};
    hipError_t e = hipLaunchCooperativeKernel((const void*)fwd_kernel, dim3(grid), dim3(512), args, LDS_BYTES, stream);
    if (e != hipSuccess) fprintf(stderr, "cooperative launch failed: %s (grid %d)\n", hipGetErrorString(e), grid);
#endif
}
```

```cpp
#include <hip/hip_runtime.h>
#include <hip/hip_cooperative_groups.h>
#include <cstdio>
#include <cstdint>
namespace cg = cooperative_groups;

#ifndef MK_MULTI
#define MK_MULTI 0
#endif

#ifndef REP_IN
#define REP_IN 1
#endif
#ifndef REP_UP
#define REP_UP 1
#endif
#ifndef REP_A
#define REP_A 1
#endif
#ifndef REP_OD
#define REP_OD 1
#endif
#ifndef REP_P
#define REP_P 1
#endif
#ifndef REP_BC
#define REP_BC 1
#endif
#ifndef REP_M
#define REP_M 1
#endif

__device__ __forceinline__ int pg8_ltid() { int t = threadIdx.x; asm volatile("" : "+v"(t)); return t; }
namespace pg8 {
#define PG8_LAS __attribute__((address_space(3)))
typedef unsigned short bf16_t;
typedef short bf16x8 __attribute__((ext_vector_type(8)));
typedef float f32x4 __attribute__((ext_vector_type(4)));
typedef unsigned u32x4 __attribute__((ext_vector_type(4)));
constexpr int BM = 256, BK = 64, HALF = 128, HTB = HALF * BK * 2  , STAGE_BYTES = 8 * HTB, NXCD = 8, WGM = 8;

__host__ __device__ __forceinline__ int lds_byte(int r, int c) { const int st = (r >> 4) * 2 + (c >> 5), rr = r & 15, cc = c & 31, ob = rr * 64 + cc * 2; return st * 1024 + (ob ^ (((ob >> 9) & 1) << 5)); }
__host__ __device__ __forceinline__ void stage_rc(int b, int& R, int& C) { const int st = b / 1024, sb = b % 1024, swz = sb ^ (((sb >> 9) & 1) << 5); R = (st >> 1) * 16 + swz / 64; C = (st & 1) * 32 + (swz % 64) / 2; }
__host__ __device__ __forceinline__ int perm32(int rho) { const int n = rho >> 4, i = rho & 15; return 8 * (i >> 2) + 4 * n + (i & 3); }

struct Unit { int pm, pn; };
struct Gemm { const bf16_t* A; const bf16_t* Bt; int M, N, K, ldk; };

struct StaticOrder {
    int nM, nN, nwg, G, c;
    __host__ __device__ void init(int M, int N, int G_, int c_) { nM = M / BM; nN = N / BM; nwg = nM * nN; G = G_; c = c_; }
    __host__ __device__ bool next(int i, Unit& u) const {
        const long L = (long)i * G + c; if (L >= nwg) return false;
        int wgid = (int)L; { const int q = nwg / NXCD, r = nwg % NXCD, xcd = wgid % NXCD, off = wgid / NXCD; wgid = (xcd < r ? xcd * (q + 1) : r * (q + 1) + (xcd - r) * q) + off; }
        const int nig = WGM * nN, gid = wgid / nig, fm = gid * WGM, gsz = (nM - fm) < WGM ? (nM - fm) : WGM;
        u.pm = fm + ((wgid % nig) % gsz); u.pn = (wgid % nig) / gsz; return true;
    }
    __device__ __forceinline__ void a_ready(const Unit&) const {}
    __device__ __forceinline__ void done(const Unit&) const {}
};

__device__ __forceinline__ unsigned cvt_pk_bf16(float lo, float hi) { unsigned r; asm volatile("v_cvt_pk_bf16_f32 %0, %1, %2" : "=v"(r) : "v"(lo), "v"(hi)); return r; }
typedef unsigned u32x2 __attribute__((ext_vector_type(2)));

struct OneUnit {
    Unit u;
    __device__ __forceinline__ bool next(int i, Unit& o) const { if (i != 0) return false; o = u; return true; }
    __device__ __forceinline__ void a_ready(const Unit&) const {}
    __device__ __forceinline__ void done(const Unit&) const {}
};

struct EpiInProj {
    static constexpr bool PERM = false, AFTER_DRAIN = false;
    bf16_t* H; const float* tabA; const float* tabB;
    __device__ __forceinline__ void operator()(const f32x4 (&acc)[2][2][4][2], const Unit& u, int wr, int wc, int fr, int fq) const {
        const int pn = u.pn; const bool latent = u.pm < 128;
        const float scale = (pn == 0) ? 0.17677669529663687f * 1.4426950408889634f : ((pn == 3 || pn == 5) ? 0.125f * 1.4426950408889634f : 1.0f);
#pragma unroll
        for (int bj = 0; bj < 2; ++bj) {
            int mode = (pn == 0 || pn == 1) ? 1 : ((pn == 3 || (pn == 4 && bj == 0)) ? 2 : 0);
            if (!latent) mode = 0;
#ifdef TEST_NOROPE
            mode = 0;
#endif
#pragma unroll
            for (int ai = 0; ai < 2; ++ai)
#pragma unroll
                for (int m = 0; m < 4; ++m) {
                    const int r = u.pm * BM + ai * HALF + wr * 64 + m * 16 + fr;
                    f32x4 v0 = acc[ai][bj][m][0], v1 = acc[ai][bj][m][1];
                    if (mode != 0) {
                        const int t = r & 8191, trow = t >> 6, tcol = t & 63;
                        const float* tp;
                        if (mode == 1) { const int pos = (fq < 2) ? trow : tcol; tp = tabA + (pos * 8 + 4 * (fq & 1)) * 2; }
                        else { const int pos = (wc & 1) ? tcol : trow; tp = tabB + (pos * 16 + 4 * fq) * 2; }
                        const f32x4 cs0 = *(const f32x4*)tp, cs1 = *(const f32x4*)(tp + 4);
                        const float c0 = cs0[0], s0 = cs0[1], c1 = cs0[2], s1 = cs0[3], c2 = cs1[0], s2 = cs1[1], c3 = cs1[2], s3 = cs1[3];
                        f32x4 a = v0, b = v1;
                        v0[0] = a[0] * c0 - b[0] * s0; v1[0] = b[0] * c0 + a[0] * s0;
                        v0[1] = a[1] * c1 - b[1] * s1; v1[1] = b[1] * c1 + a[1] * s1;
                        v0[2] = a[2] * c2 - b[2] * s2; v1[2] = b[2] * c2 + a[2] * s2;
                        v0[3] = a[3] * c3 - b[3] * s3; v1[3] = b[3] * c3 + a[3] * s3;
                    }
                    v0 = v0 * scale; v1 = v1 * scale;
                    bf16_t* rowp = H + (size_t)r * 2816 + pn * BM + bj * HALF + wc * 32 + 4 * fq;
                    u32x2 w0, w1; w0.x = cvt_pk_bf16(v0[0], v0[1]); w0.y = cvt_pk_bf16(v0[2], v0[3]); w1.x = cvt_pk_bf16(v1[0], v1[1]); w1.y = cvt_pk_bf16(v1[2], v1[3]);
                    *(u32x2*)rowp = w0; *(u32x2*)(rowp + 16) = w1;
                }
        }
    }
};

struct EpiRes {
    static constexpr bool PERM = false, AFTER_DRAIN = false;
    const float* baseL; const float* baseC; float* outL; float* outC; const float* modl; int goff;
    __device__ __forceinline__ void operator()(const f32x4 (&acc)[2][2][4][2], const Unit& u, int wr, int wc, int fr, int fq) const {
        const bool ctx = u.pm >= 128; const int slot = ctx ? 4 : (u.pm >> 5);
        const int row0 = (ctx ? (u.pm - 128) : u.pm) * BM + wr * 64 + fr;
        const float* bp = ctx ? baseC : baseL; float* op = ctx ? outC : outL;
        const int col0 = u.pn * BM + wc * 32 + 4 * fq;
        f32x4 gv[2][2];
#pragma unroll
        for (int bj = 0; bj < 2; ++bj)
#pragma unroll
            for (int n = 0; n < 2; ++n) gv[bj][n] = *(const f32x4*)(modl + slot * 6144 + goff + col0 + bj * HALF + n * 16);
#pragma unroll
        for (int ai = 0; ai < 2; ++ai)
#pragma unroll
            for (int m = 0; m < 4; ++m) {
                const size_t off = (size_t)(row0 + ai * HALF + m * 16) * 1024 + col0;
#pragma unroll
                for (int bj = 0; bj < 2; ++bj)
#pragma unroll
                    for (int n = 0; n < 2; ++n) {
                        const f32x4 bs = *(const f32x4*)(bp + off + bj * HALF + n * 16);
                        *(f32x4*)(op + off + bj * HALF + n * 16) = bs + gv[bj][n] * acc[ai][bj][m][n];
                    }
                asm volatile("" ::: "memory");
            }
    }
};

struct EpiSlab {
    static constexpr bool PERM = false, AFTER_DRAIN = false;
    float* slab; const float* gate;
    __device__ __forceinline__ void operator()(const f32x4 (&acc)[2][2][4][2], const Unit& u, int wr, int wc, int fr, int fq) const {
        const int row0 = u.pm * BM + wr * 64 + fr, col0 = u.pn * BM + wc * 32 + 4 * fq;
#pragma unroll
        for (int bj = 0; bj < 2; ++bj)
#pragma unroll
            for (int n = 0; n < 2; ++n) {
                const f32x4 gv = *(const f32x4*)(gate + col0 + bj * HALF + n * 16);
#pragma unroll
                for (int ai = 0; ai < 2; ++ai)
#pragma unroll
                    for (int m = 0; m < 4; ++m)
                        *(f32x4*)(slab + (size_t)(row0 + ai * HALF + m * 16) * 1024 + col0 + bj * HALF + n * 16) = gv * acc[ai][bj][m][n];
            }
    }
};

struct EpiUpConv {
    static constexpr bool PERM = false, AFTER_DRAIN = true;
    bf16_t* ACT; const float* cw; const float* cb;
    static constexpr int TP = 520;
    __device__ __forceinline__ void fused(f32x4 (&acc)[2][2][4][2], const Unit& u, int wr, int wc, int fr, int fq, PG8_LAS unsigned char* lds, int wid, int lane) const {
#pragma unroll
        for (int ai = 0; ai < 2; ++ai)
#pragma unroll
            for (int m = 0; m < 4; ++m) {
                const int row = ai * HALF + wr * 64 + m * 16 + fr;
#pragma unroll
                for (int bj = 0; bj < 2; ++bj)
#pragma unroll
                    for (int n = 0; n < 2; ++n) {
                        const f32x4 v = acc[ai][bj][m][n]; u32x2 w; w.x = cvt_pk_bf16(v[0], v[1]); w.y = cvt_pk_bf16(v[2], v[3]);
                        *(PG8_LAS u32x2*)(lds + row * TP + (bj * HALF + wc * 32 + n * 16 + 4 * fq) * 2) = w;
                    }
            }
        const int tid = wid * 64 + lane, ch = tid & 15;
        const int gcol = u.pn * 128 + ch * 8;
        float wg[3][8], wv[3][8], bg[8], bv[8];
#pragma unroll
        for (int k = 0; k < 3; ++k) {
            const f32x4 a0 = *(const f32x4*)(cw + k * 5632 + gcol), a1 = *(const f32x4*)(cw + k * 5632 + gcol + 4);
            const f32x4 b0 = *(const f32x4*)(cw + k * 5632 + 2816 + gcol), b1 = *(const f32x4*)(cw + k * 5632 + 2816 + gcol + 4);
#pragma unroll
            for (int e = 0; e < 4; ++e) { wg[k][e] = a0[e]; wg[k][4 + e] = a1[e]; wv[k][e] = b0[e]; wv[k][4 + e] = b1[e]; }
        }
        {
            const f32x4 a0 = *(const f32x4*)(cb + gcol), a1 = *(const f32x4*)(cb + gcol + 4), b0 = *(const f32x4*)(cb + 2816 + gcol), b1 = *(const f32x4*)(cb + 2816 + gcol + 4);
#pragma unroll
            for (int e = 0; e < 4; ++e) { bg[e] = a0[e]; bg[4 + e] = a1[e]; bv[e] = b0[e]; bv[4 + e] = b1[e]; }
        }
        const bool lat = u.pm < 132; int rowbase, ti;
        if (lat) { const int s = u.pm / 33; ti = u.pm - s * 33; rowbase = s * 8192; } else { ti = u.pm - 132; rowbase = 32768; }
        asm volatile("s_waitcnt lgkmcnt(0)" ::: "memory"); __builtin_amdgcn_s_barrier(); asm volatile("" ::: "memory");
        for (int it = tid; it < 254 * 16; it += 512) {
            const int j = 1 + (it >> 4); const int p = 254 * ti - 1 + j;
            int orow; bool ok;
            if (lat) { ok = p < 8192; orow = rowbase + p; } else { const int sq = p / 257, r = p - sq * 257; ok = (p < 1029) && (r != 0); orow = rowbase + sq * 256 + r - 1; }
            if (ok) {
                float g[8], v[8];
#pragma unroll
                for (int e = 0; e < 8; ++e) { g[e] = bg[e]; v[e] = bv[e]; }
#pragma unroll
                for (int k = 0; k < 3; ++k) {
                    const PG8_LAS unsigned char* rp = lds + (j - 1 + k) * TP + ch * 16;
                    const u32x2 g0 = *(const PG8_LAS u32x2*)rp, g1 = *(const PG8_LAS u32x2*)(rp + 8);
                    const u32x2 v0 = *(const PG8_LAS u32x2*)(rp + 256), v1 = *(const PG8_LAS u32x2*)(rp + 264);
                    const unsigned gw[4] = {g0.x, g0.y, g1.x, g1.y}, vw[4] = {v0.x, v0.y, v1.x, v1.y};
#pragma unroll
                    for (int e = 0; e < 4; ++e) {
                        g[2 * e] += wg[k][2 * e] * __uint_as_float(gw[e] << 16); g[2 * e + 1] += wg[k][2 * e + 1] * __uint_as_float(gw[e] & 0xffff0000u);
                        v[2 * e] += wv[k][2 * e] * __uint_as_float(vw[e] << 16); v[2 * e + 1] += wv[k][2 * e + 1] * __uint_as_float(vw[e] & 0xffff0000u);
                    }
                }
                float o[8];
#pragma unroll
                for (int e = 0; e < 8; ++e) o[e] = g[e] / (1.f + __expf(-g[e])) * v[e];
                u32x4 w; w.x = cvt_pk_bf16(o[0], o[1]); w.y = cvt_pk_bf16(o[2], o[3]); w.z = cvt_pk_bf16(o[4], o[5]); w.w = cvt_pk_bf16(o[6], o[7]);
                *(u32x4*)(ACT + (size_t)orow * 2816 + gcol) = w;
            }
        }
        asm volatile("s_waitcnt lgkmcnt(0)" ::: "memory"); __builtin_amdgcn_s_barrier(); asm volatile("" ::: "memory");
    }
};
template <class Epi, class Sched, bool ALIGN_EPI = false, bool SP2 = false>
__device__ __forceinline__ void gemm_phase(PG8_LAS unsigned char* lds, const Gemm g, const Sched& S, const Epi& E) {
    const int tid = pg8_ltid(), wid = __builtin_amdgcn_readfirstlane(tid >> 6), lane = tid & 63, wr = wid >> 2, wc = wid & 3, fr = lane & 15, fq = lane >> 4;
    const int K = g.ldk, nt = g.K / BK;
    unsigned voffA[2], voffB[2];
#pragma unroll
    for (int i = 0; i < 2; ++i) { int R, C; stage_rc(tid * 16 + i * 8192, R, C); const int Rb = Epi::PERM ? ((R & ~31) + perm32(R & 31)) : R;
        voffA[i] = (unsigned)(R * K + C) * 2u; voffB[i] = (unsigned)(Rb * K + C) * 2u; }
    const size_t kstep = (size_t)(BK * 2);
    const size_t hstep = (size_t)HALF * K * 2;
    const size_t tstep = 2 * hstep;
    const unsigned ldsw = (unsigned)wid * 1024u;
    const int aoff = lds_byte(wr * 64 + fr, fq * 8), boff = lds_byte(wc * 32 + fr, fq * 8);
#define PG8_SA(b, h) (((b) * 2 + (h)) * HTB)
#define PG8_SB(b, h) ((4 + (b) * 2 + (h)) * HTB)
#define PG8_STAGE(bufoff, gbase, voff) do { _Pragma("unroll") for (int _i = 0; _i < 2; ++_i) \
        __builtin_amdgcn_global_load_lds((const unsigned*)((const char*)(gbase) + (voff)[_i]), (PG8_LAS unsigned*)(lds + (bufoff) + ldsw + _i * 8192), 16, 0, 0); } while (0)
#define PG8_LDA(dst, b, h) do { _Pragma("unroll") for (int m = 0; m < 4; ++m) _Pragma("unroll") for (int k = 0; k < 2; ++k) dst[m][k] = *(const PG8_LAS bf16x8*)(lds + PG8_SA(b, h) + aoff + m * 2048 + k * 1024); } while (0)
#define PG8_LDB(dst, b, h) do { _Pragma("unroll") for (int n = 0; n < 2; ++n) _Pragma("unroll") for (int k = 0; k < 2; ++k) dst[n][k] = *(const PG8_LAS bf16x8*)(lds + PG8_SB(b, h) + boff + n * 2048 + k * 1024); } while (0)
#define PG8_MMA(ai, bj, At, Bt) do { __builtin_amdgcn_s_setprio(1); _Pragma("unroll") for (int m = 0; m < 4; ++m) _Pragma("unroll") for (int n = 0; n < 2; ++n) _Pragma("unroll") for (int k = 0; k < 2; ++k) \
        acc[ai][bj][m][n] = __builtin_amdgcn_mfma_f32_16x16x32_bf16(Bt[n][k], At[m][k], acc[ai][bj][m][n], 0, 0, 0); __builtin_amdgcn_s_setprio(0); } while (0)
#define PG8_WAIT_V(n) asm volatile("s_waitcnt vmcnt(" #n ")" ::: "memory")
#define PG8_WAIT_L(n) asm volatile("s_waitcnt lgkmcnt(" #n ")" ::: "memory")
#define PG8_BAR __builtin_amdgcn_s_barrier()
#define PG8_SCHED __builtin_amdgcn_sched_barrier(0)
    Unit cur, nxt; int ui = 0;
    if (!S.next(0, cur)) return;
    f32x4 acc[2][2][4][2];
#pragma unroll
    for (int a = 0; a < 2; ++a)
#pragma unroll
        for (int b = 0; b < 2; ++b)
#pragma unroll
            for (int m = 0; m < 4; ++m)
#pragma unroll
                for (int n = 0; n < 2; ++n) acc[a][b][m][n] = (f32x4){0.f, 0.f, 0.f, 0.f};
    bf16x8 At[4][2], B0[2][2], B1[2][2];
    const char* cA = (const char*)g.A + (size_t)cur.pm * tstep; const char* cB = (const char*)g.Bt + (size_t)cur.pn * tstep;
    S.a_ready(cur);
    if constexpr (SP2) {
        PG8_STAGE(PG8_SB(0, 0), cB, voffB); PG8_STAGE(PG8_SB(0, 1), cB + hstep, voffB); PG8_STAGE(PG8_SA(0, 0), cA, voffA); PG8_STAGE(PG8_SA(0, 1), cA + hstep, voffA);
        if (wr == 1) PG8_BAR;
        PG8_WAIT_V(2); PG8_BAR;
        PG8_STAGE(PG8_SB(1, 0), cB + kstep, voffB); PG8_STAGE(PG8_SA(1, 0), cA + kstep, voffA); PG8_STAGE(PG8_SB(1, 1), cB + hstep + kstep, voffB);
        PG8_WAIT_V(6); PG8_BAR;
    } else {
        PG8_STAGE(PG8_SB(0, 0), cB, voffB); PG8_STAGE(PG8_SA(0, 0), cA, voffA); PG8_STAGE(PG8_SB(0, 1), cB + hstep, voffB); PG8_STAGE(PG8_SA(0, 1), cA + hstep, voffA);
        if (wr == 1) PG8_BAR;
        PG8_WAIT_V(4); PG8_BAR;
        PG8_STAGE(PG8_SB(1, 0), cB + kstep, voffB); PG8_STAGE(PG8_SA(1, 0), cA + kstep, voffA); PG8_STAGE(PG8_SB(1, 1), cB + hstep + kstep, voffB);
        PG8_WAIT_V(6); PG8_BAR;
    }
    for (;;) {
        const bool has_next = S.next(ui + 1, nxt);
        const char* nA = has_next ? (const char*)g.A + (size_t)nxt.pm * tstep : cA; const char* nB = has_next ? (const char*)g.Bt + (size_t)nxt.pn * tstep : cB;
        for (int t = 0; t < nt; t += 2) {
            const bool last = (t == nt - 2);
            const char* a1 = cA + (size_t)(t + 1) * kstep;
            const char* a2 = last ? nA : cA + (size_t)(t + 2) * kstep; const char* b2 = last ? nB : cB + (size_t)(t + 2) * kstep;
            const char* a3 = a2 + kstep; const char* b3 = b2 + kstep;
            if (last && has_next) S.a_ready(nxt);
            if constexpr (SP2) {
            PG8_LDB(B0, 0, 0); PG8_LDB(B1, 0, 1); PG8_SCHED; PG8_LDA(At, 0, 0); PG8_STAGE(PG8_SA(1, 1), a1 + hstep, voffA);
            PG8_WAIT_V(8); PG8_WAIT_L(0); PG8_BAR; PG8_MMA(0, 0, At, B0); PG8_MMA(0, 1, At, B1); PG8_BAR; PG8_SCHED;
            PG8_LDA(At, 0, 1); PG8_STAGE(PG8_SB(0, 0), b2, voffB); PG8_STAGE(PG8_SB(0, 1), b2 + hstep, voffB); PG8_STAGE(PG8_SA(0, 0), a2, voffA);
            PG8_WAIT_V(8); PG8_WAIT_L(0); PG8_BAR; PG8_MMA(1, 0, At, B0); PG8_MMA(1, 1, At, B1); PG8_BAR; PG8_SCHED;
            PG8_LDB(B0, 1, 0); PG8_LDB(B1, 1, 1); PG8_SCHED; PG8_LDA(At, 1, 0); PG8_STAGE(PG8_SA(0, 1), a2 + hstep, voffA);
            PG8_WAIT_V(8); PG8_WAIT_L(0); PG8_BAR; PG8_MMA(0, 0, At, B0); PG8_MMA(0, 1, At, B1); PG8_BAR; PG8_SCHED;
            PG8_LDA(At, 1, 1); PG8_STAGE(PG8_SB(1, 0), b3, voffB); PG8_STAGE(PG8_SB(1, 1), b3 + hstep, voffB); PG8_STAGE(PG8_SA(1, 0), a3, voffA);
            PG8_WAIT_V(8); PG8_WAIT_L(0); PG8_BAR; PG8_MMA(1, 0, At, B0); PG8_MMA(1, 1, At, B1); PG8_BAR; PG8_SCHED;
            } else {
            PG8_LDB(B0, 0, 0); PG8_SCHED; PG8_LDA(At, 0, 0); PG8_STAGE(PG8_SA(1, 1), a1 + hstep, voffA);
            PG8_WAIT_L(8); PG8_BAR; PG8_WAIT_L(0); PG8_MMA(0, 0, At, B0); PG8_BAR; PG8_SCHED;
            PG8_LDB(B1, 0, 1); PG8_STAGE(PG8_SB(0, 0), b2, voffB);
            PG8_BAR; PG8_WAIT_L(0); PG8_MMA(0, 1, At, B1); PG8_BAR;
            PG8_LDA(At, 0, 1); PG8_STAGE(PG8_SA(0, 0), a2, voffA);
            PG8_BAR; PG8_WAIT_L(0); PG8_MMA(1, 0, At, B0); PG8_BAR; PG8_SCHED;
            PG8_STAGE(PG8_SB(0, 1), b2 + hstep, voffB);
            PG8_WAIT_V(6); PG8_BAR; PG8_MMA(1, 1, At, B1); PG8_BAR;
            PG8_LDB(B0, 1, 0); PG8_SCHED; PG8_LDA(At, 1, 0); PG8_STAGE(PG8_SA(0, 1), a2 + hstep, voffA);
            PG8_WAIT_L(8); PG8_BAR; PG8_WAIT_L(0); PG8_MMA(0, 0, At, B0); PG8_BAR; PG8_SCHED;
            PG8_LDB(B1, 1, 1); PG8_STAGE(PG8_SB(1, 0), b3, voffB);
            PG8_BAR; PG8_WAIT_L(0); PG8_MMA(0, 1, At, B1); PG8_BAR;
            PG8_LDA(At, 1, 1); PG8_STAGE(PG8_SA(1, 0), a3, voffA);
            PG8_BAR; PG8_WAIT_L(0); PG8_MMA(1, 0, At, B0); PG8_BAR; PG8_SCHED;
            PG8_STAGE(PG8_SB(1, 1), b3 + hstep, voffB);
            PG8_WAIT_V(6); PG8_BAR; PG8_MMA(1, 1, At, B1); PG8_BAR;
            }
        }
        if constexpr (ALIGN_EPI) { if (wr == 0) PG8_BAR; }
        if constexpr (!Epi::AFTER_DRAIN) { E(acc, cur, wr, wc, fr, fq); S.done(cur); }
        if (!has_next) break;
#pragma unroll
        for (int a = 0; a < 2; ++a)
#pragma unroll
            for (int b = 0; b < 2; ++b)
#pragma unroll
                for (int m = 0; m < 4; ++m)
#pragma unroll
                    for (int n = 0; n < 2; ++n) acc[a][b][m][n] = (f32x4){0.f, 0.f, 0.f, 0.f};
        cur = nxt; cA = nA; cB = nB; ++ui;
        if constexpr (ALIGN_EPI) { if (wr == 1) PG8_BAR; }
    }
    PG8_WAIT_V(0);
    if constexpr (!ALIGN_EPI) { if (wr == 0) PG8_BAR; }
    PG8_BAR;
    if constexpr (Epi::AFTER_DRAIN) { E.fused(acc, cur, wr, wc, fr, fq, lds, wid, lane); S.done(cur); }
#undef PG8_SA
#undef PG8_SB
#undef PG8_STAGE
#undef PG8_LDA
#undef PG8_LDB
#undef PG8_MMA
#undef PG8_WAIT_V
#undef PG8_WAIT_L
#undef PG8_BAR
#undef PG8_SCHED
}
}
#define LAS __attribute__((address_space(3)))
typedef unsigned short bf16_t;
typedef short bf16x8 __attribute__((ext_vector_type(8)));
typedef short s16x4 __attribute__((ext_vector_type(4)));
typedef float f32x4 __attribute__((ext_vector_type(4)));
typedef float f32x16 __attribute__((ext_vector_type(16)));
typedef unsigned u32x4 __attribute__((ext_vector_type(4)));
typedef unsigned u32x2 __attribute__((ext_vector_type(2)));

constexpr int DM = 1024, NB = 4, SEQ = 8192, DEPTH = 4, CTXL = 256;
constexpr int ML = NB * SEQ, MC = NB * CTXL, MT = ML + MC;
constexpr int INC = 2816, DFF = 2816, UPC = 5632;
constexpr int NMX_L = NB * 33, NMX_ALL = NB * 33 + 5;
constexpr float LOG2E = 1.4426950408889634f;

constexpr size_t MiB = 1u << 20;
constexpr size_t WS_MOD = 1 * MiB;
constexpr size_t WS_MODP = 2 * MiB;
constexpr size_t WS_TAB = 10 * MiB;
constexpr size_t WS_XC = 11 * MiB;
constexpr size_t WS_W = 16 * MiB;
constexpr size_t W_LAYER = 24 * MiB, W_OUT_OFF = (size_t)2816 * 1024 * 2, W_UP_OFF = W_OUT_OFF + (size_t)1024 * 1024 * 2, W_DN_OFF = W_UP_OFF + (size_t)5632 * 1024 * 2;
constexpr size_t WS_XN = 112 * MiB;
constexpr size_t WS_O = 182 * MiB;
constexpr size_t WS_H = 248 * MiB;
constexpr size_t WS_END = WS_H + (size_t)MT * 2816 * 2;
static_assert(W_DN_OFF + (size_t)1024 * 2816 * 2 <= W_LAYER, "weights per layer");
static_assert(WS_XN + (size_t)NMX_ALL * 256 * 1024 * 2 <= WS_O && WS_O + (size_t)MT * 1024 * 2 <= WS_H && WS_END <= 512 * MiB, "ws map");

constexpr int RING_BYTES = 135168;
constexpr int LDS_BYTES = 147456;

__device__ __forceinline__ unsigned pkbf(float lo, float hi) { unsigned r; asm volatile("v_cvt_pk_bf16_f32 %0, %1, %2" : "=v"(r) : "v"(lo), "v"(hi)); return r; }
__device__ __forceinline__ float bflo(unsigned w) { return __uint_as_float(w << 16); }
__device__ __forceinline__ float bfhi(unsigned w) { return __uint_as_float(w & 0xffff0000u); }
__device__ __forceinline__ float wave_sum(float v, int lane) {
#pragma unroll
    for (int o = 1; o < 64; o <<= 1) v += __int_as_float(__builtin_amdgcn_ds_bpermute((lane ^ o) << 2, __float_as_int(v)));
    return v;
}
__device__ __forceinline__ float xhalf_max(float v) { auto rr = __builtin_amdgcn_permlane32_swap(__float_as_uint(v), __float_as_uint(v), false, false); return fmaxf(__uint_as_float(rr[0]), __uint_as_float(rr[1])); }
__device__ __forceinline__ float xhalf_sum(float v) { auto rr = __builtin_amdgcn_permlane32_swap(__float_as_uint(v), __float_as_uint(v), false, false); return __uint_as_float(rr[0]) + __uint_as_float(rr[1]); }

namespace att {
constexpr int KP = 144, VP = 136;
constexpr int L_KS = 0, L_VT = 64 * KP, L_RPB = L_VT + 64 * VP, L_END = L_RPB + 2048;
__device__ __forceinline__ int crow(int r, int h) { return (r & 3) + 8 * (r >> 2) + 4 * h; }

struct TileRegs { u32x4 k, v; };
__device__ __forceinline__ void tile_gload(TileRegs& R, const bf16_t* H, int krow, int kcol, int vcol, int tid) {
    const int key = tid >> 3, ch = tid & 7;
    const bf16_t* p = H + (size_t)(krow + key) * INC;
    R.k = *(const u32x4*)(p + kcol + 8 * ch); R.v = *(const u32x4*)(p + vcol + 8 * ch);
}
__device__ __forceinline__ void tile_swrite(const TileRegs& R, LAS unsigned char* lds, int tid) {
    const int key = tid >> 3, ch = tid & 7;
    *(LAS u32x4*)(lds + L_KS + key * KP + ch * 16) = R.k;
    LAS unsigned short* vt = (LAS unsigned short*)(lds + L_VT);
#pragma unroll
    for (int j = 0; j < 4; ++j) { const unsigned w = R.v[j]; vt[(8 * ch + 2 * j) * (VP / 2) + key] = (unsigned short)(w & 0xffffu); vt[(8 * ch + 2 * j + 1) * (VP / 2) + key] = (unsigned short)(w >> 16); }
}
template <int KS0, int NKS>
__device__ __forceinline__ f32x16 qk_block(const LAS unsigned char* lds, int kb, int r32, int hh, const bf16x8 (&qf)[4]) {
    f32x16 s = {0.f, 0.f, 0.f, 0.f, 0.f, 0.f, 0.f, 0.f, 0.f, 0.f, 0.f, 0.f, 0.f, 0.f, 0.f, 0.f};
#pragma unroll
    for (int ks = KS0; ks < KS0 + NKS; ++ks) {
        const bf16x8 kf = *(const LAS bf16x8*)(lds + L_KS + (kb * 32 + r32) * KP + ks * 32 + hh * 16);
        s = __builtin_amdgcn_mfma_f32_32x32x16_bf16(kf, qf[ks], s, 0, 0, 0);
    }
    return s;
}
__device__ __forceinline__ void softmax_pv(f32x16 (&s)[2], float& m, float& l, f32x16 (&O)[2], const LAS unsigned char* lds, int r32, int hh) {
    float mx = s[0][0];
#pragma unroll
    for (int r = 1; r < 16; ++r) mx = fmaxf(mx, s[0][r]);
#pragma unroll
    for (int r = 0; r < 16; ++r) mx = fmaxf(mx, s[1][r]);
    mx = xhalf_max(mx);
    __builtin_amdgcn_sched_barrier(0);
    const float mn = fmaxf(m, mx);
    const float alpha = __builtin_amdgcn_exp2f(m - mn);
    m = mn; l *= alpha;
#pragma unroll
    for (int r = 0; r < 16; ++r) { O[0][r] *= alpha; O[1][r] *= alpha; }
    float ps = 0.f;
#pragma unroll
    for (int kb = 0; kb < 2; ++kb)
#pragma unroll
        for (int r = 0; r < 16; ++r) { const float p = __builtin_amdgcn_exp2f(s[kb][r] - mn); s[kb][r] = p; ps += p; }
    l += ps;
    __builtin_amdgcn_sched_barrier(0);
#pragma unroll
    for (int kb = 0; kb < 2; ++kb)
#pragma unroll
        for (int sk = 0; sk < 2; ++sk) {
            __builtin_amdgcn_sched_barrier(0);
            u32x4 pw; pw.x = pkbf(s[kb][8 * sk + 0], s[kb][8 * sk + 1]); pw.y = pkbf(s[kb][8 * sk + 2], s[kb][8 * sk + 3]);
            pw.z = pkbf(s[kb][8 * sk + 4], s[kb][8 * sk + 5]); pw.w = pkbf(s[kb][8 * sk + 6], s[kb][8 * sk + 7]);
            const bf16x8 pf = __builtin_bit_cast(bf16x8, pw);
#pragma unroll
            for (int dvb = 0; dvb < 2; ++dvb) {
                const LAS unsigned char* a = lds + L_VT + (dvb * 32 + r32) * VP + (kb * 32 + 16 * sk + 4 * hh) * 2;
                const s16x4 lo = *(const LAS s16x4*)a, hi = *(const LAS s16x4*)(a + 16);
                const bf16x8 vf = {lo[0], lo[1], lo[2], lo[3], hi[0], hi[1], hi[2], hi[3]};
                O[dvb] = __builtin_amdgcn_mfma_f32_32x32x16_bf16(vf, pf, O[dvb], 0, 0, 0);
            }
        }
}
__device__ __forceinline__ void store_o(const f32x16 (&o)[2], bf16_t* orow, int hh) {
#pragma unroll
    for (int dvb = 0; dvb < 2; ++dvb)
#pragma unroll
        for (int g = 0; g < 4; ++g) {
            u32x2 w; w.x = pkbf(o[dvb][4 * g], o[dvb][4 * g + 1]); w.y = pkbf(o[dvb][4 * g + 2], o[dvb][4 * g + 3]);
            *(u32x2*)(orow + dvb * 32 + 8 * g + 4 * hh) = w;
        }
}

__device__ __forceinline__ void unit_A_safe(const bool CTXQ, LAS unsigned char* lds, const bf16_t* H, bf16_t* Ob, int b, int h, int qb, float lam, float ofac, const float* subw) {
    const int tid = pg8_ltid(), lane = tid & 63, r32 = lane & 31, hh = lane >> 5, wid = tid >> 6;
    const int qrow = CTXQ ? (ML + b * CTXL + wid * 32 + r32) : (b * SEQ + qb * 256 + wid * 32 + r32);
    const int qcol = h * 64, kcol = 256 + h * 64, vcol = 512 + h * 64;
    bf16x8 qf[4];
#pragma unroll
    for (int ks = 0; ks < 4; ++ks) qf[ks] = *(const bf16x8*)(H + (size_t)qrow * INC + qcol + 16 * ks + 8 * hh);
    const int NT = CTXQ ? 4 : 132;
    f32x16 O1[2], O2[2];
#pragma unroll
    for (int r = 0; r < 16; ++r) { O1[0][r] = 0.f; O1[1][r] = 0.f; O2[0][r] = 0.f; O2[1][r] = 0.f; }
    float m1 = -INFINITY, m2 = -INFINITY, l1 = 0.f, l2 = 0.f;
    TileRegs R;
    tile_gload(R, H, CTXQ ? (ML + b * CTXL) : (b * SEQ), kcol, vcol, tid);
    for (int t = 0; t < NT; ++t) {
        __syncthreads();
        tile_swrite(R, lds, tid);
        __syncthreads();
        if (t + 1 < NT) { const int tn = t + 1; const int krow = CTXQ ? (ML + b * CTXL + 64 * tn) : (tn < 128 ? b * SEQ + 64 * tn : ML + b * CTXL + 64 * (tn - 128)); tile_gload(R, H, krow, kcol, vcol, tid); }
        { f32x16 s[2]; s[0] = qk_block<0, 2>(lds, 0, r32, hh, qf); s[1] = qk_block<0, 2>(lds, 1, r32, hh, qf); softmax_pv(s, m1, l1, O1, lds, r32, hh); }
        __builtin_amdgcn_sched_barrier(0);
        { f32x16 s[2]; s[0] = qk_block<2, 2>(lds, 0, r32, hh, qf); s[1] = qk_block<2, 2>(lds, 1, r32, hh, qf); softmax_pv(s, m2, l2, O2, lds, r32, hh); }
        __builtin_amdgcn_sched_barrier(0);
    }
    l1 = xhalf_sum(l1); l2 = xhalf_sum(l2);
    const float i1 = 1.f / l1, i2 = lam / l2;
    float ss = 0.f;
#pragma unroll
    for (int dvb = 0; dvb < 2; ++dvb)
#pragma unroll
        for (int r = 0; r < 16; ++r) { const float o = O1[dvb][r] * i1 - O2[dvb][r] * i2; O1[dvb][r] = o; ss += o * o; }
    ss = xhalf_sum(ss);
    float li_ = ofac; asm volatile("" : "+s"(li_));
    const float rn = rsqrtf(ss * (1.f / 64.f) + 1e-6f) * (1.f - li_);
#pragma unroll
    for (int dvb = 0; dvb < 2; ++dvb)
#pragma unroll
        for (int g = 0; g < 4; ++g) {
            const f32x4 w = *(const f32x4*)(subw + dvb * 32 + 8 * g + 4 * hh);
#pragma unroll
            for (int e = 0; e < 4; ++e) O1[dvb][4 * g + e] *= rn * w[e];
        }
    store_o(O1, Ob + (size_t)qrow * DM + h * 64, hh);
}


constexpr int A_KP = 144, A_VP = 192, A_VOFF = 64 * A_KP, A_BUF = A_VOFF + 64 * A_VP;
constexpr float ATHR = 10.f;
typedef short v4i16_t __attribute__((ext_vector_type(4)));
__device__ __forceinline__ s16x4 vtr(const LAS unsigned char* p) { return __builtin_bit_cast(s16x4, __builtin_amdgcn_ds_read_tr16_b64_v4i16((LAS v4i16_t*)p)); }
__device__ __forceinline__ void tileA_swrite(const TileRegs& R, LAS unsigned char* buf, int tid) {
    const int key = tid >> 3, ch = tid & 7;
    *(LAS u32x4*)(buf + key * A_KP + ch * 16) = R.k;
    *(LAS u32x4*)(buf + A_VOFF + key * A_VP + ch * 16) = R.v;
}
__device__ __forceinline__ float max16(const f32x16& s) {
    float a = fmaxf(fmaxf(s[0], s[1]), s[2]), b = fmaxf(fmaxf(s[3], s[4]), s[5]), c = fmaxf(fmaxf(s[6], s[7]), s[8]), d = fmaxf(fmaxf(s[9], s[10]), s[11]);
    a = fmaxf(fmaxf(a, s[12]), s[13]); b = fmaxf(fmaxf(b, s[14]), s[15]);
    return fmaxf(fmaxf(a, b), fmaxf(c, d));
}
__device__ __forceinline__ float expsum16(f32x16& s) {
    float a = 0.f, b = 0.f, c = 0.f, d = 0.f;
#pragma unroll
    for (int r = 0; r < 16; r += 4) {
        s[r] = __builtin_amdgcn_exp2f(s[r]); s[r + 1] = __builtin_amdgcn_exp2f(s[r + 1]); s[r + 2] = __builtin_amdgcn_exp2f(s[r + 2]); s[r + 3] = __builtin_amdgcn_exp2f(s[r + 3]);
        a += s[r]; b += s[r + 1]; c += s[r + 2]; d += s[r + 3];
    }
    return (a + b) + (c + d);
}
__device__ __forceinline__ bf16x8 packp(const f32x16& s, int sk) {
    u32x4 pw; pw.x = pkbf(s[8 * sk + 0], s[8 * sk + 1]); pw.y = pkbf(s[8 * sk + 2], s[8 * sk + 3]); pw.z = pkbf(s[8 * sk + 4], s[8 * sk + 5]); pw.w = pkbf(s[8 * sk + 6], s[8 * sk + 7]);
    return __builtin_bit_cast(bf16x8, pw);
}
__device__ __forceinline__ void exp16(f32x16& s) {
#pragma unroll
    for (int r = 0; r < 16; ++r) s[r] = __builtin_amdgcn_exp2f(s[r]);
}
constexpr float AREF = 20.f, AGUARD = 60.f;
#ifndef SGB_V
#define SGB_V 5
#endif
template <bool HAVE>
__device__ __forceinline__ void stepA(bf16x8 (&pc)[2][2], const LAS unsigned char* kbuf, int kb, const LAS unsigned char* vb, const LAS unsigned char* qs, int r32, int hh,
                                      float mref1, float mref2, f32x16 (&O1)[2], f32x16 (&O2)[2], f32x16& L1, f32x16& L2, const bf16x8& ones) {
    const LAS unsigned char* kp = kbuf + (kb * 32 + r32) * A_KP + hh * 16;
    const bf16x8 k0 = *(const LAS bf16x8*)(kp), k1 = *(const LAS bf16x8*)(kp + 32), k2 = *(const LAS bf16x8*)(kp + 64), k3 = *(const LAS bf16x8*)(kp + 96);
    const bf16x8 q0 = *(const LAS bf16x8*)(qs), q1 = *(const LAS bf16x8*)(qs + 32), q2 = *(const LAS bf16x8*)(qs + 64), q3 = *(const LAS bf16x8*)(qs + 96);
    bf16x8 vf[2][2];
#pragma unroll
    for (int sk = 0; sk < 2; ++sk)
#pragma unroll
        for (int dvb = 0; dvb < 2; ++dvb) {
            const LAS unsigned char* a = vb + 16 * sk * A_VP + dvb * 64;
            const s16x4 lo = vtr(a), hi = vtr(a + 8 * A_VP);
            vf[sk][dvb] = (bf16x8){lo[0], lo[1], lo[2], lo[3], hi[0], hi[1], hi[2], hi[3]};
        }
    const f32x16 z = {0.f, 0.f, 0.f, 0.f, 0.f, 0.f, 0.f, 0.f, 0.f, 0.f, 0.f, 0.f, 0.f, 0.f, 0.f, 0.f};
    f32x16 s1 = __builtin_amdgcn_mfma_f32_32x32x16_bf16(k0, q0, z, 0, 0, 0);
    f32x16 s2 = __builtin_amdgcn_mfma_f32_32x32x16_bf16(k2, q2, z, 0, 0, 0);
    s1 = __builtin_amdgcn_mfma_f32_32x32x16_bf16(k1, q1, s1, 0, 0, 0);
    s2 = __builtin_amdgcn_mfma_f32_32x32x16_bf16(k3, q3, s2, 0, 0, 0);
#pragma unroll
    for (int sk = 0; sk < 2; ++sk) {
        L1 = __builtin_amdgcn_mfma_f32_32x32x16_bf16(ones, pc[0][sk], L1, 0, 0, 0);
        L2 = __builtin_amdgcn_mfma_f32_32x32x16_bf16(ones, pc[1][sk], L2, 0, 0, 0);
#pragma unroll
        for (int dvb = 0; dvb < 2; ++dvb) {
            O1[dvb] = __builtin_amdgcn_mfma_f32_32x32x16_bf16(vf[sk][dvb], pc[0][sk], O1[dvb], 0, 0, 0);
            O2[dvb] = __builtin_amdgcn_mfma_f32_32x32x16_bf16(vf[sk][dvb], pc[1][sk], O2[dvb], 0, 0, 0);
        }
    }
    if (HAVE) {
#pragma unroll
        for (int r = 0; r < 16; ++r) { s1[r] -= mref1; s2[r] -= mref2; }
    }
    exp16(s1); exp16(s2);
    bf16x8 pn[2][2];
    pn[0][0] = packp(s1, 0); pn[0][1] = packp(s1, 1); pn[1][0] = packp(s2, 0); pn[1][1] = packp(s2, 1);
#ifndef EXP_NOSGB
    __builtin_amdgcn_sched_group_barrier(0x008, 6, 0);
#pragma unroll
    for (int i = 0; i < 10; ++i) { __builtin_amdgcn_sched_group_barrier(0x002, SGB_V, 0); __builtin_amdgcn_sched_group_barrier(0x008, 1, 0); }
    __builtin_amdgcn_sched_group_barrier(0x002, 48, 0);
#endif
    pc[0][0] = pn[0][0]; pc[0][1] = pn[0][1]; pc[1][0] = pn[1][0]; pc[1][1] = pn[1][1];
}
__device__ __forceinline__ void unit_A(const bool CTXQ, LAS unsigned char* lds, const bf16_t* H, bf16_t* Ob, int b, int h, int qb, float lam, float ofac, const float* subw) {
    const int tid = pg8_ltid(), lane = tid & 63, r32 = lane & 31, hh = lane >> 5, wid = tid >> 6;
    const int qrow = CTXQ ? (ML + b * CTXL + wid * 32 + r32) : (b * SEQ + qb * 256 + wid * 32 + r32);
    const int qcol = h * 64, kcol = 256 + h * 64, vcol = 512 + h * 64;
    const int NT = CTXQ ? 4 : 132;
    f32x16 O1[2], O2[2], L1, L2;
#pragma unroll
    for (int r = 0; r < 16; ++r) { O1[0][r] = 0.f; O1[1][r] = 0.f; O2[0][r] = 0.f; O2[1][r] = 0.f; L1[r] = 0.f; L2[r] = 0.f; }
    const bf16x8 ones = {0x3F80, 0x3F80, 0x3F80, 0x3F80, 0x3F80, 0x3F80, 0x3F80, 0x3F80};
    const int voff = A_VOFF + (4 * hh + ((lane & 15) >> 2)) * A_VP + (((lane >> 4) & 1) * 16 + (lane & 3) * 4) * 2;
    const int krow0 = CTXQ ? (ML + b * CTXL) : (b * SEQ);
    LAS unsigned char* qs = lds + 3 * A_BUF + (wid * 32 + r32) * A_KP + hh * 16;
    volatile LAS unsigned* flag = (volatile LAS unsigned*)(lds + RING_BYTES + 128);
    TileRegs R;
    __syncthreads();
    if (tid == 0) *flag = 0u;
#pragma unroll
    for (int ks = 0; ks < 4; ++ks) *(LAS bf16x8*)(qs + ks * 32) = *(const bf16x8*)(H + (size_t)qrow * INC + qcol + 16 * ks + 8 * hh);
    tile_gload(R, H, krow0, kcol, vcol, tid);       tileA_swrite(R, lds, tid);
    tile_gload(R, H, krow0 + 64, kcol, vcol, tid);  tileA_swrite(R, lds + A_BUF, tid);
    tile_gload(R, H, krow0 + 128, kcol, vcol, tid);
    __syncthreads();
    bf16x8 pc[2][2];
    {
        const LAS unsigned char* kp = lds + r32 * A_KP + hh * 16;
        const f32x16 z = {0.f, 0.f, 0.f, 0.f, 0.f, 0.f, 0.f, 0.f, 0.f, 0.f, 0.f, 0.f, 0.f, 0.f, 0.f, 0.f};
        f32x16 sa1 = __builtin_amdgcn_mfma_f32_32x32x16_bf16(*(const LAS bf16x8*)(kp), *(const LAS bf16x8*)(qs), z, 0, 0, 0);
        sa1 = __builtin_amdgcn_mfma_f32_32x32x16_bf16(*(const LAS bf16x8*)(kp + 32), *(const LAS bf16x8*)(qs + 32), sa1, 0, 0, 0);
        f32x16 sa2 = __builtin_amdgcn_mfma_f32_32x32x16_bf16(*(const LAS bf16x8*)(kp + 64), *(const LAS bf16x8*)(qs + 64), z, 0, 0, 0);
        sa2 = __builtin_amdgcn_mfma_f32_32x32x16_bf16(*(const LAS bf16x8*)(kp + 96), *(const LAS bf16x8*)(qs + 96), sa2, 0, 0, 0);
        const float mx1 = xhalf_max(max16(sa1)), mx2 = xhalf_max(max16(sa2));
        if (__any((fabsf(mx1) > AREF) || (fabsf(mx2) > AREF)) != 0) *flag = 1u;
        exp16(sa1); exp16(sa2);
        pc[0][0] = packp(sa1, 0); pc[0][1] = packp(sa1, 1); pc[1][0] = packp(sa2, 0); pc[1][1] = packp(sa2, 1);
    }
    int bc = 0, t = 0;
#define UNITA_STAGE() \
        const int bn = (bc == 2 * A_BUF) ? 0 : bc + A_BUF, bw = (bn == 2 * A_BUF) ? 0 : bn + A_BUF; \
        if (t + 2 < NT) { \
            tileA_swrite(R, lds + bw, tid); \
            if (t + 3 < NT) { const int tn = t + 3; const int krow = CTXQ ? (krow0 + 64 * tn) : (tn < 128 ? b * SEQ + 64 * tn : ML + b * CTXL + 64 * (tn - 128)); tile_gload(R, H, krow, kcol, vcol, tid); } \
        }
#define UNITA_GUARD() (__any((L1[0] > 1.152921504606846976e18f) || (L2[0] > 1.152921504606846976e18f)) != 0)
    unsigned fl = 0u;
    {
        for (; t < NT; ++t) {
            if (__builtin_expect(fl != 0u, 0)) break;
            fl = *flag;
            if (__builtin_expect(UNITA_GUARD(), 0)) *flag = 1u;
            UNITA_STAGE()
            stepA<false>(pc, lds + bc, 1, lds + bc + voff, qs, r32, hh, 0.f, 0.f, O1, O2, L1, L2, ones);
            stepA<false>(pc, lds + bn, 0, lds + bc + voff + 32 * A_VP, qs, r32, hh, 0.f, 0.f, O1, O2, L1, L2, ones);
            __syncthreads();
            bc = bn;
        }
    }
#undef UNITA_STAGE
#undef UNITA_GUARD
    if (*flag != 0u) { unit_A_safe(CTXQ, lds, H, Ob, b, h, qb, lam, ofac, subw); return; }
    const float i1 = 1.f / L1[0], i2 = lam / L2[0];
    float ss = 0.f;
#pragma unroll
    for (int dvb = 0; dvb < 2; ++dvb)
#pragma unroll
        for (int r = 0; r < 16; ++r) { const float o = O1[dvb][r] * i1 - O2[dvb][r] * i2; O1[dvb][r] = o; ss += o * o; }
    ss = xhalf_sum(ss);
    float li_ = ofac; asm volatile("" : "+s"(li_));
    const float rn = rsqrtf(ss * (1.f / 64.f) + 1e-6f) * (1.f - li_);
#pragma unroll
    for (int dvb = 0; dvb < 2; ++dvb)
#pragma unroll
        for (int g = 0; g < 4; ++g) {
            const f32x4 w = *(const f32x4*)(subw + dvb * 32 + 8 * g + 4 * hh);
#pragma unroll
            for (int e = 0; e < 4; ++e) O1[dvb][4 * g + e] *= rn * w[e];
        }
    store_o(O1, Ob + (size_t)qrow * DM + h * 64, hh);
}

template <int MODE> __device__ __forceinline__ int tile_row_f(int t, int b, int lo, int nloc) {
    if (MODE == 1) return (t < nloc) ? (b * SEQ + 64 * (lo + t)) : (ML + b * CTXL + 64 * (t - nloc));
    if (MODE == 2) return (t < 4) ? (ML + b * CTXL + 64 * t) : (b * SEQ + 64 * (lo + t - 4));
    return ML + b * CTXL + 64 * t;
}
__device__ __forceinline__ int tile_row_r(int MODE, int t, int b, int lo, int nloc) {
    if (MODE == 1) return (t < nloc) ? (b * SEQ + 64 * (lo + t)) : (ML + b * CTXL + 64 * (t - nloc));
    if (MODE == 2) return (t < 4) ? (ML + b * CTXL + 64 * t) : (b * SEQ + 64 * (lo + t - 4));
    return ML + b * CTXL + 64 * t;
}
__device__ __forceinline__ void unit_BC(const int MODE, LAS unsigned char* lds, const bf16_t* H, bf16_t* Ob, int b, int hd, int blk, const float* sink_l, const float* rpb_l) {
    const int tid = pg8_ltid(), lane = tid & 63, r32 = lane & 31, hh = lane >> 5, wid = tid >> 6;
    int qrow, qcol, kcol, vcol, ocol, qpos = 0, r_w = 0, qc = 0, lo = 0, nloc = 0;
    float m = -INFINITY, l = 0.f;
    if (MODE == 1) {
        const int g = wid >> 2, head = hd * 2 + g; qpos = 128 * blk + 32 * (wid & 3) + r32; qrow = b * SEQ + qpos;
        qcol = 768 + head * 64; kcol = 1024 + hd * 64; vcol = 1152 + hd * 64; ocol = 256 + head * 64;
        lo = 2 * blk - 2; if (lo < 0) lo = 0; int hi = 2 * blk + 3; if (hi > 127) hi = 127; nloc = hi - lo + 1;
        m = sink_l[head] * LOG2E; l = (hh == 0) ? 1.f : 0.f;
    } else if (MODE == 3) {
        const int head = hd * 2 + blk; qrow = ML + b * CTXL + wid * 32 + r32;
        qcol = 768 + head * 64; kcol = 1024 + hd * 64; vcol = 1152 + hd * 64; ocol = 256 + head * 64;
        m = sink_l[head] * LOG2E; l = (hh == 0) ? 1.f : 0.f;
    } else if (MODE == 2) {
        r_w = 4 * blk + (wid >> 1); qc = 32 * (wid & 1) + r32; qrow = b * SEQ + r_w * 64 + qc;
        qcol = 1280 + hd * 64; kcol = 1536 + hd * 64; vcol = 1792 + hd * 64; ocol = 512 + hd * 64;
        int a0 = 4 * blk - 4; if (a0 < 0) a0 = 0; if (a0 > 120) a0 = 120; int a3 = 4 * blk + 3 - 4; if (a3 < 0) a3 = 0; if (a3 > 120) a3 = 120;
        lo = a0; nloc = a3 + 7 - a0 + 1;
    } else {
        qrow = ML + b * CTXL + wid * 32 + r32;
        qcol = 1280 + hd * 64; kcol = 1536 + hd * 64; vcol = 1792 + hd * 64; ocol = 512 + hd * 64;
    }
    bf16x8 qf[4];
#pragma unroll
    for (int ks = 0; ks < 4; ++ks) qf[ks] = *(const bf16x8*)(H + (size_t)qrow * INC + qcol + 16 * ks + 8 * hh);
    f32x16 O[2];
#pragma unroll
    for (int r = 0; r < 16; ++r) { O[0][r] = 0.f; O[1][r] = 0.f; }
    const int NT = 4 + nloc;
    int rs = 0;
    if (MODE == 2) { rs = r_w - 4; if (rs < 0) rs = 0; if (rs > 120) rs = 120; }
    const LAS float* rpbs = (const LAS float*)(lds + L_RPB);
    TileRegs R;
    tile_gload(R, H, tile_row_r(MODE, 0, b, lo, nloc), kcol, vcol, tid);
    for (int t = 0; t < NT; ++t) {
        __syncthreads();
        tile_swrite(R, lds, tid);
        if (MODE == 2 && t == 0) { for (int i = tid; i < 465; i += 512) ((LAS float*)(lds + L_RPB))[i] = rpb_l[hd * 465 + i] * LOG2E; }
        __syncthreads();
        if (t + 1 < NT) tile_gload(R, H, tile_row_r(MODE, t + 1, b, lo, nloc), kcol, vcol, tid);
        bool active = true; int kr = 0;
        if (MODE == 2 && t >= 4) { kr = lo + t - 4; active = (kr >= rs) && (kr < rs + 8); }
        if (active) {
            f32x16 s[2]; s[0] = qk_block<0, 4>(lds, 0, r32, hh, qf); s[1] = qk_block<0, 4>(lds, 1, r32, hh, qf);
            if (MODE == 1 && t < nloc) {
                const int kbase = 64 * (lo + t) - qpos;
#pragma unroll
                for (int kb = 0; kb < 2; ++kb)
#pragma unroll
                    for (int r = 0; r < 16; ++r) { const int d = kbase + kb * 32 + crow(r, hh); if (d > 128 || d < -128) s[kb][r] = -INFINITY; }
            }
            if (MODE == 2 && t >= 4) {
                int cs = qc - 8; if (cs < 0) cs = 0; if (cs > 48) cs = 48;
                const int bbase = (kr - r_w + 7) * 31 + 15 - qc;
#pragma unroll
                for (int kb = 0; kb < 2; ++kb)
#pragma unroll
                    for (int r = 0; r < 16; ++r) {
                        const int kc = kb * 32 + crow(r, hh);
                        const bool ok = (kc >= cs) && (kc < cs + 16);
                        int bi = bbase + kc; bi = ok ? bi : 0;
                        const float bias = rpbs[bi];
                        s[kb][r] = ok ? (s[kb][r] + bias) : -INFINITY;
                    }
            }
            softmax_pv(s, m, l, O, lds, r32, hh);
        }
    }
    l = xhalf_sum(l);
    const float il = 1.f / l;
#pragma unroll
    for (int r = 0; r < 16; ++r) { O[0][r] *= il; O[1][r] *= il; }
    store_o(O, Ob + (size_t)qrow * DM + ocol, hh);
}

template <int MODE>
__device__ __forceinline__ void bcf_compute(const LAS unsigned char* cur, int t, int nloc, int lo, int qpos, int kr, int r_w, int qc, const bf16x8 (&qf)[4], f32x16 (&O)[2], f32x16& L,
                                            const bf16x8& ones, const LAS float* rpbs, int voff, int r32, int hh) {
    f32x16 s[2];
    const f32x16 z = {0.f, 0.f, 0.f, 0.f, 0.f, 0.f, 0.f, 0.f, 0.f, 0.f, 0.f, 0.f, 0.f, 0.f, 0.f, 0.f};
#pragma unroll
    for (int kb = 0; kb < 2; ++kb) {
        const LAS unsigned char* kp = cur + (kb * 32 + r32) * A_KP + hh * 16;
        s[kb] = __builtin_amdgcn_mfma_f32_32x32x16_bf16(*(const LAS bf16x8*)(kp), qf[0], z, 0, 0, 0);
        s[kb] = __builtin_amdgcn_mfma_f32_32x32x16_bf16(*(const LAS bf16x8*)(kp + 32), qf[1], s[kb], 0, 0, 0);
        s[kb] = __builtin_amdgcn_mfma_f32_32x32x16_bf16(*(const LAS bf16x8*)(kp + 64), qf[2], s[kb], 0, 0, 0);
        s[kb] = __builtin_amdgcn_mfma_f32_32x32x16_bf16(*(const LAS bf16x8*)(kp + 96), qf[3], s[kb], 0, 0, 0);
    }
    if (MODE == 1 && t < nloc) {
        const int kbase = 64 * (lo + t) - qpos;
#pragma unroll
        for (int kb = 0; kb < 2; ++kb)
#pragma unroll
            for (int r = 0; r < 16; ++r) { const int d = kbase + kb * 32 + crow(r, hh); if (d > 128 || d < -128) s[kb][r] = -INFINITY; }
    }
    if (MODE == 2 && t >= 4) {
        int cs = qc - 8; if (cs < 0) cs = 0; if (cs > 48) cs = 48;
        const int bbase = (kr - r_w + 7) * 31 + 15 - qc;
#pragma unroll
        for (int kb = 0; kb < 2; ++kb)
#pragma unroll
            for (int r = 0; r < 16; ++r) {
                const int kc = kb * 32 + crow(r, hh);
                const bool ok = (kc >= cs) && (kc < cs + 16);
                int bi = bbase + kc; bi = ok ? bi : 0;
                const float bias = rpbs[bi];
                s[kb][r] = ok ? (s[kb][r] + bias) : -INFINITY;
            }
    }
#pragma unroll
    for (int kb = 0; kb < 2; ++kb) {
        exp16(s[kb]);
#pragma unroll
        for (int sk = 0; sk < 2; ++sk) {
            const bf16x8 p = packp(s[kb], sk);
            L = __builtin_amdgcn_mfma_f32_32x32x16_bf16(ones, p, L, 0, 0, 0);
#pragma unroll
            for (int dvb = 0; dvb < 2; ++dvb) {
                const LAS unsigned char* a = cur + voff + (kb * 32 + 16 * sk) * A_VP + dvb * 64;
                const s16x4 vlo = vtr(a), vhi = vtr(a + 8 * A_VP);
                const bf16x8 vf = {vlo[0], vlo[1], vlo[2], vlo[3], vhi[0], vhi[1], vhi[2], vhi[3]};
                O[dvb] = __builtin_amdgcn_mfma_f32_32x32x16_bf16(vf, p, O[dvb], 0, 0, 0);
            }
        }
    }
}
template <int MODE>
__device__ __forceinline__ bool unit_BC_fast(LAS unsigned char* lds, const bf16_t* H, bf16_t* Ob, int b, int hd, int blk, const float* sink_l, const float* rpb_l) {
    const int tid = pg8_ltid(), lane = tid & 63, r32 = lane & 31, hh = lane >> 5, wid = tid >> 6;
    int qrow, qcol, kcol, vcol, ocol, qpos = 0, r_w = 0, qc = 0, lo = 0, nloc = 0;
    float linit = 0.f;
    if (MODE == 1) {
        const int g = wid >> 2, head = hd * 2 + g; qpos = 128 * blk + 32 * (wid & 3) + r32; qrow = b * SEQ + qpos;
        qcol = 768 + head * 64; kcol = 1024 + hd * 64; vcol = 1152 + hd * 64; ocol = 256 + head * 64;
        lo = 2 * blk - 2; if (lo < 0) lo = 0; int hi = 2 * blk + 3; if (hi > 127) hi = 127; nloc = hi - lo + 1;
        linit = __builtin_amdgcn_exp2f(sink_l[head] * LOG2E);
    } else if (MODE == 3) {
        const int head = hd * 2 + blk; qrow = ML + b * CTXL + wid * 32 + r32;
        qcol = 768 + head * 64; kcol = 1024 + hd * 64; vcol = 1152 + hd * 64; ocol = 256 + head * 64;
        linit = __builtin_amdgcn_exp2f(sink_l[head] * LOG2E);
    } else if (MODE == 2) {
        r_w = 4 * blk + (wid >> 1); qc = 32 * (wid & 1) + r32; qrow = b * SEQ + r_w * 64 + qc;
        qcol = 1280 + hd * 64; kcol = 1536 + hd * 64; vcol = 1792 + hd * 64; ocol = 512 + hd * 64;
        int a0 = 4 * blk - 4; if (a0 < 0) a0 = 0; if (a0 > 120) a0 = 120; int a3 = 4 * blk + 3 - 4; if (a3 < 0) a3 = 0; if (a3 > 120) a3 = 120;
        lo = a0; nloc = a3 + 7 - a0 + 1;
    } else {
        qrow = ML + b * CTXL + wid * 32 + r32;
        qcol = 1280 + hd * 64; kcol = 1536 + hd * 64; vcol = 1792 + hd * 64; ocol = 512 + hd * 64;
    }
    bf16x8 qf[4];
#pragma unroll
    for (int ks = 0; ks < 4; ++ks) qf[ks] = *(const bf16x8*)(H + (size_t)qrow * INC + qcol + 16 * ks + 8 * hh);
    f32x16 O[2], L;
#pragma unroll
    for (int r = 0; r < 16; ++r) { O[0][r] = 0.f; O[1][r] = 0.f; L[r] = linit; }
    const bf16x8 ones = {0x3F80, 0x3F80, 0x3F80, 0x3F80, 0x3F80, 0x3F80, 0x3F80, 0x3F80};
    const int NT = 4 + nloc;
    int rs = 0;
    if (MODE == 2) { rs = r_w - 4; if (rs < 0) rs = 0; if (rs > 120) rs = 120; }
    const int voff = A_VOFF + (4 * hh + ((lane & 15) >> 2)) * A_VP + (((lane >> 4) & 1) * 16 + (lane & 3) * 4) * 2;
    LAS float* rpbs = (LAS float*)(lds + 2 * A_BUF);
    volatile LAS unsigned* flag = (volatile LAS unsigned*)(lds + RING_BYTES + 128);
    TileRegs Ra, Rb;
    __syncthreads();
    if (tid == 0) *flag = 0u;
    if (MODE == 2) { for (int i = tid; i < 465; i += 512) rpbs[i] = rpb_l[hd * 465 + i] * LOG2E; }
    tile_gload(Ra, H, tile_row_f<MODE>(0, b, lo, nloc), kcol, vcol, tid);
    tileA_swrite(Ra, lds, tid);
    tile_gload(Rb, H, tile_row_f<MODE>(1, b, lo, nloc), kcol, vcol, tid);
    tile_gload(Ra, H, tile_row_f<MODE>(2, b, lo, nloc), kcol, vcol, tid);
    __syncthreads();
#define BCF_TILE(T, RS) { \
        const int t = (T); \
        const LAS unsigned char* cur = lds + (t & 1) * A_BUF; \
        if (t + 1 < NT) { \
            tileA_swrite(RS, lds + ((t + 1) & 1) * A_BUF, tid); \
            if (t + 3 < NT) tile_gload(RS, H, tile_row_f<MODE>(t + 3, b, lo, nloc), kcol, vcol, tid); \
        } \
        bool active = true; int kr = 0; \
        if (MODE == 2 && t >= 4) { kr = lo + t - 4; active = (kr >= rs) && (kr < rs + 8); } \
        if (active) bcf_compute<MODE>(cur, t, nloc, lo, qpos, kr, r_w, qc, qf, O, L, ones, rpbs, voff, r32, hh); \
        __syncthreads(); }
    for (int t2 = 0; t2 < NT; t2 += 2) {
        BCF_TILE(t2, Rb)
        if (t2 + 1 < NT) BCF_TILE(t2 + 1, Ra)
    }
#undef BCF_TILE
    const float lsum = L[0];
    if (__any(!((lsum > 1e-30f) && (lsum < 1e30f))) != 0) *flag = 1u;
    __syncthreads();
    if (*flag != 0u) return true;
    const float il = 1.f / lsum;
#pragma unroll
    for (int r = 0; r < 16; ++r) { O[0][r] *= il; O[1][r] *= il; }
    store_o(O, Ob + (size_t)qrow * DM + ocol, hh);
    return false;
}
}
__device__ __forceinline__ float silu_f(float v) { return v / (1.f + __expf(-v)); }

__device__ __forceinline__ int wrow_map(int type, int n) {
    if (type == 1) { if (n < 512) { const int p = n & 31, blk = p >> 3; const int np = (blk == 1) ? p + 8 : ((blk == 2) ? p - 8 : p); return (n & ~31) + np; } return n; }
    if (type == 2) { const int half = (n >= 2816) ? 1 : 0; const int j = n - half * 2816; return (j >> 7) * 256 + half * 128 + (j & 127); }
    return n;
}
__device__ __forceinline__ void transpose_item(const float* W, int K, int N, bf16_t* WT, int type, LAS float* scr, int item, int lane) {
    const int nblk = N / 32, kb = item / nblk, nb = item - kb * nblk, k0 = 64 * kb, n0 = 32 * nb;
#pragma unroll 8
    for (int i = 0; i < 32; ++i) { const int kk = 2 * i + (lane >> 5); scr[kk * 33 + (lane & 31)] = W[(size_t)(k0 + kk) * N + n0 + (lane & 31)]; }
    asm volatile("s_waitcnt lgkmcnt(0)" ::: "memory");
    const int c = lane & 7;
#pragma unroll
    for (int j = 0; j < 4; ++j) {
        const int n = (lane >> 3) + 8 * j; const LAS float* s = scr + (8 * c) * 33 + n;
        u32x4 o; o.x = pkbf(s[0 * 33], s[1 * 33]); o.y = pkbf(s[2 * 33], s[3 * 33]); o.z = pkbf(s[4 * 33], s[5 * 33]); o.w = pkbf(s[6 * 33], s[7 * 33]);
        *(u32x4*)(WT + (size_t)wrow_map(type, n0 + n) * K + k0 + 8 * c) = o;
    }
    asm volatile("s_waitcnt lgkmcnt(0)" ::: "memory");
}

__device__ __forceinline__ void sincos_f(float x, float& c, float& s) {
    const float k = rintf(x * 0.636619772f);
    float r = fmaf(-k, 1.57079625129699707031f, x); r = fmaf(-k, 7.54978941586159635335e-08f, r);
    const float r2 = r * r;
    const float sr = r * (1.f + r2 * (-1.f / 6 + r2 * (1.f / 120 + r2 * (-1.f / 5040 + r2 * (1.f / 362880)))));
    const float cr = 1.f + r2 * (-0.5f + r2 * (1.f / 24 + r2 * (-1.f / 720 + r2 * (1.f / 40320 + r2 * (-1.f / 3628800)))));
    const int q = ((int)k) & 3;
    s = (q == 0) ? sr : (q == 1) ? cr : (q == 2) ? -sr : -cr;
    c = (q == 0) ? cr : (q == 1) ? -sr : (q == 2) ? -cr : sr;
}

__device__ __forceinline__ void norm_mod_row(const float* src, const float* nw, const float* sh, const float* sc, bf16_t* dst, int lane, const float* slab = nullptr, int nslab = 0, float* xout = nullptr) {
    u32x2* o8 = (u32x2*)dst + lane;
    if (src == nullptr) {
#pragma unroll
        for (int j = 0; j < 4; ++j) o8[64 * j] = (u32x2){0u, 0u};
        return;
    }
    const f32x4* xr = (const f32x4*)src + lane;
    f32x4 v[4]; float s = 0.f;
#pragma unroll
    for (int j = 0; j < 4; ++j) v[j] = xr[64 * j];
    for (int p = 0; p < nslab; ++p) {
        const f32x4* sr = (const f32x4*)(slab + (size_t)p * 1024 * 1024) + lane;
#pragma unroll
        for (int j = 0; j < 4; ++j) v[j] += sr[64 * j];
    }
    if (xout != nullptr) {
#pragma unroll
        for (int j = 0; j < 4; ++j) ((f32x4*)xout + lane)[64 * j] = v[j];
    }
#pragma unroll
    for (int j = 0; j < 4; ++j) s += (v[j][0] * v[j][0] + v[j][1] * v[j][1]) + (v[j][2] * v[j][2] + v[j][3] * v[j][3]);
    const float rstd = rsqrtf(wave_sum(s, lane) * (1.f / 1024.f) + 1e-6f);
#pragma unroll
    for (int j = 0; j < 4; ++j) {
        const int k = 4 * (64 * j + lane);
        const f32x4 w = *(const f32x4*)(nw + k), a = *(const f32x4*)(sc + k), d = *(const f32x4*)(sh + k);
        f32x4 y;
#pragma unroll
        for (int e = 0; e < 4; ++e) y[e] = (v[j][e] * rstd * w[e]) * (1.f + a[e]) + d[e];
        u32x2 p; p.x = pkbf(y[0], y[1]); p.y = pkbf(y[2], y[3]);
        o8[64 * j] = p;
    }
}

#define XB_TMO      128
#define XB_XCNT(j)  (256  + 64 * (j))
#define XB_XSUB(j)  (1280 + 64 * (j))
#define XB_XGEN(j)  (2304 + 64 * (j))
#define XB_TOP      3328
#define XB_TOPGEN   3392
#define XCD_BAR_WORDS 3456
#define XB_SPIN_CAP (1u << 18)

__device__ __forceinline__ unsigned xb_ld(unsigned* p)              { return __hip_atomic_load(p, __ATOMIC_RELAXED, __HIP_MEMORY_SCOPE_AGENT); }
__device__ __forceinline__ unsigned xb_add(unsigned* p, unsigned v) { return __hip_atomic_fetch_add(p, v, __ATOMIC_RELAXED, __HIP_MEMORY_SCOPE_AGENT); }
__device__ __forceinline__ unsigned xb_xcc_id() { return (unsigned)__builtin_amdgcn_s_getreg((3 << 11) | 20) & 0xFu; }
#define XB_SPIN(cond, bar) do { unsigned _sp = 0; while (cond) { __builtin_amdgcn_s_sleep(1); \
    if ((++_sp & 255u) == 0u) { if (xb_ld(&(bar)[XB_TMO])) break; if (_sp > XB_SPIN_CAP) { atomicAdd(&(bar)[XB_TMO], 1u); break; } } } } while (0)

struct XcdBarrier {
    unsigned* bar; unsigned x;
    volatile LAS unsigned* st;
};

__device__ __forceinline__ XcdBarrier xcd_barrier_post(unsigned* bar, volatile LAS unsigned* st) {
    XcdBarrier b; b.bar = bar; b.x = xb_xcc_id(); b.st = st;
    if (threadIdx.x == 0) (void)xb_add(&bar[XB_XCNT(b.x)], 1u);
    return b;
}
__device__ __forceinline__ void xcd_barrier_complete(unsigned* bar, unsigned x, unsigned& nloc, unsigned& nx) {
    const unsigned G = gridDim.x * gridDim.y * gridDim.z;
    unsigned sum, cnt, mine, sp = 0u;
    for (;;) {
        sum = 0u; cnt = 0u; mine = 0u;
#pragma unroll
        for (unsigned j = 0; j < 16; ++j) { const unsigned c = xb_ld(&bar[XB_XCNT(j)]); sum += c; cnt += (c > 0u) ? 1u : 0u; mine = (j == x) ? c : mine; }
        if (sum == G) break;
        __builtin_amdgcn_s_sleep(1);
        if ((++sp & 255u) == 0u) { if (xb_ld(&bar[XB_TMO])) break; if (sp > XB_SPIN_CAP) { atomicAdd(&bar[XB_TMO], 1u); break; } }
    }
    nloc = mine > 0u ? mine : 1u; nx = cnt > 0u ? cnt : 1u;
}

__device__ __forceinline__ void xcd_barrier(const XcdBarrier& b) {
    asm volatile("s_waitcnt vmcnt(0)" ::: "memory");
    __syncthreads();
    if (threadIdx.x == 0) {
        unsigned* bar = b.bar;
        __builtin_amdgcn_s_waitcnt(0);
        unsigned nloc = b.st[0], nx = b.st[1];
        if (nloc == 0u) { xcd_barrier_complete(bar, b.x, nloc, nx); b.st[0] = nloc; b.st[1] = nx; }
        const unsigned old = xb_add(&bar[XB_XSUB(b.x)], 1u);
        const unsigned gen = old / nloc;
        if (old + 1u == (gen + 1u) * nloc) {
            __builtin_amdgcn_fence(__ATOMIC_RELEASE, "agent");
            asm volatile("s_waitcnt vmcnt(0)" ::: "memory");
            const unsigned og = xb_add(&bar[XB_TOP], 1u);
            const unsigned tg = og / nx;
            if (og + 1u == (tg + 1u) * nx) xb_add(&bar[XB_TOPGEN], 1u);
            else XB_SPIN(xb_ld(&bar[XB_TOPGEN]) == tg, bar);
            __builtin_amdgcn_fence(__ATOMIC_ACQUIRE, "agent");
            xb_add(&bar[XB_XGEN(b.x)], 1u);
            asm volatile("s_waitcnt vmcnt(0)" ::: "memory");
        } else {
            XB_SPIN(xb_ld(&bar[XB_XGEN(b.x)]) == gen, bar);
            __builtin_amdgcn_fence(__ATOMIC_ACQUIRE, "agent");
            asm volatile("s_waitcnt vmcnt(0)" ::: "memory");
        }
    }
    __syncthreads();
}

struct Args { const float* in[23]; float* out; unsigned char* ws; int ph_lo, ph_hi, coop, pad; };
typedef const __attribute__((address_space(4))) Args* KArgs;
__device__ __forceinline__ KArgs kargs() { KArgs p = (KArgs)__builtin_amdgcn_kernarg_segment_ptr(); asm volatile("" : "+s"(p)); return p; }
constexpr int N_PHASES = 2 + 7 * DEPTH + 1;

__global__ void __launch_bounds__(512, 2) fwd_kernel(Args a) {
    extern __shared__ __attribute__((aligned(16))) unsigned char lds_raw[];
    LAS unsigned char* lds = (LAS unsigned char*)lds_raw;
    volatile LAS unsigned* bar_st = (volatile LAS unsigned*)(lds + RING_BYTES + 64);
    if (threadIdx.x < 2) bar_st[threadIdx.x] = 0u;
    __syncthreads();
    if (kargs()->coop) (void)xcd_barrier_post((unsigned*)kargs()->ws, bar_st);
    const int ph_lo = kargs()->ph_lo, ph_hi = kargs()->ph_hi;
    for (int ph = ph_lo; ph < ph_hi; ++ph) {
        KArgs ka = kargs();
        const int tid = pg8_ltid(), lane = tid & 63, wave = __builtin_amdgcn_readfirstlane(tid >> 6);
        int G = gridDim.x, bx = blockIdx.x; asm volatile("" : "+s"(G), "+s"(bx));
        const int vcu = (G % 8 == 0) ? (bx % 8) * (G / 8) + bx / 8 : bx;
        const int gw = vcu * 8 + wave, NGW = G * 8;
        unsigned char* ws = ka->ws;
        float* MOD = (float*)(ws + WS_MOD); float* MODP = (float*)(ws + WS_MODP);
        float* tabA = (float*)(ws + WS_TAB); float* tabB = tabA + 128 * 8 * 2;
        float* XCA = (float*)(ws + WS_XC); float* XCB = (float*)(ws + WS_MODP);
        bf16_t* XN = (bf16_t*)(ws + WS_XN); bf16_t* Ob = (bf16_t*)(ws + WS_O); bf16_t* Hb = (bf16_t*)(ws + WS_H); bf16_t* ACT = Hb;
        float* XL = ka->out;
        if (ph == 0) {
          {
            const float* w_mod = ka->in[6]; const float* c_in = ka->in[1]; const float* cctx_in = ka->in[3];
            for (int it = gw; it < 1536; it += NGW) {
                const int ks = it & 15, cgp = (it >> 4) % 24, l = it / 384;
                const int n0 = cgp * 256 + lane * 4;
                f32x4 acc[5];
#pragma unroll
                for (int s = 0; s < 5; ++s) acc[s] = (f32x4){0.f, 0.f, 0.f, 0.f};
                const float* wp = w_mod + ((size_t)l * 1024 + ks * 64) * 6144 + n0;
                for (int kk = 0; kk < 64; ++kk) {
                    const int k = ks * 64 + kk;
                    const f32x4 w = *(const f32x4*)(wp + (size_t)kk * 6144);
#pragma unroll
                    for (int s = 0; s < 4; ++s) acc[s] += silu_f(c_in[s * 1024 + k]) * w;
                    acc[4] += silu_f(cctx_in[k]) * w;
                }
#pragma unroll
                for (int s = 0; s < 5; ++s) *(f32x4*)(MODP + ((size_t)(ks * 4 + l) * 5 + s) * 6144 + n0) = acc[s];
            }
            LAS float* scr = (LAS float*)(lds + wave * 16384);
            for (int it = gw; it < 4 * 6144; it += NGW) {
                const int l = it / 6144; int r = it - l * 6144;
                unsigned char* wl = ws + WS_W + (size_t)l * W_LAYER;
                if (r < 1408) { transpose_item(ka->in[8] + (size_t)l * 1024 * 2816, 1024, 2816, (bf16_t*)wl, 1, scr, r, lane); continue; } r -= 1408;
                if (r < 512) { transpose_item(ka->in[9] + (size_t)l * 1024 * 1024, 1024, 1024, (bf16_t*)(wl + W_OUT_OFF), 0, scr, r, lane); continue; } r -= 512;
                if (r < 2816) { transpose_item(ka->in[18] + (size_t)l * 1024 * 5632, 1024, 5632, (bf16_t*)(wl + W_UP_OFF), 2, scr, r, lane); continue; } r -= 2816;
                transpose_item(ka->in[21] + (size_t)l * 2816 * 1024, 2816, 1024, (bf16_t*)(wl + W_DN_OFF), 0, scr, r, lane);
            }
            for (int idx = vcu * 512 + tid; idx < 3072; idx += G * 512) {
                int pos, i; float e;
                if (idx < 1024) { pos = idx >> 3; i = idx & 7; e = (float)i * 0.125f; } else { const int j = idx - 1024; pos = j >> 4; i = j & 15; e = (float)i * 0.0625f; }
                const float freq = exp2f(-e * 13.287712379549449f);
                const float ang = (float)pos * freq;
                float cc, ss; sincos_f(ang, cc, ss);
                float* tp = (idx < 1024) ? (tabA + idx * 2) : (tabB + (idx - 1024) * 2);
                tp[0] = cc; tp[1] = ss;
            }
          }
        } else if (ph == 1) {
            const float* b_mod = ka->in[7];
            for (int idx = vcu * 512 + tid; idx < 4 * 5 * 6144; idx += G * 512) {
                const int l = idx / 30720, n = idx % 6144;
                float s = b_mod[l * 6144 + n];
#pragma unroll
                for (int ks = 0; ks < 16; ++ks) s += MODP[(size_t)ks * 122880 + idx];
                MOD[idx] = s;
            }
        } else if (ph == N_PHASES - 1) {
            const float* fw = ka->in[22];
            for (int m = gw; m < ML; m += NGW) {
                f32x4* xr = (f32x4*)(XL + (size_t)m * DM) + lane;
                f32x4 v[4]; float s = 0.f;
#pragma unroll
                for (int j = 0; j < 4; ++j) { v[j] = xr[64 * j]; s += (v[j][0] * v[j][0] + v[j][1] * v[j][1]) + (v[j][2] * v[j][2] + v[j][3] * v[j][3]); }
                const float rstd = rsqrtf(wave_sum(s, lane) * (1.f / 1024.f) + 1e-6f);
#pragma unroll
                for (int j = 0; j < 4; ++j) { const f32x4 w = *(const f32x4*)(fw + 4 * (64 * j + lane)); xr[64 * j] = v[j] * rstd * w; }
            }
        } else {
            const int l = (ph - 2) / 7, k = (ph - 2) % 7;
            const bool need_ctx = l < DEPTH - 1;
            const float* modl = MOD + (size_t)l * 5 * 6144;
            unsigned char* wl = ws + WS_W + (size_t)l * W_LAYER;
            const float* srcL = (l == 0) ? ka->in[0] : XL;
            if (k == 0) {
                const float* nw = ka->in[4] + l * 1024;
                for (int m = gw; m < MT; m += NGW) {
                    const bool lat = m < ML; const int slot = lat ? (m >> 13) : 4;
                    if (lat) norm_mod_row(srcL + (size_t)m * DM, nw, modl + slot * 6144, modl + slot * 6144 + 1024, XN + (size_t)m * DM, lane);
                    else {
                        const size_t ro = (size_t)(m - ML) * DM;
                        norm_mod_row((l == 0 ? ka->in[2] : (const float*)XCB) + ro, nw, modl + slot * 6144, modl + slot * 6144 + 1024, XN + (size_t)m * DM, lane,
                                     (const float*)Ob + ro, (l == 0) ? 0 : 11, XCA + ro);
                    }
                }
            } else if (k == 1) {
                pg8::Gemm g{XN, (const bf16_t*)wl, MT, INC, DM, DM}; pg8::StaticOrder S; S.init(MT, INC, G, bx);
                pg8::EpiInProj E{Hb, tabA, tabB};
#ifndef DIS_IN
                pg8::gemm_phase<pg8::EpiInProj, pg8::StaticOrder, true, true>(lds, g, S, E);
#endif
            } else if (k == 2) {
                float lam, ofac;
                {
                    float d1 = 0.f, d2 = 0.f;
                    for (int i = 0; i < 32; ++i) { d1 += ka->in[10][l * 32 + i] * ka->in[11][l * 32 + i]; d2 += ka->in[12][l * 32 + i] * ka->in[13][l * 32 + i]; }
                    const float li = 0.8f - 0.6f * expf(-0.3f * (float)l);
                    lam = expf(d1) - expf(d2) + li;
                    lam = __uint_as_float(__builtin_amdgcn_readfirstlane(__float_as_uint(lam))); ofac = __uint_as_float(__builtin_amdgcn_readfirstlane(__float_as_uint(li)));
                }
                const float* subw = ka->in[14] + l * 64; const float* sink_l = ka->in[15] + l * 4; const float* rpb_l = ka->in[16] + (size_t)l * 4 * 465;
#ifndef DIS_A
                for (int u = vcu; u < 512 + (need_ctx ? 16 : 0); u += G) {
                    const bool cq = u >= 512; const int bh = cq ? (u - 512) : (u >> 5);
                    att::unit_A(cq, lds, Hb, Ob, bh >> 2, bh & 3, u & 31, lam, ofac, subw);
                }
#endif
#ifndef DIS_B
                for (int u = vcu; u < 1024 + (need_ctx ? 32 : 0); u += G) {
                    int mode, ub, uh, ublk; bool redo = true;
                    if (u < 512) { mode = 1; ub = u >> 7; uh = (u >> 6) & 1; ublk = u & 63; redo = att::unit_BC_fast<1>(lds, Hb, Ob, ub, uh, ublk, sink_l, rpb_l); }
                    else if (u < 1024) { const int v = u - 512; mode = 2; ub = v >> 7; uh = (v >> 5) & 3; ublk = v & 31; redo = att::unit_BC_fast<2>(lds, Hb, Ob, ub, uh, ublk, sink_l, rpb_l); }
                    else { const int v = u - 1024, bh = v & 15; if (v < 16) { mode = 3; ub = bh >> 2; uh = (bh >> 1) & 1; ublk = bh & 1; } else { mode = 4; ub = bh >> 2; uh = bh & 3; ublk = 0; } }
                    if (redo) att::unit_BC(mode, lds, Hb, Ob, ub, uh, ublk, sink_l, rpb_l);
                }
#endif
                {
                    const float* cwl = ka->in[17] + (size_t)l * 3 * 256;
                    const int rows = need_ctx ? MT : ML;
                    for (int idx = vcu * 512 + tid; idx < rows * 32; idx += G * 512) {
                        const int row = idx >> 5, c0 = (idx & 31) * 8;
                        int t, len; if (row < ML) { t = row & 8191; len = SEQ; } else { t = (row - ML) & 255; len = CTXL; }
                        const bf16_t* hp = Hb + (size_t)row * INC + 2048 + c0;
                        const u32x4 bg = *(const u32x4*)hp, cg1 = *(const u32x4*)(hp + 256), xi1 = *(const u32x4*)(hp + 512);
                        u32x4 cg0 = {0u, 0u, 0u, 0u}, xi0 = cg0, cg2 = cg0, xi2 = cg0;
                        if (t > 0) { cg0 = *(const u32x4*)(hp - INC + 256); xi0 = *(const u32x4*)(hp - INC + 512); }
                        if (t < len - 1) { cg2 = *(const u32x4*)(hp + INC + 256); xi2 = *(const u32x4*)(hp + INC + 512); }
                        float w0[8], w1[8], w2[8];
#pragma unroll
                        for (int e = 0; e < 8; ++e) { w0[e] = cwl[c0 + e]; w1[e] = cwl[256 + c0 + e]; w2[e] = cwl[512 + c0 + e]; }
                        u32x4 ow;
#pragma unroll
                        for (int e = 0; e < 4; ++e) {
                            const float ylo = w0[2 * e] * bflo(cg0[e]) * bflo(xi0[e]) + w1[2 * e] * bflo(cg1[e]) * bflo(xi1[e]) + w2[2 * e] * bflo(cg2[e]) * bflo(xi2[e]);
                            const float yhi = w0[2 * e + 1] * bfhi(cg0[e]) * bfhi(xi0[e]) + w1[2 * e + 1] * bfhi(cg1[e]) * bfhi(xi1[e]) + w2[2 * e + 1] * bfhi(cg2[e]) * bfhi(xi2[e]);
                            ow[e] = pkbf(bflo(bg[e]) * ylo, bfhi(bg[e]) * yhi);
                        }
                        *(u32x4*)(Ob + (size_t)row * DM + 768 + c0) = ow;
                    }
                }
                __syncthreads();
            } else if (k == 4) {
                const float* nw = ka->in[5] + l * 1024;
                const int nrows = (need_ctx ? NMX_ALL : NMX_L) * 256;
                for (int e = gw; e < nrows; e += NGW) {
                    const int pm = e >> 8, j = e & 255;
                    int t, slot; const float* base; int len;
                    if (pm < NMX_L) { const int s = pm / 33, ti = pm - s * 33; t = 254 * ti - 1 + j; len = SEQ; slot = s; base = XL + (size_t)s * SEQ * DM; }
                    else { const int p = 254 * (pm - NMX_L) - 1 + j; const int sq = (p < 0) ? 0 : p / 257, r = p - sq * 257; t = (p >= 0 && p < 1029 && r != 0) ? (r - 1) : -1; len = CTXL; slot = 4; base = XCA + (size_t)sq * CTXL * DM; }
                    const bool ok = (t >= 0 && t < len);
                    const float* src = ok ? (base + (size_t)t * DM) : nullptr;
                    if (pm < NMX_L || !ok) norm_mod_row(src, nw, modl + slot * 6144 + 3072, modl + slot * 6144 + 4096, XN + (size_t)e * DM, lane);
                    else {
                        const size_t ro = (size_t)(src - XCA);
                        norm_mod_row(src, nw, modl + slot * 6144 + 3072, modl + slot * 6144 + 4096, XN + (size_t)e * DM, lane, (const float*)Hb + ro, 4, XCB + ro);
                    }
                }
            } else if (k == 5) {
                const int nM = need_ctx ? NMX_ALL : NMX_L;
                pg8::Gemm g{XN, (const bf16_t*)(wl + W_UP_OFF), nM * 256, UPC, DM, DM}; pg8::StaticOrder S; S.init(nM * 256, UPC, G, bx);
                pg8::EpiUpConv E{ACT, ka->in[19] + (size_t)l * 3 * UPC, ka->in[20] + (size_t)l * UPC};
                pg8::OneUnit one;
#ifndef DIS_UP
                for (int i = 0; S.next(i, one.u); ++i) pg8::gemm_phase<pg8::EpiUpConv, pg8::OneUnit, false, true>(lds, g, one, E);
#endif
            } else {
                const bool isout = (k == 3); const int KK = isout ? DM : DFF;
                const bf16_t* Ap = isout ? (const bf16_t*)Ob : (const bf16_t*)ACT; const bf16_t* Bp = (const bf16_t*)(wl + (isout ? W_OUT_OFF : W_DN_OFF));
                {
                    pg8::Gemm g{Ap, Bp, ML, DM, KK, KK}; pg8::StaticOrder S; S.init(ML, DM, G, bx);
                    pg8::EpiRes E{isout ? srcL : (const float*)XL, nullptr, XL, nullptr, modl, isout ? 2048 : 5120};
#ifndef DIS_OUT
                    pg8::gemm_phase<pg8::EpiRes, pg8::StaticOrder, true, true>(lds, g, S, E);
#endif
                }
                if (need_ctx) {
                    const int P = isout ? 4 : 11, klen = KK / P;
                    for (int su = bx; su < 16 * P; su += G) {
                        const int tile = su / P, part = su - tile * P;
                        pg8::Gemm gs{Ap + (size_t)ML * KK + part * klen, Bp + part * klen, MC, DM, klen, KK};
                        pg8::OneUnit one; one.u.pm = tile >> 2; one.u.pn = tile & 3;
                        pg8::EpiSlab EA{(isout ? (float*)Hb : (float*)Ob) + (size_t)part * 1024 * 1024, modl + 4 * 6144 + (isout ? 2048 : 5120)};
                        pg8::gemm_phase<pg8::EpiSlab, pg8::OneUnit, false, true>(lds, gs, one, EA);
                    }
                }
            }
        }
        if (ph + 1 < ph_hi && kargs()->coop) {
            if (ph == 0) cg::this_grid().sync();
            else { XcdBarrier b; b.bar = (unsigned*)kargs()->ws; b.x = xb_xcc_id(); b.st = bar_st; xcd_barrier(b); }
        }
    }
}

extern "C" void kernel_launch(void* const* d_in, const int* in_sizes, int n_in, void* d_out, int out_size, void* d_ws, size_t ws_size, hipStream_t stream) {
    static int grid = 0;
    if (grid == 0) {
        if (n_in != 23 || out_size != ML * DM || ws_size < WS_END) { fprintf(stderr, "kernel_launch: unexpected shapes (n_in %d out %d ws %zu need %zu)\n", n_in, out_size, ws_size, (size_t)WS_END); grid = -1; return; }
        int dev = 0, cus = 0, per_cu = 0;
        if (hipGetDevice(&dev) != hipSuccess || hipDeviceGetAttribute(&cus, hipDeviceAttributeMultiprocessorCount, dev) != hipSuccess) { grid = -1; return; }
        if (hipFuncSetAttribute((const void*)fwd_kernel, hipFuncAttributeMaxDynamicSharedMemorySize, LDS_BYTES) != hipSuccess) { fprintf(stderr, "kernel_launch: hipFuncSetAttribute failed\n"); grid = -1; return; }
        if (hipOccupancyMaxActiveBlocksPerMultiprocessor(&per_cu, (const void*)fwd_kernel, 512, LDS_BYTES) != hipSuccess || per_cu < 1) fprintf(stderr, "kernel_launch: occupancy query says %d\n", per_cu);
        (void)hipGetLastError();
        grid = cus;
    }
    if (grid < 0) return;
    Args a{};
    for (int i = 0; i < 23; ++i) a.in[i] = (const float*)d_in[i];
    a.out = (float*)d_out; a.ws = (unsigned char*)d_ws;
#if MK_MULTI
    for (int ph = 0; ph < N_PHASES; ++ph) {
        a.ph_lo = ph; a.ph_hi = ph + 1; a.coop = 0;
        hipLaunchKernelGGL(fwd_kernel, dim3(grid), dim3(512), LDS_BYTES, stream, a);
    }
#else
    a.ph_lo = 0; a.ph_hi = N_PHASES; a.coop = 1;
    if (hipMemsetAsync(d_ws, 0, 16384, stream) != hipSuccess) { fprintf(stderr, "kernel_launch: memset failed\n"); return; }
    void* args[] = {&a};
    hipError_t e = hipLaunchCooperativeKernel((const void*)fwd_kernel, dim3(grid), dim3(512), args, LDS_BYTES, stream);
    if (e != hipSuccess) fprintf(stderr, "cooperative launch failed: %s (grid %d)\n", hipGetErrorString(e), grid);
#endif
}
```

```cpp
#include <hip/hip_runtime.h>
#include <hip/hip_cooperative_groups.h>
#include <cstdio>
#include <cstdint>
namespace cg = cooperative_groups;

#ifndef MK_MULTI
#define MK_MULTI 0
#endif

#ifndef REP_IN
#define REP_IN 1
#endif
#ifndef REP_UP
#define REP_UP 1
#endif
#ifndef REP_A
#define REP_A 1
#endif
#ifndef REP_OD
#define REP_OD 1
#endif
#ifndef REP_P
#define REP_P 1
#endif
#ifndef REP_BC
#define REP_BC 1
#endif
#ifndef REP_M
#define REP_M 1
#endif

__device__ __forceinline__ int pg8_ltid() { int t = threadIdx.x; asm volatile("" : "+v"(t)); return t; }
namespace pg8 {
#define PG8_LAS __attribute__((address_space(3)))
typedef unsigned short bf16_t;
typedef short bf16x8 __attribute__((ext_vector_type(8)));
typedef float f32x4 __attribute__((ext_vector_type(4)));
typedef unsigned u32x4 __attribute__((ext_vector_type(4)));
constexpr int BM = 256, BK = 64, HALF = 128, HTB = HALF * BK * 2  , STAGE_BYTES = 8 * HTB, NXCD = 8, WGM = 8;

__host__ __device__ __forceinline__ int lds_byte(int r, int c) { const int st = (r >> 4) * 2 + (c >> 5), rr = r & 15, cc = c & 31, ob = rr * 64 + cc * 2; return st * 1024 + (ob ^ (((ob >> 9) & 1) << 5)); }
__host__ __device__ __forceinline__ void stage_rc(int b, int& R, int& C) { const int st = b / 1024, sb = b % 1024, swz = sb ^ (((sb >> 9) & 1) << 5); R = (st >> 1) * 16 + swz / 64; C = (st & 1) * 32 + (swz % 64) / 2; }
__host__ __device__ __forceinline__ int perm32(int rho) { const int n = rho >> 4, i = rho & 15; return 8 * (i >> 2) + 4 * n + (i & 3); }

struct Unit { int pm, pn; };
struct Gemm { const bf16_t* A; const bf16_t* Bt; int M, N, K, ldk; };

struct StaticOrder {
    int nM, nN, nwg, G, c;
    __host__ __device__ void init(int M, int N, int G_, int c_) { nM = M / BM; nN = N / BM; nwg = nM * nN; G = G_; c = c_; }
    __host__ __device__ bool next(int i, Unit& u) const {
        const long L = (long)i * G + c; if (L >= nwg) return false;
        int wgid = (int)L; { const int q = nwg / NXCD, r = nwg % NXCD, xcd = wgid % NXCD, off = wgid / NXCD; wgid = (xcd < r ? xcd * (q + 1) : r * (q + 1) + (xcd - r) * q) + off; }
        const int nig = WGM * nN, gid = wgid / nig, fm = gid * WGM, gsz = (nM - fm) < WGM ? (nM - fm) : WGM;
        u.pm = fm + ((wgid % nig) % gsz); u.pn = (wgid % nig) / gsz; return true;
    }
    __device__ __forceinline__ void a_ready(const Unit&) const {}
    __device__ __forceinline__ void done(const Unit&) const {}
};

__device__ __forceinline__ unsigned cvt_pk_bf16(float lo, float hi) { unsigned r; asm volatile("v_cvt_pk_bf16_f32 %0, %1, %2" : "=v"(r) : "v"(lo), "v"(hi)); return r; }
typedef unsigned u32x2 __attribute__((ext_vector_type(2)));

struct OneUnit {
    Unit u;
    __device__ __forceinline__ bool next(int i, Unit& o) const { if (i != 0) return false; o = u; return true; }
    __device__ __forceinline__ void a_ready(const Unit&) const {}
    __device__ __forceinline__ void done(const Unit&) const {}
};

struct EpiInProj {
    static constexpr bool PERM = false, AFTER_DRAIN = false;
    bf16_t* H; const float* tabA; const float* tabB;
    __device__ __forceinline__ void operator()(const f32x4 (&acc)[2][2][4][2], const Unit& u, int wr, int wc, int fr, int fq) const {
        const int pn = u.pn; const bool latent = u.pm < 128;
        const float scale = (pn == 0) ? 0.17677669529663687f * 1.4426950408889634f : ((pn == 3 || pn == 5) ? 0.125f * 1.4426950408889634f : 1.0f);
#pragma unroll
        for (int bj = 0; bj < 2; ++bj) {
            int mode = (pn == 0 || pn == 1) ? 1 : ((pn == 3 || (pn == 4 && bj == 0)) ? 2 : 0);
            if (!latent) mode = 0;
#ifdef TEST_NOROPE
            mode = 0;
#endif
#pragma unroll
            for (int ai = 0; ai < 2; ++ai)
#pragma unroll
                for (int m = 0; m < 4; ++m) {
                    const int r = u.pm * BM + ai * HALF + wr * 64 + m * 16 + fr;
                    f32x4 v0 = acc[ai][bj][m][0], v1 = acc[ai][bj][m][1];
                    if (mode != 0) {
                        const int t = r & 8191, trow = t >> 6, tcol = t & 63;
                        const float* tp;
                        if (mode == 1) { const int pos = (fq < 2) ? trow : tcol; tp = tabA + (pos * 8 + 4 * (fq & 1)) * 2; }
                        else { const int pos = (wc & 1) ? tcol : trow; tp = tabB + (pos * 16 + 4 * fq) * 2; }
                        const f32x4 cs0 = *(const f32x4*)tp, cs1 = *(const f32x4*)(tp + 4);
                        const float c0 = cs0[0], s0 = cs0[1], c1 = cs0[2], s1 = cs0[3], c2 = cs1[0], s2 = cs1[1], c3 = cs1[2], s3 = cs1[3];
                        f32x4 a = v0, b = v1;
                        v0[0] = a[0] * c0 - b[0] * s0; v1[0] = b[0] * c0 + a[0] * s0;
                        v0[1] = a[1] * c1 - b[1] * s1; v1[1] = b[1] * c1 + a[1] * s1;
                        v0[2] = a[2] * c2 - b[2] * s2; v1[2] = b[2] * c2 + a[2] * s2;
                        v0[3] = a[3] * c3 - b[3] * s3; v1[3] = b[3] * c3 + a[3] * s3;
                    }
                    v0 = v0 * scale; v1 = v1 * scale;
                    bf16_t* rowp = H + (size_t)r * 2816 + pn * BM + bj * HALF + wc * 32 + 4 * fq;
                    u32x2 w0, w1; w0.x = cvt_pk_bf16(v0[0], v0[1]); w0.y = cvt_pk_bf16(v0[2], v0[3]); w1.x = cvt_pk_bf16(v1[0], v1[1]); w1.y = cvt_pk_bf16(v1[2], v1[3]);
                    *(u32x2*)rowp = w0; *(u32x2*)(rowp + 16) = w1;
                }
        }
    }
};

struct EpiRes {
    static constexpr bool PERM = false, AFTER_DRAIN = false;
    const float* baseL; const float* baseC; float* outL; float* outC; const float* modl; int goff;
    __device__ __forceinline__ void operator()(const f32x4 (&acc)[2][2][4][2], const Unit& u, int wr, int wc, int fr, int fq) const {
        const bool ctx = u.pm >= 128; const int slot = ctx ? 4 : (u.pm >> 5);
        const int row0 = (ctx ? (u.pm - 128) : u.pm) * BM + wr * 64 + fr;
        const float* bp = ctx ? baseC : baseL; float* op = ctx ? outC : outL;
        const int col0 = u.pn * BM + wc * 32 + 4 * fq;
        f32x4 gv[2][2];
#pragma unroll
        for (int bj = 0; bj < 2; ++bj)
#pragma unroll
            for (int n = 0; n < 2; ++n) gv[bj][n] = *(const f32x4*)(modl + slot * 6144 + goff + col0 + bj * HALF + n * 16);
#pragma unroll
        for (int ai = 0; ai < 2; ++ai)
#pragma unroll
            for (int m = 0; m < 4; ++m) {
                const size_t off = (size_t)(row0 + ai * HALF + m * 16) * 1024 + col0;
#pragma unroll
                for (int bj = 0; bj < 2; ++bj)
#pragma unroll
                    for (int n = 0; n < 2; ++n) {
                        const f32x4 bs = *(const f32x4*)(bp + off + bj * HALF + n * 16);
                        *(f32x4*)(op + off + bj * HALF + n * 16) = bs + gv[bj][n] * acc[ai][bj][m][n];
                    }
                asm volatile("" ::: "memory");
            }
    }
};

struct EpiSlab {
    static constexpr bool PERM = false, AFTER_DRAIN = false;
    float* slab; const float* gate;
    __device__ __forceinline__ void operator()(const f32x4 (&acc)[2][2][4][2], const Unit& u, int wr, int wc, int fr, int fq) const {
        const int row0 = u.pm * BM + wr * 64 + fr, col0 = u.pn * BM + wc * 32 + 4 * fq;
#pragma unroll
        for (int bj = 0; bj < 2; ++bj)
#pragma unroll
            for (int n = 0; n < 2; ++n) {
                const f32x4 gv = *(const f32x4*)(gate + col0 + bj * HALF + n * 16);
#pragma unroll
                for (int ai = 0; ai < 2; ++ai)
#pragma unroll
                    for (int m = 0; m < 4; ++m)
                        *(f32x4*)(slab + (size_t)(row0 + ai * HALF + m * 16) * 1024 + col0 + bj * HALF + n * 16) = gv * acc[ai][bj][m][n];
            }
    }
};

struct EpiUpConv {
    static constexpr bool PERM = false, AFTER_DRAIN = true;
    bf16_t* ACT; const float* cw; const float* cb;
    static constexpr int TP = 520;
    __device__ __forceinline__ void fused(f32x4 (&acc)[2][2][4][2], const Unit& u, int wr, int wc, int fr, int fq, PG8_LAS unsigned char* lds, int wid, int lane) const {
#pragma unroll
        for (int ai = 0; ai < 2; ++ai)
#pragma unroll
            for (int m = 0; m < 4; ++m) {
                const int row = ai * HALF + wr * 64 + m * 16 + fr;
#pragma unroll
                for (int bj = 0; bj < 2; ++bj)
#pragma unroll
                    for (int n = 0; n < 2; ++n) {
                        const f32x4 v = acc[ai][bj][m][n]; u32x2 w; w.x = cvt_pk_bf16(v[0], v[1]); w.y = cvt_pk_bf16(v[2], v[3]);
                        *(PG8_LAS u32x2*)(lds + row * TP + (bj * HALF + wc * 32 + n * 16 + 4 * fq) * 2) = w;
                    }
            }
        const int tid = wid * 64 + lane, ch = tid & 15;
        const int gcol = u.pn * 128 + ch * 8;
        float wg[3][8], wv[3][8], bg[8], bv[8];
#pragma unroll
        for (int k = 0; k < 3; ++k) {
            const f32x4 a0 = *(const f32x4*)(cw + k * 5632 + gcol), a1 = *(const f32x4*)(cw + k * 5632 + gcol + 4);
            const f32x4 b0 = *(const f32x4*)(cw + k * 5632 + 2816 + gcol), b1 = *(const f32x4*)(cw + k * 5632 + 2816 + gcol + 4);
#pragma unroll
            for (int e = 0; e < 4; ++e) { wg[k][e] = a0[e]; wg[k][4 + e] = a1[e]; wv[k][e] = b0[e]; wv[k][4 + e] = b1[e]; }
        }
        {
            const f32x4 a0 = *(const f32x4*)(cb + gcol), a1 = *(const f32x4*)(cb + gcol + 4), b0 = *(const f32x4*)(cb + 2816 + gcol), b1 = *(const f32x4*)(cb + 2816 + gcol + 4);
#pragma unroll
            for (int e = 0; e < 4; ++e) { bg[e] = a0[e]; bg[4 + e] = a1[e]; bv[e] = b0[e]; bv[4 + e] = b1[e]; }
        }
        const bool lat = u.pm < 132; int rowbase, ti;
        if (lat) { const int s = u.pm / 33; ti = u.pm - s * 33; rowbase = s * 8192; } else { ti = u.pm - 132; rowbase = 32768; }
        asm volatile("s_waitcnt lgkmcnt(0)" ::: "memory"); __builtin_amdgcn_s_barrier(); asm volatile("" ::: "memory");
        for (int it = tid; it < 254 * 16; it += 512) {
            const int j = 1 + (it >> 4); const int p = 254 * ti - 1 + j;
            int orow; bool ok;
            if (lat) { ok = p < 8192; orow = rowbase + p; } else { const int sq = p / 257, r = p - sq * 257; ok = (p < 1029) && (r != 0); orow = rowbase + sq * 256 + r - 1; }
            if (ok) {
                float g[8], v[8];
#pragma unroll
                for (int e = 0; e < 8; ++e) { g[e] = bg[e]; v[e] = bv[e]; }
#pragma unroll
                for (int k = 0; k < 3; ++k) {
                    const PG8_LAS unsigned char* rp = lds + (j - 1 + k) * TP + ch * 16;
                    const u32x2 g0 = *(const PG8_LAS u32x2*)rp, g1 = *(const PG8_LAS u32x2*)(rp + 8);
                    const u32x2 v0 = *(const PG8_LAS u32x2*)(rp + 256), v1 = *(const PG8_LAS u32x2*)(rp + 264);
                    const unsigned gw[4] = {g0.x, g0.y, g1.x, g1.y}, vw[4] = {v0.x, v0.y, v1.x, v1.y};
#pragma unroll
                    for (int e = 0; e < 4; ++e) {
                        g[2 * e] += wg[k][2 * e] * __uint_as_float(gw[e] << 16); g[2 * e + 1] += wg[k][2 * e + 1] * __uint_as_float(gw[e] & 0xffff0000u);
                        v[2 * e] += wv[k][2 * e] * __uint_as_float(vw[e] << 16); v[2 * e + 1] += wv[k][2 * e + 1] * __uint_as_float(vw[e] & 0xffff0000u);
                    }
                }
                float o[8];
#pragma unroll
                for (int e = 0; e < 8; ++e) o[e] = g[e] / (1.f + __expf(-g[e])) * v[e];
                u32x4 w; w.x = cvt_pk_bf16(o[0], o[1]); w.y = cvt_pk_bf16(o[2], o[3]); w.z = cvt_pk_bf16(o[4], o[5]); w.w = cvt_pk_bf16(o[6], o[7]);
                *(u32x4*)(ACT + (size_t)orow * 2816 + gcol) = w;
            }
        }
        asm volatile("s_waitcnt lgkmcnt(0)" ::: "memory"); __builtin_amdgcn_s_barrier(); asm volatile("" ::: "memory");
    }
};
template <class Epi, class Sched, bool ALIGN_EPI = false, bool SP2 = false>
__device__ __forceinline__ void gemm_phase(PG8_LAS unsigned char* lds, const Gemm g, const Sched& S, const Epi& E) {
    const int tid = pg8_ltid(), wid = __builtin_amdgcn_readfirstlane(tid >> 6), lane = tid & 63, wr = wid >> 2, wc = wid & 3, fr = lane & 15, fq = lane >> 4;
    const int K = g.ldk, nt = g.K / BK;
    unsigned voffA[2], voffB[2];
#pragma unroll
    for (int i = 0; i < 2; ++i) { int R, C; stage_rc(tid * 16 + i * 8192, R, C); const int Rb = Epi::PERM ? ((R & ~31) + perm32(R & 31)) : R;
        voffA[i] = (unsigned)(R * K + C) * 2u; voffB[i] = (unsigned)(Rb * K + C) * 2u; }
    const size_t kstep = (size_t)(BK * 2);
    const size_t hstep = (size_t)HALF * K * 2;
    const size_t tstep = 2 * hstep;
    const unsigned ldsw = (unsigned)wid * 1024u;
    const int aoff = lds_byte(wr * 64 + fr, fq * 8), boff = lds_byte(wc * 32 + fr, fq * 8);
#define PG8_SA(b, h) (((b) * 2 + (h)) * HTB)
#define PG8_SB(b, h) ((4 + (b) * 2 + (h)) * HTB)
#define PG8_STAGE(bufoff, gbase, voff) do { _Pragma("unroll") for (int _i = 0; _i < 2; ++_i) \
        __builtin_amdgcn_global_load_lds((const unsigned*)((const char*)(gbase) + (voff)[_i]), (PG8_LAS unsigned*)(lds + (bufoff) + ldsw + _i * 8192), 16, 0, 0); } while (0)
#define PG8_LDA(dst, b, h) do { _Pragma("unroll") for (int m = 0; m < 4; ++m) _Pragma("unroll") for (int k = 0; k < 2; ++k) dst[m][k] = *(const PG8_LAS bf16x8*)(lds + PG8_SA(b, h) + aoff + m * 2048 + k * 1024); } while (0)
#define PG8_LDB(dst, b, h) do { _Pragma("unroll") for (int n = 0; n < 2; ++n) _Pragma("unroll") for (int k = 0; k < 2; ++k) dst[n][k] = *(const PG8_LAS bf16x8*)(lds + PG8_SB(b, h) + boff + n * 2048 + k * 1024); } while (0)
#define PG8_MMA(ai, bj, At, Bt) do { __builtin_amdgcn_s_setprio(1); _Pragma("unroll") for (int m = 0; m < 4; ++m) _Pragma("unroll") for (int n = 0; n < 2; ++n) _Pragma("unroll") for (int k = 0; k < 2; ++k) \
        acc[ai][bj][m][n] = __builtin_amdgcn_mfma_f32_16x16x32_bf16(Bt[n][k], At[m][k], acc[ai][bj][m][n], 0, 0, 0); __builtin_amdgcn_s_setprio(0); } while (0)
#define PG8_WAIT_V(n) asm volatile("s_waitcnt vmcnt(" #n ")" ::: "memory")
#define PG8_WAIT_L(n) asm volatile("s_waitcnt lgkmcnt(" #n ")" ::: "memory")
#define PG8_BAR __builtin_amdgcn_s_barrier()
#define PG8_SCHED __builtin_amdgcn_sched_barrier(0)
    Unit cur, nxt; int ui = 0;
    if (!S.next(0, cur)) return;
    f32x4 acc[2][2][4][2];
#pragma unroll
    for (int a = 0; a < 2; ++a)
#pragma unroll
        for (int b = 0; b < 2; ++b)
#pragma unroll
            for (int m = 0; m < 4; ++m)
#pragma unroll
                for (int n = 0; n < 2; ++n) acc[a][b][m][n] = (f32x4){0.f, 0.f, 0.f, 0.f};
    bf16x8 At[4][2], B0[2][2], B1[2][2];
    const char* cA = (const char*)g.A + (size_t)cur.pm * tstep; const char* cB = (const char*)g.Bt + (size_t)cur.pn * tstep;
    S.a_ready(cur);
    if constexpr (SP2) {
        PG8_STAGE(PG8_SB(0, 0), cB, voffB); PG8_STAGE(PG8_SB(0, 1), cB + hstep, voffB); PG8_STAGE(PG8_SA(0, 0), cA, voffA); PG8_STAGE(PG8_SA(0, 1), cA + hstep, voffA);
        if (wr == 1) PG8_BAR;
        PG8_WAIT_V(2); PG8_BAR;
        PG8_STAGE(PG8_SB(1, 0), cB + kstep, voffB); PG8_STAGE(PG8_SA(1, 0), cA + kstep, voffA); PG8_STAGE(PG8_SB(1, 1), cB + hstep + kstep, voffB);
        PG8_WAIT_V(6); PG8_BAR;
    } else {
        PG8_STAGE(PG8_SB(0, 0), cB, voffB); PG8_STAGE(PG8_SA(0, 0), cA, voffA); PG8_STAGE(PG8_SB(0, 1), cB + hstep, voffB); PG8_STAGE(PG8_SA(0, 1), cA + hstep, voffA);
        if (wr == 1) PG8_BAR;
        PG8_WAIT_V(4); PG8_BAR;
        PG8_STAGE(PG8_SB(1, 0), cB + kstep, voffB); PG8_STAGE(PG8_SA(1, 0), cA + kstep, voffA); PG8_STAGE(PG8_SB(1, 1), cB + hstep + kstep, voffB);
        PG8_WAIT_V(6); PG8_BAR;
    }
    for (;;) {
        const bool has_next = S.next(ui + 1, nxt);
        const char* nA = has_next ? (const char*)g.A + (size_t)nxt.pm * tstep : cA; const char* nB = has_next ? (const char*)g.Bt + (size_t)nxt.pn * tstep : cB;
        for (int t = 0; t < nt; t += 2) {
            const bool last = (t == nt - 2);
            const char* a1 = cA + (size_t)(t + 1) * kstep;
            const char* a2 = last ? nA : cA + (size_t)(t + 2) * kstep; const char* b2 = last ? nB : cB + (size_t)(t + 2) * kstep;
            const char* a3 = a2 + kstep; const char* b3 = b2 + kstep;
            if (last && has_next) S.a_ready(nxt);
            if constexpr (SP2) {
            PG8_LDB(B0, 0, 0); PG8_LDB(B1, 0, 1); PG8_SCHED; PG8_LDA(At, 0, 0); PG8_STAGE(PG8_SA(1, 1), a1 + hstep, voffA);
            PG8_WAIT_V(8); PG8_WAIT_L(0); PG8_BAR; PG8_MMA(0, 0, At, B0); PG8_MMA(0, 1, At, B1); PG8_BAR; PG8_SCHED;
            PG8_LDA(At, 0, 1); PG8_STAGE(PG8_SB(0, 0), b2, voffB); PG8_STAGE(PG8_SB(0, 1), b2 + hstep, voffB); PG8_STAGE(PG8_SA(0, 0), a2, voffA);
            PG8_WAIT_V(8); PG8_WAIT_L(0); PG8_BAR; PG8_MMA(1, 0, At, B0); PG8_MMA(1, 1, At, B1); PG8_BAR; PG8_SCHED;
            PG8_LDB(B0, 1, 0); PG8_LDB(B1, 1, 1); PG8_SCHED; PG8_LDA(At, 1, 0); PG8_STAGE(PG8_SA(0, 1), a2 + hstep, voffA);
            PG8_WAIT_V(8); PG8_WAIT_L(0); PG8_BAR; PG8_MMA(0, 0, At, B0); PG8_MMA(0, 1, At, B1); PG8_BAR; PG8_SCHED;
            PG8_LDA(At, 1, 1); PG8_STAGE(PG8_SB(1, 0), b3, voffB); PG8_STAGE(PG8_SB(1, 1), b3 + hstep, voffB); PG8_STAGE(PG8_SA(1, 0), a3, voffA);
            PG8_WAIT_V(8); PG8_WAIT_L(0); PG8_BAR; PG8_MMA(1, 0, At, B0); PG8_MMA(1, 1, At, B1); PG8_BAR; PG8_SCHED;
            } else {
            PG8_LDB(B0, 0, 0); PG8_SCHED; PG8_LDA(At, 0, 0); PG8_STAGE(PG8_SA(1, 1), a1 + hstep, voffA);
            PG8_WAIT_L(8); PG8_BAR; PG8_WAIT_L(0); PG8_MMA(0, 0, At, B0); PG8_BAR; PG8_SCHED;
            PG8_LDB(B1, 0, 1); PG8_STAGE(PG8_SB(0, 0), b2, voffB);
            PG8_BAR; PG8_WAIT_L(0); PG8_MMA(0, 1, At, B1); PG8_BAR;
            PG8_LDA(At, 0, 1); PG8_STAGE(PG8_SA(0, 0), a2, voffA);
            PG8_BAR; PG8_WAIT_L(0); PG8_MMA(1, 0, At, B0); PG8_BAR; PG8_SCHED;
            PG8_STAGE(PG8_SB(0, 1), b2 + hstep, voffB);
            PG8_WAIT_V(6); PG8_BAR; PG8_MMA(1, 1, At, B1); PG8_BAR;
            PG8_LDB(B0, 1, 0); PG8_SCHED; PG8_LDA(At, 1, 0); PG8_STAGE(PG8_SA(0, 1), a2 + hstep, voffA);
            PG8_WAIT_L(8); PG8_BAR; PG8_WAIT_L(0); PG8_MMA(0, 0, At, B0); PG8_BAR; PG8_SCHED;
            PG8_LDB(B1, 1, 1); PG8_STAGE(PG8_SB(1, 0), b3, voffB);
            PG8_BAR; PG8_WAIT_L(0); PG8_MMA(0, 1, At, B1); PG8_BAR;
            PG8_LDA(At, 1, 1); PG8_STAGE(PG8_SA(1, 0), a3, voffA);
            PG8_BAR; PG8_WAIT_L(0); PG8_MMA(1, 0, At, B0); PG8_BAR; PG8_SCHED;
            PG8_STAGE(PG8_SB(1, 1), b3 + hstep, voffB);
            PG8_WAIT_V(6); PG8_BAR; PG8_MMA(1, 1, At, B1); PG8_BAR;
            }
        }
        if constexpr (ALIGN_EPI) { if (wr == 0) PG8_BAR; }
        if constexpr (!Epi::AFTER_DRAIN) { E(acc, cur, wr, wc, fr, fq); S.done(cur); }
        if (!has_next) break;
#pragma unroll
        for (int a = 0; a < 2; ++a)
#pragma unroll
            for (int b = 0; b < 2; ++b)
#pragma unroll
                for (int m = 0; m < 4; ++m)
#pragma unroll
                    for (int n = 0; n < 2; ++n) acc[a][b][m][n] = (f32x4){0.f, 0.f, 0.f, 0.f};
        cur = nxt; cA = nA; cB = nB; ++ui;
        if constexpr (ALIGN_EPI) { if (wr == 1) PG8_BAR; }
    }
    PG8_WAIT_V(0);
    if constexpr (!ALIGN_EPI) { if (wr == 0) PG8_BAR; }
    PG8_BAR;
    if constexpr (Epi::AFTER_DRAIN) { E.fused(acc, cur, wr, wc, fr, fq, lds, wid, lane); S.done(cur); }
#undef PG8_SA
#undef PG8_SB
#undef PG8_STAGE
#undef PG8_LDA
#undef PG8_LDB
#undef PG8_MMA
#undef PG8_WAIT_V
#undef PG8_WAIT_L
#undef PG8_BAR
#undef PG8_SCHED
}
}
#define LAS __attribute__((address_space(3)))
typedef unsigned short bf16_t;
typedef short bf16x8 __attribute__((ext_vector_type(8)));
typedef short s16x4 __attribute__((ext_vector_type(4)));
typedef float f32x4 __attribute__((ext_vector_type(4)));
typedef float f32x16 __attribute__((ext_vector_type(16)));
typedef unsigned u32x4 __attribute__((ext_vector_type(4)));
typedef unsigned u32x2 __attribute__((ext_vector_type(2)));

constexpr int DM = 1024, NB = 4, SEQ = 8192, DEPTH = 4, CTXL = 256;
constexpr int ML = NB * SEQ, MC = NB * CTXL, MT = ML + MC;
constexpr int INC = 2816, DFF = 2816, UPC = 5632;
constexpr int NMX_L = NB * 33, NMX_ALL = NB * 33 + 5;
constexpr float LOG2E = 1.4426950408889634f;

constexpr size_t MiB = 1u << 20;
constexpr size_t WS_MOD = 1 * MiB;
constexpr size_t WS_MODP = 2 * MiB;
constexpr size_t WS_TAB = 10 * MiB;
constexpr size_t WS_XC = 11 * MiB;
constexpr size_t WS_W = 16 * MiB;
constexpr size_t W_LAYER = 24 * MiB, W_OUT_OFF = (size_t)2816 * 1024 * 2, W_UP_OFF = W_OUT_OFF + (size_t)1024 * 1024 * 2, W_DN_OFF = W_UP_OFF + (size_t)5632 * 1024 * 2;
constexpr size_t WS_XN = 112 * MiB;
constexpr size_t WS_O = 182 * MiB;
constexpr size_t WS_H = 248 * MiB;
constexpr size_t WS_END = WS_H + (size_t)MT * 2816 * 2;
static_assert(W_DN_OFF + (size_t)1024 * 2816 * 2 <= W_LAYER, "weights per layer");
static_assert(WS_XN + (size_t)NMX_ALL * 256 * 1024 * 2 <= WS_O && WS_O + (size_t)MT * 1024 * 2 <= WS_H && WS_END <= 512 * MiB, "ws map");

constexpr int RING_BYTES = 135168;
constexpr int LDS_BYTES = 147456;

__device__ __forceinline__ unsigned pkbf(float lo, float hi) { unsigned r; asm volatile("v_cvt_pk_bf16_f32 %0, %1, %2" : "=v"(r) : "v"(lo), "v"(hi)); return r; }
__device__ __forceinline__ float bflo(unsigned w) { return __uint_as_float(w << 16); }
__device__ __forceinline__ float bfhi(unsigned w) { return __uint_as_float(w & 0xffff0000u); }
__device__ __forceinline__ float dpp_add(float v, const int ctrl_sel) {
    int m;
    if (ctrl_sel == 0) m = __builtin_amdgcn_update_dpp(0, __float_as_int(v), 0xB1, 0xF, 0xF, true);
    else if (ctrl_sel == 1) m = __builtin_amdgcn_update_dpp(0, __float_as_int(v), 0x4E, 0xF, 0xF, true);
    else if (ctrl_sel == 2) m = __builtin_amdgcn_update_dpp(0, __float_as_int(v), 0x124, 0xF, 0xF, true);
    else m = __builtin_amdgcn_update_dpp(0, __float_as_int(v), 0x128, 0xF, 0xF, true);
    return v + __int_as_float(m);
}
__device__ __forceinline__ float wave_sum(float v, int lane) {
    v = dpp_add(v, 0); v = dpp_add(v, 1); v = dpp_add(v, 2); v = dpp_add(v, 3);
    v += __int_as_float(__builtin_amdgcn_ds_bpermute((lane ^ 16) << 2, __float_as_int(v)));
    auto rr = __builtin_amdgcn_permlane32_swap(__float_as_uint(v), __float_as_uint(v), false, false);
    return __uint_as_float(rr[0]) + __uint_as_float(rr[1]);
}
__device__ __forceinline__ float xhalf_max(float v) { auto rr = __builtin_amdgcn_permlane32_swap(__float_as_uint(v), __float_as_uint(v), false, false); return fmaxf(__uint_as_float(rr[0]), __uint_as_float(rr[1])); }
__device__ __forceinline__ float xhalf_sum(float v) { auto rr = __builtin_amdgcn_permlane32_swap(__float_as_uint(v), __float_as_uint(v), false, false); return __uint_as_float(rr[0]) + __uint_as_float(rr[1]); }

namespace att {
constexpr int KP = 144, VP = 136;
constexpr int L_KS = 0, L_VT = 64 * KP, L_RPB = L_VT + 64 * VP, L_END = L_RPB + 2048;
__device__ __forceinline__ int crow(int r, int h) { return (r & 3) + 8 * (r >> 2) + 4 * h; }

struct TileRegs { u32x4 k, v; };
__device__ __forceinline__ void tile_gload(TileRegs& R, const bf16_t* H, int krow, int kcol, int vcol, int tid) {
    const int key = tid >> 3, ch = tid & 7;
    const bf16_t* p = H + (size_t)(krow + key) * INC;
    R.k = *(const u32x4*)(p + kcol + 8 * ch); R.v = *(const u32x4*)(p + vcol + 8 * ch);
}
__device__ __forceinline__ void tile_swrite(const TileRegs& R, LAS unsigned char* lds, int tid) {
    const int key = tid >> 3, ch = tid & 7;
    *(LAS u32x4*)(lds + L_KS + key * KP + ch * 16) = R.k;
    LAS unsigned short* vt = (LAS unsigned short*)(lds + L_VT);
#pragma unroll
    for (int j = 0; j < 4; ++j) { const unsigned w = R.v[j]; vt[(8 * ch + 2 * j) * (VP / 2) + key] = (unsigned short)(w & 0xffffu); vt[(8 * ch + 2 * j + 1) * (VP / 2) + key] = (unsigned short)(w >> 16); }
}
template <int KS0, int NKS>
__device__ __forceinline__ f32x16 qk_block(const LAS unsigned char* lds, int kb, int r32, int hh, const bf16x8 (&qf)[4]) {
    f32x16 s = {0.f, 0.f, 0.f, 0.f, 0.f, 0.f, 0.f, 0.f, 0.f, 0.f, 0.f, 0.f, 0.f, 0.f, 0.f, 0.f};
#pragma unroll
    for (int ks = KS0; ks < KS0 + NKS; ++ks) {
        const bf16x8 kf = *(const LAS bf16x8*)(lds + L_KS + (kb * 32 + r32) * KP + ks * 32 + hh * 16);
        s = __builtin_amdgcn_mfma_f32_32x32x16_bf16(kf, qf[ks], s, 0, 0, 0);
    }
    return s;
}
__device__ __forceinline__ void softmax_pv(f32x16 (&s)[2], float& m, float& l, f32x16 (&O)[2], const LAS unsigned char* lds, int r32, int hh) {
    float mx = s[0][0];
#pragma unroll
    for (int r = 1; r < 16; ++r) mx = fmaxf(mx, s[0][r]);
#pragma unroll
    for (int r = 0; r < 16; ++r) mx = fmaxf(mx, s[1][r]);
    mx = xhalf_max(mx);
    __builtin_amdgcn_sched_barrier(0);
    const float mn = fmaxf(m, mx);
    const float alpha = __builtin_amdgcn_exp2f(m - mn);
    m = mn; l *= alpha;
#pragma unroll
    for (int r = 0; r < 16; ++r) { O[0][r] *= alpha; O[1][r] *= alpha; }
    float ps = 0.f;
#pragma unroll
    for (int kb = 0; kb < 2; ++kb)
#pragma unroll
        for (int r = 0; r < 16; ++r) { const float p = __builtin_amdgcn_exp2f(s[kb][r] - mn); s[kb][r] = p; ps += p; }
    l += ps;
    __builtin_amdgcn_sched_barrier(0);
#pragma unroll
    for (int kb = 0; kb < 2; ++kb)
#pragma unroll
        for (int sk = 0; sk < 2; ++sk) {
            __builtin_amdgcn_sched_barrier(0);
            u32x4 pw; pw.x = pkbf(s[kb][8 * sk + 0], s[kb][8 * sk + 1]); pw.y = pkbf(s[kb][8 * sk + 2], s[kb][8 * sk + 3]);
            pw.z = pkbf(s[kb][8 * sk + 4], s[kb][8 * sk + 5]); pw.w = pkbf(s[kb][8 * sk + 6], s[kb][8 * sk + 7]);
            const bf16x8 pf = __builtin_bit_cast(bf16x8, pw);
#pragma unroll
            for (int dvb = 0; dvb < 2; ++dvb) {
                const LAS unsigned char* a = lds + L_VT + (dvb * 32 + r32) * VP + (kb * 32 + 16 * sk + 4 * hh) * 2;
                const s16x4 lo = *(const LAS s16x4*)a, hi = *(const LAS s16x4*)(a + 16);
                const bf16x8 vf = {lo[0], lo[1], lo[2], lo[3], hi[0], hi[1], hi[2], hi[3]};
                O[dvb] = __builtin_amdgcn_mfma_f32_32x32x16_bf16(vf, pf, O[dvb], 0, 0, 0);
            }
        }
}
__device__ __forceinline__ void store_o(const f32x16 (&o)[2], bf16_t* orow, int hh) {
#pragma unroll
    for (int dvb = 0; dvb < 2; ++dvb)
#pragma unroll
        for (int g = 0; g < 4; ++g) {
            u32x2 w; w.x = pkbf(o[dvb][4 * g], o[dvb][4 * g + 1]); w.y = pkbf(o[dvb][4 * g + 2], o[dvb][4 * g + 3]);
            *(u32x2*)(orow + dvb * 32 + 8 * g + 4 * hh) = w;
        }
}

__device__ __forceinline__ void unit_A_safe(const bool CTXQ, LAS unsigned char* lds, const bf16_t* H, bf16_t* Ob, int b, int h, int qb, float lam, float ofac, const float* subw) {
    const int tid = pg8_ltid(), lane = tid & 63, r32 = lane & 31, hh = lane >> 5, wid = tid >> 6;
    const int qrow = CTXQ ? (ML + b * CTXL + wid * 32 + r32) : (b * SEQ + qb * 256 + wid * 32 + r32);
    const int qcol = h * 64, kcol = 256 + h * 64, vcol = 512 + h * 64;
    bf16x8 qf[4];
#pragma unroll
    for (int ks = 0; ks < 4; ++ks) qf[ks] = *(const bf16x8*)(H + (size_t)qrow * INC + qcol + 16 * ks + 8 * hh);
    const int NT = CTXQ ? 4 : 132;
    f32x16 O1[2], O2[2];
#pragma unroll
    for (int r = 0; r < 16; ++r) { O1[0][r] = 0.f; O1[1][r] = 0.f; O2[0][r] = 0.f; O2[1][r] = 0.f; }
    float m1 = -INFINITY, m2 = -INFINITY, l1 = 0.f, l2 = 0.f;
    TileRegs R;
    tile_gload(R, H, CTXQ ? (ML + b * CTXL) : (b * SEQ), kcol, vcol, tid);
    for (int t = 0; t < NT; ++t) {
        __syncthreads();
        tile_swrite(R, lds, tid);
        __syncthreads();
        if (t + 1 < NT) { const int tn = t + 1; const int krow = CTXQ ? (ML + b * CTXL + 64 * tn) : (tn < 128 ? b * SEQ + 64 * tn : ML + b * CTXL + 64 * (tn - 128)); tile_gload(R, H, krow, kcol, vcol, tid); }
        { f32x16 s[2]; s[0] = qk_block<0, 2>(lds, 0, r32, hh, qf); s[1] = qk_block<0, 2>(lds, 1, r32, hh, qf); softmax_pv(s, m1, l1, O1, lds, r32, hh); }
        __builtin_amdgcn_sched_barrier(0);
        { f32x16 s[2]; s[0] = qk_block<2, 2>(lds, 0, r32, hh, qf); s[1] = qk_block<2, 2>(lds, 1, r32, hh, qf); softmax_pv(s, m2, l2, O2, lds, r32, hh); }
        __builtin_amdgcn_sched_barrier(0);
    }
    l1 = xhalf_sum(l1); l2 = xhalf_sum(l2);
    const float i1 = 1.f / l1, i2 = lam / l2;
    float ss = 0.f;
#pragma unroll
    for (int dvb = 0; dvb < 2; ++dvb)
#pragma unroll
        for (int r = 0; r < 16; ++r) { const float o = O1[dvb][r] * i1 - O2[dvb][r] * i2; O1[dvb][r] = o; ss += o * o; }
    ss = xhalf_sum(ss);
    float li_ = ofac; asm volatile("" : "+s"(li_));
    const float rn = rsqrtf(ss * (1.f / 64.f) + 1e-6f) * (1.f - li_);
#pragma unroll
    for (int dvb = 0; dvb < 2; ++dvb)
#pragma unroll
        for (int g = 0; g < 4; ++g) {
            const f32x4 w = *(const f32x4*)(subw + dvb * 32 + 8 * g + 4 * hh);
#pragma unroll
            for (int e = 0; e < 4; ++e) O1[dvb][4 * g + e] *= rn * w[e];
        }
    store_o(O1, Ob + (size_t)qrow * DM + h * 64, hh);
}


constexpr int A_KP = 144, A_VP = 192, A_VOFF = 64 * A_KP, A_BUF = A_VOFF + 64 * A_VP;
constexpr float ATHR = 10.f;
typedef short v4i16_t __attribute__((ext_vector_type(4)));
__device__ __forceinline__ s16x4 vtr(const LAS unsigned char* p) { return __builtin_bit_cast(s16x4, __builtin_amdgcn_ds_read_tr16_b64_v4i16((LAS v4i16_t*)p)); }
__device__ __forceinline__ void tileA_swrite(const TileRegs& R, LAS unsigned char* buf, int tid) {
    const int key = tid >> 3, ch = tid & 7;
    *(LAS u32x4*)(buf + key * A_KP + ch * 16) = R.k;
    *(LAS u32x4*)(buf + A_VOFF + key * A_VP + ch * 16) = R.v;
}
__device__ __forceinline__ float max16(const f32x16& s) {
    float a = fmaxf(fmaxf(s[0], s[1]), s[2]), b = fmaxf(fmaxf(s[3], s[4]), s[5]), c = fmaxf(fmaxf(s[6], s[7]), s[8]), d = fmaxf(fmaxf(s[9], s[10]), s[11]);
    a = fmaxf(fmaxf(a, s[12]), s[13]); b = fmaxf(fmaxf(b, s[14]), s[15]);
    return fmaxf(fmaxf(a, b), fmaxf(c, d));
}
__device__ __forceinline__ float expsum16(f32x16& s) {
    float a = 0.f, b = 0.f, c = 0.f, d = 0.f;
#pragma unroll
    for (int r = 0; r < 16; r += 4) {
        s[r] = __builtin_amdgcn_exp2f(s[r]); s[r + 1] = __builtin_amdgcn_exp2f(s[r + 1]); s[r + 2] = __builtin_amdgcn_exp2f(s[r + 2]); s[r + 3] = __builtin_amdgcn_exp2f(s[r + 3]);
        a += s[r]; b += s[r + 1]; c += s[r + 2]; d += s[r + 3];
    }
    return (a + b) + (c + d);
}
__device__ __forceinline__ bf16x8 packp(const f32x16& s, int sk) {
    u32x4 pw; pw.x = pkbf(s[8 * sk + 0], s[8 * sk + 1]); pw.y = pkbf(s[8 * sk + 2], s[8 * sk + 3]); pw.z = pkbf(s[8 * sk + 4], s[8 * sk + 5]); pw.w = pkbf(s[8 * sk + 6], s[8 * sk + 7]);
    return __builtin_bit_cast(bf16x8, pw);
}
__device__ __forceinline__ void exp16(f32x16& s) {
#pragma unroll
    for (int r = 0; r < 16; ++r) s[r] = __builtin_amdgcn_exp2f(s[r]);
}
constexpr float AREF = 20.f, AGUARD = 60.f;
#ifndef SGB_V
#define SGB_V 5
#endif
template <bool HAVE>
__device__ __forceinline__ void stepA(bf16x8 (&pc)[2][2], const LAS unsigned char* kbuf, int kb, const LAS unsigned char* vb, const LAS unsigned char* qs, int r32, int hh,
                                      float mref1, float mref2, f32x16 (&O1)[2], f32x16 (&O2)[2], f32x16& L1, f32x16& L2, const bf16x8& ones) {
    const LAS unsigned char* kp = kbuf + (kb * 32 + r32) * A_KP + hh * 16;
    const bf16x8 k0 = *(const LAS bf16x8*)(kp), k1 = *(const LAS bf16x8*)(kp + 32), k2 = *(const LAS bf16x8*)(kp + 64), k3 = *(const LAS bf16x8*)(kp + 96);
    const bf16x8 q0 = *(const LAS bf16x8*)(qs), q1 = *(const LAS bf16x8*)(qs + 32), q2 = *(const LAS bf16x8*)(qs + 64), q3 = *(const LAS bf16x8*)(qs + 96);
    bf16x8 vf[2][2];
#pragma unroll
    for (int sk = 0; sk < 2; ++sk)
#pragma unroll
        for (int dvb = 0; dvb < 2; ++dvb) {
            const LAS unsigned char* a = vb + 16 * sk * A_VP + dvb * 64;
            const s16x4 lo = vtr(a), hi = vtr(a + 8 * A_VP);
            vf[sk][dvb] = (bf16x8){lo[0], lo[1], lo[2], lo[3], hi[0], hi[1], hi[2], hi[3]};
        }
    const f32x16 z = {0.f, 0.f, 0.f, 0.f, 0.f, 0.f, 0.f, 0.f, 0.f, 0.f, 0.f, 0.f, 0.f, 0.f, 0.f, 0.f};
    f32x16 s1 = __builtin_amdgcn_mfma_f32_32x32x16_bf16(k0, q0, z, 0, 0, 0);
    f32x16 s2 = __builtin_amdgcn_mfma_f32_32x32x16_bf16(k2, q2, z, 0, 0, 0);
    s1 = __builtin_amdgcn_mfma_f32_32x32x16_bf16(k1, q1, s1, 0, 0, 0);
    s2 = __builtin_amdgcn_mfma_f32_32x32x16_bf16(k3, q3, s2, 0, 0, 0);
#pragma unroll
    for (int sk = 0; sk < 2; ++sk) {
        L1 = __builtin_amdgcn_mfma_f32_32x32x16_bf16(ones, pc[0][sk], L1, 0, 0, 0);
        L2 = __builtin_amdgcn_mfma_f32_32x32x16_bf16(ones, pc[1][sk], L2, 0, 0, 0);
#pragma unroll
        for (int dvb = 0; dvb < 2; ++dvb) {
            O1[dvb] = __builtin_amdgcn_mfma_f32_32x32x16_bf16(vf[sk][dvb], pc[0][sk], O1[dvb], 0, 0, 0);
            O2[dvb] = __builtin_amdgcn_mfma_f32_32x32x16_bf16(vf[sk][dvb], pc[1][sk], O2[dvb], 0, 0, 0);
        }
    }
    if (HAVE) {
#pragma unroll
        for (int r = 0; r < 16; ++r) { s1[r] -= mref1; s2[r] -= mref2; }
    }
    exp16(s1); exp16(s2);
    bf16x8 pn[2][2];
    pn[0][0] = packp(s1, 0); pn[0][1] = packp(s1, 1); pn[1][0] = packp(s2, 0); pn[1][1] = packp(s2, 1);
#ifndef EXP_NOSGB
    __builtin_amdgcn_sched_group_barrier(0x008, 6, 0);
#pragma unroll
    for (int i = 0; i < 10; ++i) { __builtin_amdgcn_sched_group_barrier(0x002, SGB_V, 0); __builtin_amdgcn_sched_group_barrier(0x008, 1, 0); }
    __builtin_amdgcn_sched_group_barrier(0x002, 48, 0);
#endif
    pc[0][0] = pn[0][0]; pc[0][1] = pn[0][1]; pc[1][0] = pn[1][0]; pc[1][1] = pn[1][1];
}
__device__ __forceinline__ void unit_A(const bool CTXQ, LAS unsigned char* lds, const bf16_t* H, bf16_t* Ob, int b, int h, int qb, float lam, float ofac, const float* subw) {
    const int tid = pg8_ltid(), lane = tid & 63, r32 = lane & 31, hh = lane >> 5, wid = tid >> 6;
    const int qrow = CTXQ ? (ML + b * CTXL + wid * 32 + r32) : (b * SEQ + qb * 256 + wid * 32 + r32);
    const int qcol = h * 64, kcol = 256 + h * 64, vcol = 512 + h * 64;
    const int NT = CTXQ ? 4 : 132;
    f32x16 O1[2], O2[2], L1, L2;
#pragma unroll
    for (int r = 0; r < 16; ++r) { O1[0][r] = 0.f; O1[1][r] = 0.f; O2[0][r] = 0.f; O2[1][r] = 0.f; L1[r] = 0.f; L2[r] = 0.f; }
    const bf16x8 ones = {0x3F80, 0x3F80, 0x3F80, 0x3F80, 0x3F80, 0x3F80, 0x3F80, 0x3F80};
    const int voff = A_VOFF + (4 * hh + ((lane & 15) >> 2)) * A_VP + (((lane >> 4) & 1) * 16 + (lane & 3) * 4) * 2;
    const int krow0 = CTXQ ? (ML + b * CTXL) : (b * SEQ);
    LAS unsigned char* qs = lds + 3 * A_BUF + (wid * 32 + r32) * A_KP + hh * 16;
    volatile LAS unsigned* flag = (volatile LAS unsigned*)(lds + RING_BYTES + 128);
    TileRegs R;
    __syncthreads();
    if (tid == 0) *flag = 0u;
#pragma unroll
    for (int ks = 0; ks < 4; ++ks) *(LAS bf16x8*)(qs + ks * 32) = *(const bf16x8*)(H + (size_t)qrow * INC + qcol + 16 * ks + 8 * hh);
    tile_gload(R, H, krow0, kcol, vcol, tid);       tileA_swrite(R, lds, tid);
    tile_gload(R, H, krow0 + 64, kcol, vcol, tid);  tileA_swrite(R, lds + A_BUF, tid);
    tile_gload(R, H, krow0 + 128, kcol, vcol, tid);
    __syncthreads();
    bf16x8 pc[2][2];
    {
        const LAS unsigned char* kp = lds + r32 * A_KP + hh * 16;
        const f32x16 z = {0.f, 0.f, 0.f, 0.f, 0.f, 0.f, 0.f, 0.f, 0.f, 0.f, 0.f, 0.f, 0.f, 0.f, 0.f, 0.f};
        f32x16 sa1 = __builtin_amdgcn_mfma_f32_32x32x16_bf16(*(const LAS bf16x8*)(kp), *(const LAS bf16x8*)(qs), z, 0, 0, 0);
        sa1 = __builtin_amdgcn_mfma_f32_32x32x16_bf16(*(const LAS bf16x8*)(kp + 32), *(const LAS bf16x8*)(qs + 32), sa1, 0, 0, 0);
        f32x16 sa2 = __builtin_amdgcn_mfma_f32_32x32x16_bf16(*(const LAS bf16x8*)(kp + 64), *(const LAS bf16x8*)(qs + 64), z, 0, 0, 0);
        sa2 = __builtin_amdgcn_mfma_f32_32x32x16_bf16(*(const LAS bf16x8*)(kp + 96), *(const LAS bf16x8*)(qs + 96), sa2, 0, 0, 0);
        const float mx1 = xhalf_max(max16(sa1)), mx2 = xhalf_max(max16(sa2));
        if (__any((fabsf(mx1) > AREF) || (fabsf(mx2) > AREF)) != 0) *flag = 1u;
        exp16(sa1); exp16(sa2);
        pc[0][0] = packp(sa1, 0); pc[0][1] = packp(sa1, 1); pc[1][0] = packp(sa2, 0); pc[1][1] = packp(sa2, 1);
    }
    int bc = 0, t = 0;
#define UNITA_STAGE() \
        const int bn = (bc == 2 * A_BUF) ? 0 : bc + A_BUF, bw = (bn == 2 * A_BUF) ? 0 : bn + A_BUF; \
        if (t + 2 < NT) { \
            tileA_swrite(R, lds + bw, tid); \
            if (t + 3 < NT) { const int tn = t + 3; const int krow = CTXQ ? (krow0 + 64 * tn) : (tn < 128 ? b * SEQ + 64 * tn : ML + b * CTXL + 64 * (tn - 128)); tile_gload(R, H, krow, kcol, vcol, tid); } \
        }
#define UNITA_GUARD() (__any((L1[0] > 1.152921504606846976e18f) || (L2[0] > 1.152921504606846976e18f)) != 0)
    unsigned fl = 0u;
    {
        for (; t < NT; ++t) {
            if (__builtin_expect(fl != 0u, 0)) break;
            fl = *flag;
            if (__builtin_expect(UNITA_GUARD(), 0)) *flag = 1u;
            UNITA_STAGE()
            stepA<false>(pc, lds + bc, 1, lds + bc + voff, qs, r32, hh, 0.f, 0.f, O1, O2, L1, L2, ones);
            stepA<false>(pc, lds + bn, 0, lds + bc + voff + 32 * A_VP, qs, r32, hh, 0.f, 0.f, O1, O2, L1, L2, ones);
            __syncthreads();
            bc = bn;
        }
    }
#undef UNITA_STAGE
#undef UNITA_GUARD
    if (*flag != 0u) { unit_A_safe(CTXQ, lds, H, Ob, b, h, qb, lam, ofac, subw); return; }
    const float i1 = 1.f / L1[0], i2 = lam / L2[0];
    float ss = 0.f;
#pragma unroll
    for (int dvb = 0; dvb < 2; ++dvb)
#pragma unroll
        for (int r = 0; r < 16; ++r) { const float o = O1[dvb][r] * i1 - O2[dvb][r] * i2; O1[dvb][r] = o; ss += o * o; }
    ss = xhalf_sum(ss);
    float li_ = ofac; asm volatile("" : "+s"(li_));
    const float rn = rsqrtf(ss * (1.f / 64.f) + 1e-6f) * (1.f - li_);
#pragma unroll
    for (int dvb = 0; dvb < 2; ++dvb)
#pragma unroll
        for (int g = 0; g < 4; ++g) {
            const f32x4 w = *(const f32x4*)(subw + dvb * 32 + 8 * g + 4 * hh);
#pragma unroll
            for (int e = 0; e < 4; ++e) O1[dvb][4 * g + e] *= rn * w[e];
        }
    store_o(O1, Ob + (size_t)qrow * DM + h * 64, hh);
}

template <int MODE> __device__ __forceinline__ int tile_row_f(int t, int b, int lo, int nloc) {
    if (MODE == 1) return (t < nloc) ? (b * SEQ + 64 * (lo + t)) : (ML + b * CTXL + 64 * (t - nloc));
    if (MODE == 2) return (t < 4) ? (ML + b * CTXL + 64 * t) : (b * SEQ + 64 * (lo + t - 4));
    return ML + b * CTXL + 64 * t;
}
__device__ __forceinline__ int tile_row_r(int MODE, int t, int b, int lo, int nloc) {
    if (MODE == 1) return (t < nloc) ? (b * SEQ + 64 * (lo + t)) : (ML + b * CTXL + 64 * (t - nloc));
    if (MODE == 2) return (t < 4) ? (ML + b * CTXL + 64 * t) : (b * SEQ + 64 * (lo + t - 4));
    return ML + b * CTXL + 64 * t;
}
__device__ __forceinline__ void unit_BC(const int MODE, LAS unsigned char* lds, const bf16_t* H, bf16_t* Ob, int b, int hd, int blk, const float* sink_l, const float* rpb_l) {
    const int tid = pg8_ltid(), lane = tid & 63, r32 = lane & 31, hh = lane >> 5, wid = tid >> 6;
    int qrow, qcol, kcol, vcol, ocol, qpos = 0, r_w = 0, qc = 0, lo = 0, nloc = 0;
    float m = -INFINITY, l = 0.f;
    if (MODE == 1) {
        const int g = wid >> 2, head = hd * 2 + g; qpos = 128 * blk + 32 * (wid & 3) + r32; qrow = b * SEQ + qpos;
        qcol = 768 + head * 64; kcol = 1024 + hd * 64; vcol = 1152 + hd * 64; ocol = 256 + head * 64;
        lo = 2 * blk - 2; if (lo < 0) lo = 0; int hi = 2 * blk + 3; if (hi > 127) hi = 127; nloc = hi - lo + 1;
        m = sink_l[head] * LOG2E; l = (hh == 0) ? 1.f : 0.f;
    } else if (MODE == 3) {
        const int head = hd * 2 + blk; qrow = ML + b * CTXL + wid * 32 + r32;
        qcol = 768 + head * 64; kcol = 1024 + hd * 64; vcol = 1152 + hd * 64; ocol = 256 + head * 64;
        m = sink_l[head] * LOG2E; l = (hh == 0) ? 1.f : 0.f;
    } else if (MODE == 2) {
        r_w = 4 * blk + (wid >> 1); qc = 32 * (wid & 1) + r32; qrow = b * SEQ + r_w * 64 + qc;
        qcol = 1280 + hd * 64; kcol = 1536 + hd * 64; vcol = 1792 + hd * 64; ocol = 512 + hd * 64;
        int a0 = 4 * blk - 4; if (a0 < 0) a0 = 0; if (a0 > 120) a0 = 120; int a3 = 4 * blk + 3 - 4; if (a3 < 0) a3 = 0; if (a3 > 120) a3 = 120;
        lo = a0; nloc = a3 + 7 - a0 + 1;
    } else {
        qrow = ML + b * CTXL + wid * 32 + r32;
        qcol = 1280 + hd * 64; kcol = 1536 + hd * 64; vcol = 1792 + hd * 64; ocol = 512 + hd * 64;
    }
    bf16x8 qf[4];
#pragma unroll
    for (int ks = 0; ks < 4; ++ks) qf[ks] = *(const bf16x8*)(H + (size_t)qrow * INC + qcol + 16 * ks + 8 * hh);
    f32x16 O[2];
#pragma unroll
    for (int r = 0; r < 16; ++r) { O[0][r] = 0.f; O[1][r] = 0.f; }
    const int NT = 4 + nloc;
    int rs = 0;
    if (MODE == 2) { rs = r_w - 4; if (rs < 0) rs = 0; if (rs > 120) rs = 120; }
    const LAS float* rpbs = (const LAS float*)(lds + L_RPB);
    TileRegs R;
    tile_gload(R, H, tile_row_r(MODE, 0, b, lo, nloc), kcol, vcol, tid);
    for (int t = 0; t < NT; ++t) {
        __syncthreads();
        tile_swrite(R, lds, tid);
        if (MODE == 2 && t == 0) { for (int i = tid; i < 465; i += 512) ((LAS float*)(lds + L_RPB))[i] = rpb_l[hd * 465 + i] * LOG2E; }
        __syncthreads();
        if (t + 1 < NT) tile_gload(R, H, tile_row_r(MODE, t + 1, b, lo, nloc), kcol, vcol, tid);
        bool active = true; int kr = 0;
        if (MODE == 2 && t >= 4) { kr = lo + t - 4; active = (kr >= rs) && (kr < rs + 8); }
        if (active) {
            f32x16 s[2]; s[0] = qk_block<0, 4>(lds, 0, r32, hh, qf); s[1] = qk_block<0, 4>(lds, 1, r32, hh, qf);
            if (MODE == 1 && t < nloc) {
                const int kbase = 64 * (lo + t) - qpos;
#pragma unroll
                for (int kb = 0; kb < 2; ++kb)
#pragma unroll
                    for (int r = 0; r < 16; ++r) { const int d = kbase + kb * 32 + crow(r, hh); if (d > 128 || d < -128) s[kb][r] = -INFINITY; }
            }
            if (MODE == 2 && t >= 4) {
                int cs = qc - 8; if (cs < 0) cs = 0; if (cs > 48) cs = 48;
                const int bbase = (kr - r_w + 7) * 31 + 15 - qc;
#pragma unroll
                for (int kb = 0; kb < 2; ++kb)
#pragma unroll
                    for (int r = 0; r < 16; ++r) {
                        const int kc = kb * 32 + crow(r, hh);
                        const bool ok = (kc >= cs) && (kc < cs + 16);
                        int bi = bbase + kc; bi = ok ? bi : 0;
                        const float bias = rpbs[bi];
                        s[kb][r] = ok ? (s[kb][r] + bias) : -INFINITY;
                    }
            }
            softmax_pv(s, m, l, O, lds, r32, hh);
        }
    }
    l = xhalf_sum(l);
    const float il = 1.f / l;
#pragma unroll
    for (int r = 0; r < 16; ++r) { O[0][r] *= il; O[1][r] *= il; }
    store_o(O, Ob + (size_t)qrow * DM + ocol, hh);
}

template <int MODE>
__device__ __forceinline__ void bcf_compute(const LAS unsigned char* cur, int t, int nloc, int lo, int qpos, int kr, int r_w, int qc, const bf16x8 (&qf)[4], f32x16 (&O)[2], f32x16& L,
                                            const bf16x8& ones, const LAS float* rpbs, int voff, int r32, int hh) {
    f32x16 s[2];
    const f32x16 z = {0.f, 0.f, 0.f, 0.f, 0.f, 0.f, 0.f, 0.f, 0.f, 0.f, 0.f, 0.f, 0.f, 0.f, 0.f, 0.f};
#pragma unroll
    for (int kb = 0; kb < 2; ++kb) {
        const LAS unsigned char* kp = cur + (kb * 32 + r32) * A_KP + hh * 16;
        s[kb] = __builtin_amdgcn_mfma_f32_32x32x16_bf16(*(const LAS bf16x8*)(kp), qf[0], z, 0, 0, 0);
        s[kb] = __builtin_amdgcn_mfma_f32_32x32x16_bf16(*(const LAS bf16x8*)(kp + 32), qf[1], s[kb], 0, 0, 0);
        s[kb] = __builtin_amdgcn_mfma_f32_32x32x16_bf16(*(const LAS bf16x8*)(kp + 64), qf[2], s[kb], 0, 0, 0);
        s[kb] = __builtin_amdgcn_mfma_f32_32x32x16_bf16(*(const LAS bf16x8*)(kp + 96), qf[3], s[kb], 0, 0, 0);
    }
    if (MODE == 1 && t < nloc) {
        const int kbase = 64 * (lo + t) - qpos;
#pragma unroll
        for (int kb = 0; kb < 2; ++kb)
#pragma unroll
            for (int r = 0; r < 16; ++r) { const int d = kbase + kb * 32 + crow(r, hh); if (d > 128 || d < -128) s[kb][r] = -INFINITY; }
    }
    if (MODE == 2 && t >= 4) {
        int cs = qc - 8; if (cs < 0) cs = 0; if (cs > 48) cs = 48;
        const int bbase = (kr - r_w + 7) * 31 + 15 - qc;
#pragma unroll
        for (int kb = 0; kb < 2; ++kb)
#pragma unroll
            for (int r = 0; r < 16; ++r) {
                const int kc = kb * 32 + crow(r, hh);
                const bool ok = (kc >= cs) && (kc < cs + 16);
                int bi = bbase + kc; bi = ok ? bi : 0;
                const float bias = rpbs[bi];
                s[kb][r] = ok ? (s[kb][r] + bias) : -INFINITY;
            }
    }
#pragma unroll
    for (int kb = 0; kb < 2; ++kb) {
        exp16(s[kb]);
#pragma unroll
        for (int sk = 0; sk < 2; ++sk) {
            const bf16x8 p = packp(s[kb], sk);
            L = __builtin_amdgcn_mfma_f32_32x32x16_bf16(ones, p, L, 0, 0, 0);
#pragma unroll
            for (int dvb = 0; dvb < 2; ++dvb) {
                const LAS unsigned char* a = cur + voff + (kb * 32 + 16 * sk) * A_VP + dvb * 64;
                const s16x4 vlo = vtr(a), vhi = vtr(a + 8 * A_VP);
                const bf16x8 vf = {vlo[0], vlo[1], vlo[2], vlo[3], vhi[0], vhi[1], vhi[2], vhi[3]};
                O[dvb] = __builtin_amdgcn_mfma_f32_32x32x16_bf16(vf, p, O[dvb], 0, 0, 0);
            }
        }
    }
}
template <int MODE>
__device__ __forceinline__ bool unit_BC_fast(LAS unsigned char* lds, const bf16_t* H, bf16_t* Ob, int b, int hd, int blk, const float* sink_l, const float* rpb_l) {
    const int tid = pg8_ltid(), lane = tid & 63, r32 = lane & 31, hh = lane >> 5, wid = tid >> 6;
    int qrow, qcol, kcol, vcol, ocol, qpos = 0, r_w = 0, qc = 0, lo = 0, nloc = 0;
    float linit = 0.f;
    if (MODE == 1) {
        const int g = wid >> 2, head = hd * 2 + g; qpos = 128 * blk + 32 * (wid & 3) + r32; qrow = b * SEQ + qpos;
        qcol = 768 + head * 64; kcol = 1024 + hd * 64; vcol = 1152 + hd * 64; ocol = 256 + head * 64;
        lo = 2 * blk - 2; if (lo < 0) lo = 0; int hi = 2 * blk + 3; if (hi > 127) hi = 127; nloc = hi - lo + 1;
        linit = __builtin_amdgcn_exp2f(sink_l[head] * LOG2E);
    } else if (MODE == 3) {
        const int head = hd * 2 + blk; qrow = ML + b * CTXL + wid * 32 + r32;
        qcol = 768 + head * 64; kcol = 1024 + hd * 64; vcol = 1152 + hd * 64; ocol = 256 + head * 64;
        linit = __builtin_amdgcn_exp2f(sink_l[head] * LOG2E);
    } else if (MODE == 2) {
        r_w = 4 * blk + (wid >> 1); qc = 32 * (wid & 1) + r32; qrow = b * SEQ + r_w * 64 + qc;
        qcol = 1280 + hd * 64; kcol = 1536 + hd * 64; vcol = 1792 + hd * 64; ocol = 512 + hd * 64;
        int a0 = 4 * blk - 4; if (a0 < 0) a0 = 0; if (a0 > 120) a0 = 120; int a3 = 4 * blk + 3 - 4; if (a3 < 0) a3 = 0; if (a3 > 120) a3 = 120;
        lo = a0; nloc = a3 + 7 - a0 + 1;
    } else {
        qrow = ML + b * CTXL + wid * 32 + r32;
        qcol = 1280 + hd * 64; kcol = 1536 + hd * 64; vcol = 1792 + hd * 64; ocol = 512 + hd * 64;
    }
    bf16x8 qf[4];
#pragma unroll
    for (int ks = 0; ks < 4; ++ks) qf[ks] = *(const bf16x8*)(H + (size_t)qrow * INC + qcol + 16 * ks + 8 * hh);
    f32x16 O[2], L;
#pragma unroll
    for (int r = 0; r < 16; ++r) { O[0][r] = 0.f; O[1][r] = 0.f; L[r] = linit; }
    const bf16x8 ones = {0x3F80, 0x3F80, 0x3F80, 0x3F80, 0x3F80, 0x3F80, 0x3F80, 0x3F80};
    const int NT = 4 + nloc;
    int rs = 0;
    if (MODE == 2) { rs = r_w - 4; if (rs < 0) rs = 0; if (rs > 120) rs = 120; }
    const int voff = A_VOFF + (4 * hh + ((lane & 15) >> 2)) * A_VP + (((lane >> 4) & 1) * 16 + (lane & 3) * 4) * 2;
    LAS float* rpbs = (LAS float*)(lds + 2 * A_BUF);
    volatile LAS unsigned* flag = (volatile LAS unsigned*)(lds + RING_BYTES + 128);
    TileRegs Ra, Rb;
    __syncthreads();
    if (tid == 0) *flag = 0u;
    if (MODE == 2) { for (int i = tid; i < 465; i += 512) rpbs[i] = rpb_l[hd * 465 + i] * LOG2E; }
    tile_gload(Ra, H, tile_row_f<MODE>(0, b, lo, nloc), kcol, vcol, tid);
    tileA_swrite(Ra, lds, tid);
    tile_gload(Rb, H, tile_row_f<MODE>(1, b, lo, nloc), kcol, vcol, tid);
    tile_gload(Ra, H, tile_row_f<MODE>(2, b, lo, nloc), kcol, vcol, tid);
    __syncthreads();
#define BCF_TILE(T, RS) { \
        const int t = (T); \
        const LAS unsigned char* cur = lds + (t & 1) * A_BUF; \
        if (t + 1 < NT) { \
            tileA_swrite(RS, lds + ((t + 1) & 1) * A_BUF, tid); \
            if (t + 3 < NT) tile_gload(RS, H, tile_row_f<MODE>(t + 3, b, lo, nloc), kcol, vcol, tid); \
        } \
        bool active = true; int kr = 0; \
        if (MODE == 2 && t >= 4) { kr = lo + t - 4; active = (kr >= rs) && (kr < rs + 8); } \
        if (active) bcf_compute<MODE>(cur, t, nloc, lo, qpos, kr, r_w, qc, qf, O, L, ones, rpbs, voff, r32, hh); \
        __syncthreads(); }
    for (int t2 = 0; t2 < NT; t2 += 2) {
        BCF_TILE(t2, Rb)
        if (t2 + 1 < NT) BCF_TILE(t2 + 1, Ra)
    }
#undef BCF_TILE
    const float lsum = L[0];
    if (__any(!((lsum > 1e-30f) && (lsum < 1e30f))) != 0) *flag = 1u;
    __syncthreads();
    if (*flag != 0u) return true;
    const float il = 1.f / lsum;
#pragma unroll
    for (int r = 0; r < 16; ++r) { O[0][r] *= il; O[1][r] *= il; }
    store_o(O, Ob + (size_t)qrow * DM + ocol, hh);
    return false;
}
}
__device__ __forceinline__ float silu_f(float v) { return v / (1.f + __expf(-v)); }

__device__ __forceinline__ int wrow_map(int type, int n) {
    if (type == 1) { if (n < 512) { const int p = n & 31, blk = p >> 3; const int np = (blk == 1) ? p + 8 : ((blk == 2) ? p - 8 : p); return (n & ~31) + np; } return n; }
    if (type == 2) { const int half = (n >= 2816) ? 1 : 0; const int j = n - half * 2816; return (j >> 7) * 256 + half * 128 + (j & 127); }
    return n;
}
__device__ __forceinline__ void transpose_item(const float* W, int K, int N, bf16_t* WT, int type, LAS float* scr, int item, int lane) {
    const int nblk = N / 32, kb = item / nblk, nb = item - kb * nblk, k0 = 64 * kb, n0 = 32 * nb;
#pragma unroll 8
    for (int i = 0; i < 32; ++i) { const int kk = 2 * i + (lane >> 5); scr[kk * 33 + (lane & 31)] = W[(size_t)(k0 + kk) * N + n0 + (lane & 31)]; }
    asm volatile("s_waitcnt lgkmcnt(0)" ::: "memory");
    const int c = lane & 7;
#pragma unroll
    for (int j = 0; j < 4; ++j) {
        const int n = (lane >> 3) + 8 * j; const LAS float* s = scr + (8 * c) * 33 + n;
        u32x4 o; o.x = pkbf(s[0 * 33], s[1 * 33]); o.y = pkbf(s[2 * 33], s[3 * 33]); o.z = pkbf(s[4 * 33], s[5 * 33]); o.w = pkbf(s[6 * 33], s[7 * 33]);
        *(u32x4*)(WT + (size_t)wrow_map(type, n0 + n) * K + k0 + 8 * c) = o;
    }
    asm volatile("s_waitcnt lgkmcnt(0)" ::: "memory");
}

__device__ __forceinline__ void sincos_f(float x, float& c, float& s) {
    const float k = rintf(x * 0.636619772f);
    float r = fmaf(-k, 1.57079625129699707031f, x); r = fmaf(-k, 7.54978941586159635335e-08f, r);
    const float r2 = r * r;
    const float sr = r * (1.f + r2 * (-1.f / 6 + r2 * (1.f / 120 + r2 * (-1.f / 5040 + r2 * (1.f / 362880)))));
    const float cr = 1.f + r2 * (-0.5f + r2 * (1.f / 24 + r2 * (-1.f / 720 + r2 * (1.f / 40320 + r2 * (-1.f / 3628800)))));
    const int q = ((int)k) & 3;
    s = (q == 0) ? sr : (q == 1) ? cr : (q == 2) ? -sr : -cr;
    c = (q == 0) ? cr : (q == 1) ? -sr : (q == 2) ? -cr : sr;
}

__device__ __forceinline__ void norm_mod_row(const float* src, const float* nw, const float* sh, const float* sc, bf16_t* dst, int lane, const float* slab = nullptr, int nslab = 0, float* xout = nullptr) {
    u32x2* o8 = (u32x2*)dst + lane;
    if (src == nullptr) {
#pragma unroll
        for (int j = 0; j < 4; ++j) o8[64 * j] = (u32x2){0u, 0u};
        return;
    }
    const f32x4* xr = (const f32x4*)src + lane;
    f32x4 v[4]; float s = 0.f;
#pragma unroll
    for (int j = 0; j < 4; ++j) v[j] = xr[64 * j];
    for (int p = 0; p < nslab; ++p) {
        const f32x4* sr = (const f32x4*)(slab + (size_t)p * 1024 * 1024) + lane;
#pragma unroll
        for (int j = 0; j < 4; ++j) v[j] += sr[64 * j];
    }
    if (xout != nullptr) {
#pragma unroll
        for (int j = 0; j < 4; ++j) ((f32x4*)xout + lane)[64 * j] = v[j];
    }
#pragma unroll
    for (int j = 0; j < 4; ++j) s += (v[j][0] * v[j][0] + v[j][1] * v[j][1]) + (v[j][2] * v[j][2] + v[j][3] * v[j][3]);
    const float rstd = rsqrtf(wave_sum(s, lane) * (1.f / 1024.f) + 1e-6f);
#pragma unroll
    for (int j = 0; j < 4; ++j) {
        const int k = 4 * (64 * j + lane);
        const f32x4 w = *(const f32x4*)(nw + k), a = *(const f32x4*)(sc + k), d = *(const f32x4*)(sh + k);
        f32x4 y;
#pragma unroll
        for (int e = 0; e < 4; ++e) y[e] = (v[j][e] * rstd * w[e]) * (1.f + a[e]) + d[e];
        u32x2 p; p.x = pkbf(y[0], y[1]); p.y = pkbf(y[2], y[3]);
        o8[64 * j] = p;
    }
}

#define XB_TMO      128
#define XB_XCNT(j)  (256  + 64 * (j))
#define XB_XSUB(j)  (1280 + 64 * (j))
#define XB_XGEN(j)  (2304 + 64 * (j))
#define XB_TOP      3328
#define XB_TOPGEN   3392
#define XCD_BAR_WORDS 3456
#define XB_SPIN_CAP (1u << 18)

__device__ __forceinline__ unsigned xb_ld(unsigned* p)              { return __hip_atomic_load(p, __ATOMIC_RELAXED, __HIP_MEMORY_SCOPE_AGENT); }
__device__ __forceinline__ unsigned xb_add(unsigned* p, unsigned v) { return __hip_atomic_fetch_add(p, v, __ATOMIC_RELAXED, __HIP_MEMORY_SCOPE_AGENT); }
__device__ __forceinline__ unsigned xb_xcc_id() { return (unsigned)__builtin_amdgcn_s_getreg((3 << 11) | 20) & 0xFu; }
#define XB_SPIN(cond, bar) do { unsigned _sp = 0; while (cond) { __builtin_amdgcn_s_sleep(1); \
    if ((++_sp & 255u) == 0u) { if (xb_ld(&(bar)[XB_TMO])) break; if (_sp > XB_SPIN_CAP) { atomicAdd(&(bar)[XB_TMO], 1u); break; } } } } while (0)

struct XcdBarrier {
    unsigned* bar; unsigned x;
    volatile LAS unsigned* st;
};

__device__ __forceinline__ XcdBarrier xcd_barrier_post(unsigned* bar, volatile LAS unsigned* st) {
    XcdBarrier b; b.bar = bar; b.x = xb_xcc_id(); b.st = st;
    if (threadIdx.x == 0) (void)xb_add(&bar[XB_XCNT(b.x)], 1u);
    return b;
}
__device__ __forceinline__ void xcd_barrier_complete(unsigned* bar, unsigned x, unsigned& nloc, unsigned& nx) {
    const unsigned G = gridDim.x * gridDim.y * gridDim.z;
    unsigned sum, cnt, mine, sp = 0u;
    for (;;) {
        sum = 0u; cnt = 0u; mine = 0u;
#pragma unroll
        for (unsigned j = 0; j < 16; ++j) { const unsigned c = xb_ld(&bar[XB_XCNT(j)]); sum += c; cnt += (c > 0u) ? 1u : 0u; mine = (j == x) ? c : mine; }
        if (sum == G) break;
        __builtin_amdgcn_s_sleep(1);
        if ((++sp & 255u) == 0u) { if (xb_ld(&bar[XB_TMO])) break; if (sp > XB_SPIN_CAP) { atomicAdd(&bar[XB_TMO], 1u); break; } }
    }
    nloc = mine > 0u ? mine : 1u; nx = cnt > 0u ? cnt : 1u;
}

__device__ __forceinline__ void xcd_barrier(const XcdBarrier& b) {
    asm volatile("s_waitcnt vmcnt(0)" ::: "memory");
    __syncthreads();
    if (threadIdx.x == 0) {
        unsigned* bar = b.bar;
        __builtin_amdgcn_s_waitcnt(0);
        unsigned nloc = b.st[0], nx = b.st[1];
        if (nloc == 0u) { xcd_barrier_complete(bar, b.x, nloc, nx); b.st[0] = nloc; b.st[1] = nx; }
        const unsigned old = xb_add(&bar[XB_XSUB(b.x)], 1u);
        const unsigned gen = old / nloc;
        if (old + 1u == (gen + 1u) * nloc) {
            __builtin_amdgcn_fence(__ATOMIC_RELEASE, "agent");
            asm volatile("s_waitcnt vmcnt(0)" ::: "memory");
            const unsigned og = xb_add(&bar[XB_TOP], 1u);
            const unsigned tg = og / nx;
            if (og + 1u == (tg + 1u) * nx) xb_add(&bar[XB_TOPGEN], 1u);
            else XB_SPIN(xb_ld(&bar[XB_TOPGEN]) == tg, bar);
            __builtin_amdgcn_fence(__ATOMIC_ACQUIRE, "agent");
            xb_add(&bar[XB_XGEN(b.x)], 1u);
            asm volatile("s_waitcnt vmcnt(0)" ::: "memory");
        } else {
            XB_SPIN(xb_ld(&bar[XB_XGEN(b.x)]) == gen, bar);
            __builtin_amdgcn_fence(__ATOMIC_ACQUIRE, "agent");
            asm volatile("s_waitcnt vmcnt(0)" ::: "memory");
        }
    }
    __syncthreads();
}

struct Args { const float* in[23]; float* out; unsigned char* ws; int ph_lo, ph_hi, coop, pad; };
typedef const __attribute__((address_space(4))) Args* KArgs;
__device__ __forceinline__ KArgs kargs() { KArgs p = (KArgs)__builtin_amdgcn_kernarg_segment_ptr(); asm volatile("" : "+s"(p)); return p; }
constexpr int N_PHASES = 2 + 7 * DEPTH + 1;

__global__ void __launch_bounds__(512, 2) fwd_kernel(Args a) {
    extern __shared__ __attribute__((aligned(16))) unsigned char lds_raw[];
    LAS unsigned char* lds = (LAS unsigned char*)lds_raw;
    volatile LAS unsigned* bar_st = (volatile LAS unsigned*)(lds + RING_BYTES + 64);
    if (threadIdx.x < 2) bar_st[threadIdx.x] = 0u;
    __syncthreads();
    if (kargs()->coop) (void)xcd_barrier_post((unsigned*)kargs()->ws, bar_st);
    const int ph_lo = kargs()->ph_lo, ph_hi = kargs()->ph_hi;
    for (int ph = ph_lo; ph < ph_hi; ++ph) {
        KArgs ka = kargs();
        const int tid = pg8_ltid(), lane = tid & 63, wave = __builtin_amdgcn_readfirstlane(tid >> 6);
        int G = gridDim.x, bx = blockIdx.x; asm volatile("" : "+s"(G), "+s"(bx));
        const int vcu = (G % 8 == 0) ? (bx % 8) * (G / 8) + bx / 8 : bx;
        const int gw = vcu * 8 + wave, NGW = G * 8;
        unsigned char* ws = ka->ws;
        float* MOD = (float*)(ws + WS_MOD); float* MODP = (float*)(ws + WS_MODP);
        float* tabA = (float*)(ws + WS_TAB); float* tabB = tabA + 128 * 8 * 2;
        float* XCA = (float*)(ws + WS_XC); float* XCB = (float*)(ws + WS_MODP);
        bf16_t* XN = (bf16_t*)(ws + WS_XN); bf16_t* Ob = (bf16_t*)(ws + WS_O); bf16_t* Hb = (bf16_t*)(ws + WS_H); bf16_t* ACT = Hb;
        float* XL = ka->out;
        if (ph == 0) {
          {
            const float* w_mod = ka->in[6]; const float* c_in = ka->in[1]; const float* cctx_in = ka->in[3];
            for (int it = gw; it < 1536; it += NGW) {
                const int ks = it & 15, cgp = (it >> 4) % 24, l = it / 384;
                const int n0 = cgp * 256 + lane * 4;
                f32x4 acc[5];
#pragma unroll
                for (int s = 0; s < 5; ++s) acc[s] = (f32x4){0.f, 0.f, 0.f, 0.f};
                const float* wp = w_mod + ((size_t)l * 1024 + ks * 64) * 6144 + n0;
                for (int kk = 0; kk < 64; ++kk) {
                    const int k = ks * 64 + kk;
                    const f32x4 w = *(const f32x4*)(wp + (size_t)kk * 6144);
#pragma unroll
                    for (int s = 0; s < 4; ++s) acc[s] += silu_f(c_in[s * 1024 + k]) * w;
                    acc[4] += silu_f(cctx_in[k]) * w;
                }
#pragma unroll
                for (int s = 0; s < 5; ++s) *(f32x4*)(MODP + ((size_t)(ks * 4 + l) * 5 + s) * 6144 + n0) = acc[s];
            }
            LAS float* scr = (LAS float*)(lds + wave * 16384);
            for (int it = gw; it < 4 * 6144; it += NGW) {
                const int l = it / 6144; int r = it - l * 6144;
                unsigned char* wl = ws + WS_W + (size_t)l * W_LAYER;
                if (r < 1408) { transpose_item(ka->in[8] + (size_t)l * 1024 * 2816, 1024, 2816, (bf16_t*)wl, 1, scr, r, lane); continue; } r -= 1408;
                if (r < 512) { transpose_item(ka->in[9] + (size_t)l * 1024 * 1024, 1024, 1024, (bf16_t*)(wl + W_OUT_OFF), 0, scr, r, lane); continue; } r -= 512;
                if (r < 2816) { transpose_item(ka->in[18] + (size_t)l * 1024 * 5632, 1024, 5632, (bf16_t*)(wl + W_UP_OFF), 2, scr, r, lane); continue; } r -= 2816;
                transpose_item(ka->in[21] + (size_t)l * 2816 * 1024, 2816, 1024, (bf16_t*)(wl + W_DN_OFF), 0, scr, r, lane);
            }
            for (int idx = vcu * 512 + tid; idx < 3072; idx += G * 512) {
                int pos, i; float e;
                if (idx < 1024) { pos = idx >> 3; i = idx & 7; e = (float)i * 0.125f; } else { const int j = idx - 1024; pos = j >> 4; i = j & 15; e = (float)i * 0.0625f; }
                const float freq = exp2f(-e * 13.287712379549449f);
                const float ang = (float)pos * freq;
                float cc, ss; sincos_f(ang, cc, ss);
                float* tp = (idx < 1024) ? (tabA + idx * 2) : (tabB + (idx - 1024) * 2);
                tp[0] = cc; tp[1] = ss;
            }
          }
        } else if (ph == 1) {
            const float* b_mod = ka->in[7];
            for (int idx = vcu * 512 + tid; idx < 4 * 5 * 6144; idx += G * 512) {
                const int l = idx / 30720, n = idx % 6144;
                float s = b_mod[l * 6144 + n];
#pragma unroll
                for (int ks = 0; ks < 16; ++ks) s += MODP[(size_t)ks * 122880 + idx];
                MOD[idx] = s;
            }
        } else if (ph == N_PHASES - 1) {
            const float* fw = ka->in[22];
            for (int m = gw; m < ML; m += NGW) {
                f32x4* xr = (f32x4*)(XL + (size_t)m * DM) + lane;
                f32x4 v[4]; float s = 0.f;
#pragma unroll
                for (int j = 0; j < 4; ++j) { v[j] = xr[64 * j]; s += (v[j][0] * v[j][0] + v[j][1] * v[j][1]) + (v[j][2] * v[j][2] + v[j][3] * v[j][3]); }
                const float rstd = rsqrtf(wave_sum(s, lane) * (1.f / 1024.f) + 1e-6f);
#pragma unroll
                for (int j = 0; j < 4; ++j) { const f32x4 w = *(const f32x4*)(fw + 4 * (64 * j + lane)); xr[64 * j] = v[j] * rstd * w; }
            }
        } else {
            const int l = (ph - 2) / 7, k = (ph - 2) % 7;
            const bool need_ctx = l < DEPTH - 1;
            const float* modl = MOD + (size_t)l * 5 * 6144;
            unsigned char* wl = ws + WS_W + (size_t)l * W_LAYER;
            const float* srcL = (l == 0) ? ka->in[0] : XL;
            if (k == 0) {
                const float* nw = ka->in[4] + l * 1024;
                for (int m = gw; m < MT; m += NGW) {
                    const bool lat = m < ML; const int slot = lat ? (m >> 13) : 4;
                    if (lat) norm_mod_row(srcL + (size_t)m * DM, nw, modl + slot * 6144, modl + slot * 6144 + 1024, XN + (size_t)m * DM, lane);
                    else {
                        const size_t ro = (size_t)(m - ML) * DM;
                        norm_mod_row((l == 0 ? ka->in[2] : (const float*)XCB) + ro, nw, modl + slot * 6144, modl + slot * 6144 + 1024, XN + (size_t)m * DM, lane,
                                     (const float*)Ob + ro, (l == 0) ? 0 : 11, XCA + ro);
                    }
                }
            } else if (k == 1) {
                pg8::Gemm g{XN, (const bf16_t*)wl, MT, INC, DM, DM}; pg8::StaticOrder S; S.init(MT, INC, G, bx);
                pg8::EpiInProj E{Hb, tabA, tabB};
#ifndef DIS_IN
                pg8::gemm_phase<pg8::EpiInProj, pg8::StaticOrder, true, true>(lds, g, S, E);
#endif
            } else if (k == 2) {
                float lam, ofac;
                {
                    float d1 = 0.f, d2 = 0.f;
                    for (int i = 0; i < 32; ++i) { d1 += ka->in[10][l * 32 + i] * ka->in[11][l * 32 + i]; d2 += ka->in[12][l * 32 + i] * ka->in[13][l * 32 + i]; }
                    const float li = 0.8f - 0.6f * expf(-0.3f * (float)l);
                    lam = expf(d1) - expf(d2) + li;
                    lam = __uint_as_float(__builtin_amdgcn_readfirstlane(__float_as_uint(lam))); ofac = __uint_as_float(__builtin_amdgcn_readfirstlane(__float_as_uint(li)));
                }
                const float* subw = ka->in[14] + l * 64; const float* sink_l = ka->in[15] + l * 4; const float* rpb_l = ka->in[16] + (size_t)l * 4 * 465;
#ifndef DIS_A
                for (int u = vcu; u < 512 + (need_ctx ? 16 : 0); u += G) {
                    const bool cq = u >= 512; const int bh = cq ? (u - 512) : (u >> 5);
                    att::unit_A(cq, lds, Hb, Ob, bh >> 2, bh & 3, u & 31, lam, ofac, subw);
                }
#endif
#ifndef DIS_B
                for (int u = vcu; u < 1024 + (need_ctx ? 32 : 0); u += G) {
                    int mode, ub, uh, ublk; bool redo = true;
                    if (u < 512) { mode = 1; ub = u >> 7; uh = (u >> 6) & 1; ublk = u & 63; redo = att::unit_BC_fast<1>(lds, Hb, Ob, ub, uh, ublk, sink_l, rpb_l); }
                    else if (u < 1024) { const int v = u - 512; mode = 2; ub = v >> 7; uh = (v >> 5) & 3; ublk = v & 31; redo = att::unit_BC_fast<2>(lds, Hb, Ob, ub, uh, ublk, sink_l, rpb_l); }
                    else { const int v = u - 1024, bh = v & 15; if (v < 16) { mode = 3; ub = bh >> 2; uh = (bh >> 1) & 1; ublk = bh & 1; } else { mode = 4; ub = bh >> 2; uh = bh & 3; ublk = 0; } }
                    if (redo) att::unit_BC(mode, lds, Hb, Ob, ub, uh, ublk, sink_l, rpb_l);
                }
#endif
                {
                    const float* cwl = ka->in[17] + (size_t)l * 3 * 256;
                    const int rows = need_ctx ? MT : ML;
                    for (int idx = vcu * 512 + tid; idx < rows * 32; idx += G * 512) {
                        const int row = idx >> 5, c0 = (idx & 31) * 8;
                        int t, len; if (row < ML) { t = row & 8191; len = SEQ; } else { t = (row - ML) & 255; len = CTXL; }
                        const bf16_t* hp = Hb + (size_t)row * INC + 2048 + c0;
                        const u32x4 bg = *(const u32x4*)hp, cg1 = *(const u32x4*)(hp + 256), xi1 = *(const u32x4*)(hp + 512);
                        u32x4 cg0 = {0u, 0u, 0u, 0u}, xi0 = cg0, cg2 = cg0, xi2 = cg0;
                        if (t > 0) { cg0 = *(const u32x4*)(hp - INC + 256); xi0 = *(const u32x4*)(hp - INC + 512); }
                        if (t < len - 1) { cg2 = *(const u32x4*)(hp + INC + 256); xi2 = *(const u32x4*)(hp + INC + 512); }
                        float w0[8], w1[8], w2[8];
#pragma unroll
                        for (int e = 0; e < 8; ++e) { w0[e] = cwl[c0 + e]; w1[e] = cwl[256 + c0 + e]; w2[e] = cwl[512 + c0 + e]; }
                        u32x4 ow;
#pragma unroll
                        for (int e = 0; e < 4; ++e) {
                            const float ylo = w0[2 * e] * bflo(cg0[e]) * bflo(xi0[e]) + w1[2 * e] * bflo(cg1[e]) * bflo(xi1[e]) + w2[2 * e] * bflo(cg2[e]) * bflo(xi2[e]);
                            const float yhi = w0[2 * e + 1] * bfhi(cg0[e]) * bfhi(xi0[e]) + w1[2 * e + 1] * bfhi(cg1[e]) * bfhi(xi1[e]) + w2[2 * e + 1] * bfhi(cg2[e]) * bfhi(xi2[e]);
                            ow[e] = pkbf(bflo(bg[e]) * ylo, bfhi(bg[e]) * yhi);
                        }
                        *(u32x4*)(Ob + (size_t)row * DM + 768 + c0) = ow;
                    }
                }
                __syncthreads();
            } else if (k == 4) {
                const float* nw = ka->in[5] + l * 1024;
                const int nrows = (need_ctx ? NMX_ALL : NMX_L) * 256;
                for (int e = gw; e < nrows; e += NGW) {
                    const int pm = e >> 8, j = e & 255;
                    int t, slot; const float* base; int len;
                    if (pm < NMX_L) { const int s = pm / 33, ti = pm - s * 33; t = 254 * ti - 1 + j; len = SEQ; slot = s; base = XL + (size_t)s * SEQ * DM; }
                    else { const int p = 254 * (pm - NMX_L) - 1 + j; const int sq = (p < 0) ? 0 : p / 257, r = p - sq * 257; t = (p >= 0 && p < 1029 && r != 0) ? (r - 1) : -1; len = CTXL; slot = 4; base = XCA + (size_t)sq * CTXL * DM; }
                    const bool ok = (t >= 0 && t < len);
                    const float* src = ok ? (base + (size_t)t * DM) : nullptr;
                    if (pm < NMX_L || !ok) norm_mod_row(src, nw, modl + slot * 6144 + 3072, modl + slot * 6144 + 4096, XN + (size_t)e * DM, lane);
                    else {
                        const size_t ro = (size_t)(src - XCA);
                        norm_mod_row(src, nw, modl + slot * 6144 + 3072, modl + slot * 6144 + 4096, XN + (size_t)e * DM, lane, (const float*)Hb + ro, 4, XCB + ro);
                    }
                }
            } else if (k == 5) {
                const int nM = need_ctx ? NMX_ALL : NMX_L;
                pg8::Gemm g{XN, (const bf16_t*)(wl + W_UP_OFF), nM * 256, UPC, DM, DM}; pg8::StaticOrder S; S.init(nM * 256, UPC, G, bx);
                pg8::EpiUpConv E{ACT, ka->in[19] + (size_t)l * 3 * UPC, ka->in[20] + (size_t)l * UPC};
                pg8::OneUnit one;
#ifndef DIS_UP
                for (int i = 0; S.next(i, one.u); ++i) pg8::gemm_phase<pg8::EpiUpConv, pg8::OneUnit, false, true>(lds, g, one, E);
#endif
            } else {
                const bool isout = (k == 3); const int KK = isout ? DM : DFF;
                const bf16_t* Ap = isout ? (const bf16_t*)Ob : (const bf16_t*)ACT; const bf16_t* Bp = (const bf16_t*)(wl + (isout ? W_OUT_OFF : W_DN_OFF));
                {
                    pg8::Gemm g{Ap, Bp, ML, DM, KK, KK}; pg8::StaticOrder S; S.init(ML, DM, G, bx);
                    pg8::EpiRes E{isout ? srcL : (const float*)XL, nullptr, XL, nullptr, modl, isout ? 2048 : 5120};
#ifndef DIS_OUT
                    pg8::gemm_phase<pg8::EpiRes, pg8::StaticOrder, true, true>(lds, g, S, E);
#endif
                }
                if (need_ctx) {
                    const int P = isout ? 4 : 11, klen = KK / P;
                    for (int su = bx; su < 16 * P; su += G) {
                        const int tile = su / P, part = su - tile * P;
                        pg8::Gemm gs{Ap + (size_t)ML * KK + part * klen, Bp + part * klen, MC, DM, klen, KK};
                        pg8::OneUnit one; one.u.pm = tile >> 2; one.u.pn = tile & 3;
                        pg8::EpiSlab EA{(isout ? (float*)Hb : (float*)Ob) + (size_t)part * 1024 * 1024, modl + 4 * 6144 + (isout ? 2048 : 5120)};
                        pg8::gemm_phase<pg8::EpiSlab, pg8::OneUnit, false, true>(lds, gs, one, EA);
                    }
                }
            }
        }
        if (ph + 1 < ph_hi && kargs()->coop) {
            if (kargs()->coop == 2) cg::this_grid().sync();
            else { XcdBarrier b; b.bar = (unsigned*)kargs()->ws; b.x = xb_xcc_id(); b.st = bar_st; xcd_barrier(b); }
        }
    }
}

extern "C" void kernel_launch(void* const* d_in, const int* in_sizes, int n_in, void* d_out, int out_size, void* d_ws, size_t ws_size, hipStream_t stream) {
    static int grid = 0;
    if (grid == 0) {
        if (n_in != 23 || out_size != ML * DM || ws_size < WS_END) { fprintf(stderr, "kernel_launch: unexpected shapes (n_in %d out %d ws %zu need %zu)\n", n_in, out_size, ws_size, (size_t)WS_END); grid = -1; return; }
        int dev = 0, cus = 0, per_cu = 0;
        if (hipGetDevice(&dev) != hipSuccess || hipDeviceGetAttribute(&cus, hipDeviceAttributeMultiprocessorCount, dev) != hipSuccess) { grid = -1; return; }
        if (hipFuncSetAttribute((const void*)fwd_kernel, hipFuncAttributeMaxDynamicSharedMemorySize, LDS_BYTES) != hipSuccess) { fprintf(stderr, "kernel_launch: hipFuncSetAttribute failed\n"); grid = -1; return; }
        if (hipOccupancyMaxActiveBlocksPerMultiprocessor(&per_cu, (const void*)fwd_kernel, 512, LDS_BYTES) != hipSuccess || per_cu < 1) fprintf(stderr, "kernel_launch: occupancy query says %d\n", per_cu);
        (void)hipGetLastError();
        grid = cus;
    }
    if (grid < 0) return;
    Args a{};
    for (int i = 0; i < 23; ++i) a.in[i] = (const float*)d_in[i];
    a.out = (float*)d_out; a.ws = (unsigned char*)d_ws;
#if MK_MULTI
    for (int ph = 0; ph < N_PHASES; ++ph) {
        a.ph_lo = ph; a.ph_hi = ph + 1; a.coop = 0;
        hipLaunchKernelGGL(fwd_kernel, dim3(grid), dim3(512), LDS_BYTES, stream, a);
    }
#else
    a.ph_lo = 0; a.ph_hi = N_PHASES; a.coop = 1;
    if (hipMemsetAsync(d_ws, 0, 16384, stream) != hipSuccess) { fprintf(stderr, "kernel_launch: memset failed\n"); return; }
    void* args[] = {&a};
    hipError_t e = hipLaunchCooperativeKernel((const void*)fwd_kernel, dim3(grid), dim3(512), args, LDS_BYTES, stream);
    if (e != hipSuccess) fprintf(stderr, "cooperative launch failed: %s (grid %d)\n", hipGetErrorString(e), grid);
#endif
}
```

```cpp
#include <hip/hip_runtime.h>
#include <hip/hip_cooperative_groups.h>
#include <cstdio>
#include <cstdint>
namespace cg = cooperative_groups;

#ifndef MK_MULTI
#define MK_MULTI 0
#endif

#ifndef REP_IN
#define REP_IN 1
#endif
#ifndef REP_UP
#define REP_UP 1
#endif
#ifndef REP_A
#define REP_A 1
#endif
#ifndef REP_OD
#define REP_OD 1
#endif
#ifndef REP_P
#define REP_P 1
#endif
#ifndef REP_BC
#define REP_BC 1
#endif
#ifndef REP_M
#define REP_M 1
#endif

__device__ __forceinline__ int pg8_ltid() { int t = threadIdx.x; asm volatile("" : "+v"(t)); return t; }
namespace pg8 {
#define PG8_LAS __attribute__((address_space(3)))
typedef unsigned short bf16_t;
typedef short bf16x8 __attribute__((ext_vector_type(8)));
typedef float f32x4 __attribute__((ext_vector_type(4)));
typedef unsigned u32x4 __attribute__((ext_vector_type(4)));
constexpr int BM = 256, BK = 64, HALF = 128, HTB = HALF * BK * 2  , STAGE_BYTES = 8 * HTB, NXCD = 8, WGM = 8;

__host__ __device__ __forceinline__ int lds_byte(int r, int c) { const int st = (r >> 4) * 2 + (c >> 5), rr = r & 15, cc = c & 31, ob = rr * 64 + cc * 2; return st * 1024 + (ob ^ (((ob >> 9) & 1) << 5)); }
__host__ __device__ __forceinline__ void stage_rc(int b, int& R, int& C) { const int st = b / 1024, sb = b % 1024, swz = sb ^ (((sb >> 9) & 1) << 5); R = (st >> 1) * 16 + swz / 64; C = (st & 1) * 32 + (swz % 64) / 2; }
__host__ __device__ __forceinline__ int perm32(int rho) { const int n = rho >> 4, i = rho & 15; return 8 * (i >> 2) + 4 * n + (i & 3); }

struct Unit { int pm, pn; };
struct Gemm { const bf16_t* A; const bf16_t* Bt; int M, N, K, ldk; };

struct StaticOrder {
    int nM, nN, nwg, G, c;
    __host__ __device__ void init(int M, int N, int G_, int c_) { nM = M / BM; nN = N / BM; nwg = nM * nN; G = G_; c = c_; }
    __host__ __device__ bool next(int i, Unit& u) const {
        const long L = (long)i * G + c; if (L >= nwg) return false;
        int wgid = (int)L; { const int q = nwg / NXCD, r = nwg % NXCD, xcd = wgid % NXCD, off = wgid / NXCD; wgid = (xcd < r ? xcd * (q + 1) : r * (q + 1) + (xcd - r) * q) + off; }
        const int nig = WGM * nN, gid = wgid / nig, fm = gid * WGM, gsz = (nM - fm) < WGM ? (nM - fm) : WGM;
        u.pm = fm + ((wgid % nig) % gsz); u.pn = (wgid % nig) / gsz; return true;
    }
    __device__ __forceinline__ void a_ready(const Unit&) const {}
    __device__ __forceinline__ void done(const Unit&) const {}
};

typedef float pg8_f32x2 __attribute__((ext_vector_type(2))); typedef __bf16 pg8_bf16x2 __attribute__((ext_vector_type(2)));
__device__ __forceinline__ unsigned cvt_pk_bf16(float lo, float hi) { pg8_f32x2 v = {lo, hi}; pg8_bf16x2 b = __builtin_convertvector(v, pg8_bf16x2); return __builtin_bit_cast(unsigned, b); }
typedef unsigned u32x2 __attribute__((ext_vector_type(2)));

struct OneUnit {
    Unit u;
    __device__ __forceinline__ bool next(int i, Unit& o) const { if (i != 0) return false; o = u; return true; }
    __device__ __forceinline__ void a_ready(const Unit&) const {}
    __device__ __forceinline__ void done(const Unit&) const {}
};

struct EpiInProj {
    static constexpr bool PERM = false, AFTER_DRAIN = false;
    bf16_t* H; const float* tabA; const float* tabB;
    __device__ __forceinline__ void operator()(const f32x4 (&acc)[2][2][4][2], const Unit& u, int wr, int wc, int fr, int fq) const {
        const int pn = u.pn; const bool latent = u.pm < 128;
        const float scale = (pn == 0) ? 0.17677669529663687f * 1.4426950408889634f : ((pn == 3 || pn == 5) ? 0.125f * 1.4426950408889634f : 1.0f);
#pragma unroll
        for (int bj = 0; bj < 2; ++bj) {
            int mode = (pn == 0 || pn == 1) ? 1 : ((pn == 3 || (pn == 4 && bj == 0)) ? 2 : 0);
            if (!latent) mode = 0;
#ifdef TEST_NOROPE
            mode = 0;
#endif
#pragma unroll
            for (int ai = 0; ai < 2; ++ai)
#pragma unroll
                for (int m = 0; m < 4; ++m) {
                    const int r = u.pm * BM + ai * HALF + wr * 64 + m * 16 + fr;
                    f32x4 v0 = acc[ai][bj][m][0], v1 = acc[ai][bj][m][1];
                    if (mode != 0) {
                        const int t = r & 8191, trow = t >> 6, tcol = t & 63;
                        const float* tp;
                        if (mode == 1) { const int pos = (fq < 2) ? trow : tcol; tp = tabA + (pos * 8 + 4 * (fq & 1)) * 2; }
                        else { const int pos = (wc & 1) ? tcol : trow; tp = tabB + (pos * 16 + 4 * fq) * 2; }
                        const f32x4 cs0 = *(const f32x4*)tp, cs1 = *(const f32x4*)(tp + 4);
                        const float c0 = cs0[0], s0 = cs0[1], c1 = cs0[2], s1 = cs0[3], c2 = cs1[0], s2 = cs1[1], c3 = cs1[2], s3 = cs1[3];
                        f32x4 a = v0, b = v1;
                        v0[0] = a[0] * c0 - b[0] * s0; v1[0] = b[0] * c0 + a[0] * s0;
                        v0[1] = a[1] * c1 - b[1] * s1; v1[1] = b[1] * c1 + a[1] * s1;
                        v0[2] = a[2] * c2 - b[2] * s2; v1[2] = b[2] * c2 + a[2] * s2;
                        v0[3] = a[3] * c3 - b[3] * s3; v1[3] = b[3] * c3 + a[3] * s3;
                    }
                    v0 = v0 * scale; v1 = v1 * scale;
                    bf16_t* rowp = H + (size_t)r * 2816 + pn * BM + bj * HALF + wc * 32 + 4 * fq;
                    u32x2 w0, w1; w0.x = cvt_pk_bf16(v0[0], v0[1]); w0.y = cvt_pk_bf16(v0[2], v0[3]); w1.x = cvt_pk_bf16(v1[0], v1[1]); w1.y = cvt_pk_bf16(v1[2], v1[3]);
                    *(u32x2*)rowp = w0; *(u32x2*)(rowp + 16) = w1;
                }
        }
    }
};

struct EpiRes {
    static constexpr bool PERM = false, AFTER_DRAIN = false;
    const float* baseL; const float* baseC; float* outL; float* outC; const float* modl; int goff;
    __device__ __forceinline__ void operator()(const f32x4 (&acc)[2][2][4][2], const Unit& u, int wr, int wc, int fr, int fq) const {
        const bool ctx = u.pm >= 128; const int slot = ctx ? 4 : (u.pm >> 5);
        const int row0 = (ctx ? (u.pm - 128) : u.pm) * BM + wr * 64 + fr;
        const float* bp = ctx ? baseC : baseL; float* op = ctx ? outC : outL;
        const int col0 = u.pn * BM + wc * 32 + 4 * fq;
        f32x4 gv[2][2];
#pragma unroll
        for (int bj = 0; bj < 2; ++bj)
#pragma unroll
            for (int n = 0; n < 2; ++n) gv[bj][n] = *(const f32x4*)(modl + slot * 6144 + goff + col0 + bj * HALF + n * 16);
#pragma unroll
        for (int ai = 0; ai < 2; ++ai)
#pragma unroll
            for (int m = 0; m < 4; ++m) {
                const size_t off = (size_t)(row0 + ai * HALF + m * 16) * 1024 + col0;
#pragma unroll
                for (int bj = 0; bj < 2; ++bj)
#pragma unroll
                    for (int n = 0; n < 2; ++n) {
                        const f32x4 bs = *(const f32x4*)(bp + off + bj * HALF + n * 16);
                        *(f32x4*)(op + off + bj * HALF + n * 16) = bs + gv[bj][n] * acc[ai][bj][m][n];
                    }
                asm volatile("" ::: "memory");
            }
    }
};

struct EpiSlab {
    static constexpr bool PERM = false, AFTER_DRAIN = false;
    float* slab; const float* gate;
    __device__ __forceinline__ void operator()(const f32x4 (&acc)[2][2][4][2], const Unit& u, int wr, int wc, int fr, int fq) const {
        const int row0 = u.pm * BM + wr * 64 + fr, col0 = u.pn * BM + wc * 32 + 4 * fq;
#pragma unroll
        for (int bj = 0; bj < 2; ++bj)
#pragma unroll
            for (int n = 0; n < 2; ++n) {
                const f32x4 gv = *(const f32x4*)(gate + col0 + bj * HALF + n * 16);
#pragma unroll
                for (int ai = 0; ai < 2; ++ai)
#pragma unroll
                    for (int m = 0; m < 4; ++m)
                        *(f32x4*)(slab + (size_t)(row0 + ai * HALF + m * 16) * 1024 + col0 + bj * HALF + n * 16) = gv * acc[ai][bj][m][n];
            }
    }
};

struct EpiUpConv {
    static constexpr bool PERM = false, AFTER_DRAIN = true;
    bf16_t* ACT; const float* cw; const float* cb;
    static constexpr int TP = 520;
    __device__ __forceinline__ void fused(f32x4 (&acc)[2][2][4][2], const Unit& u, int wr, int wc, int fr, int fq, PG8_LAS unsigned char* lds, int wid, int lane) const {
#pragma unroll
        for (int ai = 0; ai < 2; ++ai)
#pragma unroll
            for (int m = 0; m < 4; ++m) {
                const int row = ai * HALF + wr * 64 + m * 16 + fr;
#pragma unroll
                for (int bj = 0; bj < 2; ++bj)
#pragma unroll
                    for (int n = 0; n < 2; ++n) {
                        const f32x4 v = acc[ai][bj][m][n]; u32x2 w; w.x = cvt_pk_bf16(v[0], v[1]); w.y = cvt_pk_bf16(v[2], v[3]);
                        *(PG8_LAS u32x2*)(lds + row * TP + (bj * HALF + wc * 32 + n * 16 + 4 * fq) * 2) = w;
                    }
            }
        const int tid = wid * 64 + lane, ch = tid & 15;
        const int gcol = u.pn * 128 + ch * 8;
        float wg[3][8], wv[3][8], bg[8], bv[8];
#pragma unroll
        for (int k = 0; k < 3; ++k) {
            const f32x4 a0 = *(const f32x4*)(cw + k * 5632 + gcol), a1 = *(const f32x4*)(cw + k * 5632 + gcol + 4);
            const f32x4 b0 = *(const f32x4*)(cw + k * 5632 + 2816 + gcol), b1 = *(const f32x4*)(cw + k * 5632 + 2816 + gcol + 4);
#pragma unroll
            for (int e = 0; e < 4; ++e) { wg[k][e] = a0[e]; wg[k][4 + e] = a1[e]; wv[k][e] = b0[e]; wv[k][4 + e] = b1[e]; }
        }
        {
            const f32x4 a0 = *(const f32x4*)(cb + gcol), a1 = *(const f32x4*)(cb + gcol + 4), b0 = *(const f32x4*)(cb + 2816 + gcol), b1 = *(const f32x4*)(cb + 2816 + gcol + 4);
#pragma unroll
            for (int e = 0; e < 4; ++e) { bg[e] = a0[e]; bg[4 + e] = a1[e]; bv[e] = b0[e]; bv[4 + e] = b1[e]; }
        }
        const bool lat = u.pm < 132; int rowbase, ti;
        if (lat) { const int s = u.pm / 33; ti = u.pm - s * 33; rowbase = s * 8192; } else { ti = u.pm - 132; rowbase = 32768; }
        asm volatile("s_waitcnt lgkmcnt(0)" ::: "memory"); __builtin_amdgcn_s_barrier(); asm volatile("" ::: "memory");
        for (int it = tid; it < 254 * 16; it += 512) {
            const int j = 1 + (it >> 4); const int p = 254 * ti - 1 + j;
            int orow; bool ok;
            if (lat) { ok = p < 8192; orow = rowbase + p; } else { const int sq = p / 257, r = p - sq * 257; ok = (p < 1029) && (r != 0); orow = rowbase + sq * 256 + r - 1; }
            if (ok) {
                float g[8], v[8];
#pragma unroll
                for (int e = 0; e < 8; ++e) { g[e] = bg[e]; v[e] = bv[e]; }
#pragma unroll
                for (int k = 0; k < 3; ++k) {
                    const PG8_LAS unsigned char* rp = lds + (j - 1 + k) * TP + ch * 16;
                    const u32x2 g0 = *(const PG8_LAS u32x2*)rp, g1 = *(const PG8_LAS u32x2*)(rp + 8);
                    const u32x2 v0 = *(const PG8_LAS u32x2*)(rp + 256), v1 = *(const PG8_LAS u32x2*)(rp + 264);
                    const unsigned gw[4] = {g0.x, g0.y, g1.x, g1.y}, vw[4] = {v0.x, v0.y, v1.x, v1.y};
#pragma unroll
                    for (int e = 0; e < 4; ++e) {
                        g[2 * e] += wg[k][2 * e] * __uint_as_float(gw[e] << 16); g[2 * e + 1] += wg[k][2 * e + 1] * __uint_as_float(gw[e] & 0xffff0000u);
                        v[2 * e] += wv[k][2 * e] * __uint_as_float(vw[e] << 16); v[2 * e + 1] += wv[k][2 * e + 1] * __uint_as_float(vw[e] & 0xffff0000u);
                    }
                }
                float o[8];
#pragma unroll
                for (int e = 0; e < 8; ++e) o[e] = g[e] / (1.f + __expf(-g[e])) * v[e];
                u32x4 w; w.x = cvt_pk_bf16(o[0], o[1]); w.y = cvt_pk_bf16(o[2], o[3]); w.z = cvt_pk_bf16(o[4], o[5]); w.w = cvt_pk_bf16(o[6], o[7]);
                *(u32x4*)(ACT + (size_t)orow * 2816 + gcol) = w;
            }
        }
        asm volatile("s_waitcnt lgkmcnt(0)" ::: "memory"); __builtin_amdgcn_s_barrier(); asm volatile("" ::: "memory");
    }
};
template <class Epi, class Sched, bool ALIGN_EPI = false, bool SP2 = false>
__device__ __forceinline__ void gemm_phase(PG8_LAS unsigned char* lds, const Gemm g, const Sched& S, const Epi& E) {
    const int tid = pg8_ltid(), wid = __builtin_amdgcn_readfirstlane(tid >> 6), lane = tid & 63, wr = wid >> 2, wc = wid & 3, fr = lane & 15, fq = lane >> 4;
    const int K = g.ldk, nt = g.K / BK;
    unsigned voffA[2], voffB[2];
#pragma unroll
    for (int i = 0; i < 2; ++i) { int R, C; stage_rc(tid * 16 + i * 8192, R, C); const int Rb = Epi::PERM ? ((R & ~31) + perm32(R & 31)) : R;
        voffA[i] = (unsigned)(R * K + C) * 2u; voffB[i] = (unsigned)(Rb * K + C) * 2u; }
    const size_t kstep = (size_t)(BK * 2);
    const size_t hstep = (size_t)HALF * K * 2;
    const size_t tstep = 2 * hstep;
    const unsigned ldsw = (unsigned)wid * 1024u;
    const int aoff = lds_byte(wr * 64 + fr, fq * 8), boff = lds_byte(wc * 32 + fr, fq * 8);
#define PG8_SA(b, h) (((b) * 2 + (h)) * HTB)
#define PG8_SB(b, h) ((4 + (b) * 2 + (h)) * HTB)
#define PG8_STAGE(bufoff, gbase, voff) do { _Pragma("unroll") for (int _i = 0; _i < 2; ++_i) \
        __builtin_amdgcn_global_load_lds((const unsigned*)((const char*)(gbase) + (voff)[_i]), (PG8_LAS unsigned*)(lds + (bufoff) + ldsw + _i * 8192), 16, 0, 0); } while (0)
#define PG8_LDA(dst, b, h) do { _Pragma("unroll") for (int m = 0; m < 4; ++m) _Pragma("unroll") for (int k = 0; k < 2; ++k) dst[m][k] = *(const PG8_LAS bf16x8*)(lds + PG8_SA(b, h) + aoff + m * 2048 + k * 1024); } while (0)
#define PG8_LDB(dst, b, h) do { _Pragma("unroll") for (int n = 0; n < 2; ++n) _Pragma("unroll") for (int k = 0; k < 2; ++k) dst[n][k] = *(const PG8_LAS bf16x8*)(lds + PG8_SB(b, h) + boff + n * 2048 + k * 1024); } while (0)
#define PG8_MMA(ai, bj, At, Bt) do { __builtin_amdgcn_s_setprio(1); _Pragma("unroll") for (int m = 0; m < 4; ++m) _Pragma("unroll") for (int n = 0; n < 2; ++n) _Pragma("unroll") for (int k = 0; k < 2; ++k) \
        acc[ai][bj][m][n] = __builtin_amdgcn_mfma_f32_16x16x32_bf16(Bt[n][k], At[m][k], acc[ai][bj][m][n], 0, 0, 0); __builtin_amdgcn_s_setprio(0); } while (0)
#define PG8_WAIT_V(n) asm volatile("s_waitcnt vmcnt(" #n ")" ::: "memory")
#define PG8_WAIT_L(n) asm volatile("s_waitcnt lgkmcnt(" #n ")" ::: "memory")
#define PG8_BAR __builtin_amdgcn_s_barrier()
#define PG8_SCHED __builtin_amdgcn_sched_barrier(0)
    Unit cur, nxt; int ui = 0;
    if (!S.next(0, cur)) return;
    f32x4 acc[2][2][4][2];
#pragma unroll
    for (int a = 0; a < 2; ++a)
#pragma unroll
        for (int b = 0; b < 2; ++b)
#pragma unroll
            for (int m = 0; m < 4; ++m)
#pragma unroll
                for (int n = 0; n < 2; ++n) acc[a][b][m][n] = (f32x4){0.f, 0.f, 0.f, 0.f};
    bf16x8 At[4][2], B0[2][2], B1[2][2];
    const char* cA = (const char*)g.A + (size_t)cur.pm * tstep; const char* cB = (const char*)g.Bt + (size_t)cur.pn * tstep;
    S.a_ready(cur);
    if constexpr (SP2) {
        PG8_STAGE(PG8_SB(0, 0), cB, voffB); PG8_STAGE(PG8_SB(0, 1), cB + hstep, voffB); PG8_STAGE(PG8_SA(0, 0), cA, voffA); PG8_STAGE(PG8_SA(0, 1), cA + hstep, voffA);
        if (wr == 1) PG8_BAR;
        PG8_WAIT_V(2); PG8_BAR;
        PG8_STAGE(PG8_SB(1, 0), cB + kstep, voffB); PG8_STAGE(PG8_SA(1, 0), cA + kstep, voffA); PG8_STAGE(PG8_SB(1, 1), cB + hstep + kstep, voffB);
        PG8_WAIT_V(6); PG8_BAR;
    } else {
        PG8_STAGE(PG8_SB(0, 0), cB, voffB); PG8_STAGE(PG8_SA(0, 0), cA, voffA); PG8_STAGE(PG8_SB(0, 1), cB + hstep, voffB); PG8_STAGE(PG8_SA(0, 1), cA + hstep, voffA);
        if (wr == 1) PG8_BAR;
        PG8_WAIT_V(4); PG8_BAR;
        PG8_STAGE(PG8_SB(1, 0), cB + kstep, voffB); PG8_STAGE(PG8_SA(1, 0), cA + kstep, voffA); PG8_STAGE(PG8_SB(1, 1), cB + hstep + kstep, voffB);
        PG8_WAIT_V(6); PG8_BAR;
    }
    for (;;) {
        const bool has_next = S.next(ui + 1, nxt);
        const char* nA = has_next ? (const char*)g.A + (size_t)nxt.pm * tstep : cA; const char* nB = has_next ? (const char*)g.Bt + (size_t)nxt.pn * tstep : cB;
        for (int t = 0; t < nt; t += 2) {
            const bool last = (t == nt - 2);
            const char* a1 = cA + (size_t)(t + 1) * kstep;
            const char* a2 = last ? nA : cA + (size_t)(t + 2) * kstep; const char* b2 = last ? nB : cB + (size_t)(t + 2) * kstep;
            const char* a3 = a2 + kstep; const char* b3 = b2 + kstep;
            if (last && has_next) S.a_ready(nxt);
            if constexpr (SP2) {
            PG8_LDB(B0, 0, 0); PG8_LDB(B1, 0, 1); PG8_SCHED; PG8_LDA(At, 0, 0); PG8_STAGE(PG8_SA(1, 1), a1 + hstep, voffA);
            PG8_WAIT_V(8); PG8_WAIT_L(0); PG8_BAR; PG8_MMA(0, 0, At, B0); PG8_MMA(0, 1, At, B1); PG8_BAR; PG8_SCHED;
            PG8_LDA(At, 0, 1); PG8_STAGE(PG8_SB(0, 0), b2, voffB); PG8_STAGE(PG8_SB(0, 1), b2 + hstep, voffB); PG8_STAGE(PG8_SA(0, 0), a2, voffA);
            PG8_WAIT_V(8); PG8_WAIT_L(0); PG8_BAR; PG8_MMA(1, 0, At, B0); PG8_MMA(1, 1, At, B1); PG8_BAR; PG8_SCHED;
            PG8_LDB(B0, 1, 0); PG8_LDB(B1, 1, 1); PG8_SCHED; PG8_LDA(At, 1, 0); PG8_STAGE(PG8_SA(0, 1), a2 + hstep, voffA);
            PG8_WAIT_V(8); PG8_WAIT_L(0); PG8_BAR; PG8_MMA(0, 0, At, B0); PG8_MMA(0, 1, At, B1); PG8_BAR; PG8_SCHED;
            PG8_LDA(At, 1, 1); PG8_STAGE(PG8_SB(1, 0), b3, voffB); PG8_STAGE(PG8_SB(1, 1), b3 + hstep, voffB); PG8_STAGE(PG8_SA(1, 0), a3, voffA);
            PG8_WAIT_V(8); PG8_WAIT_L(0); PG8_BAR; PG8_MMA(1, 0, At, B0); PG8_MMA(1, 1, At, B1); PG8_BAR; PG8_SCHED;
            } else {
            PG8_LDB(B0, 0, 0); PG8_SCHED; PG8_LDA(At, 0, 0); PG8_STAGE(PG8_SA(1, 1), a1 + hstep, voffA);
            PG8_WAIT_L(8); PG8_BAR; PG8_WAIT_L(0); PG8_MMA(0, 0, At, B0); PG8_BAR; PG8_SCHED;
            PG8_LDB(B1, 0, 1); PG8_STAGE(PG8_SB(0, 0), b2, voffB);
            PG8_BAR; PG8_WAIT_L(0); PG8_MMA(0, 1, At, B1); PG8_BAR;
            PG8_LDA(At, 0, 1); PG8_STAGE(PG8_SA(0, 0), a2, voffA);
            PG8_BAR; PG8_WAIT_L(0); PG8_MMA(1, 0, At, B0); PG8_BAR; PG8_SCHED;
            PG8_STAGE(PG8_SB(0, 1), b2 + hstep, voffB);
            PG8_WAIT_V(6); PG8_BAR; PG8_MMA(1, 1, At, B1); PG8_BAR;
            PG8_LDB(B0, 1, 0); PG8_SCHED; PG8_LDA(At, 1, 0); PG8_STAGE(PG8_SA(0, 1), a2 + hstep, voffA);
            PG8_WAIT_L(8); PG8_BAR; PG8_WAIT_L(0); PG8_MMA(0, 0, At, B0); PG8_BAR; PG8_SCHED;
            PG8_LDB(B1, 1, 1); PG8_STAGE(PG8_SB(1, 0), b3, voffB);
            PG8_BAR; PG8_WAIT_L(0); PG8_MMA(0, 1, At, B1); PG8_BAR;
            PG8_LDA(At, 1, 1); PG8_STAGE(PG8_SA(1, 0), a3, voffA);
            PG8_BAR; PG8_WAIT_L(0); PG8_MMA(1, 0, At, B0); PG8_BAR; PG8_SCHED;
            PG8_STAGE(PG8_SB(1, 1), b3 + hstep, voffB);
            PG8_WAIT_V(6); PG8_BAR; PG8_MMA(1, 1, At, B1); PG8_BAR;
            }
        }
        if constexpr (ALIGN_EPI) { if (wr == 0) PG8_BAR; }
        if constexpr (!Epi::AFTER_DRAIN) { E(acc, cur, wr, wc, fr, fq); S.done(cur); }
        if (!has_next) break;
#pragma unroll
        for (int a = 0; a < 2; ++a)
#pragma unroll
            for (int b = 0; b < 2; ++b)
#pragma unroll
                for (int m = 0; m < 4; ++m)
#pragma unroll
                    for (int n = 0; n < 2; ++n) acc[a][b][m][n] = (f32x4){0.f, 0.f, 0.f, 0.f};
        cur = nxt; cA = nA; cB = nB; ++ui;
        if constexpr (ALIGN_EPI) { if (wr == 1) PG8_BAR; }
    }
    PG8_WAIT_V(0);
    if constexpr (!ALIGN_EPI) { if (wr == 0) PG8_BAR; }
    PG8_BAR;
    if constexpr (Epi::AFTER_DRAIN) { E.fused(acc, cur, wr, wc, fr, fq, lds, wid, lane); S.done(cur); }
#undef PG8_SA
#undef PG8_SB
#undef PG8_STAGE
#undef PG8_LDA
#undef PG8_LDB
#undef PG8_MMA
#undef PG8_WAIT_V
#undef PG8_WAIT_L
#undef PG8_BAR
#undef PG8_SCHED
}
}
#define LAS __attribute__((address_space(3)))
typedef unsigned short bf16_t;
typedef short bf16x8 __attribute__((ext_vector_type(8)));
typedef short s16x4 __attribute__((ext_vector_type(4)));
typedef float f32x4 __attribute__((ext_vector_type(4)));
typedef float f32x16 __attribute__((ext_vector_type(16)));
typedef unsigned u32x4 __attribute__((ext_vector_type(4)));
typedef unsigned u32x2 __attribute__((ext_vector_type(2)));

constexpr int DM = 1024, NB = 4, SEQ = 8192, DEPTH = 4, CTXL = 256;
constexpr int ML = NB * SEQ, MC = NB * CTXL, MT = ML + MC;
constexpr int INC = 2816, DFF = 2816, UPC = 5632;
constexpr int NMX_L = NB * 33, NMX_ALL = NB * 33 + 5;
constexpr float LOG2E = 1.4426950408889634f;

constexpr size_t MiB = 1u << 20;
constexpr size_t WS_MOD = 1 * MiB;
constexpr size_t WS_MODP = 2 * MiB;
constexpr size_t WS_TAB = 10 * MiB;
constexpr size_t WS_XC = 11 * MiB;
constexpr size_t WS_W = 16 * MiB;
constexpr size_t W_LAYER = 24 * MiB, W_OUT_OFF = (size_t)2816 * 1024 * 2, W_UP_OFF = W_OUT_OFF + (size_t)1024 * 1024 * 2, W_DN_OFF = W_UP_OFF + (size_t)5632 * 1024 * 2;
constexpr size_t WS_XN = 112 * MiB;
constexpr size_t WS_O = 182 * MiB;
constexpr size_t WS_H = 248 * MiB;
constexpr size_t WS_END = WS_H + (size_t)MT * 2816 * 2;
static_assert(W_DN_OFF + (size_t)1024 * 2816 * 2 <= W_LAYER, "weights per layer");
static_assert(WS_XN + (size_t)NMX_ALL * 256 * 1024 * 2 <= WS_O && WS_O + (size_t)MT * 1024 * 2 <= WS_H && WS_END <= 512 * MiB, "ws map");

constexpr int RING_BYTES = 135168;
constexpr int LDS_BYTES = 147456;

__device__ __forceinline__ unsigned pkbf(float lo, float hi) { return pg8::cvt_pk_bf16(lo, hi); }
__device__ __forceinline__ float bflo(unsigned w) { return __uint_as_float(w << 16); }
__device__ __forceinline__ float bfhi(unsigned w) { return __uint_as_float(w & 0xffff0000u); }
__device__ __forceinline__ float dpp_add(float v, const int ctrl_sel) {
    int m;
    if (ctrl_sel == 0) m = __builtin_amdgcn_update_dpp(0, __float_as_int(v), 0xB1, 0xF, 0xF, true);
    else if (ctrl_sel == 1) m = __builtin_amdgcn_update_dpp(0, __float_as_int(v), 0x4E, 0xF, 0xF, true);
    else if (ctrl_sel == 2) m = __builtin_amdgcn_update_dpp(0, __float_as_int(v), 0x124, 0xF, 0xF, true);
    else m = __builtin_amdgcn_update_dpp(0, __float_as_int(v), 0x128, 0xF, 0xF, true);
    return v + __int_as_float(m);
}
__device__ __forceinline__ float wave_sum(float v, int lane) {
    v = dpp_add(v, 0); v = dpp_add(v, 1); v = dpp_add(v, 2); v = dpp_add(v, 3);
    v += __int_as_float(__builtin_amdgcn_ds_bpermute((lane ^ 16) << 2, __float_as_int(v)));
    auto rr = __builtin_amdgcn_permlane32_swap(__float_as_uint(v), __float_as_uint(v), false, false);
    return __uint_as_float(rr[0]) + __uint_as_float(rr[1]);
}
__device__ __forceinline__ float xhalf_max(float v) { auto rr = __builtin_amdgcn_permlane32_swap(__float_as_uint(v), __float_as_uint(v), false, false); return fmaxf(__uint_as_float(rr[0]), __uint_as_float(rr[1])); }
__device__ __forceinline__ float xhalf_sum(float v) { auto rr = __builtin_amdgcn_permlane32_swap(__float_as_uint(v), __float_as_uint(v), false, false); return __uint_as_float(rr[0]) + __uint_as_float(rr[1]); }

namespace att {
constexpr int KP = 144, VP = 136;
constexpr int L_KS = 0, L_VT = 64 * KP, L_RPB = L_VT + 64 * VP, L_END = L_RPB + 2048;
__device__ __forceinline__ int crow(int r, int h) { return (r & 3) + 8 * (r >> 2) + 4 * h; }

struct TileRegs { u32x4 k, v; };
__device__ __forceinline__ void tile_gload(TileRegs& R, const bf16_t* H, int krow, int kcol, int vcol, int tid) {
    const int key = tid >> 3, ch = tid & 7;
    const bf16_t* p = H + (size_t)(krow + key) * INC;
    R.k = *(const u32x4*)(p + kcol + 8 * ch); R.v = *(const u32x4*)(p + vcol + 8 * ch);
}
__device__ __forceinline__ void tile_swrite(const TileRegs& R, LAS unsigned char* lds, int tid) {
    const int key = tid >> 3, ch = tid & 7;
    *(LAS u32x4*)(lds + L_KS + key * KP + ch * 16) = R.k;
    LAS unsigned short* vt = (LAS unsigned short*)(lds + L_VT);
#pragma unroll
    for (int j = 0; j < 4; ++j) { const unsigned w = R.v[j]; vt[(8 * ch + 2 * j) * (VP / 2) + key] = (unsigned short)(w & 0xffffu); vt[(8 * ch + 2 * j + 1) * (VP / 2) + key] = (unsigned short)(w >> 16); }
}
template <int KS0, int NKS>
__device__ __forceinline__ f32x16 qk_block(const LAS unsigned char* lds, int kb, int r32, int hh, const bf16x8 (&qf)[4]) {
    f32x16 s = {0.f, 0.f, 0.f, 0.f, 0.f, 0.f, 0.f, 0.f, 0.f, 0.f, 0.f, 0.f, 0.f, 0.f, 0.f, 0.f};
#pragma unroll
    for (int ks = KS0; ks < KS0 + NKS; ++ks) {
        const bf16x8 kf = *(const LAS bf16x8*)(lds + L_KS + (kb * 32 + r32) * KP + ks * 32 + hh * 16);
        s = __builtin_amdgcn_mfma_f32_32x32x16_bf16(kf, qf[ks], s, 0, 0, 0);
    }
    return s;
}
__device__ __forceinline__ void softmax_pv(f32x16 (&s)[2], float& m, float& l, f32x16 (&O)[2], const LAS unsigned char* lds, int r32, int hh) {
    float mx = s[0][0];
#pragma unroll
    for (int r = 1; r < 16; ++r) mx = fmaxf(mx, s[0][r]);
#pragma unroll
    for (int r = 0; r < 16; ++r) mx = fmaxf(mx, s[1][r]);
    mx = xhalf_max(mx);
    __builtin_amdgcn_sched_barrier(0);
    const float mn = fmaxf(m, mx);
    const float alpha = __builtin_amdgcn_exp2f(m - mn);
    m = mn; l *= alpha;
#pragma unroll
    for (int r = 0; r < 16; ++r) { O[0][r] *= alpha; O[1][r] *= alpha; }
    float ps = 0.f;
#pragma unroll
    for (int kb = 0; kb < 2; ++kb)
#pragma unroll
        for (int r = 0; r < 16; ++r) { const float p = __builtin_amdgcn_exp2f(s[kb][r] - mn); s[kb][r] = p; ps += p; }
    l += ps;
    __builtin_amdgcn_sched_barrier(0);
#pragma unroll
    for (int kb = 0; kb < 2; ++kb)
#pragma unroll
        for (int sk = 0; sk < 2; ++sk) {
            __builtin_amdgcn_sched_barrier(0);
            u32x4 pw; pw.x = pkbf(s[kb][8 * sk + 0], s[kb][8 * sk + 1]); pw.y = pkbf(s[kb][8 * sk + 2], s[kb][8 * sk + 3]);
            pw.z = pkbf(s[kb][8 * sk + 4], s[kb][8 * sk + 5]); pw.w = pkbf(s[kb][8 * sk + 6], s[kb][8 * sk + 7]);
            const bf16x8 pf = __builtin_bit_cast(bf16x8, pw);
#pragma unroll
            for (int dvb = 0; dvb < 2; ++dvb) {
                const LAS unsigned char* a = lds + L_VT + (dvb * 32 + r32) * VP + (kb * 32 + 16 * sk + 4 * hh) * 2;
                const s16x4 lo = *(const LAS s16x4*)a, hi = *(const LAS s16x4*)(a + 16);
                const bf16x8 vf = {lo[0], lo[1], lo[2], lo[3], hi[0], hi[1], hi[2], hi[3]};
                O[dvb] = __builtin_amdgcn_mfma_f32_32x32x16_bf16(vf, pf, O[dvb], 0, 0, 0);
            }
        }
}
__device__ __forceinline__ void store_o(const f32x16 (&o)[2], bf16_t* orow, int hh) {
#pragma unroll
    for (int dvb = 0; dvb < 2; ++dvb)
#pragma unroll
        for (int g = 0; g < 4; ++g) {
            u32x2 w; w.x = pkbf(o[dvb][4 * g], o[dvb][4 * g + 1]); w.y = pkbf(o[dvb][4 * g + 2], o[dvb][4 * g + 3]);
            *(u32x2*)(orow + dvb * 32 + 8 * g + 4 * hh) = w;
        }
}

__device__ __forceinline__ void unit_A_safe(const bool CTXQ, LAS unsigned char* lds, const bf16_t* H, bf16_t* Ob, int b, int h, int qb, float lam, float ofac, const float* subw) {
    const int tid = pg8_ltid(), lane = tid & 63, r32 = lane & 31, hh = lane >> 5, wid = tid >> 6;
    const int qrow = CTXQ ? (ML + b * CTXL + wid * 32 + r32) : (b * SEQ + qb * 256 + wid * 32 + r32);
    const int qcol = h * 64, kcol = 256 + h * 64, vcol = 512 + h * 64;
    bf16x8 qf[4];
#pragma unroll
    for (int ks = 0; ks < 4; ++ks) qf[ks] = *(const bf16x8*)(H + (size_t)qrow * INC + qcol + 16 * ks + 8 * hh);
    const int NT = CTXQ ? 4 : 132;
    f32x16 O1[2], O2[2];
#pragma unroll
    for (int r = 0; r < 16; ++r) { O1[0][r] = 0.f; O1[1][r] = 0.f; O2[0][r] = 0.f; O2[1][r] = 0.f; }
    float m1 = -INFINITY, m2 = -INFINITY, l1 = 0.f, l2 = 0.f;
    TileRegs R;
    tile_gload(R, H, CTXQ ? (ML + b * CTXL) : (b * SEQ), kcol, vcol, tid);
    for (int t = 0; t < NT; ++t) {
        __syncthreads();
        tile_swrite(R, lds, tid);
        __syncthreads();
        if (t + 1 < NT) { const int tn = t + 1; const int krow = CTXQ ? (ML + b * CTXL + 64 * tn) : (tn < 128 ? b * SEQ + 64 * tn : ML + b * CTXL + 64 * (tn - 128)); tile_gload(R, H, krow, kcol, vcol, tid); }
        { f32x16 s[2]; s[0] = qk_block<0, 2>(lds, 0, r32, hh, qf); s[1] = qk_block<0, 2>(lds, 1, r32, hh, qf); softmax_pv(s, m1, l1, O1, lds, r32, hh); }
        __builtin_amdgcn_sched_barrier(0);
        { f32x16 s[2]; s[0] = qk_block<2, 2>(lds, 0, r32, hh, qf); s[1] = qk_block<2, 2>(lds, 1, r32, hh, qf); softmax_pv(s, m2, l2, O2, lds, r32, hh); }
        __builtin_amdgcn_sched_barrier(0);
    }
    l1 = xhalf_sum(l1); l2 = xhalf_sum(l2);
    const float i1 = 1.f / l1, i2 = lam / l2;
    float ss = 0.f;
#pragma unroll
    for (int dvb = 0; dvb < 2; ++dvb)
#pragma unroll
        for (int r = 0; r < 16; ++r) { const float o = O1[dvb][r] * i1 - O2[dvb][r] * i2; O1[dvb][r] = o; ss += o * o; }
    ss = xhalf_sum(ss);
    float li_ = ofac; asm volatile("" : "+s"(li_));
    const float rn = rsqrtf(ss * (1.f / 64.f) + 1e-6f) * (1.f - li_);
#pragma unroll
    for (int dvb = 0; dvb < 2; ++dvb)
#pragma unroll
        for (int g = 0; g < 4; ++g) {
            const f32x4 w = *(const f32x4*)(subw + dvb * 32 + 8 * g + 4 * hh);
#pragma unroll
            for (int e = 0; e < 4; ++e) O1[dvb][4 * g + e] *= rn * w[e];
        }
    store_o(O1, Ob + (size_t)qrow * DM + h * 64, hh);
}


constexpr int A_KP = 144, A_VP = 192, A_VOFF = 64 * A_KP, A_BUF = A_VOFF + 64 * A_VP;
constexpr float ATHR = 10.f;
typedef short v4i16_t __attribute__((ext_vector_type(4)));
__device__ __forceinline__ s16x4 vtr(const LAS unsigned char* p) { return __builtin_bit_cast(s16x4, __builtin_amdgcn_ds_read_tr16_b64_v4i16((LAS v4i16_t*)p)); }
__device__ __forceinline__ void tileA_swrite(const TileRegs& R, LAS unsigned char* buf, int tid) {
    const int key = tid >> 3, ch = tid & 7;
    *(LAS u32x4*)(buf + key * A_KP + ch * 16) = R.k;
    *(LAS u32x4*)(buf + A_VOFF + key * A_VP + ch * 16) = R.v;
}
__device__ __forceinline__ float max16(const f32x16& s) {
    float a = fmaxf(fmaxf(s[0], s[1]), s[2]), b = fmaxf(fmaxf(s[3], s[4]), s[5]), c = fmaxf(fmaxf(s[6], s[7]), s[8]), d = fmaxf(fmaxf(s[9], s[10]), s[11]);
    a = fmaxf(fmaxf(a, s[12]), s[13]); b = fmaxf(fmaxf(b, s[14]), s[15]);
    return fmaxf(fmaxf(a, b), fmaxf(c, d));
}
__device__ __forceinline__ float expsum16(f32x16& s) {
    float a = 0.f, b = 0.f, c = 0.f, d = 0.f;
#pragma unroll
    for (int r = 0; r < 16; r += 4) {
        s[r] = __builtin_amdgcn_exp2f(s[r]); s[r + 1] = __builtin_amdgcn_exp2f(s[r + 1]); s[r + 2] = __builtin_amdgcn_exp2f(s[r + 2]); s[r + 3] = __builtin_amdgcn_exp2f(s[r + 3]);
        a += s[r]; b += s[r + 1]; c += s[r + 2]; d += s[r + 3];
    }
    return (a + b) + (c + d);
}
__device__ __forceinline__ bf16x8 packp(const f32x16& s, int sk) {
    u32x4 pw; pw.x = pkbf(s[8 * sk + 0], s[8 * sk + 1]); pw.y = pkbf(s[8 * sk + 2], s[8 * sk + 3]); pw.z = pkbf(s[8 * sk + 4], s[8 * sk + 5]); pw.w = pkbf(s[8 * sk + 6], s[8 * sk + 7]);
    return __builtin_bit_cast(bf16x8, pw);
}
__device__ __forceinline__ void exp16(f32x16& s) {
#pragma unroll
    for (int r = 0; r < 16; ++r) s[r] = __builtin_amdgcn_exp2f(s[r]);
}
constexpr float AREF = 20.f, AGUARD = 60.f;
#ifndef SGB_V
#define SGB_V 5
#endif
template <bool HAVE>
__device__ __forceinline__ void stepA(bf16x8 (&pc)[2][2], const LAS unsigned char* kbuf, int kb, const LAS unsigned char* vb, const LAS unsigned char* qs, int r32, int hh,
                                      float mref1, float mref2, f32x16 (&O1)[2], f32x16 (&O2)[2], f32x16& L1, f32x16& L2, const bf16x8& ones) {
    const LAS unsigned char* kp = kbuf + (kb * 32 + r32) * A_KP + hh * 16;
    const bf16x8 k0 = *(const LAS bf16x8*)(kp), k1 = *(const LAS bf16x8*)(kp + 32), k2 = *(const LAS bf16x8*)(kp + 64), k3 = *(const LAS bf16x8*)(kp + 96);
    const bf16x8 q0 = *(const LAS bf16x8*)(qs), q1 = *(const LAS bf16x8*)(qs + 32), q2 = *(const LAS bf16x8*)(qs + 64), q3 = *(const LAS bf16x8*)(qs + 96);
    bf16x8 vf[2][2];
#pragma unroll
    for (int sk = 0; sk < 2; ++sk)
#pragma unroll
        for (int dvb = 0; dvb < 2; ++dvb) {
            const LAS unsigned char* a = vb + 16 * sk * A_VP + dvb * 64;
            const s16x4 lo = vtr(a), hi = vtr(a + 8 * A_VP);
            vf[sk][dvb] = (bf16x8){lo[0], lo[1], lo[2], lo[3], hi[0], hi[1], hi[2], hi[3]};
        }
    const f32x16 z = {0.f, 0.f, 0.f, 0.f, 0.f, 0.f, 0.f, 0.f, 0.f, 0.f, 0.f, 0.f, 0.f, 0.f, 0.f, 0.f};
    f32x16 s1 = __builtin_amdgcn_mfma_f32_32x32x16_bf16(k0, q0, z, 0, 0, 0);
    f32x16 s2 = __builtin_amdgcn_mfma_f32_32x32x16_bf16(k2, q2, z, 0, 0, 0);
    s1 = __builtin_amdgcn_mfma_f32_32x32x16_bf16(k1, q1, s1, 0, 0, 0);
    s2 = __builtin_amdgcn_mfma_f32_32x32x16_bf16(k3, q3, s2, 0, 0, 0);
#pragma unroll
    for (int sk = 0; sk < 2; ++sk) {
        L1 = __builtin_amdgcn_mfma_f32_32x32x16_bf16(ones, pc[0][sk], L1, 0, 0, 0);
        L2 = __builtin_amdgcn_mfma_f32_32x32x16_bf16(ones, pc[1][sk], L2, 0, 0, 0);
#pragma unroll
        for (int dvb = 0; dvb < 2; ++dvb) {
            O1[dvb] = __builtin_amdgcn_mfma_f32_32x32x16_bf16(vf[sk][dvb], pc[0][sk], O1[dvb], 0, 0, 0);
            O2[dvb] = __builtin_amdgcn_mfma_f32_32x32x16_bf16(vf[sk][dvb], pc[1][sk], O2[dvb], 0, 0, 0);
        }
    }
    if (HAVE) {
#pragma unroll
        for (int r = 0; r < 16; ++r) { s1[r] -= mref1; s2[r] -= mref2; }
    }
    exp16(s1); exp16(s2);
    bf16x8 pn[2][2];
    pn[0][0] = packp(s1, 0); pn[0][1] = packp(s1, 1); pn[1][0] = packp(s2, 0); pn[1][1] = packp(s2, 1);
#if 0
    __builtin_amdgcn_sched_group_barrier(0x008, 6, 0);
#pragma unroll
    for (int i = 0; i < 10; ++i) { __builtin_amdgcn_sched_group_barrier(0x002, SGB_V, 0); __builtin_amdgcn_sched_group_barrier(0x008, 1, 0); }
    __builtin_amdgcn_sched_group_barrier(0x002, 48, 0);
#endif
    pc[0][0] = pn[0][0]; pc[0][1] = pn[0][1]; pc[1][0] = pn[1][0]; pc[1][1] = pn[1][1];
}
__device__ __forceinline__ void unit_A(const bool CTXQ, LAS unsigned char* lds, const bf16_t* H, bf16_t* Ob, int b, int h, int qb, float lam, float ofac, const float* subw) {
    const int tid = pg8_ltid(), lane = tid & 63, r32 = lane & 31, hh = lane >> 5, wid = tid >> 6;
    const int qrow = CTXQ ? (ML + b * CTXL + wid * 32 + r32) : (b * SEQ + qb * 256 + wid * 32 + r32);
    const int qcol = h * 64, kcol = 256 + h * 64, vcol = 512 + h * 64;
    const int NT = CTXQ ? 4 : 132;
    f32x16 O1[2], O2[2], L1, L2;
#pragma unroll
    for (int r = 0; r < 16; ++r) { O1[0][r] = 0.f; O1[1][r] = 0.f; O2[0][r] = 0.f; O2[1][r] = 0.f; L1[r] = 0.f; L2[r] = 0.f; }
    const bf16x8 ones = {0x3F80, 0x3F80, 0x3F80, 0x3F80, 0x3F80, 0x3F80, 0x3F80, 0x3F80};
    const int voff = A_VOFF + (4 * hh + ((lane & 15) >> 2)) * A_VP + (((lane >> 4) & 1) * 16 + (lane & 3) * 4) * 2;
    const int krow0 = CTXQ ? (ML + b * CTXL) : (b * SEQ);
    LAS unsigned char* qs = lds + 3 * A_BUF + (wid * 32 + r32) * A_KP + hh * 16;
    volatile LAS unsigned* flag = (volatile LAS unsigned*)(lds + RING_BYTES + 128);
    TileRegs R;
    __syncthreads();
    if (tid == 0) *flag = 0u;
#pragma unroll
    for (int ks = 0; ks < 4; ++ks) *(LAS bf16x8*)(qs + ks * 32) = *(const bf16x8*)(H + (size_t)qrow * INC + qcol + 16 * ks + 8 * hh);
    tile_gload(R, H, krow0, kcol, vcol, tid);       tileA_swrite(R, lds, tid);
    tile_gload(R, H, krow0 + 64, kcol, vcol, tid);  tileA_swrite(R, lds + A_BUF, tid);
    tile_gload(R, H, krow0 + 128, kcol, vcol, tid);
    __syncthreads();
    bf16x8 pc[2][2];
    {
        const LAS unsigned char* kp = lds + r32 * A_KP + hh * 16;
        const f32x16 z = {0.f, 0.f, 0.f, 0.f, 0.f, 0.f, 0.f, 0.f, 0.f, 0.f, 0.f, 0.f, 0.f, 0.f, 0.f, 0.f};
        f32x16 sa1 = __builtin_amdgcn_mfma_f32_32x32x16_bf16(*(const LAS bf16x8*)(kp), *(const LAS bf16x8*)(qs), z, 0, 0, 0);
        sa1 = __builtin_amdgcn_mfma_f32_32x32x16_bf16(*(const LAS bf16x8*)(kp + 32), *(const LAS bf16x8*)(qs + 32), sa1, 0, 0, 0);
        f32x16 sa2 = __builtin_amdgcn_mfma_f32_32x32x16_bf16(*(const LAS bf16x8*)(kp + 64), *(const LAS bf16x8*)(qs + 64), z, 0, 0, 0);
        sa2 = __builtin_amdgcn_mfma_f32_32x32x16_bf16(*(const LAS bf16x8*)(kp + 96), *(const LAS bf16x8*)(qs + 96), sa2, 0, 0, 0);
        const float mx1 = xhalf_max(max16(sa1)), mx2 = xhalf_max(max16(sa2));
        if (__any((fabsf(mx1) > AREF) || (fabsf(mx2) > AREF)) != 0) *flag = 1u;
        exp16(sa1); exp16(sa2);
        pc[0][0] = packp(sa1, 0); pc[0][1] = packp(sa1, 1); pc[1][0] = packp(sa2, 0); pc[1][1] = packp(sa2, 1);
    }
    int bc = 0, t = 0;
#define UNITA_STAGE() \
        const int bn = (bc == 2 * A_BUF) ? 0 : bc + A_BUF, bw = (bn == 2 * A_BUF) ? 0 : bn + A_BUF; \
        if (t + 2 < NT) { \
            tileA_swrite(R, lds + bw, tid); \
            if (t + 3 < NT) { const int tn = t + 3; const int krow = CTXQ ? (krow0 + 64 * tn) : (tn < 128 ? b * SEQ + 64 * tn : ML + b * CTXL + 64 * (tn - 128)); tile_gload(R, H, krow, kcol, vcol, tid); } \
        }
#define UNITA_GUARD() (__any((L1[0] > 1.152921504606846976e18f) || (L2[0] > 1.152921504606846976e18f)) != 0)
    unsigned fl = 0u;
    {
        for (; t < NT; ++t) {
            if (__builtin_expect(fl != 0u, 0)) break;
            fl = *flag;
            if (__builtin_expect(UNITA_GUARD(), 0)) *flag = 1u;
            UNITA_STAGE()
            stepA<false>(pc, lds + bc, 1, lds + bc + voff, qs, r32, hh, 0.f, 0.f, O1, O2, L1, L2, ones);
            stepA<false>(pc, lds + bn, 0, lds + bc + voff + 32 * A_VP, qs, r32, hh, 0.f, 0.f, O1, O2, L1, L2, ones);
            __syncthreads();
            bc = bn;
        }
    }
#undef UNITA_STAGE
#undef UNITA_GUARD
    if (*flag != 0u) { unit_A_safe(CTXQ, lds, H, Ob, b, h, qb, lam, ofac, subw); return; }
    const float i1 = 1.f / L1[0], i2 = lam / L2[0];
    float ss = 0.f;
#pragma unroll
    for (int dvb = 0; dvb < 2; ++dvb)
#pragma unroll
        for (int r = 0; r < 16; ++r) { const float o = O1[dvb][r] * i1 - O2[dvb][r] * i2; O1[dvb][r] = o; ss += o * o; }
    ss = xhalf_sum(ss);
    float li_ = ofac; asm volatile("" : "+s"(li_));
    const float rn = rsqrtf(ss * (1.f / 64.f) + 1e-6f) * (1.f - li_);
#pragma unroll
    for (int dvb = 0; dvb < 2; ++dvb)
#pragma unroll
        for (int g = 0; g < 4; ++g) {
            const f32x4 w = *(const f32x4*)(subw + dvb * 32 + 8 * g + 4 * hh);
#pragma unroll
            for (int e = 0; e < 4; ++e) O1[dvb][4 * g + e] *= rn * w[e];
        }
    store_o(O1, Ob + (size_t)qrow * DM + h * 64, hh);
}

template <int MODE> __device__ __forceinline__ int tile_row_f(int t, int b, int lo, int nloc) {
    if (MODE == 1) return (t < nloc) ? (b * SEQ + 64 * (lo + t)) : (ML + b * CTXL + 64 * (t - nloc));
    if (MODE == 2) return (t < 4) ? (ML + b * CTXL + 64 * t) : (b * SEQ + 64 * (lo + t - 4));
    return ML + b * CTXL + 64 * t;
}
__device__ __forceinline__ int tile_row_r(int MODE, int t, int b, int lo, int nloc) {
    if (MODE == 1) return (t < nloc) ? (b * SEQ + 64 * (lo + t)) : (ML + b * CTXL + 64 * (t - nloc));
    if (MODE == 2) return (t < 4) ? (ML + b * CTXL + 64 * t) : (b * SEQ + 64 * (lo + t - 4));
    return ML + b * CTXL + 64 * t;
}
__device__ __forceinline__ void unit_BC(const int MODE, LAS unsigned char* lds, const bf16_t* H, bf16_t* Ob, int b, int hd, int blk, const float* sink_l, const float* rpb_l) {
    const int tid = pg8_ltid(), lane = tid & 63, r32 = lane & 31, hh = lane >> 5, wid = tid >> 6;
    int qrow, qcol, kcol, vcol, ocol, qpos = 0, r_w = 0, qc = 0, lo = 0, nloc = 0;
    float m = -INFINITY, l = 0.f;
    if (MODE == 1) {
        const int g = wid >> 2, head = hd * 2 + g; qpos = 128 * blk + 32 * (wid & 3) + r32; qrow = b * SEQ + qpos;
        qcol = 768 + head * 64; kcol = 1024 + hd * 64; vcol = 1152 + hd * 64; ocol = 256 + head * 64;
        lo = 2 * blk - 2; if (lo < 0) lo = 0; int hi = 2 * blk + 3; if (hi > 127) hi = 127; nloc = hi - lo + 1;
        m = sink_l[head] * LOG2E; l = (hh == 0) ? 1.f : 0.f;
    } else if (MODE == 3) {
        const int head = hd * 2 + blk; qrow = ML + b * CTXL + wid * 32 + r32;
        qcol = 768 + head * 64; kcol = 1024 + hd * 64; vcol = 1152 + hd * 64; ocol = 256 + head * 64;
        m = sink_l[head] * LOG2E; l = (hh == 0) ? 1.f : 0.f;
    } else if (MODE == 2) {
        r_w = 4 * blk + (wid >> 1); qc = 32 * (wid & 1) + r32; qrow = b * SEQ + r_w * 64 + qc;
        qcol = 1280 + hd * 64; kcol = 1536 + hd * 64; vcol = 1792 + hd * 64; ocol = 512 + hd * 64;
        int a0 = 4 * blk - 4; if (a0 < 0) a0 = 0; if (a0 > 120) a0 = 120; int a3 = 4 * blk + 3 - 4; if (a3 < 0) a3 = 0; if (a3 > 120) a3 = 120;
        lo = a0; nloc = a3 + 7 - a0 + 1;
    } else {
        qrow = ML + b * CTXL + wid * 32 + r32;
        qcol = 1280 + hd * 64; kcol = 1536 + hd * 64; vcol = 1792 + hd * 64; ocol = 512 + hd * 64;
    }
    bf16x8 qf[4];
#pragma unroll
    for (int ks = 0; ks < 4; ++ks) qf[ks] = *(const bf16x8*)(H + (size_t)qrow * INC + qcol + 16 * ks + 8 * hh);
    f32x16 O[2];
#pragma unroll
    for (int r = 0; r < 16; ++r) { O[0][r] = 0.f; O[1][r] = 0.f; }
    const int NT = 4 + nloc;
    int rs = 0;
    if (MODE == 2) { rs = r_w - 4; if (rs < 0) rs = 0; if (rs > 120) rs = 120; }
    const LAS float* rpbs = (const LAS float*)(lds + L_RPB);
    TileRegs R;
    tile_gload(R, H, tile_row_r(MODE, 0, b, lo, nloc), kcol, vcol, tid);
    for (int t = 0; t < NT; ++t) {
        __syncthreads();
        tile_swrite(R, lds, tid);
        if (MODE == 2 && t == 0) { for (int i = tid; i < 465; i += 512) ((LAS float*)(lds + L_RPB))[i] = rpb_l[hd * 465 + i] * LOG2E; }
        __syncthreads();
        if (t + 1 < NT) tile_gload(R, H, tile_row_r(MODE, t + 1, b, lo, nloc), kcol, vcol, tid);
        bool active = true; int kr = 0;
        if (MODE == 2 && t >= 4) { kr = lo + t - 4; active = (kr >= rs) && (kr < rs + 8); }
        if (active) {
            f32x16 s[2]; s[0] = qk_block<0, 4>(lds, 0, r32, hh, qf); s[1] = qk_block<0, 4>(lds, 1, r32, hh, qf);
            if (MODE == 1 && t < nloc) {
                const int kbase = 64 * (lo + t) - qpos;
#pragma unroll
                for (int kb = 0; kb < 2; ++kb)
#pragma unroll
                    for (int r = 0; r < 16; ++r) { const int d = kbase + kb * 32 + crow(r, hh); if (d > 128 || d < -128) s[kb][r] = -INFINITY; }
            }
            if (MODE == 2 && t >= 4) {
                int cs = qc - 8; if (cs < 0) cs = 0; if (cs > 48) cs = 48;
                const int bbase = (kr - r_w + 7) * 31 + 15 - qc;
#pragma unroll
                for (int kb = 0; kb < 2; ++kb)
#pragma unroll
                    for (int r = 0; r < 16; ++r) {
                        const int kc = kb * 32 + crow(r, hh);
                        const bool ok = (kc >= cs) && (kc < cs + 16);
                        int bi = bbase + kc; bi = ok ? bi : 0;
                        const float bias = rpbs[bi];
                        s[kb][r] = ok ? (s[kb][r] + bias) : -INFINITY;
                    }
            }
            softmax_pv(s, m, l, O, lds, r32, hh);
        }
    }
    l = xhalf_sum(l);
    const float il = 1.f / l;
#pragma unroll
    for (int r = 0; r < 16; ++r) { O[0][r] *= il; O[1][r] *= il; }
    store_o(O, Ob + (size_t)qrow * DM + ocol, hh);
}

template <int MODE>
__device__ __forceinline__ void bcf_compute(const LAS unsigned char* cur, int t, int nloc, int lo, int qpos, int kr, int r_w, int qc, const bf16x8 (&qf)[4], f32x16 (&O)[2], f32x16& L,
                                            const bf16x8& ones, const LAS float* rpbs, int voff, int r32, int hh) {
    f32x16 s[2];
    const f32x16 z = {0.f, 0.f, 0.f, 0.f, 0.f, 0.f, 0.f, 0.f, 0.f, 0.f, 0.f, 0.f, 0.f, 0.f, 0.f, 0.f};
#pragma unroll
    for (int kb = 0; kb < 2; ++kb) {
        const LAS unsigned char* kp = cur + (kb * 32 + r32) * A_KP + hh * 16;
        s[kb] = __builtin_amdgcn_mfma_f32_32x32x16_bf16(*(const LAS bf16x8*)(kp), qf[0], z, 0, 0, 0);
        s[kb] = __builtin_amdgcn_mfma_f32_32x32x16_bf16(*(const LAS bf16x8*)(kp + 32), qf[1], s[kb], 0, 0, 0);
        s[kb] = __builtin_amdgcn_mfma_f32_32x32x16_bf16(*(const LAS bf16x8*)(kp + 64), qf[2], s[kb], 0, 0, 0);
        s[kb] = __builtin_amdgcn_mfma_f32_32x32x16_bf16(*(const LAS bf16x8*)(kp + 96), qf[3], s[kb], 0, 0, 0);
    }
    if (MODE == 1 && t < nloc) {
        const int kbase = 64 * (lo + t) - qpos;
#pragma unroll
        for (int kb = 0; kb < 2; ++kb)
#pragma unroll
            for (int r = 0; r < 16; ++r) { const int d = kbase + kb * 32 + crow(r, hh); if (d > 128 || d < -128) s[kb][r] = -INFINITY; }
    }
    if (MODE == 2 && t >= 4) {
        int cs = qc - 8; if (cs < 0) cs = 0; if (cs > 48) cs = 48;
        const int bbase = (kr - r_w + 7) * 31 + 15 - qc;
#pragma unroll
        for (int kb = 0; kb < 2; ++kb)
#pragma unroll
            for (int r = 0; r < 16; ++r) {
                const int kc = kb * 32 + crow(r, hh);
                const bool ok = (kc >= cs) && (kc < cs + 16);
                int bi = bbase + kc; bi = ok ? bi : 0;
                const float bias = rpbs[bi];
                s[kb][r] = ok ? (s[kb][r] + bias) : -INFINITY;
            }
    }
#pragma unroll
    for (int kb = 0; kb < 2; ++kb) {
        exp16(s[kb]);
#pragma unroll
        for (int sk = 0; sk < 2; ++sk) {
            const bf16x8 p = packp(s[kb], sk);
            L = __builtin_amdgcn_mfma_f32_32x32x16_bf16(ones, p, L, 0, 0, 0);
#pragma unroll
            for (int dvb = 0; dvb < 2; ++dvb) {
                const LAS unsigned char* a = cur + voff + (kb * 32 + 16 * sk) * A_VP + dvb * 64;
                const s16x4 vlo = vtr(a), vhi = vtr(a + 8 * A_VP);
                const bf16x8 vf = {vlo[0], vlo[1], vlo[2], vlo[3], vhi[0], vhi[1], vhi[2], vhi[3]};
                O[dvb] = __builtin_amdgcn_mfma_f32_32x32x16_bf16(vf, p, O[dvb], 0, 0, 0);
            }
        }
    }
}
template <int MODE>
__device__ __forceinline__ bool unit_BC_fast(LAS unsigned char* lds, const bf16_t* H, bf16_t* Ob, int b, int hd, int blk, const float* sink_l, const float* rpb_l) {
    const int tid = pg8_ltid(), lane = tid & 63, r32 = lane & 31, hh = lane >> 5, wid = tid >> 6;
    int qrow, qcol, kcol, vcol, ocol, qpos = 0, r_w = 0, qc = 0, lo = 0, nloc = 0;
    float linit = 0.f;
    if (MODE == 1) {
        const int g = wid >> 2, head = hd * 2 + g; qpos = 128 * blk + 32 * (wid & 3) + r32; qrow = b * SEQ + qpos;
        qcol = 768 + head * 64; kcol = 1024 + hd * 64; vcol = 1152 + hd * 64; ocol = 256 + head * 64;
        lo = 2 * blk - 2; if (lo < 0) lo = 0; int hi = 2 * blk + 3; if (hi > 127) hi = 127; nloc = hi - lo + 1;
        linit = __builtin_amdgcn_exp2f(sink_l[head] * LOG2E);
    } else if (MODE == 3) {
        const int head = hd * 2 + blk; qrow = ML + b * CTXL + wid * 32 + r32;
        qcol = 768 + head * 64; kcol = 1024 + hd * 64; vcol = 1152 + hd * 64; ocol = 256 + head * 64;
        linit = __builtin_amdgcn_exp2f(sink_l[head] * LOG2E);
    } else if (MODE == 2) {
        r_w = 4 * blk + (wid >> 1); qc = 32 * (wid & 1) + r32; qrow = b * SEQ + r_w * 64 + qc;
        qcol = 1280 + hd * 64; kcol = 1536 + hd * 64; vcol = 1792 + hd * 64; ocol = 512 + hd * 64;
        int a0 = 4 * blk - 4; if (a0 < 0) a0 = 0; if (a0 > 120) a0 = 120; int a3 = 4 * blk + 3 - 4; if (a3 < 0) a3 = 0; if (a3 > 120) a3 = 120;
        lo = a0; nloc = a3 + 7 - a0 + 1;
    } else {
        qrow = ML + b * CTXL + wid * 32 + r32;
        qcol = 1280 + hd * 64; kcol = 1536 + hd * 64; vcol = 1792 + hd * 64; ocol = 512 + hd * 64;
    }
    bf16x8 qf[4];
#pragma unroll
    for (int ks = 0; ks < 4; ++ks) qf[ks] = *(const bf16x8*)(H + (size_t)qrow * INC + qcol + 16 * ks + 8 * hh);
    f32x16 O[2], L;
#pragma unroll
    for (int r = 0; r < 16; ++r) { O[0][r] = 0.f; O[1][r] = 0.f; L[r] = linit; }
    const bf16x8 ones = {0x3F80, 0x3F80, 0x3F80, 0x3F80, 0x3F80, 0x3F80, 0x3F80, 0x3F80};
    const int NT = 4 + nloc;
    int rs = 0;
    if (MODE == 2) { rs = r_w - 4; if (rs < 0) rs = 0; if (rs > 120) rs = 120; }
    const int voff = A_VOFF + (4 * hh + ((lane & 15) >> 2)) * A_VP + (((lane >> 4) & 1) * 16 + (lane & 3) * 4) * 2;
    LAS float* rpbs = (LAS float*)(lds + 2 * A_BUF);
    volatile LAS unsigned* flag = (volatile LAS unsigned*)(lds + RING_BYTES + 128);
    TileRegs Ra, Rb;
    __syncthreads();
    if (tid == 0) *flag = 0u;
    if (MODE == 2) { for (int i = tid; i < 465; i += 512) rpbs[i] = rpb_l[hd * 465 + i] * LOG2E; }
    tile_gload(Ra, H, tile_row_f<MODE>(0, b, lo, nloc), kcol, vcol, tid);
    tileA_swrite(Ra, lds, tid);
    tile_gload(Rb, H, tile_row_f<MODE>(1, b, lo, nloc), kcol, vcol, tid);
    tile_gload(Ra, H, tile_row_f<MODE>(2, b, lo, nloc), kcol, vcol, tid);
    __syncthreads();
#define BCF_TILE(T, RS) { \
        const int t = (T); \
        const LAS unsigned char* cur = lds + (t & 1) * A_BUF; \
        if (t + 1 < NT) { \
            tileA_swrite(RS, lds + ((t + 1) & 1) * A_BUF, tid); \
            if (t + 3 < NT) tile_gload(RS, H, tile_row_f<MODE>(t + 3, b, lo, nloc), kcol, vcol, tid); \
        } \
        bool active = true; int kr = 0; \
        if (MODE == 2 && t >= 4) { kr = lo + t - 4; active = (kr >= rs) && (kr < rs + 8); } \
        if (active) bcf_compute<MODE>(cur, t, nloc, lo, qpos, kr, r_w, qc, qf, O, L, ones, rpbs, voff, r32, hh); \
        __syncthreads(); }
    for (int t2 = 0; t2 < NT; t2 += 2) {
        BCF_TILE(t2, Rb)
        if (t2 + 1 < NT) BCF_TILE(t2 + 1, Ra)
    }
#undef BCF_TILE
    const float lsum = L[0];
    if (__any(!((lsum > 1e-30f) && (lsum < 1e30f))) != 0) *flag = 1u;
    __syncthreads();
    if (*flag != 0u) return true;
    const float il = 1.f / lsum;
#pragma unroll
    for (int r = 0; r < 16; ++r) { O[0][r] *= il; O[1][r] *= il; }
    store_o(O, Ob + (size_t)qrow * DM + ocol, hh);
    return false;
}
}
__device__ __forceinline__ float silu_f(float v) { return v / (1.f + __expf(-v)); }

__device__ __forceinline__ int wrow_map(int type, int n) {
    if (type == 1) { if (n < 512) { const int p = n & 31, blk = p >> 3; const int np = (blk == 1) ? p + 8 : ((blk == 2) ? p - 8 : p); return (n & ~31) + np; } return n; }
    if (type == 2) { const int half = (n >= 2816) ? 1 : 0; const int j = n - half * 2816; return (j >> 7) * 256 + half * 128 + (j & 127); }
    return n;
}
__device__ __forceinline__ void transpose_item(const float* W, int K, int N, bf16_t* WT, int type, LAS float* scr, int item, int lane) {
    const int nblk = N / 32, kb = item / nblk, nb = item - kb * nblk, k0 = 64 * kb, n0 = 32 * nb;
#pragma unroll 8
    for (int i = 0; i < 32; ++i) { const int kk = 2 * i + (lane >> 5); scr[kk * 33 + (lane & 31)] = W[(size_t)(k0 + kk) * N + n0 + (lane & 31)]; }
    asm volatile("s_waitcnt lgkmcnt(0)" ::: "memory");
    const int c = lane & 7;
#pragma unroll
    for (int j = 0; j < 4; ++j) {
        const int n = (lane >> 3) + 8 * j; const LAS float* s = scr + (8 * c) * 33 + n;
        u32x4 o; o.x = pkbf(s[0 * 33], s[1 * 33]); o.y = pkbf(s[2 * 33], s[3 * 33]); o.z = pkbf(s[4 * 33], s[5 * 33]); o.w = pkbf(s[6 * 33], s[7 * 33]);
        *(u32x4*)(WT + (size_t)wrow_map(type, n0 + n) * K + k0 + 8 * c) = o;
    }
    asm volatile("s_waitcnt lgkmcnt(0)" ::: "memory");
}

__device__ __forceinline__ void sincos_f(float x, float& c, float& s) {
    const float k = rintf(x * 0.636619772f);
    float r = fmaf(-k, 1.57079625129699707031f, x); r = fmaf(-k, 7.54978941586159635335e-08f, r);
    const float r2 = r * r;
    const float sr = r * (1.f + r2 * (-1.f / 6 + r2 * (1.f / 120 + r2 * (-1.f / 5040 + r2 * (1.f / 362880)))));
    const float cr = 1.f + r2 * (-0.5f + r2 * (1.f / 24 + r2 * (-1.f / 720 + r2 * (1.f / 40320 + r2 * (-1.f / 3628800)))));
    const int q = ((int)k) & 3;
    s = (q == 0) ? sr : (q == 1) ? cr : (q == 2) ? -sr : -cr;
    c = (q == 0) ? cr : (q == 1) ? -sr : (q == 2) ? -cr : sr;
}

__device__ __forceinline__ void norm_mod_row(const float* src, const float* nw, const float* sh, const float* sc, bf16_t* dst, int lane, const float* slab = nullptr, int nslab = 0, float* xout = nullptr) {
    u32x2* o8 = (u32x2*)dst + lane;
    if (src == nullptr) {
#pragma unroll
        for (int j = 0; j < 4; ++j) o8[64 * j] = (u32x2){0u, 0u};
        return;
    }
    const f32x4* xr = (const f32x4*)src + lane;
    f32x4 v[4]; float s = 0.f;
#pragma unroll
    for (int j = 0; j < 4; ++j) v[j] = xr[64 * j];
    for (int p = 0; p < nslab; ++p) {
        const f32x4* sr = (const f32x4*)(slab + (size_t)p * 1024 * 1024) + lane;
#pragma unroll
        for (int j = 0; j < 4; ++j) v[j] += sr[64 * j];
    }
    if (xout != nullptr) {
#pragma unroll
        for (int j = 0; j < 4; ++j) ((f32x4*)xout + lane)[64 * j] = v[j];
    }
#pragma unroll
    for (int j = 0; j < 4; ++j) s += (v[j][0] * v[j][0] + v[j][1] * v[j][1]) + (v[j][2] * v[j][2] + v[j][3] * v[j][3]);
    const float rstd = rsqrtf(wave_sum(s, lane) * (1.f / 1024.f) + 1e-6f);
#pragma unroll
    for (int j = 0; j < 4; ++j) {
        const int k = 4 * (64 * j + lane);
        const f32x4 w = *(const f32x4*)(nw + k), a = *(const f32x4*)(sc + k), d = *(const f32x4*)(sh + k);
        f32x4 y;
#pragma unroll
        for (int e = 0; e < 4; ++e) y[e] = (v[j][e] * rstd * w[e]) * (1.f + a[e]) + d[e];
        u32x2 p; p.x = pkbf(y[0], y[1]); p.y = pkbf(y[2], y[3]);
        o8[64 * j] = p;
    }
}

#define XB_TMO      128
#define XB_XCNT(j)  (256  + 64 * (j))
#define XB_XSUB(j)  (1280 + 64 * (j))
#define XB_XGEN(j)  (2304 + 64 * (j))
#define XB_TOP      3328
#define XB_TOPGEN   3392
#define XCD_BAR_WORDS 3456
#define XB_SPIN_CAP (1u << 18)

__device__ __forceinline__ unsigned xb_ld(unsigned* p)              { return __hip_atomic_load(p, __ATOMIC_RELAXED, __HIP_MEMORY_SCOPE_AGENT); }
__device__ __forceinline__ unsigned xb_add(unsigned* p, unsigned v) { return __hip_atomic_fetch_add(p, v, __ATOMIC_RELAXED, __HIP_MEMORY_SCOPE_AGENT); }
__device__ __forceinline__ unsigned xb_xcc_id() { return (unsigned)__builtin_amdgcn_s_getreg((3 << 11) | 20) & 0xFu; }
#define XB_SPIN(cond, bar) do { unsigned _sp = 0; while (cond) { __builtin_amdgcn_s_sleep(1); \
    if ((++_sp & 255u) == 0u) { if (xb_ld(&(bar)[XB_TMO])) break; if (_sp > XB_SPIN_CAP) { atomicAdd(&(bar)[XB_TMO], 1u); break; } } } } while (0)

struct XcdBarrier {
    unsigned* bar; unsigned x;
    volatile LAS unsigned* st;
};

__device__ __forceinline__ XcdBarrier xcd_barrier_post(unsigned* bar, volatile LAS unsigned* st) {
    XcdBarrier b; b.bar = bar; b.x = xb_xcc_id(); b.st = st;
    if (threadIdx.x == 0) (void)xb_add(&bar[XB_XCNT(b.x)], 1u);
    return b;
}
__device__ __forceinline__ void xcd_barrier_complete(unsigned* bar, unsigned x, unsigned& nloc, unsigned& nx) {
    const unsigned G = gridDim.x * gridDim.y * gridDim.z;
    unsigned sum, cnt, mine, sp = 0u;
    for (;;) {
        sum = 0u; cnt = 0u; mine = 0u;
#pragma unroll
        for (unsigned j = 0; j < 16; ++j) { const unsigned c = xb_ld(&bar[XB_XCNT(j)]); sum += c; cnt += (c > 0u) ? 1u : 0u; mine = (j == x) ? c : mine; }
        if (sum == G) break;
        __builtin_amdgcn_s_sleep(1);
        if ((++sp & 255u) == 0u) { if (xb_ld(&bar[XB_TMO])) break; if (sp > XB_SPIN_CAP) { atomicAdd(&bar[XB_TMO], 1u); break; } }
    }
    nloc = mine > 0u ? mine : 1u; nx = cnt > 0u ? cnt : 1u;
}

__device__ __forceinline__ void xcd_barrier(const XcdBarrier& b) {
    asm volatile("s_waitcnt vmcnt(0)" ::: "memory");
    __syncthreads();
    if (threadIdx.x == 0) {
        unsigned* bar = b.bar;
        __builtin_amdgcn_s_waitcnt(0);
        unsigned nloc = b.st[0], nx = b.st[1];
        if (nloc == 0u) { xcd_barrier_complete(bar, b.x, nloc, nx); b.st[0] = nloc; b.st[1] = nx; }
        const unsigned old = xb_add(&bar[XB_XSUB(b.x)], 1u);
        const unsigned gen = old / nloc;
        if (old + 1u == (gen + 1u) * nloc) {
            __builtin_amdgcn_fence(__ATOMIC_RELEASE, "agent");
            asm volatile("s_waitcnt vmcnt(0)" ::: "memory");
            const unsigned og = xb_add(&bar[XB_TOP], 1u);
            const unsigned tg = og / nx;
            if (og + 1u == (tg + 1u) * nx) xb_add(&bar[XB_TOPGEN], 1u);
            else XB_SPIN(xb_ld(&bar[XB_TOPGEN]) == tg, bar);
            __builtin_amdgcn_fence(__ATOMIC_ACQUIRE, "agent");
            xb_add(&bar[XB_XGEN(b.x)], 1u);
            asm volatile("s_waitcnt vmcnt(0)" ::: "memory");
        } else {
            XB_SPIN(xb_ld(&bar[XB_XGEN(b.x)]) == gen, bar);
            __builtin_amdgcn_fence(__ATOMIC_ACQUIRE, "agent");
            asm volatile("s_waitcnt vmcnt(0)" ::: "memory");
        }
    }
    __syncthreads();
}

struct Args { const float* in[23]; float* out; unsigned char* ws; int ph_lo, ph_hi, coop, pad; };
typedef const __attribute__((address_space(4))) Args* KArgs;
__device__ __forceinline__ KArgs kargs() { KArgs p = (KArgs)__builtin_amdgcn_kernarg_segment_ptr(); asm volatile("" : "+s"(p)); return p; }
constexpr int N_PHASES = 2 + 7 * DEPTH + 1;

__global__ void __launch_bounds__(512, 2) fwd_kernel(Args a) {
    extern __shared__ __attribute__((aligned(16))) unsigned char lds_raw[];
    LAS unsigned char* lds = (LAS unsigned char*)lds_raw;
    volatile LAS unsigned* bar_st = (volatile LAS unsigned*)(lds + RING_BYTES + 64);
    if (threadIdx.x < 2) bar_st[threadIdx.x] = 0u;
    __syncthreads();
    if (kargs()->coop) (void)xcd_barrier_post((unsigned*)kargs()->ws, bar_st);
    const int ph_lo = kargs()->ph_lo, ph_hi = kargs()->ph_hi;
    for (int ph = ph_lo; ph < ph_hi; ++ph) {
        KArgs ka = kargs();
        const int tid = pg8_ltid(), lane = tid & 63, wave = __builtin_amdgcn_readfirstlane(tid >> 6);
        int G = gridDim.x, bx = blockIdx.x; asm volatile("" : "+s"(G), "+s"(bx));
        const int vcu = (G % 8 == 0) ? (bx % 8) * (G / 8) + bx / 8 : bx;
        const int gw = vcu * 8 + wave, NGW = G * 8;
        unsigned char* ws = ka->ws;
        float* MOD = (float*)(ws + WS_MOD); float* MODP = (float*)(ws + WS_MODP);
        float* tabA = (float*)(ws + WS_TAB); float* tabB = tabA + 128 * 8 * 2;
        float* XCA = (float*)(ws + WS_XC); float* XCB = (float*)(ws + WS_MODP);
        bf16_t* XN = (bf16_t*)(ws + WS_XN); bf16_t* Ob = (bf16_t*)(ws + WS_O); bf16_t* Hb = (bf16_t*)(ws + WS_H); bf16_t* ACT = Hb;
        float* XL = ka->out;
        if (ph == 0) {
          {
            const float* w_mod = ka->in[6]; const float* c_in = ka->in[1]; const float* cctx_in = ka->in[3];
            for (int it = gw; it < 1536; it += NGW) {
                const int ks = it & 15, cgp = (it >> 4) % 24, l = it / 384;
                const int n0 = cgp * 256 + lane * 4;
                f32x4 acc[5];
#pragma unroll
                for (int s = 0; s < 5; ++s) acc[s] = (f32x4){0.f, 0.f, 0.f, 0.f};
                const float* wp = w_mod + ((size_t)l * 1024 + ks * 64) * 6144 + n0;
                for (int kk = 0; kk < 64; ++kk) {
                    const int k = ks * 64 + kk;
                    const f32x4 w = *(const f32x4*)(wp + (size_t)kk * 6144);
#pragma unroll
                    for (int s = 0; s < 4; ++s) acc[s] += silu_f(c_in[s * 1024 + k]) * w;
                    acc[4] += silu_f(cctx_in[k]) * w;
                }
#pragma unroll
                for (int s = 0; s < 5; ++s) *(f32x4*)(MODP + ((size_t)(ks * 4 + l) * 5 + s) * 6144 + n0) = acc[s];
            }
            LAS float* scr = (LAS float*)(lds + wave * 16384);
            for (int it = gw; it < 4 * 6144; it += NGW) {
                const int l = it / 6144; int r = it - l * 6144;
                unsigned char* wl = ws + WS_W + (size_t)l * W_LAYER;
                if (r < 1408) { transpose_item(ka->in[8] + (size_t)l * 1024 * 2816, 1024, 2816, (bf16_t*)wl, 1, scr, r, lane); continue; } r -= 1408;
                if (r < 512) { transpose_item(ka->in[9] + (size_t)l * 1024 * 1024, 1024, 1024, (bf16_t*)(wl + W_OUT_OFF), 0, scr, r, lane); continue; } r -= 512;
                if (r < 2816) { transpose_item(ka->in[18] + (size_t)l * 1024 * 5632, 1024, 5632, (bf16_t*)(wl + W_UP_OFF), 2, scr, r, lane); continue; } r -= 2816;
                transpose_item(ka->in[21] + (size_t)l * 2816 * 1024, 2816, 1024, (bf16_t*)(wl + W_DN_OFF), 0, scr, r, lane);
            }
            for (int idx = vcu * 512 + tid; idx < 3072; idx += G * 512) {
                int pos, i; float e;
                if (idx < 1024) { pos = idx >> 3; i = idx & 7; e = (float)i * 0.125f; } else { const int j = idx - 1024; pos = j >> 4; i = j & 15; e = (float)i * 0.0625f; }
                const float freq = exp2f(-e * 13.287712379549449f);
                const float ang = (float)pos * freq;
                float cc, ss; sincos_f(ang, cc, ss);
                float* tp = (idx < 1024) ? (tabA + idx * 2) : (tabB + (idx - 1024) * 2);
                tp[0] = cc; tp[1] = ss;
            }
          }
        } else if (ph == 1) {
            const float* b_mod = ka->in[7];
            for (int idx = vcu * 512 + tid; idx < 4 * 5 * 6144; idx += G * 512) {
                const int l = idx / 30720, n = idx % 6144;
                float s = b_mod[l * 6144 + n];
#pragma unroll
                for (int ks = 0; ks < 16; ++ks) s += MODP[(size_t)ks * 122880 + idx];
                MOD[idx] = s;
            }
        } else if (ph == N_PHASES - 1) {
            const float* fw = ka->in[22];
            for (int m = gw; m < ML; m += NGW) {
                f32x4* xr = (f32x4*)(XL + (size_t)m * DM) + lane;
                f32x4 v[4]; float s = 0.f;
#pragma unroll
                for (int j = 0; j < 4; ++j) { v[j] = xr[64 * j]; s += (v[j][0] * v[j][0] + v[j][1] * v[j][1]) + (v[j][2] * v[j][2] + v[j][3] * v[j][3]); }
                const float rstd = rsqrtf(wave_sum(s, lane) * (1.f / 1024.f) + 1e-6f);
#pragma unroll
                for (int j = 0; j < 4; ++j) { const f32x4 w = *(const f32x4*)(fw + 4 * (64 * j + lane)); xr[64 * j] = v[j] * rstd * w; }
            }
        } else {
            const int l = (ph - 2) / 7, k = (ph - 2) % 7;
            const bool need_ctx = l < DEPTH - 1;
            const float* modl = MOD + (size_t)l * 5 * 6144;
            unsigned char* wl = ws + WS_W + (size_t)l * W_LAYER;
            const float* srcL = (l == 0) ? ka->in[0] : XL;
            if (k == 0) {
                const float* nw = ka->in[4] + l * 1024;
                for (int m = gw; m < MT; m += NGW) {
                    const bool lat = m < ML; const int slot = lat ? (m >> 13) : 4;
                    if (lat) norm_mod_row(srcL + (size_t)m * DM, nw, modl + slot * 6144, modl + slot * 6144 + 1024, XN + (size_t)m * DM, lane);
                    else {
                        const size_t ro = (size_t)(m - ML) * DM;
                        norm_mod_row((l == 0 ? ka->in[2] : (const float*)XCB) + ro, nw, modl + slot * 6144, modl + slot * 6144 + 1024, XN + (size_t)m * DM, lane,
                                     (const float*)Ob + ro, (l == 0) ? 0 : 11, XCA + ro);
                    }
                }
            } else if (k == 1) {
                pg8::Gemm g{XN, (const bf16_t*)wl, MT, INC, DM, DM}; pg8::StaticOrder S; S.init(MT, INC, G, bx);
                pg8::EpiInProj E{Hb, tabA, tabB};
#ifndef DIS_IN
                pg8::gemm_phase<pg8::EpiInProj, pg8::StaticOrder, true, true>(lds, g, S, E);
#endif
            } else if (k == 2) {
                float lam, ofac;
                {
                    float d1 = 0.f, d2 = 0.f;
                    for (int i = 0; i < 32; ++i) { d1 += ka->in[10][l * 32 + i] * ka->in[11][l * 32 + i]; d2 += ka->in[12][l * 32 + i] * ka->in[13][l * 32 + i]; }
                    const float li = 0.8f - 0.6f * expf(-0.3f * (float)l);
                    lam = expf(d1) - expf(d2) + li;
                    lam = __uint_as_float(__builtin_amdgcn_readfirstlane(__float_as_uint(lam))); ofac = __uint_as_float(__builtin_amdgcn_readfirstlane(__float_as_uint(li)));
                }
                const float* subw = ka->in[14] + l * 64; const float* sink_l = ka->in[15] + l * 4; const float* rpb_l = ka->in[16] + (size_t)l * 4 * 465;
#ifndef DIS_A
                for (int u = vcu; u < 512 + (need_ctx ? 16 : 0); u += G) {
                    const bool cq = u >= 512; const int bh = cq ? (u - 512) : (u >> 5);
                    att::unit_A(cq, lds, Hb, Ob, bh >> 2, bh & 3, u & 31, lam, ofac, subw);
                }
#endif
#ifndef DIS_B
                for (int u = vcu; u < 1024 + (need_ctx ? 32 : 0); u += G) {
                    int mode, ub, uh, ublk; bool redo = true;
                    if (u < 512) { mode = 1; ub = u >> 7; uh = (u >> 6) & 1; ublk = u & 63; redo = att::unit_BC_fast<1>(lds, Hb, Ob, ub, uh, ublk, sink_l, rpb_l); }
                    else if (u < 1024) { const int v = u - 512; mode = 2; ub = v >> 7; uh = (v >> 5) & 3; ublk = v & 31; redo = att::unit_BC_fast<2>(lds, Hb, Ob, ub, uh, ublk, sink_l, rpb_l); }
                    else { const int v = u - 1024, bh = v & 15; if (v < 16) { mode = 3; ub = bh >> 2; uh = (bh >> 1) & 1; ublk = bh & 1; } else { mode = 4; ub = bh >> 2; uh = bh & 3; ublk = 0; } }
                    if (redo) att::unit_BC(mode, lds, Hb, Ob, ub, uh, ublk, sink_l, rpb_l);
                }
#endif
                {
                    const float* cwl = ka->in[17] + (size_t)l * 3 * 256;
                    const int rows = need_ctx ? MT : ML;
                    for (int idx = vcu * 512 + tid; idx < rows * 32; idx += G * 512) {
                        const int row = idx >> 5, c0 = (idx & 31) * 8;
                        int t, len; if (row < ML) { t = row & 8191; len = SEQ; } else { t = (row - ML) & 255; len = CTXL; }
                        const bf16_t* hp = Hb + (size_t)row * INC + 2048 + c0;
                        const u32x4 bg = *(const u32x4*)hp, cg1 = *(const u32x4*)(hp + 256), xi1 = *(const u32x4*)(hp + 512);
                        u32x4 cg0 = {0u, 0u, 0u, 0u}, xi0 = cg0, cg2 = cg0, xi2 = cg0;
                        if (t > 0) { cg0 = *(const u32x4*)(hp - INC + 256); xi0 = *(const u32x4*)(hp - INC + 512); }
                        if (t < len - 1) { cg2 = *(const u32x4*)(hp + INC + 256); xi2 = *(const u32x4*)(hp + INC + 512); }
                        float w0[8], w1[8], w2[8];
#pragma unroll
                        for (int e = 0; e < 8; ++e) { w0[e] = cwl[c0 + e]; w1[e] = cwl[256 + c0 + e]; w2[e] = cwl[512 + c0 + e]; }
                        u32x4 ow;
#pragma unroll
                        for (int e = 0; e < 4; ++e) {
                            const float ylo = w0[2 * e] * bflo(cg0[e]) * bflo(xi0[e]) + w1[2 * e] * bflo(cg1[e]) * bflo(xi1[e]) + w2[2 * e] * bflo(cg2[e]) * bflo(xi2[e]);
                            const float yhi = w0[2 * e + 1] * bfhi(cg0[e]) * bfhi(xi0[e]) + w1[2 * e + 1] * bfhi(cg1[e]) * bfhi(xi1[e]) + w2[2 * e + 1] * bfhi(cg2[e]) * bfhi(xi2[e]);
                            ow[e] = pkbf(bflo(bg[e]) * ylo, bfhi(bg[e]) * yhi);
                        }
                        *(u32x4*)(Ob + (size_t)row * DM + 768 + c0) = ow;
                    }
                }
                __syncthreads();
            } else if (k == 4) {
                const float* nw = ka->in[5] + l * 1024;
                const int nrows = (need_ctx ? NMX_ALL : NMX_L) * 256;
                for (int e = gw; e < nrows; e += NGW) {
                    const int pm = e >> 8, j = e & 255;
                    int t, slot; const float* base; int len;
                    if (pm < NMX_L) { const int s = pm / 33, ti = pm - s * 33; t = 254 * ti - 1 + j; len = SEQ; slot = s; base = XL + (size_t)s * SEQ * DM; }
                    else { const int p = 254 * (pm - NMX_L) - 1 + j; const int sq = (p < 0) ? 0 : p / 257, r = p - sq * 257; t = (p >= 0 && p < 1029 && r != 0) ? (r - 1) : -1; len = CTXL; slot = 4; base = XCA + (size_t)sq * CTXL * DM; }
                    const bool ok = (t >= 0 && t < len);
                    const float* src = ok ? (base + (size_t)t * DM) : nullptr;
                    if (pm < NMX_L || !ok) norm_mod_row(src, nw, modl + slot * 6144 + 3072, modl + slot * 6144 + 4096, XN + (size_t)e * DM, lane);
                    else {
                        const size_t ro = (size_t)(src - XCA);
                        norm_mod_row(src, nw, modl + slot * 6144 + 3072, modl + slot * 6144 + 4096, XN + (size_t)e * DM, lane, (const float*)Hb + ro, 4, XCB + ro);
                    }
                }
            } else if (k == 5) {
                const int nM = need_ctx ? NMX_ALL : NMX_L;
                pg8::Gemm g{XN, (const bf16_t*)(wl + W_UP_OFF), nM * 256, UPC, DM, DM}; pg8::StaticOrder S; S.init(nM * 256, UPC, G, bx);
                pg8::EpiUpConv E{ACT, ka->in[19] + (size_t)l * 3 * UPC, ka->in[20] + (size_t)l * UPC};
                pg8::OneUnit one;
#ifndef DIS_UP
                for (int i = 0; S.next(i, one.u); ++i) pg8::gemm_phase<pg8::EpiUpConv, pg8::OneUnit, false, true>(lds, g, one, E);
#endif
            } else {
                const bool isout = (k == 3); const int KK = isout ? DM : DFF;
                const bf16_t* Ap = isout ? (const bf16_t*)Ob : (const bf16_t*)ACT; const bf16_t* Bp = (const bf16_t*)(wl + (isout ? W_OUT_OFF : W_DN_OFF));
                {
                    pg8::Gemm g{Ap, Bp, ML, DM, KK, KK}; pg8::StaticOrder S; S.init(ML, DM, G, bx);
                    pg8::EpiRes E{isout ? srcL : (const float*)XL, nullptr, XL, nullptr, modl, isout ? 2048 : 5120};
#ifndef DIS_OUT
                    pg8::gemm_phase<pg8::EpiRes, pg8::StaticOrder, true, true>(lds, g, S, E);
#endif
                }
                if (need_ctx) {
                    const int P = isout ? 4 : 11, klen = KK / P;
                    for (int su = bx; su < 16 * P; su += G) {
                        const int tile = su / P, part = su - tile * P;
                        pg8::Gemm gs{Ap + (size_t)ML * KK + part * klen, Bp + part * klen, MC, DM, klen, KK};
                        pg8::OneUnit one; one.u.pm = tile >> 2; one.u.pn = tile & 3;
                        pg8::EpiSlab EA{(isout ? (float*)Hb : (float*)Ob) + (size_t)part * 1024 * 1024, modl + 4 * 6144 + (isout ? 2048 : 5120)};
                        pg8::gemm_phase<pg8::EpiSlab, pg8::OneUnit, false, true>(lds, gs, one, EA);
                    }
                }
            }
        }
        if (ph + 1 < ph_hi && kargs()->coop) {
            if (kargs()->coop == 2) cg::this_grid().sync();
            else { XcdBarrier b; b.bar = (unsigned*)kargs()->ws; b.x = xb_xcc_id(); b.st = bar_st; xcd_barrier(b); }
        }
    }
}

extern "C" void kernel_launch(void* const* d_in, const int* in_sizes, int n_in, void* d_out, int out_size, void* d_ws, size_t ws_size, hipStream_t stream) {
    static int grid = 0;
    if (grid == 0) {
        if (n_in != 23 || out_size != ML * DM || ws_size < WS_END) { fprintf(stderr, "kernel_launch: unexpected shapes (n_in %d out %d ws %zu need %zu)\n", n_in, out_size, ws_size, (size_t)WS_END); grid = -1; return; }
        int dev = 0, cus = 0, per_cu = 0;
        if (hipGetDevice(&dev) != hipSuccess || hipDeviceGetAttribute(&cus, hipDeviceAttributeMultiprocessorCount, dev) != hipSuccess) { grid = -1; return; }
        if (hipFuncSetAttribute((const void*)fwd_kernel, hipFuncAttributeMaxDynamicSharedMemorySize, LDS_BYTES) != hipSuccess) { fprintf(stderr, "kernel_launch: hipFuncSetAttribute failed\n"); grid = -1; return; }
        if (hipOccupancyMaxActiveBlocksPerMultiprocessor(&per_cu, (const void*)fwd_kernel, 512, LDS_BYTES) != hipSuccess || per_cu < 1) fprintf(stderr, "kernel_launch: occupancy query says %d\n", per_cu);
        (void)hipGetLastError();
        grid = cus;
    }
    if (grid < 0) return;
    Args a{};
    for (int i = 0; i < 23; ++i) a.in[i] = (const float*)d_in[i];
    a.out = (float*)d_out; a.ws = (unsigned char*)d_ws;
#if MK_MULTI
    for (int ph = 0; ph < N_PHASES; ++ph) {
        a.ph_lo = ph; a.ph_hi = ph + 1; a.coop = 0;
        hipLaunchKernelGGL(fwd_kernel, dim3(grid), dim3(512), LDS_BYTES, stream, a);
    }
#else
    a.ph_lo = 0; a.ph_hi = N_PHASES; a.coop = 1;
    if (hipMemsetAsync(d_ws, 0, 16384, stream) != hipSuccess) { fprintf(stderr, "kernel_launch: memset failed\n"); return; }
    void* args[] = {&a};
    hipError_t e = hipLaunchCooperativeKernel((const void*)fwd_kernel, dim3(grid), dim3(512), args, LDS_BYTES, stream);
    if (e != hipSuccess) fprintf(stderr, "cooperative launch failed: %s (grid %d)\n", hipGetErrorString(e), grid);
#endif
}
```

```cpp
#include <hip/hip_runtime.h>
#include <hip/hip_cooperative_groups.h>
#include <cstdio>
#include <cstdint>
namespace cg = cooperative_groups;

#ifndef MK_MULTI
#define MK_MULTI 0
#endif

#ifndef REP_IN
#define REP_IN 1
#endif
#ifndef REP_UP
#define REP_UP 1
#endif
#ifndef REP_A
#define REP_A 1
#endif
#ifndef REP_OD
#define REP_OD 1
#endif
#ifndef REP_P
#define REP_P 1
#endif
#ifndef REP_BC
#define REP_BC 1
#endif
#ifndef REP_M
#define REP_M 1
#endif

__device__ __forceinline__ int pg8_ltid() { int t = threadIdx.x; asm volatile("" : "+v"(t)); return t; }
namespace pg8 {
#define PG8_LAS __attribute__((address_space(3)))
typedef unsigned short bf16_t;
typedef short bf16x8 __attribute__((ext_vector_type(8)));
typedef float f32x4 __attribute__((ext_vector_type(4)));
typedef unsigned u32x4 __attribute__((ext_vector_type(4)));
constexpr int BM = 256, BK = 64, HALF = 128, HTB = HALF * BK * 2  , STAGE_BYTES = 8 * HTB, NXCD = 8, WGM = 8;

__host__ __device__ __forceinline__ int lds_byte(int r, int c) { const int st = (r >> 4) * 2 + (c >> 5), rr = r & 15, cc = c & 31, ob = rr * 64 + cc * 2; return st * 1024 + (ob ^ (((ob >> 9) & 1) << 5)); }
__host__ __device__ __forceinline__ void stage_rc(int b, int& R, int& C) { const int st = b / 1024, sb = b % 1024, swz = sb ^ (((sb >> 9) & 1) << 5); R = (st >> 1) * 16 + swz / 64; C = (st & 1) * 32 + (swz % 64) / 2; }
__host__ __device__ __forceinline__ int perm32(int rho) { const int n = rho >> 4, i = rho & 15; return 8 * (i >> 2) + 4 * n + (i & 3); }

struct Unit { int pm, pn; };
struct Gemm { const bf16_t* A; const bf16_t* Bt; int M, N, K, ldk; };

struct StaticOrder {
    int nM, nN, nwg, G, c;
    __host__ __device__ void init(int M, int N, int G_, int c_) { nM = M / BM; nN = N / BM; nwg = nM * nN; G = G_; c = c_; }
    __host__ __device__ bool next(int i, Unit& u) const {
        const long L = (long)i * G + c; if (L >= nwg) return false;
        int wgid = (int)L; { const int q = nwg / NXCD, r = nwg % NXCD, xcd = wgid % NXCD, off = wgid / NXCD; wgid = (xcd < r ? xcd * (q + 1) : r * (q + 1) + (xcd - r) * q) + off; }
        const int nig = WGM * nN, gid = wgid / nig, fm = gid * WGM, gsz = (nM - fm) < WGM ? (nM - fm) : WGM;
        u.pm = fm + ((wgid % nig) % gsz); u.pn = (wgid % nig) / gsz; return true;
    }
    __device__ __forceinline__ void a_ready(const Unit&) const {}
    __device__ __forceinline__ void done(const Unit&) const {}
};

typedef float pg8_f32x2 __attribute__((ext_vector_type(2))); typedef __bf16 pg8_bf16x2 __attribute__((ext_vector_type(2)));
__device__ __forceinline__ unsigned cvt_pk_bf16(float lo, float hi) { pg8_f32x2 v = {lo, hi}; pg8_bf16x2 b = __builtin_convertvector(v, pg8_bf16x2); return __builtin_bit_cast(unsigned, b); }
typedef unsigned u32x2 __attribute__((ext_vector_type(2)));

struct OneUnit {
    Unit u;
    __device__ __forceinline__ bool next(int i, Unit& o) const { if (i != 0) return false; o = u; return true; }
    __device__ __forceinline__ void a_ready(const Unit&) const {}
    __device__ __forceinline__ void done(const Unit&) const {}
};

struct EpiInProj {
    static constexpr bool PERM = false, AFTER_DRAIN = false;
    bf16_t* H; const float* tabA; const float* tabB;
    __device__ __forceinline__ void operator()(const f32x4 (&acc)[2][2][4][2], const Unit& u, int wr, int wc, int fr, int fq) const {
        const int pn = u.pn; const bool latent = u.pm < 128;
        const float scale = (pn == 0) ? 0.17677669529663687f * 1.4426950408889634f : ((pn == 3 || pn == 5) ? 0.125f * 1.4426950408889634f : 1.0f);
#pragma unroll
        for (int bj = 0; bj < 2; ++bj) {
            int mode = (pn == 0 || pn == 1) ? 1 : ((pn == 3 || (pn == 4 && bj == 0)) ? 2 : 0);
            if (!latent) mode = 0;
#ifdef TEST_NOROPE
            mode = 0;
#endif
#pragma unroll
            for (int ai = 0; ai < 2; ++ai)
#pragma unroll
                for (int m = 0; m < 4; ++m) {
                    const int r = u.pm * BM + ai * HALF + wr * 64 + m * 16 + fr;
                    f32x4 v0 = acc[ai][bj][m][0], v1 = acc[ai][bj][m][1];
                    if (mode != 0) {
                        const int t = r & 8191, trow = t >> 6, tcol = t & 63;
                        const float* tp;
                        if (mode == 1) { const int pos = (fq < 2) ? trow : tcol; tp = tabA + (pos * 8 + 4 * (fq & 1)) * 2; }
                        else { const int pos = (wc & 1) ? tcol : trow; tp = tabB + (pos * 16 + 4 * fq) * 2; }
                        const f32x4 cs0 = *(const f32x4*)tp, cs1 = *(const f32x4*)(tp + 4);
                        const float c0 = cs0[0], s0 = cs0[1], c1 = cs0[2], s1 = cs0[3], c2 = cs1[0], s2 = cs1[1], c3 = cs1[2], s3 = cs1[3];
                        f32x4 a = v0, b = v1;
                        v0[0] = a[0] * c0 - b[0] * s0; v1[0] = b[0] * c0 + a[0] * s0;
                        v0[1] = a[1] * c1 - b[1] * s1; v1[1] = b[1] * c1 + a[1] * s1;
                        v0[2] = a[2] * c2 - b[2] * s2; v1[2] = b[2] * c2 + a[2] * s2;
                        v0[3] = a[3] * c3 - b[3] * s3; v1[3] = b[3] * c3 + a[3] * s3;
                    }
                    v0 = v0 * scale; v1 = v1 * scale;
                    bf16_t* rowp = H + (size_t)r * 2816 + pn * BM + bj * HALF + wc * 32 + 4 * fq;
                    u32x2 w0, w1; w0.x = cvt_pk_bf16(v0[0], v0[1]); w0.y = cvt_pk_bf16(v0[2], v0[3]); w1.x = cvt_pk_bf16(v1[0], v1[1]); w1.y = cvt_pk_bf16(v1[2], v1[3]);
                    *(u32x2*)rowp = w0; *(u32x2*)(rowp + 16) = w1;
                }
        }
    }
};

struct EpiRes {
    static constexpr bool PERM = false, AFTER_DRAIN = false;
    const float* baseL; const float* baseC; float* outL; float* outC; const float* modl; int goff;
    __device__ __forceinline__ void operator()(const f32x4 (&acc)[2][2][4][2], const Unit& u, int wr, int wc, int fr, int fq) const {
        const bool ctx = u.pm >= 128; const int slot = ctx ? 4 : (u.pm >> 5);
        const int row0 = (ctx ? (u.pm - 128) : u.pm) * BM + wr * 64 + fr;
        const float* bp = ctx ? baseC : baseL; float* op = ctx ? outC : outL;
        const int col0 = u.pn * BM + wc * 32 + 4 * fq;
        f32x4 gv[2][2];
#pragma unroll
        for (int bj = 0; bj < 2; ++bj)
#pragma unroll
            for (int n = 0; n < 2; ++n) gv[bj][n] = *(const f32x4*)(modl + slot * 6144 + goff + col0 + bj * HALF + n * 16);
#pragma unroll
        for (int ai = 0; ai < 2; ++ai)
#pragma unroll
            for (int m = 0; m < 4; ++m) {
                const size_t off = (size_t)(row0 + ai * HALF + m * 16) * 1024 + col0;
#pragma unroll
                for (int bj = 0; bj < 2; ++bj)
#pragma unroll
                    for (int n = 0; n < 2; ++n) {
                        const f32x4 bs = *(const f32x4*)(bp + off + bj * HALF + n * 16);
                        *(f32x4*)(op + off + bj * HALF + n * 16) = bs + gv[bj][n] * acc[ai][bj][m][n];
                    }
                asm volatile("" ::: "memory");
            }
    }
};

struct EpiSlab {
    static constexpr bool PERM = false, AFTER_DRAIN = false;
    float* slab; const float* gate;
    __device__ __forceinline__ void operator()(const f32x4 (&acc)[2][2][4][2], const Unit& u, int wr, int wc, int fr, int fq) const {
        const int row0 = u.pm * BM + wr * 64 + fr, col0 = u.pn * BM + wc * 32 + 4 * fq;
#pragma unroll
        for (int bj = 0; bj < 2; ++bj)
#pragma unroll
            for (int n = 0; n < 2; ++n) {
                const f32x4 gv = *(const f32x4*)(gate + col0 + bj * HALF + n * 16);
#pragma unroll
                for (int ai = 0; ai < 2; ++ai)
#pragma unroll
                    for (int m = 0; m < 4; ++m)
                        *(f32x4*)(slab + (size_t)(row0 + ai * HALF + m * 16) * 1024 + col0 + bj * HALF + n * 16) = gv * acc[ai][bj][m][n];
            }
    }
};

struct EpiUpConv {
    static constexpr bool PERM = false, AFTER_DRAIN = true;
    bf16_t* ACT; const float* cw; const float* cb;
    static constexpr int TP = 520;
    __device__ __forceinline__ void fused(f32x4 (&acc)[2][2][4][2], const Unit& u, int wr, int wc, int fr, int fq, PG8_LAS unsigned char* lds, int wid, int lane) const {
#pragma unroll
        for (int ai = 0; ai < 2; ++ai)
#pragma unroll
            for (int m = 0; m < 4; ++m) {
                const int row = ai * HALF + wr * 64 + m * 16 + fr;
#pragma unroll
                for (int bj = 0; bj < 2; ++bj)
#pragma unroll
                    for (int n = 0; n < 2; ++n) {
                        const f32x4 v = acc[ai][bj][m][n]; u32x2 w; w.x = cvt_pk_bf16(v[0], v[1]); w.y = cvt_pk_bf16(v[2], v[3]);
                        *(PG8_LAS u32x2*)(lds + row * TP + (bj * HALF + wc * 32 + n * 16 + 4 * fq) * 2) = w;
                    }
            }
        const int tid = wid * 64 + lane, ch = tid & 15;
        const int gcol = u.pn * 128 + ch * 8;
        float wg[3][8], wv[3][8], bg[8], bv[8];
#pragma unroll
        for (int k = 0; k < 3; ++k) {
            const f32x4 a0 = *(const f32x4*)(cw + k * 5632 + gcol), a1 = *(const f32x4*)(cw + k * 5632 + gcol + 4);
            const f32x4 b0 = *(const f32x4*)(cw + k * 5632 + 2816 + gcol), b1 = *(const f32x4*)(cw + k * 5632 + 2816 + gcol + 4);
#pragma unroll
            for (int e = 0; e < 4; ++e) { wg[k][e] = a0[e]; wg[k][4 + e] = a1[e]; wv[k][e] = b0[e]; wv[k][4 + e] = b1[e]; }
        }
        {
            const f32x4 a0 = *(const f32x4*)(cb + gcol), a1 = *(const f32x4*)(cb + gcol + 4), b0 = *(const f32x4*)(cb + 2816 + gcol), b1 = *(const f32x4*)(cb + 2816 + gcol + 4);
#pragma unroll
            for (int e = 0; e < 4; ++e) { bg[e] = a0[e]; bg[4 + e] = a1[e]; bv[e] = b0[e]; bv[4 + e] = b1[e]; }
        }
        const bool lat = u.pm < 132; int rowbase, ti;
        if (lat) { const int s = u.pm / 33; ti = u.pm - s * 33; rowbase = s * 8192; } else { ti = u.pm - 132; rowbase = 32768; }
        asm volatile("s_waitcnt lgkmcnt(0)" ::: "memory"); __builtin_amdgcn_s_barrier(); asm volatile("" ::: "memory");
        for (int it = tid; it < 254 * 16; it += 512) {
            const int j = 1 + (it >> 4); const int p = 254 * ti - 1 + j;
            int orow; bool ok;
            if (lat) { ok = p < 8192; orow = rowbase + p; } else { const int sq = p / 257, r = p - sq * 257; ok = (p < 1029) && (r != 0); orow = rowbase + sq * 256 + r - 1; }
            if (ok) {
                float g[8], v[8];
#pragma unroll
                for (int e = 0; e < 8; ++e) { g[e] = bg[e]; v[e] = bv[e]; }
#pragma unroll
                for (int k = 0; k < 3; ++k) {
                    const PG8_LAS unsigned char* rp = lds + (j - 1 + k) * TP + ch * 16;
                    const u32x2 g0 = *(const PG8_LAS u32x2*)rp, g1 = *(const PG8_LAS u32x2*)(rp + 8);
                    const u32x2 v0 = *(const PG8_LAS u32x2*)(rp + 256), v1 = *(const PG8_LAS u32x2*)(rp + 264);
                    const unsigned gw[4] = {g0.x, g0.y, g1.x, g1.y}, vw[4] = {v0.x, v0.y, v1.x, v1.y};
#pragma unroll
                    for (int e = 0; e < 4; ++e) {
                        g[2 * e] += wg[k][2 * e] * __uint_as_float(gw[e] << 16); g[2 * e + 1] += wg[k][2 * e + 1] * __uint_as_float(gw[e] & 0xffff0000u);
                        v[2 * e] += wv[k][2 * e] * __uint_as_float(vw[e] << 16); v[2 * e + 1] += wv[k][2 * e + 1] * __uint_as_float(vw[e] & 0xffff0000u);
                    }
                }
                float o[8];
#pragma unroll
                for (int e = 0; e < 8; ++e) o[e] = g[e] / (1.f + __expf(-g[e])) * v[e];
                u32x4 w; w.x = cvt_pk_bf16(o[0], o[1]); w.y = cvt_pk_bf16(o[2], o[3]); w.z = cvt_pk_bf16(o[4], o[5]); w.w = cvt_pk_bf16(o[6], o[7]);
                *(u32x4*)(ACT + (size_t)orow * 2816 + gcol) = w;
            }
        }
        asm volatile("s_waitcnt lgkmcnt(0)" ::: "memory"); __builtin_amdgcn_s_barrier(); asm volatile("" ::: "memory");
    }
};
template <class Epi, class Sched, bool ALIGN_EPI = false, bool SP2 = false>
__device__ __forceinline__ void gemm_phase(PG8_LAS unsigned char* lds, const Gemm g, const Sched& S, const Epi& E) {
    const int tid = pg8_ltid(), wid = __builtin_amdgcn_readfirstlane(tid >> 6), lane = tid & 63, wr = wid >> 2, wc = wid & 3, fr = lane & 15, fq = lane >> 4;
    const int K = g.ldk, nt = g.K / BK;
    unsigned voffA[2], voffB[2];
#pragma unroll
    for (int i = 0; i < 2; ++i) { int R, C; stage_rc(tid * 16 + i * 8192, R, C); const int Rb = Epi::PERM ? ((R & ~31) + perm32(R & 31)) : R;
        voffA[i] = (unsigned)(R * K + C) * 2u; voffB[i] = (unsigned)(Rb * K + C) * 2u; }
    const size_t kstep = (size_t)(BK * 2);
    const size_t hstep = (size_t)HALF * K * 2;
    const size_t tstep = 2 * hstep;
    const unsigned ldsw = (unsigned)wid * 1024u;
    const int aoff = lds_byte(wr * 64 + fr, fq * 8), boff = lds_byte(wc * 32 + fr, fq * 8);
#define PG8_SA(b, h) (((b) * 2 + (h)) * HTB)
#define PG8_SB(b, h) ((4 + (b) * 2 + (h)) * HTB)
#define PG8_STAGE(bufoff, gbase, voff) do { _Pragma("unroll") for (int _i = 0; _i < 2; ++_i) \
        __builtin_amdgcn_global_load_lds((const unsigned*)((const char*)(gbase) + (voff)[_i]), (PG8_LAS unsigned*)(lds + (bufoff) + ldsw + _i * 8192), 16, 0, 0); } while (0)
#define PG8_LDA(dst, b, h) do { _Pragma("unroll") for (int m = 0; m < 4; ++m) _Pragma("unroll") for (int k = 0; k < 2; ++k) dst[m][k] = *(const PG8_LAS bf16x8*)(lds + PG8_SA(b, h) + aoff + m * 2048 + k * 1024); } while (0)
#define PG8_LDB(dst, b, h) do { _Pragma("unroll") for (int n = 0; n < 2; ++n) _Pragma("unroll") for (int k = 0; k < 2; ++k) dst[n][k] = *(const PG8_LAS bf16x8*)(lds + PG8_SB(b, h) + boff + n * 2048 + k * 1024); } while (0)
#define PG8_MMA(ai, bj, At, Bt) do { __builtin_amdgcn_s_setprio(1); _Pragma("unroll") for (int m = 0; m < 4; ++m) _Pragma("unroll") for (int n = 0; n < 2; ++n) _Pragma("unroll") for (int k = 0; k < 2; ++k) \
        acc[ai][bj][m][n] = __builtin_amdgcn_mfma_f32_16x16x32_bf16(Bt[n][k], At[m][k], acc[ai][bj][m][n], 0, 0, 0); __builtin_amdgcn_s_setprio(0); } while (0)
#define PG8_WAIT_V(n) asm volatile("s_waitcnt vmcnt(" #n ")" ::: "memory")
#define PG8_WAIT_L(n) asm volatile("s_waitcnt lgkmcnt(" #n ")" ::: "memory")
#define PG8_BAR __builtin_amdgcn_s_barrier()
#define PG8_SCHED __builtin_amdgcn_sched_barrier(0)
    Unit cur, nxt; int ui = 0;
    if (!S.next(0, cur)) return;
    f32x4 acc[2][2][4][2];
#pragma unroll
    for (int a = 0; a < 2; ++a)
#pragma unroll
        for (int b = 0; b < 2; ++b)
#pragma unroll
            for (int m = 0; m < 4; ++m)
#pragma unroll
                for (int n = 0; n < 2; ++n) acc[a][b][m][n] = (f32x4){0.f, 0.f, 0.f, 0.f};
    bf16x8 At[4][2], B0[2][2], B1[2][2];
    const char* cA = (const char*)g.A + (size_t)cur.pm * tstep; const char* cB = (const char*)g.Bt + (size_t)cur.pn * tstep;
    S.a_ready(cur);
    if constexpr (SP2) {
        PG8_STAGE(PG8_SB(0, 0), cB, voffB); PG8_STAGE(PG8_SB(0, 1), cB + hstep, voffB); PG8_STAGE(PG8_SA(0, 0), cA, voffA); PG8_STAGE(PG8_SA(0, 1), cA + hstep, voffA);
        if (wr == 1) PG8_BAR;
        PG8_WAIT_V(2); PG8_BAR;
        PG8_STAGE(PG8_SB(1, 0), cB + kstep, voffB); PG8_STAGE(PG8_SA(1, 0), cA + kstep, voffA); PG8_STAGE(PG8_SB(1, 1), cB + hstep + kstep, voffB);
        PG8_WAIT_V(6); PG8_BAR;
    } else {
        PG8_STAGE(PG8_SB(0, 0), cB, voffB); PG8_STAGE(PG8_SA(0, 0), cA, voffA); PG8_STAGE(PG8_SB(0, 1), cB + hstep, voffB); PG8_STAGE(PG8_SA(0, 1), cA + hstep, voffA);
        if (wr == 1) PG8_BAR;
        PG8_WAIT_V(4); PG8_BAR;
        PG8_STAGE(PG8_SB(1, 0), cB + kstep, voffB); PG8_STAGE(PG8_SA(1, 0), cA + kstep, voffA); PG8_STAGE(PG8_SB(1, 1), cB + hstep + kstep, voffB);
        PG8_WAIT_V(6); PG8_BAR;
    }
    for (;;) {
        const bool has_next = S.next(ui + 1, nxt);
        const char* nA = has_next ? (const char*)g.A + (size_t)nxt.pm * tstep : cA; const char* nB = has_next ? (const char*)g.Bt + (size_t)nxt.pn * tstep : cB;
        for (int t = 0; t < nt; t += 2) {
            const bool last = (t == nt - 2);
            const char* a1 = cA + (size_t)(t + 1) * kstep;
            const char* a2 = last ? nA : cA + (size_t)(t + 2) * kstep; const char* b2 = last ? nB : cB + (size_t)(t + 2) * kstep;
            const char* a3 = a2 + kstep; const char* b3 = b2 + kstep;
            if (last && has_next) S.a_ready(nxt);
            if constexpr (SP2) {
            PG8_LDB(B0, 0, 0); PG8_LDB(B1, 0, 1); PG8_SCHED; PG8_LDA(At, 0, 0); PG8_STAGE(PG8_SA(1, 1), a1 + hstep, voffA);
            PG8_WAIT_V(8); PG8_WAIT_L(0); PG8_BAR; PG8_MMA(0, 0, At, B0); PG8_MMA(0, 1, At, B1); PG8_BAR; PG8_SCHED;
            PG8_LDA(At, 0, 1); PG8_STAGE(PG8_SB(0, 0), b2, voffB); PG8_STAGE(PG8_SB(0, 1), b2 + hstep, voffB); PG8_STAGE(PG8_SA(0, 0), a2, voffA);
            PG8_WAIT_V(8); PG8_WAIT_L(0); PG8_BAR; PG8_MMA(1, 0, At, B0); PG8_MMA(1, 1, At, B1); PG8_BAR; PG8_SCHED;
            PG8_LDB(B0, 1, 0); PG8_LDB(B1, 1, 1); PG8_SCHED; PG8_LDA(At, 1, 0); PG8_STAGE(PG8_SA(0, 1), a2 + hstep, voffA);
            PG8_WAIT_V(8); PG8_WAIT_L(0); PG8_BAR; PG8_MMA(0, 0, At, B0); PG8_MMA(0, 1, At, B1); PG8_BAR; PG8_SCHED;
            PG8_LDA(At, 1, 1); PG8_STAGE(PG8_SB(1, 0), b3, voffB); PG8_STAGE(PG8_SB(1, 1), b3 + hstep, voffB); PG8_STAGE(PG8_SA(1, 0), a3, voffA);
            PG8_WAIT_V(8); PG8_WAIT_L(0); PG8_BAR; PG8_MMA(1, 0, At, B0); PG8_MMA(1, 1, At, B1); PG8_BAR; PG8_SCHED;
            } else {
            PG8_LDB(B0, 0, 0); PG8_SCHED; PG8_LDA(At, 0, 0); PG8_STAGE(PG8_SA(1, 1), a1 + hstep, voffA);
            PG8_WAIT_L(8); PG8_BAR; PG8_WAIT_L(0); PG8_MMA(0, 0, At, B0); PG8_BAR; PG8_SCHED;
            PG8_LDB(B1, 0, 1); PG8_STAGE(PG8_SB(0, 0), b2, voffB);
            PG8_BAR; PG8_WAIT_L(0); PG8_MMA(0, 1, At, B1); PG8_BAR;
            PG8_LDA(At, 0, 1); PG8_STAGE(PG8_SA(0, 0), a2, voffA);
            PG8_BAR; PG8_WAIT_L(0); PG8_MMA(1, 0, At, B0); PG8_BAR; PG8_SCHED;
            PG8_STAGE(PG8_SB(0, 1), b2 + hstep, voffB);
            PG8_WAIT_V(6); PG8_BAR; PG8_MMA(1, 1, At, B1); PG8_BAR;
            PG8_LDB(B0, 1, 0); PG8_SCHED; PG8_LDA(At, 1, 0); PG8_STAGE(PG8_SA(0, 1), a2 + hstep, voffA);
            PG8_WAIT_L(8); PG8_BAR; PG8_WAIT_L(0); PG8_MMA(0, 0, At, B0); PG8_BAR; PG8_SCHED;
            PG8_LDB(B1, 1, 1); PG8_STAGE(PG8_SB(1, 0), b3, voffB);
            PG8_BAR; PG8_WAIT_L(0); PG8_MMA(0, 1, At, B1); PG8_BAR;
            PG8_LDA(At, 1, 1); PG8_STAGE(PG8_SA(1, 0), a3, voffA);
            PG8_BAR; PG8_WAIT_L(0); PG8_MMA(1, 0, At, B0); PG8_BAR; PG8_SCHED;
            PG8_STAGE(PG8_SB(1, 1), b3 + hstep, voffB);
            PG8_WAIT_V(6); PG8_BAR; PG8_MMA(1, 1, At, B1); PG8_BAR;
            }
        }
        if constexpr (ALIGN_EPI) { if (wr == 0) PG8_BAR; }
        if constexpr (!Epi::AFTER_DRAIN) { E(acc, cur, wr, wc, fr, fq); S.done(cur); }
        if (!has_next) break;
#pragma unroll
        for (int a = 0; a < 2; ++a)
#pragma unroll
            for (int b = 0; b < 2; ++b)
#pragma unroll
                for (int m = 0; m < 4; ++m)
#pragma unroll
                    for (int n = 0; n < 2; ++n) acc[a][b][m][n] = (f32x4){0.f, 0.f, 0.f, 0.f};
        cur = nxt; cA = nA; cB = nB; ++ui;
        if constexpr (ALIGN_EPI) { if (wr == 1) PG8_BAR; }
    }
    PG8_WAIT_V(0);
    if constexpr (!ALIGN_EPI) { if (wr == 0) PG8_BAR; }
    PG8_BAR;
    if constexpr (Epi::AFTER_DRAIN) { E.fused(acc, cur, wr, wc, fr, fq, lds, wid, lane); S.done(cur); }
#undef PG8_SA
#undef PG8_SB
#undef PG8_STAGE
#undef PG8_LDA
#undef PG8_LDB
#undef PG8_MMA
#undef PG8_WAIT_V
#undef PG8_WAIT_L
#undef PG8_BAR
#undef PG8_SCHED
}
}
#define LAS __attribute__((address_space(3)))
typedef unsigned short bf16_t;
typedef short bf16x8 __attribute__((ext_vector_type(8)));
typedef short s16x4 __attribute__((ext_vector_type(4)));
typedef float f32x4 __attribute__((ext_vector_type(4)));
typedef float f32x16 __attribute__((ext_vector_type(16)));
typedef unsigned u32x4 __attribute__((ext_vector_type(4)));
typedef unsigned u32x2 __attribute__((ext_vector_type(2)));

constexpr int DM = 1024, NB = 4, SEQ = 8192, DEPTH = 4, CTXL = 256;
constexpr int ML = NB * SEQ, MC = NB * CTXL, MT = ML + MC;
constexpr int INC = 2816, DFF = 2816, UPC = 5632;
constexpr int NMX_L = NB * 33, NMX_ALL = NB * 33 + 5;
constexpr float LOG2E = 1.4426950408889634f;

constexpr size_t MiB = 1u << 20;
constexpr size_t WS_MOD = 1 * MiB;
constexpr size_t WS_MODP = 2 * MiB;
constexpr size_t WS_TAB = 10 * MiB;
constexpr size_t WS_XC = 11 * MiB;
constexpr size_t WS_W = 16 * MiB;
constexpr size_t W_LAYER = 24 * MiB, W_OUT_OFF = (size_t)2816 * 1024 * 2, W_UP_OFF = W_OUT_OFF + (size_t)1024 * 1024 * 2, W_DN_OFF = W_UP_OFF + (size_t)5632 * 1024 * 2;
constexpr size_t WS_XN = 112 * MiB;
constexpr size_t WS_O = 182 * MiB;
constexpr size_t WS_H = 248 * MiB;
constexpr size_t WS_END = WS_H + (size_t)MT * 2816 * 2;
static_assert(W_DN_OFF + (size_t)1024 * 2816 * 2 <= W_LAYER, "weights per layer");
static_assert(WS_XN + (size_t)NMX_ALL * 256 * 1024 * 2 <= WS_O && WS_O + (size_t)MT * 1024 * 2 <= WS_H && WS_END <= 512 * MiB, "ws map");

constexpr int RING_BYTES = 135168;
constexpr int LDS_BYTES = 147456;

__device__ __forceinline__ unsigned pkbf(float lo, float hi) { return pg8::cvt_pk_bf16(lo, hi); }
__device__ __forceinline__ float bflo(unsigned w) { return __uint_as_float(w << 16); }
__device__ __forceinline__ float bfhi(unsigned w) { return __uint_as_float(w & 0xffff0000u); }
__device__ __forceinline__ float dpp_add(float v, const int ctrl_sel) {
    int m;
    if (ctrl_sel == 0) m = __builtin_amdgcn_update_dpp(0, __float_as_int(v), 0xB1, 0xF, 0xF, true);
    else if (ctrl_sel == 1) m = __builtin_amdgcn_update_dpp(0, __float_as_int(v), 0x4E, 0xF, 0xF, true);
    else if (ctrl_sel == 2) m = __builtin_amdgcn_update_dpp(0, __float_as_int(v), 0x124, 0xF, 0xF, true);
    else m = __builtin_amdgcn_update_dpp(0, __float_as_int(v), 0x128, 0xF, 0xF, true);
    return v + __int_as_float(m);
}
__device__ __forceinline__ float wave_sum(float v, int lane) {
    v = dpp_add(v, 0); v = dpp_add(v, 1); v = dpp_add(v, 2); v = dpp_add(v, 3);
    v += __int_as_float(__builtin_amdgcn_ds_bpermute((lane ^ 16) << 2, __float_as_int(v)));
    auto rr = __builtin_amdgcn_permlane32_swap(__float_as_uint(v), __float_as_uint(v), false, false);
    return __uint_as_float(rr[0]) + __uint_as_float(rr[1]);
}
__device__ __forceinline__ float xhalf_max(float v) { auto rr = __builtin_amdgcn_permlane32_swap(__float_as_uint(v), __float_as_uint(v), false, false); return fmaxf(__uint_as_float(rr[0]), __uint_as_float(rr[1])); }
__device__ __forceinline__ float xhalf_sum(float v) { auto rr = __builtin_amdgcn_permlane32_swap(__float_as_uint(v), __float_as_uint(v), false, false); return __uint_as_float(rr[0]) + __uint_as_float(rr[1]); }

namespace att {
constexpr int KP = 144, VP = 136;
constexpr int L_KS = 0, L_VT = 64 * KP, L_RPB = L_VT + 64 * VP, L_END = L_RPB + 2048;
__device__ __forceinline__ int crow(int r, int h) { return (r & 3) + 8 * (r >> 2) + 4 * h; }

struct TileRegs { u32x4 k, v; };
__device__ __forceinline__ void tile_gload(TileRegs& R, const bf16_t* H, int krow, int kcol, int vcol, int tid) {
    const int key = tid >> 3, ch = tid & 7;
    const bf16_t* p = H + (size_t)(krow + key) * INC;
    R.k = *(const u32x4*)(p + kcol + 8 * ch); R.v = *(const u32x4*)(p + vcol + 8 * ch);
}
__device__ __forceinline__ void tile_swrite(const TileRegs& R, LAS unsigned char* lds, int tid) {
    const int key = tid >> 3, ch = tid & 7;
    *(LAS u32x4*)(lds + L_KS + key * KP + ch * 16) = R.k;
    LAS unsigned short* vt = (LAS unsigned short*)(lds + L_VT);
#pragma unroll
    for (int j = 0; j < 4; ++j) { const unsigned w = R.v[j]; vt[(8 * ch + 2 * j) * (VP / 2) + key] = (unsigned short)(w & 0xffffu); vt[(8 * ch + 2 * j + 1) * (VP / 2) + key] = (unsigned short)(w >> 16); }
}
template <int KS0, int NKS>
__device__ __forceinline__ f32x16 qk_block(const LAS unsigned char* lds, int kb, int r32, int hh, const bf16x8 (&qf)[4]) {
    f32x16 s = {0.f, 0.f, 0.f, 0.f, 0.f, 0.f, 0.f, 0.f, 0.f, 0.f, 0.f, 0.f, 0.f, 0.f, 0.f, 0.f};
#pragma unroll
    for (int ks = KS0; ks < KS0 + NKS; ++ks) {
        const bf16x8 kf = *(const LAS bf16x8*)(lds + L_KS + (kb * 32 + r32) * KP + ks * 32 + hh * 16);
        s = __builtin_amdgcn_mfma_f32_32x32x16_bf16(kf, qf[ks], s, 0, 0, 0);
    }
    return s;
}
__device__ __forceinline__ void softmax_pv(f32x16 (&s)[2], float& m, float& l, f32x16 (&O)[2], const LAS unsigned char* lds, int r32, int hh) {
    float mx = s[0][0];
#pragma unroll
    for (int r = 1; r < 16; ++r) mx = fmaxf(mx, s[0][r]);
#pragma unroll
    for (int r = 0; r < 16; ++r) mx = fmaxf(mx, s[1][r]);
    mx = xhalf_max(mx);
    __builtin_amdgcn_sched_barrier(0);
    const float mn = fmaxf(m, mx);
    const float alpha = __builtin_amdgcn_exp2f(m - mn);
    m = mn; l *= alpha;
#pragma unroll
    for (int r = 0; r < 16; ++r) { O[0][r] *= alpha; O[1][r] *= alpha; }
    float ps = 0.f;
#pragma unroll
    for (int kb = 0; kb < 2; ++kb)
#pragma unroll
        for (int r = 0; r < 16; ++r) { const float p = __builtin_amdgcn_exp2f(s[kb][r] - mn); s[kb][r] = p; ps += p; }
    l += ps;
    __builtin_amdgcn_sched_barrier(0);
#pragma unroll
    for (int kb = 0; kb < 2; ++kb)
#pragma unroll
        for (int sk = 0; sk < 2; ++sk) {
            __builtin_amdgcn_sched_barrier(0);
            u32x4 pw; pw.x = pkbf(s[kb][8 * sk + 0], s[kb][8 * sk + 1]); pw.y = pkbf(s[kb][8 * sk + 2], s[kb][8 * sk + 3]);
            pw.z = pkbf(s[kb][8 * sk + 4], s[kb][8 * sk + 5]); pw.w = pkbf(s[kb][8 * sk + 6], s[kb][8 * sk + 7]);
            const bf16x8 pf = __builtin_bit_cast(bf16x8, pw);
#pragma unroll
            for (int dvb = 0; dvb < 2; ++dvb) {
                const LAS unsigned char* a = lds + L_VT + (dvb * 32 + r32) * VP + (kb * 32 + 16 * sk + 4 * hh) * 2;
                const s16x4 lo = *(const LAS s16x4*)a, hi = *(const LAS s16x4*)(a + 16);
                const bf16x8 vf = {lo[0], lo[1], lo[2], lo[3], hi[0], hi[1], hi[2], hi[3]};
                O[dvb] = __builtin_amdgcn_mfma_f32_32x32x16_bf16(vf, pf, O[dvb], 0, 0, 0);
            }
        }
}
__device__ __forceinline__ void store_o(const f32x16 (&o)[2], bf16_t* orow, int hh) {
#pragma unroll
    for (int dvb = 0; dvb < 2; ++dvb)
#pragma unroll
        for (int g = 0; g < 4; ++g) {
            u32x2 w; w.x = pkbf(o[dvb][4 * g], o[dvb][4 * g + 1]); w.y = pkbf(o[dvb][4 * g + 2], o[dvb][4 * g + 3]);
            *(u32x2*)(orow + dvb * 32 + 8 * g + 4 * hh) = w;
        }
}

__device__ __forceinline__ void unit_A_safe(const bool CTXQ, LAS unsigned char* lds, const bf16_t* H, bf16_t* Ob, int b, int h, int qb, float lam, float ofac, const float* subw) {
    const int tid = pg8_ltid(), lane = tid & 63, r32 = lane & 31, hh = lane >> 5, wid = tid >> 6;
    const int qrow = CTXQ ? (ML + b * CTXL + wid * 32 + r32) : (b * SEQ + qb * 256 + wid * 32 + r32);
    const int qcol = h * 64, kcol = 256 + h * 64, vcol = 512 + h * 64;
    bf16x8 qf[4];
#pragma unroll
    for (int ks = 0; ks < 4; ++ks) qf[ks] = *(const bf16x8*)(H + (size_t)qrow * INC + qcol + 16 * ks + 8 * hh);
    const int NT = CTXQ ? 4 : 132;
    f32x16 O1[2], O2[2];
#pragma unroll
    for (int r = 0; r < 16; ++r) { O1[0][r] = 0.f; O1[1][r] = 0.f; O2[0][r] = 0.f; O2[1][r] = 0.f; }
    float m1 = -INFINITY, m2 = -INFINITY, l1 = 0.f, l2 = 0.f;
    TileRegs R;
    tile_gload(R, H, CTXQ ? (ML + b * CTXL) : (b * SEQ), kcol, vcol, tid);
    for (int t = 0; t < NT; ++t) {
        __syncthreads();
        tile_swrite(R, lds, tid);
        __syncthreads();
        if (t + 1 < NT) { const int tn = t + 1; const int krow = CTXQ ? (ML + b * CTXL + 64 * tn) : (tn < 128 ? b * SEQ + 64 * tn : ML + b * CTXL + 64 * (tn - 128)); tile_gload(R, H, krow, kcol, vcol, tid); }
        { f32x16 s[2]; s[0] = qk_block<0, 2>(lds, 0, r32, hh, qf); s[1] = qk_block<0, 2>(lds, 1, r32, hh, qf); softmax_pv(s, m1, l1, O1, lds, r32, hh); }
        __builtin_amdgcn_sched_barrier(0);
        { f32x16 s[2]; s[0] = qk_block<2, 2>(lds, 0, r32, hh, qf); s[1] = qk_block<2, 2>(lds, 1, r32, hh, qf); softmax_pv(s, m2, l2, O2, lds, r32, hh); }
        __builtin_amdgcn_sched_barrier(0);
    }
    l1 = xhalf_sum(l1); l2 = xhalf_sum(l2);
    const float i1 = 1.f / l1, i2 = lam / l2;
    float ss = 0.f;
#pragma unroll
    for (int dvb = 0; dvb < 2; ++dvb)
#pragma unroll
        for (int r = 0; r < 16; ++r) { const float o = O1[dvb][r] * i1 - O2[dvb][r] * i2; O1[dvb][r] = o; ss += o * o; }
    ss = xhalf_sum(ss);
    float li_ = ofac; asm volatile("" : "+s"(li_));
    const float rn = rsqrtf(ss * (1.f / 64.f) + 1e-6f) * (1.f - li_);
#pragma unroll
    for (int dvb = 0; dvb < 2; ++dvb)
#pragma unroll
        for (int g = 0; g < 4; ++g) {
            const f32x4 w = *(const f32x4*)(subw + dvb * 32 + 8 * g + 4 * hh);
#pragma unroll
            for (int e = 0; e < 4; ++e) O1[dvb][4 * g + e] *= rn * w[e];
        }
    store_o(O1, Ob + (size_t)qrow * DM + h * 64, hh);
}


constexpr int A_KP = 144, A_VP = 192, A_VOFF = 64 * A_KP, A_BUF = A_VOFF + 64 * A_VP;
constexpr float ATHR = 10.f;
typedef short v4i16_t __attribute__((ext_vector_type(4)));
__device__ __forceinline__ s16x4 vtr(const LAS unsigned char* p) { return __builtin_bit_cast(s16x4, __builtin_amdgcn_ds_read_tr16_b64_v4i16((LAS v4i16_t*)p)); }
__device__ __forceinline__ void tileA_swrite(const TileRegs& R, LAS unsigned char* buf, int tid) {
    const int key = tid >> 3, ch = tid & 7;
    *(LAS u32x4*)(buf + key * A_KP + ch * 16) = R.k;
    *(LAS u32x4*)(buf + A_VOFF + key * A_VP + ch * 16) = R.v;
}
__device__ __forceinline__ float max16(const f32x16& s) {
    float a = fmaxf(fmaxf(s[0], s[1]), s[2]), b = fmaxf(fmaxf(s[3], s[4]), s[5]), c = fmaxf(fmaxf(s[6], s[7]), s[8]), d = fmaxf(fmaxf(s[9], s[10]), s[11]);
    a = fmaxf(fmaxf(a, s[12]), s[13]); b = fmaxf(fmaxf(b, s[14]), s[15]);
    return fmaxf(fmaxf(a, b), fmaxf(c, d));
}
__device__ __forceinline__ float expsum16(f32x16& s) {
    float a = 0.f, b = 0.f, c = 0.f, d = 0.f;
#pragma unroll
    for (int r = 0; r < 16; r += 4) {
        s[r] = __builtin_amdgcn_exp2f(s[r]); s[r + 1] = __builtin_amdgcn_exp2f(s[r + 1]); s[r + 2] = __builtin_amdgcn_exp2f(s[r + 2]); s[r + 3] = __builtin_amdgcn_exp2f(s[r + 3]);
        a += s[r]; b += s[r + 1]; c += s[r + 2]; d += s[r + 3];
    }
    return (a + b) + (c + d);
}
__device__ __forceinline__ bf16x8 packp(const f32x16& s, int sk) {
    u32x4 pw; pw.x = pkbf(s[8 * sk + 0], s[8 * sk + 1]); pw.y = pkbf(s[8 * sk + 2], s[8 * sk + 3]); pw.z = pkbf(s[8 * sk + 4], s[8 * sk + 5]); pw.w = pkbf(s[8 * sk + 6], s[8 * sk + 7]);
    return __builtin_bit_cast(bf16x8, pw);
}
__device__ __forceinline__ void exp16(f32x16& s) {
#pragma unroll
    for (int r = 0; r < 16; ++r) s[r] = __builtin_amdgcn_exp2f(s[r]);
}
constexpr float AREF = 20.f, AGUARD = 60.f;
#ifndef SGB_V
#define SGB_V 5
#endif
template <bool HAVE>
__device__ __forceinline__ void stepA(bf16x8 (&pc)[2][2], const LAS unsigned char* kbuf, int kb, const LAS unsigned char* vb, const bf16x8 (&qv)[4], int r32, int hh,
                                      float mref1, float mref2, f32x16 (&O1)[2], f32x16 (&O2)[2], f32x16& L1, f32x16& L2, const bf16x8& ones) {
    const LAS unsigned char* kp = kbuf + (kb * 32 + r32) * A_KP + hh * 16;
    const bf16x8 k0 = *(const LAS bf16x8*)(kp), k1 = *(const LAS bf16x8*)(kp + 32), k2 = *(const LAS bf16x8*)(kp + 64), k3 = *(const LAS bf16x8*)(kp + 96);
    const bf16x8 q0 = qv[0], q1 = qv[1], q2 = qv[2], q3 = qv[3];
    bf16x8 vf[2][2];
#pragma unroll
    for (int sk = 0; sk < 2; ++sk)
#pragma unroll
        for (int dvb = 0; dvb < 2; ++dvb) {
            const LAS unsigned char* a = vb + 16 * sk * A_VP + dvb * 64;
            const s16x4 lo = vtr(a), hi = vtr(a + 8 * A_VP);
            vf[sk][dvb] = (bf16x8){lo[0], lo[1], lo[2], lo[3], hi[0], hi[1], hi[2], hi[3]};
        }
    const f32x16 z = {0.f, 0.f, 0.f, 0.f, 0.f, 0.f, 0.f, 0.f, 0.f, 0.f, 0.f, 0.f, 0.f, 0.f, 0.f, 0.f};
    f32x16 s1 = __builtin_amdgcn_mfma_f32_32x32x16_bf16(k0, q0, z, 0, 0, 0);
    f32x16 s2 = __builtin_amdgcn_mfma_f32_32x32x16_bf16(k2, q2, z, 0, 0, 0);
    s1 = __builtin_amdgcn_mfma_f32_32x32x16_bf16(k1, q1, s1, 0, 0, 0);
    s2 = __builtin_amdgcn_mfma_f32_32x32x16_bf16(k3, q3, s2, 0, 0, 0);
#pragma unroll
    for (int sk = 0; sk < 2; ++sk) {
        L1 = __builtin_amdgcn_mfma_f32_32x32x16_bf16(ones, pc[0][sk], L1, 0, 0, 0);
        L2 = __builtin_amdgcn_mfma_f32_32x32x16_bf16(ones, pc[1][sk], L2, 0, 0, 0);
#pragma unroll
        for (int dvb = 0; dvb < 2; ++dvb) {
            O1[dvb] = __builtin_amdgcn_mfma_f32_32x32x16_bf16(vf[sk][dvb], pc[0][sk], O1[dvb], 0, 0, 0);
            O2[dvb] = __builtin_amdgcn_mfma_f32_32x32x16_bf16(vf[sk][dvb], pc[1][sk], O2[dvb], 0, 0, 0);
        }
    }
    if (HAVE) {
#pragma unroll
        for (int r = 0; r < 16; ++r) { s1[r] -= mref1; s2[r] -= mref2; }
    }
    exp16(s1); exp16(s2);
    bf16x8 pn[2][2];
    pn[0][0] = packp(s1, 0); pn[0][1] = packp(s1, 1); pn[1][0] = packp(s2, 0); pn[1][1] = packp(s2, 1);
#if 0
    __builtin_amdgcn_sched_group_barrier(0x008, 6, 0);
#pragma unroll
    for (int i = 0; i < 10; ++i) { __builtin_amdgcn_sched_group_barrier(0x002, SGB_V, 0); __builtin_amdgcn_sched_group_barrier(0x008, 1, 0); }
    __builtin_amdgcn_sched_group_barrier(0x002, 48, 0);
#endif
    pc[0][0] = pn[0][0]; pc[0][1] = pn[0][1]; pc[1][0] = pn[1][0]; pc[1][1] = pn[1][1];
}
__device__ __forceinline__ void unit_A(const bool CTXQ, LAS unsigned char* lds, const bf16_t* H, bf16_t* Ob, int b, int h, int qb, float lam, float ofac, const float* subw) {
    const int tid = pg8_ltid(), lane = tid & 63, r32 = lane & 31, hh = lane >> 5, wid = tid >> 6;
    const int qrow = CTXQ ? (ML + b * CTXL + wid * 32 + r32) : (b * SEQ + qb * 256 + wid * 32 + r32);
    const int qcol = h * 64, kcol = 256 + h * 64, vcol = 512 + h * 64;
    const int NT = CTXQ ? 4 : 132;
    f32x16 O1[2], O2[2], L1, L2;
#pragma unroll
    for (int r = 0; r < 16; ++r) { O1[0][r] = 0.f; O1[1][r] = 0.f; O2[0][r] = 0.f; O2[1][r] = 0.f; L1[r] = 0.f; L2[r] = 0.f; }
    const bf16x8 ones = {0x3F80, 0x3F80, 0x3F80, 0x3F80, 0x3F80, 0x3F80, 0x3F80, 0x3F80};
    const int voff = A_VOFF + (4 * hh + ((lane & 15) >> 2)) * A_VP + (((lane >> 4) & 1) * 16 + (lane & 3) * 4) * 2;
    const int krow0 = CTXQ ? (ML + b * CTXL) : (b * SEQ);
    LAS unsigned char* qs = lds + 3 * A_BUF + (wid * 32 + r32) * A_KP + hh * 16;
    volatile LAS unsigned* flag = (volatile LAS unsigned*)(lds + RING_BYTES + 128);
    TileRegs R;
    __syncthreads();
    if (tid == 0) *flag = 0u;
#pragma unroll
    for (int ks = 0; ks < 4; ++ks) *(LAS bf16x8*)(qs + ks * 32) = *(const bf16x8*)(H + (size_t)qrow * INC + qcol + 16 * ks + 8 * hh);
    tile_gload(R, H, krow0, kcol, vcol, tid);       tileA_swrite(R, lds, tid);
    tile_gload(R, H, krow0 + 64, kcol, vcol, tid);  tileA_swrite(R, lds + A_BUF, tid);
    tile_gload(R, H, krow0 + 128, kcol, vcol, tid);
    __syncthreads();
    bf16x8 pc[2][2];
    {
        const LAS unsigned char* kp = lds + r32 * A_KP + hh * 16;
        const f32x16 z = {0.f, 0.f, 0.f, 0.f, 0.f, 0.f, 0.f, 0.f, 0.f, 0.f, 0.f, 0.f, 0.f, 0.f, 0.f, 0.f};
        f32x16 sa1 = __builtin_amdgcn_mfma_f32_32x32x16_bf16(*(const LAS bf16x8*)(kp), *(const LAS bf16x8*)(qs), z, 0, 0, 0);
        sa1 = __builtin_amdgcn_mfma_f32_32x32x16_bf16(*(const LAS bf16x8*)(kp + 32), *(const LAS bf16x8*)(qs + 32), sa1, 0, 0, 0);
        f32x16 sa2 = __builtin_amdgcn_mfma_f32_32x32x16_bf16(*(const LAS bf16x8*)(kp + 64), *(const LAS bf16x8*)(qs + 64), z, 0, 0, 0);
        sa2 = __builtin_amdgcn_mfma_f32_32x32x16_bf16(*(const LAS bf16x8*)(kp + 96), *(const LAS bf16x8*)(qs + 96), sa2, 0, 0, 0);
        const float mx1 = xhalf_max(max16(sa1)), mx2 = xhalf_max(max16(sa2));
        if (__any((fabsf(mx1) > AREF) || (fabsf(mx2) > AREF)) != 0) *flag = 1u;
        exp16(sa1); exp16(sa2);
        pc[0][0] = packp(sa1, 0); pc[0][1] = packp(sa1, 1); pc[1][0] = packp(sa2, 0); pc[1][1] = packp(sa2, 1);
    }
    bf16x8 qv[4];
#pragma unroll
    for (int ks = 0; ks < 4; ++ks) qv[ks] = *(const LAS bf16x8*)(qs + ks * 32);
    int bc = 0, t = 0;
#define UNITA_STAGE() \
        const int bn = (bc == 2 * A_BUF) ? 0 : bc + A_BUF, bw = (bn == 2 * A_BUF) ? 0 : bn + A_BUF; \
        if (t + 2 < NT) { \
            tileA_swrite(R, lds + bw, tid); \
            if (t + 3 < NT) { const int tn = t + 3; const int krow = CTXQ ? (krow0 + 64 * tn) : (tn < 128 ? b * SEQ + 64 * tn : ML + b * CTXL + 64 * (tn - 128)); tile_gload(R, H, krow, kcol, vcol, tid); } \
        }
#define UNITA_GUARD() (__any((L1[0] > 1.152921504606846976e18f) || (L2[0] > 1.152921504606846976e18f)) != 0)
    unsigned fl = 0u;
    {
        for (; t < NT; ++t) {
            if (__builtin_expect(fl != 0u, 0)) break;
            fl = *flag;
            if (__builtin_expect(UNITA_GUARD(), 0)) *flag = 1u;
            UNITA_STAGE()
            stepA<false>(pc, lds + bc, 1, lds + bc + voff, qv, r32, hh, 0.f, 0.f, O1, O2, L1, L2, ones);
            stepA<false>(pc, lds + bn, 0, lds + bc + voff + 32 * A_VP, qv, r32, hh, 0.f, 0.f, O1, O2, L1, L2, ones);
            __syncthreads();
            bc = bn;
        }
    }
#undef UNITA_STAGE
#undef UNITA_GUARD
    if (*flag != 0u) { unit_A_safe(CTXQ, lds, H, Ob, b, h, qb, lam, ofac, subw); return; }
    const float i1 = 1.f / L1[0], i2 = lam / L2[0];
    float ss = 0.f;
#pragma unroll
    for (int dvb = 0; dvb < 2; ++dvb)
#pragma unroll
        for (int r = 0; r < 16; ++r) { const float o = O1[dvb][r] * i1 - O2[dvb][r] * i2; O1[dvb][r] = o; ss += o * o; }
    ss = xhalf_sum(ss);
    float li_ = ofac; asm volatile("" : "+s"(li_));
    const float rn = rsqrtf(ss * (1.f / 64.f) + 1e-6f) * (1.f - li_);
#pragma unroll
    for (int dvb = 0; dvb < 2; ++dvb)
#pragma unroll
        for (int g = 0; g < 4; ++g) {
            const f32x4 w = *(const f32x4*)(subw + dvb * 32 + 8 * g + 4 * hh);
#pragma unroll
            for (int e = 0; e < 4; ++e) O1[dvb][4 * g + e] *= rn * w[e];
        }
    store_o(O1, Ob + (size_t)qrow * DM + h * 64, hh);
}

template <int MODE> __device__ __forceinline__ int tile_row_f(int t, int b, int lo, int nloc) {
    if (MODE == 1) return (t < nloc) ? (b * SEQ + 64 * (lo + t)) : (ML + b * CTXL + 64 * (t - nloc));
    if (MODE == 2) return (t < 4) ? (ML + b * CTXL + 64 * t) : (b * SEQ + 64 * (lo + t - 4));
    return ML + b * CTXL + 64 * t;
}
__device__ __forceinline__ int tile_row_r(int MODE, int t, int b, int lo, int nloc) {
    if (MODE == 1) return (t < nloc) ? (b * SEQ + 64 * (lo + t)) : (ML + b * CTXL + 64 * (t - nloc));
    if (MODE == 2) return (t < 4) ? (ML + b * CTXL + 64 * t) : (b * SEQ + 64 * (lo + t - 4));
    return ML + b * CTXL + 64 * t;
}
__device__ __forceinline__ void unit_BC(const int MODE, LAS unsigned char* lds, const bf16_t* H, bf16_t* Ob, int b, int hd, int blk, const float* sink_l, const float* rpb_l) {
    const int tid = pg8_ltid(), lane = tid & 63, r32 = lane & 31, hh = lane >> 5, wid = tid >> 6;
    int qrow, qcol, kcol, vcol, ocol, qpos = 0, r_w = 0, qc = 0, lo = 0, nloc = 0;
    float m = -INFINITY, l = 0.f;
    if (MODE == 1) {
        const int g = wid >> 2, head = hd * 2 + g; qpos = 128 * blk + 32 * (wid & 3) + r32; qrow = b * SEQ + qpos;
        qcol = 768 + head * 64; kcol = 1024 + hd * 64; vcol = 1152 + hd * 64; ocol = 256 + head * 64;
        lo = 2 * blk - 2; if (lo < 0) lo = 0; int hi = 2 * blk + 3; if (hi > 127) hi = 127; nloc = hi - lo + 1;
        m = sink_l[head] * LOG2E; l = (hh == 0) ? 1.f : 0.f;
    } else if (MODE == 3) {
        const int head = hd * 2 + blk; qrow = ML + b * CTXL + wid * 32 + r32;
        qcol = 768 + head * 64; kcol = 1024 + hd * 64; vcol = 1152 + hd * 64; ocol = 256 + head * 64;
        m = sink_l[head] * LOG2E; l = (hh == 0) ? 1.f : 0.f;
    } else if (MODE == 2) {
        r_w = 4 * blk + (wid >> 1); qc = 32 * (wid & 1) + r32; qrow = b * SEQ + r_w * 64 + qc;
        qcol = 1280 + hd * 64; kcol = 1536 + hd * 64; vcol = 1792 + hd * 64; ocol = 512 + hd * 64;
        int a0 = 4 * blk - 4; if (a0 < 0) a0 = 0; if (a0 > 120) a0 = 120; int a3 = 4 * blk + 3 - 4; if (a3 < 0) a3 = 0; if (a3 > 120) a3 = 120;
        lo = a0; nloc = a3 + 7 - a0 + 1;
    } else {
        qrow = ML + b * CTXL + wid * 32 + r32;
        qcol = 1280 + hd * 64; kcol = 1536 + hd * 64; vcol = 1792 + hd * 64; ocol = 512 + hd * 64;
    }
    bf16x8 qf[4];
#pragma unroll
    for (int ks = 0; ks < 4; ++ks) qf[ks] = *(const bf16x8*)(H + (size_t)qrow * INC + qcol + 16 * ks + 8 * hh);
    f32x16 O[2];
#pragma unroll
    for (int r = 0; r < 16; ++r) { O[0][r] = 0.f; O[1][r] = 0.f; }
    const int NT = 4 + nloc;
    int rs = 0;
    if (MODE == 2) { rs = r_w - 4; if (rs < 0) rs = 0; if (rs > 120) rs = 120; }
    const LAS float* rpbs = (const LAS float*)(lds + L_RPB);
    TileRegs R;
    tile_gload(R, H, tile_row_r(MODE, 0, b, lo, nloc), kcol, vcol, tid);
    for (int t = 0; t < NT; ++t) {
        __syncthreads();
        tile_swrite(R, lds, tid);
        if (MODE == 2 && t == 0) { for (int i = tid; i < 465; i += 512) ((LAS float*)(lds + L_RPB))[i] = rpb_l[hd * 465 + i] * LOG2E; }
        __syncthreads();
        if (t + 1 < NT) tile_gload(R, H, tile_row_r(MODE, t + 1, b, lo, nloc), kcol, vcol, tid);
        bool active = true; int kr = 0;
        if (MODE == 2 && t >= 4) { kr = lo + t - 4; active = (kr >= rs) && (kr < rs + 8); }
        if (active) {
            f32x16 s[2]; s[0] = qk_block<0, 4>(lds, 0, r32, hh, qf); s[1] = qk_block<0, 4>(lds, 1, r32, hh, qf);
            if (MODE == 1 && t < nloc) {
                const int kbase = 64 * (lo + t) - qpos;
#pragma unroll
                for (int kb = 0; kb < 2; ++kb)
#pragma unroll
                    for (int r = 0; r < 16; ++r) { const int d = kbase + kb * 32 + crow(r, hh); if (d > 128 || d < -128) s[kb][r] = -INFINITY; }
            }
            if (MODE == 2 && t >= 4) {
                int cs = qc - 8; if (cs < 0) cs = 0; if (cs > 48) cs = 48;
                const int bbase = (kr - r_w + 7) * 31 + 15 - qc;
#pragma unroll
                for (int kb = 0; kb < 2; ++kb)
#pragma unroll
                    for (int r = 0; r < 16; ++r) {
                        const int kc = kb * 32 + crow(r, hh);
                        const bool ok = (kc >= cs) && (kc < cs + 16);
                        int bi = bbase + kc; bi = ok ? bi : 0;
                        const float bias = rpbs[bi];
                        s[kb][r] = ok ? (s[kb][r] + bias) : -INFINITY;
                    }
            }
            softmax_pv(s, m, l, O, lds, r32, hh);
        }
    }
    l = xhalf_sum(l);
    const float il = 1.f / l;
#pragma unroll
    for (int r = 0; r < 16; ++r) { O[0][r] *= il; O[1][r] *= il; }
    store_o(O, Ob + (size_t)qrow * DM + ocol, hh);
}

template <int MODE>
__device__ __forceinline__ void bcf_compute(const LAS unsigned char* cur, int t, int nloc, int lo, int qpos, int kr, int r_w, int qc, const bf16x8 (&qf)[4], f32x16 (&O)[2], f32x16& L,
                                            const bf16x8& ones, const LAS float* rpbs, int voff, int r32, int hh) {
    f32x16 s[2];
    const f32x16 z = {0.f, 0.f, 0.f, 0.f, 0.f, 0.f, 0.f, 0.f, 0.f, 0.f, 0.f, 0.f, 0.f, 0.f, 0.f, 0.f};
#pragma unroll
    for (int kb = 0; kb < 2; ++kb) {
        const LAS unsigned char* kp = cur + (kb * 32 + r32) * A_KP + hh * 16;
        s[kb] = __builtin_amdgcn_mfma_f32_32x32x16_bf16(*(const LAS bf16x8*)(kp), qf[0], z, 0, 0, 0);
        s[kb] = __builtin_amdgcn_mfma_f32_32x32x16_bf16(*(const LAS bf16x8*)(kp + 32), qf[1], s[kb], 0, 0, 0);
        s[kb] = __builtin_amdgcn_mfma_f32_32x32x16_bf16(*(const LAS bf16x8*)(kp + 64), qf[2], s[kb], 0, 0, 0);
        s[kb] = __builtin_amdgcn_mfma_f32_32x32x16_bf16(*(const LAS bf16x8*)(kp + 96), qf[3], s[kb], 0, 0, 0);
    }
    if (MODE == 1 && t < nloc) {
        const int kbase = 64 * (lo + t) - qpos;
#pragma unroll
        for (int kb = 0; kb < 2; ++kb)
#pragma unroll
            for (int r = 0; r < 16; ++r) { const int d = kbase + kb * 32 + crow(r, hh); if (d > 128 || d < -128) s[kb][r] = -INFINITY; }
    }
    if (MODE == 2 && t >= 4) {
        int cs = qc - 8; if (cs < 0) cs = 0; if (cs > 48) cs = 48;
        const int bbase = (kr - r_w + 7) * 31 + 15 - qc;
#pragma unroll
        for (int kb = 0; kb < 2; ++kb)
#pragma unroll
            for (int r = 0; r < 16; ++r) {
                const int kc = kb * 32 + crow(r, hh);
                const bool ok = (kc >= cs) && (kc < cs + 16);
                int bi = bbase + kc; bi = ok ? bi : 0;
                const float bias = rpbs[bi];
                s[kb][r] = ok ? (s[kb][r] + bias) : -INFINITY;
            }
    }
#pragma unroll
    for (int kb = 0; kb < 2; ++kb) {
        exp16(s[kb]);
#pragma unroll
        for (int sk = 0; sk < 2; ++sk) {
            const bf16x8 p = packp(s[kb], sk);
            L = __builtin_amdgcn_mfma_f32_32x32x16_bf16(ones, p, L, 0, 0, 0);
#pragma unroll
            for (int dvb = 0; dvb < 2; ++dvb) {
                const LAS unsigned char* a = cur + voff + (kb * 32 + 16 * sk) * A_VP + dvb * 64;
                const s16x4 vlo = vtr(a), vhi = vtr(a + 8 * A_VP);
                const bf16x8 vf = {vlo[0], vlo[1], vlo[2], vlo[3], vhi[0], vhi[1], vhi[2], vhi[3]};
                O[dvb] = __builtin_amdgcn_mfma_f32_32x32x16_bf16(vf, p, O[dvb], 0, 0, 0);
            }
        }
    }
}
template <int MODE>
__device__ __forceinline__ bool unit_BC_fast(LAS unsigned char* lds, const bf16_t* H, bf16_t* Ob, int b, int hd, int blk, const float* sink_l, const float* rpb_l) {
    const int tid = pg8_ltid(), lane = tid & 63, r32 = lane & 31, hh = lane >> 5, wid = tid >> 6;
    int qrow, qcol, kcol, vcol, ocol, qpos = 0, r_w = 0, qc = 0, lo = 0, nloc = 0;
    float linit = 0.f;
    if (MODE == 1) {
        const int g = wid >> 2, head = hd * 2 + g; qpos = 128 * blk + 32 * (wid & 3) + r32; qrow = b * SEQ + qpos;
        qcol = 768 + head * 64; kcol = 1024 + hd * 64; vcol = 1152 + hd * 64; ocol = 256 + head * 64;
        lo = 2 * blk - 2; if (lo < 0) lo = 0; int hi = 2 * blk + 3; if (hi > 127) hi = 127; nloc = hi - lo + 1;
        linit = __builtin_amdgcn_exp2f(sink_l[head] * LOG2E);
    } else if (MODE == 3) {
        const int head = hd * 2 + blk; qrow = ML + b * CTXL + wid * 32 + r32;
        qcol = 768 + head * 64; kcol = 1024 + hd * 64; vcol = 1152 + hd * 64; ocol = 256 + head * 64;
        linit = __builtin_amdgcn_exp2f(sink_l[head] * LOG2E);
    } else if (MODE == 2) {
        r_w = 4 * blk + (wid >> 1); qc = 32 * (wid & 1) + r32; qrow = b * SEQ + r_w * 64 + qc;
        qcol = 1280 + hd * 64; kcol = 1536 + hd * 64; vcol = 1792 + hd * 64; ocol = 512 + hd * 64;
        int a0 = 4 * blk - 4; if (a0 < 0) a0 = 0; if (a0 > 120) a0 = 120; int a3 = 4 * blk + 3 - 4; if (a3 < 0) a3 = 0; if (a3 > 120) a3 = 120;
        lo = a0; nloc = a3 + 7 - a0 + 1;
    } else {
        qrow = ML + b * CTXL + wid * 32 + r32;
        qcol = 1280 + hd * 64; kcol = 1536 + hd * 64; vcol = 1792 + hd * 64; ocol = 512 + hd * 64;
    }
    bf16x8 qf[4];
#pragma unroll
    for (int ks = 0; ks < 4; ++ks) qf[ks] = *(const bf16x8*)(H + (size_t)qrow * INC + qcol + 16 * ks + 8 * hh);
    f32x16 O[2], L;
#pragma unroll
    for (int r = 0; r < 16; ++r) { O[0][r] = 0.f; O[1][r] = 0.f; L[r] = linit; }
    const bf16x8 ones = {0x3F80, 0x3F80, 0x3F80, 0x3F80, 0x3F80, 0x3F80, 0x3F80, 0x3F80};
    const int NT = 4 + nloc;
    int rs = 0;
    if (MODE == 2) { rs = r_w - 4; if (rs < 0) rs = 0; if (rs > 120) rs = 120; }
    const int voff = A_VOFF + (4 * hh + ((lane & 15) >> 2)) * A_VP + (((lane >> 4) & 1) * 16 + (lane & 3) * 4) * 2;
    LAS float* rpbs = (LAS float*)(lds + 2 * A_BUF);
    volatile LAS unsigned* flag = (volatile LAS unsigned*)(lds + RING_BYTES + 128);
    TileRegs Ra, Rb;
    __syncthreads();
    if (tid == 0) *flag = 0u;
    if (MODE == 2) { for (int i = tid; i < 465; i += 512) rpbs[i] = rpb_l[hd * 465 + i] * LOG2E; }
    tile_gload(Ra, H, tile_row_f<MODE>(0, b, lo, nloc), kcol, vcol, tid);
    tileA_swrite(Ra, lds, tid);
    tile_gload(Rb, H, tile_row_f<MODE>(1, b, lo, nloc), kcol, vcol, tid);
    tile_gload(Ra, H, tile_row_f<MODE>(2, b, lo, nloc), kcol, vcol, tid);
    __syncthreads();
#define BCF_TILE(T, RS) { \
        const int t = (T); \
        const LAS unsigned char* cur = lds + (t & 1) * A_BUF; \
        if (t + 1 < NT) { \
            tileA_swrite(RS, lds + ((t + 1) & 1) * A_BUF, tid); \
            if (t + 3 < NT) tile_gload(RS, H, tile_row_f<MODE>(t + 3, b, lo, nloc), kcol, vcol, tid); \
        } \
        bool active = true; int kr = 0; \
        if (MODE == 2 && t >= 4) { kr = lo + t - 4; active = (kr >= rs) && (kr < rs + 8); } \
        if (active) bcf_compute<MODE>(cur, t, nloc, lo, qpos, kr, r_w, qc, qf, O, L, ones, rpbs, voff, r32, hh); \
        __syncthreads(); }
    for (int t2 = 0; t2 < NT; t2 += 2) {
        BCF_TILE(t2, Rb)
        if (t2 + 1 < NT) BCF_TILE(t2 + 1, Ra)
    }
#undef BCF_TILE
    const float lsum = L[0];
    if (__any(!((lsum > 1e-30f) && (lsum < 1e30f))) != 0) *flag = 1u;
    __syncthreads();
    if (*flag != 0u) return true;
    const float il = 1.f / lsum;
#pragma unroll
    for (int r = 0; r < 16; ++r) { O[0][r] *= il; O[1][r] *= il; }
    store_o(O, Ob + (size_t)qrow * DM + ocol, hh);
    return false;
}
}
__device__ __forceinline__ float silu_f(float v) { return v / (1.f + __expf(-v)); }

__device__ __forceinline__ int wrow_map(int type, int n) {
    if (type == 1) { if (n < 512) { const int p = n & 31, blk = p >> 3; const int np = (blk == 1) ? p + 8 : ((blk == 2) ? p - 8 : p); return (n & ~31) + np; } return n; }
    if (type == 2) { const int half = (n >= 2816) ? 1 : 0; const int j = n - half * 2816; return (j >> 7) * 256 + half * 128 + (j & 127); }
    return n;
}
__device__ __forceinline__ void transpose_item(const float* W, int K, int N, bf16_t* WT, int type, LAS float* scr, int item, int lane) {
    const int nblk = N / 32, kb = item / nblk, nb = item - kb * nblk, k0 = 64 * kb, n0 = 32 * nb;
#pragma unroll 8
    for (int i = 0; i < 32; ++i) { const int kk = 2 * i + (lane >> 5); scr[kk * 33 + (lane & 31)] = W[(size_t)(k0 + kk) * N + n0 + (lane & 31)]; }
    asm volatile("s_waitcnt lgkmcnt(0)" ::: "memory");
    const int c = lane & 7;
#pragma unroll
    for (int j = 0; j < 4; ++j) {
        const int n = (lane >> 3) + 8 * j; const LAS float* s = scr + (8 * c) * 33 + n;
        u32x4 o; o.x = pkbf(s[0 * 33], s[1 * 33]); o.y = pkbf(s[2 * 33], s[3 * 33]); o.z = pkbf(s[4 * 33], s[5 * 33]); o.w = pkbf(s[6 * 33], s[7 * 33]);
        *(u32x4*)(WT + (size_t)wrow_map(type, n0 + n) * K + k0 + 8 * c) = o;
    }
    asm volatile("s_waitcnt lgkmcnt(0)" ::: "memory");
}

__device__ __forceinline__ void sincos_f(float x, float& c, float& s) {
    const float k = rintf(x * 0.636619772f);
    float r = fmaf(-k, 1.57079625129699707031f, x); r = fmaf(-k, 7.54978941586159635335e-08f, r);
    const float r2 = r * r;
    const float sr = r * (1.f + r2 * (-1.f / 6 + r2 * (1.f / 120 + r2 * (-1.f / 5040 + r2 * (1.f / 362880)))));
    const float cr = 1.f + r2 * (-0.5f + r2 * (1.f / 24 + r2 * (-1.f / 720 + r2 * (1.f / 40320 + r2 * (-1.f / 3628800)))));
    const int q = ((int)k) & 3;
    s = (q == 0) ? sr : (q == 1) ? cr : (q == 2) ? -sr : -cr;
    c = (q == 0) ? cr : (q == 1) ? -sr : (q == 2) ? -cr : sr;
}

__device__ __forceinline__ void norm_mod_row(const float* src, const float* nw, const float* sh, const float* sc, bf16_t* dst, int lane, const float* slab = nullptr, int nslab = 0, float* xout = nullptr) {
    u32x2* o8 = (u32x2*)dst + lane;
    if (src == nullptr) {
#pragma unroll
        for (int j = 0; j < 4; ++j) o8[64 * j] = (u32x2){0u, 0u};
        return;
    }
    const f32x4* xr = (const f32x4*)src + lane;
    f32x4 v[4]; float s = 0.f;
#pragma unroll
    for (int j = 0; j < 4; ++j) v[j] = xr[64 * j];
    for (int p = 0; p < nslab; ++p) {
        const f32x4* sr = (const f32x4*)(slab + (size_t)p * 1024 * 1024) + lane;
#pragma unroll
        for (int j = 0; j < 4; ++j) v[j] += sr[64 * j];
    }
    if (xout != nullptr) {
#pragma unroll
        for (int j = 0; j < 4; ++j) ((f32x4*)xout + lane)[64 * j] = v[j];
    }
#pragma unroll
    for (int j = 0; j < 4; ++j) s += (v[j][0] * v[j][0] + v[j][1] * v[j][1]) + (v[j][2] * v[j][2] + v[j][3] * v[j][3]);
    const float rstd = rsqrtf(wave_sum(s, lane) * (1.f / 1024.f) + 1e-6f);
#pragma unroll
    for (int j = 0; j < 4; ++j) {
        const int k = 4 * (64 * j + lane);
        const f32x4 w = *(const f32x4*)(nw + k), a = *(const f32x4*)(sc + k), d = *(const f32x4*)(sh + k);
        f32x4 y;
#pragma unroll
        for (int e = 0; e < 4; ++e) y[e] = (v[j][e] * rstd * w[e]) * (1.f + a[e]) + d[e];
        u32x2 p; p.x = pkbf(y[0], y[1]); p.y = pkbf(y[2], y[3]);
        o8[64 * j] = p;
    }
}

#define XB_TMO      128
#define XB_XCNT(j)  (256  + 64 * (j))
#define XB_XSUB(j)  (1280 + 64 * (j))
#define XB_XGEN(j)  (2304 + 64 * (j))
#define XB_TOP      3328
#define XB_TOPGEN   3392
#define XCD_BAR_WORDS 3456
#define XB_SPIN_CAP (1u << 18)

__device__ __forceinline__ unsigned xb_ld(unsigned* p)              { return __hip_atomic_load(p, __ATOMIC_RELAXED, __HIP_MEMORY_SCOPE_AGENT); }
__device__ __forceinline__ unsigned xb_add(unsigned* p, unsigned v) { return __hip_atomic_fetch_add(p, v, __ATOMIC_RELAXED, __HIP_MEMORY_SCOPE_AGENT); }
__device__ __forceinline__ unsigned xb_xcc_id() { return (unsigned)__builtin_amdgcn_s_getreg((3 << 11) | 20) & 0xFu; }
#define XB_SPIN(cond, bar) do { unsigned _sp = 0; while (cond) { __builtin_amdgcn_s_sleep(1); \
    if ((++_sp & 255u) == 0u) { if (xb_ld(&(bar)[XB_TMO])) break; if (_sp > XB_SPIN_CAP) { atomicAdd(&(bar)[XB_TMO], 1u); break; } } } } while (0)

struct XcdBarrier {
    unsigned* bar; unsigned x;
    volatile LAS unsigned* st;
};

__device__ __forceinline__ XcdBarrier xcd_barrier_post(unsigned* bar, volatile LAS unsigned* st) {
    XcdBarrier b; b.bar = bar; b.x = xb_xcc_id(); b.st = st;
    if (threadIdx.x == 0) (void)xb_add(&bar[XB_XCNT(b.x)], 1u);
    return b;
}
__device__ __forceinline__ void xcd_barrier_complete(unsigned* bar, unsigned x, unsigned& nloc, unsigned& nx) {
    const unsigned G = gridDim.x * gridDim.y * gridDim.z;
    unsigned sum, cnt, mine, sp = 0u;
    for (;;) {
        sum = 0u; cnt = 0u; mine = 0u;
#pragma unroll
        for (unsigned j = 0; j < 16; ++j) { const unsigned c = xb_ld(&bar[XB_XCNT(j)]); sum += c; cnt += (c > 0u) ? 1u : 0u; mine = (j == x) ? c : mine; }
        if (sum == G) break;
        __builtin_amdgcn_s_sleep(1);
        if ((++sp & 255u) == 0u) { if (xb_ld(&bar[XB_TMO])) break; if (sp > XB_SPIN_CAP) { atomicAdd(&bar[XB_TMO], 1u); break; } }
    }
    nloc = mine > 0u ? mine : 1u; nx = cnt > 0u ? cnt : 1u;
}

__device__ __forceinline__ void xcd_barrier(const XcdBarrier& b) {
    asm volatile("s_waitcnt vmcnt(0)" ::: "memory");
    __syncthreads();
    if (threadIdx.x == 0) {
        unsigned* bar = b.bar;
        __builtin_amdgcn_s_waitcnt(0);
        unsigned nloc = b.st[0], nx = b.st[1];
        if (nloc == 0u) { xcd_barrier_complete(bar, b.x, nloc, nx); b.st[0] = nloc; b.st[1] = nx; }
        const unsigned old = xb_add(&bar[XB_XSUB(b.x)], 1u);
        const unsigned gen = old / nloc;
        if (old + 1u == (gen + 1u) * nloc) {
            __builtin_amdgcn_fence(__ATOMIC_RELEASE, "agent");
            asm volatile("s_waitcnt vmcnt(0)" ::: "memory");
            const unsigned og = xb_add(&bar[XB_TOP], 1u);
            const unsigned tg = og / nx;
            if (og + 1u == (tg + 1u) * nx) xb_add(&bar[XB_TOPGEN], 1u);
            else XB_SPIN(xb_ld(&bar[XB_TOPGEN]) == tg, bar);
            __builtin_amdgcn_fence(__ATOMIC_ACQUIRE, "agent");
            xb_add(&bar[XB_XGEN(b.x)], 1u);
            asm volatile("s_waitcnt vmcnt(0)" ::: "memory");
        } else {
            XB_SPIN(xb_ld(&bar[XB_XGEN(b.x)]) == gen, bar);
            __builtin_amdgcn_fence(__ATOMIC_ACQUIRE, "agent");
            asm volatile("s_waitcnt vmcnt(0)" ::: "memory");
        }
    }
    __syncthreads();
}

struct Args { const float* in[23]; float* out; unsigned char* ws; int ph_lo, ph_hi, coop, pad; };
typedef const __attribute__((address_space(4))) Args* KArgs;
__device__ __forceinline__ KArgs kargs() { KArgs p = (KArgs)__builtin_amdgcn_kernarg_segment_ptr(); asm volatile("" : "+s"(p)); return p; }
constexpr int N_PHASES = 2 + 7 * DEPTH + 1;

__global__ void __launch_bounds__(512, 2) fwd_kernel(Args a) {
    extern __shared__ __attribute__((aligned(16))) unsigned char lds_raw[];
    LAS unsigned char* lds = (LAS unsigned char*)lds_raw;
    volatile LAS unsigned* bar_st = (volatile LAS unsigned*)(lds + RING_BYTES + 64);
    if (threadIdx.x < 2) bar_st[threadIdx.x] = 0u;
    __syncthreads();
    if (kargs()->coop) (void)xcd_barrier_post((unsigned*)kargs()->ws, bar_st);
    const int ph_lo = kargs()->ph_lo, ph_hi = kargs()->ph_hi;
    for (int ph = ph_lo; ph < ph_hi; ++ph) {
        KArgs ka = kargs();
        const int tid = pg8_ltid(), lane = tid & 63, wave = __builtin_amdgcn_readfirstlane(tid >> 6);
        int G = gridDim.x, bx = blockIdx.x; asm volatile("" : "+s"(G), "+s"(bx));
        const int vcu = (G % 8 == 0) ? (bx % 8) * (G / 8) + bx / 8 : bx;
        const int gw = vcu * 8 + wave, NGW = G * 8;
        unsigned char* ws = ka->ws;
        float* MOD = (float*)(ws + WS_MOD); float* MODP = (float*)(ws + WS_MODP);
        float* tabA = (float*)(ws + WS_TAB); float* tabB = tabA + 128 * 8 * 2;
        float* XCA = (float*)(ws + WS_XC); float* XCB = (float*)(ws + WS_MODP);
        bf16_t* XN = (bf16_t*)(ws + WS_XN); bf16_t* Ob = (bf16_t*)(ws + WS_O); bf16_t* Hb = (bf16_t*)(ws + WS_H); bf16_t* ACT = Hb;
        float* XL = ka->out;
        if (ph == 0) {
          {
            const float* w_mod = ka->in[6]; const float* c_in = ka->in[1]; const float* cctx_in = ka->in[3];
            for (int it = gw; it < 1536; it += NGW) {
                const int ks = it & 15, cgp = (it >> 4) % 24, l = it / 384;
                const int n0 = cgp * 256 + lane * 4;
                f32x4 acc[5];
#pragma unroll
                for (int s = 0; s < 5; ++s) acc[s] = (f32x4){0.f, 0.f, 0.f, 0.f};
                const float* wp = w_mod + ((size_t)l * 1024 + ks * 64) * 6144 + n0;
                for (int kk = 0; kk < 64; ++kk) {
                    const int k = ks * 64 + kk;
                    const f32x4 w = *(const f32x4*)(wp + (size_t)kk * 6144);
#pragma unroll
                    for (int s = 0; s < 4; ++s) acc[s] += silu_f(c_in[s * 1024 + k]) * w;
                    acc[4] += silu_f(cctx_in[k]) * w;
                }
#pragma unroll
                for (int s = 0; s < 5; ++s) *(f32x4*)(MODP + ((size_t)(ks * 4 + l) * 5 + s) * 6144 + n0) = acc[s];
            }
            LAS float* scr = (LAS float*)(lds + wave * 16384);
            for (int it = gw; it < 4 * 6144; it += NGW) {
                const int l = it / 6144; int r = it - l * 6144;
                unsigned char* wl = ws + WS_W + (size_t)l * W_LAYER;
                if (r < 1408) { transpose_item(ka->in[8] + (size_t)l * 1024 * 2816, 1024, 2816, (bf16_t*)wl, 1, scr, r, lane); continue; } r -= 1408;
                if (r < 512) { transpose_item(ka->in[9] + (size_t)l * 1024 * 1024, 1024, 1024, (bf16_t*)(wl + W_OUT_OFF), 0, scr, r, lane); continue; } r -= 512;
                if (r < 2816) { transpose_item(ka->in[18] + (size_t)l * 1024 * 5632, 1024, 5632, (bf16_t*)(wl + W_UP_OFF), 2, scr, r, lane); continue; } r -= 2816;
                transpose_item(ka->in[21] + (size_t)l * 2816 * 1024, 2816, 1024, (bf16_t*)(wl + W_DN_OFF), 0, scr, r, lane);
            }
            for (int idx = vcu * 512 + tid; idx < 3072; idx += G * 512) {
                int pos, i; float e;
                if (idx < 1024) { pos = idx >> 3; i = idx & 7; e = (float)i * 0.125f; } else { const int j = idx - 1024; pos = j >> 4; i = j & 15; e = (float)i * 0.0625f; }
                const float freq = exp2f(-e * 13.287712379549449f);
                const float ang = (float)pos * freq;
                float cc, ss; sincos_f(ang, cc, ss);
                float* tp = (idx < 1024) ? (tabA + idx * 2) : (tabB + (idx - 1024) * 2);
                tp[0] = cc; tp[1] = ss;
            }
          }
        } else if (ph == 1) {
            const float* b_mod = ka->in[7];
            for (int idx = vcu * 512 + tid; idx < 4 * 5 * 6144; idx += G * 512) {
                const int l = idx / 30720, n = idx % 6144;
                float s = b_mod[l * 6144 + n];
#pragma unroll
                for (int ks = 0; ks < 16; ++ks) s += MODP[(size_t)ks * 122880 + idx];
                MOD[idx] = s;
            }
        } else if (ph == N_PHASES - 1) {
            const float* fw = ka->in[22];
            for (int m = gw; m < ML; m += NGW) {
                f32x4* xr = (f32x4*)(XL + (size_t)m * DM) + lane;
                f32x4 v[4]; float s = 0.f;
#pragma unroll
                for (int j = 0; j < 4; ++j) { v[j] = xr[64 * j]; s += (v[j][0] * v[j][0] + v[j][1] * v[j][1]) + (v[j][2] * v[j][2] + v[j][3] * v[j][3]); }
                const float rstd = rsqrtf(wave_sum(s, lane) * (1.f / 1024.f) + 1e-6f);
#pragma unroll
                for (int j = 0; j < 4; ++j) { const f32x4 w = *(const f32x4*)(fw + 4 * (64 * j + lane)); xr[64 * j] = v[j] * rstd * w; }
            }
        } else {
            const int l = (ph - 2) / 7, k = (ph - 2) % 7;
            const bool need_ctx = l < DEPTH - 1;
            const float* modl = MOD + (size_t)l * 5 * 6144;
            unsigned char* wl = ws + WS_W + (size_t)l * W_LAYER;
            const float* srcL = (l == 0) ? ka->in[0] : XL;
            if (k == 0) {
                const float* nw = ka->in[4] + l * 1024;
                for (int m = gw; m < MT; m += NGW) {
                    const bool lat = m < ML; const int slot = lat ? (m >> 13) : 4;
                    if (lat) norm_mod_row(srcL + (size_t)m * DM, nw, modl + slot * 6144, modl + slot * 6144 + 1024, XN + (size_t)m * DM, lane);
                    else {
                        const size_t ro = (size_t)(m - ML) * DM;
                        norm_mod_row((l == 0 ? ka->in[2] : (const float*)XCB) + ro, nw, modl + slot * 6144, modl + slot * 6144 + 1024, XN + (size_t)m * DM, lane,
                                     (const float*)Ob + ro, (l == 0) ? 0 : 11, XCA + ro);
                    }
                }
            } else if (k == 1) {
                pg8::Gemm g{XN, (const bf16_t*)wl, MT, INC, DM, DM}; pg8::StaticOrder S; S.init(MT, INC, G, bx);
                pg8::EpiInProj E{Hb, tabA, tabB};
#ifndef DIS_IN
                pg8::gemm_phase<pg8::EpiInProj, pg8::StaticOrder, true, true>(lds, g, S, E);
#endif
            } else if (k == 2) {
                float lam, ofac;
                {
                    float d1 = 0.f, d2 = 0.f;
                    for (int i = 0; i < 32; ++i) { d1 += ka->in[10][l * 32 + i] * ka->in[11][l * 32 + i]; d2 += ka->in[12][l * 32 + i] * ka->in[13][l * 32 + i]; }
                    const float li = 0.8f - 0.6f * expf(-0.3f * (float)l);
                    lam = expf(d1) - expf(d2) + li;
                    lam = __uint_as_float(__builtin_amdgcn_readfirstlane(__float_as_uint(lam))); ofac = __uint_as_float(__builtin_amdgcn_readfirstlane(__float_as_uint(li)));
                }
                const float* subw = ka->in[14] + l * 64; const float* sink_l = ka->in[15] + l * 4; const float* rpb_l = ka->in[16] + (size_t)l * 4 * 465;
#ifndef DIS_A
                for (int u = vcu; u < 512 + (need_ctx ? 16 : 0); u += G) {
                    const bool cq = u >= 512; const int bh = cq ? (u - 512) : (u >> 5);
                    att::unit_A(cq, lds, Hb, Ob, bh >> 2, bh & 3, u & 31, lam, ofac, subw);
                }
#endif
#ifndef DIS_B
                for (int u = vcu; u < 1024 + (need_ctx ? 32 : 0); u += G) {
                    int mode, ub, uh, ublk; bool redo = true;
                    if (u < 512) { mode = 1; ub = u >> 7; uh = (u >> 6) & 1; ublk = u & 63; redo = att::unit_BC_fast<1>(lds, Hb, Ob, ub, uh, ublk, sink_l, rpb_l); }
                    else if (u < 1024) { const int v = u - 512; mode = 2; ub = v >> 7; uh = (v >> 5) & 3; ublk = v & 31; redo = att::unit_BC_fast<2>(lds, Hb, Ob, ub, uh, ublk, sink_l, rpb_l); }
                    else { const int v = u - 1024, bh = v & 15; if (v < 16) { mode = 3; ub = bh >> 2; uh = (bh >> 1) & 1; ublk = bh & 1; } else { mode = 4; ub = bh >> 2; uh = bh & 3; ublk = 0; } }
                    if (redo) att::unit_BC(mode, lds, Hb, Ob, ub, uh, ublk, sink_l, rpb_l);
                }
#endif
                {
                    const float* cwl = ka->in[17] + (size_t)l * 3 * 256;
                    const int rows = need_ctx ? MT : ML;
                    for (int idx = vcu * 512 + tid; idx < rows * 32; idx += G * 512) {
                        const int row = idx >> 5, c0 = (idx & 31) * 8;
                        int t, len; if (row < ML) { t = row & 8191; len = SEQ; } else { t = (row - ML) & 255; len = CTXL; }
                        const bf16_t* hp = Hb + (size_t)row * INC + 2048 + c0;
                        const u32x4 bg = *(const u32x4*)hp, cg1 = *(const u32x4*)(hp + 256), xi1 = *(const u32x4*)(hp + 512);
                        u32x4 cg0 = {0u, 0u, 0u, 0u}, xi0 = cg0, cg2 = cg0, xi2 = cg0;
                        if (t > 0) { cg0 = *(const u32x4*)(hp - INC + 256); xi0 = *(const u32x4*)(hp - INC + 512); }
                        if (t < len - 1) { cg2 = *(const u32x4*)(hp + INC + 256); xi2 = *(const u32x4*)(hp + INC + 512); }
                        float w0[8], w1[8], w2[8];
#pragma unroll
                        for (int e = 0; e < 8; ++e) { w0[e] = cwl[c0 + e]; w1[e] = cwl[256 + c0 + e]; w2[e] = cwl[512 + c0 + e]; }
                        u32x4 ow;
#pragma unroll
                        for (int e = 0; e < 4; ++e) {
                            const float ylo = w0[2 * e] * bflo(cg0[e]) * bflo(xi0[e]) + w1[2 * e] * bflo(cg1[e]) * bflo(xi1[e]) + w2[2 * e] * bflo(cg2[e]) * bflo(xi2[e]);
                            const float yhi = w0[2 * e + 1] * bfhi(cg0[e]) * bfhi(xi0[e]) + w1[2 * e + 1] * bfhi(cg1[e]) * bfhi(xi1[e]) + w2[2 * e + 1] * bfhi(cg2[e]) * bfhi(xi2[e]);
                            ow[e] = pkbf(bflo(bg[e]) * ylo, bfhi(bg[e]) * yhi);
                        }
                        *(u32x4*)(Ob + (size_t)row * DM + 768 + c0) = ow;
                    }
                }
                __syncthreads();
            } else if (k == 4) {
                const float* nw = ka->in[5] + l * 1024;
                const int nrows = (need_ctx ? NMX_ALL : NMX_L) * 256;
                for (int e = gw; e < nrows; e += NGW) {
                    const int pm = e >> 8, j = e & 255;
                    int t, slot; const float* base; int len;
                    if (pm < NMX_L) { const int s = pm / 33, ti = pm - s * 33; t = 254 * ti - 1 + j; len = SEQ; slot = s; base = XL + (size_t)s * SEQ * DM; }
                    else { const int p = 254 * (pm - NMX_L) - 1 + j; const int sq = (p < 0) ? 0 : p / 257, r = p - sq * 257; t = (p >= 0 && p < 1029 && r != 0) ? (r - 1) : -1; len = CTXL; slot = 4; base = XCA + (size_t)sq * CTXL * DM; }
                    const bool ok = (t >= 0 && t < len);
                    const float* src = ok ? (base + (size_t)t * DM) : nullptr;
                    if (pm < NMX_L || !ok) norm_mod_row(src, nw, modl + slot * 6144 + 3072, modl + slot * 6144 + 4096, XN + (size_t)e * DM, lane);
                    else {
                        const size_t ro = (size_t)(src - XCA);
                        norm_mod_row(src, nw, modl + slot * 6144 + 3072, modl + slot * 6144 + 4096, XN + (size_t)e * DM, lane, (const float*)Hb + ro, 4, XCB + ro);
                    }
                }
            } else if (k == 5) {
                const int nM = need_ctx ? NMX_ALL : NMX_L;
                pg8::Gemm g{XN, (const bf16_t*)(wl + W_UP_OFF), nM * 256, UPC, DM, DM}; pg8::StaticOrder S; S.init(nM * 256, UPC, G, bx);
                pg8::EpiUpConv E{ACT, ka->in[19] + (size_t)l * 3 * UPC, ka->in[20] + (size_t)l * UPC};
                pg8::OneUnit one;
#ifndef DIS_UP
                for (int i = 0; S.next(i, one.u); ++i) pg8::gemm_phase<pg8::EpiUpConv, pg8::OneUnit, false, true>(lds, g, one, E);
#endif
            } else {
                const bool isout = (k == 3); const int KK = isout ? DM : DFF;
                const bf16_t* Ap = isout ? (const bf16_t*)Ob : (const bf16_t*)ACT; const bf16_t* Bp = (const bf16_t*)(wl + (isout ? W_OUT_OFF : W_DN_OFF));
                {
                    pg8::Gemm g{Ap, Bp, ML, DM, KK, KK}; pg8::StaticOrder S; S.init(ML, DM, G, bx);
                    pg8::EpiRes E{isout ? srcL : (const float*)XL, nullptr, XL, nullptr, modl, isout ? 2048 : 5120};
#ifndef DIS_OUT
                    pg8::gemm_phase<pg8::EpiRes, pg8::StaticOrder, true, true>(lds, g, S, E);
#endif
                }
                if (need_ctx) {
                    const int P = isout ? 4 : 11, klen = KK / P;
                    for (int su = bx; su < 16 * P; su += G) {
                        const int tile = su / P, part = su - tile * P;
                        pg8::Gemm gs{Ap + (size_t)ML * KK + part * klen, Bp + part * klen, MC, DM, klen, KK};
                        pg8::OneUnit one; one.u.pm = tile >> 2; one.u.pn = tile & 3;
                        pg8::EpiSlab EA{(isout ? (float*)Hb : (float*)Ob) + (size_t)part * 1024 * 1024, modl + 4 * 6144 + (isout ? 2048 : 5120)};
                        pg8::gemm_phase<pg8::EpiSlab, pg8::OneUnit, false, true>(lds, gs, one, EA);
                    }
                }
            }
        }
        if (ph + 1 < ph_hi && kargs()->coop) {
            if (kargs()->coop == 2) cg::this_grid().sync();
            else { XcdBarrier b; b.bar = (unsigned*)kargs()->ws; b.x = xb_xcc_id(); b.st = bar_st; xcd_barrier(b); }
        }
    }
}

extern "C" void kernel_launch(void* const* d_in, const int* in_sizes, int n_in, void* d_out, int out_size, void* d_ws, size_t ws_size, hipStream_t stream) {
    static int grid = 0;
    if (grid == 0) {
        if (n_in != 23 || out_size != ML * DM || ws_size < WS_END) { fprintf(stderr, "kernel_launch: unexpected shapes (n_in %d out %d ws %zu need %zu)\n", n_in, out_size, ws_size, (size_t)WS_END); grid = -1; return; }
        int dev = 0, cus = 0, per_cu = 0;
        if (hipGetDevice(&dev) != hipSuccess || hipDeviceGetAttribute(&cus, hipDeviceAttributeMultiprocessorCount, dev) != hipSuccess) { grid = -1; return; }
        if (hipFuncSetAttribute((const void*)fwd_kernel, hipFuncAttributeMaxDynamicSharedMemorySize, LDS_BYTES) != hipSuccess) { fprintf(stderr, "kernel_launch: hipFuncSetAttribute failed\n"); grid = -1; return; }
        if (hipOccupancyMaxActiveBlocksPerMultiprocessor(&per_cu, (const void*)fwd_kernel, 512, LDS_BYTES) != hipSuccess || per_cu < 1) fprintf(stderr, "kernel_launch: occupancy query says %d\n", per_cu);
        (void)hipGetLastError();
        grid = cus;
    }
    if (grid < 0) return;
    Args a{};
    for (int i = 0; i < 23; ++i) a.in[i] = (const float*)d_in[i];
    a.out = (float*)d_out; a.ws = (unsigned char*)d_ws;
#if MK_MULTI
    for (int ph = 0; ph < N_PHASES; ++ph) {
        a.ph_lo = ph; a.ph_hi = ph + 1; a.coop = 0;
        hipLaunchKernelGGL(fwd_kernel, dim3(grid), dim3(512), LDS_BYTES, stream, a);
    }
#else
    a.ph_lo = 0; a.ph_hi = N_PHASES; a.coop = 1;
    if (hipMemsetAsync(d_ws, 0, 16384, stream) != hipSuccess) { fprintf(stderr, "kernel_launch: memset failed\n"); return; }
    void* args[] = {&a};
    hipError_t e = hipLaunchCooperativeKernel((const void*)fwd_kernel, dim3(grid), dim3(512), args, LDS_BYTES, stream);
    if (e != hipSuccess) fprintf(stderr, "cooperative launch failed: %s (grid %d)\n", hipGetErrorString(e), grid);
#endif
}
```

```cpp
#include <hip/hip_runtime.h>
#include <hip/hip_cooperative_groups.h>
#include <cstdio>
#include <cstdint>
namespace cg = cooperative_groups;

#ifndef MK_MULTI
#define MK_MULTI 0
#endif

#ifndef REP_IN
#define REP_IN 1
#endif
#ifndef REP_UP
#define REP_UP 1
#endif
#ifndef REP_A
#define REP_A 1
#endif
#ifndef REP_OD
#define REP_OD 1
#endif
#ifndef REP_P
#define REP_P 1
#endif
#ifndef REP_BC
#define REP_BC 1
#endif
#ifndef REP_M
#define REP_M 1
#endif

__device__ __forceinline__ int pg8_ltid() { int t = threadIdx.x; asm volatile("" : "+v"(t)); return t; }
namespace pg8 {
#define PG8_LAS __attribute__((address_space(3)))
typedef unsigned short bf16_t;
typedef short bf16x8 __attribute__((ext_vector_type(8)));
typedef float f32x4 __attribute__((ext_vector_type(4)));
typedef unsigned u32x4 __attribute__((ext_vector_type(4)));
constexpr int BM = 256, BK = 64, HALF = 128, HTB = HALF * BK * 2  , STAGE_BYTES = 8 * HTB, NXCD = 8, WGM = 8;

__host__ __device__ __forceinline__ int lds_byte(int r, int c) { const int st = (r >> 4) * 2 + (c >> 5), rr = r & 15, cc = c & 31, ob = rr * 64 + cc * 2; return st * 1024 + (ob ^ (((ob >> 9) & 1) << 5)); }
__host__ __device__ __forceinline__ void stage_rc(int b, int& R, int& C) { const int st = b / 1024, sb = b % 1024, swz = sb ^ (((sb >> 9) & 1) << 5); R = (st >> 1) * 16 + swz / 64; C = (st & 1) * 32 + (swz % 64) / 2; }
__host__ __device__ __forceinline__ int perm32(int rho) { const int n = rho >> 4, i = rho & 15; return 8 * (i >> 2) + 4 * n + (i & 3); }

struct Unit { int pm, pn; };
struct Gemm { const bf16_t* A; const bf16_t* Bt; int M, N, K, ldk; };

struct StaticOrder {
    int nM, nN, nwg, G, c;
    __host__ __device__ void init(int M, int N, int G_, int c_) { nM = M / BM; nN = N / BM; nwg = nM * nN; G = G_; c = c_; }
    __host__ __device__ bool next(int i, Unit& u) const {
        const long L = (long)i * G + c; if (L >= nwg) return false;
        int wgid = (int)L; { const int q = nwg / NXCD, r = nwg % NXCD, xcd = wgid % NXCD, off = wgid / NXCD; wgid = (xcd < r ? xcd * (q + 1) : r * (q + 1) + (xcd - r) * q) + off; }
        const int nig = WGM * nN, gid = wgid / nig, fm = gid * WGM, gsz = (nM - fm) < WGM ? (nM - fm) : WGM;
        u.pm = fm + ((wgid % nig) % gsz); u.pn = (wgid % nig) / gsz; return true;
    }
    __device__ __forceinline__ void a_ready(const Unit&) const {}
    __device__ __forceinline__ void done(const Unit&) const {}
};

typedef float pg8_f32x2 __attribute__((ext_vector_type(2))); typedef __bf16 pg8_bf16x2 __attribute__((ext_vector_type(2)));
__device__ __forceinline__ unsigned cvt_pk_bf16(float lo, float hi) { pg8_f32x2 v = {lo, hi}; pg8_bf16x2 b = __builtin_convertvector(v, pg8_bf16x2); return __builtin_bit_cast(unsigned, b); }
typedef unsigned u32x2 __attribute__((ext_vector_type(2)));

struct OneUnit {
    Unit u;
    __device__ __forceinline__ bool next(int i, Unit& o) const { if (i != 0) return false; o = u; return true; }
    __device__ __forceinline__ void a_ready(const Unit&) const {}
    __device__ __forceinline__ void done(const Unit&) const {}
};

struct EpiInProj {
    static constexpr bool PERM = true, AFTER_DRAIN = false;
    bf16_t* H; const float* tabA; const float* tabB;
    __device__ __forceinline__ void operator()(const f32x4 (&acc)[2][2][4][2], const Unit& u, int wr, int wc, int fr, int fq) const {
        const int pn = u.pn; const bool latent = u.pm < 128;
        const float scale = (pn == 0) ? 0.17677669529663687f * 1.4426950408889634f : ((pn == 3 || pn == 5) ? 0.125f * 1.4426950408889634f : 1.0f);
#pragma unroll
        for (int bj = 0; bj < 2; ++bj) {
            int mode = (pn == 0 || pn == 1) ? 1 : ((pn == 3 || (pn == 4 && bj == 0)) ? 2 : 0);
            if (!latent) mode = 0;
#ifdef TEST_NOROPE
            mode = 0;
#endif
#pragma unroll
            for (int ai = 0; ai < 2; ++ai)
#pragma unroll
                for (int m = 0; m < 4; ++m) {
                    const int r = u.pm * BM + ai * HALF + wr * 64 + m * 16 + fr;
                    f32x4 v0 = acc[ai][bj][m][0], v1 = acc[ai][bj][m][1];
                    if (mode != 0) {
                        const int t = r & 8191, trow = t >> 6, tcol = t & 63;
                        const float* tp;
                        if (mode == 1) { const int pos = (fq < 2) ? trow : tcol; tp = tabA + (pos * 8 + 4 * (fq & 1)) * 2; }
                        else { const int pos = (wc & 1) ? tcol : trow; tp = tabB + (pos * 16 + 4 * fq) * 2; }
                        const f32x4 cs0 = *(const f32x4*)tp, cs1 = *(const f32x4*)(tp + 4);
                        const float c0 = cs0[0], s0 = cs0[1], c1 = cs0[2], s1 = cs0[3], c2 = cs1[0], s2 = cs1[1], c3 = cs1[2], s3 = cs1[3];
                        f32x4 a = v0, b = v1;
                        v0[0] = a[0] * c0 - b[0] * s0; v1[0] = b[0] * c0 + a[0] * s0;
                        v0[1] = a[1] * c1 - b[1] * s1; v1[1] = b[1] * c1 + a[1] * s1;
                        v0[2] = a[2] * c2 - b[2] * s2; v1[2] = b[2] * c2 + a[2] * s2;
                        v0[3] = a[3] * c3 - b[3] * s3; v1[3] = b[3] * c3 + a[3] * s3;
                    }
                    v0 = v0 * scale; v1 = v1 * scale;
                    bf16_t* rowp = H + (size_t)r * 2816 + pn * BM + bj * HALF + wc * 32 + 8 * fq;
                    u32x4 w; w.x = cvt_pk_bf16(v0[0], v0[1]); w.y = cvt_pk_bf16(v0[2], v0[3]); w.z = cvt_pk_bf16(v1[0], v1[1]); w.w = cvt_pk_bf16(v1[2], v1[3]);
                    *(u32x4*)rowp = w;
                }
        }
    }
};

struct EpiRes {
    static constexpr bool PERM = false, AFTER_DRAIN = false;
    const float* baseL; const float* baseC; float* outL; float* outC; const float* modl; int goff;
    __device__ __forceinline__ void operator()(const f32x4 (&acc)[2][2][4][2], const Unit& u, int wr, int wc, int fr, int fq) const {
        const bool ctx = u.pm >= 128; const int slot = ctx ? 4 : (u.pm >> 5);
        const int row0 = (ctx ? (u.pm - 128) : u.pm) * BM + wr * 64 + fr;
        const float* bp = ctx ? baseC : baseL; float* op = ctx ? outC : outL;
        const int col0 = u.pn * BM + wc * 32 + 4 * fq;
        f32x4 gv[2][2];
#pragma unroll
        for (int bj = 0; bj < 2; ++bj)
#pragma unroll
            for (int n = 0; n < 2; ++n) gv[bj][n] = *(const f32x4*)(modl + slot * 6144 + goff + col0 + bj * HALF + n * 16);
#pragma unroll
        for (int ai = 0; ai < 2; ++ai)
#pragma unroll
            for (int m = 0; m < 4; ++m) {
                const size_t off = (size_t)(row0 + ai * HALF + m * 16) * 1024 + col0;
#pragma unroll
                for (int bj = 0; bj < 2; ++bj)
#pragma unroll
                    for (int n = 0; n < 2; ++n) {
                        const f32x4 bs = *(const f32x4*)(bp + off + bj * HALF + n * 16);
                        *(f32x4*)(op + off + bj * HALF + n * 16) = bs + gv[bj][n] * acc[ai][bj][m][n];
                    }
                asm volatile("" ::: "memory");
            }
    }
};

struct EpiSlab {
    static constexpr bool PERM = false, AFTER_DRAIN = false;
    float* slab; const float* gate;
    __device__ __forceinline__ void operator()(const f32x4 (&acc)[2][2][4][2], const Unit& u, int wr, int wc, int fr, int fq) const {
        const int row0 = u.pm * BM + wr * 64 + fr, col0 = u.pn * BM + wc * 32 + 4 * fq;
#pragma unroll
        for (int bj = 0; bj < 2; ++bj)
#pragma unroll
            for (int n = 0; n < 2; ++n) {
                const f32x4 gv = *(const f32x4*)(gate + col0 + bj * HALF + n * 16);
#pragma unroll
                for (int ai = 0; ai < 2; ++ai)
#pragma unroll
                    for (int m = 0; m < 4; ++m)
                        *(f32x4*)(slab + (size_t)(row0 + ai * HALF + m * 16) * 1024 + col0 + bj * HALF + n * 16) = gv * acc[ai][bj][m][n];
            }
    }
};

struct EpiUpConv {
    static constexpr bool PERM = false, AFTER_DRAIN = true;
    bf16_t* ACT; const float* cw; const float* cb;
    static constexpr int TP = 520;
    __device__ __forceinline__ void fused(f32x4 (&acc)[2][2][4][2], const Unit& u, int wr, int wc, int fr, int fq, PG8_LAS unsigned char* lds, int wid, int lane) const {
#pragma unroll
        for (int ai = 0; ai < 2; ++ai)
#pragma unroll
            for (int m = 0; m < 4; ++m) {
                const int row = ai * HALF + wr * 64 + m * 16 + fr;
#pragma unroll
                for (int bj = 0; bj < 2; ++bj)
#pragma unroll
                    for (int n = 0; n < 2; ++n) {
                        const f32x4 v = acc[ai][bj][m][n]; u32x2 w; w.x = cvt_pk_bf16(v[0], v[1]); w.y = cvt_pk_bf16(v[2], v[3]);
                        *(PG8_LAS u32x2*)(lds + row * TP + (bj * HALF + wc * 32 + n * 16 + 4 * fq) * 2) = w;
                    }
            }
        const int tid = wid * 64 + lane, ch = tid & 15;
        const int gcol = u.pn * 128 + ch * 8;
        float wg[3][8], wv[3][8], bg[8], bv[8];
#pragma unroll
        for (int k = 0; k < 3; ++k) {
            const f32x4 a0 = *(const f32x4*)(cw + k * 5632 + gcol), a1 = *(const f32x4*)(cw + k * 5632 + gcol + 4);
            const f32x4 b0 = *(const f32x4*)(cw + k * 5632 + 2816 + gcol), b1 = *(const f32x4*)(cw + k * 5632 + 2816 + gcol + 4);
#pragma unroll
            for (int e = 0; e < 4; ++e) { wg[k][e] = a0[e]; wg[k][4 + e] = a1[e]; wv[k][e] = b0[e]; wv[k][4 + e] = b1[e]; }
        }
        {
            const f32x4 a0 = *(const f32x4*)(cb + gcol), a1 = *(const f32x4*)(cb + gcol + 4), b0 = *(const f32x4*)(cb + 2816 + gcol), b1 = *(const f32x4*)(cb + 2816 + gcol + 4);
#pragma unroll
            for (int e = 0; e < 4; ++e) { bg[e] = a0[e]; bg[4 + e] = a1[e]; bv[e] = b0[e]; bv[4 + e] = b1[e]; }
        }
        const bool lat = u.pm < 132; int rowbase, ti;
        if (lat) { const int s = u.pm / 33; ti = u.pm - s * 33; rowbase = s * 8192; } else { ti = u.pm - 132; rowbase = 32768; }
        asm volatile("s_waitcnt lgkmcnt(0)" ::: "memory"); __builtin_amdgcn_s_barrier(); asm volatile("" ::: "memory");
        for (int it = tid; it < 254 * 16; it += 512) {
            const int j = 1 + (it >> 4); const int p = 254 * ti - 1 + j;
            int orow; bool ok;
            if (lat) { ok = p < 8192; orow = rowbase + p; } else { const int sq = p / 257, r = p - sq * 257; ok = (p < 1029) && (r != 0); orow = rowbase + sq * 256 + r - 1; }
            if (ok) {
                float g[8], v[8];
#pragma unroll
                for (int e = 0; e < 8; ++e) { g[e] = bg[e]; v[e] = bv[e]; }
#pragma unroll
                for (int k = 0; k < 3; ++k) {
                    const PG8_LAS unsigned char* rp = lds + (j - 1 + k) * TP + ch * 16;
                    const u32x2 g0 = *(const PG8_LAS u32x2*)rp, g1 = *(const PG8_LAS u32x2*)(rp + 8);
                    const u32x2 v0 = *(const PG8_LAS u32x2*)(rp + 256), v1 = *(const PG8_LAS u32x2*)(rp + 264);
                    const unsigned gw[4] = {g0.x, g0.y, g1.x, g1.y}, vw[4] = {v0.x, v0.y, v1.x, v1.y};
#pragma unroll
                    for (int e = 0; e < 4; ++e) {
                        g[2 * e] += wg[k][2 * e] * __uint_as_float(gw[e] << 16); g[2 * e + 1] += wg[k][2 * e + 1] * __uint_as_float(gw[e] & 0xffff0000u);
                        v[2 * e] += wv[k][2 * e] * __uint_as_float(vw[e] << 16); v[2 * e + 1] += wv[k][2 * e + 1] * __uint_as_float(vw[e] & 0xffff0000u);
                    }
                }
                float o[8];
#pragma unroll
                for (int e = 0; e < 8; ++e) o[e] = g[e] / (1.f + __expf(-g[e])) * v[e];
                u32x4 w; w.x = cvt_pk_bf16(o[0], o[1]); w.y = cvt_pk_bf16(o[2], o[3]); w.z = cvt_pk_bf16(o[4], o[5]); w.w = cvt_pk_bf16(o[6], o[7]);
                *(u32x4*)(ACT + (size_t)orow * 2816 + gcol) = w;
            }
        }
        asm volatile("s_waitcnt lgkmcnt(0)" ::: "memory"); __builtin_amdgcn_s_barrier(); asm volatile("" ::: "memory");
    }
};
template <class Epi, class Sched, bool ALIGN_EPI = false, bool SP2 = false>
__device__ __forceinline__ void gemm_phase(PG8_LAS unsigned char* lds, const Gemm g, const Sched& S, const Epi& E) {
    const int tid = pg8_ltid(), wid = __builtin_amdgcn_readfirstlane(tid >> 6), lane = tid & 63, wr = wid >> 2, wc = wid & 3, fr = lane & 15, fq = lane >> 4;
    const int K = g.ldk, nt = g.K / BK;
    unsigned voffA[2], voffB[2];
#pragma unroll
    for (int i = 0; i < 2; ++i) { int R, C; stage_rc(tid * 16 + i * 8192, R, C); const int Rb = Epi::PERM ? ((R & ~31) + perm32(R & 31)) : R;
        voffA[i] = (unsigned)(R * K + C) * 2u; voffB[i] = (unsigned)(Rb * K + C) * 2u; }
    const size_t kstep = (size_t)(BK * 2);
    const size_t hstep = (size_t)HALF * K * 2;
    const size_t tstep = 2 * hstep;
    const unsigned ldsw = (unsigned)wid * 1024u;
    const int aoff = lds_byte(wr * 64 + fr, fq * 8), boff = lds_byte(wc * 32 + fr, fq * 8);
#define PG8_SA(b, h) (((b) * 2 + (h)) * HTB)
#define PG8_SB(b, h) ((4 + (b) * 2 + (h)) * HTB)
#define PG8_STAGE(bufoff, gbase, voff) do { _Pragma("unroll") for (int _i = 0; _i < 2; ++_i) \
        __builtin_amdgcn_global_load_lds((const unsigned*)((const char*)(gbase) + (voff)[_i]), (PG8_LAS unsigned*)(lds + (bufoff) + ldsw + _i * 8192), 16, 0, 0); } while (0)
#define PG8_LDA(dst, b, h) do { _Pragma("unroll") for (int m = 0; m < 4; ++m) _Pragma("unroll") for (int k = 0; k < 2; ++k) dst[m][k] = *(const PG8_LAS bf16x8*)(lds + PG8_SA(b, h) + aoff + m * 2048 + k * 1024); } while (0)
#define PG8_LDB(dst, b, h) do { _Pragma("unroll") for (int n = 0; n < 2; ++n) _Pragma("unroll") for (int k = 0; k < 2; ++k) dst[n][k] = *(const PG8_LAS bf16x8*)(lds + PG8_SB(b, h) + boff + n * 2048 + k * 1024); } while (0)
#define PG8_MMA(ai, bj, At, Bt) do { __builtin_amdgcn_s_setprio(1); _Pragma("unroll") for (int m = 0; m < 4; ++m) _Pragma("unroll") for (int n = 0; n < 2; ++n) _Pragma("unroll") for (int k = 0; k < 2; ++k) \
        acc[ai][bj][m][n] = __builtin_amdgcn_mfma_f32_16x16x32_bf16(Bt[n][k], At[m][k], acc[ai][bj][m][n], 0, 0, 0); __builtin_amdgcn_s_setprio(0); } while (0)
#define PG8_WAIT_V(n) asm volatile("s_waitcnt vmcnt(" #n ")" ::: "memory")
#define PG8_WAIT_L(n) asm volatile("s_waitcnt lgkmcnt(" #n ")" ::: "memory")
#define PG8_BAR __builtin_amdgcn_s_barrier()
#define PG8_SCHED __builtin_amdgcn_sched_barrier(0)
    Unit cur, nxt; int ui = 0;
    if (!S.next(0, cur)) return;
    f32x4 acc[2][2][4][2];
#pragma unroll
    for (int a = 0; a < 2; ++a)
#pragma unroll
        for (int b = 0; b < 2; ++b)
#pragma unroll
            for (int m = 0; m < 4; ++m)
#pragma unroll
                for (int n = 0; n < 2; ++n) acc[a][b][m][n] = (f32x4){0.f, 0.f, 0.f, 0.f};
    bf16x8 At[4][2], B0[2][2], B1[2][2];
    const char* cA = (const char*)g.A + (size_t)cur.pm * tstep; const char* cB = (const char*)g.Bt + (size_t)cur.pn * tstep;
    S.a_ready(cur);
    if constexpr (SP2) {
        PG8_STAGE(PG8_SB(0, 0), cB, voffB); PG8_STAGE(PG8_SB(0, 1), cB + hstep, voffB); PG8_STAGE(PG8_SA(0, 0), cA, voffA); PG8_STAGE(PG8_SA(0, 1), cA + hstep, voffA);
        if (wr == 1) PG8_BAR;
        PG8_WAIT_V(2); PG8_BAR;
        PG8_STAGE(PG8_SB(1, 0), cB + kstep, voffB); PG8_STAGE(PG8_SA(1, 0), cA + kstep, voffA); PG8_STAGE(PG8_SB(1, 1), cB + hstep + kstep, voffB);
        PG8_WAIT_V(6); PG8_BAR;
    } else {
        PG8_STAGE(PG8_SB(0, 0), cB, voffB); PG8_STAGE(PG8_SA(0, 0), cA, voffA); PG8_STAGE(PG8_SB(0, 1), cB + hstep, voffB); PG8_STAGE(PG8_SA(0, 1), cA + hstep, voffA);
        if (wr == 1) PG8_BAR;
        PG8_WAIT_V(4); PG8_BAR;
        PG8_STAGE(PG8_SB(1, 0), cB + kstep, voffB); PG8_STAGE(PG8_SA(1, 0), cA + kstep, voffA); PG8_STAGE(PG8_SB(1, 1), cB + hstep + kstep, voffB);
        PG8_WAIT_V(6); PG8_BAR;
    }
    for (;;) {
        const bool has_next = S.next(ui + 1, nxt);
        const char* nA = has_next ? (const char*)g.A + (size_t)nxt.pm * tstep : cA; const char* nB = has_next ? (const char*)g.Bt + (size_t)nxt.pn * tstep : cB;
        for (int t = 0; t < nt; t += 2) {
            const bool last = (t == nt - 2);
            const char* a1 = cA + (size_t)(t + 1) * kstep;
            const char* a2 = last ? nA : cA + (size_t)(t + 2) * kstep; const char* b2 = last ? nB : cB + (size_t)(t + 2) * kstep;
            const char* a3 = a2 + kstep; const char* b3 = b2 + kstep;
            if (last && has_next) S.a_ready(nxt);
            if constexpr (SP2) {
            PG8_LDB(B0, 0, 0); PG8_LDB(B1, 0, 1); PG8_SCHED; PG8_LDA(At, 0, 0); PG8_STAGE(PG8_SA(1, 1), a1 + hstep, voffA);
            PG8_WAIT_V(8); PG8_WAIT_L(0); PG8_BAR; PG8_MMA(0, 0, At, B0); PG8_MMA(0, 1, At, B1); PG8_BAR; PG8_SCHED;
            PG8_LDA(At, 0, 1); PG8_STAGE(PG8_SB(0, 0), b2, voffB); PG8_STAGE(PG8_SB(0, 1), b2 + hstep, voffB); PG8_STAGE(PG8_SA(0, 0), a2, voffA);
            PG8_WAIT_V(8); PG8_WAIT_L(0); PG8_BAR; PG8_MMA(1, 0, At, B0); PG8_MMA(1, 1, At, B1); PG8_BAR; PG8_SCHED;
            PG8_LDB(B0, 1, 0); PG8_LDB(B1, 1, 1); PG8_SCHED; PG8_LDA(At, 1, 0); PG8_STAGE(PG8_SA(0, 1), a2 + hstep, voffA);
            PG8_WAIT_V(8); PG8_WAIT_L(0); PG8_BAR; PG8_MMA(0, 0, At, B0); PG8_MMA(0, 1, At, B1); PG8_BAR; PG8_SCHED;
            PG8_LDA(At, 1, 1); PG8_STAGE(PG8_SB(1, 0), b3, voffB); PG8_STAGE(PG8_SB(1, 1), b3 + hstep, voffB); PG8_STAGE(PG8_SA(1, 0), a3, voffA);
            PG8_WAIT_V(8); PG8_WAIT_L(0); PG8_BAR; PG8_MMA(1, 0, At, B0); PG8_MMA(1, 1, At, B1); PG8_BAR; PG8_SCHED;
            } else {
            PG8_LDB(B0, 0, 0); PG8_SCHED; PG8_LDA(At, 0, 0); PG8_STAGE(PG8_SA(1, 1), a1 + hstep, voffA);
            PG8_WAIT_L(8); PG8_BAR; PG8_WAIT_L(0); PG8_MMA(0, 0, At, B0); PG8_BAR; PG8_SCHED;
            PG8_LDB(B1, 0, 1); PG8_STAGE(PG8_SB(0, 0), b2, voffB);
            PG8_BAR; PG8_WAIT_L(0); PG8_MMA(0, 1, At, B1); PG8_BAR;
            PG8_LDA(At, 0, 1); PG8_STAGE(PG8_SA(0, 0), a2, voffA);
            PG8_BAR; PG8_WAIT_L(0); PG8_MMA(1, 0, At, B0); PG8_BAR; PG8_SCHED;
            PG8_STAGE(PG8_SB(0, 1), b2 + hstep, voffB);
            PG8_WAIT_V(6); PG8_BAR; PG8_MMA(1, 1, At, B1); PG8_BAR;
            PG8_LDB(B0, 1, 0); PG8_SCHED; PG8_LDA(At, 1, 0); PG8_STAGE(PG8_SA(0, 1), a2 + hstep, voffA);
            PG8_WAIT_L(8); PG8_BAR; PG8_WAIT_L(0); PG8_MMA(0, 0, At, B0); PG8_BAR; PG8_SCHED;
            PG8_LDB(B1, 1, 1); PG8_STAGE(PG8_SB(1, 0), b3, voffB);
            PG8_BAR; PG8_WAIT_L(0); PG8_MMA(0, 1, At, B1); PG8_BAR;
            PG8_LDA(At, 1, 1); PG8_STAGE(PG8_SA(1, 0), a3, voffA);
            PG8_BAR; PG8_WAIT_L(0); PG8_MMA(1, 0, At, B0); PG8_BAR; PG8_SCHED;
            PG8_STAGE(PG8_SB(1, 1), b3 + hstep, voffB);
            PG8_WAIT_V(6); PG8_BAR; PG8_MMA(1, 1, At, B1); PG8_BAR;
            }
        }
        if constexpr (ALIGN_EPI) { if (wr == 0) PG8_BAR; }
        if constexpr (!Epi::AFTER_DRAIN) { E(acc, cur, wr, wc, fr, fq); S.done(cur); }
        if (!has_next) break;
#pragma unroll
        for (int a = 0; a < 2; ++a)
#pragma unroll
            for (int b = 0; b < 2; ++b)
#pragma unroll
                for (int m = 0; m < 4; ++m)
#pragma unroll
                    for (int n = 0; n < 2; ++n) acc[a][b][m][n] = (f32x4){0.f, 0.f, 0.f, 0.f};
        cur = nxt; cA = nA; cB = nB; ++ui;
        if constexpr (ALIGN_EPI) { if (wr == 1) PG8_BAR; }
    }
    PG8_WAIT_V(0);
    if constexpr (!ALIGN_EPI) { if (wr == 0) PG8_BAR; }
    PG8_BAR;
    if constexpr (Epi::AFTER_DRAIN) { E.fused(acc, cur, wr, wc, fr, fq, lds, wid, lane); S.done(cur); }
#undef PG8_SA
#undef PG8_SB
#undef PG8_STAGE
#undef PG8_LDA
#undef PG8_LDB
#undef PG8_MMA
#undef PG8_WAIT_V
#undef PG8_WAIT_L
#undef PG8_BAR
#undef PG8_SCHED
}
}
#define LAS __attribute__((address_space(3)))
typedef unsigned short bf16_t;
typedef short bf16x8 __attribute__((ext_vector_type(8)));
typedef short s16x4 __attribute__((ext_vector_type(4)));
typedef float f32x4 __attribute__((ext_vector_type(4)));
typedef float f32x16 __attribute__((ext_vector_type(16)));
typedef unsigned u32x4 __attribute__((ext_vector_type(4)));
typedef unsigned u32x2 __attribute__((ext_vector_type(2)));

constexpr int DM = 1024, NB = 4, SEQ = 8192, DEPTH = 4, CTXL = 256;
constexpr int ML = NB * SEQ, MC = NB * CTXL, MT = ML + MC;
constexpr int INC = 2816, DFF = 2816, UPC = 5632;
constexpr int NMX_L = NB * 33, NMX_ALL = NB * 33 + 5;
constexpr float LOG2E = 1.4426950408889634f;

constexpr size_t MiB = 1u << 20;
constexpr size_t WS_MOD = 1 * MiB;
constexpr size_t WS_MODP = 2 * MiB;
constexpr size_t WS_TAB = 10 * MiB;
constexpr size_t WS_XC = 11 * MiB;
constexpr size_t WS_W = 16 * MiB;
constexpr size_t W_LAYER = 24 * MiB, W_OUT_OFF = (size_t)2816 * 1024 * 2, W_UP_OFF = W_OUT_OFF + (size_t)1024 * 1024 * 2, W_DN_OFF = W_UP_OFF + (size_t)5632 * 1024 * 2;
constexpr size_t WS_XN = 112 * MiB;
constexpr size_t WS_O = 182 * MiB;
constexpr size_t WS_H = 248 * MiB;
constexpr size_t WS_END = WS_H + (size_t)MT * 2816 * 2;
static_assert(W_DN_OFF + (size_t)1024 * 2816 * 2 <= W_LAYER, "weights per layer");
static_assert(WS_XN + (size_t)NMX_ALL * 256 * 1024 * 2 <= WS_O && WS_O + (size_t)MT * 1024 * 2 <= WS_H && WS_END <= 512 * MiB, "ws map");

constexpr int RING_BYTES = 135168;
constexpr int LDS_BYTES = 147456;

__device__ __forceinline__ unsigned pkbf(float lo, float hi) { return pg8::cvt_pk_bf16(lo, hi); }
__device__ __forceinline__ float bflo(unsigned w) { return __uint_as_float(w << 16); }
__device__ __forceinline__ float bfhi(unsigned w) { return __uint_as_float(w & 0xffff0000u); }
__device__ __forceinline__ float dpp_add(float v, const int ctrl_sel) {
    int m;
    if (ctrl_sel == 0) m = __builtin_amdgcn_update_dpp(0, __float_as_int(v), 0xB1, 0xF, 0xF, true);
    else if (ctrl_sel == 1) m = __builtin_amdgcn_update_dpp(0, __float_as_int(v), 0x4E, 0xF, 0xF, true);
    else if (ctrl_sel == 2) m = __builtin_amdgcn_update_dpp(0, __float_as_int(v), 0x124, 0xF, 0xF, true);
    else m = __builtin_amdgcn_update_dpp(0, __float_as_int(v), 0x128, 0xF, 0xF, true);
    return v + __int_as_float(m);
}
__device__ __forceinline__ float wave_sum(float v, int lane) {
    v = dpp_add(v, 0); v = dpp_add(v, 1); v = dpp_add(v, 2); v = dpp_add(v, 3);
    v += __int_as_float(__builtin_amdgcn_ds_bpermute((lane ^ 16) << 2, __float_as_int(v)));
    auto rr = __builtin_amdgcn_permlane32_swap(__float_as_uint(v), __float_as_uint(v), false, false);
    return __uint_as_float(rr[0]) + __uint_as_float(rr[1]);
}
__device__ __forceinline__ float xhalf_max(float v) { auto rr = __builtin_amdgcn_permlane32_swap(__float_as_uint(v), __float_as_uint(v), false, false); return fmaxf(__uint_as_float(rr[0]), __uint_as_float(rr[1])); }
__device__ __forceinline__ float xhalf_sum(float v) { auto rr = __builtin_amdgcn_permlane32_swap(__float_as_uint(v), __float_as_uint(v), false, false); return __uint_as_float(rr[0]) + __uint_as_float(rr[1]); }

namespace att {
constexpr int KP = 144, VP = 136;
constexpr int L_KS = 0, L_VT = 64 * KP, L_RPB = L_VT + 64 * VP, L_END = L_RPB + 2048;
__device__ __forceinline__ int crow(int r, int h) { return (r & 3) + 8 * (r >> 2) + 4 * h; }

struct TileRegs { u32x4 k, v; };
__device__ __forceinline__ void tile_gload(TileRegs& R, const bf16_t* H, int krow, int kcol, int vcol, int tid) {
    const int key = tid >> 3, ch = tid & 7;
    const bf16_t* p = H + (size_t)(krow + key) * INC;
    R.k = *(const u32x4*)(p + kcol + 8 * ch); R.v = *(const u32x4*)(p + vcol + 8 * ch);
}
__device__ __forceinline__ void tile_swrite(const TileRegs& R, LAS unsigned char* lds, int tid) {
    const int key = tid >> 3, ch = tid & 7;
    *(LAS u32x4*)(lds + L_KS + key * KP + ch * 16) = R.k;
    LAS unsigned short* vt = (LAS unsigned short*)(lds + L_VT);
#pragma unroll
    for (int j = 0; j < 4; ++j) { const unsigned w = R.v[j]; vt[(8 * ch + 2 * j) * (VP / 2) + key] = (unsigned short)(w & 0xffffu); vt[(8 * ch + 2 * j + 1) * (VP / 2) + key] = (unsigned short)(w >> 16); }
}
template <int KS0, int NKS>
__device__ __forceinline__ f32x16 qk_block(const LAS unsigned char* lds, int kb, int r32, int hh, const bf16x8 (&qf)[4]) {
    f32x16 s = {0.f, 0.f, 0.f, 0.f, 0.f, 0.f, 0.f, 0.f, 0.f, 0.f, 0.f, 0.f, 0.f, 0.f, 0.f, 0.f};
#pragma unroll
    for (int ks = KS0; ks < KS0 + NKS; ++ks) {
        const bf16x8 kf = *(const LAS bf16x8*)(lds + L_KS + (kb * 32 + r32) * KP + ks * 32 + hh * 16);
        s = __builtin_amdgcn_mfma_f32_32x32x16_bf16(kf, qf[ks], s, 0, 0, 0);
    }
    return s;
}
__device__ __forceinline__ void softmax_pv(f32x16 (&s)[2], float& m, float& l, f32x16 (&O)[2], const LAS unsigned char* lds, int r32, int hh) {
    float mx = s[0][0];
#pragma unroll
    for (int r = 1; r < 16; ++r) mx = fmaxf(mx, s[0][r]);
#pragma unroll
    for (int r = 0; r < 16; ++r) mx = fmaxf(mx, s[1][r]);
    mx = xhalf_max(mx);
    __builtin_amdgcn_sched_barrier(0);
    const float mn = fmaxf(m, mx);
    const float alpha = __builtin_amdgcn_exp2f(m - mn);
    m = mn; l *= alpha;
#pragma unroll
    for (int r = 0; r < 16; ++r) { O[0][r] *= alpha; O[1][r] *= alpha; }
    float ps = 0.f;
#pragma unroll
    for (int kb = 0; kb < 2; ++kb)
#pragma unroll
        for (int r = 0; r < 16; ++r) { const float p = __builtin_amdgcn_exp2f(s[kb][r] - mn); s[kb][r] = p; ps += p; }
    l += ps;
    __builtin_amdgcn_sched_barrier(0);
#pragma unroll
    for (int kb = 0; kb < 2; ++kb)
#pragma unroll
        for (int sk = 0; sk < 2; ++sk) {
            __builtin_amdgcn_sched_barrier(0);
            u32x4 pw; pw.x = pkbf(s[kb][8 * sk + 0], s[kb][8 * sk + 1]); pw.y = pkbf(s[kb][8 * sk + 2], s[kb][8 * sk + 3]);
            pw.z = pkbf(s[kb][8 * sk + 4], s[kb][8 * sk + 5]); pw.w = pkbf(s[kb][8 * sk + 6], s[kb][8 * sk + 7]);
            const bf16x8 pf = __builtin_bit_cast(bf16x8, pw);
#pragma unroll
            for (int dvb = 0; dvb < 2; ++dvb) {
                const LAS unsigned char* a = lds + L_VT + (dvb * 32 + r32) * VP + (kb * 32 + 16 * sk + 4 * hh) * 2;
                const s16x4 lo = *(const LAS s16x4*)a, hi = *(const LAS s16x4*)(a + 16);
                const bf16x8 vf = {lo[0], lo[1], lo[2], lo[3], hi[0], hi[1], hi[2], hi[3]};
                O[dvb] = __builtin_amdgcn_mfma_f32_32x32x16_bf16(vf, pf, O[dvb], 0, 0, 0);
            }
        }
}
__device__ __forceinline__ void store_o(const f32x16 (&o)[2], bf16_t* orow, int hh) {
#pragma unroll
    for (int dvb = 0; dvb < 2; ++dvb)
#pragma unroll
        for (int g = 0; g < 4; ++g) {
            u32x2 w; w.x = pkbf(o[dvb][4 * g], o[dvb][4 * g + 1]); w.y = pkbf(o[dvb][4 * g + 2], o[dvb][4 * g + 3]);
            *(u32x2*)(orow + dvb * 32 + 8 * g + 4 * hh) = w;
        }
}

__device__ __forceinline__ void unit_A_safe(const bool CTXQ, LAS unsigned char* lds, const bf16_t* H, bf16_t* Ob, int b, int h, int qb, float lam, float ofac, const float* subw) {
    const int tid = pg8_ltid(), lane = tid & 63, r32 = lane & 31, hh = lane >> 5, wid = tid >> 6;
    const int qrow = CTXQ ? (ML + b * CTXL + wid * 32 + r32) : (b * SEQ + qb * 256 + wid * 32 + r32);
    const int qcol = h * 64, kcol = 256 + h * 64, vcol = 512 + h * 64;
    bf16x8 qf[4];
#pragma unroll
    for (int ks = 0; ks < 4; ++ks) qf[ks] = *(const bf16x8*)(H + (size_t)qrow * INC + qcol + 16 * ks + 8 * hh);
    const int NT = CTXQ ? 4 : 132;
    f32x16 O1[2], O2[2];
#pragma unroll
    for (int r = 0; r < 16; ++r) { O1[0][r] = 0.f; O1[1][r] = 0.f; O2[0][r] = 0.f; O2[1][r] = 0.f; }
    float m1 = -INFINITY, m2 = -INFINITY, l1 = 0.f, l2 = 0.f;
    TileRegs R;
    tile_gload(R, H, CTXQ ? (ML + b * CTXL) : (b * SEQ), kcol, vcol, tid);
    for (int t = 0; t < NT; ++t) {
        __syncthreads();
        tile_swrite(R, lds, tid);
        __syncthreads();
        if (t + 1 < NT) { const int tn = t + 1; const int krow = CTXQ ? (ML + b * CTXL + 64 * tn) : (tn < 128 ? b * SEQ + 64 * tn : ML + b * CTXL + 64 * (tn - 128)); tile_gload(R, H, krow, kcol, vcol, tid); }
        { f32x16 s[2]; s[0] = qk_block<0, 2>(lds, 0, r32, hh, qf); s[1] = qk_block<0, 2>(lds, 1, r32, hh, qf); softmax_pv(s, m1, l1, O1, lds, r32, hh); }
        __builtin_amdgcn_sched_barrier(0);
        { f32x16 s[2]; s[0] = qk_block<2, 2>(lds, 0, r32, hh, qf); s[1] = qk_block<2, 2>(lds, 1, r32, hh, qf); softmax_pv(s, m2, l2, O2, lds, r32, hh); }
        __builtin_amdgcn_sched_barrier(0);
    }
    l1 = xhalf_sum(l1); l2 = xhalf_sum(l2);
    const float i1 = 1.f / l1, i2 = lam / l2;
    float ss = 0.f;
#pragma unroll
    for (int dvb = 0; dvb < 2; ++dvb)
#pragma unroll
        for (int r = 0; r < 16; ++r) { const float o = O1[dvb][r] * i1 - O2[dvb][r] * i2; O1[dvb][r] = o; ss += o * o; }
    ss = xhalf_sum(ss);
    float li_ = ofac; asm volatile("" : "+s"(li_));
    const float rn = rsqrtf(ss * (1.f / 64.f) + 1e-6f) * (1.f - li_);
#pragma unroll
    for (int dvb = 0; dvb < 2; ++dvb)
#pragma unroll
        for (int g = 0; g < 4; ++g) {
            const f32x4 w = *(const f32x4*)(subw + dvb * 32 + 8 * g + 4 * hh);
#pragma unroll
            for (int e = 0; e < 4; ++e) O1[dvb][4 * g + e] *= rn * w[e];
        }
    store_o(O1, Ob + (size_t)qrow * DM + h * 64, hh);
}


constexpr int A_KP = 144, A_VP = 192, A_VOFF = 64 * A_KP, A_BUF = A_VOFF + 64 * A_VP;
constexpr float ATHR = 10.f;
typedef short v4i16_t __attribute__((ext_vector_type(4)));
__device__ __forceinline__ s16x4 vtr(const LAS unsigned char* p) { return __builtin_bit_cast(s16x4, __builtin_amdgcn_ds_read_tr16_b64_v4i16((LAS v4i16_t*)p)); }
__device__ __forceinline__ void tileA_swrite(const TileRegs& R, LAS unsigned char* buf, int tid) {
    const int key = tid >> 3, ch = tid & 7;
    *(LAS u32x4*)(buf + key * A_KP + ch * 16) = R.k;
    *(LAS u32x4*)(buf + A_VOFF + key * A_VP + ch * 16) = R.v;
}
__device__ __forceinline__ float max16(const f32x16& s) {
    float a = fmaxf(fmaxf(s[0], s[1]), s[2]), b = fmaxf(fmaxf(s[3], s[4]), s[5]), c = fmaxf(fmaxf(s[6], s[7]), s[8]), d = fmaxf(fmaxf(s[9], s[10]), s[11]);
    a = fmaxf(fmaxf(a, s[12]), s[13]); b = fmaxf(fmaxf(b, s[14]), s[15]);
    return fmaxf(fmaxf(a, b), fmaxf(c, d));
}
__device__ __forceinline__ float expsum16(f32x16& s) {
    float a = 0.f, b = 0.f, c = 0.f, d = 0.f;
#pragma unroll
    for (int r = 0; r < 16; r += 4) {
        s[r] = __builtin_amdgcn_exp2f(s[r]); s[r + 1] = __builtin_amdgcn_exp2f(s[r + 1]); s[r + 2] = __builtin_amdgcn_exp2f(s[r + 2]); s[r + 3] = __builtin_amdgcn_exp2f(s[r + 3]);
        a += s[r]; b += s[r + 1]; c += s[r + 2]; d += s[r + 3];
    }
    return (a + b) + (c + d);
}
__device__ __forceinline__ bf16x8 packp(const f32x16& s, int sk) {
    u32x4 pw; pw.x = pkbf(s[8 * sk + 0], s[8 * sk + 1]); pw.y = pkbf(s[8 * sk + 2], s[8 * sk + 3]); pw.z = pkbf(s[8 * sk + 4], s[8 * sk + 5]); pw.w = pkbf(s[8 * sk + 6], s[8 * sk + 7]);
    return __builtin_bit_cast(bf16x8, pw);
}
__device__ __forceinline__ void exp16(f32x16& s) {
#pragma unroll
    for (int r = 0; r < 16; ++r) s[r] = __builtin_amdgcn_exp2f(s[r]);
}
constexpr float AREF = 20.f, AGUARD = 60.f;
#ifndef SGB_V
#define SGB_V 5
#endif
template <bool HAVE>
__device__ __forceinline__ void stepA(bf16x8 (&pc)[2][2], const LAS unsigned char* kbuf, int kb, const LAS unsigned char* vb, const bf16x8 (&qv)[4], int r32, int hh,
                                      float mref1, float mref2, f32x16 (&O1)[2], f32x16 (&O2)[2], f32x16& L1, f32x16& L2, const bf16x8& ones) {
    const LAS unsigned char* kp = kbuf + (kb * 32 + r32) * A_KP + hh * 16;
    const bf16x8 k0 = *(const LAS bf16x8*)(kp), k1 = *(const LAS bf16x8*)(kp + 32), k2 = *(const LAS bf16x8*)(kp + 64), k3 = *(const LAS bf16x8*)(kp + 96);
    const bf16x8 q0 = qv[0], q1 = qv[1], q2 = qv[2], q3 = qv[3];
    bf16x8 vf[2][2];
#pragma unroll
    for (int sk = 0; sk < 2; ++sk)
#pragma unroll
        for (int dvb = 0; dvb < 2; ++dvb) {
            const LAS unsigned char* a = vb + 16 * sk * A_VP + dvb * 64;
            const s16x4 lo = vtr(a), hi = vtr(a + 8 * A_VP);
            vf[sk][dvb] = (bf16x8){lo[0], lo[1], lo[2], lo[3], hi[0], hi[1], hi[2], hi[3]};
        }
    const f32x16 z = {0.f, 0.f, 0.f, 0.f, 0.f, 0.f, 0.f, 0.f, 0.f, 0.f, 0.f, 0.f, 0.f, 0.f, 0.f, 0.f};
    f32x16 s1 = __builtin_amdgcn_mfma_f32_32x32x16_bf16(k0, q0, z, 0, 0, 0);
    f32x16 s2 = __builtin_amdgcn_mfma_f32_32x32x16_bf16(k2, q2, z, 0, 0, 0);
    s1 = __builtin_amdgcn_mfma_f32_32x32x16_bf16(k1, q1, s1, 0, 0, 0);
    s2 = __builtin_amdgcn_mfma_f32_32x32x16_bf16(k3, q3, s2, 0, 0, 0);
#pragma unroll
    for (int sk = 0; sk < 2; ++sk) {
        L1 = __builtin_amdgcn_mfma_f32_32x32x16_bf16(ones, pc[0][sk], L1, 0, 0, 0);
        L2 = __builtin_amdgcn_mfma_f32_32x32x16_bf16(ones, pc[1][sk], L2, 0, 0, 0);
#pragma unroll
        for (int dvb = 0; dvb < 2; ++dvb) {
            O1[dvb] = __builtin_amdgcn_mfma_f32_32x32x16_bf16(vf[sk][dvb], pc[0][sk], O1[dvb], 0, 0, 0);
            O2[dvb] = __builtin_amdgcn_mfma_f32_32x32x16_bf16(vf[sk][dvb], pc[1][sk], O2[dvb], 0, 0, 0);
        }
    }
    if (HAVE) {
#pragma unroll
        for (int r = 0; r < 16; ++r) { s1[r] -= mref1; s2[r] -= mref2; }
    }
    exp16(s1); exp16(s2);
    bf16x8 pn[2][2];
    pn[0][0] = packp(s1, 0); pn[0][1] = packp(s1, 1); pn[1][0] = packp(s2, 0); pn[1][1] = packp(s2, 1);
#if 0
    __builtin_amdgcn_sched_group_barrier(0x008, 6, 0);
#pragma unroll
    for (int i = 0; i < 10; ++i) { __builtin_amdgcn_sched_group_barrier(0x002, SGB_V, 0); __builtin_amdgcn_sched_group_barrier(0x008, 1, 0); }
    __builtin_amdgcn_sched_group_barrier(0x002, 48, 0);
#endif
    pc[0][0] = pn[0][0]; pc[0][1] = pn[0][1]; pc[1][0] = pn[1][0]; pc[1][1] = pn[1][1];
}
__device__ __forceinline__ void unit_A(const bool CTXQ, LAS unsigned char* lds, const bf16_t* H, bf16_t* Ob, int b, int h, int qb, float lam, float ofac, const float* subw) {
    const int tid = pg8_ltid(), lane = tid & 63, r32 = lane & 31, hh = lane >> 5, wid = tid >> 6;
    const int qrow = CTXQ ? (ML + b * CTXL + wid * 32 + r32) : (b * SEQ + qb * 256 + wid * 32 + r32);
    const int qcol = h * 64, kcol = 256 + h * 64, vcol = 512 + h * 64;
    const int NT = CTXQ ? 4 : 132;
    f32x16 O1[2], O2[2], L1, L2;
#pragma unroll
    for (int r = 0; r < 16; ++r) { O1[0][r] = 0.f; O1[1][r] = 0.f; O2[0][r] = 0.f; O2[1][r] = 0.f; L1[r] = 0.f; L2[r] = 0.f; }
    const bf16x8 ones = {0x3F80, 0x3F80, 0x3F80, 0x3F80, 0x3F80, 0x3F80, 0x3F80, 0x3F80};
    const int voff = A_VOFF + (4 * hh + ((lane & 15) >> 2)) * A_VP + (((lane >> 4) & 1) * 16 + (lane & 3) * 4) * 2;
    const int krow0 = CTXQ ? (ML + b * CTXL) : (b * SEQ);
    LAS unsigned char* qs = lds + 3 * A_BUF + (wid * 32 + r32) * A_KP + hh * 16;
    volatile LAS unsigned* flag = (volatile LAS unsigned*)(lds + RING_BYTES + 128);
    TileRegs R;
    __syncthreads();
    if (tid == 0) *flag = 0u;
#pragma unroll
    for (int ks = 0; ks < 4; ++ks) *(LAS bf16x8*)(qs + ks * 32) = *(const bf16x8*)(H + (size_t)qrow * INC + qcol + 16 * ks + 8 * hh);
    tile_gload(R, H, krow0, kcol, vcol, tid);       tileA_swrite(R, lds, tid);
    tile_gload(R, H, krow0 + 64, kcol, vcol, tid);  tileA_swrite(R, lds + A_BUF, tid);
    tile_gload(R, H, krow0 + 128, kcol, vcol, tid);
    __syncthreads();
    bf16x8 pc[2][2];
    {
        const LAS unsigned char* kp = lds + r32 * A_KP + hh * 16;
        const f32x16 z = {0.f, 0.f, 0.f, 0.f, 0.f, 0.f, 0.f, 0.f, 0.f, 0.f, 0.f, 0.f, 0.f, 0.f, 0.f, 0.f};
        f32x16 sa1 = __builtin_amdgcn_mfma_f32_32x32x16_bf16(*(const LAS bf16x8*)(kp), *(const LAS bf16x8*)(qs), z, 0, 0, 0);
        sa1 = __builtin_amdgcn_mfma_f32_32x32x16_bf16(*(const LAS bf16x8*)(kp + 32), *(const LAS bf16x8*)(qs + 32), sa1, 0, 0, 0);
        f32x16 sa2 = __builtin_amdgcn_mfma_f32_32x32x16_bf16(*(const LAS bf16x8*)(kp + 64), *(const LAS bf16x8*)(qs + 64), z, 0, 0, 0);
        sa2 = __builtin_amdgcn_mfma_f32_32x32x16_bf16(*(const LAS bf16x8*)(kp + 96), *(const LAS bf16x8*)(qs + 96), sa2, 0, 0, 0);
        const float mx1 = xhalf_max(max16(sa1)), mx2 = xhalf_max(max16(sa2));
        if (__any((fabsf(mx1) > AREF) || (fabsf(mx2) > AREF)) != 0) *flag = 1u;
        exp16(sa1); exp16(sa2);
        pc[0][0] = packp(sa1, 0); pc[0][1] = packp(sa1, 1); pc[1][0] = packp(sa2, 0); pc[1][1] = packp(sa2, 1);
    }
    bf16x8 qv[4];
#pragma unroll
    for (int ks = 0; ks < 4; ++ks) qv[ks] = *(const LAS bf16x8*)(qs + ks * 32);
    int bc = 0, t = 0;
#define UNITA_STAGE() \
        const int bn = (bc == 2 * A_BUF) ? 0 : bc + A_BUF, bw = (bn == 2 * A_BUF) ? 0 : bn + A_BUF; \
        if (t + 2 < NT) { \
            tileA_swrite(R, lds + bw, tid); \
            if (t + 3 < NT) { const int tn = t + 3; const int krow = CTXQ ? (krow0 + 64 * tn) : (tn < 128 ? b * SEQ + 64 * tn : ML + b * CTXL + 64 * (tn - 128)); tile_gload(R, H, krow, kcol, vcol, tid); } \
        }
#define UNITA_GUARD() (__any((L1[0] > 1.152921504606846976e18f) || (L2[0] > 1.152921504606846976e18f)) != 0)
    unsigned fl = 0u;
    {
        for (; t < NT; ++t) {
            if (__builtin_expect(fl != 0u, 0)) break;
            fl = *flag;
            if (__builtin_expect(UNITA_GUARD(), 0)) *flag = 1u;
            UNITA_STAGE()
            stepA<false>(pc, lds + bc, 1, lds + bc + voff, qv, r32, hh, 0.f, 0.f, O1, O2, L1, L2, ones);
            stepA<false>(pc, lds + bn, 0, lds + bc + voff + 32 * A_VP, qv, r32, hh, 0.f, 0.f, O1, O2, L1, L2, ones);
            __syncthreads();
            bc = bn;
        }
    }
#undef UNITA_STAGE
#undef UNITA_GUARD
    if (*flag != 0u) { unit_A_safe(CTXQ, lds, H, Ob, b, h, qb, lam, ofac, subw); return; }
    const float i1 = 1.f / L1[0], i2 = lam / L2[0];
    float ss = 0.f;
#pragma unroll
    for (int dvb = 0; dvb < 2; ++dvb)
#pragma unroll
        for (int r = 0; r < 16; ++r) { const float o = O1[dvb][r] * i1 - O2[dvb][r] * i2; O1[dvb][r] = o; ss += o * o; }
    ss = xhalf_sum(ss);
    float li_ = ofac; asm volatile("" : "+s"(li_));
    const float rn = rsqrtf(ss * (1.f / 64.f) + 1e-6f) * (1.f - li_);
#pragma unroll
    for (int dvb = 0; dvb < 2; ++dvb)
#pragma unroll
        for (int g = 0; g < 4; ++g) {
            const f32x4 w = *(const f32x4*)(subw + dvb * 32 + 8 * g + 4 * hh);
#pragma unroll
            for (int e = 0; e < 4; ++e) O1[dvb][4 * g + e] *= rn * w[e];
        }
    store_o(O1, Ob + (size_t)qrow * DM + h * 64, hh);
}

template <int MODE> __device__ __forceinline__ int tile_row_f(int t, int b, int lo, int nloc) {
    if (MODE == 1) return (t < nloc) ? (b * SEQ + 64 * (lo + t)) : (ML + b * CTXL + 64 * (t - nloc));
    if (MODE == 2) return (t < 4) ? (ML + b * CTXL + 64 * t) : (b * SEQ + 64 * (lo + t - 4));
    return ML + b * CTXL + 64 * t;
}
__device__ __forceinline__ int tile_row_r(int MODE, int t, int b, int lo, int nloc) {
    if (MODE == 1) return (t < nloc) ? (b * SEQ + 64 * (lo + t)) : (ML + b * CTXL + 64 * (t - nloc));
    if (MODE == 2) return (t < 4) ? (ML + b * CTXL + 64 * t) : (b * SEQ + 64 * (lo + t - 4));
    return ML + b * CTXL + 64 * t;
}
__device__ __forceinline__ void unit_BC(const int MODE, LAS unsigned char* lds, const bf16_t* H, bf16_t* Ob, int b, int hd, int blk, const float* sink_l, const float* rpb_l) {
    const int tid = pg8_ltid(), lane = tid & 63, r32 = lane & 31, hh = lane >> 5, wid = tid >> 6;
    int qrow, qcol, kcol, vcol, ocol, qpos = 0, r_w = 0, qc = 0, lo = 0, nloc = 0;
    float m = -INFINITY, l = 0.f;
    if (MODE == 1) {
        const int g = wid >> 2, head = hd * 2 + g; qpos = 128 * blk + 32 * (wid & 3) + r32; qrow = b * SEQ + qpos;
        qcol = 768 + head * 64; kcol = 1024 + hd * 64; vcol = 1152 + hd * 64; ocol = 256 + head * 64;
        lo = 2 * blk - 2; if (lo < 0) lo = 0; int hi = 2 * blk + 3; if (hi > 127) hi = 127; nloc = hi - lo + 1;
        m = sink_l[head] * LOG2E; l = (hh == 0) ? 1.f : 0.f;
    } else if (MODE == 3) {
        const int head = hd * 2 + blk; qrow = ML + b * CTXL + wid * 32 + r32;
        qcol = 768 + head * 64; kcol = 1024 + hd * 64; vcol = 1152 + hd * 64; ocol = 256 + head * 64;
        m = sink_l[head] * LOG2E; l = (hh == 0) ? 1.f : 0.f;
    } else if (MODE == 2) {
        r_w = 4 * blk + (wid >> 1); qc = 32 * (wid & 1) + r32; qrow = b * SEQ + r_w * 64 + qc;
        qcol = 1280 + hd * 64; kcol = 1536 + hd * 64; vcol = 1792 + hd * 64; ocol = 512 + hd * 64;
        int a0 = 4 * blk - 4; if (a0 < 0) a0 = 0; if (a0 > 120) a0 = 120; int a3 = 4 * blk + 3 - 4; if (a3 < 0) a3 = 0; if (a3 > 120) a3 = 120;
        lo = a0; nloc = a3 + 7 - a0 + 1;
    } else {
        qrow = ML + b * CTXL + wid * 32 + r32;
        qcol = 1280 + hd * 64; kcol = 1536 + hd * 64; vcol = 1792 + hd * 64; ocol = 512 + hd * 64;
    }
    bf16x8 qf[4];
#pragma unroll
    for (int ks = 0; ks < 4; ++ks) qf[ks] = *(const bf16x8*)(H + (size_t)qrow * INC + qcol + 16 * ks + 8 * hh);
    f32x16 O[2];
#pragma unroll
    for (int r = 0; r < 16; ++r) { O[0][r] = 0.f; O[1][r] = 0.f; }
    const int NT = 4 + nloc;
    int rs = 0;
    if (MODE == 2) { rs = r_w - 4; if (rs < 0) rs = 0; if (rs > 120) rs = 120; }
    const LAS float* rpbs = (const LAS float*)(lds + L_RPB);
    TileRegs R;
    tile_gload(R, H, tile_row_r(MODE, 0, b, lo, nloc), kcol, vcol, tid);
    for (int t = 0; t < NT; ++t) {
        __syncthreads();
        tile_swrite(R, lds, tid);
        if (MODE == 2 && t == 0) { for (int i = tid; i < 465; i += 512) ((LAS float*)(lds + L_RPB))[i] = rpb_l[hd * 465 + i] * LOG2E; }
        __syncthreads();
        if (t + 1 < NT) tile_gload(R, H, tile_row_r(MODE, t + 1, b, lo, nloc), kcol, vcol, tid);
        bool active = true; int kr = 0;
        if (MODE == 2 && t >= 4) { kr = lo + t - 4; active = (kr >= rs) && (kr < rs + 8); }
        if (active) {
            f32x16 s[2]; s[0] = qk_block<0, 4>(lds, 0, r32, hh, qf); s[1] = qk_block<0, 4>(lds, 1, r32, hh, qf);
            if (MODE == 1 && t < nloc) {
                const int kbase = 64 * (lo + t) - qpos;
#pragma unroll
                for (int kb = 0; kb < 2; ++kb)
#pragma unroll
                    for (int r = 0; r < 16; ++r) { const int d = kbase + kb * 32 + crow(r, hh); if (d > 128 || d < -128) s[kb][r] = -INFINITY; }
            }
            if (MODE == 2 && t >= 4) {
                int cs = qc - 8; if (cs < 0) cs = 0; if (cs > 48) cs = 48;
                const int bbase = (kr - r_w + 7) * 31 + 15 - qc;
#pragma unroll
                for (int kb = 0; kb < 2; ++kb)
#pragma unroll
                    for (int r = 0; r < 16; ++r) {
                        const int kc = kb * 32 + crow(r, hh);
                        const bool ok = (kc >= cs) && (kc < cs + 16);
                        int bi = bbase + kc; bi = ok ? bi : 0;
                        const float bias = rpbs[bi];
                        s[kb][r] = ok ? (s[kb][r] + bias) : -INFINITY;
                    }
            }
            softmax_pv(s, m, l, O, lds, r32, hh);
        }
    }
    l = xhalf_sum(l);
    const float il = 1.f / l;
#pragma unroll
    for (int r = 0; r < 16; ++r) { O[0][r] *= il; O[1][r] *= il; }
    store_o(O, Ob + (size_t)qrow * DM + ocol, hh);
}

template <int MODE>
__device__ __forceinline__ void bcf_compute(const LAS unsigned char* cur, int t, int nloc, int lo, int qpos, int kr, int r_w, int qc, const bf16x8 (&qf)[4], f32x16 (&O)[2], f32x16& L,
                                            const bf16x8& ones, const LAS float* rpbs, int voff, int r32, int hh) {
    f32x16 s[2];
    const f32x16 z = {0.f, 0.f, 0.f, 0.f, 0.f, 0.f, 0.f, 0.f, 0.f, 0.f, 0.f, 0.f, 0.f, 0.f, 0.f, 0.f};
#pragma unroll
    for (int kb = 0; kb < 2; ++kb) {
        const LAS unsigned char* kp = cur + (kb * 32 + r32) * A_KP + hh * 16;
        s[kb] = __builtin_amdgcn_mfma_f32_32x32x16_bf16(*(const LAS bf16x8*)(kp), qf[0], z, 0, 0, 0);
        s[kb] = __builtin_amdgcn_mfma_f32_32x32x16_bf16(*(const LAS bf16x8*)(kp + 32), qf[1], s[kb], 0, 0, 0);
        s[kb] = __builtin_amdgcn_mfma_f32_32x32x16_bf16(*(const LAS bf16x8*)(kp + 64), qf[2], s[kb], 0, 0, 0);
        s[kb] = __builtin_amdgcn_mfma_f32_32x32x16_bf16(*(const LAS bf16x8*)(kp + 96), qf[3], s[kb], 0, 0, 0);
    }
    if (MODE == 1 && t < nloc) {
        const int kbase = 64 * (lo + t) - qpos;
#pragma unroll
        for (int kb = 0; kb < 2; ++kb)
#pragma unroll
            for (int r = 0; r < 16; ++r) { const int d = kbase + kb * 32 + crow(r, hh); if (d > 128 || d < -128) s[kb][r] = -INFINITY; }
    }
    if (MODE == 2 && t >= 4) {
        int cs = qc - 8; if (cs < 0) cs = 0; if (cs > 48) cs = 48;
        const int bbase = (kr - r_w + 7) * 31 + 15 - qc;
#pragma unroll
        for (int kb = 0; kb < 2; ++kb)
#pragma unroll
            for (int r = 0; r < 16; ++r) {
                const int kc = kb * 32 + crow(r, hh);
                const bool ok = (kc >= cs) && (kc < cs + 16);
                int bi = bbase + kc; bi = ok ? bi : 0;
                const float bias = rpbs[bi];
                s[kb][r] = ok ? (s[kb][r] + bias) : -INFINITY;
            }
    }
#pragma unroll
    for (int kb = 0; kb < 2; ++kb) {
        exp16(s[kb]);
#pragma unroll
        for (int sk = 0; sk < 2; ++sk) {
            const bf16x8 p = packp(s[kb], sk);
            L = __builtin_amdgcn_mfma_f32_32x32x16_bf16(ones, p, L, 0, 0, 0);
#pragma unroll
            for (int dvb = 0; dvb < 2; ++dvb) {
                const LAS unsigned char* a = cur + voff + (kb * 32 + 16 * sk) * A_VP + dvb * 64;
                const s16x4 vlo = vtr(a), vhi = vtr(a + 8 * A_VP);
                const bf16x8 vf = {vlo[0], vlo[1], vlo[2], vlo[3], vhi[0], vhi[1], vhi[2], vhi[3]};
                O[dvb] = __builtin_amdgcn_mfma_f32_32x32x16_bf16(vf, p, O[dvb], 0, 0, 0);
            }
        }
    }
}
template <int MODE>
__device__ __forceinline__ bool unit_BC_fast(LAS unsigned char* lds, const bf16_t* H, bf16_t* Ob, int b, int hd, int blk, const float* sink_l, const float* rpb_l) {
    const int tid = pg8_ltid(), lane = tid & 63, r32 = lane & 31, hh = lane >> 5, wid = tid >> 6;
    int qrow, qcol, kcol, vcol, ocol, qpos = 0, r_w = 0, qc = 0, lo = 0, nloc = 0;
    float linit = 0.f;
    if (MODE == 1) {
        const int g = wid >> 2, head = hd * 2 + g; qpos = 128 * blk + 32 * (wid & 3) + r32; qrow = b * SEQ + qpos;
        qcol = 768 + head * 64; kcol = 1024 + hd * 64; vcol = 1152 + hd * 64; ocol = 256 + head * 64;
        lo = 2 * blk - 2; if (lo < 0) lo = 0; int hi = 2 * blk + 3; if (hi > 127) hi = 127; nloc = hi - lo + 1;
        linit = __builtin_amdgcn_exp2f(sink_l[head] * LOG2E);
    } else if (MODE == 3) {
        const int head = hd * 2 + blk; qrow = ML + b * CTXL + wid * 32 + r32;
        qcol = 768 + head * 64; kcol = 1024 + hd * 64; vcol = 1152 + hd * 64; ocol = 256 + head * 64;
        linit = __builtin_amdgcn_exp2f(sink_l[head] * LOG2E);
    } else if (MODE == 2) {
        r_w = 4 * blk + (wid >> 1); qc = 32 * (wid & 1) + r32; qrow = b * SEQ + r_w * 64 + qc;
        qcol = 1280 + hd * 64; kcol = 1536 + hd * 64; vcol = 1792 + hd * 64; ocol = 512 + hd * 64;
        int a0 = 4 * blk - 4; if (a0 < 0) a0 = 0; if (a0 > 120) a0 = 120; int a3 = 4 * blk + 3 - 4; if (a3 < 0) a3 = 0; if (a3 > 120) a3 = 120;
        lo = a0; nloc = a3 + 7 - a0 + 1;
    } else {
        qrow = ML + b * CTXL + wid * 32 + r32;
        qcol = 1280 + hd * 64; kcol = 1536 + hd * 64; vcol = 1792 + hd * 64; ocol = 512 + hd * 64;
    }
    bf16x8 qf[4];
#pragma unroll
    for (int ks = 0; ks < 4; ++ks) qf[ks] = *(const bf16x8*)(H + (size_t)qrow * INC + qcol + 16 * ks + 8 * hh);
    f32x16 O[2], L;
#pragma unroll
    for (int r = 0; r < 16; ++r) { O[0][r] = 0.f; O[1][r] = 0.f; L[r] = linit; }
    const bf16x8 ones = {0x3F80, 0x3F80, 0x3F80, 0x3F80, 0x3F80, 0x3F80, 0x3F80, 0x3F80};
    const int NT = 4 + nloc;
    int rs = 0;
    if (MODE == 2) { rs = r_w - 4; if (rs < 0) rs = 0; if (rs > 120) rs = 120; }
    const int voff = A_VOFF + (4 * hh + ((lane & 15) >> 2)) * A_VP + (((lane >> 4) & 1) * 16 + (lane & 3) * 4) * 2;
    LAS float* rpbs = (LAS float*)(lds + 2 * A_BUF);
    volatile LAS unsigned* flag = (volatile LAS unsigned*)(lds + RING_BYTES + 128);
    TileRegs Ra, Rb;
    __syncthreads();
    if (tid == 0) *flag = 0u;
    if (MODE == 2) { for (int i = tid; i < 465; i += 512) rpbs[i] = rpb_l[hd * 465 + i] * LOG2E; }
    tile_gload(Ra, H, tile_row_f<MODE>(0, b, lo, nloc), kcol, vcol, tid);
    tileA_swrite(Ra, lds, tid);
    tile_gload(Rb, H, tile_row_f<MODE>(1, b, lo, nloc), kcol, vcol, tid);
    tile_gload(Ra, H, tile_row_f<MODE>(2, b, lo, nloc), kcol, vcol, tid);
    __syncthreads();
#define BCF_TILE(T, RS) { \
        const int t = (T); \
        const LAS unsigned char* cur = lds + (t & 1) * A_BUF; \
        if (t + 1 < NT) { \
            tileA_swrite(RS, lds + ((t + 1) & 1) * A_BUF, tid); \
            if (t + 3 < NT) tile_gload(RS, H, tile_row_f<MODE>(t + 3, b, lo, nloc), kcol, vcol, tid); \
        } \
        bool active = true; int kr = 0; \
        if (MODE == 2 && t >= 4) { kr = lo + t - 4; active = (kr >= rs) && (kr < rs + 8); } \
        if (active) bcf_compute<MODE>(cur, t, nloc, lo, qpos, kr, r_w, qc, qf, O, L, ones, rpbs, voff, r32, hh); \
        __syncthreads(); }
    for (int t2 = 0; t2 < NT; t2 += 2) {
        BCF_TILE(t2, Rb)
        if (t2 + 1 < NT) BCF_TILE(t2 + 1, Ra)
    }
#undef BCF_TILE
    const float lsum = L[0];
    if (__any(!((lsum > 1e-30f) && (lsum < 1e30f))) != 0) *flag = 1u;
    __syncthreads();
    if (*flag != 0u) return true;
    const float il = 1.f / lsum;
#pragma unroll
    for (int r = 0; r < 16; ++r) { O[0][r] *= il; O[1][r] *= il; }
    store_o(O, Ob + (size_t)qrow * DM + ocol, hh);
    return false;
}
}
__device__ __forceinline__ float silu_f(float v) { return v / (1.f + __expf(-v)); }

__device__ __forceinline__ int wrow_map(int type, int n) {
    if (type == 1) {
        const bool ropeA = n < 512, ropeB = (n >= 768 && n < 1152);
        if (!ropeA && !ropeB) return n;
        int p = n & 31;
        if (ropeA) { const int blk = p >> 3; p = (blk == 1) ? p + 8 : ((blk == 2) ? p - 8 : p); }
        const int nn = p >> 4, r = p & 15;
        return (n & ~31) + 8 * (r >> 2) + 4 * nn + (r & 3);
    }
    if (type == 2) { const int half = (n >= 2816) ? 1 : 0; const int j = n - half * 2816; return (j >> 7) * 256 + half * 128 + (j & 127); }
    return n;
}
__device__ __forceinline__ void transpose_item(const float* W, int K, int N, bf16_t* WT, int type, LAS float* scr, int item, int lane) {
    const int nblk = N / 64, kb = item / nblk, nb = item - kb * nblk, k0 = 64 * kb, n0 = 64 * nb;
    const int lr = lane >> 4, lc = (lane & 15) * 4;
#pragma unroll 8
    for (int i = 0; i < 16; ++i) {
        const int kk = 4 * i + lr;
        const f32x4 v = *(const f32x4*)(W + (size_t)(k0 + kk) * N + n0 + lc);
        LAS float* d = scr + kk * 65 + lc; d[0] = v[0]; d[1] = v[1]; d[2] = v[2]; d[3] = v[3];
    }
    asm volatile("s_waitcnt lgkmcnt(0)" ::: "memory");
    const int c = lane & 7;
#pragma unroll
    for (int j = 0; j < 8; ++j) {
        const int n = (lane >> 3) + 8 * j; const LAS float* s = scr + (8 * c) * 65 + n;
        u32x4 o; o.x = pkbf(s[0 * 65], s[1 * 65]); o.y = pkbf(s[2 * 65], s[3 * 65]); o.z = pkbf(s[4 * 65], s[5 * 65]); o.w = pkbf(s[6 * 65], s[7 * 65]);
        *(u32x4*)(WT + (size_t)wrow_map(type, n0 + n) * K + k0 + 8 * c) = o;
    }
    asm volatile("s_waitcnt lgkmcnt(0)" ::: "memory");
}

__device__ __forceinline__ void sincos_f(float x, float& c, float& s) {
    const float k = rintf(x * 0.636619772f);
    float r = fmaf(-k, 1.57079625129699707031f, x); r = fmaf(-k, 7.54978941586159635335e-08f, r);
    const float r2 = r * r;
    const float sr = r * (1.f + r2 * (-1.f / 6 + r2 * (1.f / 120 + r2 * (-1.f / 5040 + r2 * (1.f / 362880)))));
    const float cr = 1.f + r2 * (-0.5f + r2 * (1.f / 24 + r2 * (-1.f / 720 + r2 * (1.f / 40320 + r2 * (-1.f / 3628800)))));
    const int q = ((int)k) & 3;
    s = (q == 0) ? sr : (q == 1) ? cr : (q == 2) ? -sr : -cr;
    c = (q == 0) ? cr : (q == 1) ? -sr : (q == 2) ? -cr : sr;
}

__device__ __forceinline__ void norm_mod_row(const float* src, const float* nw, const float* sh, const float* sc, bf16_t* dst, int lane, const float* slab = nullptr, int nslab = 0, float* xout = nullptr) {
    u32x2* o8 = (u32x2*)dst + lane;
    if (src == nullptr) {
#pragma unroll
        for (int j = 0; j < 4; ++j) o8[64 * j] = (u32x2){0u, 0u};
        return;
    }
    const f32x4* xr = (const f32x4*)src + lane;
    f32x4 v[4]; float s = 0.f;
#pragma unroll
    for (int j = 0; j < 4; ++j) v[j] = xr[64 * j];
    for (int p = 0; p < nslab; ++p) {
        const f32x4* sr = (const f32x4*)(slab + (size_t)p * 1024 * 1024) + lane;
#pragma unroll
        for (int j = 0; j < 4; ++j) v[j] += sr[64 * j];
    }
    if (xout != nullptr) {
#pragma unroll
        for (int j = 0; j < 4; ++j) ((f32x4*)xout + lane)[64 * j] = v[j];
    }
#pragma unroll
    for (int j = 0; j < 4; ++j) s += (v[j][0] * v[j][0] + v[j][1] * v[j][1]) + (v[j][2] * v[j][2] + v[j][3] * v[j][3]);
    const float rstd = rsqrtf(wave_sum(s, lane) * (1.f / 1024.f) + 1e-6f);
#pragma unroll
    for (int j = 0; j < 4; ++j) {
        const int k = 4 * (64 * j + lane);
        const f32x4 w = *(const f32x4*)(nw + k), a = *(const f32x4*)(sc + k), d = *(const f32x4*)(sh + k);
        f32x4 y;
#pragma unroll
        for (int e = 0; e < 4; ++e) y[e] = (v[j][e] * rstd * w[e]) * (1.f + a[e]) + d[e];
        u32x2 p; p.x = pkbf(y[0], y[1]); p.y = pkbf(y[2], y[3]);
        o8[64 * j] = p;
    }
}

#define XB_TMO      128
#define XB_XCNT(j)  (256  + 64 * (j))
#define XB_XSUB(j)  (1280 + 64 * (j))
#define XB_XGEN(j)  (2304 + 64 * (j))
#define XB_TOP      3328
#define XB_TOPGEN   3392
#define XCD_BAR_WORDS 3456
#define XB_SPIN_CAP (1u << 18)

__device__ __forceinline__ unsigned xb_ld(unsigned* p)              { return __hip_atomic_load(p, __ATOMIC_RELAXED, __HIP_MEMORY_SCOPE_AGENT); }
__device__ __forceinline__ unsigned xb_add(unsigned* p, unsigned v) { return __hip_atomic_fetch_add(p, v, __ATOMIC_RELAXED, __HIP_MEMORY_SCOPE_AGENT); }
__device__ __forceinline__ unsigned xb_xcc_id() { return (unsigned)__builtin_amdgcn_s_getreg((3 << 11) | 20) & 0xFu; }
#define XB_SPIN(cond, bar) do { unsigned _sp = 0; while (cond) { __builtin_amdgcn_s_sleep(1); \
    if ((++_sp & 255u) == 0u) { if (xb_ld(&(bar)[XB_TMO])) break; if (_sp > XB_SPIN_CAP) { atomicAdd(&(bar)[XB_TMO], 1u); break; } } } } while (0)

struct XcdBarrier {
    unsigned* bar; unsigned x;
    volatile LAS unsigned* st;
};

__device__ __forceinline__ XcdBarrier xcd_barrier_post(unsigned* bar, volatile LAS unsigned* st) {
    XcdBarrier b; b.bar = bar; b.x = xb_xcc_id(); b.st = st;
    if (threadIdx.x == 0) (void)xb_add(&bar[XB_XCNT(b.x)], 1u);
    return b;
}
__device__ __forceinline__ void xcd_barrier_complete(unsigned* bar, unsigned x, unsigned& nloc, unsigned& nx) {
    const unsigned G = gridDim.x * gridDim.y * gridDim.z;
    unsigned sum, cnt, mine, sp = 0u;
    for (;;) {
        sum = 0u; cnt = 0u; mine = 0u;
#pragma unroll
        for (unsigned j = 0; j < 16; ++j) { const unsigned c = xb_ld(&bar[XB_XCNT(j)]); sum += c; cnt += (c > 0u) ? 1u : 0u; mine = (j == x) ? c : mine; }
        if (sum == G) break;
        __builtin_amdgcn_s_sleep(1);
        if ((++sp & 255u) == 0u) { if (xb_ld(&bar[XB_TMO])) break; if (sp > XB_SPIN_CAP) { atomicAdd(&bar[XB_TMO], 1u); break; } }
    }
    nloc = mine > 0u ? mine : 1u; nx = cnt > 0u ? cnt : 1u;
}

__device__ __forceinline__ void xcd_barrier(const XcdBarrier& b) {
    asm volatile("s_waitcnt vmcnt(0)" ::: "memory");
    __syncthreads();
    if (threadIdx.x == 0) {
        unsigned* bar = b.bar;
        __builtin_amdgcn_s_waitcnt(0);
        unsigned nloc = b.st[0], nx = b.st[1];
        if (nloc == 0u) { xcd_barrier_complete(bar, b.x, nloc, nx); b.st[0] = nloc; b.st[1] = nx; }
        const unsigned old = xb_add(&bar[XB_XSUB(b.x)], 1u);
        const unsigned gen = old / nloc;
        if (old + 1u == (gen + 1u) * nloc) {
            __builtin_amdgcn_fence(__ATOMIC_RELEASE, "agent");
            asm volatile("s_waitcnt vmcnt(0)" ::: "memory");
            const unsigned og = xb_add(&bar[XB_TOP], 1u);
            const unsigned tg = og / nx;
            if (og + 1u == (tg + 1u) * nx) xb_add(&bar[XB_TOPGEN], 1u);
            else XB_SPIN(xb_ld(&bar[XB_TOPGEN]) == tg, bar);
            __builtin_amdgcn_fence(__ATOMIC_ACQUIRE, "agent");
            xb_add(&bar[XB_XGEN(b.x)], 1u);
            asm volatile("s_waitcnt vmcnt(0)" ::: "memory");
        } else {
            XB_SPIN(xb_ld(&bar[XB_XGEN(b.x)]) == gen, bar);
            __builtin_amdgcn_fence(__ATOMIC_ACQUIRE, "agent");
            asm volatile("s_waitcnt vmcnt(0)" ::: "memory");
        }
    }
    __syncthreads();
}

struct Args { const float* in[23]; float* out; unsigned char* ws; int ph_lo, ph_hi, coop, pad; };
typedef const __attribute__((address_space(4))) Args* KArgs;
__device__ __forceinline__ KArgs kargs() { KArgs p = (KArgs)__builtin_amdgcn_kernarg_segment_ptr(); asm volatile("" : "+s"(p)); return p; }
constexpr int N_PHASES = 2 + 7 * DEPTH + 1;

__global__ void __launch_bounds__(512, 2) fwd_kernel(Args a) {
    extern __shared__ __attribute__((aligned(16))) unsigned char lds_raw[];
    LAS unsigned char* lds = (LAS unsigned char*)lds_raw;
    volatile LAS unsigned* bar_st = (volatile LAS unsigned*)(lds + RING_BYTES + 64);
    if (threadIdx.x < 2) bar_st[threadIdx.x] = 0u;
    __syncthreads();
    if (kargs()->coop) (void)xcd_barrier_post((unsigned*)kargs()->ws, bar_st);
    const int ph_lo = kargs()->ph_lo, ph_hi = kargs()->ph_hi;
    for (int ph = ph_lo; ph < ph_hi; ++ph) {
        KArgs ka = kargs();
        const int tid = pg8_ltid(), lane = tid & 63, wave = __builtin_amdgcn_readfirstlane(tid >> 6);
        int G = gridDim.x, bx = blockIdx.x; asm volatile("" : "+s"(G), "+s"(bx));
        const int vcu = (G % 8 == 0) ? (bx % 8) * (G / 8) + bx / 8 : bx;
        const int gw = vcu * 8 + wave, NGW = G * 8;
        unsigned char* ws = ka->ws;
        float* MOD = (float*)(ws + WS_MOD); float* MODP = (float*)(ws + WS_MODP);
        float* tabA = (float*)(ws + WS_TAB); float* tabB = tabA + 128 * 8 * 2;
        float* XCA = (float*)(ws + WS_XC); float* XCB = (float*)(ws + WS_MODP);
        bf16_t* XN = (bf16_t*)(ws + WS_XN); bf16_t* Ob = (bf16_t*)(ws + WS_O); bf16_t* Hb = (bf16_t*)(ws + WS_H); bf16_t* ACT = Hb;
        float* XL = ka->out;
        if (ph == 0) {
          {
            const float* w_mod = ka->in[6]; const float* c_in = ka->in[1]; const float* cctx_in = ka->in[3];
            for (int it = gw; it < 1536; it += NGW) {
                const int ks = it & 15, cgp = (it >> 4) % 24, l = it / 384;
                const int n0 = cgp * 256 + lane * 4;
                f32x4 acc[5];
#pragma unroll
                for (int s = 0; s < 5; ++s) acc[s] = (f32x4){0.f, 0.f, 0.f, 0.f};
                const float* wp = w_mod + ((size_t)l * 1024 + ks * 64) * 6144 + n0;
                for (int kk = 0; kk < 64; ++kk) {
                    const int k = ks * 64 + kk;
                    const f32x4 w = *(const f32x4*)(wp + (size_t)kk * 6144);
#pragma unroll
                    for (int s = 0; s < 4; ++s) acc[s] += silu_f(c_in[s * 1024 + k]) * w;
                    acc[4] += silu_f(cctx_in[k]) * w;
                }
#pragma unroll
                for (int s = 0; s < 5; ++s) *(f32x4*)(MODP + ((size_t)(ks * 4 + l) * 5 + s) * 6144 + n0) = acc[s];
            }
            LAS float* scr = (LAS float*)(lds + wave * 16768);
            for (int it = gw; it < 4 * 3072; it += NGW) {
                const int l = it / 3072; int r = it - l * 3072;
                unsigned char* wl = ws + WS_W + (size_t)l * W_LAYER;
                if (r < 704) { transpose_item(ka->in[8] + (size_t)l * 1024 * 2816, 1024, 2816, (bf16_t*)wl, 1, scr, r, lane); continue; } r -= 704;
                if (r < 256) { transpose_item(ka->in[9] + (size_t)l * 1024 * 1024, 1024, 1024, (bf16_t*)(wl + W_OUT_OFF), 0, scr, r, lane); continue; } r -= 256;
                if (r < 1408) { transpose_item(ka->in[18] + (size_t)l * 1024 * 5632, 1024, 5632, (bf16_t*)(wl + W_UP_OFF), 2, scr, r, lane); continue; } r -= 1408;
                transpose_item(ka->in[21] + (size_t)l * 2816 * 1024, 2816, 1024, (bf16_t*)(wl + W_DN_OFF), 0, scr, r, lane);
            }
            for (int idx = vcu * 512 + tid; idx < 3072; idx += G * 512) {
                int pos, i; float e;
                if (idx < 1024) { pos = idx >> 3; i = idx & 7; e = (float)i * 0.125f; } else { const int j = idx - 1024; pos = j >> 4; i = j & 15; e = (float)i * 0.0625f; }
                const float freq = exp2f(-e * 13.287712379549449f);
                const float ang = (float)pos * freq;
                float cc, ss; sincos_f(ang, cc, ss);
                float* tp = (idx < 1024) ? (tabA + idx * 2) : (tabB + (idx - 1024) * 2);
                tp[0] = cc; tp[1] = ss;
            }
          }
        } else if (ph == 1) {
            const float* b_mod = ka->in[7];
            for (int idx = vcu * 512 + tid; idx < 4 * 5 * 6144; idx += G * 512) {
                const int l = idx / 30720, n = idx % 6144;
                float s = b_mod[l * 6144 + n];
#pragma unroll
                for (int ks = 0; ks < 16; ++ks) s += MODP[(size_t)ks * 122880 + idx];
                MOD[idx] = s;
            }
        } else if (ph == N_PHASES - 1) {
            const float* fw = ka->in[22];
            for (int m = gw; m < ML; m += NGW) {
                f32x4* xr = (f32x4*)(XL + (size_t)m * DM) + lane;
                f32x4 v[4]; float s = 0.f;
#pragma unroll
                for (int j = 0; j < 4; ++j) { v[j] = xr[64 * j]; s += (v[j][0] * v[j][0] + v[j][1] * v[j][1]) + (v[j][2] * v[j][2] + v[j][3] * v[j][3]); }
                const float rstd = rsqrtf(wave_sum(s, lane) * (1.f / 1024.f) + 1e-6f);
#pragma unroll
                for (int j = 0; j < 4; ++j) { const f32x4 w = *(const f32x4*)(fw + 4 * (64 * j + lane)); xr[64 * j] = v[j] * rstd * w; }
            }
        } else {
            const int l = (ph - 2) / 7, k = (ph - 2) % 7;
            const bool need_ctx = l < DEPTH - 1;
            const float* modl = MOD + (size_t)l * 5 * 6144;
            unsigned char* wl = ws + WS_W + (size_t)l * W_LAYER;
            const float* srcL = (l == 0) ? ka->in[0] : XL;
            if (k == 0) {
                const float* nw = ka->in[4] + l * 1024;
                for (int m = gw; m < MT; m += NGW) {
                    const bool lat = m < ML; const int slot = lat ? (m >> 13) : 4;
                    if (lat) norm_mod_row(srcL + (size_t)m * DM, nw, modl + slot * 6144, modl + slot * 6144 + 1024, XN + (size_t)m * DM, lane);
                    else {
                        const size_t ro = (size_t)(m - ML) * DM;
                        norm_mod_row((l == 0 ? ka->in[2] : (const float*)XCB) + ro, nw, modl + slot * 6144, modl + slot * 6144 + 1024, XN + (size_t)m * DM, lane,
                                     (const float*)Ob + ro, (l == 0) ? 0 : 11, XCA + ro);
                    }
                }
            } else if (k == 1) {
                pg8::Gemm g{XN, (const bf16_t*)wl, MT, INC, DM, DM}; pg8::StaticOrder S; S.init(MT, INC, G, bx);
                pg8::EpiInProj E{Hb, tabA, tabB};
#ifndef DIS_IN
                pg8::gemm_phase<pg8::EpiInProj, pg8::StaticOrder, true, true>(lds, g, S, E);
#endif
            } else if (k == 2) {
                float lam, ofac;
                {
                    float d1 = 0.f, d2 = 0.f;
                    for (int i = 0; i < 32; ++i) { d1 += ka->in[10][l * 32 + i] * ka->in[11][l * 32 + i]; d2 += ka->in[12][l * 32 + i] * ka->in[13][l * 32 + i]; }
                    const float li = 0.8f - 0.6f * expf(-0.3f * (float)l);
                    lam = expf(d1) - expf(d2) + li;
                    lam = __uint_as_float(__builtin_amdgcn_readfirstlane(__float_as_uint(lam))); ofac = __uint_as_float(__builtin_amdgcn_readfirstlane(__float_as_uint(li)));
                }
                const float* subw = ka->in[14] + l * 64; const float* sink_l = ka->in[15] + l * 4; const float* rpb_l = ka->in[16] + (size_t)l * 4 * 465;
#ifndef DIS_A
                for (int u = vcu; u < 512 + (need_ctx ? 16 : 0); u += G) {
                    const bool cq = u >= 512; const int bh = cq ? (u - 512) : (u >> 5);
                    att::unit_A(cq, lds, Hb, Ob, bh >> 2, bh & 3, u & 31, lam, ofac, subw);
                }
#endif
#ifndef DIS_B
                for (int u = vcu; u < 1024 + (need_ctx ? 32 : 0); u += G) {
                    int mode, ub, uh, ublk; bool redo = true;
                    if (u < 512) { mode = 1; ub = u >> 7; uh = (u >> 6) & 1; ublk = u & 63; redo = att::unit_BC_fast<1>(lds, Hb, Ob, ub, uh, ublk, sink_l, rpb_l); }
                    else if (u < 1024) { const int v = u - 512; mode = 2; ub = v >> 7; uh = (v >> 5) & 3; ublk = v & 31; redo = att::unit_BC_fast<2>(lds, Hb, Ob, ub, uh, ublk, sink_l, rpb_l); }
                    else { const int v = u - 1024, bh = v & 15; if (v < 16) { mode = 3; ub = bh >> 2; uh = (bh >> 1) & 1; ublk = bh & 1; } else { mode = 4; ub = bh >> 2; uh = bh & 3; ublk = 0; } }
                    if (redo) att::unit_BC(mode, lds, Hb, Ob, ub, uh, ublk, sink_l, rpb_l);
                }
#endif
                {
                    const float* cwl = ka->in[17] + (size_t)l * 3 * 256;
                    const int rows = need_ctx ? MT : ML;
                    for (int idx = vcu * 512 + tid; idx < rows * 32; idx += G * 512) {
                        const int row = idx >> 5, c0 = (idx & 31) * 8;
                        int t, len; if (row < ML) { t = row & 8191; len = SEQ; } else { t = (row - ML) & 255; len = CTXL; }
                        const bf16_t* hp = Hb + (size_t)row * INC + 2048 + c0;
                        const u32x4 bg = *(const u32x4*)hp, cg1 = *(const u32x4*)(hp + 256), xi1 = *(const u32x4*)(hp + 512);
                        u32x4 cg0 = {0u, 0u, 0u, 0u}, xi0 = cg0, cg2 = cg0, xi2 = cg0;
                        if (t > 0) { cg0 = *(const u32x4*)(hp - INC + 256); xi0 = *(const u32x4*)(hp - INC + 512); }
                        if (t < len - 1) { cg2 = *(const u32x4*)(hp + INC + 256); xi2 = *(const u32x4*)(hp + INC + 512); }
                        float w0[8], w1[8], w2[8];
#pragma unroll
                        for (int e = 0; e < 8; ++e) { w0[e] = cwl[c0 + e]; w1[e] = cwl[256 + c0 + e]; w2[e] = cwl[512 + c0 + e]; }
                        u32x4 ow;
#pragma unroll
                        for (int e = 0; e < 4; ++e) {
                            const float ylo = w0[2 * e] * bflo(cg0[e]) * bflo(xi0[e]) + w1[2 * e] * bflo(cg1[e]) * bflo(xi1[e]) + w2[2 * e] * bflo(cg2[e]) * bflo(xi2[e]);
                            const float yhi = w0[2 * e + 1] * bfhi(cg0[e]) * bfhi(xi0[e]) + w1[2 * e + 1] * bfhi(cg1[e]) * bfhi(xi1[e]) + w2[2 * e + 1] * bfhi(cg2[e]) * bfhi(xi2[e]);
                            ow[e] = pkbf(bflo(bg[e]) * ylo, bfhi(bg[e]) * yhi);
                        }
                        *(u32x4*)(Ob + (size_t)row * DM + 768 + c0) = ow;
                    }
                }
                __syncthreads();
            } else if (k == 4) {
                const float* nw = ka->in[5] + l * 1024;
                const int nrows = (need_ctx ? NMX_ALL : NMX_L) * 256;
                for (int e = gw; e < nrows; e += NGW) {
                    const int pm = e >> 8, j = e & 255;
                    int t, slot; const float* base; int len;
                    if (pm < NMX_L) { const int s = pm / 33, ti = pm - s * 33; t = 254 * ti - 1 + j; len = SEQ; slot = s; base = XL + (size_t)s * SEQ * DM; }
                    else { const int p = 254 * (pm - NMX_L) - 1 + j; const int sq = (p < 0) ? 0 : p / 257, r = p - sq * 257; t = (p >= 0 && p < 1029 && r != 0) ? (r - 1) : -1; len = CTXL; slot = 4; base = XCA + (size_t)sq * CTXL * DM; }
                    const bool ok = (t >= 0 && t < len);
                    const float* src = ok ? (base + (size_t)t * DM) : nullptr;
                    if (pm < NMX_L || !ok) norm_mod_row(src, nw, modl + slot * 6144 + 3072, modl + slot * 6144 + 4096, XN + (size_t)e * DM, lane);
                    else {
                        const size_t ro = (size_t)(src - XCA);
                        norm_mod_row(src, nw, modl + slot * 6144 + 3072, modl + slot * 6144 + 4096, XN + (size_t)e * DM, lane, (const float*)Hb + ro, 4, XCB + ro);
                    }
                }
            } else if (k == 5) {
                const int nM = need_ctx ? NMX_ALL : NMX_L;
                pg8::Gemm g{XN, (const bf16_t*)(wl + W_UP_OFF), nM * 256, UPC, DM, DM}; pg8::StaticOrder S; S.init(nM * 256, UPC, G, bx);
                pg8::EpiUpConv E{ACT, ka->in[19] + (size_t)l * 3 * UPC, ka->in[20] + (size_t)l * UPC};
                pg8::OneUnit one;
#ifndef DIS_UP
                for (int i = 0; S.next(i, one.u); ++i) pg8::gemm_phase<pg8::EpiUpConv, pg8::OneUnit, false, true>(lds, g, one, E);
#endif
            } else {
                const bool isout = (k == 3); const int KK = isout ? DM : DFF;
                const bf16_t* Ap = isout ? (const bf16_t*)Ob : (const bf16_t*)ACT; const bf16_t* Bp = (const bf16_t*)(wl + (isout ? W_OUT_OFF : W_DN_OFF));
                {
                    pg8::Gemm g{Ap, Bp, ML, DM, KK, KK}; pg8::StaticOrder S; S.init(ML, DM, G, bx);
                    pg8::EpiRes E{isout ? srcL : (const float*)XL, nullptr, XL, nullptr, modl, isout ? 2048 : 5120};
#ifndef DIS_OUT
                    pg8::gemm_phase<pg8::EpiRes, pg8::StaticOrder, true, true>(lds, g, S, E);
#endif
                }
                if (need_ctx) {
                    const int P = isout ? 4 : 11, klen = KK / P;
                    for (int su = bx; su < 16 * P; su += G) {
                        const int tile = su / P, part = su - tile * P;
                        pg8::Gemm gs{Ap + (size_t)ML * KK + part * klen, Bp + part * klen, MC, DM, klen, KK};
                        pg8::OneUnit one; one.u.pm = tile >> 2; one.u.pn = tile & 3;
                        pg8::EpiSlab EA{(isout ? (float*)Hb : (float*)Ob) + (size_t)part * 1024 * 1024, modl + 4 * 6144 + (isout ? 2048 : 5120)};
                        pg8::gemm_phase<pg8::EpiSlab, pg8::OneUnit, false, true>(lds, gs, one, EA);
                    }
                }
            }
        }
        if (ph + 1 < ph_hi && kargs()->coop) {
            if (kargs()->coop == 2) cg::this_grid().sync();
            else { XcdBarrier b; b.bar = (unsigned*)kargs()->ws; b.x = xb_xcc_id(); b.st = bar_st; xcd_barrier(b); }
        }
    }
}

extern "C" void kernel_launch(void* const* d_in, const int* in_sizes, int n_in, void* d_out, int out_size, void* d_ws, size_t ws_size, hipStream_t stream) {
    static int grid = 0;
    if (grid == 0) {
        if (n_in != 23 || out_size != ML * DM || ws_size < WS_END) { fprintf(stderr, "kernel_launch: unexpected shapes (n_in %d out %d ws %zu need %zu)\n", n_in, out_size, ws_size, (size_t)WS_END); grid = -1; return; }
        int dev = 0, cus = 0, per_cu = 0;
        if (hipGetDevice(&dev) != hipSuccess || hipDeviceGetAttribute(&cus, hipDeviceAttributeMultiprocessorCount, dev) != hipSuccess) { grid = -1; return; }
        if (hipFuncSetAttribute((const void*)fwd_kernel, hipFuncAttributeMaxDynamicSharedMemorySize, LDS_BYTES) != hipSuccess) { fprintf(stderr, "kernel_launch: hipFuncSetAttribute failed\n"); grid = -1; return; }
        if (hipOccupancyMaxActiveBlocksPerMultiprocessor(&per_cu, (const void*)fwd_kernel, 512, LDS_BYTES) != hipSuccess || per_cu < 1) fprintf(stderr, "kernel_launch: occupancy query says %d\n", per_cu);
        (void)hipGetLastError();
        grid = cus;
    }
    if (grid < 0) return;
    Args a{};
    for (int i = 0; i < 23; ++i) a.in[i] = (const float*)d_in[i];
    a.out = (float*)d_out; a.ws = (unsigned char*)d_ws;
#if MK_MULTI
    for (int ph = 0; ph < N_PHASES; ++ph) {
        a.ph_lo = ph; a.ph_hi = ph + 1; a.coop = 0;
        hipLaunchKernelGGL(fwd_kernel, dim3(grid), dim3(512), LDS_BYTES, stream, a);
    }
#else
    a.ph_lo = 0; a.ph_hi = N_PHASES; a.coop = 1;
    if (hipMemsetAsync(d_ws, 0, 16384, stream) != hipSuccess) { fprintf(stderr, "kernel_launch: memset failed\n"); return; }
    void* args[] = {&a};
    hipError_t e = hipLaunchCooperativeKernel((const void*)fwd_kernel, dim3(grid), dim3(512), args, LDS_BYTES, stream);
    if (e != hipSuccess) fprintf(stderr, "cooperative launch failed: %s (grid %d)\n", hipGetErrorString(e), grid);
#endif
}
```

```cpp
#include <hip/hip_runtime.h>
#include <hip/hip_cooperative_groups.h>
#include <cstdio>
#include <cstdint>
namespace cg = cooperative_groups;

#ifndef MK_MULTI
#define MK_MULTI 0
#endif

#ifndef REP_IN
#define REP_IN 1
#endif
#ifndef REP_UP
#define REP_UP 1
#endif
#ifndef REP_A
#define REP_A 1
#endif
#ifndef REP_OD
#define REP_OD 1
#endif
#ifndef REP_P
#define REP_P 1
#endif
#ifndef REP_BC
#define REP_BC 1
#endif
#ifndef REP_M
#define REP_M 1
#endif

__device__ __forceinline__ int pg8_ltid() { int t = threadIdx.x; asm volatile("" : "+v"(t)); return t; }
namespace pg8 {
#define PG8_LAS __attribute__((address_space(3)))
typedef unsigned short bf16_t;
typedef short bf16x8 __attribute__((ext_vector_type(8)));
typedef float f32x4 __attribute__((ext_vector_type(4)));
typedef unsigned u32x4 __attribute__((ext_vector_type(4)));
constexpr int BM = 256, BK = 64, HALF = 128, HTB = HALF * BK * 2  , STAGE_BYTES = 8 * HTB, NXCD = 8, WGM = 8;

__host__ __device__ __forceinline__ int lds_byte(int r, int c) { const int st = (r >> 4) * 2 + (c >> 5), rr = r & 15, cc = c & 31, ob = rr * 64 + cc * 2; return st * 1024 + (ob ^ (((ob >> 9) & 1) << 5)); }
__host__ __device__ __forceinline__ void stage_rc(int b, int& R, int& C) { const int st = b / 1024, sb = b % 1024, swz = sb ^ (((sb >> 9) & 1) << 5); R = (st >> 1) * 16 + swz / 64; C = (st & 1) * 32 + (swz % 64) / 2; }
__host__ __device__ __forceinline__ int perm32(int rho) { const int n = rho >> 4, i = rho & 15; return 8 * (i >> 2) + 4 * n + (i & 3); }

struct Unit { int pm, pn; };
struct Gemm { const bf16_t* A; const bf16_t* Bt; int M, N, K, ldk; };

struct StaticOrder {
    int nM, nN, nwg, G, c;
    __host__ __device__ void init(int M, int N, int G_, int c_) { nM = M / BM; nN = N / BM; nwg = nM * nN; G = G_; c = c_; }
    __host__ __device__ bool next(int i, Unit& u) const {
        const long L = (long)i * G + c; if (L >= nwg) return false;
        int wgid = (int)L; { const int q = nwg / NXCD, r = nwg % NXCD, xcd = wgid % NXCD, off = wgid / NXCD; wgid = (xcd < r ? xcd * (q + 1) : r * (q + 1) + (xcd - r) * q) + off; }
        const int nig = WGM * nN, gid = wgid / nig, fm = gid * WGM, gsz = (nM - fm) < WGM ? (nM - fm) : WGM;
        u.pm = fm + ((wgid % nig) % gsz); u.pn = (wgid % nig) / gsz; return true;
    }
    __device__ __forceinline__ void a_ready(const Unit&) const {}
    __device__ __forceinline__ void done(const Unit&) const {}
};

typedef float pg8_f32x2 __attribute__((ext_vector_type(2))); typedef __bf16 pg8_bf16x2 __attribute__((ext_vector_type(2)));
__device__ __forceinline__ unsigned cvt_pk_bf16(float lo, float hi) { pg8_f32x2 v = {lo, hi}; pg8_bf16x2 b = __builtin_convertvector(v, pg8_bf16x2); return __builtin_bit_cast(unsigned, b); }
typedef unsigned u32x2 __attribute__((ext_vector_type(2)));

struct OneUnit {
    Unit u;
    __device__ __forceinline__ bool next(int i, Unit& o) const { if (i != 0) return false; o = u; return true; }
    __device__ __forceinline__ void a_ready(const Unit&) const {}
    __device__ __forceinline__ void done(const Unit&) const {}
};

struct EpiInProj {
    static constexpr bool PERM = true, AFTER_DRAIN = false;
    bf16_t* H; const float* tabA; const float* tabB;
    __device__ __forceinline__ void operator()(const f32x4 (&acc)[2][2][4][2], const Unit& u, int wr, int wc, int fr, int fq) const {
        const int pn = u.pn; const bool latent = u.pm < 128;
        const float scale = (pn == 0) ? 0.17677669529663687f * 1.4426950408889634f : ((pn == 3 || pn == 5) ? 0.125f * 1.4426950408889634f : 1.0f);
#pragma unroll
        for (int bj = 0; bj < 2; ++bj) {
            int mode = (pn == 0 || pn == 1) ? 1 : ((pn == 3 || (pn == 4 && bj == 0)) ? 2 : 0);
            if (!latent) mode = 0;
#ifdef TEST_NOROPE
            mode = 0;
#endif
#pragma unroll
            for (int ai = 0; ai < 2; ++ai)
#pragma unroll
                for (int m = 0; m < 4; ++m) {
                    const int r = u.pm * BM + ai * HALF + wr * 64 + m * 16 + fr;
                    f32x4 v0 = acc[ai][bj][m][0], v1 = acc[ai][bj][m][1];
                    if (mode != 0) {
                        const int t = r & 8191, trow = t >> 6, tcol = t & 63;
                        const float* tp;
                        if (mode == 1) { const int pos = (fq < 2) ? trow : tcol; tp = tabA + (pos * 8 + 4 * (fq & 1)) * 2; }
                        else { const int pos = (wc & 1) ? tcol : trow; tp = tabB + (pos * 16 + 4 * fq) * 2; }
                        const f32x4 cs0 = *(const f32x4*)tp, cs1 = *(const f32x4*)(tp + 4);
                        const float c0 = cs0[0], s0 = cs0[1], c1 = cs0[2], s1 = cs0[3], c2 = cs1[0], s2 = cs1[1], c3 = cs1[2], s3 = cs1[3];
                        f32x4 a = v0, b = v1;
                        v0[0] = a[0] * c0 - b[0] * s0; v1[0] = b[0] * c0 + a[0] * s0;
                        v0[1] = a[1] * c1 - b[1] * s1; v1[1] = b[1] * c1 + a[1] * s1;
                        v0[2] = a[2] * c2 - b[2] * s2; v1[2] = b[2] * c2 + a[2] * s2;
                        v0[3] = a[3] * c3 - b[3] * s3; v1[3] = b[3] * c3 + a[3] * s3;
                    }
                    v0 = v0 * scale; v1 = v1 * scale;
                    bf16_t* rowp = H + (size_t)r * 2816 + pn * BM + bj * HALF + wc * 32 + 8 * fq;
                    u32x4 w; w.x = cvt_pk_bf16(v0[0], v0[1]); w.y = cvt_pk_bf16(v0[2], v0[3]); w.z = cvt_pk_bf16(v1[0], v1[1]); w.w = cvt_pk_bf16(v1[2], v1[3]);
                    *(u32x4*)rowp = w;
                }
        }
    }
};

struct EpiRes {
    static constexpr bool PERM = false, AFTER_DRAIN = false;
    const float* baseL; const float* baseC; float* outL; float* outC; const float* modl; int goff;
    __device__ __forceinline__ void operator()(const f32x4 (&acc)[2][2][4][2], const Unit& u, int wr, int wc, int fr, int fq) const {
        const bool ctx = u.pm >= 128; const int slot = ctx ? 4 : (u.pm >> 5);
        const int row0 = (ctx ? (u.pm - 128) : u.pm) * BM + wr * 64 + fr;
        const float* bp = ctx ? baseC : baseL; float* op = ctx ? outC : outL;
        const int col0 = u.pn * BM + wc * 32 + 4 * fq;
        f32x4 gv[2][2];
#pragma unroll
        for (int bj = 0; bj < 2; ++bj)
#pragma unroll
            for (int n = 0; n < 2; ++n) gv[bj][n] = *(const f32x4*)(modl + slot * 6144 + goff + col0 + bj * HALF + n * 16);
#pragma unroll
        for (int ai = 0; ai < 2; ++ai)
#pragma unroll
            for (int m = 0; m < 4; ++m) {
                const size_t off = (size_t)(row0 + ai * HALF + m * 16) * 1024 + col0;
#pragma unroll
                for (int bj = 0; bj < 2; ++bj)
#pragma unroll
                    for (int n = 0; n < 2; ++n) {
                        const f32x4 bs = *(const f32x4*)(bp + off + bj * HALF + n * 16);
                        *(f32x4*)(op + off + bj * HALF + n * 16) = bs + gv[bj][n] * acc[ai][bj][m][n];
                    }
                asm volatile("" ::: "memory");
            }
    }
};

struct EpiSlab {
    static constexpr bool PERM = false, AFTER_DRAIN = false;
    float* slab; const float* gate;
    __device__ __forceinline__ void operator()(const f32x4 (&acc)[2][2][4][2], const Unit& u, int wr, int wc, int fr, int fq) const {
        const int row0 = u.pm * BM + wr * 64 + fr, col0 = u.pn * BM + wc * 32 + 4 * fq;
#pragma unroll
        for (int bj = 0; bj < 2; ++bj)
#pragma unroll
            for (int n = 0; n < 2; ++n) {
                const f32x4 gv = *(const f32x4*)(gate + col0 + bj * HALF + n * 16);
#pragma unroll
                for (int ai = 0; ai < 2; ++ai)
#pragma unroll
                    for (int m = 0; m < 4; ++m)
                        *(f32x4*)(slab + (size_t)(row0 + ai * HALF + m * 16) * 1024 + col0 + bj * HALF + n * 16) = gv * acc[ai][bj][m][n];
            }
    }
};

struct EpiUpConv {
    static constexpr bool PERM = false, AFTER_DRAIN = true;
    bf16_t* ACT; const float* cw; const float* cb;
    static constexpr int TP = 520;
    __device__ __forceinline__ void fused(f32x4 (&acc)[2][2][4][2], const Unit& u, int wr, int wc, int fr, int fq, PG8_LAS unsigned char* lds, int wid, int lane) const {
#pragma unroll
        for (int ai = 0; ai < 2; ++ai)
#pragma unroll
            for (int m = 0; m < 4; ++m) {
                const int row = ai * HALF + wr * 64 + m * 16 + fr;
#pragma unroll
                for (int bj = 0; bj < 2; ++bj)
#pragma unroll
                    for (int n = 0; n < 2; ++n) {
                        const f32x4 v = acc[ai][bj][m][n]; u32x2 w; w.x = cvt_pk_bf16(v[0], v[1]); w.y = cvt_pk_bf16(v[2], v[3]);
                        *(PG8_LAS u32x2*)(lds + row * TP + (bj * HALF + wc * 32 + n * 16 + 4 * fq) * 2) = w;
                    }
            }
        const int tid = wid * 64 + lane, ch = tid & 15;
        const int gcol = u.pn * 128 + ch * 8;
        float wg[3][8], wv[3][8], bg[8], bv[8];
#pragma unroll
        for (int k = 0; k < 3; ++k) {
            const f32x4 a0 = *(const f32x4*)(cw + k * 5632 + gcol), a1 = *(const f32x4*)(cw + k * 5632 + gcol + 4);
            const f32x4 b0 = *(const f32x4*)(cw + k * 5632 + 2816 + gcol), b1 = *(const f32x4*)(cw + k * 5632 + 2816 + gcol + 4);
#pragma unroll
            for (int e = 0; e < 4; ++e) { wg[k][e] = a0[e]; wg[k][4 + e] = a1[e]; wv[k][e] = b0[e]; wv[k][4 + e] = b1[e]; }
        }
        {
            const f32x4 a0 = *(const f32x4*)(cb + gcol), a1 = *(const f32x4*)(cb + gcol + 4), b0 = *(const f32x4*)(cb + 2816 + gcol), b1 = *(const f32x4*)(cb + 2816 + gcol + 4);
#pragma unroll
            for (int e = 0; e < 4; ++e) { bg[e] = a0[e]; bg[4 + e] = a1[e]; bv[e] = b0[e]; bv[4 + e] = b1[e]; }
        }
        const bool lat = u.pm < 132; int rowbase, ti;
        if (lat) { const int s = u.pm / 33; ti = u.pm - s * 33; rowbase = s * 8192; } else { ti = u.pm - 132; rowbase = 32768; }
        asm volatile("s_waitcnt lgkmcnt(0)" ::: "memory"); __builtin_amdgcn_s_barrier(); asm volatile("" ::: "memory");
        for (int it = tid; it < 254 * 16; it += 512) {
            const int j = 1 + (it >> 4); const int p = 254 * ti - 1 + j;
            int orow; bool ok;
            if (lat) { ok = p < 8192; orow = rowbase + p; } else { const int sq = p / 257, r = p - sq * 257; ok = (p < 1029) && (r != 0); orow = rowbase + sq * 256 + r - 1; }
            if (ok) {
                float g[8], v[8];
#pragma unroll
                for (int e = 0; e < 8; ++e) { g[e] = bg[e]; v[e] = bv[e]; }
#pragma unroll
                for (int k = 0; k < 3; ++k) {
                    const PG8_LAS unsigned char* rp = lds + (j - 1 + k) * TP + ch * 16;
                    const u32x2 g0 = *(const PG8_LAS u32x2*)rp, g1 = *(const PG8_LAS u32x2*)(rp + 8);
                    const u32x2 v0 = *(const PG8_LAS u32x2*)(rp + 256), v1 = *(const PG8_LAS u32x2*)(rp + 264);
                    const unsigned gw[4] = {g0.x, g0.y, g1.x, g1.y}, vw[4] = {v0.x, v0.y, v1.x, v1.y};
#pragma unroll
                    for (int e = 0; e < 4; ++e) {
                        g[2 * e] += wg[k][2 * e] * __uint_as_float(gw[e] << 16); g[2 * e + 1] += wg[k][2 * e + 1] * __uint_as_float(gw[e] & 0xffff0000u);
                        v[2 * e] += wv[k][2 * e] * __uint_as_float(vw[e] << 16); v[2 * e + 1] += wv[k][2 * e + 1] * __uint_as_float(vw[e] & 0xffff0000u);
                    }
                }
                float o[8];
#pragma unroll
                for (int e = 0; e < 8; ++e) o[e] = g[e] / (1.f + __expf(-g[e])) * v[e];
                u32x4 w; w.x = cvt_pk_bf16(o[0], o[1]); w.y = cvt_pk_bf16(o[2], o[3]); w.z = cvt_pk_bf16(o[4], o[5]); w.w = cvt_pk_bf16(o[6], o[7]);
                *(u32x4*)(ACT + (size_t)orow * 2816 + gcol) = w;
            }
        }
        asm volatile("s_waitcnt lgkmcnt(0)" ::: "memory"); __builtin_amdgcn_s_barrier(); asm volatile("" ::: "memory");
    }
};
template <class Epi, class Sched, bool ALIGN_EPI = false, bool SP2 = false>
__device__ __forceinline__ void gemm_phase(PG8_LAS unsigned char* lds, const Gemm g, const Sched& S, const Epi& E) {
    const int tid = pg8_ltid(), wid = __builtin_amdgcn_readfirstlane(tid >> 6), lane = tid & 63, wr = wid >> 2, wc = wid & 3, fr = lane & 15, fq = lane >> 4;
    const int K = g.ldk, nt = g.K / BK;
    unsigned voffA[2], voffB[2];
#pragma unroll
    for (int i = 0; i < 2; ++i) { int R, C; stage_rc(tid * 16 + i * 8192, R, C); const int Rb = Epi::PERM ? ((R & ~31) + perm32(R & 31)) : R;
        voffA[i] = (unsigned)(R * K + C) * 2u; voffB[i] = (unsigned)(Rb * K + C) * 2u; }
    const size_t kstep = (size_t)(BK * 2);
    const size_t hstep = (size_t)HALF * K * 2;
    const size_t tstep = 2 * hstep;
    const unsigned ldsw = (unsigned)wid * 1024u;
    const int aoff = lds_byte(wr * 64 + fr, fq * 8), boff = lds_byte(wc * 32 + fr, fq * 8);
#define PG8_SA(b, h) (((b) * 2 + (h)) * HTB)
#define PG8_SB(b, h) ((4 + (b) * 2 + (h)) * HTB)
#define PG8_STAGE(bufoff, gbase, voff) do { _Pragma("unroll") for (int _i = 0; _i < 2; ++_i) \
        __builtin_amdgcn_global_load_lds((const unsigned*)((const char*)(gbase) + (voff)[_i]), (PG8_LAS unsigned*)(lds + (bufoff) + ldsw + _i * 8192), 16, 0, 0); } while (0)
#define PG8_LDA(dst, b, h) do { _Pragma("unroll") for (int m = 0; m < 4; ++m) _Pragma("unroll") for (int k = 0; k < 2; ++k) dst[m][k] = *(const PG8_LAS bf16x8*)(lds + PG8_SA(b, h) + aoff + m * 2048 + k * 1024); } while (0)
#define PG8_LDB(dst, b, h) do { _Pragma("unroll") for (int n = 0; n < 2; ++n) _Pragma("unroll") for (int k = 0; k < 2; ++k) dst[n][k] = *(const PG8_LAS bf16x8*)(lds + PG8_SB(b, h) + boff + n * 2048 + k * 1024); } while (0)
#define PG8_MMA(ai, bj, At, Bt) do { __builtin_amdgcn_s_setprio(1); _Pragma("unroll") for (int m = 0; m < 4; ++m) _Pragma("unroll") for (int n = 0; n < 2; ++n) _Pragma("unroll") for (int k = 0; k < 2; ++k) \
        acc[ai][bj][m][n] = __builtin_amdgcn_mfma_f32_16x16x32_bf16(Bt[n][k], At[m][k], acc[ai][bj][m][n], 0, 0, 0); __builtin_amdgcn_s_setprio(0); } while (0)
#define PG8_WAIT_V(n) asm volatile("s_waitcnt vmcnt(" #n ")" ::: "memory")
#define PG8_WAIT_L(n) asm volatile("s_waitcnt lgkmcnt(" #n ")" ::: "memory")
#define PG8_BAR __builtin_amdgcn_s_barrier()
#define PG8_SCHED __builtin_amdgcn_sched_barrier(0)
    Unit cur, nxt; int ui = 0;
    if (!S.next(0, cur)) return;
    f32x4 acc[2][2][4][2];
#pragma unroll
    for (int a = 0; a < 2; ++a)
#pragma unroll
        for (int b = 0; b < 2; ++b)
#pragma unroll
            for (int m = 0; m < 4; ++m)
#pragma unroll
                for (int n = 0; n < 2; ++n) acc[a][b][m][n] = (f32x4){0.f, 0.f, 0.f, 0.f};
    bf16x8 At[4][2], B0[2][2], B1[2][2];
    const char* cA = (const char*)g.A + (size_t)cur.pm * tstep; const char* cB = (const char*)g.Bt + (size_t)cur.pn * tstep;
    S.a_ready(cur);
    if constexpr (SP2) {
        PG8_STAGE(PG8_SB(0, 0), cB, voffB); PG8_STAGE(PG8_SB(0, 1), cB + hstep, voffB); PG8_STAGE(PG8_SA(0, 0), cA, voffA); PG8_STAGE(PG8_SA(0, 1), cA + hstep, voffA);
        if (wr == 1) PG8_BAR;
        PG8_WAIT_V(2); PG8_BAR;
        PG8_STAGE(PG8_SB(1, 0), cB + kstep, voffB); PG8_STAGE(PG8_SA(1, 0), cA + kstep, voffA); PG8_STAGE(PG8_SB(1, 1), cB + hstep + kstep, voffB);
        PG8_WAIT_V(6); PG8_BAR;
    } else {
        PG8_STAGE(PG8_SB(0, 0), cB, voffB); PG8_STAGE(PG8_SA(0, 0), cA, voffA); PG8_STAGE(PG8_SB(0, 1), cB + hstep, voffB); PG8_STAGE(PG8_SA(0, 1), cA + hstep, voffA);
        if (wr == 1) PG8_BAR;
        PG8_WAIT_V(4); PG8_BAR;
        PG8_STAGE(PG8_SB(1, 0), cB + kstep, voffB); PG8_STAGE(PG8_SA(1, 0), cA + kstep, voffA); PG8_STAGE(PG8_SB(1, 1), cB + hstep + kstep, voffB);
        PG8_WAIT_V(6); PG8_BAR;
    }
    for (;;) {
        const bool has_next = S.next(ui + 1, nxt);
        const char* nA = has_next ? (const char*)g.A + (size_t)nxt.pm * tstep : cA; const char* nB = has_next ? (const char*)g.Bt + (size_t)nxt.pn * tstep : cB;
        for (int t = 0; t < nt; t += 2) {
            const bool last = (t == nt - 2);
            const char* a1 = cA + (size_t)(t + 1) * kstep;
            const char* a2 = last ? nA : cA + (size_t)(t + 2) * kstep; const char* b2 = last ? nB : cB + (size_t)(t + 2) * kstep;
            const char* a3 = a2 + kstep; const char* b3 = b2 + kstep;
            if (last && has_next) S.a_ready(nxt);
            if constexpr (SP2) {
            PG8_LDB(B0, 0, 0); PG8_LDB(B1, 0, 1); PG8_SCHED; PG8_LDA(At, 0, 0); PG8_STAGE(PG8_SA(1, 1), a1 + hstep, voffA);
            PG8_WAIT_V(8); PG8_WAIT_L(0); PG8_BAR; PG8_MMA(0, 0, At, B0); PG8_MMA(0, 1, At, B1); PG8_BAR; PG8_SCHED;
            PG8_LDA(At, 0, 1); PG8_STAGE(PG8_SB(0, 0), b2, voffB); PG8_STAGE(PG8_SB(0, 1), b2 + hstep, voffB); PG8_STAGE(PG8_SA(0, 0), a2, voffA);
            PG8_WAIT_V(8); PG8_WAIT_L(0); PG8_BAR; PG8_MMA(1, 0, At, B0); PG8_MMA(1, 1, At, B1); PG8_BAR; PG8_SCHED;
            PG8_LDB(B0, 1, 0); PG8_LDB(B1, 1, 1); PG8_SCHED; PG8_LDA(At, 1, 0); PG8_STAGE(PG8_SA(0, 1), a2 + hstep, voffA);
            PG8_WAIT_V(8); PG8_WAIT_L(0); PG8_BAR; PG8_MMA(0, 0, At, B0); PG8_MMA(0, 1, At, B1); PG8_BAR; PG8_SCHED;
            PG8_LDA(At, 1, 1); PG8_STAGE(PG8_SB(1, 0), b3, voffB); PG8_STAGE(PG8_SB(1, 1), b3 + hstep, voffB); PG8_STAGE(PG8_SA(1, 0), a3, voffA);
            PG8_WAIT_V(8); PG8_WAIT_L(0); PG8_BAR; PG8_MMA(1, 0, At, B0); PG8_MMA(1, 1, At, B1); PG8_BAR; PG8_SCHED;
            } else {
            PG8_LDB(B0, 0, 0); PG8_SCHED; PG8_LDA(At, 0, 0); PG8_STAGE(PG8_SA(1, 1), a1 + hstep, voffA);
            PG8_WAIT_L(8); PG8_BAR; PG8_WAIT_L(0); PG8_MMA(0, 0, At, B0); PG8_BAR; PG8_SCHED;
            PG8_LDB(B1, 0, 1); PG8_STAGE(PG8_SB(0, 0), b2, voffB);
            PG8_BAR; PG8_WAIT_L(0); PG8_MMA(0, 1, At, B1); PG8_BAR;
            PG8_LDA(At, 0, 1); PG8_STAGE(PG8_SA(0, 0), a2, voffA);
            PG8_BAR; PG8_WAIT_L(0); PG8_MMA(1, 0, At, B0); PG8_BAR; PG8_SCHED;
            PG8_STAGE(PG8_SB(0, 1), b2 + hstep, voffB);
            PG8_WAIT_V(6); PG8_BAR; PG8_MMA(1, 1, At, B1); PG8_BAR;
            PG8_LDB(B0, 1, 0); PG8_SCHED; PG8_LDA(At, 1, 0); PG8_STAGE(PG8_SA(0, 1), a2 + hstep, voffA);
            PG8_WAIT_L(8); PG8_BAR; PG8_WAIT_L(0); PG8_MMA(0, 0, At, B0); PG8_BAR; PG8_SCHED;
            PG8_LDB(B1, 1, 1); PG8_STAGE(PG8_SB(1, 0), b3, voffB);
            PG8_BAR; PG8_WAIT_L(0); PG8_MMA(0, 1, At, B1); PG8_BAR;
            PG8_LDA(At, 1, 1); PG8_STAGE(PG8_SA(1, 0), a3, voffA);
            PG8_BAR; PG8_WAIT_L(0); PG8_MMA(1, 0, At, B0); PG8_BAR; PG8_SCHED;
            PG8_STAGE(PG8_SB(1, 1), b3 + hstep, voffB);
            PG8_WAIT_V(6); PG8_BAR; PG8_MMA(1, 1, At, B1); PG8_BAR;
            }
        }
        if constexpr (ALIGN_EPI) { if (wr == 0) PG8_BAR; }
        if constexpr (!Epi::AFTER_DRAIN) { E(acc, cur, wr, wc, fr, fq); S.done(cur); }
        if (!has_next) break;
#pragma unroll
        for (int a = 0; a < 2; ++a)
#pragma unroll
            for (int b = 0; b < 2; ++b)
#pragma unroll
                for (int m = 0; m < 4; ++m)
#pragma unroll
                    for (int n = 0; n < 2; ++n) acc[a][b][m][n] = (f32x4){0.f, 0.f, 0.f, 0.f};
        cur = nxt; cA = nA; cB = nB; ++ui;
        if constexpr (ALIGN_EPI) { if (wr == 1) PG8_BAR; }
    }
    PG8_WAIT_V(0);
    if constexpr (!ALIGN_EPI) { if (wr == 0) PG8_BAR; }
    PG8_BAR;
    if constexpr (Epi::AFTER_DRAIN) { E.fused(acc, cur, wr, wc, fr, fq, lds, wid, lane); S.done(cur); }
#undef PG8_SA
#undef PG8_SB
#undef PG8_STAGE
#undef PG8_LDA
#undef PG8_LDB
#undef PG8_MMA
#undef PG8_WAIT_V
#undef PG8_WAIT_L
#undef PG8_BAR
#undef PG8_SCHED
}
}
#define LAS __attribute__((address_space(3)))
typedef unsigned short bf16_t;
typedef short bf16x8 __attribute__((ext_vector_type(8)));
typedef short s16x4 __attribute__((ext_vector_type(4)));
typedef float f32x4 __attribute__((ext_vector_type(4)));
typedef float f32x16 __attribute__((ext_vector_type(16)));
typedef unsigned u32x4 __attribute__((ext_vector_type(4)));
typedef unsigned u32x2 __attribute__((ext_vector_type(2)));

constexpr int DM = 1024, NB = 4, SEQ = 8192, DEPTH = 4, CTXL = 256;
constexpr int ML = NB * SEQ, MC = NB * CTXL, MT = ML + MC;
constexpr int INC = 2816, DFF = 2816, UPC = 5632;
constexpr int NMX_L = NB * 33, NMX_ALL = NB * 33 + 5;
constexpr float LOG2E = 1.4426950408889634f;

constexpr size_t MiB = 1u << 20;
constexpr size_t WS_MOD = 1 * MiB;
constexpr size_t WS_MODP = 2 * MiB;
constexpr size_t WS_TAB = 10 * MiB;
constexpr size_t WS_XC = 11 * MiB;
constexpr size_t WS_W = 16 * MiB;
constexpr size_t W_LAYER = 24 * MiB, W_OUT_OFF = (size_t)2816 * 1024 * 2, W_UP_OFF = W_OUT_OFF + (size_t)1024 * 1024 * 2, W_DN_OFF = W_UP_OFF + (size_t)5632 * 1024 * 2;
constexpr size_t WS_XN = 112 * MiB;
constexpr size_t WS_O = 182 * MiB;
constexpr size_t WS_H = 248 * MiB;
constexpr size_t WS_END = WS_H + (size_t)MT * 2816 * 2;
static_assert(W_DN_OFF + (size_t)1024 * 2816 * 2 <= W_LAYER, "weights per layer");
static_assert(WS_XN + (size_t)NMX_ALL * 256 * 1024 * 2 <= WS_O && WS_O + (size_t)MT * 1024 * 2 <= WS_H && WS_END <= 512 * MiB, "ws map");

constexpr int RING_BYTES = 135168;
constexpr int LDS_BYTES = 147456;

__device__ __forceinline__ unsigned pkbf(float lo, float hi) { return pg8::cvt_pk_bf16(lo, hi); }
__device__ __forceinline__ float bflo(unsigned w) { return __uint_as_float(w << 16); }
__device__ __forceinline__ float bfhi(unsigned w) { return __uint_as_float(w & 0xffff0000u); }
__device__ __forceinline__ float dpp_add(float v, const int ctrl_sel) {
    int m;
    if (ctrl_sel == 0) m = __builtin_amdgcn_update_dpp(0, __float_as_int(v), 0xB1, 0xF, 0xF, true);
    else if (ctrl_sel == 1) m = __builtin_amdgcn_update_dpp(0, __float_as_int(v), 0x4E, 0xF, 0xF, true);
    else if (ctrl_sel == 2) m = __builtin_amdgcn_update_dpp(0, __float_as_int(v), 0x124, 0xF, 0xF, true);
    else m = __builtin_amdgcn_update_dpp(0, __float_as_int(v), 0x128, 0xF, 0xF, true);
    return v + __int_as_float(m);
}
__device__ __forceinline__ float wave_sum(float v, int lane) {
    v = dpp_add(v, 0); v = dpp_add(v, 1); v = dpp_add(v, 2); v = dpp_add(v, 3);
    v += __int_as_float(__builtin_amdgcn_ds_bpermute((lane ^ 16) << 2, __float_as_int(v)));
    auto rr = __builtin_amdgcn_permlane32_swap(__float_as_uint(v), __float_as_uint(v), false, false);
    return __uint_as_float(rr[0]) + __uint_as_float(rr[1]);
}
__device__ __forceinline__ float xhalf_max(float v) { auto rr = __builtin_amdgcn_permlane32_swap(__float_as_uint(v), __float_as_uint(v), false, false); return fmaxf(__uint_as_float(rr[0]), __uint_as_float(rr[1])); }
__device__ __forceinline__ float xhalf_sum(float v) { auto rr = __builtin_amdgcn_permlane32_swap(__float_as_uint(v), __float_as_uint(v), false, false); return __uint_as_float(rr[0]) + __uint_as_float(rr[1]); }

namespace att {
constexpr int KP = 144, VP = 136;
constexpr int L_KS = 0, L_VT = 64 * KP, L_RPB = L_VT + 64 * VP, L_END = L_RPB + 2048;
__device__ __forceinline__ int crow(int r, int h) { return (r & 3) + 8 * (r >> 2) + 4 * h; }

struct TileRegs { u32x4 k, v; };
__device__ __forceinline__ void tile_gload(TileRegs& R, const bf16_t* H, int krow, int kcol, int vcol, int tid) {
    const int key = tid >> 3, ch = tid & 7;
    const bf16_t* p = H + (size_t)(krow + key) * INC;
    R.k = *(const u32x4*)(p + kcol + 8 * ch); R.v = *(const u32x4*)(p + vcol + 8 * ch);
}
__device__ __forceinline__ void tile_swrite(const TileRegs& R, LAS unsigned char* lds, int tid) {
    const int key = tid >> 3, ch = tid & 7;
    *(LAS u32x4*)(lds + L_KS + key * KP + ch * 16) = R.k;
    LAS unsigned short* vt = (LAS unsigned short*)(lds + L_VT);
#pragma unroll
    for (int j = 0; j < 4; ++j) { const unsigned w = R.v[j]; vt[(8 * ch + 2 * j) * (VP / 2) + key] = (unsigned short)(w & 0xffffu); vt[(8 * ch + 2 * j + 1) * (VP / 2) + key] = (unsigned short)(w >> 16); }
}
template <int KS0, int NKS>
__device__ __forceinline__ f32x16 qk_block(const LAS unsigned char* lds, int kb, int r32, int hh, const bf16x8 (&qf)[4]) {
    f32x16 s = {0.f, 0.f, 0.f, 0.f, 0.f, 0.f, 0.f, 0.f, 0.f, 0.f, 0.f, 0.f, 0.f, 0.f, 0.f, 0.f};
#pragma unroll
    for (int ks = KS0; ks < KS0 + NKS; ++ks) {
        const bf16x8 kf = *(const LAS bf16x8*)(lds + L_KS + (kb * 32 + r32) * KP + ks * 32 + hh * 16);
        s = __builtin_amdgcn_mfma_f32_32x32x16_bf16(kf, qf[ks], s, 0, 0, 0);
    }
    return s;
}
__device__ __forceinline__ void softmax_pv(f32x16 (&s)[2], float& m, float& l, f32x16 (&O)[2], const LAS unsigned char* lds, int r32, int hh) {
    float mx = s[0][0];
#pragma unroll
    for (int r = 1; r < 16; ++r) mx = fmaxf(mx, s[0][r]);
#pragma unroll
    for (int r = 0; r < 16; ++r) mx = fmaxf(mx, s[1][r]);
    mx = xhalf_max(mx);
    __builtin_amdgcn_sched_barrier(0);
    const float mn = fmaxf(m, mx);
    const float alpha = __builtin_amdgcn_exp2f(m - mn);
    m = mn; l *= alpha;
#pragma unroll
    for (int r = 0; r < 16; ++r) { O[0][r] *= alpha; O[1][r] *= alpha; }
    float ps = 0.f;
#pragma unroll
    for (int kb = 0; kb < 2; ++kb)
#pragma unroll
        for (int r = 0; r < 16; ++r) { const float p = __builtin_amdgcn_exp2f(s[kb][r] - mn); s[kb][r] = p; ps += p; }
    l += ps;
    __builtin_amdgcn_sched_barrier(0);
#pragma unroll
    for (int kb = 0; kb < 2; ++kb)
#pragma unroll
        for (int sk = 0; sk < 2; ++sk) {
            __builtin_amdgcn_sched_barrier(0);
            u32x4 pw; pw.x = pkbf(s[kb][8 * sk + 0], s[kb][8 * sk + 1]); pw.y = pkbf(s[kb][8 * sk + 2], s[kb][8 * sk + 3]);
            pw.z = pkbf(s[kb][8 * sk + 4], s[kb][8 * sk + 5]); pw.w = pkbf(s[kb][8 * sk + 6], s[kb][8 * sk + 7]);
            const bf16x8 pf = __builtin_bit_cast(bf16x8, pw);
#pragma unroll
            for (int dvb = 0; dvb < 2; ++dvb) {
                const LAS unsigned char* a = lds + L_VT + (dvb * 32 + r32) * VP + (kb * 32 + 16 * sk + 4 * hh) * 2;
                const s16x4 lo = *(const LAS s16x4*)a, hi = *(const LAS s16x4*)(a + 16);
                const bf16x8 vf = {lo[0], lo[1], lo[2], lo[3], hi[0], hi[1], hi[2], hi[3]};
                O[dvb] = __builtin_amdgcn_mfma_f32_32x32x16_bf16(vf, pf, O[dvb], 0, 0, 0);
            }
        }
}
__device__ __forceinline__ void store_o(const f32x16 (&o)[2], bf16_t* orow, int hh) {
#pragma unroll
    for (int dvb = 0; dvb < 2; ++dvb)
#pragma unroll
        for (int g = 0; g < 4; ++g) {
            u32x2 w; w.x = pkbf(o[dvb][4 * g], o[dvb][4 * g + 1]); w.y = pkbf(o[dvb][4 * g + 2], o[dvb][4 * g + 3]);
            *(u32x2*)(orow + dvb * 32 + 8 * g + 4 * hh) = w;
        }
}

__device__ __forceinline__ void unit_A_safe(const bool CTXQ, LAS unsigned char* lds, const bf16_t* H, bf16_t* Ob, int b, int h, int qb, float lam, float ofac, const float* subw) {
    const int tid = pg8_ltid(), lane = tid & 63, r32 = lane & 31, hh = lane >> 5, wid = tid >> 6;
    const int qrow = CTXQ ? (ML + b * CTXL + wid * 32 + r32) : (b * SEQ + qb * 256 + wid * 32 + r32);
    const int qcol = h * 64, kcol = 256 + h * 64, vcol = 512 + h * 64;
    bf16x8 qf[4];
#pragma unroll
    for (int ks = 0; ks < 4; ++ks) qf[ks] = *(const bf16x8*)(H + (size_t)qrow * INC + qcol + 16 * ks + 8 * hh);
    const int NT = CTXQ ? 4 : 132;
    f32x16 O1[2], O2[2];
#pragma unroll
    for (int r = 0; r < 16; ++r) { O1[0][r] = 0.f; O1[1][r] = 0.f; O2[0][r] = 0.f; O2[1][r] = 0.f; }
    float m1 = -INFINITY, m2 = -INFINITY, l1 = 0.f, l2 = 0.f;
    TileRegs R;
    tile_gload(R, H, CTXQ ? (ML + b * CTXL) : (b * SEQ), kcol, vcol, tid);
    for (int t = 0; t < NT; ++t) {
        __syncthreads();
        tile_swrite(R, lds, tid);
        __syncthreads();
        if (t + 1 < NT) { const int tn = t + 1; const int krow = CTXQ ? (ML + b * CTXL + 64 * tn) : (tn < 128 ? b * SEQ + 64 * tn : ML + b * CTXL + 64 * (tn - 128)); tile_gload(R, H, krow, kcol, vcol, tid); }
        { f32x16 s[2]; s[0] = qk_block<0, 2>(lds, 0, r32, hh, qf); s[1] = qk_block<0, 2>(lds, 1, r32, hh, qf); softmax_pv(s, m1, l1, O1, lds, r32, hh); }
        __builtin_amdgcn_sched_barrier(0);
        { f32x16 s[2]; s[0] = qk_block<2, 2>(lds, 0, r32, hh, qf); s[1] = qk_block<2, 2>(lds, 1, r32, hh, qf); softmax_pv(s, m2, l2, O2, lds, r32, hh); }
        __builtin_amdgcn_sched_barrier(0);
    }
    l1 = xhalf_sum(l1); l2 = xhalf_sum(l2);
    const float i1 = 1.f / l1, i2 = lam / l2;
    float ss = 0.f;
#pragma unroll
    for (int dvb = 0; dvb < 2; ++dvb)
#pragma unroll
        for (int r = 0; r < 16; ++r) { const float o = O1[dvb][r] * i1 - O2[dvb][r] * i2; O1[dvb][r] = o; ss += o * o; }
    ss = xhalf_sum(ss);
    float li_ = ofac; asm volatile("" : "+s"(li_));
    const float rn = rsqrtf(ss * (1.f / 64.f) + 1e-6f) * (1.f - li_);
#pragma unroll
    for (int dvb = 0; dvb < 2; ++dvb)
#pragma unroll
        for (int g = 0; g < 4; ++g) {
            const f32x4 w = *(const f32x4*)(subw + dvb * 32 + 8 * g + 4 * hh);
#pragma unroll
            for (int e = 0; e < 4; ++e) O1[dvb][4 * g + e] *= rn * w[e];
        }
    store_o(O1, Ob + (size_t)qrow * DM + h * 64, hh);
}


constexpr int A_KP = 144, A_VP = 192, A_VOFF = 64 * A_KP, A_BUF = A_VOFF + 64 * A_VP;
constexpr float ATHR = 10.f;
typedef short v4i16_t __attribute__((ext_vector_type(4)));
__device__ __forceinline__ s16x4 vtr(const LAS unsigned char* p) { return __builtin_bit_cast(s16x4, __builtin_amdgcn_ds_read_tr16_b64_v4i16((LAS v4i16_t*)p)); }
__device__ __forceinline__ void tileA_swrite(const TileRegs& R, LAS unsigned char* buf, int tid) {
    const int key = tid >> 3, ch = tid & 7;
    *(LAS u32x4*)(buf + key * A_KP + ch * 16) = R.k;
    *(LAS u32x4*)(buf + A_VOFF + key * A_VP + ch * 16) = R.v;
}
__device__ __forceinline__ float max16(const f32x16& s) {
    float a = fmaxf(fmaxf(s[0], s[1]), s[2]), b = fmaxf(fmaxf(s[3], s[4]), s[5]), c = fmaxf(fmaxf(s[6], s[7]), s[8]), d = fmaxf(fmaxf(s[9], s[10]), s[11]);
    a = fmaxf(fmaxf(a, s[12]), s[13]); b = fmaxf(fmaxf(b, s[14]), s[15]);
    return fmaxf(fmaxf(a, b), fmaxf(c, d));
}
__device__ __forceinline__ float expsum16(f32x16& s) {
    float a = 0.f, b = 0.f, c = 0.f, d = 0.f;
#pragma unroll
    for (int r = 0; r < 16; r += 4) {
        s[r] = __builtin_amdgcn_exp2f(s[r]); s[r + 1] = __builtin_amdgcn_exp2f(s[r + 1]); s[r + 2] = __builtin_amdgcn_exp2f(s[r + 2]); s[r + 3] = __builtin_amdgcn_exp2f(s[r + 3]);
        a += s[r]; b += s[r + 1]; c += s[r + 2]; d += s[r + 3];
    }
    return (a + b) + (c + d);
}
__device__ __forceinline__ bf16x8 packp(const f32x16& s, int sk) {
    u32x4 pw; pw.x = pkbf(s[8 * sk + 0], s[8 * sk + 1]); pw.y = pkbf(s[8 * sk + 2], s[8 * sk + 3]); pw.z = pkbf(s[8 * sk + 4], s[8 * sk + 5]); pw.w = pkbf(s[8 * sk + 6], s[8 * sk + 7]);
    return __builtin_bit_cast(bf16x8, pw);
}
__device__ __forceinline__ void exp16(f32x16& s) {
#pragma unroll
    for (int r = 0; r < 16; ++r) s[r] = __builtin_amdgcn_exp2f(s[r]);
}
constexpr float AREF = 20.f, AGUARD = 60.f;
#ifndef SGB_V
#define SGB_V 5
#endif
template <bool HAVE>
__device__ __forceinline__ void stepA(bf16x8 (&pc)[2][2], const LAS unsigned char* kbuf, int kb, const LAS unsigned char* vb, const bf16x8 (&qv)[4], int r32, int hh,
                                      float mref1, float mref2, f32x16 (&O1)[2], f32x16 (&O2)[2], f32x16& L1, f32x16& L2, const bf16x8& ones) {
    const LAS unsigned char* kp = kbuf + (kb * 32 + r32) * A_KP + hh * 16;
    const bf16x8 k0 = *(const LAS bf16x8*)(kp), k1 = *(const LAS bf16x8*)(kp + 32), k2 = *(const LAS bf16x8*)(kp + 64), k3 = *(const LAS bf16x8*)(kp + 96);
    const bf16x8 q0 = qv[0], q1 = qv[1], q2 = qv[2], q3 = qv[3];
    bf16x8 vf[2][2];
#pragma unroll
    for (int sk = 0; sk < 2; ++sk)
#pragma unroll
        for (int dvb = 0; dvb < 2; ++dvb) {
            const LAS unsigned char* a = vb + 16 * sk * A_VP + dvb * 64;
            const s16x4 lo = vtr(a), hi = vtr(a + 8 * A_VP);
            vf[sk][dvb] = (bf16x8){lo[0], lo[1], lo[2], lo[3], hi[0], hi[1], hi[2], hi[3]};
        }
    const f32x16 z = {0.f, 0.f, 0.f, 0.f, 0.f, 0.f, 0.f, 0.f, 0.f, 0.f, 0.f, 0.f, 0.f, 0.f, 0.f, 0.f};
    f32x16 s1 = __builtin_amdgcn_mfma_f32_32x32x16_bf16(k0, q0, z, 0, 0, 0);
    f32x16 s2 = __builtin_amdgcn_mfma_f32_32x32x16_bf16(k2, q2, z, 0, 0, 0);
    s1 = __builtin_amdgcn_mfma_f32_32x32x16_bf16(k1, q1, s1, 0, 0, 0);
    s2 = __builtin_amdgcn_mfma_f32_32x32x16_bf16(k3, q3, s2, 0, 0, 0);
#pragma unroll
    for (int sk = 0; sk < 2; ++sk) {
        L1 = __builtin_amdgcn_mfma_f32_32x32x16_bf16(ones, pc[0][sk], L1, 0, 0, 0);
        L2 = __builtin_amdgcn_mfma_f32_32x32x16_bf16(ones, pc[1][sk], L2, 0, 0, 0);
#pragma unroll
        for (int dvb = 0; dvb < 2; ++dvb) {
            O1[dvb] = __builtin_amdgcn_mfma_f32_32x32x16_bf16(vf[sk][dvb], pc[0][sk], O1[dvb], 0, 0, 0);
            O2[dvb] = __builtin_amdgcn_mfma_f32_32x32x16_bf16(vf[sk][dvb], pc[1][sk], O2[dvb], 0, 0, 0);
        }
    }
    if (HAVE) {
#pragma unroll
        for (int r = 0; r < 16; ++r) { s1[r] -= mref1; s2[r] -= mref2; }
    }
    exp16(s1); exp16(s2);
    bf16x8 pn[2][2];
    pn[0][0] = packp(s1, 0); pn[0][1] = packp(s1, 1); pn[1][0] = packp(s2, 0); pn[1][1] = packp(s2, 1);
#if 0
    __builtin_amdgcn_sched_group_barrier(0x008, 6, 0);
#pragma unroll
    for (int i = 0; i < 10; ++i) { __builtin_amdgcn_sched_group_barrier(0x002, SGB_V, 0); __builtin_amdgcn_sched_group_barrier(0x008, 1, 0); }
    __builtin_amdgcn_sched_group_barrier(0x002, 48, 0);
#endif
    pc[0][0] = pn[0][0]; pc[0][1] = pn[0][1]; pc[1][0] = pn[1][0]; pc[1][1] = pn[1][1];
}
__device__ __forceinline__ void unit_A(const bool CTXQ, LAS unsigned char* lds, const bf16_t* H, bf16_t* Ob, int b, int h, int qb, float lam, float ofac, const float* subw) {
    const int tid = pg8_ltid(), lane = tid & 63, r32 = lane & 31, hh = lane >> 5, wid = tid >> 6;
    const int qrow = CTXQ ? (ML + b * CTXL + wid * 32 + r32) : (b * SEQ + qb * 256 + wid * 32 + r32);
    const int qcol = h * 64, kcol = 256 + h * 64, vcol = 512 + h * 64;
    const int NT = CTXQ ? 4 : 132;
    f32x16 O1[2], O2[2], L1, L2;
#pragma unroll
    for (int r = 0; r < 16; ++r) { O1[0][r] = 0.f; O1[1][r] = 0.f; O2[0][r] = 0.f; O2[1][r] = 0.f; L1[r] = 0.f; L2[r] = 0.f; }
    const bf16x8 ones = {0x3F80, 0x3F80, 0x3F80, 0x3F80, 0x3F80, 0x3F80, 0x3F80, 0x3F80};
    const int voff = A_VOFF + (4 * hh + ((lane & 15) >> 2)) * A_VP + (((lane >> 4) & 1) * 16 + (lane & 3) * 4) * 2;
    const int krow0 = CTXQ ? (ML + b * CTXL) : (b * SEQ);
    LAS unsigned char* qs = lds + 3 * A_BUF + (wid * 32 + r32) * A_KP + hh * 16;
    volatile LAS unsigned* flag = (volatile LAS unsigned*)(lds + RING_BYTES + 128);
    TileRegs R;
    __syncthreads();
    if (tid == 0) *flag = 0u;
#pragma unroll
    for (int ks = 0; ks < 4; ++ks) *(LAS bf16x8*)(qs + ks * 32) = *(const bf16x8*)(H + (size_t)qrow * INC + qcol + 16 * ks + 8 * hh);
    tile_gload(R, H, krow0, kcol, vcol, tid);       tileA_swrite(R, lds, tid);
    tile_gload(R, H, krow0 + 64, kcol, vcol, tid);  tileA_swrite(R, lds + A_BUF, tid);
    tile_gload(R, H, krow0 + 128, kcol, vcol, tid);
    __syncthreads();
    bf16x8 pc[2][2];
    {
        const LAS unsigned char* kp = lds + r32 * A_KP + hh * 16;
        const f32x16 z = {0.f, 0.f, 0.f, 0.f, 0.f, 0.f, 0.f, 0.f, 0.f, 0.f, 0.f, 0.f, 0.f, 0.f, 0.f, 0.f};
        f32x16 sa1 = __builtin_amdgcn_mfma_f32_32x32x16_bf16(*(const LAS bf16x8*)(kp), *(const LAS bf16x8*)(qs), z, 0, 0, 0);
        sa1 = __builtin_amdgcn_mfma_f32_32x32x16_bf16(*(const LAS bf16x8*)(kp + 32), *(const LAS bf16x8*)(qs + 32), sa1, 0, 0, 0);
        f32x16 sa2 = __builtin_amdgcn_mfma_f32_32x32x16_bf16(*(const LAS bf16x8*)(kp + 64), *(const LAS bf16x8*)(qs + 64), z, 0, 0, 0);
        sa2 = __builtin_amdgcn_mfma_f32_32x32x16_bf16(*(const LAS bf16x8*)(kp + 96), *(const LAS bf16x8*)(qs + 96), sa2, 0, 0, 0);
        exp16(sa1); exp16(sa2);
        pc[0][0] = packp(sa1, 0); pc[0][1] = packp(sa1, 1); pc[1][0] = packp(sa2, 0); pc[1][1] = packp(sa2, 1);
    }
    bf16x8 qv[4];
#pragma unroll
    for (int ks = 0; ks < 4; ++ks) qv[ks] = *(const LAS bf16x8*)(qs + ks * 32);
    int bc = 0, t = 0;
#define UNITA_STAGE() \
        const int bn = (bc == 2 * A_BUF) ? 0 : bc + A_BUF, bw = (bn == 2 * A_BUF) ? 0 : bn + A_BUF; \
        if (t + 2 < NT) { \
            tileA_swrite(R, lds + bw, tid); \
            if (t + 3 < NT) { const int tn = t + 3; const int krow = CTXQ ? (krow0 + 64 * tn) : (tn < 128 ? b * SEQ + 64 * tn : ML + b * CTXL + 64 * (tn - 128)); tile_gload(R, H, krow, kcol, vcol, tid); } \
        }
#define UNITA_GUARD() (__any((L1[0] > 1.152921504606846976e18f) || (L2[0] > 1.152921504606846976e18f)) != 0)
    {
        for (; t < NT; ++t) {
            UNITA_STAGE()
            stepA<false>(pc, lds + bc, 1, lds + bc + voff, qv, r32, hh, 0.f, 0.f, O1, O2, L1, L2, ones);
            stepA<false>(pc, lds + bn, 0, lds + bc + voff + 32 * A_VP, qv, r32, hh, 0.f, 0.f, O1, O2, L1, L2, ones);
            __syncthreads();
            bc = bn;
        }
    }
#undef UNITA_STAGE
#undef UNITA_GUARD
    if (__any(!((L1[0] > 1e-30f) && (L1[0] < 1e30f) && (L2[0] > 1e-30f) && (L2[0] < 1e30f))) != 0) *flag = 1u;
    __syncthreads();
    if (*flag != 0u) { unit_A_safe(CTXQ, lds, H, Ob, b, h, qb, lam, ofac, subw); return; }
    const float i1 = 1.f / L1[0], i2 = lam / L2[0];
    float ss = 0.f;
#pragma unroll
    for (int dvb = 0; dvb < 2; ++dvb)
#pragma unroll
        for (int r = 0; r < 16; ++r) { const float o = O1[dvb][r] * i1 - O2[dvb][r] * i2; O1[dvb][r] = o; ss += o * o; }
    ss = xhalf_sum(ss);
    float li_ = ofac; asm volatile("" : "+s"(li_));
    const float rn = rsqrtf(ss * (1.f / 64.f) + 1e-6f) * (1.f - li_);
#pragma unroll
    for (int dvb = 0; dvb < 2; ++dvb)
#pragma unroll
        for (int g = 0; g < 4; ++g) {
            const f32x4 w = *(const f32x4*)(subw + dvb * 32 + 8 * g + 4 * hh);
#pragma unroll
            for (int e = 0; e < 4; ++e) O1[dvb][4 * g + e] *= rn * w[e];
        }
    store_o(O1, Ob + (size_t)qrow * DM + h * 64, hh);
}

template <int MODE> __device__ __forceinline__ int tile_row_f(int t, int b, int lo, int nloc) {
    if (MODE == 1) return (t < nloc) ? (b * SEQ + 64 * (lo + t)) : (ML + b * CTXL + 64 * (t - nloc));
    if (MODE == 2) return (t < 4) ? (ML + b * CTXL + 64 * t) : (b * SEQ + 64 * (lo + t - 4));
    return ML + b * CTXL + 64 * t;
}
__device__ __forceinline__ int tile_row_r(int MODE, int t, int b, int lo, int nloc) {
    if (MODE == 1) return (t < nloc) ? (b * SEQ + 64 * (lo + t)) : (ML + b * CTXL + 64 * (t - nloc));
    if (MODE == 2) return (t < 4) ? (ML + b * CTXL + 64 * t) : (b * SEQ + 64 * (lo + t - 4));
    return ML + b * CTXL + 64 * t;
}
__device__ __forceinline__ void unit_BC(const int MODE, LAS unsigned char* lds, const bf16_t* H, bf16_t* Ob, int b, int hd, int blk, const float* sink_l, const float* rpb_l) {
    const int tid = pg8_ltid(), lane = tid & 63, r32 = lane & 31, hh = lane >> 5, wid = tid >> 6;
    int qrow, qcol, kcol, vcol, ocol, qpos = 0, r_w = 0, qc = 0, lo = 0, nloc = 0;
    float m = -INFINITY, l = 0.f;
    if (MODE == 1) {
        const int g = wid >> 2, head = hd * 2 + g; qpos = 128 * blk + 32 * (wid & 3) + r32; qrow = b * SEQ + qpos;
        qcol = 768 + head * 64; kcol = 1024 + hd * 64; vcol = 1152 + hd * 64; ocol = 256 + head * 64;
        lo = 2 * blk - 2; if (lo < 0) lo = 0; int hi = 2 * blk + 3; if (hi > 127) hi = 127; nloc = hi - lo + 1;
        m = sink_l[head] * LOG2E; l = (hh == 0) ? 1.f : 0.f;
    } else if (MODE == 3) {
        const int head = hd * 2 + blk; qrow = ML + b * CTXL + wid * 32 + r32;
        qcol = 768 + head * 64; kcol = 1024 + hd * 64; vcol = 1152 + hd * 64; ocol = 256 + head * 64;
        m = sink_l[head] * LOG2E; l = (hh == 0) ? 1.f : 0.f;
    } else if (MODE == 2) {
        r_w = 4 * blk + (wid >> 1); qc = 32 * (wid & 1) + r32; qrow = b * SEQ + r_w * 64 + qc;
        qcol = 1280 + hd * 64; kcol = 1536 + hd * 64; vcol = 1792 + hd * 64; ocol = 512 + hd * 64;
        int a0 = 4 * blk - 4; if (a0 < 0) a0 = 0; if (a0 > 120) a0 = 120; int a3 = 4 * blk + 3 - 4; if (a3 < 0) a3 = 0; if (a3 > 120) a3 = 120;
        lo = a0; nloc = a3 + 7 - a0 + 1;
    } else {
        qrow = ML + b * CTXL + wid * 32 + r32;
        qcol = 1280 + hd * 64; kcol = 1536 + hd * 64; vcol = 1792 + hd * 64; ocol = 512 + hd * 64;
    }
    bf16x8 qf[4];
#pragma unroll
    for (int ks = 0; ks < 4; ++ks) qf[ks] = *(const bf16x8*)(H + (size_t)qrow * INC + qcol + 16 * ks + 8 * hh);
    f32x16 O[2];
#pragma unroll
    for (int r = 0; r < 16; ++r) { O[0][r] = 0.f; O[1][r] = 0.f; }
    const int NT = 4 + nloc;
    int rs = 0;
    if (MODE == 2) { rs = r_w - 4; if (rs < 0) rs = 0; if (rs > 120) rs = 120; }
    const LAS float* rpbs = (const LAS float*)(lds + L_RPB);
    TileRegs R;
    tile_gload(R, H, tile_row_r(MODE, 0, b, lo, nloc), kcol, vcol, tid);
    for (int t = 0; t < NT; ++t) {
        __syncthreads();
        tile_swrite(R, lds, tid);
        if (MODE == 2 && t == 0) { for (int i = tid; i < 465; i += 512) ((LAS float*)(lds + L_RPB))[i] = rpb_l[hd * 465 + i] * LOG2E; }
        __syncthreads();
        if (t + 1 < NT) tile_gload(R, H, tile_row_r(MODE, t + 1, b, lo, nloc), kcol, vcol, tid);
        bool active = true; int kr = 0;
        if (MODE == 2 && t >= 4) { kr = lo + t - 4; active = (kr >= rs) && (kr < rs + 8); }
        if (active) {
            f32x16 s[2]; s[0] = qk_block<0, 4>(lds, 0, r32, hh, qf); s[1] = qk_block<0, 4>(lds, 1, r32, hh, qf);
            if (MODE == 1 && t < nloc) {
                const int kbase = 64 * (lo + t) - qpos;
#pragma unroll
                for (int kb = 0; kb < 2; ++kb)
#pragma unroll
                    for (int r = 0; r < 16; ++r) { const int d = kbase + kb * 32 + crow(r, hh); if (d > 128 || d < -128) s[kb][r] = -INFINITY; }
            }
            if (MODE == 2 && t >= 4) {
                int cs = qc - 8; if (cs < 0) cs = 0; if (cs > 48) cs = 48;
                const int bbase = (kr - r_w + 7) * 31 + 15 - qc;
#pragma unroll
                for (int kb = 0; kb < 2; ++kb)
#pragma unroll
                    for (int r = 0; r < 16; ++r) {
                        const int kc = kb * 32 + crow(r, hh);
                        const bool ok = (kc >= cs) && (kc < cs + 16);
                        int bi = bbase + kc; bi = ok ? bi : 0;
                        const float bias = rpbs[bi];
                        s[kb][r] = ok ? (s[kb][r] + bias) : -INFINITY;
                    }
            }
            softmax_pv(s, m, l, O, lds, r32, hh);
        }
    }
    l = xhalf_sum(l);
    const float il = 1.f / l;
#pragma unroll
    for (int r = 0; r < 16; ++r) { O[0][r] *= il; O[1][r] *= il; }
    store_o(O, Ob + (size_t)qrow * DM + ocol, hh);
}

template <int MODE>
__device__ __forceinline__ void bcf_compute(const LAS unsigned char* cur, int t, int nloc, int lo, int qpos, int kr, int r_w, int qc, const bf16x8 (&qf)[4], f32x16 (&O)[2], f32x16& L,
                                            const bf16x8& ones, const LAS float* rpbs, int voff, int r32, int hh) {
    f32x16 s[2];
    const f32x16 z = {0.f, 0.f, 0.f, 0.f, 0.f, 0.f, 0.f, 0.f, 0.f, 0.f, 0.f, 0.f, 0.f, 0.f, 0.f, 0.f};
#pragma unroll
    for (int kb = 0; kb < 2; ++kb) {
        const LAS unsigned char* kp = cur + (kb * 32 + r32) * A_KP + hh * 16;
        s[kb] = __builtin_amdgcn_mfma_f32_32x32x16_bf16(*(const LAS bf16x8*)(kp), qf[0], z, 0, 0, 0);
        s[kb] = __builtin_amdgcn_mfma_f32_32x32x16_bf16(*(const LAS bf16x8*)(kp + 32), qf[1], s[kb], 0, 0, 0);
        s[kb] = __builtin_amdgcn_mfma_f32_32x32x16_bf16(*(const LAS bf16x8*)(kp + 64), qf[2], s[kb], 0, 0, 0);
        s[kb] = __builtin_amdgcn_mfma_f32_32x32x16_bf16(*(const LAS bf16x8*)(kp + 96), qf[3], s[kb], 0, 0, 0);
    }
    if (MODE == 1 && t < nloc) {
        const int kbase = 64 * (lo + t) - qpos;
#pragma unroll
        for (int kb = 0; kb < 2; ++kb)
#pragma unroll
            for (int r = 0; r < 16; ++r) { const int d = kbase + kb * 32 + crow(r, hh); if (d > 128 || d < -128) s[kb][r] = -INFINITY; }
    }
    if (MODE == 2 && t >= 4) {
        int cs = qc - 8; if (cs < 0) cs = 0; if (cs > 48) cs = 48;
        const int bbase = (kr - r_w + 7) * 31 + 15 - qc;
#pragma unroll
        for (int kb = 0; kb < 2; ++kb)
#pragma unroll
            for (int r = 0; r < 16; ++r) {
                const int kc = kb * 32 + crow(r, hh);
                const bool ok = (kc >= cs) && (kc < cs + 16);
                int bi = bbase + kc; bi = ok ? bi : 0;
                const float bias = rpbs[bi];
                s[kb][r] = ok ? (s[kb][r] + bias) : -INFINITY;
            }
    }
#pragma unroll
    for (int kb = 0; kb < 2; ++kb) {
        exp16(s[kb]);
#pragma unroll
        for (int sk = 0; sk < 2; ++sk) {
            const bf16x8 p = packp(s[kb], sk);
            L = __builtin_amdgcn_mfma_f32_32x32x16_bf16(ones, p, L, 0, 0, 0);
#pragma unroll
            for (int dvb = 0; dvb < 2; ++dvb) {
                const LAS unsigned char* a = cur + voff + (kb * 32 + 16 * sk) * A_VP + dvb * 64;
                const s16x4 vlo = vtr(a), vhi = vtr(a + 8 * A_VP);
                const bf16x8 vf = {vlo[0], vlo[1], vlo[2], vlo[3], vhi[0], vhi[1], vhi[2], vhi[3]};
                O[dvb] = __builtin_amdgcn_mfma_f32_32x32x16_bf16(vf, p, O[dvb], 0, 0, 0);
            }
        }
    }
}
template <int MODE>
__device__ __forceinline__ bool unit_BC_fast(LAS unsigned char* lds, const bf16_t* H, bf16_t* Ob, int b, int hd, int blk, const float* sink_l, const float* rpb_l) {
    const int tid = pg8_ltid(), lane = tid & 63, r32 = lane & 31, hh = lane >> 5, wid = tid >> 6;
    int qrow, qcol, kcol, vcol, ocol, qpos = 0, r_w = 0, qc = 0, lo = 0, nloc = 0;
    float linit = 0.f;
    if (MODE == 1) {
        const int g = wid >> 2, head = hd * 2 + g; qpos = 128 * blk + 32 * (wid & 3) + r32; qrow = b * SEQ + qpos;
        qcol = 768 + head * 64; kcol = 1024 + hd * 64; vcol = 1152 + hd * 64; ocol = 256 + head * 64;
        lo = 2 * blk - 2; if (lo < 0) lo = 0; int hi = 2 * blk + 3; if (hi > 127) hi = 127; nloc = hi - lo + 1;
        linit = __builtin_amdgcn_exp2f(sink_l[head] * LOG2E);
    } else if (MODE == 3) {
        const int head = hd * 2 + blk; qrow = ML + b * CTXL + wid * 32 + r32;
        qcol = 768 + head * 64; kcol = 1024 + hd * 64; vcol = 1152 + hd * 64; ocol = 256 + head * 64;
        linit = __builtin_amdgcn_exp2f(sink_l[head] * LOG2E);
    } else if (MODE == 2) {
        r_w = 4 * blk + (wid >> 1); qc = 32 * (wid & 1) + r32; qrow = b * SEQ + r_w * 64 + qc;
        qcol = 1280 + hd * 64; kcol = 1536 + hd * 64; vcol = 1792 + hd * 64; ocol = 512 + hd * 64;
        int a0 = 4 * blk - 4; if (a0 < 0) a0 = 0; if (a0 > 120) a0 = 120; int a3 = 4 * blk + 3 - 4; if (a3 < 0) a3 = 0; if (a3 > 120) a3 = 120;
        lo = a0; nloc = a3 + 7 - a0 + 1;
    } else {
        qrow = ML + b * CTXL + wid * 32 + r32;
        qcol = 1280 + hd * 64; kcol = 1536 + hd * 64; vcol = 1792 + hd * 64; ocol = 512 + hd * 64;
    }
    bf16x8 qf[4];
#pragma unroll
    for (int ks = 0; ks < 4; ++ks) qf[ks] = *(const bf16x8*)(H + (size_t)qrow * INC + qcol + 16 * ks + 8 * hh);
    f32x16 O[2], L;
#pragma unroll
    for (int r = 0; r < 16; ++r) { O[0][r] = 0.f; O[1][r] = 0.f; L[r] = linit; }
    const bf16x8 ones = {0x3F80, 0x3F80, 0x3F80, 0x3F80, 0x3F80, 0x3F80, 0x3F80, 0x3F80};
    const int NT = 4 + nloc;
    int rs = 0;
    if (MODE == 2) { rs = r_w - 4; if (rs < 0) rs = 0; if (rs > 120) rs = 120; }
    const int voff = A_VOFF + (4 * hh + ((lane & 15) >> 2)) * A_VP + (((lane >> 4) & 1) * 16 + (lane & 3) * 4) * 2;
    LAS float* rpbs = (LAS float*)(lds + 2 * A_BUF);
    volatile LAS unsigned* flag = (volatile LAS unsigned*)(lds + RING_BYTES + 128);
    TileRegs Ra, Rb;
    __syncthreads();
    if (tid == 0) *flag = 0u;
    if (MODE == 2) { for (int i = tid; i < 465; i += 512) rpbs[i] = rpb_l[hd * 465 + i] * LOG2E; }
    tile_gload(Ra, H, tile_row_f<MODE>(0, b, lo, nloc), kcol, vcol, tid);
    tileA_swrite(Ra, lds, tid);
    tile_gload(Rb, H, tile_row_f<MODE>(1, b, lo, nloc), kcol, vcol, tid);
    tile_gload(Ra, H, tile_row_f<MODE>(2, b, lo, nloc), kcol, vcol, tid);
    __syncthreads();
#define BCF_TILE(T, RS) { \
        const int t = (T); \
        const LAS unsigned char* cur = lds + (t & 1) * A_BUF; \
        if (t + 1 < NT) { \
            tileA_swrite(RS, lds + ((t + 1) & 1) * A_BUF, tid); \
            if (t + 3 < NT) tile_gload(RS, H, tile_row_f<MODE>(t + 3, b, lo, nloc), kcol, vcol, tid); \
        } \
        bool active = true; int kr = 0; \
        if (MODE == 2 && t >= 4) { kr = lo + t - 4; active = (kr >= rs) && (kr < rs + 8); } \
        if (active) bcf_compute<MODE>(cur, t, nloc, lo, qpos, kr, r_w, qc, qf, O, L, ones, rpbs, voff, r32, hh); \
        __syncthreads(); }
    for (int t2 = 0; t2 < NT; t2 += 2) {
        BCF_TILE(t2, Rb)
        if (t2 + 1 < NT) BCF_TILE(t2 + 1, Ra)
    }
#undef BCF_TILE
    const float lsum = L[0];
    if (__any(!((lsum > 1e-30f) && (lsum < 1e30f))) != 0) *flag = 1u;
    __syncthreads();
    if (*flag != 0u) return true;
    const float il = 1.f / lsum;
#pragma unroll
    for (int r = 0; r < 16; ++r) { O[0][r] *= il; O[1][r] *= il; }
    store_o(O, Ob + (size_t)qrow * DM + ocol, hh);
    return false;
}
}
__device__ __forceinline__ float silu_f(float v) { return v / (1.f + __expf(-v)); }

__device__ __forceinline__ int wrow_map(int type, int n) {
    if (type == 1) {
        const bool ropeA = n < 512, ropeB = (n >= 768 && n < 1152);
        if (!ropeA && !ropeB) return n;
        int p = n & 31;
        if (ropeA) { const int blk = p >> 3; p = (blk == 1) ? p + 8 : ((blk == 2) ? p - 8 : p); }
        const int nn = p >> 4, r = p & 15;
        return (n & ~31) + 8 * (r >> 2) + 4 * nn + (r & 3);
    }
    if (type == 2) { const int half = (n >= 2816) ? 1 : 0; const int j = n - half * 2816; return (j >> 7) * 256 + half * 128 + (j & 127); }
    return n;
}
__device__ __forceinline__ void transpose_item(const float* W, int K, int N, bf16_t* WT, int type, LAS float* scr, int item, int lane) {
    const int nblk = N / 64, kb = item / nblk, nb = item - kb * nblk, k0 = 64 * kb, n0 = 64 * nb;
    const int lr = lane >> 4, lc = (lane & 15) * 4;
#pragma unroll 8
    for (int i = 0; i < 16; ++i) {
        const int kk = 4 * i + lr;
        const f32x4 v = *(const f32x4*)(W + (size_t)(k0 + kk) * N + n0 + lc);
        LAS float* d = scr + kk * 65 + lc; d[0] = v[0]; d[1] = v[1]; d[2] = v[2]; d[3] = v[3];
    }
    asm volatile("s_waitcnt lgkmcnt(0)" ::: "memory");
    const int c = lane & 7;
#pragma unroll
    for (int j = 0; j < 8; ++j) {
        const int n = (lane >> 3) + 8 * j; const LAS float* s = scr + (8 * c) * 65 + n;
        u32x4 o; o.x = pkbf(s[0 * 65], s[1 * 65]); o.y = pkbf(s[2 * 65], s[3 * 65]); o.z = pkbf(s[4 * 65], s[5 * 65]); o.w = pkbf(s[6 * 65], s[7 * 65]);
        *(u32x4*)(WT + (size_t)wrow_map(type, n0 + n) * K + k0 + 8 * c) = o;
    }
    asm volatile("s_waitcnt lgkmcnt(0)" ::: "memory");
}

__device__ __forceinline__ void sincos_f(float x, float& c, float& s) {
    const float k = rintf(x * 0.636619772f);
    float r = fmaf(-k, 1.57079625129699707031f, x); r = fmaf(-k, 7.54978941586159635335e-08f, r);
    const float r2 = r * r;
    const float sr = r * (1.f + r2 * (-1.f / 6 + r2 * (1.f / 120 + r2 * (-1.f / 5040 + r2 * (1.f / 362880)))));
    const float cr = 1.f + r2 * (-0.5f + r2 * (1.f / 24 + r2 * (-1.f / 720 + r2 * (1.f / 40320 + r2 * (-1.f / 3628800)))));
    const int q = ((int)k) & 3;
    s = (q == 0) ? sr : (q == 1) ? cr : (q == 2) ? -sr : -cr;
    c = (q == 0) ? cr : (q == 1) ? -sr : (q == 2) ? -cr : sr;
}

__device__ __forceinline__ void norm_mod_row(const float* src, const float* nw, const float* sh, const float* sc, bf16_t* dst, int lane, const float* slab = nullptr, int nslab = 0, float* xout = nullptr) {
    u32x2* o8 = (u32x2*)dst + lane;
    if (src == nullptr) {
#pragma unroll
        for (int j = 0; j < 4; ++j) o8[64 * j] = (u32x2){0u, 0u};
        return;
    }
    const f32x4* xr = (const f32x4*)src + lane;
    f32x4 v[4]; float s = 0.f;
#pragma unroll
    for (int j = 0; j < 4; ++j) v[j] = xr[64 * j];
    for (int p = 0; p < nslab; ++p) {
        const f32x4* sr = (const f32x4*)(slab + (size_t)p * 1024 * 1024) + lane;
#pragma unroll
        for (int j = 0; j < 4; ++j) v[j] += sr[64 * j];
    }
    if (xout != nullptr) {
#pragma unroll
        for (int j = 0; j < 4; ++j) ((f32x4*)xout + lane)[64 * j] = v[j];
    }
#pragma unroll
    for (int j = 0; j < 4; ++j) s += (v[j][0] * v[j][0] + v[j][1] * v[j][1]) + (v[j][2] * v[j][2] + v[j][3] * v[j][3]);
    const float rstd = rsqrtf(wave_sum(s, lane) * (1.f / 1024.f) + 1e-6f);
#pragma unroll
    for (int j = 0; j < 4; ++j) {
        const int k = 4 * (64 * j + lane);
        const f32x4 w = *(const f32x4*)(nw + k), a = *(const f32x4*)(sc + k), d = *(const f32x4*)(sh + k);
        f32x4 y;
#pragma unroll
        for (int e = 0; e < 4; ++e) y[e] = (v[j][e] * rstd * w[e]) * (1.f + a[e]) + d[e];
        u32x2 p; p.x = pkbf(y[0], y[1]); p.y = pkbf(y[2], y[3]);
        o8[64 * j] = p;
    }
}

#define XB_TMO      128
#define XB_XCNT(j)  (256  + 64 * (j))
#define XB_XSUB(j)  (1280 + 64 * (j))
#define XB_XGEN(j)  (2304 + 64 * (j))
#define XB_TOP      3328
#define XB_TOPGEN   3392
#define XCD_BAR_WORDS 3456
#define XB_SPIN_CAP (1u << 18)

__device__ __forceinline__ unsigned xb_ld(unsigned* p)              { return __hip_atomic_load(p, __ATOMIC_RELAXED, __HIP_MEMORY_SCOPE_AGENT); }
__device__ __forceinline__ unsigned xb_add(unsigned* p, unsigned v) { return __hip_atomic_fetch_add(p, v, __ATOMIC_RELAXED, __HIP_MEMORY_SCOPE_AGENT); }
__device__ __forceinline__ unsigned xb_xcc_id() { return (unsigned)__builtin_amdgcn_s_getreg((3 << 11) | 20) & 0xFu; }
#define XB_SPIN(cond, bar) do { unsigned _sp = 0; while (cond) { __builtin_amdgcn_s_sleep(1); \
    if ((++_sp & 255u) == 0u) { if (xb_ld(&(bar)[XB_TMO])) break; if (_sp > XB_SPIN_CAP) { atomicAdd(&(bar)[XB_TMO], 1u); break; } } } } while (0)

struct XcdBarrier {
    unsigned* bar; unsigned x;
    volatile LAS unsigned* st;
};

__device__ __forceinline__ XcdBarrier xcd_barrier_post(unsigned* bar, volatile LAS unsigned* st) {
    XcdBarrier b; b.bar = bar; b.x = xb_xcc_id(); b.st = st;
    if (threadIdx.x == 0) (void)xb_add(&bar[XB_XCNT(b.x)], 1u);
    return b;
}
__device__ __forceinline__ void xcd_barrier_complete(unsigned* bar, unsigned x, unsigned& nloc, unsigned& nx) {
    const unsigned G = gridDim.x * gridDim.y * gridDim.z;
    unsigned sum, cnt, mine, sp = 0u;
    for (;;) {
        sum = 0u; cnt = 0u; mine = 0u;
#pragma unroll
        for (unsigned j = 0; j < 16; ++j) { const unsigned c = xb_ld(&bar[XB_XCNT(j)]); sum += c; cnt += (c > 0u) ? 1u : 0u; mine = (j == x) ? c : mine; }
        if (sum == G) break;
        __builtin_amdgcn_s_sleep(1);
        if ((++sp & 255u) == 0u) { if (xb_ld(&bar[XB_TMO])) break; if (sp > XB_SPIN_CAP) { atomicAdd(&bar[XB_TMO], 1u); break; } }
    }
    nloc = mine > 0u ? mine : 1u; nx = cnt > 0u ? cnt : 1u;
}

__device__ __forceinline__ void xcd_barrier(const XcdBarrier& b) {
    asm volatile("s_waitcnt vmcnt(0)" ::: "memory");
    __syncthreads();
    if (threadIdx.x == 0) {
        unsigned* bar = b.bar;
        __builtin_amdgcn_s_waitcnt(0);
        unsigned nloc = b.st[0], nx = b.st[1];
        if (nloc == 0u) { xcd_barrier_complete(bar, b.x, nloc, nx); b.st[0] = nloc; b.st[1] = nx; }
        const unsigned old = xb_add(&bar[XB_XSUB(b.x)], 1u);
        const unsigned gen = old / nloc;
        if (old + 1u == (gen + 1u) * nloc) {
            __builtin_amdgcn_fence(__ATOMIC_RELEASE, "agent");
            asm volatile("s_waitcnt vmcnt(0)" ::: "memory");
            const unsigned og = xb_add(&bar[XB_TOP], 1u);
            const unsigned tg = og / nx;
            if (og + 1u == (tg + 1u) * nx) xb_add(&bar[XB_TOPGEN], 1u);
            else XB_SPIN(xb_ld(&bar[XB_TOPGEN]) == tg, bar);
            __builtin_amdgcn_fence(__ATOMIC_ACQUIRE, "agent");
            xb_add(&bar[XB_XGEN(b.x)], 1u);
            asm volatile("s_waitcnt vmcnt(0)" ::: "memory");
        } else {
            XB_SPIN(xb_ld(&bar[XB_XGEN(b.x)]) == gen, bar);
            __builtin_amdgcn_fence(__ATOMIC_ACQUIRE, "agent");
            asm volatile("s_waitcnt vmcnt(0)" ::: "memory");
        }
    }
    __syncthreads();
}

struct Args { const float* in[23]; float* out; unsigned char* ws; int ph_lo, ph_hi, coop, pad; };
typedef const __attribute__((address_space(4))) Args* KArgs;
__device__ __forceinline__ KArgs kargs() { KArgs p = (KArgs)__builtin_amdgcn_kernarg_segment_ptr(); asm volatile("" : "+s"(p)); return p; }
constexpr int N_PHASES = 2 + 7 * DEPTH + 1;

__global__ void __launch_bounds__(512, 2) fwd_kernel(Args a) {
    extern __shared__ __attribute__((aligned(16))) unsigned char lds_raw[];
    LAS unsigned char* lds = (LAS unsigned char*)lds_raw;
    volatile LAS unsigned* bar_st = (volatile LAS unsigned*)(lds + RING_BYTES + 64);
    if (threadIdx.x < 2) bar_st[threadIdx.x] = 0u;
    __syncthreads();
    if (kargs()->coop) (void)xcd_barrier_post((unsigned*)kargs()->ws, bar_st);
    const int ph_lo = kargs()->ph_lo, ph_hi = kargs()->ph_hi;
    for (int ph = ph_lo; ph < ph_hi; ++ph) {
        KArgs ka = kargs();
        const int tid = pg8_ltid(), lane = tid & 63, wave = __builtin_amdgcn_readfirstlane(tid >> 6);
        int G = gridDim.x, bx = blockIdx.x; asm volatile("" : "+s"(G), "+s"(bx));
        const int vcu = (G % 8 == 0) ? (bx % 8) * (G / 8) + bx / 8 : bx;
        const int gw = vcu * 8 + wave, NGW = G * 8;
        unsigned char* ws = ka->ws;
        float* MOD = (float*)(ws + WS_MOD); float* MODP = (float*)(ws + WS_MODP);
        float* tabA = (float*)(ws + WS_TAB); float* tabB = tabA + 128 * 8 * 2;
        float* XCA = (float*)(ws + WS_XC); float* XCB = (float*)(ws + WS_MODP);
        bf16_t* XN = (bf16_t*)(ws + WS_XN); bf16_t* Ob = (bf16_t*)(ws + WS_O); bf16_t* Hb = (bf16_t*)(ws + WS_H); bf16_t* ACT = Hb;
        float* XL = ka->out;
        if (ph == 0) {
          {
            const float* w_mod = ka->in[6]; const float* c_in = ka->in[1]; const float* cctx_in = ka->in[3];
            for (int it = gw; it < 1536; it += NGW) {
                const int ks = it & 15, cgp = (it >> 4) % 24, l = it / 384;
                const int n0 = cgp * 256 + lane * 4;
                f32x4 acc[5];
#pragma unroll
                for (int s = 0; s < 5; ++s) acc[s] = (f32x4){0.f, 0.f, 0.f, 0.f};
                const float* wp = w_mod + ((size_t)l * 1024 + ks * 64) * 6144 + n0;
                for (int kk = 0; kk < 64; ++kk) {
                    const int k = ks * 64 + kk;
                    const f32x4 w = *(const f32x4*)(wp + (size_t)kk * 6144);
#pragma unroll
                    for (int s = 0; s < 4; ++s) acc[s] += silu_f(c_in[s * 1024 + k]) * w;
                    acc[4] += silu_f(cctx_in[k]) * w;
                }
#pragma unroll
                for (int s = 0; s < 5; ++s) *(f32x4*)(MODP + ((size_t)(ks * 4 + l) * 5 + s) * 6144 + n0) = acc[s];
            }
            LAS float* scr = (LAS float*)(lds + wave * 16768);
            for (int it = gw; it < 4 * 3072; it += NGW) {
                const int l = it / 3072; int r = it - l * 3072;
                unsigned char* wl = ws + WS_W + (size_t)l * W_LAYER;
                if (r < 704) { transpose_item(ka->in[8] + (size_t)l * 1024 * 2816, 1024, 2816, (bf16_t*)wl, 1, scr, r, lane); continue; } r -= 704;
                if (r < 256) { transpose_item(ka->in[9] + (size_t)l * 1024 * 1024, 1024, 1024, (bf16_t*)(wl + W_OUT_OFF), 0, scr, r, lane); continue; } r -= 256;
                if (r < 1408) { transpose_item(ka->in[18] + (size_t)l * 1024 * 5632, 1024, 5632, (bf16_t*)(wl + W_UP_OFF), 2, scr, r, lane); continue; } r -= 1408;
                transpose_item(ka->in[21] + (size_t)l * 2816 * 1024, 2816, 1024, (bf16_t*)(wl + W_DN_OFF), 0, scr, r, lane);
            }
            for (int idx = vcu * 512 + tid; idx < 3072; idx += G * 512) {
                int pos, i; float e;
                if (idx < 1024) { pos = idx >> 3; i = idx & 7; e = (float)i * 0.125f; } else { const int j = idx - 1024; pos = j >> 4; i = j & 15; e = (float)i * 0.0625f; }
                const float freq = exp2f(-e * 13.287712379549449f);
                const float ang = (float)pos * freq;
                float cc, ss; sincos_f(ang, cc, ss);
                float* tp = (idx < 1024) ? (tabA + idx * 2) : (tabB + (idx - 1024) * 2);
                tp[0] = cc; tp[1] = ss;
            }
          }
        } else if (ph == 1) {
            const float* b_mod = ka->in[7];
            for (int idx = vcu * 512 + tid; idx < 4 * 5 * 6144; idx += G * 512) {
                const int l = idx / 30720, n = idx % 6144;
                float s = b_mod[l * 6144 + n];
#pragma unroll
                for (int ks = 0; ks < 16; ++ks) s += MODP[(size_t)ks * 122880 + idx];
                MOD[idx] = s;
            }
        } else if (ph == N_PHASES - 1) {
            const float* fw = ka->in[22];
            for (int m = gw; m < ML; m += NGW) {
                f32x4* xr = (f32x4*)(XL + (size_t)m * DM) + lane;
                f32x4 v[4]; float s = 0.f;
#pragma unroll
                for (int j = 0; j < 4; ++j) { v[j] = xr[64 * j]; s += (v[j][0] * v[j][0] + v[j][1] * v[j][1]) + (v[j][2] * v[j][2] + v[j][3] * v[j][3]); }
                const float rstd = rsqrtf(wave_sum(s, lane) * (1.f / 1024.f) + 1e-6f);
#pragma unroll
                for (int j = 0; j < 4; ++j) { const f32x4 w = *(const f32x4*)(fw + 4 * (64 * j + lane)); xr[64 * j] = v[j] * rstd * w; }
            }
        } else {
            const int l = (ph - 2) / 7, k = (ph - 2) % 7;
            const bool need_ctx = l < DEPTH - 1;
            const float* modl = MOD + (size_t)l * 5 * 6144;
            unsigned char* wl = ws + WS_W + (size_t)l * W_LAYER;
            const float* srcL = (l == 0) ? ka->in[0] : XL;
            if (k == 0) {
                const float* nw = ka->in[4] + l * 1024;
                for (int m = gw; m < MT; m += NGW) {
                    const bool lat = m < ML; const int slot = lat ? (m >> 13) : 4;
                    if (lat) norm_mod_row(srcL + (size_t)m * DM, nw, modl + slot * 6144, modl + slot * 6144 + 1024, XN + (size_t)m * DM, lane);
                    else {
                        const size_t ro = (size_t)(m - ML) * DM;
                        norm_mod_row((l == 0 ? ka->in[2] : (const float*)XCB) + ro, nw, modl + slot * 6144, modl + slot * 6144 + 1024, XN + (size_t)m * DM, lane,
                                     (const float*)Ob + ro, (l == 0) ? 0 : 11, XCA + ro);
                    }
                }
            } else if (k == 1) {
                pg8::Gemm g{XN, (const bf16_t*)wl, MT, INC, DM, DM}; pg8::StaticOrder S; S.init(MT, INC, G, bx);
                pg8::EpiInProj E{Hb, tabA, tabB};
#ifndef DIS_IN
                pg8::gemm_phase<pg8::EpiInProj, pg8::StaticOrder, true, true>(lds, g, S, E);
#endif
            } else if (k == 2) {
                float lam, ofac;
                {
                    float d1 = 0.f, d2 = 0.f;
                    for (int i = 0; i < 32; ++i) { d1 += ka->in[10][l * 32 + i] * ka->in[11][l * 32 + i]; d2 += ka->in[12][l * 32 + i] * ka->in[13][l * 32 + i]; }
                    const float li = 0.8f - 0.6f * expf(-0.3f * (float)l);
                    lam = expf(d1) - expf(d2) + li;
                    lam = __uint_as_float(__builtin_amdgcn_readfirstlane(__float_as_uint(lam))); ofac = __uint_as_float(__builtin_amdgcn_readfirstlane(__float_as_uint(li)));
                }
                const float* subw = ka->in[14] + l * 64; const float* sink_l = ka->in[15] + l * 4; const float* rpb_l = ka->in[16] + (size_t)l * 4 * 465;
#ifndef DIS_A
                for (int u = vcu; u < 512 + (need_ctx ? 16 : 0); u += G) {
                    const bool cq = u >= 512; const int bh = cq ? (u - 512) : (u >> 5);
                    att::unit_A(cq, lds, Hb, Ob, bh >> 2, bh & 3, u & 31, lam, ofac, subw);
                }
#endif
#ifndef DIS_B
                for (int u = vcu; u < 1024 + (need_ctx ? 32 : 0); u += G) {
                    int mode, ub, uh, ublk; bool redo = true;
                    if (u < 512) { mode = 1; ub = u >> 7; uh = (u >> 6) & 1; ublk = u & 63; redo = att::unit_BC_fast<1>(lds, Hb, Ob, ub, uh, ublk, sink_l, rpb_l); }
                    else if (u < 1024) { const int v = u - 512; mode = 2; ub = v >> 7; uh = (v >> 5) & 3; ublk = v & 31; redo = att::unit_BC_fast<2>(lds, Hb, Ob, ub, uh, ublk, sink_l, rpb_l); }
                    else { const int v = u - 1024, bh = v & 15; if (v < 16) { mode = 3; ub = bh >> 2; uh = (bh >> 1) & 1; ublk = bh & 1; } else { mode = 4; ub = bh >> 2; uh = bh & 3; ublk = 0; } }
                    if (redo) att::unit_BC(mode, lds, Hb, Ob, ub, uh, ublk, sink_l, rpb_l);
                }
#endif
                {
                    const float* cwl = ka->in[17] + (size_t)l * 3 * 256;
                    const int rows = need_ctx ? MT : ML;
                    const int c0 = (tid & 31) * 8;
                    float w0[8], w1[8], w2[8];
#pragma unroll
                    for (int e = 0; e < 8; ++e) { w0[e] = cwl[c0 + e]; w1[e] = cwl[256 + c0 + e]; w2[e] = cwl[512 + c0 + e]; }
                    for (int idx = vcu * 512 + tid; idx < rows * 32; idx += G * 512) {
                        const int row = idx >> 5;
                        int t, len; if (row < ML) { t = row & 8191; len = SEQ; } else { t = (row - ML) & 255; len = CTXL; }
                        const bf16_t* hp = Hb + (size_t)row * INC + 2048 + c0;
                        const u32x4 bg = *(const u32x4*)hp, cg1 = *(const u32x4*)(hp + 256), xi1 = *(const u32x4*)(hp + 512);
                        u32x4 cg0 = {0u, 0u, 0u, 0u}, xi0 = cg0, cg2 = cg0, xi2 = cg0;
                        if (t > 0) { cg0 = *(const u32x4*)(hp - INC + 256); xi0 = *(const u32x4*)(hp - INC + 512); }
                        if (t < len - 1) { cg2 = *(const u32x4*)(hp + INC + 256); xi2 = *(const u32x4*)(hp + INC + 512); }
                        u32x4 ow;
#pragma unroll
                        for (int e = 0; e < 4; ++e) {
                            const float ylo = w0[2 * e] * bflo(cg0[e]) * bflo(xi0[e]) + w1[2 * e] * bflo(cg1[e]) * bflo(xi1[e]) + w2[2 * e] * bflo(cg2[e]) * bflo(xi2[e]);
                            const float yhi = w0[2 * e + 1] * bfhi(cg0[e]) * bfhi(xi0[e]) + w1[2 * e + 1] * bfhi(cg1[e]) * bfhi(xi1[e]) + w2[2 * e + 1] * bfhi(cg2[e]) * bfhi(xi2[e]);
                            ow[e] = pkbf(bflo(bg[e]) * ylo, bfhi(bg[e]) * yhi);
                        }
                        *(u32x4*)(Ob + (size_t)row * DM + 768 + c0) = ow;
                    }
                }
                __syncthreads();
            } else if (k == 4) {
                const float* nw = ka->in[5] + l * 1024;
                const int nrows = (need_ctx ? NMX_ALL : NMX_L) * 256;
                for (int e = gw; e < nrows; e += NGW) {
                    const int pm = e >> 8, j = e & 255;
                    int t, slot; const float* base; int len;
                    if (pm < NMX_L) { const int s = pm / 33, ti = pm - s * 33; t = 254 * ti - 1 + j; len = SEQ; slot = s; base = XL + (size_t)s * SEQ * DM; }
                    else { const int p = 254 * (pm - NMX_L) - 1 + j; const int sq = (p < 0) ? 0 : p / 257, r = p - sq * 257; t = (p >= 0 && p < 1029 && r != 0) ? (r - 1) : -1; len = CTXL; slot = 4; base = XCA + (size_t)sq * CTXL * DM; }
                    const bool ok = (t >= 0 && t < len);
                    const float* src = ok ? (base + (size_t)t * DM) : nullptr;
                    if (pm < NMX_L || !ok) norm_mod_row(src, nw, modl + slot * 6144 + 3072, modl + slot * 6144 + 4096, XN + (size_t)e * DM, lane);
                    else {
                        const size_t ro = (size_t)(src - XCA);
                        norm_mod_row(src, nw, modl + slot * 6144 + 3072, modl + slot * 6144 + 4096, XN + (size_t)e * DM, lane, (const float*)Hb + ro, 4, XCB + ro);
                    }
                }
            } else if (k == 5) {
                const int nM = need_ctx ? NMX_ALL : NMX_L;
                pg8::Gemm g{XN, (const bf16_t*)(wl + W_UP_OFF), nM * 256, UPC, DM, DM}; pg8::StaticOrder S; S.init(nM * 256, UPC, G, bx);
                pg8::EpiUpConv E{ACT, ka->in[19] + (size_t)l * 3 * UPC, ka->in[20] + (size_t)l * UPC};
                pg8::OneUnit one;
#ifndef DIS_UP
                for (int i = 0; S.next(i, one.u); ++i) pg8::gemm_phase<pg8::EpiUpConv, pg8::OneUnit, false, true>(lds, g, one, E);
#endif
            } else {
                const bool isout = (k == 3); const int KK = isout ? DM : DFF;
                const bf16_t* Ap = isout ? (const bf16_t*)Ob : (const bf16_t*)ACT; const bf16_t* Bp = (const bf16_t*)(wl + (isout ? W_OUT_OFF : W_DN_OFF));
                {
                    pg8::Gemm g{Ap, Bp, ML, DM, KK, KK}; pg8::StaticOrder S; S.init(ML, DM, G, bx);
                    pg8::EpiRes E{isout ? srcL : (const float*)XL, nullptr, XL, nullptr, modl, isout ? 2048 : 5120};
#ifndef DIS_OUT
                    pg8::gemm_phase<pg8::EpiRes, pg8::StaticOrder, true, true>(lds, g, S, E);
#endif
                }
                if (need_ctx) {
                    const int P = isout ? 4 : 11, klen = KK / P;
                    for (int su = bx; su < 16 * P; su += G) {
                        const int tile = su / P, part = su - tile * P;
                        pg8::Gemm gs{Ap + (size_t)ML * KK + part * klen, Bp + part * klen, MC, DM, klen, KK};
                        pg8::OneUnit one; one.u.pm = tile >> 2; one.u.pn = tile & 3;
                        pg8::EpiSlab EA{(isout ? (float*)Hb : (float*)Ob) + (size_t)part * 1024 * 1024, modl + 4 * 6144 + (isout ? 2048 : 5120)};
                        pg8::gemm_phase<pg8::EpiSlab, pg8::OneUnit, false, true>(lds, gs, one, EA);
                    }
                }
            }
        }
        if (ph + 1 < ph_hi && kargs()->coop) {
            if (kargs()->coop == 2) cg::this_grid().sync();
            else { XcdBarrier b; b.bar = (unsigned*)kargs()->ws; b.x = xb_xcc_id(); b.st = bar_st; xcd_barrier(b); }
        }
    }
}

extern "C" void kernel_launch(void* const* d_in, const int* in_sizes, int n_in, void* d_out, int out_size, void* d_ws, size_t ws_size, hipStream_t stream) {
    static int grid = 0;
    if (grid == 0) {
        if (n_in != 23 || out_size != ML * DM || ws_size < WS_END) { fprintf(stderr, "kernel_launch: unexpected shapes (n_in %d out %d ws %zu need %zu)\n", n_in, out_size, ws_size, (size_t)WS_END); grid = -1; return; }
        int dev = 0, cus = 0, per_cu = 0;
        if (hipGetDevice(&dev) != hipSuccess || hipDeviceGetAttribute(&cus, hipDeviceAttributeMultiprocessorCount, dev) != hipSuccess) { grid = -1; return; }
        if (hipFuncSetAttribute((const void*)fwd_kernel, hipFuncAttributeMaxDynamicSharedMemorySize, LDS_BYTES) != hipSuccess) { fprintf(stderr, "kernel_launch: hipFuncSetAttribute failed\n"); grid = -1; return; }
        if (hipOccupancyMaxActiveBlocksPerMultiprocessor(&per_cu, (const void*)fwd_kernel, 512, LDS_BYTES) != hipSuccess || per_cu < 1) fprintf(stderr, "kernel_launch: occupancy query says %d\n", per_cu);
        (void)hipGetLastError();
        grid = cus;
    }
    if (grid < 0) return;
    Args a{};
    for (int i = 0; i < 23; ++i) a.in[i] = (const float*)d_in[i];
    a.out = (float*)d_out; a.ws = (unsigned char*)d_ws;
#if MK_MULTI
    for (int ph = 0; ph < N_PHASES; ++ph) {
        a.ph_lo = ph; a.ph_hi = ph + 1; a.coop = 0;
        hipLaunchKernelGGL(fwd_kernel, dim3(grid), dim3(512), LDS_BYTES, stream, a);
    }
#else
    a.ph_lo = 0; a.ph_hi = N_PHASES; a.coop = 1;
    if (hipMemsetAsync(d_ws, 0, 16384, stream) != hipSuccess) { fprintf(stderr, "kernel_launch: memset failed\n"); return; }
    void* args[] = {&a};
    hipError_t e = hipLaunchCooperativeKernel((const void*)fwd_kernel, dim3(grid), dim3(512), args, LDS_BYTES, stream);
    if (e != hipSuccess) fprintf(stderr, "cooperative launch failed: %s (grid %d)\n", hipGetErrorString(e), grid);
#endif
}
```

```cpp
#include <hip/hip_runtime.h>
#include <hip/hip_cooperative_groups.h>
#include <cstdio>
#include <cstdint>
namespace cg = cooperative_groups;

#ifndef MK_MULTI
#define MK_MULTI 0
#endif

#ifndef REP_IN
#define REP_IN 1
#endif
#ifndef REP_UP
#define REP_UP 1
#endif
#ifndef REP_A
#define REP_A 1
#endif
#ifndef REP_OD
#define REP_OD 1
#endif
#ifndef REP_P
#define REP_P 1
#endif
#ifndef REP_BC
#define REP_BC 1
#endif
#ifndef REP_M
#define REP_M 1
#endif

__device__ __forceinline__ int pg8_ltid() { int t = threadIdx.x; asm volatile("" : "+v"(t)); return t; }
namespace pg8 {
#define PG8_LAS __attribute__((address_space(3)))
typedef unsigned short bf16_t;
typedef short bf16x8 __attribute__((ext_vector_type(8)));
typedef float f32x4 __attribute__((ext_vector_type(4)));
typedef unsigned u32x4 __attribute__((ext_vector_type(4)));
constexpr int BM = 256, BK = 64, HALF = 128, HTB = HALF * BK * 2  , STAGE_BYTES = 8 * HTB, NXCD = 8, WGM = 8;

__host__ __device__ __forceinline__ int lds_byte(int r, int c) { const int st = (r >> 4) * 2 + (c >> 5), rr = r & 15, cc = c & 31, ob = rr * 64 + cc * 2; return st * 1024 + (ob ^ (((ob >> 9) & 1) << 5)); }
__host__ __device__ __forceinline__ void stage_rc(int b, int& R, int& C) { const int st = b / 1024, sb = b % 1024, swz = sb ^ (((sb >> 9) & 1) << 5); R = (st >> 1) * 16 + swz / 64; C = (st & 1) * 32 + (swz % 64) / 2; }
__host__ __device__ __forceinline__ int perm32(int rho) { const int n = rho >> 4, i = rho & 15; return 8 * (i >> 2) + 4 * n + (i & 3); }

struct Unit { int pm, pn; };
struct Gemm { const bf16_t* A; const bf16_t* Bt; int M, N, K, ldk; };

struct StaticOrder {
    int nM, nN, nwg, G, c;
    __host__ __device__ void init(int M, int N, int G_, int c_) { nM = M / BM; nN = N / BM; nwg = nM * nN; G = G_; c = c_; }
    __host__ __device__ bool next(int i, Unit& u) const {
        const long L = (long)i * G + c; if (L >= nwg) return false;
        int wgid = (int)L; { const int q = nwg / NXCD, r = nwg % NXCD, xcd = wgid % NXCD, off = wgid / NXCD; wgid = (xcd < r ? xcd * (q + 1) : r * (q + 1) + (xcd - r) * q) + off; }
        const int nig = WGM * nN, gid = wgid / nig, fm = gid * WGM, gsz = (nM - fm) < WGM ? (nM - fm) : WGM;
        u.pm = fm + ((wgid % nig) % gsz); u.pn = (wgid % nig) / gsz; return true;
    }
    __device__ __forceinline__ void a_ready(const Unit&) const {}
    __device__ __forceinline__ void done(const Unit&) const {}
};

typedef float pg8_f32x2 __attribute__((ext_vector_type(2))); typedef __bf16 pg8_bf16x2 __attribute__((ext_vector_type(2)));
__device__ __forceinline__ unsigned cvt_pk_bf16(float lo, float hi) { pg8_f32x2 v = {lo, hi}; pg8_bf16x2 b = __builtin_convertvector(v, pg8_bf16x2); return __builtin_bit_cast(unsigned, b); }
typedef unsigned u32x2 __attribute__((ext_vector_type(2)));

struct OneUnit {
    Unit u;
    __device__ __forceinline__ bool next(int i, Unit& o) const { if (i != 0) return false; o = u; return true; }
    __device__ __forceinline__ void a_ready(const Unit&) const {}
    __device__ __forceinline__ void done(const Unit&) const {}
};

struct EpiInProj {
    static constexpr bool PERM = true, AFTER_DRAIN = false;
    bf16_t* H; const float* tabA; const float* tabB;
    __device__ __forceinline__ void operator()(const f32x4 (&acc)[2][2][4][2], const Unit& u, int wr, int wc, int fr, int fq) const {
        const int pn = u.pn; const bool latent = u.pm < 128;
        const float scale = (pn == 0) ? 0.17677669529663687f * 1.4426950408889634f : ((pn == 3 || pn == 5) ? 0.125f * 1.4426950408889634f : 1.0f);
#pragma unroll
        for (int bj = 0; bj < 2; ++bj) {
            int mode = (pn == 0 || pn == 1) ? 1 : ((pn == 3 || (pn == 4 && bj == 0)) ? 2 : 0);
            if (!latent) mode = 0;
#ifdef TEST_NOROPE
            mode = 0;
#endif
#pragma unroll
            for (int ai = 0; ai < 2; ++ai)
#pragma unroll
                for (int m = 0; m < 4; ++m) {
                    const int r = u.pm * BM + ai * HALF + wr * 64 + m * 16 + fr;
                    f32x4 v0 = acc[ai][bj][m][0], v1 = acc[ai][bj][m][1];
                    if (mode != 0) {
                        const int t = r & 8191, trow = t >> 6, tcol = t & 63;
                        const float* tp;
                        if (mode == 1) { const int pos = (fq < 2) ? trow : tcol; tp = tabA + (pos * 8 + 4 * (fq & 1)) * 2; }
                        else { const int pos = (wc & 1) ? tcol : trow; tp = tabB + (pos * 16 + 4 * fq) * 2; }
                        const f32x4 cs0 = *(const f32x4*)tp, cs1 = *(const f32x4*)(tp + 4);
                        const float c0 = cs0[0], s0 = cs0[1], c1 = cs0[2], s1 = cs0[3], c2 = cs1[0], s2 = cs1[1], c3 = cs1[2], s3 = cs1[3];
                        f32x4 a = v0, b = v1;
                        v0[0] = a[0] * c0 - b[0] * s0; v1[0] = b[0] * c0 + a[0] * s0;
                        v0[1] = a[1] * c1 - b[1] * s1; v1[1] = b[1] * c1 + a[1] * s1;
                        v0[2] = a[2] * c2 - b[2] * s2; v1[2] = b[2] * c2 + a[2] * s2;
                        v0[3] = a[3] * c3 - b[3] * s3; v1[3] = b[3] * c3 + a[3] * s3;
                    }
                    v0 = v0 * scale; v1 = v1 * scale;
                    bf16_t* rowp = H + (size_t)r * 2816 + pn * BM + bj * HALF + wc * 32 + 8 * fq;
                    u32x4 w; w.x = cvt_pk_bf16(v0[0], v0[1]); w.y = cvt_pk_bf16(v0[2], v0[3]); w.z = cvt_pk_bf16(v1[0], v1[1]); w.w = cvt_pk_bf16(v1[2], v1[3]);
                    *(u32x4*)rowp = w;
                }
        }
    }
};

struct EpiRes {
    static constexpr bool PERM = false, AFTER_DRAIN = false;
    const float* base32; const bf16_t* base16; bf16_t* out16; const float* modl; int goff;
    __device__ __forceinline__ void operator()(const f32x4 (&acc)[2][2][4][2], const Unit& u, int wr, int wc, int fr, int fq) const {
        const int slot = u.pm >> 5;
        const int row0 = u.pm * BM + wr * 64 + fr;
        const int col0 = u.pn * BM + wc * 32 + 4 * fq;
        f32x4 gv[2][2];
#pragma unroll
        for (int bj = 0; bj < 2; ++bj)
#pragma unroll
            for (int n = 0; n < 2; ++n) gv[bj][n] = *(const f32x4*)(modl + slot * 6144 + goff + col0 + bj * HALF + n * 16);
        const bool f32in = (base32 != nullptr);
#pragma unroll
        for (int ai = 0; ai < 2; ++ai)
#pragma unroll
            for (int m = 0; m < 4; ++m) {
                const size_t off = (size_t)(row0 + ai * HALF + m * 16) * 1024 + col0;
#pragma unroll
                for (int bj = 0; bj < 2; ++bj)
#pragma unroll
                    for (int n = 0; n < 2; ++n) {
                        f32x4 bs;
                        if (f32in) bs = *(const f32x4*)(base32 + off + bj * HALF + n * 16);
                        else { const u32x2 w = *(const u32x2*)(base16 + off + bj * HALF + n * 16); bs = (f32x4){__uint_as_float(w.x << 16), __uint_as_float(w.x & 0xffff0000u), __uint_as_float(w.y << 16), __uint_as_float(w.y & 0xffff0000u)}; }
                        const f32x4 o = bs + gv[bj][n] * acc[ai][bj][m][n];
                        u32x2 ow; ow.x = cvt_pk_bf16(o[0], o[1]); ow.y = cvt_pk_bf16(o[2], o[3]);
                        *(u32x2*)(out16 + off + bj * HALF + n * 16) = ow;
                    }
                asm volatile("" ::: "memory");
            }
    }
};

struct EpiSlab {
    static constexpr bool PERM = false, AFTER_DRAIN = false;
    float* slab; const float* gate;
    __device__ __forceinline__ void operator()(const f32x4 (&acc)[2][2][4][2], const Unit& u, int wr, int wc, int fr, int fq) const {
        const int row0 = u.pm * BM + wr * 64 + fr, col0 = u.pn * BM + wc * 32 + 4 * fq;
#pragma unroll
        for (int bj = 0; bj < 2; ++bj)
#pragma unroll
            for (int n = 0; n < 2; ++n) {
                const f32x4 gv = *(const f32x4*)(gate + col0 + bj * HALF + n * 16);
#pragma unroll
                for (int ai = 0; ai < 2; ++ai)
#pragma unroll
                    for (int m = 0; m < 4; ++m)
                        *(f32x4*)(slab + (size_t)(row0 + ai * HALF + m * 16) * 1024 + col0 + bj * HALF + n * 16) = gv * acc[ai][bj][m][n];
            }
    }
};

struct EpiUpConv {
    static constexpr bool PERM = false, AFTER_DRAIN = true;
    bf16_t* ACT; const float* cw; const float* cb;
    static constexpr int TP = 520;
    __device__ __forceinline__ void fused(f32x4 (&acc)[2][2][4][2], const Unit& u, int wr, int wc, int fr, int fq, PG8_LAS unsigned char* lds, int wid, int lane) const {
#pragma unroll
        for (int ai = 0; ai < 2; ++ai)
#pragma unroll
            for (int m = 0; m < 4; ++m) {
                const int row = ai * HALF + wr * 64 + m * 16 + fr;
#pragma unroll
                for (int bj = 0; bj < 2; ++bj)
#pragma unroll
                    for (int n = 0; n < 2; ++n) {
                        const f32x4 v = acc[ai][bj][m][n]; u32x2 w; w.x = cvt_pk_bf16(v[0], v[1]); w.y = cvt_pk_bf16(v[2], v[3]);
                        *(PG8_LAS u32x2*)(lds + row * TP + (bj * HALF + wc * 32 + n * 16 + 4 * fq) * 2) = w;
                    }
            }
        const int tid = wid * 64 + lane, ch = tid & 15;
        const int gcol = u.pn * 128 + ch * 8;
        float wg[3][8], wv[3][8], bg[8], bv[8];
#pragma unroll
        for (int k = 0; k < 3; ++k) {
            const f32x4 a0 = *(const f32x4*)(cw + k * 5632 + gcol), a1 = *(const f32x4*)(cw + k * 5632 + gcol + 4);
            const f32x4 b0 = *(const f32x4*)(cw + k * 5632 + 2816 + gcol), b1 = *(const f32x4*)(cw + k * 5632 + 2816 + gcol + 4);
#pragma unroll
            for (int e = 0; e < 4; ++e) { wg[k][e] = a0[e]; wg[k][4 + e] = a1[e]; wv[k][e] = b0[e]; wv[k][4 + e] = b1[e]; }
        }
        {
            const f32x4 a0 = *(const f32x4*)(cb + gcol), a1 = *(const f32x4*)(cb + gcol + 4), b0 = *(const f32x4*)(cb + 2816 + gcol), b1 = *(const f32x4*)(cb + 2816 + gcol + 4);
#pragma unroll
            for (int e = 0; e < 4; ++e) { bg[e] = a0[e]; bg[4 + e] = a1[e]; bv[e] = b0[e]; bv[4 + e] = b1[e]; }
        }
        const bool lat = u.pm < 132; int rowbase, ti;
        if (lat) { const int s = u.pm / 33; ti = u.pm - s * 33; rowbase = s * 8192; } else { ti = u.pm - 132; rowbase = 32768; }
        asm volatile("s_waitcnt lgkmcnt(0)" ::: "memory"); __builtin_amdgcn_s_barrier(); asm volatile("" ::: "memory");
        for (int it = tid; it < 254 * 16; it += 512) {
            const int j = 1 + (it >> 4); const int p = 254 * ti - 1 + j;
            int orow; bool ok;
            if (lat) { ok = p < 8192; orow = rowbase + p; } else { const int sq = p / 257, r = p - sq * 257; ok = (p < 1029) && (r != 0); orow = rowbase + sq * 256 + r - 1; }
            if (ok) {
                float g[8], v[8];
#pragma unroll
                for (int e = 0; e < 8; ++e) { g[e] = bg[e]; v[e] = bv[e]; }
#pragma unroll
                for (int k = 0; k < 3; ++k) {
                    const PG8_LAS unsigned char* rp = lds + (j - 1 + k) * TP + ch * 16;
                    const u32x2 g0 = *(const PG8_LAS u32x2*)rp, g1 = *(const PG8_LAS u32x2*)(rp + 8);
                    const u32x2 v0 = *(const PG8_LAS u32x2*)(rp + 256), v1 = *(const PG8_LAS u32x2*)(rp + 264);
                    const unsigned gw[4] = {g0.x, g0.y, g1.x, g1.y}, vw[4] = {v0.x, v0.y, v1.x, v1.y};
#pragma unroll
                    for (int e = 0; e < 4; ++e) {
                        g[2 * e] += wg[k][2 * e] * __uint_as_float(gw[e] << 16); g[2 * e + 1] += wg[k][2 * e + 1] * __uint_as_float(gw[e] & 0xffff0000u);
                        v[2 * e] += wv[k][2 * e] * __uint_as_float(vw[e] << 16); v[2 * e + 1] += wv[k][2 * e + 1] * __uint_as_float(vw[e] & 0xffff0000u);
                    }
                }
                float o[8];
#pragma unroll
                for (int e = 0; e < 8; ++e) o[e] = g[e] / (1.f + __expf(-g[e])) * v[e];
                u32x4 w; w.x = cvt_pk_bf16(o[0], o[1]); w.y = cvt_pk_bf16(o[2], o[3]); w.z = cvt_pk_bf16(o[4], o[5]); w.w = cvt_pk_bf16(o[6], o[7]);
                *(u32x4*)(ACT + (size_t)orow * 2816 + gcol) = w;
            }
        }
        asm volatile("s_waitcnt lgkmcnt(0)" ::: "memory"); __builtin_amdgcn_s_barrier(); asm volatile("" ::: "memory");
    }
};
template <class Epi, class Sched, bool ALIGN_EPI = false, bool SP2 = false>
__device__ __forceinline__ void gemm_phase(PG8_LAS unsigned char* lds, const Gemm g, const Sched& S, const Epi& E) {
    const int tid = pg8_ltid(), wid = __builtin_amdgcn_readfirstlane(tid >> 6), lane = tid & 63, wr = wid >> 2, wc = wid & 3, fr = lane & 15, fq = lane >> 4;
    const int K = g.ldk, nt = g.K / BK;
    unsigned voffA[2], voffB[2];
#pragma unroll
    for (int i = 0; i < 2; ++i) { int R, C; stage_rc(tid * 16 + i * 8192, R, C); const int Rb = Epi::PERM ? ((R & ~31) + perm32(R & 31)) : R;
        voffA[i] = (unsigned)(R * K + C) * 2u; voffB[i] = (unsigned)(Rb * K + C) * 2u; }
    const size_t kstep = (size_t)(BK * 2);
    const size_t hstep = (size_t)HALF * K * 2;
    const size_t tstep = 2 * hstep;
    const unsigned ldsw = (unsigned)wid * 1024u;
    const int aoff = lds_byte(wr * 64 + fr, fq * 8), boff = lds_byte(wc * 32 + fr, fq * 8);
#define PG8_SA(b, h) (((b) * 2 + (h)) * HTB)
#define PG8_SB(b, h) ((4 + (b) * 2 + (h)) * HTB)
#define PG8_STAGE(bufoff, gbase, voff) do { _Pragma("unroll") for (int _i = 0; _i < 2; ++_i) \
        __builtin_amdgcn_global_load_lds((const unsigned*)((const char*)(gbase) + (voff)[_i]), (PG8_LAS unsigned*)(lds + (bufoff) + ldsw + _i * 8192), 16, 0, 0); } while (0)
#define PG8_LDA(dst, b, h) do { _Pragma("unroll") for (int m = 0; m < 4; ++m) _Pragma("unroll") for (int k = 0; k < 2; ++k) dst[m][k] = *(const PG8_LAS bf16x8*)(lds + PG8_SA(b, h) + aoff + m * 2048 + k * 1024); } while (0)
#define PG8_LDB(dst, b, h) do { _Pragma("unroll") for (int n = 0; n < 2; ++n) _Pragma("unroll") for (int k = 0; k < 2; ++k) dst[n][k] = *(const PG8_LAS bf16x8*)(lds + PG8_SB(b, h) + boff + n * 2048 + k * 1024); } while (0)
#define PG8_MMA(ai, bj, At, Bt) do { __builtin_amdgcn_s_setprio(1); _Pragma("unroll") for (int m = 0; m < 4; ++m) _Pragma("unroll") for (int n = 0; n < 2; ++n) _Pragma("unroll") for (int k = 0; k < 2; ++k) \
        acc[ai][bj][m][n] = __builtin_amdgcn_mfma_f32_16x16x32_bf16(Bt[n][k], At[m][k], acc[ai][bj][m][n], 0, 0, 0); __builtin_amdgcn_s_setprio(0); } while (0)
#define PG8_WAIT_V(n) asm volatile("s_waitcnt vmcnt(" #n ")" ::: "memory")
#define PG8_WAIT_L(n) asm volatile("s_waitcnt lgkmcnt(" #n ")" ::: "memory")
#define PG8_BAR __builtin_amdgcn_s_barrier()
#define PG8_SCHED __builtin_amdgcn_sched_barrier(0)
    Unit cur, nxt; int ui = 0;
    if (!S.next(0, cur)) return;
    f32x4 acc[2][2][4][2];
#pragma unroll
    for (int a = 0; a < 2; ++a)
#pragma unroll
        for (int b = 0; b < 2; ++b)
#pragma unroll
            for (int m = 0; m < 4; ++m)
#pragma unroll
                for (int n = 0; n < 2; ++n) acc[a][b][m][n] = (f32x4){0.f, 0.f, 0.f, 0.f};
    bf16x8 At[4][2], B0[2][2], B1[2][2];
    const char* cA = (const char*)g.A + (size_t)cur.pm * tstep; const char* cB = (const char*)g.Bt + (size_t)cur.pn * tstep;
    S.a_ready(cur);
    if constexpr (SP2) {
        PG8_STAGE(PG8_SB(0, 0), cB, voffB); PG8_STAGE(PG8_SB(0, 1), cB + hstep, voffB); PG8_STAGE(PG8_SA(0, 0), cA, voffA); PG8_STAGE(PG8_SA(0, 1), cA + hstep, voffA);
        if (wr == 1) PG8_BAR;
        PG8_WAIT_V(2); PG8_BAR;
        PG8_STAGE(PG8_SB(1, 0), cB + kstep, voffB); PG8_STAGE(PG8_SA(1, 0), cA + kstep, voffA); PG8_STAGE(PG8_SB(1, 1), cB + hstep + kstep, voffB);
        PG8_WAIT_V(6); PG8_BAR;
    } else {
        PG8_STAGE(PG8_SB(0, 0), cB, voffB); PG8_STAGE(PG8_SA(0, 0), cA, voffA); PG8_STAGE(PG8_SB(0, 1), cB + hstep, voffB); PG8_STAGE(PG8_SA(0, 1), cA + hstep, voffA);
        if (wr == 1) PG8_BAR;
        PG8_WAIT_V(4); PG8_BAR;
        PG8_STAGE(PG8_SB(1, 0), cB + kstep, voffB); PG8_STAGE(PG8_SA(1, 0), cA + kstep, voffA); PG8_STAGE(PG8_SB(1, 1), cB + hstep + kstep, voffB);
        PG8_WAIT_V(6); PG8_BAR;
    }
    for (;;) {
        const bool has_next = S.next(ui + 1, nxt);
        const char* nA = has_next ? (const char*)g.A + (size_t)nxt.pm * tstep : cA; const char* nB = has_next ? (const char*)g.Bt + (size_t)nxt.pn * tstep : cB;
        for (int t = 0; t < nt; t += 2) {
            const bool last = (t == nt - 2);
            const char* a1 = cA + (size_t)(t + 1) * kstep;
            const char* a2 = last ? nA : cA + (size_t)(t + 2) * kstep; const char* b2 = last ? nB : cB + (size_t)(t + 2) * kstep;
            const char* a3 = a2 + kstep; const char* b3 = b2 + kstep;
            if (last && has_next) S.a_ready(nxt);
            if constexpr (SP2) {
            PG8_LDB(B0, 0, 0); PG8_LDB(B1, 0, 1); PG8_SCHED; PG8_LDA(At, 0, 0); PG8_STAGE(PG8_SA(1, 1), a1 + hstep, voffA);
            PG8_WAIT_V(8); PG8_WAIT_L(0); PG8_BAR; PG8_MMA(0, 0, At, B0); PG8_MMA(0, 1, At, B1); PG8_BAR; PG8_SCHED;
            PG8_LDA(At, 0, 1); PG8_STAGE(PG8_SB(0, 0), b2, voffB); PG8_STAGE(PG8_SB(0, 1), b2 + hstep, voffB); PG8_STAGE(PG8_SA(0, 0), a2, voffA);
            PG8_WAIT_V(8); PG8_WAIT_L(0); PG8_BAR; PG8_MMA(1, 0, At, B0); PG8_MMA(1, 1, At, B1); PG8_BAR; PG8_SCHED;
            PG8_LDB(B0, 1, 0); PG8_LDB(B1, 1, 1); PG8_SCHED; PG8_LDA(At, 1, 0); PG8_STAGE(PG8_SA(0, 1), a2 + hstep, voffA);
            PG8_WAIT_V(8); PG8_WAIT_L(0); PG8_BAR; PG8_MMA(0, 0, At, B0); PG8_MMA(0, 1, At, B1); PG8_BAR; PG8_SCHED;
            PG8_LDA(At, 1, 1); PG8_STAGE(PG8_SB(1, 0), b3, voffB); PG8_STAGE(PG8_SB(1, 1), b3 + hstep, voffB); PG8_STAGE(PG8_SA(1, 0), a3, voffA);
            PG8_WAIT_V(8); PG8_WAIT_L(0); PG8_BAR; PG8_MMA(1, 0, At, B0); PG8_MMA(1, 1, At, B1); PG8_BAR; PG8_SCHED;
            } else {
            PG8_LDB(B0, 0, 0); PG8_SCHED; PG8_LDA(At, 0, 0); PG8_STAGE(PG8_SA(1, 1), a1 + hstep, voffA);
            PG8_WAIT_L(8); PG8_BAR; PG8_WAIT_L(0); PG8_MMA(0, 0, At, B0); PG8_BAR; PG8_SCHED;
            PG8_LDB(B1, 0, 1); PG8_STAGE(PG8_SB(0, 0), b2, voffB);
            PG8_BAR; PG8_WAIT_L(0); PG8_MMA(0, 1, At, B1); PG8_BAR;
            PG8_LDA(At, 0, 1); PG8_STAGE(PG8_SA(0, 0), a2, voffA);
            PG8_BAR; PG8_WAIT_L(0); PG8_MMA(1, 0, At, B0); PG8_BAR; PG8_SCHED;
            PG8_STAGE(PG8_SB(0, 1), b2 + hstep, voffB);
            PG8_WAIT_V(6); PG8_BAR; PG8_MMA(1, 1, At, B1); PG8_BAR;
            PG8_LDB(B0, 1, 0); PG8_SCHED; PG8_LDA(At, 1, 0); PG8_STAGE(PG8_SA(0, 1), a2 + hstep, voffA);
            PG8_WAIT_L(8); PG8_BAR; PG8_WAIT_L(0); PG8_MMA(0, 0, At, B0); PG8_BAR; PG8_SCHED;
            PG8_LDB(B1, 1, 1); PG8_STAGE(PG8_SB(1, 0), b3, voffB);
            PG8_BAR; PG8_WAIT_L(0); PG8_MMA(0, 1, At, B1); PG8_BAR;
            PG8_LDA(At, 1, 1); PG8_STAGE(PG8_SA(1, 0), a3, voffA);
            PG8_BAR; PG8_WAIT_L(0); PG8_MMA(1, 0, At, B0); PG8_BAR; PG8_SCHED;
            PG8_STAGE(PG8_SB(1, 1), b3 + hstep, voffB);
            PG8_WAIT_V(6); PG8_BAR; PG8_MMA(1, 1, At, B1); PG8_BAR;
            }
        }
        if constexpr (ALIGN_EPI) { if (wr == 0) PG8_BAR; }
        if constexpr (!Epi::AFTER_DRAIN) { E(acc, cur, wr, wc, fr, fq); S.done(cur); }
        if (!has_next) break;
#pragma unroll
        for (int a = 0; a < 2; ++a)
#pragma unroll
            for (int b = 0; b < 2; ++b)
#pragma unroll
                for (int m = 0; m < 4; ++m)
#pragma unroll
                    for (int n = 0; n < 2; ++n) acc[a][b][m][n] = (f32x4){0.f, 0.f, 0.f, 0.f};
        cur = nxt; cA = nA; cB = nB; ++ui;
        if constexpr (ALIGN_EPI) { if (wr == 1) PG8_BAR; }
    }
    PG8_WAIT_V(0);
    if constexpr (!ALIGN_EPI) { if (wr == 0) PG8_BAR; }
    PG8_BAR;
    if constexpr (Epi::AFTER_DRAIN) { E.fused(acc, cur, wr, wc, fr, fq, lds, wid, lane); S.done(cur); }
#undef PG8_SA
#undef PG8_SB
#undef PG8_STAGE
#undef PG8_LDA
#undef PG8_LDB
#undef PG8_MMA
#undef PG8_WAIT_V
#undef PG8_WAIT_L
#undef PG8_BAR
#undef PG8_SCHED
}
}
#define LAS __attribute__((address_space(3)))
typedef unsigned short bf16_t;
typedef short bf16x8 __attribute__((ext_vector_type(8)));
typedef short s16x4 __attribute__((ext_vector_type(4)));
typedef float f32x4 __attribute__((ext_vector_type(4)));
typedef float f32x16 __attribute__((ext_vector_type(16)));
typedef unsigned u32x4 __attribute__((ext_vector_type(4)));
typedef unsigned u32x2 __attribute__((ext_vector_type(2)));

constexpr int DM = 1024, NB = 4, SEQ = 8192, DEPTH = 4, CTXL = 256;
constexpr int ML = NB * SEQ, MC = NB * CTXL, MT = ML + MC;
constexpr int INC = 2816, DFF = 2816, UPC = 5632;
constexpr int NMX_L = NB * 33, NMX_ALL = NB * 33 + 5;
constexpr float LOG2E = 1.4426950408889634f;

constexpr size_t MiB = 1u << 20;
constexpr size_t WS_MOD = 1 * MiB;
constexpr size_t WS_MODP = 2 * MiB;
constexpr size_t WS_TAB = 10 * MiB;
constexpr size_t WS_XC = 11 * MiB;
constexpr size_t WS_W = 16 * MiB;
constexpr size_t W_LAYER = 24 * MiB, W_OUT_OFF = (size_t)2816 * 1024 * 2, W_UP_OFF = W_OUT_OFF + (size_t)1024 * 1024 * 2, W_DN_OFF = W_UP_OFF + (size_t)5632 * 1024 * 2;
constexpr size_t WS_XN = 112 * MiB;
constexpr size_t WS_O = 182 * MiB;
constexpr size_t WS_H = 248 * MiB;
constexpr size_t WS_XB = 430 * MiB;
constexpr size_t WS_END = WS_XB + (size_t)ML * 1024 * 2;
static_assert(W_DN_OFF + (size_t)1024 * 2816 * 2 <= W_LAYER, "weights per layer");
static_assert(WS_XN + (size_t)NMX_ALL * 256 * 1024 * 2 <= WS_O && WS_O + (size_t)MT * 1024 * 2 <= WS_H && WS_H + (size_t)MT * 2816 * 2 <= WS_XB && WS_END <= 512 * MiB, "ws map");

constexpr int RING_BYTES = 135168;
constexpr int LDS_BYTES = 147456;

__device__ __forceinline__ unsigned pkbf(float lo, float hi) { return pg8::cvt_pk_bf16(lo, hi); }
__device__ __forceinline__ float bflo(unsigned w) { return __uint_as_float(w << 16); }
__device__ __forceinline__ float bfhi(unsigned w) { return __uint_as_float(w & 0xffff0000u); }
__device__ __forceinline__ float dpp_add(float v, const int ctrl_sel) {
    int m;
    if (ctrl_sel == 0) m = __builtin_amdgcn_update_dpp(0, __float_as_int(v), 0xB1, 0xF, 0xF, true);
    else if (ctrl_sel == 1) m = __builtin_amdgcn_update_dpp(0, __float_as_int(v), 0x4E, 0xF, 0xF, true);
    else if (ctrl_sel == 2) m = __builtin_amdgcn_update_dpp(0, __float_as_int(v), 0x124, 0xF, 0xF, true);
    else m = __builtin_amdgcn_update_dpp(0, __float_as_int(v), 0x128, 0xF, 0xF, true);
    return v + __int_as_float(m);
}
__device__ __forceinline__ float wave_sum(float v, int lane) {
    v = dpp_add(v, 0); v = dpp_add(v, 1); v = dpp_add(v, 2); v = dpp_add(v, 3);
    v += __int_as_float(__builtin_amdgcn_ds_bpermute((lane ^ 16) << 2, __float_as_int(v)));
    auto rr = __builtin_amdgcn_permlane32_swap(__float_as_uint(v), __float_as_uint(v), false, false);
    return __uint_as_float(rr[0]) + __uint_as_float(rr[1]);
}
__device__ __forceinline__ float xhalf_max(float v) { auto rr = __builtin_amdgcn_permlane32_swap(__float_as_uint(v), __float_as_uint(v), false, false); return fmaxf(__uint_as_float(rr[0]), __uint_as_float(rr[1])); }
__device__ __forceinline__ float xhalf_sum(float v) { auto rr = __builtin_amdgcn_permlane32_swap(__float_as_uint(v), __float_as_uint(v), false, false); return __uint_as_float(rr[0]) + __uint_as_float(rr[1]); }

namespace att {
constexpr int KP = 144, VP = 136;
constexpr int L_KS = 0, L_VT = 64 * KP, L_RPB = L_VT + 64 * VP, L_END = L_RPB + 2048;
__device__ __forceinline__ int crow(int r, int h) { return (r & 3) + 8 * (r >> 2) + 4 * h; }

struct TileRegs { u32x4 k, v; };
__device__ __forceinline__ void tile_gload(TileRegs& R, const bf16_t* H, int krow, int kcol, int vcol, int tid) {
    const int key = tid >> 3, ch = tid & 7;
    const bf16_t* p = H + (size_t)(krow + key) * INC;
    R.k = *(const u32x4*)(p + kcol + 8 * ch); R.v = *(const u32x4*)(p + vcol + 8 * ch);
}
__device__ __forceinline__ void tile_swrite(const TileRegs& R, LAS unsigned char* lds, int tid) {
    const int key = tid >> 3, ch = tid & 7;
    *(LAS u32x4*)(lds + L_KS + key * KP + ch * 16) = R.k;
    LAS unsigned short* vt = (LAS unsigned short*)(lds + L_VT);
#pragma unroll
    for (int j = 0; j < 4; ++j) { const unsigned w = R.v[j]; vt[(8 * ch + 2 * j) * (VP / 2) + key] = (unsigned short)(w & 0xffffu); vt[(8 * ch + 2 * j + 1) * (VP / 2) + key] = (unsigned short)(w >> 16); }
}
template <int KS0, int NKS>
__device__ __forceinline__ f32x16 qk_block(const LAS unsigned char* lds, int kb, int r32, int hh, const bf16x8 (&qf)[4]) {
    f32x16 s = {0.f, 0.f, 0.f, 0.f, 0.f, 0.f, 0.f, 0.f, 0.f, 0.f, 0.f, 0.f, 0.f, 0.f, 0.f, 0.f};
#pragma unroll
    for (int ks = KS0; ks < KS0 + NKS; ++ks) {
        const bf16x8 kf = *(const LAS bf16x8*)(lds + L_KS + (kb * 32 + r32) * KP + ks * 32 + hh * 16);
        s = __builtin_amdgcn_mfma_f32_32x32x16_bf16(kf, qf[ks], s, 0, 0, 0);
    }
    return s;
}
__device__ __forceinline__ void softmax_pv(f32x16 (&s)[2], float& m, float& l, f32x16 (&O)[2], const LAS unsigned char* lds, int r32, int hh) {
    float mx = s[0][0];
#pragma unroll
    for (int r = 1; r < 16; ++r) mx = fmaxf(mx, s[0][r]);
#pragma unroll
    for (int r = 0; r < 16; ++r) mx = fmaxf(mx, s[1][r]);
    mx = xhalf_max(mx);
    __builtin_amdgcn_sched_barrier(0);
    const float mn = fmaxf(m, mx);
    const float alpha = __builtin_amdgcn_exp2f(m - mn);
    m = mn; l *= alpha;
#pragma unroll
    for (int r = 0; r < 16; ++r) { O[0][r] *= alpha; O[1][r] *= alpha; }
    float ps = 0.f;
#pragma unroll
    for (int kb = 0; kb < 2; ++kb)
#pragma unroll
        for (int r = 0; r < 16; ++r) { const float p = __builtin_amdgcn_exp2f(s[kb][r] - mn); s[kb][r] = p; ps += p; }
    l += ps;
    __builtin_amdgcn_sched_barrier(0);
#pragma unroll
    for (int kb = 0; kb < 2; ++kb)
#pragma unroll
        for (int sk = 0; sk < 2; ++sk) {
            __builtin_amdgcn_sched_barrier(0);
            u32x4 pw; pw.x = pkbf(s[kb][8 * sk + 0], s[kb][8 * sk + 1]); pw.y = pkbf(s[kb][8 * sk + 2], s[kb][8 * sk + 3]);
            pw.z = pkbf(s[kb][8 * sk + 4], s[kb][8 * sk + 5]); pw.w = pkbf(s[kb][8 * sk + 6], s[kb][8 * sk + 7]);
            const bf16x8 pf = __builtin_bit_cast(bf16x8, pw);
#pragma unroll
            for (int dvb = 0; dvb < 2; ++dvb) {
                const LAS unsigned char* a = lds + L_VT + (dvb * 32 + r32) * VP + (kb * 32 + 16 * sk + 4 * hh) * 2;
                const s16x4 lo = *(const LAS s16x4*)a, hi = *(const LAS s16x4*)(a + 16);
                const bf16x8 vf = {lo[0], lo[1], lo[2], lo[3], hi[0], hi[1], hi[2], hi[3]};
                O[dvb] = __builtin_amdgcn_mfma_f32_32x32x16_bf16(vf, pf, O[dvb], 0, 0, 0);
            }
        }
}
__device__ __forceinline__ void store_o(const f32x16 (&o)[2], bf16_t* orow, int hh) {
#pragma unroll
    for (int dvb = 0; dvb < 2; ++dvb)
#pragma unroll
        for (int g = 0; g < 4; ++g) {
            u32x2 w; w.x = pkbf(o[dvb][4 * g], o[dvb][4 * g + 1]); w.y = pkbf(o[dvb][4 * g + 2], o[dvb][4 * g + 3]);
            *(u32x2*)(orow + dvb * 32 + 8 * g + 4 * hh) = w;
        }
}

__device__ __forceinline__ void unit_A_safe(const bool CTXQ, LAS unsigned char* lds, const bf16_t* H, bf16_t* Ob, int b, int h, int qb, float lam, float ofac, const float* subw) {
    const int tid = pg8_ltid(), lane = tid & 63, r32 = lane & 31, hh = lane >> 5, wid = tid >> 6;
    const int qrow = CTXQ ? (ML + b * CTXL + wid * 32 + r32) : (b * SEQ + qb * 256 + wid * 32 + r32);
    const int qcol = h * 64, kcol = 256 + h * 64, vcol = 512 + h * 64;
    bf16x8 qf[4];
#pragma unroll
    for (int ks = 0; ks < 4; ++ks) qf[ks] = *(const bf16x8*)(H + (size_t)qrow * INC + qcol + 16 * ks + 8 * hh);
    const int NT = CTXQ ? 4 : 132;
    f32x16 O1[2], O2[2];
#pragma unroll
    for (int r = 0; r < 16; ++r) { O1[0][r] = 0.f; O1[1][r] = 0.f; O2[0][r] = 0.f; O2[1][r] = 0.f; }
    float m1 = -INFINITY, m2 = -INFINITY, l1 = 0.f, l2 = 0.f;
    TileRegs R;
    tile_gload(R, H, CTXQ ? (ML + b * CTXL) : (b * SEQ), kcol, vcol, tid);
    for (int t = 0; t < NT; ++t) {
        __syncthreads();
        tile_swrite(R, lds, tid);
        __syncthreads();
        if (t + 1 < NT) { const int tn = t + 1; const int krow = CTXQ ? (ML + b * CTXL + 64 * tn) : (tn < 128 ? b * SEQ + 64 * tn : ML + b * CTXL + 64 * (tn - 128)); tile_gload(R, H, krow, kcol, vcol, tid); }
        { f32x16 s[2]; s[0] = qk_block<0, 2>(lds, 0, r32, hh, qf); s[1] = qk_block<0, 2>(lds, 1, r32, hh, qf); softmax_pv(s, m1, l1, O1, lds, r32, hh); }
        __builtin_amdgcn_sched_barrier(0);
        { f32x16 s[2]; s[0] = qk_block<2, 2>(lds, 0, r32, hh, qf); s[1] = qk_block<2, 2>(lds, 1, r32, hh, qf); softmax_pv(s, m2, l2, O2, lds, r32, hh); }
        __builtin_amdgcn_sched_barrier(0);
    }
    l1 = xhalf_sum(l1); l2 = xhalf_sum(l2);
    const float i1 = 1.f / l1, i2 = lam / l2;
    float ss = 0.f;
#pragma unroll
    for (int dvb = 0; dvb < 2; ++dvb)
#pragma unroll
        for (int r = 0; r < 16; ++r) { const float o = O1[dvb][r] * i1 - O2[dvb][r] * i2; O1[dvb][r] = o; ss += o * o; }
    ss = xhalf_sum(ss);
    float li_ = ofac; asm volatile("" : "+s"(li_));
    const float rn = rsqrtf(ss * (1.f / 64.f) + 1e-6f) * (1.f - li_);
#pragma unroll
    for (int dvb = 0; dvb < 2; ++dvb)
#pragma unroll
        for (int g = 0; g < 4; ++g) {
            const f32x4 w = *(const f32x4*)(subw + dvb * 32 + 8 * g + 4 * hh);
#pragma unroll
            for (int e = 0; e < 4; ++e) O1[dvb][4 * g + e] *= rn * w[e];
        }
    store_o(O1, Ob + (size_t)qrow * DM + h * 64, hh);
}


constexpr int A_KP = 144, A_VP = 192, A_VOFF = 64 * A_KP, A_BUF = A_VOFF + 64 * A_VP;
constexpr float ATHR = 10.f;
typedef short v4i16_t __attribute__((ext_vector_type(4)));
__device__ __forceinline__ s16x4 vtr(const LAS unsigned char* p) { return __builtin_bit_cast(s16x4, __builtin_amdgcn_ds_read_tr16_b64_v4i16((LAS v4i16_t*)p)); }
__device__ __forceinline__ void tileA_swrite(const TileRegs& R, LAS unsigned char* buf, int tid) {
    const int key = tid >> 3, ch = tid & 7;
    *(LAS u32x4*)(buf + key * A_KP + ch * 16) = R.k;
    *(LAS u32x4*)(buf + A_VOFF + key * A_VP + ch * 16) = R.v;
}
__device__ __forceinline__ float max16(const f32x16& s) {
    float a = fmaxf(fmaxf(s[0], s[1]), s[2]), b = fmaxf(fmaxf(s[3], s[4]), s[5]), c = fmaxf(fmaxf(s[6], s[7]), s[8]), d = fmaxf(fmaxf(s[9], s[10]), s[11]);
    a = fmaxf(fmaxf(a, s[12]), s[13]); b = fmaxf(fmaxf(b, s[14]), s[15]);
    return fmaxf(fmaxf(a, b), fmaxf(c, d));
}
__device__ __forceinline__ float expsum16(f32x16& s) {
    float a = 0.f, b = 0.f, c = 0.f, d = 0.f;
#pragma unroll
    for (int r = 0; r < 16; r += 4) {
        s[r] = __builtin_amdgcn_exp2f(s[r]); s[r + 1] = __builtin_amdgcn_exp2f(s[r + 1]); s[r + 2] = __builtin_amdgcn_exp2f(s[r + 2]); s[r + 3] = __builtin_amdgcn_exp2f(s[r + 3]);
        a += s[r]; b += s[r + 1]; c += s[r + 2]; d += s[r + 3];
    }
    return (a + b) + (c + d);
}
__device__ __forceinline__ bf16x8 packp(const f32x16& s, int sk) {
    u32x4 pw; pw.x = pkbf(s[8 * sk + 0], s[8 * sk + 1]); pw.y = pkbf(s[8 * sk + 2], s[8 * sk + 3]); pw.z = pkbf(s[8 * sk + 4], s[8 * sk + 5]); pw.w = pkbf(s[8 * sk + 6], s[8 * sk + 7]);
    return __builtin_bit_cast(bf16x8, pw);
}
__device__ __forceinline__ void exp16(f32x16& s) {
#pragma unroll
    for (int r = 0; r < 16; ++r) s[r] = __builtin_amdgcn_exp2f(s[r]);
}
constexpr float AREF = 20.f, AGUARD = 60.f;
#ifndef SGB_V
#define SGB_V 5
#endif
template <bool HAVE>
__device__ __forceinline__ void stepA(bf16x8 (&pc)[2][2], const LAS unsigned char* kbuf, int kb, const LAS unsigned char* vb, const bf16x8 (&qv)[4], int r32, int hh,
                                      float mref1, float mref2, f32x16 (&O1)[2], f32x16 (&O2)[2], f32x16& L1, f32x16& L2, const bf16x8& ones) {
    const LAS unsigned char* kp = kbuf + (kb * 32 + r32) * A_KP + hh * 16;
    const bf16x8 k0 = *(const LAS bf16x8*)(kp), k1 = *(const LAS bf16x8*)(kp + 32), k2 = *(const LAS bf16x8*)(kp + 64), k3 = *(const LAS bf16x8*)(kp + 96);
    const bf16x8 q0 = qv[0], q1 = qv[1], q2 = qv[2], q3 = qv[3];
    bf16x8 vf[2][2];
#pragma unroll
    for (int sk = 0; sk < 2; ++sk)
#pragma unroll
        for (int dvb = 0; dvb < 2; ++dvb) {
            const LAS unsigned char* a = vb + 16 * sk * A_VP + dvb * 64;
            const s16x4 lo = vtr(a), hi = vtr(a + 8 * A_VP);
            vf[sk][dvb] = (bf16x8){lo[0], lo[1], lo[2], lo[3], hi[0], hi[1], hi[2], hi[3]};
        }
    const f32x16 z = {0.f, 0.f, 0.f, 0.f, 0.f, 0.f, 0.f, 0.f, 0.f, 0.f, 0.f, 0.f, 0.f, 0.f, 0.f, 0.f};
    f32x16 s1 = __builtin_amdgcn_mfma_f32_32x32x16_bf16(k0, q0, z, 0, 0, 0);
    f32x16 s2 = __builtin_amdgcn_mfma_f32_32x32x16_bf16(k2, q2, z, 0, 0, 0);
    s1 = __builtin_amdgcn_mfma_f32_32x32x16_bf16(k1, q1, s1, 0, 0, 0);
    s2 = __builtin_amdgcn_mfma_f32_32x32x16_bf16(k3, q3, s2, 0, 0, 0);
#pragma unroll
    for (int sk = 0; sk < 2; ++sk) {
        L1 = __builtin_amdgcn_mfma_f32_32x32x16_bf16(ones, pc[0][sk], L1, 0, 0, 0);
        L2 = __builtin_amdgcn_mfma_f32_32x32x16_bf16(ones, pc[1][sk], L2, 0, 0, 0);
#pragma unroll
        for (int dvb = 0; dvb < 2; ++dvb) {
            O1[dvb] = __builtin_amdgcn_mfma_f32_32x32x16_bf16(vf[sk][dvb], pc[0][sk], O1[dvb], 0, 0, 0);
            O2[dvb] = __builtin_amdgcn_mfma_f32_32x32x16_bf16(vf[sk][dvb], pc[1][sk], O2[dvb], 0, 0, 0);
        }
    }
    if (HAVE) {
#pragma unroll
        for (int r = 0; r < 16; ++r) { s1[r] -= mref1; s2[r] -= mref2; }
    }
    exp16(s1); exp16(s2);
    bf16x8 pn[2][2];
    pn[0][0] = packp(s1, 0); pn[0][1] = packp(s1, 1); pn[1][0] = packp(s2, 0); pn[1][1] = packp(s2, 1);
#if 0
    __builtin_amdgcn_sched_group_barrier(0x008, 6, 0);
#pragma unroll
    for (int i = 0; i < 10; ++i) { __builtin_amdgcn_sched_group_barrier(0x002, SGB_V, 0); __builtin_amdgcn_sched_group_barrier(0x008, 1, 0); }
    __builtin_amdgcn_sched_group_barrier(0x002, 48, 0);
#endif
    pc[0][0] = pn[0][0]; pc[0][1] = pn[0][1]; pc[1][0] = pn[1][0]; pc[1][1] = pn[1][1];
}
__device__ __forceinline__ void unit_A(const bool CTXQ, LAS unsigned char* lds, const bf16_t* H, bf16_t* Ob, int b, int h, int qb, float lam, float ofac, const float* subw) {
    const int tid = pg8_ltid(), lane = tid & 63, r32 = lane & 31, hh = lane >> 5, wid = tid >> 6;
    const int qrow = CTXQ ? (ML + b * CTXL + wid * 32 + r32) : (b * SEQ + qb * 256 + wid * 32 + r32);
    const int qcol = h * 64, kcol = 256 + h * 64, vcol = 512 + h * 64;
    const int NT = CTXQ ? 4 : 132;
    f32x16 O1[2], O2[2], L1, L2;
#pragma unroll
    for (int r = 0; r < 16; ++r) { O1[0][r] = 0.f; O1[1][r] = 0.f; O2[0][r] = 0.f; O2[1][r] = 0.f; L1[r] = 0.f; L2[r] = 0.f; }
    const bf16x8 ones = {0x3F80, 0x3F80, 0x3F80, 0x3F80, 0x3F80, 0x3F80, 0x3F80, 0x3F80};
    const int voff = A_VOFF + (4 * hh + ((lane & 15) >> 2)) * A_VP + (((lane >> 4) & 1) * 16 + (lane & 3) * 4) * 2;
    const int krow0 = CTXQ ? (ML + b * CTXL) : (b * SEQ);
    LAS unsigned char* qs = lds + 3 * A_BUF + (wid * 32 + r32) * A_KP + hh * 16;
    volatile LAS unsigned* flag = (volatile LAS unsigned*)(lds + RING_BYTES + 128);
    TileRegs R;
    __syncthreads();
    if (tid == 0) *flag = 0u;
#pragma unroll
    for (int ks = 0; ks < 4; ++ks) *(LAS bf16x8*)(qs + ks * 32) = *(const bf16x8*)(H + (size_t)qrow * INC + qcol + 16 * ks + 8 * hh);
    tile_gload(R, H, krow0, kcol, vcol, tid);       tileA_swrite(R, lds, tid);
    tile_gload(R, H, krow0 + 64, kcol, vcol, tid);  tileA_swrite(R, lds + A_BUF, tid);
    tile_gload(R, H, krow0 + 128, kcol, vcol, tid);
    __syncthreads();
    bf16x8 pc[2][2];
    {
        const LAS unsigned char* kp = lds + r32 * A_KP + hh * 16;
        const f32x16 z = {0.f, 0.f, 0.f, 0.f, 0.f, 0.f, 0.f, 0.f, 0.f, 0.f, 0.f, 0.f, 0.f, 0.f, 0.f, 0.f};
        f32x16 sa1 = __builtin_amdgcn_mfma_f32_32x32x16_bf16(*(const LAS bf16x8*)(kp), *(const LAS bf16x8*)(qs), z, 0, 0, 0);
        sa1 = __builtin_amdgcn_mfma_f32_32x32x16_bf16(*(const LAS bf16x8*)(kp + 32), *(const LAS bf16x8*)(qs + 32), sa1, 0, 0, 0);
        f32x16 sa2 = __builtin_amdgcn_mfma_f32_32x32x16_bf16(*(const LAS bf16x8*)(kp + 64), *(const LAS bf16x8*)(qs + 64), z, 0, 0, 0);
        sa2 = __builtin_amdgcn_mfma_f32_32x32x16_bf16(*(const LAS bf16x8*)(kp + 96), *(const LAS bf16x8*)(qs + 96), sa2, 0, 0, 0);
        exp16(sa1); exp16(sa2);
        pc[0][0] = packp(sa1, 0); pc[0][1] = packp(sa1, 1); pc[1][0] = packp(sa2, 0); pc[1][1] = packp(sa2, 1);
    }
    bf16x8 qv[4];
#pragma unroll
    for (int ks = 0; ks < 4; ++ks) qv[ks] = *(const LAS bf16x8*)(qs + ks * 32);
    int bc = 0, t = 0;
#define UNITA_STAGE() \
        const int bn = (bc == 2 * A_BUF) ? 0 : bc + A_BUF, bw = (bn == 2 * A_BUF) ? 0 : bn + A_BUF; \
        if (t + 2 < NT) { \
            tileA_swrite(R, lds + bw, tid); \
            if (t + 3 < NT) { const int tn = t + 3; const int krow = CTXQ ? (krow0 + 64 * tn) : (tn < 128 ? b * SEQ + 64 * tn : ML + b * CTXL + 64 * (tn - 128)); tile_gload(R, H, krow, kcol, vcol, tid); } \
        }
#define UNITA_GUARD() (__any((L1[0] > 1.152921504606846976e18f) || (L2[0] > 1.152921504606846976e18f)) != 0)
    {
        for (; t < NT; ++t) {
            UNITA_STAGE()
            stepA<false>(pc, lds + bc, 1, lds + bc + voff, qv, r32, hh, 0.f, 0.f, O1, O2, L1, L2, ones);
            stepA<false>(pc, lds + bn, 0, lds + bc + voff + 32 * A_VP, qv, r32, hh, 0.f, 0.f, O1, O2, L1, L2, ones);
            __syncthreads();
            bc = bn;
        }
    }
#undef UNITA_STAGE
#undef UNITA_GUARD
    if (__any(!((L1[0] > 1e-30f) && (L1[0] < 1e30f) && (L2[0] > 1e-30f) && (L2[0] < 1e30f))) != 0) *flag = 1u;
    __syncthreads();
    if (*flag != 0u) { unit_A_safe(CTXQ, lds, H, Ob, b, h, qb, lam, ofac, subw); return; }
    const float i1 = 1.f / L1[0], i2 = lam / L2[0];
    float ss = 0.f;
#pragma unroll
    for (int dvb = 0; dvb < 2; ++dvb)
#pragma unroll
        for (int r = 0; r < 16; ++r) { const float o = O1[dvb][r] * i1 - O2[dvb][r] * i2; O1[dvb][r] = o; ss += o * o; }
    ss = xhalf_sum(ss);
    float li_ = ofac; asm volatile("" : "+s"(li_));
    const float rn = rsqrtf(ss * (1.f / 64.f) + 1e-6f) * (1.f - li_);
#pragma unroll
    for (int dvb = 0; dvb < 2; ++dvb)
#pragma unroll
        for (int g = 0; g < 4; ++g) {
            const f32x4 w = *(const f32x4*)(subw + dvb * 32 + 8 * g + 4 * hh);
#pragma unroll
            for (int e = 0; e < 4; ++e) O1[dvb][4 * g + e] *= rn * w[e];
        }
    store_o(O1, Ob + (size_t)qrow * DM + h * 64, hh);
}

template <int MODE> __device__ __forceinline__ int tile_row_f(int t, int b, int lo, int nloc) {
    if (MODE == 1) return (t < nloc) ? (b * SEQ + 64 * (lo + t)) : (ML + b * CTXL + 64 * (t - nloc));
    if (MODE == 2) return (t < 4) ? (ML + b * CTXL + 64 * t) : (b * SEQ + 64 * (lo + t - 4));
    return ML + b * CTXL + 64 * t;
}
__device__ __forceinline__ int tile_row_r(int MODE, int t, int b, int lo, int nloc) {
    if (MODE == 1) return (t < nloc) ? (b * SEQ + 64 * (lo + t)) : (ML + b * CTXL + 64 * (t - nloc));
    if (MODE == 2) return (t < 4) ? (ML + b * CTXL + 64 * t) : (b * SEQ + 64 * (lo + t - 4));
    return ML + b * CTXL + 64 * t;
}
__device__ __forceinline__ void unit_BC(const int MODE, LAS unsigned char* lds, const bf16_t* H, bf16_t* Ob, int b, int hd, int blk, const float* sink_l, const float* rpb_l) {
    const int tid = pg8_ltid(), lane = tid & 63, r32 = lane & 31, hh = lane >> 5, wid = tid >> 6;
    int qrow, qcol, kcol, vcol, ocol, qpos = 0, r_w = 0, qc = 0, lo = 0, nloc = 0;
    float m = -INFINITY, l = 0.f;
    if (MODE == 1) {
        const int g = wid >> 2, head = hd * 2 + g; qpos = 128 * blk + 32 * (wid & 3) + r32; qrow = b * SEQ + qpos;
        qcol = 768 + head * 64; kcol = 1024 + hd * 64; vcol = 1152 + hd * 64; ocol = 256 + head * 64;
        lo = 2 * blk - 2; if (lo < 0) lo = 0; int hi = 2 * blk + 3; if (hi > 127) hi = 127; nloc = hi - lo + 1;
        m = sink_l[head] * LOG2E; l = (hh == 0) ? 1.f : 0.f;
    } else if (MODE == 3) {
        const int head = hd * 2 + blk; qrow = ML + b * CTXL + wid * 32 + r32;
        qcol = 768 + head * 64; kcol = 1024 + hd * 64; vcol = 1152 + hd * 64; ocol = 256 + head * 64;
        m = sink_l[head] * LOG2E; l = (hh == 0) ? 1.f : 0.f;
    } else if (MODE == 2) {
        r_w = 4 * blk + (wid >> 1); qc = 32 * (wid & 1) + r32; qrow = b * SEQ + r_w * 64 + qc;
        qcol = 1280 + hd * 64; kcol = 1536 + hd * 64; vcol = 1792 + hd * 64; ocol = 512 + hd * 64;
        int a0 = 4 * blk - 4; if (a0 < 0) a0 = 0; if (a0 > 120) a0 = 120; int a3 = 4 * blk + 3 - 4; if (a3 < 0) a3 = 0; if (a3 > 120) a3 = 120;
        lo = a0; nloc = a3 + 7 - a0 + 1;
    } else {
        qrow = ML + b * CTXL + wid * 32 + r32;
        qcol = 1280 + hd * 64; kcol = 1536 + hd * 64; vcol = 1792 + hd * 64; ocol = 512 + hd * 64;
    }
    bf16x8 qf[4];
#pragma unroll
    for (int ks = 0; ks < 4; ++ks) qf[ks] = *(const bf16x8*)(H + (size_t)qrow * INC + qcol + 16 * ks + 8 * hh);
    f32x16 O[2];
#pragma unroll
    for (int r = 0; r < 16; ++r) { O[0][r] = 0.f; O[1][r] = 0.f; }
    const int NT = 4 + nloc;
    int rs = 0;
    if (MODE == 2) { rs = r_w - 4; if (rs < 0) rs = 0; if (rs > 120) rs = 120; }
    const LAS float* rpbs = (const LAS float*)(lds + L_RPB);
    TileRegs R;
    tile_gload(R, H, tile_row_r(MODE, 0, b, lo, nloc), kcol, vcol, tid);
    for (int t = 0; t < NT; ++t) {
        __syncthreads();
        tile_swrite(R, lds, tid);
        if (MODE == 2 && t == 0) { for (int i = tid; i < 465; i += 512) ((LAS float*)(lds + L_RPB))[i] = rpb_l[hd * 465 + i] * LOG2E; }
        __syncthreads();
        if (t + 1 < NT) tile_gload(R, H, tile_row_r(MODE, t + 1, b, lo, nloc), kcol, vcol, tid);
        bool active = true; int kr = 0;
        if (MODE == 2 && t >= 4) { kr = lo + t - 4; active = (kr >= rs) && (kr < rs + 8); }
        if (active) {
            f32x16 s[2]; s[0] = qk_block<0, 4>(lds, 0, r32, hh, qf); s[1] = qk_block<0, 4>(lds, 1, r32, hh, qf);
            if (MODE == 1 && t < nloc) {
                const int kbase = 64 * (lo + t) - qpos;
#pragma unroll
                for (int kb = 0; kb < 2; ++kb)
#pragma unroll
                    for (int r = 0; r < 16; ++r) { const int d = kbase + kb * 32 + crow(r, hh); if (d > 128 || d < -128) s[kb][r] = -INFINITY; }
            }
            if (MODE == 2 && t >= 4) {
                int cs = qc - 8; if (cs < 0) cs = 0; if (cs > 48) cs = 48;
                const int bbase = (kr - r_w + 7) * 31 + 15 - qc;
#pragma unroll
                for (int kb = 0; kb < 2; ++kb)
#pragma unroll
                    for (int r = 0; r < 16; ++r) {
                        const int kc = kb * 32 + crow(r, hh);
                        const bool ok = (kc >= cs) && (kc < cs + 16);
                        int bi = bbase + kc; bi = ok ? bi : 0;
                        const float bias = rpbs[bi];
                        s[kb][r] = ok ? (s[kb][r] + bias) : -INFINITY;
                    }
            }
            softmax_pv(s, m, l, O, lds, r32, hh);
        }
    }
    l = xhalf_sum(l);
    const float il = 1.f / l;
#pragma unroll
    for (int r = 0; r < 16; ++r) { O[0][r] *= il; O[1][r] *= il; }
    store_o(O, Ob + (size_t)qrow * DM + ocol, hh);
}

template <int MODE>
__device__ __forceinline__ void bcf_compute(const LAS unsigned char* cur, int t, int nloc, int lo, int qpos, int kr, int r_w, int qc, const bf16x8 (&qf)[4], f32x16 (&O)[2], f32x16& L,
                                            const bf16x8& ones, const LAS float* rpbs, int voff, int r32, int hh) {
    f32x16 s[2];
    const f32x16 z = {0.f, 0.f, 0.f, 0.f, 0.f, 0.f, 0.f, 0.f, 0.f, 0.f, 0.f, 0.f, 0.f, 0.f, 0.f, 0.f};
#pragma unroll
    for (int kb = 0; kb < 2; ++kb) {
        const LAS unsigned char* kp = cur + (kb * 32 + r32) * A_KP + hh * 16;
        s[kb] = __builtin_amdgcn_mfma_f32_32x32x16_bf16(*(const LAS bf16x8*)(kp), qf[0], z, 0, 0, 0);
        s[kb] = __builtin_amdgcn_mfma_f32_32x32x16_bf16(*(const LAS bf16x8*)(kp + 32), qf[1], s[kb], 0, 0, 0);
        s[kb] = __builtin_amdgcn_mfma_f32_32x32x16_bf16(*(const LAS bf16x8*)(kp + 64), qf[2], s[kb], 0, 0, 0);
        s[kb] = __builtin_amdgcn_mfma_f32_32x32x16_bf16(*(const LAS bf16x8*)(kp + 96), qf[3], s[kb], 0, 0, 0);
    }
    if (MODE == 1 && t < nloc) {
        const int kbase = 64 * (lo + t) - qpos;
#pragma unroll
        for (int kb = 0; kb < 2; ++kb)
#pragma unroll
            for (int r = 0; r < 16; ++r) { const int d = kbase + kb * 32 + crow(r, hh); if (d > 128 || d < -128) s[kb][r] = -INFINITY; }
    }
    if (MODE == 2 && t >= 4) {
        int cs = qc - 8; if (cs < 0) cs = 0; if (cs > 48) cs = 48;
        const int bbase = (kr - r_w + 7) * 31 + 15 - qc;
#pragma unroll
        for (int kb = 0; kb < 2; ++kb)
#pragma unroll
            for (int r = 0; r < 16; ++r) {
                const int kc = kb * 32 + crow(r, hh);
                const bool ok = (kc >= cs) && (kc < cs + 16);
                int bi = bbase + kc; bi = ok ? bi : 0;
                const float bias = rpbs[bi];
                s[kb][r] = ok ? (s[kb][r] + bias) : -INFINITY;
            }
    }
#pragma unroll
    for (int kb = 0; kb < 2; ++kb) {
        exp16(s[kb]);
#pragma unroll
        for (int sk = 0; sk < 2; ++sk) {
            const bf16x8 p = packp(s[kb], sk);
            L = __builtin_amdgcn_mfma_f32_32x32x16_bf16(ones, p, L, 0, 0, 0);
#pragma unroll
            for (int dvb = 0; dvb < 2; ++dvb) {
                const LAS unsigned char* a = cur + voff + (kb * 32 + 16 * sk) * A_VP + dvb * 64;
                const s16x4 vlo = vtr(a), vhi = vtr(a + 8 * A_VP);
                const bf16x8 vf = {vlo[0], vlo[1], vlo[2], vlo[3], vhi[0], vhi[1], vhi[2], vhi[3]};
                O[dvb] = __builtin_amdgcn_mfma_f32_32x32x16_bf16(vf, p, O[dvb], 0, 0, 0);
            }
        }
    }
}
template <int MODE>
__device__ __forceinline__ bool unit_BC_fast(LAS unsigned char* lds, const bf16_t* H, bf16_t* Ob, int b, int hd, int blk, const float* sink_l, const float* rpb_l) {
    const int tid = pg8_ltid(), lane = tid & 63, r32 = lane & 31, hh = lane >> 5, wid = tid >> 6;
    int qrow, qcol, kcol, vcol, ocol, qpos = 0, r_w = 0, qc = 0, lo = 0, nloc = 0;
    float linit = 0.f;
    if (MODE == 1) {
        const int g = wid >> 2, head = hd * 2 + g; qpos = 128 * blk + 32 * (wid & 3) + r32; qrow = b * SEQ + qpos;
        qcol = 768 + head * 64; kcol = 1024 + hd * 64; vcol = 1152 + hd * 64; ocol = 256 + head * 64;
        lo = 2 * blk - 2; if (lo < 0) lo = 0; int hi = 2 * blk + 3; if (hi > 127) hi = 127; nloc = hi - lo + 1;
        linit = __builtin_amdgcn_exp2f(sink_l[head] * LOG2E);
    } else if (MODE == 3) {
        const int head = hd * 2 + blk; qrow = ML + b * CTXL + wid * 32 + r32;
        qcol = 768 + head * 64; kcol = 1024 + hd * 64; vcol = 1152 + hd * 64; ocol = 256 + head * 64;
        linit = __builtin_amdgcn_exp2f(sink_l[head] * LOG2E);
    } else if (MODE == 2) {
        r_w = 4 * blk + (wid >> 1); qc = 32 * (wid & 1) + r32; qrow = b * SEQ + r_w * 64 + qc;
        qcol = 1280 + hd * 64; kcol = 1536 + hd * 64; vcol = 1792 + hd * 64; ocol = 512 + hd * 64;
        int a0 = 4 * blk - 4; if (a0 < 0) a0 = 0; if (a0 > 120) a0 = 120; int a3 = 4 * blk + 3 - 4; if (a3 < 0) a3 = 0; if (a3 > 120) a3 = 120;
        lo = a0; nloc = a3 + 7 - a0 + 1;
    } else {
        qrow = ML + b * CTXL + wid * 32 + r32;
        qcol = 1280 + hd * 64; kcol = 1536 + hd * 64; vcol = 1792 + hd * 64; ocol = 512 + hd * 64;
    }
    bf16x8 qf[4];
#pragma unroll
    for (int ks = 0; ks < 4; ++ks) qf[ks] = *(const bf16x8*)(H + (size_t)qrow * INC + qcol + 16 * ks + 8 * hh);
    f32x16 O[2], L;
#pragma unroll
    for (int r = 0; r < 16; ++r) { O[0][r] = 0.f; O[1][r] = 0.f; L[r] = linit; }
    const bf16x8 ones = {0x3F80, 0x3F80, 0x3F80, 0x3F80, 0x3F80, 0x3F80, 0x3F80, 0x3F80};
    const int NT = 4 + nloc;
    int rs = 0;
    if (MODE == 2) { rs = r_w - 4; if (rs < 0) rs = 0; if (rs > 120) rs = 120; }
    const int voff = A_VOFF + (4 * hh + ((lane & 15) >> 2)) * A_VP + (((lane >> 4) & 1) * 16 + (lane & 3) * 4) * 2;
    LAS float* rpbs = (LAS float*)(lds + 2 * A_BUF);
    volatile LAS unsigned* flag = (volatile LAS unsigned*)(lds + RING_BYTES + 128);
    TileRegs Ra, Rb;
    __syncthreads();
    if (tid == 0) *flag = 0u;
    if (MODE == 2) { for (int i = tid; i < 465; i += 512) rpbs[i] = rpb_l[hd * 465 + i] * LOG2E; }
    tile_gload(Ra, H, tile_row_f<MODE>(0, b, lo, nloc), kcol, vcol, tid);
    tileA_swrite(Ra, lds, tid);
    tile_gload(Rb, H, tile_row_f<MODE>(1, b, lo, nloc), kcol, vcol, tid);
    tile_gload(Ra, H, tile_row_f<MODE>(2, b, lo, nloc), kcol, vcol, tid);
    __syncthreads();
#define BCF_TILE(T, RS) { \
        const int t = (T); \
        const LAS unsigned char* cur = lds + (t & 1) * A_BUF; \
        if (t + 1 < NT) { \
            tileA_swrite(RS, lds + ((t + 1) & 1) * A_BUF, tid); \
            if (t + 3 < NT) tile_gload(RS, H, tile_row_f<MODE>(t + 3, b, lo, nloc), kcol, vcol, tid); \
        } \
        bool active = true; int kr = 0; \
        if (MODE == 2 && t >= 4) { kr = lo + t - 4; active = (kr >= rs) && (kr < rs + 8); } \
        if (active) bcf_compute<MODE>(cur, t, nloc, lo, qpos, kr, r_w, qc, qf, O, L, ones, rpbs, voff, r32, hh); \
        __syncthreads(); }
    for (int t2 = 0; t2 < NT; t2 += 2) {
        BCF_TILE(t2, Rb)
        if (t2 + 1 < NT) BCF_TILE(t2 + 1, Ra)
    }
#undef BCF_TILE
    const float lsum = L[0];
    if (__any(!((lsum > 1e-30f) && (lsum < 1e30f))) != 0) *flag = 1u;
    __syncthreads();
    if (*flag != 0u) return true;
    const float il = 1.f / lsum;
#pragma unroll
    for (int r = 0; r < 16; ++r) { O[0][r] *= il; O[1][r] *= il; }
    store_o(O, Ob + (size_t)qrow * DM + ocol, hh);
    return false;
}
}
__device__ __forceinline__ float silu_f(float v) { return v / (1.f + __expf(-v)); }

__device__ __forceinline__ int wrow_map(int type, int n) {
    if (type == 1) {
        const bool ropeA = n < 512, ropeB = (n >= 768 && n < 1152);
        if (!ropeA && !ropeB) return n;
        int p = n & 31;
        if (ropeA) { const int blk = p >> 3; p = (blk == 1) ? p + 8 : ((blk == 2) ? p - 8 : p); }
        const int nn = p >> 4, r = p & 15;
        return (n & ~31) + 8 * (r >> 2) + 4 * nn + (r & 3);
    }
    if (type == 2) { const int half = (n >= 2816) ? 1 : 0; const int j = n - half * 2816; return (j >> 7) * 256 + half * 128 + (j & 127); }
    return n;
}
__device__ __forceinline__ void transpose_item(const float* W, int K, int N, bf16_t* WT, int type, LAS float* scr, int item, int lane) {
    const int nblk = N / 64, kb = item / nblk, nb = item - kb * nblk, k0 = 64 * kb, n0 = 64 * nb;
    const int lr = lane >> 4, lc = (lane & 15) * 4;
#pragma unroll 8
    for (int i = 0; i < 16; ++i) {
        const int kk = 4 * i + lr;
        const f32x4 v = *(const f32x4*)(W + (size_t)(k0 + kk) * N + n0 + lc);
        LAS float* d = scr + kk * 65 + lc; d[0] = v[0]; d[1] = v[1]; d[2] = v[2]; d[3] = v[3];
    }
    asm volatile("s_waitcnt lgkmcnt(0)" ::: "memory");
    const int c = lane & 7;
#pragma unroll
    for (int j = 0; j < 8; ++j) {
        const int n = (lane >> 3) + 8 * j; const LAS float* s = scr + (8 * c) * 65 + n;
        u32x4 o; o.x = pkbf(s[0 * 65], s[1 * 65]); o.y = pkbf(s[2 * 65], s[3 * 65]); o.z = pkbf(s[4 * 65], s[5 * 65]); o.w = pkbf(s[6 * 65], s[7 * 65]);
        *(u32x4*)(WT + (size_t)wrow_map(type, n0 + n) * K + k0 + 8 * c) = o;
    }
    asm volatile("s_waitcnt lgkmcnt(0)" ::: "memory");
}

__device__ __forceinline__ void sincos_f(float x, float& c, float& s) {
    const float k = rintf(x * 0.636619772f);
    float r = fmaf(-k, 1.57079625129699707031f, x); r = fmaf(-k, 7.54978941586159635335e-08f, r);
    const float r2 = r * r;
    const float sr = r * (1.f + r2 * (-1.f / 6 + r2 * (1.f / 120 + r2 * (-1.f / 5040 + r2 * (1.f / 362880)))));
    const float cr = 1.f + r2 * (-0.5f + r2 * (1.f / 24 + r2 * (-1.f / 720 + r2 * (1.f / 40320 + r2 * (-1.f / 3628800)))));
    const int q = ((int)k) & 3;
    s = (q == 0) ? sr : (q == 1) ? cr : (q == 2) ? -sr : -cr;
    c = (q == 0) ? cr : (q == 1) ? -sr : (q == 2) ? -cr : sr;
}

__device__ __forceinline__ void norm_mod_row(const float* src, const float* nw, const float* sh, const float* sc, bf16_t* dst, int lane, const float* slab = nullptr, int nslab = 0, float* xout = nullptr, bool src16 = false) {
    u32x2* o8 = (u32x2*)dst + lane;
    if (src == nullptr) {
#pragma unroll
        for (int j = 0; j < 4; ++j) o8[64 * j] = (u32x2){0u, 0u};
        return;
    }
    const f32x4* xr = (const f32x4*)src + lane;
    f32x4 v[4]; float s = 0.f;
    if (src16) {
        const u32x2* xh = (const u32x2*)src + lane;
#pragma unroll
        for (int j = 0; j < 4; ++j) { const u32x2 w = xh[64 * j]; v[j] = (f32x4){bflo(w.x), bfhi(w.x), bflo(w.y), bfhi(w.y)}; }
    } else {
#pragma unroll
        for (int j = 0; j < 4; ++j) v[j] = xr[64 * j];
    }
    for (int p = 0; p < nslab; ++p) {
        const f32x4* sr = (const f32x4*)(slab + (size_t)p * 1024 * 1024) + lane;
#pragma unroll
        for (int j = 0; j < 4; ++j) v[j] += sr[64 * j];
    }
    if (xout != nullptr) {
#pragma unroll
        for (int j = 0; j < 4; ++j) ((f32x4*)xout + lane)[64 * j] = v[j];
    }
#pragma unroll
    for (int j = 0; j < 4; ++j) s += (v[j][0] * v[j][0] + v[j][1] * v[j][1]) + (v[j][2] * v[j][2] + v[j][3] * v[j][3]);
    const float rstd = rsqrtf(wave_sum(s, lane) * (1.f / 1024.f) + 1e-6f);
#pragma unroll
    for (int j = 0; j < 4; ++j) {
        const int k = 4 * (64 * j + lane);
        const f32x4 w = *(const f32x4*)(nw + k), a = *(const f32x4*)(sc + k), d = *(const f32x4*)(sh + k);
        f32x4 y;
#pragma unroll
        for (int e = 0; e < 4; ++e) y[e] = (v[j][e] * rstd * w[e]) * (1.f + a[e]) + d[e];
        u32x2 p; p.x = pkbf(y[0], y[1]); p.y = pkbf(y[2], y[3]);
        o8[64 * j] = p;
    }
}

#define XB_TMO      128
#define XB_XCNT(j)  (256  + 64 * (j))
#define XB_XSUB(j)  (1280 + 64 * (j))
#define XB_XGEN(j)  (2304 + 64 * (j))
#define XB_TOP      3328
#define XB_TOPGEN   3392
#define XCD_BAR_WORDS 3456
#define XB_SPIN_CAP (1u << 18)

__device__ __forceinline__ unsigned xb_ld(unsigned* p)              { return __hip_atomic_load(p, __ATOMIC_RELAXED, __HIP_MEMORY_SCOPE_AGENT); }
__device__ __forceinline__ unsigned xb_add(unsigned* p, unsigned v) { return __hip_atomic_fetch_add(p, v, __ATOMIC_RELAXED, __HIP_MEMORY_SCOPE_AGENT); }
__device__ __forceinline__ unsigned xb_xcc_id() { return (unsigned)__builtin_amdgcn_s_getreg((3 << 11) | 20) & 0xFu; }
#define XB_SPIN(cond, bar) do { unsigned _sp = 0; while (cond) { __builtin_amdgcn_s_sleep(1); \
    if ((++_sp & 255u) == 0u) { if (xb_ld(&(bar)[XB_TMO])) break; if (_sp > XB_SPIN_CAP) { atomicAdd(&(bar)[XB_TMO], 1u); break; } } } } while (0)

struct XcdBarrier {
    unsigned* bar; unsigned x;
    volatile LAS unsigned* st;
};

__device__ __forceinline__ XcdBarrier xcd_barrier_post(unsigned* bar, volatile LAS unsigned* st) {
    XcdBarrier b; b.bar = bar; b.x = xb_xcc_id(); b.st = st;
    if (threadIdx.x == 0) (void)xb_add(&bar[XB_XCNT(b.x)], 1u);
    return b;
}
__device__ __forceinline__ void xcd_barrier_complete(unsigned* bar, unsigned x, unsigned& nloc, unsigned& nx) {
    const unsigned G = gridDim.x * gridDim.y * gridDim.z;
    unsigned sum, cnt, mine, sp = 0u;
    for (;;) {
        sum = 0u; cnt = 0u; mine = 0u;
#pragma unroll
        for (unsigned j = 0; j < 16; ++j) { const unsigned c = xb_ld(&bar[XB_XCNT(j)]); sum += c; cnt += (c > 0u) ? 1u : 0u; mine = (j == x) ? c : mine; }
        if (sum == G) break;
        __builtin_amdgcn_s_sleep(1);
        if ((++sp & 255u) == 0u) { if (xb_ld(&bar[XB_TMO])) break; if (sp > XB_SPIN_CAP) { atomicAdd(&bar[XB_TMO], 1u); break; } }
    }
    nloc = mine > 0u ? mine : 1u; nx = cnt > 0u ? cnt : 1u;
}

__device__ __forceinline__ void xcd_barrier(const XcdBarrier& b) {
    asm volatile("s_waitcnt vmcnt(0)" ::: "memory");
    __syncthreads();
    if (threadIdx.x == 0) {
        unsigned* bar = b.bar;
        __builtin_amdgcn_s_waitcnt(0);
        unsigned nloc = b.st[0], nx = b.st[1];
        if (nloc == 0u) { xcd_barrier_complete(bar, b.x, nloc, nx); b.st[0] = nloc; b.st[1] = nx; }
        const unsigned old = xb_add(&bar[XB_XSUB(b.x)], 1u);
        const unsigned gen = old / nloc;
        if (old + 1u == (gen + 1u) * nloc) {
            __builtin_amdgcn_fence(__ATOMIC_RELEASE, "agent");
            asm volatile("s_waitcnt vmcnt(0)" ::: "memory");
            const unsigned og = xb_add(&bar[XB_TOP], 1u);
            const unsigned tg = og / nx;
            if (og + 1u == (tg + 1u) * nx) xb_add(&bar[XB_TOPGEN], 1u);
            else XB_SPIN(xb_ld(&bar[XB_TOPGEN]) == tg, bar);
            __builtin_amdgcn_fence(__ATOMIC_ACQUIRE, "agent");
            xb_add(&bar[XB_XGEN(b.x)], 1u);
            asm volatile("s_waitcnt vmcnt(0)" ::: "memory");
        } else {
            XB_SPIN(xb_ld(&bar[XB_XGEN(b.x)]) == gen, bar);
            __builtin_amdgcn_fence(__ATOMIC_ACQUIRE, "agent");
            asm volatile("s_waitcnt vmcnt(0)" ::: "memory");
        }
    }
    __syncthreads();
}

struct Args { const float* in[23]; float* out; unsigned char* ws; int ph_lo, ph_hi, coop, pad; };
typedef const __attribute__((address_space(4))) Args* KArgs;
__device__ __forceinline__ KArgs kargs() { KArgs p = (KArgs)__builtin_amdgcn_kernarg_segment_ptr(); asm volatile("" : "+s"(p)); return p; }
constexpr int N_PHASES = 2 + 7 * DEPTH + 1;

__global__ void __launch_bounds__(512, 2) fwd_kernel(Args a) {
    extern __shared__ __attribute__((aligned(16))) unsigned char lds_raw[];
    LAS unsigned char* lds = (LAS unsigned char*)lds_raw;
    volatile LAS unsigned* bar_st = (volatile LAS unsigned*)(lds + RING_BYTES + 64);
    if (threadIdx.x < 2) bar_st[threadIdx.x] = 0u;
    __syncthreads();
    if (kargs()->coop) (void)xcd_barrier_post((unsigned*)kargs()->ws, bar_st);
    const int ph_lo = kargs()->ph_lo, ph_hi = kargs()->ph_hi;
    for (int ph = ph_lo; ph < ph_hi; ++ph) {
        KArgs ka = kargs();
        const int tid = pg8_ltid(), lane = tid & 63, wave = __builtin_amdgcn_readfirstlane(tid >> 6);
        int G = gridDim.x, bx = blockIdx.x; asm volatile("" : "+s"(G), "+s"(bx));
        const int vcu = (G % 8 == 0) ? (bx % 8) * (G / 8) + bx / 8 : bx;
        const int gw = vcu * 8 + wave, NGW = G * 8;
        unsigned char* ws = ka->ws;
        float* MOD = (float*)(ws + WS_MOD); float* MODP = (float*)(ws + WS_MODP);
        float* tabA = (float*)(ws + WS_TAB); float* tabB = tabA + 128 * 8 * 2;
        float* XCA = (float*)(ws + WS_XC); float* XCB = (float*)(ws + WS_MODP);
        bf16_t* XN = (bf16_t*)(ws + WS_XN); bf16_t* Ob = (bf16_t*)(ws + WS_O); bf16_t* Hb = (bf16_t*)(ws + WS_H); bf16_t* ACT = Hb;
        float* XL = ka->out; bf16_t* XB = (bf16_t*)(ws + WS_XB);
        if (ph == 0) {
          {
            const float* w_mod = ka->in[6]; const float* c_in = ka->in[1]; const float* cctx_in = ka->in[3];
            for (int it = gw; it < 1536; it += NGW) {
                const int ks = it & 15, cgp = (it >> 4) % 24, l = it / 384;
                const int n0 = cgp * 256 + lane * 4;
                f32x4 acc[5];
#pragma unroll
                for (int s = 0; s < 5; ++s) acc[s] = (f32x4){0.f, 0.f, 0.f, 0.f};
                const float* wp = w_mod + ((size_t)l * 1024 + ks * 64) * 6144 + n0;
                for (int kk = 0; kk < 64; ++kk) {
                    const int k = ks * 64 + kk;
                    const f32x4 w = *(const f32x4*)(wp + (size_t)kk * 6144);
#pragma unroll
                    for (int s = 0; s < 4; ++s) acc[s] += silu_f(c_in[s * 1024 + k]) * w;
                    acc[4] += silu_f(cctx_in[k]) * w;
                }
#pragma unroll
                for (int s = 0; s < 5; ++s) *(f32x4*)(MODP + ((size_t)(ks * 4 + l) * 5 + s) * 6144 + n0) = acc[s];
            }
            LAS float* scr = (LAS float*)(lds + wave * 16768);
            for (int it = gw; it < 4 * 3072; it += NGW) {
                const int l = it / 3072; int r = it - l * 3072;
                unsigned char* wl = ws + WS_W + (size_t)l * W_LAYER;
                if (r < 704) { transpose_item(ka->in[8] + (size_t)l * 1024 * 2816, 1024, 2816, (bf16_t*)wl, 1, scr, r, lane); continue; } r -= 704;
                if (r < 256) { transpose_item(ka->in[9] + (size_t)l * 1024 * 1024, 1024, 1024, (bf16_t*)(wl + W_OUT_OFF), 0, scr, r, lane); continue; } r -= 256;
                if (r < 1408) { transpose_item(ka->in[18] + (size_t)l * 1024 * 5632, 1024, 5632, (bf16_t*)(wl + W_UP_OFF), 2, scr, r, lane); continue; } r -= 1408;
                transpose_item(ka->in[21] + (size_t)l * 2816 * 1024, 2816, 1024, (bf16_t*)(wl + W_DN_OFF), 0, scr, r, lane);
            }
            for (int idx = vcu * 512 + tid; idx < 3072; idx += G * 512) {
                int pos, i; float e;
                if (idx < 1024) { pos = idx >> 3; i = idx & 7; e = (float)i * 0.125f; } else { const int j = idx - 1024; pos = j >> 4; i = j & 15; e = (float)i * 0.0625f; }
                const float freq = exp2f(-e * 13.287712379549449f);
                const float ang = (float)pos * freq;
                float cc, ss; sincos_f(ang, cc, ss);
                float* tp = (idx < 1024) ? (tabA + idx * 2) : (tabB + (idx - 1024) * 2);
                tp[0] = cc; tp[1] = ss;
            }
          }
        } else if (ph == 1) {
            const float* b_mod = ka->in[7];
            for (int idx = vcu * 512 + tid; idx < 4 * 5 * 6144; idx += G * 512) {
                const int l = idx / 30720, n = idx % 6144;
                float s = b_mod[l * 6144 + n];
#pragma unroll
                for (int ks = 0; ks < 16; ++ks) s += MODP[(size_t)ks * 122880 + idx];
                MOD[idx] = s;
            }
        } else if (ph == N_PHASES - 1) {
            const float* fw = ka->in[22];
            for (int m = gw; m < ML; m += NGW) {
                const u32x2* xh = (const u32x2*)(XB + (size_t)m * DM) + lane; f32x4* xr = (f32x4*)(XL + (size_t)m * DM) + lane;
                f32x4 v[4]; float s = 0.f;
#pragma unroll
                for (int j = 0; j < 4; ++j) { const u32x2 w = xh[64 * j]; v[j] = (f32x4){bflo(w.x), bfhi(w.x), bflo(w.y), bfhi(w.y)}; s += (v[j][0] * v[j][0] + v[j][1] * v[j][1]) + (v[j][2] * v[j][2] + v[j][3] * v[j][3]); }
                const float rstd = rsqrtf(wave_sum(s, lane) * (1.f / 1024.f) + 1e-6f);
#pragma unroll
                for (int j = 0; j < 4; ++j) { const f32x4 w = *(const f32x4*)(fw + 4 * (64 * j + lane)); xr[64 * j] = v[j] * rstd * w; }
            }
        } else {
            const int l = (ph - 2) / 7, k = (ph - 2) % 7;
            const bool need_ctx = l < DEPTH - 1;
            const float* modl = MOD + (size_t)l * 5 * 6144;
            unsigned char* wl = ws + WS_W + (size_t)l * W_LAYER;
            if (k == 0) {
                const float* nw = ka->in[4] + l * 1024;
                for (int m = gw; m < MT; m += NGW) {
                    const bool lat = m < ML; const int slot = lat ? (m >> 13) : 4;
                    if (lat) { if (l == 0) norm_mod_row(ka->in[0] + (size_t)m * DM, nw, modl + slot * 6144, modl + slot * 6144 + 1024, XN + (size_t)m * DM, lane);
                               else norm_mod_row((const float*)(XB + (size_t)m * DM), nw, modl + slot * 6144, modl + slot * 6144 + 1024, XN + (size_t)m * DM, lane, nullptr, 0, nullptr, true); }
                    else {
                        const size_t ro = (size_t)(m - ML) * DM;
                        norm_mod_row((l == 0 ? ka->in[2] : (const float*)XCB) + ro, nw, modl + slot * 6144, modl + slot * 6144 + 1024, XN + (size_t)m * DM, lane,
                                     (const float*)Ob + ro, (l == 0) ? 0 : 11, XCA + ro);
                    }
                }
            } else if (k == 1) {
                pg8::Gemm g{XN, (const bf16_t*)wl, MT, INC, DM, DM}; pg8::StaticOrder S; S.init(MT, INC, G, bx);
                pg8::EpiInProj E{Hb, tabA, tabB};
#ifndef DIS_IN
                pg8::gemm_phase<pg8::EpiInProj, pg8::StaticOrder, true, true>(lds, g, S, E);
#endif
            } else if (k == 2) {
                float lam, ofac;
                {
                    float d1 = 0.f, d2 = 0.f;
                    for (int i = 0; i < 32; ++i) { d1 += ka->in[10][l * 32 + i] * ka->in[11][l * 32 + i]; d2 += ka->in[12][l * 32 + i] * ka->in[13][l * 32 + i]; }
                    const float li = 0.8f - 0.6f * expf(-0.3f * (float)l);
                    lam = expf(d1) - expf(d2) + li;
                    lam = __uint_as_float(__builtin_amdgcn_readfirstlane(__float_as_uint(lam))); ofac = __uint_as_float(__builtin_amdgcn_readfirstlane(__float_as_uint(li)));
                }
                const float* subw = ka->in[14] + l * 64; const float* sink_l = ka->in[15] + l * 4; const float* rpb_l = ka->in[16] + (size_t)l * 4 * 465;
#ifndef DIS_A
                for (int u = vcu; u < 512 + (need_ctx ? 16 : 0); u += G) {
                    const bool cq = u >= 512; const int bh = cq ? (u - 512) : (u >> 5);
                    att::unit_A(cq, lds, Hb, Ob, bh >> 2, bh & 3, u & 31, lam, ofac, subw);
                }
#endif
#ifndef DIS_B
                for (int u = vcu; u < 1024 + (need_ctx ? 32 : 0); u += G) {
                    int mode, ub, uh, ublk; bool redo = true;
                    if (u < 512) { mode = 1; ub = u >> 7; uh = (u >> 6) & 1; ublk = u & 63; redo = att::unit_BC_fast<1>(lds, Hb, Ob, ub, uh, ublk, sink_l, rpb_l); }
                    else if (u < 1024) { const int v = u - 512; mode = 2; ub = v >> 7; uh = (v >> 5) & 3; ublk = v & 31; redo = att::unit_BC_fast<2>(lds, Hb, Ob, ub, uh, ublk, sink_l, rpb_l); }
                    else { const int v = u - 1024, bh = v & 15; if (v < 16) { mode = 3; ub = bh >> 2; uh = (bh >> 1) & 1; ublk = bh & 1; } else { mode = 4; ub = bh >> 2; uh = bh & 3; ublk = 0; } }
                    if (redo) att::unit_BC(mode, lds, Hb, Ob, ub, uh, ublk, sink_l, rpb_l);
                }
#endif
                {
                    const float* cwl = ka->in[17] + (size_t)l * 3 * 256;
                    const int rows = need_ctx ? MT : ML;
                    const int c0 = (tid & 31) * 8;
                    float w0[8], w1[8], w2[8];
#pragma unroll
                    for (int e = 0; e < 8; ++e) { w0[e] = cwl[c0 + e]; w1[e] = cwl[256 + c0 + e]; w2[e] = cwl[512 + c0 + e]; }
                    for (int idx = vcu * 512 + tid; idx < rows * 32; idx += G * 512) {
                        const int row = idx >> 5;
                        int t, len; if (row < ML) { t = row & 8191; len = SEQ; } else { t = (row - ML) & 255; len = CTXL; }
                        const bf16_t* hp = Hb + (size_t)row * INC + 2048 + c0;
                        const u32x4 bg = *(const u32x4*)hp, cg1 = *(const u32x4*)(hp + 256), xi1 = *(const u32x4*)(hp + 512);
                        u32x4 cg0 = {0u, 0u, 0u, 0u}, xi0 = cg0, cg2 = cg0, xi2 = cg0;
                        if (t > 0) { cg0 = *(const u32x4*)(hp - INC + 256); xi0 = *(const u32x4*)(hp - INC + 512); }
                        if (t < len - 1) { cg2 = *(const u32x4*)(hp + INC + 256); xi2 = *(const u32x4*)(hp + INC + 512); }
                        u32x4 ow;
#pragma unroll
                        for (int e = 0; e < 4; ++e) {
                            const float ylo = w0[2 * e] * bflo(cg0[e]) * bflo(xi0[e]) + w1[2 * e] * bflo(cg1[e]) * bflo(xi1[e]) + w2[2 * e] * bflo(cg2[e]) * bflo(xi2[e]);
                            const float yhi = w0[2 * e + 1] * bfhi(cg0[e]) * bfhi(xi0[e]) + w1[2 * e + 1] * bfhi(cg1[e]) * bfhi(xi1[e]) + w2[2 * e + 1] * bfhi(cg2[e]) * bfhi(xi2[e]);
                            ow[e] = pkbf(bflo(bg[e]) * ylo, bfhi(bg[e]) * yhi);
                        }
                        *(u32x4*)(Ob + (size_t)row * DM + 768 + c0) = ow;
                    }
                }
                __syncthreads();
            } else if (k == 4) {
                const float* nw = ka->in[5] + l * 1024;
                const int nrows = (need_ctx ? NMX_ALL : NMX_L) * 256;
                for (int e = gw; e < nrows; e += NGW) {
                    const int pm = e >> 8, j = e & 255;
                    int t, slot; const float* base; int len;
                    if (pm < NMX_L) { const int s = pm / 33, ti = pm - s * 33; t = 254 * ti - 1 + j; len = SEQ; slot = s; base = nullptr; }
                    else { const int p = 254 * (pm - NMX_L) - 1 + j; const int sq = (p < 0) ? 0 : p / 257, r = p - sq * 257; t = (p >= 0 && p < 1029 && r != 0) ? (r - 1) : -1; len = CTXL; slot = 4; base = XCA + (size_t)sq * CTXL * DM; }
                    const bool ok = (t >= 0 && t < len);
                    const float* src = ok ? ((pm < NMX_L) ? (const float*)(XB + ((size_t)slot * SEQ + t) * DM) : (base + (size_t)t * DM)) : nullptr;
                    if (pm < NMX_L || !ok) norm_mod_row(src, nw, modl + slot * 6144 + 3072, modl + slot * 6144 + 4096, XN + (size_t)e * DM, lane, nullptr, 0, nullptr, pm < NMX_L);
                    else {
                        const size_t ro = (size_t)(src - XCA);
                        norm_mod_row(src, nw, modl + slot * 6144 + 3072, modl + slot * 6144 + 4096, XN + (size_t)e * DM, lane, (const float*)Hb + ro, 4, XCB + ro);
                    }
                }
            } else if (k == 5) {
                const int nM = need_ctx ? NMX_ALL : NMX_L;
                pg8::Gemm g{XN, (const bf16_t*)(wl + W_UP_OFF), nM * 256, UPC, DM, DM}; pg8::StaticOrder S; S.init(nM * 256, UPC, G, bx);
                pg8::EpiUpConv E{ACT, ka->in[19] + (size_t)l * 3 * UPC, ka->in[20] + (size_t)l * UPC};
                pg8::OneUnit one;
#ifndef DIS_UP
                for (int i = 0; S.next(i, one.u); ++i) pg8::gemm_phase<pg8::EpiUpConv, pg8::OneUnit, false, true>(lds, g, one, E);
#endif
            } else {
                const bool isout = (k == 3); const int KK = isout ? DM : DFF;
                const bf16_t* Ap = isout ? (const bf16_t*)Ob : (const bf16_t*)ACT; const bf16_t* Bp = (const bf16_t*)(wl + (isout ? W_OUT_OFF : W_DN_OFF));
                {
                    pg8::Gemm g{Ap, Bp, ML, DM, KK, KK}; pg8::StaticOrder S; S.init(ML, DM, G, bx);
                    pg8::EpiRes E{(isout && l == 0) ? ka->in[0] : (const float*)nullptr, XB, XB, modl, isout ? 2048 : 5120};
#ifndef DIS_OUT
                    pg8::gemm_phase<pg8::EpiRes, pg8::StaticOrder, true, true>(lds, g, S, E);
#endif
                }
                if (need_ctx) {
                    const int P = isout ? 4 : 11, klen = KK / P;
                    for (int su = bx; su < 16 * P; su += G) {
                        const int tile = su / P, part = su - tile * P;
                        pg8::Gemm gs{Ap + (size_t)ML * KK + part * klen, Bp + part * klen, MC, DM, klen, KK};
                        pg8::OneUnit one; one.u.pm = tile >> 2; one.u.pn = tile & 3;
                        pg8::EpiSlab EA{(isout ? (float*)Hb : (float*)Ob) + (size_t)part * 1024 * 1024, modl + 4 * 6144 + (isout ? 2048 : 5120)};
                        pg8::gemm_phase<pg8::EpiSlab, pg8::OneUnit, false, true>(lds, gs, one, EA);
                    }
                }
            }
        }
        if (ph + 1 < ph_hi && kargs()->coop) {
            if (kargs()->coop == 2) cg::this_grid().sync();
            else { XcdBarrier b; b.bar = (unsigned*)kargs()->ws; b.x = xb_xcc_id(); b.st = bar_st; xcd_barrier(b); }
        }
    }
}

extern "C" void kernel_launch(void* const* d_in, const int* in_sizes, int n_in, void* d_out, int out_size, void* d_ws, size_t ws_size, hipStream_t stream) {
    static int grid = 0;
    if (grid == 0) {
        if (n_in != 23 || out_size != ML * DM || ws_size < WS_END) { fprintf(stderr, "kernel_launch: unexpected shapes (n_in %d out %d ws %zu need %zu)\n", n_in, out_size, ws_size, (size_t)WS_END); grid = -1; return; }
        int dev = 0, cus = 0, per_cu = 0;
        if (hipGetDevice(&dev) != hipSuccess || hipDeviceGetAttribute(&cus, hipDeviceAttributeMultiprocessorCount, dev) != hipSuccess) { grid = -1; return; }
        if (hipFuncSetAttribute((const void*)fwd_kernel, hipFuncAttributeMaxDynamicSharedMemorySize, LDS_BYTES) != hipSuccess) { fprintf(stderr, "kernel_launch: hipFuncSetAttribute failed\n"); grid = -1; return; }
        if (hipOccupancyMaxActiveBlocksPerMultiprocessor(&per_cu, (const void*)fwd_kernel, 512, LDS_BYTES) != hipSuccess || per_cu < 1) fprintf(stderr, "kernel_launch: occupancy query says %d\n", per_cu);
        (void)hipGetLastError();
        grid = cus;
    }
    if (grid < 0) return;
    Args a{};
    for (int i = 0; i < 23; ++i) a.in[i] = (const float*)d_in[i];
    a.out = (float*)d_out; a.ws = (unsigned char*)d_ws;
#if MK_MULTI
    for (int ph = 0; ph < N_PHASES; ++ph) {
        a.ph_lo = ph; a.ph_hi = ph + 1; a.coop = 0;
        hipLaunchKernelGGL(fwd_kernel, dim3(grid), dim3(512), LDS_BYTES, stream, a);
    }
#else
    a.ph_lo = 0; a.ph_hi = N_PHASES; a.coop = 1;
    if (hipMemsetAsync(d_ws, 0, 16384, stream) != hipSuccess) { fprintf(stderr, "kernel_launch: memset failed\n"); return; }
    void* args[] = {&a};
    hipError_t e = hipLaunchCooperativeKernel((const void*)fwd_kernel, dim3(grid), dim3(512), args, LDS_BYTES, stream);
    if (e != hipSuccess) fprintf(stderr, "cooperative launch failed: %s (grid %d)\n", hipGetErrorString(e), grid);
#endif
}
```

```cpp
#include <hip/hip_runtime.h>
#include <hip/hip_cooperative_groups.h>
#include <cstdio>
#include <cstdint>
namespace cg = cooperative_groups;

#ifndef MK_MULTI
#define MK_MULTI 0
#endif

#ifndef REP_IN
#define REP_IN 1
#endif
#ifndef REP_UP
#define REP_UP 1
#endif
#ifndef REP_A
#define REP_A 1
#endif
#ifndef REP_OD
#define REP_OD 1
#endif
#ifndef REP_P
#define REP_P 1
#endif
#ifndef REP_BC
#define REP_BC 1
#endif
#ifndef REP_M
#define REP_M 1
#endif

__device__ __forceinline__ int pg8_ltid() { int t = threadIdx.x; asm volatile("" : "+v"(t)); return t; }
namespace pg8 {
#define PG8_LAS __attribute__((address_space(3)))
typedef unsigned short bf16_t;
typedef short bf16x8 __attribute__((ext_vector_type(8)));
typedef float f32x4 __attribute__((ext_vector_type(4)));
typedef unsigned u32x4 __attribute__((ext_vector_type(4)));
constexpr int BM = 256, BK = 64, HALF = 128, HTB = HALF * BK * 2  , STAGE_BYTES = 8 * HTB, NXCD = 8, WGM = 8;

__host__ __device__ __forceinline__ int lds_byte(int r, int c) { const int st = (r >> 4) * 2 + (c >> 5), rr = r & 15, cc = c & 31, ob = rr * 64 + cc * 2; return st * 1024 + (ob ^ (((ob >> 9) & 1) << 5)); }
__host__ __device__ __forceinline__ void stage_rc(int b, int& R, int& C) { const int st = b / 1024, sb = b % 1024, swz = sb ^ (((sb >> 9) & 1) << 5); R = (st >> 1) * 16 + swz / 64; C = (st & 1) * 32 + (swz % 64) / 2; }
__host__ __device__ __forceinline__ int perm32(int rho) { const int n = rho >> 4, i = rho & 15; return 8 * (i >> 2) + 4 * n + (i & 3); }

struct Unit { int pm, pn; };
struct Gemm { const bf16_t* A; const bf16_t* Bt; int M, N, K, ldk; };

struct StaticOrder {
    int nM, nN, nwg, G, c;
    __host__ __device__ void init(int M, int N, int G_, int c_) { nM = M / BM; nN = N / BM; nwg = nM * nN; G = G_; c = c_; }
    __host__ __device__ bool next(int i, Unit& u) const {
        const long L = (long)i * G + c; if (L >= nwg) return false;
        int wgid = (int)L; { const int q = nwg / NXCD, r = nwg % NXCD, xcd = wgid % NXCD, off = wgid / NXCD; wgid = (xcd < r ? xcd * (q + 1) : r * (q + 1) + (xcd - r) * q) + off; }
        const int nig = WGM * nN, gid = wgid / nig, fm = gid * WGM, gsz = (nM - fm) < WGM ? (nM - fm) : WGM;
        u.pm = fm + ((wgid % nig) % gsz); u.pn = (wgid % nig) / gsz; return true;
    }
    __device__ __forceinline__ void a_ready(const Unit&) const {}
    __device__ __forceinline__ void done(const Unit&) const {}
};

typedef float pg8_f32x2 __attribute__((ext_vector_type(2))); typedef __bf16 pg8_bf16x2 __attribute__((ext_vector_type(2)));
__device__ __forceinline__ unsigned cvt_pk_bf16(float lo, float hi) { pg8_f32x2 v = {lo, hi}; pg8_bf16x2 b = __builtin_convertvector(v, pg8_bf16x2); return __builtin_bit_cast(unsigned, b); }
typedef unsigned u32x2 __attribute__((ext_vector_type(2)));

struct OneUnit {
    Unit u;
    __device__ __forceinline__ bool next(int i, Unit& o) const { if (i != 0) return false; o = u; return true; }
    __device__ __forceinline__ void a_ready(const Unit&) const {}
    __device__ __forceinline__ void done(const Unit&) const {}
};

struct EpiInProj {
    static constexpr bool PERM = true, AFTER_DRAIN = false;
    bf16_t* H; const float* tabA; const float* tabB;
    __device__ __forceinline__ void operator()(const f32x4 (&acc)[2][2][4][2], const Unit& u, int wr, int wc, int fr, int fq) const {
        const int pn = u.pn; const bool latent = u.pm < 128;
        const float scale = (pn == 0) ? 0.17677669529663687f * 1.4426950408889634f : ((pn == 3 || pn == 5) ? 0.125f * 1.4426950408889634f : 1.0f);
#pragma unroll
        for (int bj = 0; bj < 2; ++bj) {
            int mode = (pn == 0 || pn == 1) ? 1 : ((pn == 3 || (pn == 4 && bj == 0)) ? 2 : 0);
            if (!latent) mode = 0;
#ifdef TEST_NOROPE
            mode = 0;
#endif
#pragma unroll
            for (int ai = 0; ai < 2; ++ai)
#pragma unroll
                for (int m = 0; m < 4; ++m) {
                    const int r = u.pm * BM + ai * HALF + wr * 64 + m * 16 + fr;
                    f32x4 v0 = acc[ai][bj][m][0], v1 = acc[ai][bj][m][1];
                    if (mode != 0) {
                        const int t = r & 8191, trow = t >> 6, tcol = t & 63;
                        const float* tp;
                        if (mode == 1) { const int pos = (fq < 2) ? trow : tcol; tp = tabA + (pos * 8 + 4 * (fq & 1)) * 2; }
                        else { const int pos = (wc & 1) ? tcol : trow; tp = tabB + (pos * 16 + 4 * fq) * 2; }
                        const f32x4 cs0 = *(const f32x4*)tp, cs1 = *(const f32x4*)(tp + 4);
                        const float c0 = cs0[0], s0 = cs0[1], c1 = cs0[2], s1 = cs0[3], c2 = cs1[0], s2 = cs1[1], c3 = cs1[2], s3 = cs1[3];
                        f32x4 a = v0, b = v1;
                        v0[0] = a[0] * c0 - b[0] * s0; v1[0] = b[0] * c0 + a[0] * s0;
                        v0[1] = a[1] * c1 - b[1] * s1; v1[1] = b[1] * c1 + a[1] * s1;
                        v0[2] = a[2] * c2 - b[2] * s2; v1[2] = b[2] * c2 + a[2] * s2;
                        v0[3] = a[3] * c3 - b[3] * s3; v1[3] = b[3] * c3 + a[3] * s3;
                    }
                    v0 = v0 * scale; v1 = v1 * scale;
                    bf16_t* rowp = H + (size_t)r * 2816 + pn * BM + bj * HALF + wc * 32 + 8 * fq;
                    u32x4 w; w.x = cvt_pk_bf16(v0[0], v0[1]); w.y = cvt_pk_bf16(v0[2], v0[3]); w.z = cvt_pk_bf16(v1[0], v1[1]); w.w = cvt_pk_bf16(v1[2], v1[3]);
                    *(u32x4*)rowp = w;
                }
        }
    }
};

struct EpiRes {
    static constexpr bool PERM = false, AFTER_DRAIN = false;
    const float* base32; const bf16_t* base16; bf16_t* out16; const float* modl; int goff;
    __device__ __forceinline__ void operator()(const f32x4 (&acc)[2][2][4][2], const Unit& u, int wr, int wc, int fr, int fq) const {
        const int slot = u.pm >> 5;
        const int row0 = u.pm * BM + wr * 64 + fr;
        const int col0 = u.pn * BM + wc * 32 + 4 * fq;
        f32x4 gv[2][2];
#pragma unroll
        for (int bj = 0; bj < 2; ++bj)
#pragma unroll
            for (int n = 0; n < 2; ++n) gv[bj][n] = *(const f32x4*)(modl + slot * 6144 + goff + col0 + bj * HALF + n * 16);
        const bool f32in = (base32 != nullptr);
#pragma unroll
        for (int ai = 0; ai < 2; ++ai)
#pragma unroll
            for (int m = 0; m < 4; ++m) {
                const size_t off = (size_t)(row0 + ai * HALF + m * 16) * 1024 + col0;
#pragma unroll
                for (int bj = 0; bj < 2; ++bj)
#pragma unroll
                    for (int n = 0; n < 2; ++n) {
                        f32x4 bs;
                        if (f32in) bs = *(const f32x4*)(base32 + off + bj * HALF + n * 16);
                        else { const u32x2 w = *(const u32x2*)(base16 + off + bj * HALF + n * 16); bs = (f32x4){__uint_as_float(w.x << 16), __uint_as_float(w.x & 0xffff0000u), __uint_as_float(w.y << 16), __uint_as_float(w.y & 0xffff0000u)}; }
                        const f32x4 o = bs + gv[bj][n] * acc[ai][bj][m][n];
                        u32x2 ow; ow.x = cvt_pk_bf16(o[0], o[1]); ow.y = cvt_pk_bf16(o[2], o[3]);
                        *(u32x2*)(out16 + off + bj * HALF + n * 16) = ow;
                    }
                asm volatile("" ::: "memory");
            }
    }
};

struct EpiSlab {
    static constexpr bool PERM = false, AFTER_DRAIN = false;
    float* slab; const float* gate;
    __device__ __forceinline__ void operator()(const f32x4 (&acc)[2][2][4][2], const Unit& u, int wr, int wc, int fr, int fq) const {
        const int row0 = u.pm * BM + wr * 64 + fr, col0 = u.pn * BM + wc * 32 + 4 * fq;
#pragma unroll
        for (int bj = 0; bj < 2; ++bj)
#pragma unroll
            for (int n = 0; n < 2; ++n) {
                const f32x4 gv = *(const f32x4*)(gate + col0 + bj * HALF + n * 16);
#pragma unroll
                for (int ai = 0; ai < 2; ++ai)
#pragma unroll
                    for (int m = 0; m < 4; ++m)
                        *(f32x4*)(slab + (size_t)(row0 + ai * HALF + m * 16) * 1024 + col0 + bj * HALF + n * 16) = gv * acc[ai][bj][m][n];
            }
    }
};

struct EpiUpConv {
    static constexpr bool PERM = false, AFTER_DRAIN = true;
    bf16_t* ACT; const float* cw; const float* cb;
    static constexpr int TP = 520;
    __device__ __forceinline__ void fused(f32x4 (&acc)[2][2][4][2], const Unit& u, int wr, int wc, int fr, int fq, PG8_LAS unsigned char* lds, int wid, int lane) const {
#pragma unroll
        for (int ai = 0; ai < 2; ++ai)
#pragma unroll
            for (int m = 0; m < 4; ++m) {
                const int row = ai * HALF + wr * 64 + m * 16 + fr;
#pragma unroll
                for (int bj = 0; bj < 2; ++bj)
#pragma unroll
                    for (int n = 0; n < 2; ++n) {
                        const f32x4 v = acc[ai][bj][m][n]; u32x2 w; w.x = cvt_pk_bf16(v[0], v[1]); w.y = cvt_pk_bf16(v[2], v[3]);
                        *(PG8_LAS u32x2*)(lds + row * TP + (bj * HALF + wc * 32 + n * 16 + 4 * fq) * 2) = w;
                    }
            }
        const int tid = wid * 64 + lane, ch = tid & 15;
        const int gcol = u.pn * 128 + ch * 8;
        float wg[3][8], wv[3][8], bg[8], bv[8];
#pragma unroll
        for (int k = 0; k < 3; ++k) {
            const f32x4 a0 = *(const f32x4*)(cw + k * 5632 + gcol), a1 = *(const f32x4*)(cw + k * 5632 + gcol + 4);
            const f32x4 b0 = *(const f32x4*)(cw + k * 5632 + 2816 + gcol), b1 = *(const f32x4*)(cw + k * 5632 + 2816 + gcol + 4);
#pragma unroll
            for (int e = 0; e < 4; ++e) { wg[k][e] = a0[e]; wg[k][4 + e] = a1[e]; wv[k][e] = b0[e]; wv[k][4 + e] = b1[e]; }
        }
        {
            const f32x4 a0 = *(const f32x4*)(cb + gcol), a1 = *(const f32x4*)(cb + gcol + 4), b0 = *(const f32x4*)(cb + 2816 + gcol), b1 = *(const f32x4*)(cb + 2816 + gcol + 4);
#pragma unroll
            for (int e = 0; e < 4; ++e) { bg[e] = a0[e]; bg[4 + e] = a1[e]; bv[e] = b0[e]; bv[4 + e] = b1[e]; }
        }
        const bool lat = u.pm < 132; int rowbase, ti;
        if (lat) { const int s = u.pm / 33; ti = u.pm - s * 33; rowbase = s * 8192; } else { ti = u.pm - 132; rowbase = 32768; }
        asm volatile("s_waitcnt lgkmcnt(0)" ::: "memory"); __builtin_amdgcn_s_barrier(); asm volatile("" ::: "memory");
        for (int it = tid; it < 254 * 16; it += 512) {
            const int j = 1 + (it >> 4); const int p = 254 * ti - 1 + j;
            int orow; bool ok;
            if (lat) { ok = p < 8192; orow = rowbase + p; } else { const int sq = p / 257, r = p - sq * 257; ok = (p < 1029) && (r != 0); orow = rowbase + sq * 256 + r - 1; }
            if (ok) {
                float g[8], v[8];
#pragma unroll
                for (int e = 0; e < 8; ++e) { g[e] = bg[e]; v[e] = bv[e]; }
#pragma unroll
                for (int k = 0; k < 3; ++k) {
                    const PG8_LAS unsigned char* rp = lds + (j - 1 + k) * TP + ch * 16;
                    const u32x2 g0 = *(const PG8_LAS u32x2*)rp, g1 = *(const PG8_LAS u32x2*)(rp + 8);
                    const u32x2 v0 = *(const PG8_LAS u32x2*)(rp + 256), v1 = *(const PG8_LAS u32x2*)(rp + 264);
                    const unsigned gw[4] = {g0.x, g0.y, g1.x, g1.y}, vw[4] = {v0.x, v0.y, v1.x, v1.y};
#pragma unroll
                    for (int e = 0; e < 4; ++e) {
                        g[2 * e] += wg[k][2 * e] * __uint_as_float(gw[e] << 16); g[2 * e + 1] += wg[k][2 * e + 1] * __uint_as_float(gw[e] & 0xffff0000u);
                        v[2 * e] += wv[k][2 * e] * __uint_as_float(vw[e] << 16); v[2 * e + 1] += wv[k][2 * e + 1] * __uint_as_float(vw[e] & 0xffff0000u);
                    }
                }
                float o[8];
#pragma unroll
                for (int e = 0; e < 8; ++e) o[e] = g[e] * __builtin_amdgcn_rcpf(1.f + __builtin_amdgcn_exp2f(-1.4426950408889634f * g[e])) * v[e];
                u32x4 w; w.x = cvt_pk_bf16(o[0], o[1]); w.y = cvt_pk_bf16(o[2], o[3]); w.z = cvt_pk_bf16(o[4], o[5]); w.w = cvt_pk_bf16(o[6], o[7]);
                *(u32x4*)(ACT + (size_t)orow * 2816 + gcol) = w;
            }
        }
        asm volatile("s_waitcnt lgkmcnt(0)" ::: "memory"); __builtin_amdgcn_s_barrier(); asm volatile("" ::: "memory");
    }
};
template <class Epi, class Sched, bool ALIGN_EPI = false, bool SP2 = false>
__device__ __forceinline__ void gemm_phase(PG8_LAS unsigned char* lds, const Gemm g, const Sched& S, const Epi& E) {
    const int tid = pg8_ltid(), wid = __builtin_amdgcn_readfirstlane(tid >> 6), lane = tid & 63, wr = wid >> 2, wc = wid & 3, fr = lane & 15, fq = lane >> 4;
    const int K = g.ldk, nt = g.K / BK;
    unsigned voffA[2], voffB[2];
#pragma unroll
    for (int i = 0; i < 2; ++i) { int R, C; stage_rc(tid * 16 + i * 8192, R, C); const int Rb = Epi::PERM ? ((R & ~31) + perm32(R & 31)) : R;
        voffA[i] = (unsigned)(R * K + C) * 2u; voffB[i] = (unsigned)(Rb * K + C) * 2u; }
    const size_t kstep = (size_t)(BK * 2);
    const size_t hstep = (size_t)HALF * K * 2;
    const size_t tstep = 2 * hstep;
    const unsigned ldsw = (unsigned)wid * 1024u;
    const int aoff = lds_byte(wr * 64 + fr, fq * 8), boff = lds_byte(wc * 32 + fr, fq * 8);
#define PG8_SA(b, h) (((b) * 2 + (h)) * HTB)
#define PG8_SB(b, h) ((4 + (b) * 2 + (h)) * HTB)
#define PG8_STAGE(bufoff, gbase, voff) do { _Pragma("unroll") for (int _i = 0; _i < 2; ++_i) \
        __builtin_amdgcn_global_load_lds((const unsigned*)((const char*)(gbase) + (voff)[_i]), (PG8_LAS unsigned*)(lds + (bufoff) + ldsw + _i * 8192), 16, 0, 0); } while (0)
#define PG8_LDA(dst, b, h) do { _Pragma("unroll") for (int m = 0; m < 4; ++m) _Pragma("unroll") for (int k = 0; k < 2; ++k) dst[m][k] = *(const PG8_LAS bf16x8*)(lds + PG8_SA(b, h) + aoff + m * 2048 + k * 1024); } while (0)
#define PG8_LDB(dst, b, h) do { _Pragma("unroll") for (int n = 0; n < 2; ++n) _Pragma("unroll") for (int k = 0; k < 2; ++k) dst[n][k] = *(const PG8_LAS bf16x8*)(lds + PG8_SB(b, h) + boff + n * 2048 + k * 1024); } while (0)
#define PG8_MMA(ai, bj, At, Bt) do { __builtin_amdgcn_s_setprio(1); _Pragma("unroll") for (int m = 0; m < 4; ++m) _Pragma("unroll") for (int n = 0; n < 2; ++n) _Pragma("unroll") for (int k = 0; k < 2; ++k) \
        acc[ai][bj][m][n] = __builtin_amdgcn_mfma_f32_16x16x32_bf16(Bt[n][k], At[m][k], acc[ai][bj][m][n], 0, 0, 0); __builtin_amdgcn_s_setprio(0); } while (0)
#define PG8_WAIT_V(n) asm volatile("s_waitcnt vmcnt(" #n ")" ::: "memory")
#define PG8_WAIT_L(n) asm volatile("s_waitcnt lgkmcnt(" #n ")" ::: "memory")
#define PG8_BAR __builtin_amdgcn_s_barrier()
#define PG8_SCHED __builtin_amdgcn_sched_barrier(0)
    Unit cur, nxt; int ui = 0;
    if (!S.next(0, cur)) return;
    f32x4 acc[2][2][4][2];
#pragma unroll
    for (int a = 0; a < 2; ++a)
#pragma unroll
        for (int b = 0; b < 2; ++b)
#pragma unroll
            for (int m = 0; m < 4; ++m)
#pragma unroll
                for (int n = 0; n < 2; ++n) acc[a][b][m][n] = (f32x4){0.f, 0.f, 0.f, 0.f};
    bf16x8 At[4][2], B0[2][2], B1[2][2];
    const char* cA = (const char*)g.A + (size_t)cur.pm * tstep; const char* cB = (const char*)g.Bt + (size_t)cur.pn * tstep;
    S.a_ready(cur);
    if constexpr (SP2) {
        PG8_STAGE(PG8_SB(0, 0), cB, voffB); PG8_STAGE(PG8_SB(0, 1), cB + hstep, voffB); PG8_STAGE(PG8_SA(0, 0), cA, voffA); PG8_STAGE(PG8_SA(0, 1), cA + hstep, voffA);
        if (wr == 1) PG8_BAR;
        PG8_WAIT_V(2); PG8_BAR;
        PG8_STAGE(PG8_SB(1, 0), cB + kstep, voffB); PG8_STAGE(PG8_SA(1, 0), cA + kstep, voffA); PG8_STAGE(PG8_SB(1, 1), cB + hstep + kstep, voffB);
        PG8_WAIT_V(6); PG8_BAR;
    } else {
        PG8_STAGE(PG8_SB(0, 0), cB, voffB); PG8_STAGE(PG8_SA(0, 0), cA, voffA); PG8_STAGE(PG8_SB(0, 1), cB + hstep, voffB); PG8_STAGE(PG8_SA(0, 1), cA + hstep, voffA);
        if (wr == 1) PG8_BAR;
        PG8_WAIT_V(4); PG8_BAR;
        PG8_STAGE(PG8_SB(1, 0), cB + kstep, voffB); PG8_STAGE(PG8_SA(1, 0), cA + kstep, voffA); PG8_STAGE(PG8_SB(1, 1), cB + hstep + kstep, voffB);
        PG8_WAIT_V(6); PG8_BAR;
    }
    for (;;) {
        const bool has_next = S.next(ui + 1, nxt);
        const char* nA = has_next ? (const char*)g.A + (size_t)nxt.pm * tstep : cA; const char* nB = has_next ? (const char*)g.Bt + (size_t)nxt.pn * tstep : cB;
        for (int t = 0; t < nt; t += 2) {
            const bool last = (t == nt - 2);
            const char* a1 = cA + (size_t)(t + 1) * kstep;
            const char* a2 = last ? nA : cA + (size_t)(t + 2) * kstep; const char* b2 = last ? nB : cB + (size_t)(t + 2) * kstep;
            const char* a3 = a2 + kstep; const char* b3 = b2 + kstep;
            if (last && has_next) S.a_ready(nxt);
            if constexpr (SP2) {
            PG8_LDB(B0, 0, 0); PG8_LDB(B1, 0, 1); PG8_SCHED; PG8_LDA(At, 0, 0); PG8_STAGE(PG8_SA(1, 1), a1 + hstep, voffA);
            PG8_WAIT_V(8); PG8_WAIT_L(0); PG8_BAR; PG8_MMA(0, 0, At, B0); PG8_MMA(0, 1, At, B1); PG8_BAR; PG8_SCHED;
            PG8_LDA(At, 0, 1); PG8_STAGE(PG8_SB(0, 0), b2, voffB); PG8_STAGE(PG8_SB(0, 1), b2 + hstep, voffB); PG8_STAGE(PG8_SA(0, 0), a2, voffA);
            PG8_WAIT_V(8); PG8_WAIT_L(0); PG8_BAR; PG8_MMA(1, 0, At, B0); PG8_MMA(1, 1, At, B1); PG8_BAR; PG8_SCHED;
            PG8_LDB(B0, 1, 0); PG8_LDB(B1, 1, 1); PG8_SCHED; PG8_LDA(At, 1, 0); PG8_STAGE(PG8_SA(0, 1), a2 + hstep, voffA);
            PG8_WAIT_V(8); PG8_WAIT_L(0); PG8_BAR; PG8_MMA(0, 0, At, B0); PG8_MMA(0, 1, At, B1); PG8_BAR; PG8_SCHED;
            PG8_LDA(At, 1, 1); PG8_STAGE(PG8_SB(1, 0), b3, voffB); PG8_STAGE(PG8_SB(1, 1), b3 + hstep, voffB); PG8_STAGE(PG8_SA(1, 0), a3, voffA);
            PG8_WAIT_V(8); PG8_WAIT_L(0); PG8_BAR; PG8_MMA(1, 0, At, B0); PG8_MMA(1, 1, At, B1); PG8_BAR; PG8_SCHED;
            } else {
            PG8_LDB(B0, 0, 0); PG8_SCHED; PG8_LDA(At, 0, 0); PG8_STAGE(PG8_SA(1, 1), a1 + hstep, voffA);
            PG8_WAIT_L(8); PG8_BAR; PG8_WAIT_L(0); PG8_MMA(0, 0, At, B0); PG8_BAR; PG8_SCHED;
            PG8_LDB(B1, 0, 1); PG8_STAGE(PG8_SB(0, 0), b2, voffB);
            PG8_BAR; PG8_WAIT_L(0); PG8_MMA(0, 1, At, B1); PG8_BAR;
            PG8_LDA(At, 0, 1); PG8_STAGE(PG8_SA(0, 0), a2, voffA);
            PG8_BAR; PG8_WAIT_L(0); PG8_MMA(1, 0, At, B0); PG8_BAR; PG8_SCHED;
            PG8_STAGE(PG8_SB(0, 1), b2 + hstep, voffB);
            PG8_WAIT_V(6); PG8_BAR; PG8_MMA(1, 1, At, B1); PG8_BAR;
            PG8_LDB(B0, 1, 0); PG8_SCHED; PG8_LDA(At, 1, 0); PG8_STAGE(PG8_SA(0, 1), a2 + hstep, voffA);
            PG8_WAIT_L(8); PG8_BAR; PG8_WAIT_L(0); PG8_MMA(0, 0, At, B0); PG8_BAR; PG8_SCHED;
            PG8_LDB(B1, 1, 1); PG8_STAGE(PG8_SB(1, 0), b3, voffB);
            PG8_BAR; PG8_WAIT_L(0); PG8_MMA(0, 1, At, B1); PG8_BAR;
            PG8_LDA(At, 1, 1); PG8_STAGE(PG8_SA(1, 0), a3, voffA);
            PG8_BAR; PG8_WAIT_L(0); PG8_MMA(1, 0, At, B0); PG8_BAR; PG8_SCHED;
            PG8_STAGE(PG8_SB(1, 1), b3 + hstep, voffB);
            PG8_WAIT_V(6); PG8_BAR; PG8_MMA(1, 1, At, B1); PG8_BAR;
            }
        }
        if constexpr (ALIGN_EPI) { if (wr == 0) PG8_BAR; }
        if constexpr (!Epi::AFTER_DRAIN) { E(acc, cur, wr, wc, fr, fq); S.done(cur); }
        if (!has_next) break;
#pragma unroll
        for (int a = 0; a < 2; ++a)
#pragma unroll
            for (int b = 0; b < 2; ++b)
#pragma unroll
                for (int m = 0; m < 4; ++m)
#pragma unroll
                    for (int n = 0; n < 2; ++n) acc[a][b][m][n] = (f32x4){0.f, 0.f, 0.f, 0.f};
        cur = nxt; cA = nA; cB = nB; ++ui;
        if constexpr (ALIGN_EPI) { if (wr == 1) PG8_BAR; }
    }
    PG8_WAIT_V(0);
    if constexpr (!ALIGN_EPI) { if (wr == 0) PG8_BAR; }
    PG8_BAR;
    if constexpr (Epi::AFTER_DRAIN) { E.fused(acc, cur, wr, wc, fr, fq, lds, wid, lane); S.done(cur); }
#undef PG8_SA
#undef PG8_SB
#undef PG8_STAGE
#undef PG8_LDA
#undef PG8_LDB
#undef PG8_MMA
#undef PG8_WAIT_V
#undef PG8_WAIT_L
#undef PG8_BAR
#undef PG8_SCHED
}
}
#define LAS __attribute__((address_space(3)))
typedef unsigned short bf16_t;
typedef short bf16x8 __attribute__((ext_vector_type(8)));
typedef short s16x4 __attribute__((ext_vector_type(4)));
typedef float f32x4 __attribute__((ext_vector_type(4)));
typedef float f32x16 __attribute__((ext_vector_type(16)));
typedef unsigned u32x4 __attribute__((ext_vector_type(4)));
typedef unsigned u32x2 __attribute__((ext_vector_type(2)));

constexpr int DM = 1024, NB = 4, SEQ = 8192, DEPTH = 4, CTXL = 256;
constexpr int ML = NB * SEQ, MC = NB * CTXL, MT = ML + MC;
constexpr int INC = 2816, DFF = 2816, UPC = 5632;
constexpr int NMX_L = NB * 33, NMX_ALL = NB * 33 + 5;
constexpr float LOG2E = 1.4426950408889634f;

constexpr size_t MiB = 1u << 20;
constexpr size_t WS_MOD = 1 * MiB;
constexpr size_t WS_MODP = 2 * MiB;
constexpr size_t WS_TAB = 10 * MiB;
constexpr size_t WS_XC = 11 * MiB;
constexpr size_t WS_W = 16 * MiB;
constexpr size_t W_LAYER = 24 * MiB, W_OUT_OFF = (size_t)2816 * 1024 * 2, W_UP_OFF = W_OUT_OFF + (size_t)1024 * 1024 * 2, W_DN_OFF = W_UP_OFF + (size_t)5632 * 1024 * 2;
constexpr size_t WS_XN = 112 * MiB;
constexpr size_t WS_O = 182 * MiB;
constexpr size_t WS_H = 248 * MiB;
constexpr size_t WS_XB = 430 * MiB;
constexpr size_t WS_END = WS_XB + (size_t)ML * 1024 * 2;
static_assert(W_DN_OFF + (size_t)1024 * 2816 * 2 <= W_LAYER, "weights per layer");
static_assert(WS_XN + (size_t)NMX_ALL * 256 * 1024 * 2 <= WS_O && WS_O + (size_t)MT * 1024 * 2 <= WS_H && WS_H + (size_t)MT * 2816 * 2 <= WS_XB && WS_END <= 512 * MiB, "ws map");

constexpr int RING_BYTES = 135168;
constexpr int LDS_BYTES = 147456;

__device__ __forceinline__ unsigned pkbf(float lo, float hi) { return pg8::cvt_pk_bf16(lo, hi); }
__device__ __forceinline__ float bflo(unsigned w) { return __uint_as_float(w << 16); }
__device__ __forceinline__ float bfhi(unsigned w) { return __uint_as_float(w & 0xffff0000u); }
__device__ __forceinline__ float dpp_add(float v, const int ctrl_sel) {
    int m;
    if (ctrl_sel == 0) m = __builtin_amdgcn_update_dpp(0, __float_as_int(v), 0xB1, 0xF, 0xF, true);
    else if (ctrl_sel == 1) m = __builtin_amdgcn_update_dpp(0, __float_as_int(v), 0x4E, 0xF, 0xF, true);
    else if (ctrl_sel == 2) m = __builtin_amdgcn_update_dpp(0, __float_as_int(v), 0x124, 0xF, 0xF, true);
    else m = __builtin_amdgcn_update_dpp(0, __float_as_int(v), 0x128, 0xF, 0xF, true);
    return v + __int_as_float(m);
}
__device__ __forceinline__ float wave_sum(float v, int lane) {
    v = dpp_add(v, 0); v = dpp_add(v, 1); v = dpp_add(v, 2); v = dpp_add(v, 3);
    v += __int_as_float(__builtin_amdgcn_ds_bpermute((lane ^ 16) << 2, __float_as_int(v)));
    auto rr = __builtin_amdgcn_permlane32_swap(__float_as_uint(v), __float_as_uint(v), false, false);
    return __uint_as_float(rr[0]) + __uint_as_float(rr[1]);
}
__device__ __forceinline__ float xhalf_max(float v) { auto rr = __builtin_amdgcn_permlane32_swap(__float_as_uint(v), __float_as_uint(v), false, false); return fmaxf(__uint_as_float(rr[0]), __uint_as_float(rr[1])); }
__device__ __forceinline__ float xhalf_sum(float v) { auto rr = __builtin_amdgcn_permlane32_swap(__float_as_uint(v), __float_as_uint(v), false, false); return __uint_as_float(rr[0]) + __uint_as_float(rr[1]); }

namespace att {
constexpr int KP = 144, VP = 136;
constexpr int L_KS = 0, L_VT = 64 * KP, L_RPB = L_VT + 64 * VP, L_END = L_RPB + 2048;
__device__ __forceinline__ int crow(int r, int h) { return (r & 3) + 8 * (r >> 2) + 4 * h; }

struct TileRegs { u32x4 k, v; };
__device__ __forceinline__ void tile_gload(TileRegs& R, const bf16_t* H, int krow, int kcol, int vcol, int tid) {
    const int key = tid >> 3, ch = tid & 7;
    const bf16_t* p = H + (size_t)(krow + key) * INC;
    R.k = *(const u32x4*)(p + kcol + 8 * ch); R.v = *(const u32x4*)(p + vcol + 8 * ch);
}
__device__ __forceinline__ void tile_swrite(const TileRegs& R, LAS unsigned char* lds, int tid) {
    const int key = tid >> 3, ch = tid & 7;
    *(LAS u32x4*)(lds + L_KS + key * KP + ch * 16) = R.k;
    LAS unsigned short* vt = (LAS unsigned short*)(lds + L_VT);
#pragma unroll
    for (int j = 0; j < 4; ++j) { const unsigned w = R.v[j]; vt[(8 * ch + 2 * j) * (VP / 2) + key] = (unsigned short)(w & 0xffffu); vt[(8 * ch + 2 * j + 1) * (VP / 2) + key] = (unsigned short)(w >> 16); }
}
template <int KS0, int NKS>
__device__ __forceinline__ f32x16 qk_block(const LAS unsigned char* lds, int kb, int r32, int hh, const bf16x8 (&qf)[4]) {
    f32x16 s = {0.f, 0.f, 0.f, 0.f, 0.f, 0.f, 0.f, 0.f, 0.f, 0.f, 0.f, 0.f, 0.f, 0.f, 0.f, 0.f};
#pragma unroll
    for (int ks = KS0; ks < KS0 + NKS; ++ks) {
        const bf16x8 kf = *(const LAS bf16x8*)(lds + L_KS + (kb * 32 + r32) * KP + ks * 32 + hh * 16);
        s = __builtin_amdgcn_mfma_f32_32x32x16_bf16(kf, qf[ks], s, 0, 0, 0);
    }
    return s;
}
__device__ __forceinline__ void softmax_pv(f32x16 (&s)[2], float& m, float& l, f32x16 (&O)[2], const LAS unsigned char* lds, int r32, int hh) {
    float mx = s[0][0];
#pragma unroll
    for (int r = 1; r < 16; ++r) mx = fmaxf(mx, s[0][r]);
#pragma unroll
    for (int r = 0; r < 16; ++r) mx = fmaxf(mx, s[1][r]);
    mx = xhalf_max(mx);
    __builtin_amdgcn_sched_barrier(0);
    const float mn = fmaxf(m, mx);
    const float alpha = __builtin_amdgcn_exp2f(m - mn);
    m = mn; l *= alpha;
#pragma unroll
    for (int r = 0; r < 16; ++r) { O[0][r] *= alpha; O[1][r] *= alpha; }
    float ps = 0.f;
#pragma unroll
    for (int kb = 0; kb < 2; ++kb)
#pragma unroll
        for (int r = 0; r < 16; ++r) { const float p = __builtin_amdgcn_exp2f(s[kb][r] - mn); s[kb][r] = p; ps += p; }
    l += ps;
    __builtin_amdgcn_sched_barrier(0);
#pragma unroll
    for (int kb = 0; kb < 2; ++kb)
#pragma unroll
        for (int sk = 0; sk < 2; ++sk) {
            __builtin_amdgcn_sched_barrier(0);
            u32x4 pw; pw.x = pkbf(s[kb][8 * sk + 0], s[kb][8 * sk + 1]); pw.y = pkbf(s[kb][8 * sk + 2], s[kb][8 * sk + 3]);
            pw.z = pkbf(s[kb][8 * sk + 4], s[kb][8 * sk + 5]); pw.w = pkbf(s[kb][8 * sk + 6], s[kb][8 * sk + 7]);
            const bf16x8 pf = __builtin_bit_cast(bf16x8, pw);
#pragma unroll
            for (int dvb = 0; dvb < 2; ++dvb) {
                const LAS unsigned char* a = lds + L_VT + (dvb * 32 + r32) * VP + (kb * 32 + 16 * sk + 4 * hh) * 2;
                const s16x4 lo = *(const LAS s16x4*)a, hi = *(const LAS s16x4*)(a + 16);
                const bf16x8 vf = {lo[0], lo[1], lo[2], lo[3], hi[0], hi[1], hi[2], hi[3]};
                O[dvb] = __builtin_amdgcn_mfma_f32_32x32x16_bf16(vf, pf, O[dvb], 0, 0, 0);
            }
        }
}
__device__ __forceinline__ void store_o(const f32x16 (&o)[2], bf16_t* orow, int hh) {
#pragma unroll
    for (int dvb = 0; dvb < 2; ++dvb)
#pragma unroll
        for (int g = 0; g < 4; ++g) {
            u32x2 w; w.x = pkbf(o[dvb][4 * g], o[dvb][4 * g + 1]); w.y = pkbf(o[dvb][4 * g + 2], o[dvb][4 * g + 3]);
            *(u32x2*)(orow + dvb * 32 + 8 * g + 4 * hh) = w;
        }
}

__device__ __forceinline__ void unit_A_safe(const bool CTXQ, LAS unsigned char* lds, const bf16_t* H, bf16_t* Ob, int b, int h, int qb, float lam, float ofac, const float* subw) {
    const int tid = pg8_ltid(), lane = tid & 63, r32 = lane & 31, hh = lane >> 5, wid = tid >> 6;
    const int qrow = CTXQ ? (ML + b * CTXL + wid * 32 + r32) : (b * SEQ + qb * 256 + wid * 32 + r32);
    const int qcol = h * 64, kcol = 256 + h * 64, vcol = 512 + h * 64;
    bf16x8 qf[4];
#pragma unroll
    for (int ks = 0; ks < 4; ++ks) qf[ks] = *(const bf16x8*)(H + (size_t)qrow * INC + qcol + 16 * ks + 8 * hh);
    const int NT = CTXQ ? 4 : 132;
    f32x16 O1[2], O2[2];
#pragma unroll
    for (int r = 0; r < 16; ++r) { O1[0][r] = 0.f; O1[1][r] = 0.f; O2[0][r] = 0.f; O2[1][r] = 0.f; }
    float m1 = -INFINITY, m2 = -INFINITY, l1 = 0.f, l2 = 0.f;
    TileRegs R;
    tile_gload(R, H, CTXQ ? (ML + b * CTXL) : (b * SEQ), kcol, vcol, tid);
    for (int t = 0; t < NT; ++t) {
        __syncthreads();
        tile_swrite(R, lds, tid);
        __syncthreads();
        if (t + 1 < NT) { const int tn = t + 1; const int krow = CTXQ ? (ML + b * CTXL + 64 * tn) : (tn < 128 ? b * SEQ + 64 * tn : ML + b * CTXL + 64 * (tn - 128)); tile_gload(R, H, krow, kcol, vcol, tid); }
        { f32x16 s[2]; s[0] = qk_block<0, 2>(lds, 0, r32, hh, qf); s[1] = qk_block<0, 2>(lds, 1, r32, hh, qf); softmax_pv(s, m1, l1, O1, lds, r32, hh); }
        __builtin_amdgcn_sched_barrier(0);
        { f32x16 s[2]; s[0] = qk_block<2, 2>(lds, 0, r32, hh, qf); s[1] = qk_block<2, 2>(lds, 1, r32, hh, qf); softmax_pv(s, m2, l2, O2, lds, r32, hh); }
        __builtin_amdgcn_sched_barrier(0);
    }
    l1 = xhalf_sum(l1); l2 = xhalf_sum(l2);
    const float i1 = 1.f / l1, i2 = lam / l2;
    float ss = 0.f;
#pragma unroll
    for (int dvb = 0; dvb < 2; ++dvb)
#pragma unroll
        for (int r = 0; r < 16; ++r) { const float o = O1[dvb][r] * i1 - O2[dvb][r] * i2; O1[dvb][r] = o; ss += o * o; }
    ss = xhalf_sum(ss);
    float li_ = ofac; asm volatile("" : "+s"(li_));
    const float rn = rsqrtf(ss * (1.f / 64.f) + 1e-6f) * (1.f - li_);
#pragma unroll
    for (int dvb = 0; dvb < 2; ++dvb)
#pragma unroll
        for (int g = 0; g < 4; ++g) {
            const f32x4 w = *(const f32x4*)(subw + dvb * 32 + 8 * g + 4 * hh);
#pragma unroll
            for (int e = 0; e < 4; ++e) O1[dvb][4 * g + e] *= rn * w[e];
        }
    store_o(O1, Ob + (size_t)qrow * DM + h * 64, hh);
}


constexpr int A_KP = 144, A_VP = 192, A_VOFF = 64 * A_KP, A_BUF = A_VOFF + 64 * A_VP;
constexpr float ATHR = 10.f;
typedef short v4i16_t __attribute__((ext_vector_type(4)));
__device__ __forceinline__ s16x4 vtr(const LAS unsigned char* p) { return __builtin_bit_cast(s16x4, __builtin_amdgcn_ds_read_tr16_b64_v4i16((LAS v4i16_t*)p)); }
__device__ __forceinline__ void tileA_swrite(const TileRegs& R, LAS unsigned char* buf, int tid) {
    const int key = tid >> 3, ch = tid & 7;
    *(LAS u32x4*)(buf + key * A_KP + ch * 16) = R.k;
    *(LAS u32x4*)(buf + A_VOFF + key * A_VP + ch * 16) = R.v;
}
__device__ __forceinline__ float max16(const f32x16& s) {
    float a = fmaxf(fmaxf(s[0], s[1]), s[2]), b = fmaxf(fmaxf(s[3], s[4]), s[5]), c = fmaxf(fmaxf(s[6], s[7]), s[8]), d = fmaxf(fmaxf(s[9], s[10]), s[11]);
    a = fmaxf(fmaxf(a, s[12]), s[13]); b = fmaxf(fmaxf(b, s[14]), s[15]);
    return fmaxf(fmaxf(a, b), fmaxf(c, d));
}
__device__ __forceinline__ float expsum16(f32x16& s) {
    float a = 0.f, b = 0.f, c = 0.f, d = 0.f;
#pragma unroll
    for (int r = 0; r < 16; r += 4) {
        s[r] = __builtin_amdgcn_exp2f(s[r]); s[r + 1] = __builtin_amdgcn_exp2f(s[r + 1]); s[r + 2] = __builtin_amdgcn_exp2f(s[r + 2]); s[r + 3] = __builtin_amdgcn_exp2f(s[r + 3]);
        a += s[r]; b += s[r + 1]; c += s[r + 2]; d += s[r + 3];
    }
    return (a + b) + (c + d);
}
__device__ __forceinline__ bf16x8 packp(const f32x16& s, int sk) {
    u32x4 pw; pw.x = pkbf(s[8 * sk + 0], s[8 * sk + 1]); pw.y = pkbf(s[8 * sk + 2], s[8 * sk + 3]); pw.z = pkbf(s[8 * sk + 4], s[8 * sk + 5]); pw.w = pkbf(s[8 * sk + 6], s[8 * sk + 7]);
    return __builtin_bit_cast(bf16x8, pw);
}
__device__ __forceinline__ void exp16(f32x16& s) {
#pragma unroll
    for (int r = 0; r < 16; ++r) s[r] = __builtin_amdgcn_exp2f(s[r]);
}
constexpr float AREF = 20.f, AGUARD = 60.f;
#ifndef SGB_V
#define SGB_V 5
#endif
template <bool HAVE>
__device__ __forceinline__ void stepA(bf16x8 (&pc)[2][2], const LAS unsigned char* kbuf, int kb, const LAS unsigned char* vb, const bf16x8 (&qv)[4], int r32, int hh,
                                      float mref1, float mref2, f32x16 (&O1)[2], f32x16 (&O2)[2], f32x16& L1, f32x16& L2, const bf16x8& ones) {
    const LAS unsigned char* kp = kbuf + (kb * 32 + r32) * A_KP + hh * 16;
    const bf16x8 k0 = *(const LAS bf16x8*)(kp), k1 = *(const LAS bf16x8*)(kp + 32), k2 = *(const LAS bf16x8*)(kp + 64), k3 = *(const LAS bf16x8*)(kp + 96);
    const bf16x8 q0 = qv[0], q1 = qv[1], q2 = qv[2], q3 = qv[3];
    bf16x8 vf[2][2];
#pragma unroll
    for (int sk = 0; sk < 2; ++sk)
#pragma unroll
        for (int dvb = 0; dvb < 2; ++dvb) {
            const LAS unsigned char* a = vb + 16 * sk * A_VP + dvb * 64;
            const s16x4 lo = vtr(a), hi = vtr(a + 8 * A_VP);
            vf[sk][dvb] = (bf16x8){lo[0], lo[1], lo[2], lo[3], hi[0], hi[1], hi[2], hi[3]};
        }
    const f32x16 z = {0.f, 0.f, 0.f, 0.f, 0.f, 0.f, 0.f, 0.f, 0.f, 0.f, 0.f, 0.f, 0.f, 0.f, 0.f, 0.f};
    f32x16 s1 = __builtin_amdgcn_mfma_f32_32x32x16_bf16(k0, q0, z, 0, 0, 0);
    f32x16 s2 = __builtin_amdgcn_mfma_f32_32x32x16_bf16(k2, q2, z, 0, 0, 0);
    s1 = __builtin_amdgcn_mfma_f32_32x32x16_bf16(k1, q1, s1, 0, 0, 0);
    s2 = __builtin_amdgcn_mfma_f32_32x32x16_bf16(k3, q3, s2, 0, 0, 0);
#pragma unroll
    for (int sk = 0; sk < 2; ++sk) {
        L1 = __builtin_amdgcn_mfma_f32_32x32x16_bf16(ones, pc[0][sk], L1, 0, 0, 0);
        L2 = __builtin_amdgcn_mfma_f32_32x32x16_bf16(ones, pc[1][sk], L2, 0, 0, 0);
#pragma unroll
        for (int dvb = 0; dvb < 2; ++dvb) {
            O1[dvb] = __builtin_amdgcn_mfma_f32_32x32x16_bf16(vf[sk][dvb], pc[0][sk], O1[dvb], 0, 0, 0);
            O2[dvb] = __builtin_amdgcn_mfma_f32_32x32x16_bf16(vf[sk][dvb], pc[1][sk], O2[dvb], 0, 0, 0);
        }
    }
    if (HAVE) {
#pragma unroll
        for (int r = 0; r < 16; ++r) { s1[r] -= mref1; s2[r] -= mref2; }
    }
    exp16(s1); exp16(s2);
    bf16x8 pn[2][2];
    pn[0][0] = packp(s1, 0); pn[0][1] = packp(s1, 1); pn[1][0] = packp(s2, 0); pn[1][1] = packp(s2, 1);
#if 0
    __builtin_amdgcn_sched_group_barrier(0x008, 6, 0);
#pragma unroll
    for (int i = 0; i < 10; ++i) { __builtin_amdgcn_sched_group_barrier(0x002, SGB_V, 0); __builtin_amdgcn_sched_group_barrier(0x008, 1, 0); }
    __builtin_amdgcn_sched_group_barrier(0x002, 48, 0);
#endif
    pc[0][0] = pn[0][0]; pc[0][1] = pn[0][1]; pc[1][0] = pn[1][0]; pc[1][1] = pn[1][1];
}
__device__ __forceinline__ void unit_A(const bool CTXQ, LAS unsigned char* lds, const bf16_t* H, bf16_t* Ob, int b, int h, int qb, float lam, float ofac, const float* subw) {
    const int tid = pg8_ltid(), lane = tid & 63, r32 = lane & 31, hh = lane >> 5, wid = tid >> 6;
    const int qrow = CTXQ ? (ML + b * CTXL + wid * 32 + r32) : (b * SEQ + qb * 256 + wid * 32 + r32);
    const int qcol = h * 64, kcol = 256 + h * 64, vcol = 512 + h * 64;
    const int NT = CTXQ ? 4 : 132;
    f32x16 O1[2], O2[2], L1, L2;
#pragma unroll
    for (int r = 0; r < 16; ++r) { O1[0][r] = 0.f; O1[1][r] = 0.f; O2[0][r] = 0.f; O2[1][r] = 0.f; L1[r] = 0.f; L2[r] = 0.f; }
    const bf16x8 ones = {0x3F80, 0x3F80, 0x3F80, 0x3F80, 0x3F80, 0x3F80, 0x3F80, 0x3F80};
    const int voff = A_VOFF + (4 * hh + ((lane & 15) >> 2)) * A_VP + (((lane >> 4) & 1) * 16 + (lane & 3) * 4) * 2;
    const int krow0 = CTXQ ? (ML + b * CTXL) : (b * SEQ);
    LAS unsigned char* qs = lds + 3 * A_BUF + (wid * 32 + r32) * A_KP + hh * 16;
    volatile LAS unsigned* flag = (volatile LAS unsigned*)(lds + RING_BYTES + 128);
    TileRegs R;
    __syncthreads();
    if (tid == 0) *flag = 0u;
#pragma unroll
    for (int ks = 0; ks < 4; ++ks) *(LAS bf16x8*)(qs + ks * 32) = *(const bf16x8*)(H + (size_t)qrow * INC + qcol + 16 * ks + 8 * hh);
    tile_gload(R, H, krow0, kcol, vcol, tid);       tileA_swrite(R, lds, tid);
    tile_gload(R, H, krow0 + 64, kcol, vcol, tid);  tileA_swrite(R, lds + A_BUF, tid);
    tile_gload(R, H, krow0 + 128, kcol, vcol, tid);
    __syncthreads();
    bf16x8 pc[2][2];
    {
        const LAS unsigned char* kp = lds + r32 * A_KP + hh * 16;
        const f32x16 z = {0.f, 0.f, 0.f, 0.f, 0.f, 0.f, 0.f, 0.f, 0.f, 0.f, 0.f, 0.f, 0.f, 0.f, 0.f, 0.f};
        f32x16 sa1 = __builtin_amdgcn_mfma_f32_32x32x16_bf16(*(const LAS bf16x8*)(kp), *(const LAS bf16x8*)(qs), z, 0, 0, 0);
        sa1 = __builtin_amdgcn_mfma_f32_32x32x16_bf16(*(const LAS bf16x8*)(kp + 32), *(const LAS bf16x8*)(qs + 32), sa1, 0, 0, 0);
        f32x16 sa2 = __builtin_amdgcn_mfma_f32_32x32x16_bf16(*(const LAS bf16x8*)(kp + 64), *(const LAS bf16x8*)(qs + 64), z, 0, 0, 0);
        sa2 = __builtin_amdgcn_mfma_f32_32x32x16_bf16(*(const LAS bf16x8*)(kp + 96), *(const LAS bf16x8*)(qs + 96), sa2, 0, 0, 0);
        exp16(sa1); exp16(sa2);
        pc[0][0] = packp(sa1, 0); pc[0][1] = packp(sa1, 1); pc[1][0] = packp(sa2, 0); pc[1][1] = packp(sa2, 1);
    }
    bf16x8 qv[4];
#pragma unroll
    for (int ks = 0; ks < 4; ++ks) qv[ks] = *(const LAS bf16x8*)(qs + ks * 32);
    int bc = 0, t = 0;
#define UNITA_STAGE() \
        const int bn = (bc == 2 * A_BUF) ? 0 : bc + A_BUF, bw = (bn == 2 * A_BUF) ? 0 : bn + A_BUF; \
        if (t + 2 < NT) { \
            tileA_swrite(R, lds + bw, tid); \
            if (t + 3 < NT) { const int tn = t + 3; const int krow = CTXQ ? (krow0 + 64 * tn) : (tn < 128 ? b * SEQ + 64 * tn : ML + b * CTXL + 64 * (tn - 128)); tile_gload(R, H, krow, kcol, vcol, tid); } \
        }
#define UNITA_GUARD() (__any((L1[0] > 1.152921504606846976e18f) || (L2[0] > 1.152921504606846976e18f)) != 0)
    {
        for (; t < NT; ++t) {
            UNITA_STAGE()
            stepA<false>(pc, lds + bc, 1, lds + bc + voff, qv, r32, hh, 0.f, 0.f, O1, O2, L1, L2, ones);
            stepA<false>(pc, lds + bn, 0, lds + bc + voff + 32 * A_VP, qv, r32, hh, 0.f, 0.f, O1, O2, L1, L2, ones);
            __syncthreads();
            bc = bn;
        }
    }
#undef UNITA_STAGE
#undef UNITA_GUARD
    if (__any(!((L1[0] > 1e-30f) && (L1[0] < 1e30f) && (L2[0] > 1e-30f) && (L2[0] < 1e30f))) != 0) *flag = 1u;
    __syncthreads();
    if (*flag != 0u) { unit_A_safe(CTXQ, lds, H, Ob, b, h, qb, lam, ofac, subw); return; }
    const float i1 = 1.f / L1[0], i2 = lam / L2[0];
    float ss = 0.f;
#pragma unroll
    for (int dvb = 0; dvb < 2; ++dvb)
#pragma unroll
        for (int r = 0; r < 16; ++r) { const float o = O1[dvb][r] * i1 - O2[dvb][r] * i2; O1[dvb][r] = o; ss += o * o; }
    ss = xhalf_sum(ss);
    float li_ = ofac; asm volatile("" : "+s"(li_));
    const float rn = rsqrtf(ss * (1.f / 64.f) + 1e-6f) * (1.f - li_);
#pragma unroll
    for (int dvb = 0; dvb < 2; ++dvb)
#pragma unroll
        for (int g = 0; g < 4; ++g) {
            const f32x4 w = *(const f32x4*)(subw + dvb * 32 + 8 * g + 4 * hh);
#pragma unroll
            for (int e = 0; e < 4; ++e) O1[dvb][4 * g + e] *= rn * w[e];
        }
    store_o(O1, Ob + (size_t)qrow * DM + h * 64, hh);
}

template <int MODE> __device__ __forceinline__ int tile_row_f(int t, int b, int lo, int nloc) {
    if (MODE == 1) return (t < nloc) ? (b * SEQ + 64 * (lo + t)) : (ML + b * CTXL + 64 * (t - nloc));
    if (MODE == 2) return (t < 4) ? (ML + b * CTXL + 64 * t) : (b * SEQ + 64 * (lo + t - 4));
    return ML + b * CTXL + 64 * t;
}
__device__ __forceinline__ int tile_row_r(int MODE, int t, int b, int lo, int nloc) {
    if (MODE == 1) return (t < nloc) ? (b * SEQ + 64 * (lo + t)) : (ML + b * CTXL + 64 * (t - nloc));
    if (MODE == 2) return (t < 4) ? (ML + b * CTXL + 64 * t) : (b * SEQ + 64 * (lo + t - 4));
    return ML + b * CTXL + 64 * t;
}
__device__ __forceinline__ void unit_BC(const int MODE, LAS unsigned char* lds, const bf16_t* H, bf16_t* Ob, int b, int hd, int blk, const float* sink_l, const float* rpb_l) {
    const int tid = pg8_ltid(), lane = tid & 63, r32 = lane & 31, hh = lane >> 5, wid = tid >> 6;
    int qrow, qcol, kcol, vcol, ocol, qpos = 0, r_w = 0, qc = 0, lo = 0, nloc = 0;
    float m = -INFINITY, l = 0.f;
    if (MODE == 1) {
        const int g = wid >> 2, head = hd * 2 + g; qpos = 128 * blk + 32 * (wid & 3) + r32; qrow = b * SEQ + qpos;
        qcol = 768 + head * 64; kcol = 1024 + hd * 64; vcol = 1152 + hd * 64; ocol = 256 + head * 64;
        lo = 2 * blk - 2; if (lo < 0) lo = 0; int hi = 2 * blk + 3; if (hi > 127) hi = 127; nloc = hi - lo + 1;
        m = sink_l[head] * LOG2E; l = (hh == 0) ? 1.f : 0.f;
    } else if (MODE == 3) {
        const int head = hd * 2 + blk; qrow = ML + b * CTXL + wid * 32 + r32;
        qcol = 768 + head * 64; kcol = 1024 + hd * 64; vcol = 1152 + hd * 64; ocol = 256 + head * 64;
        m = sink_l[head] * LOG2E; l = (hh == 0) ? 1.f : 0.f;
    } else if (MODE == 2) {
        r_w = 4 * blk + (wid >> 1); qc = 32 * (wid & 1) + r32; qrow = b * SEQ + r_w * 64 + qc;
        qcol = 1280 + hd * 64; kcol = 1536 + hd * 64; vcol = 1792 + hd * 64; ocol = 512 + hd * 64;
        int a0 = 4 * blk - 4; if (a0 < 0) a0 = 0; if (a0 > 120) a0 = 120; int a3 = 4 * blk + 3 - 4; if (a3 < 0) a3 = 0; if (a3 > 120) a3 = 120;
        lo = a0; nloc = a3 + 7 - a0 + 1;
    } else {
        qrow = ML + b * CTXL + wid * 32 + r32;
        qcol = 1280 + hd * 64; kcol = 1536 + hd * 64; vcol = 1792 + hd * 64; ocol = 512 + hd * 64;
    }
    bf16x8 qf[4];
#pragma unroll
    for (int ks = 0; ks < 4; ++ks) qf[ks] = *(const bf16x8*)(H + (size_t)qrow * INC + qcol + 16 * ks + 8 * hh);
    f32x16 O[2];
#pragma unroll
    for (int r = 0; r < 16; ++r) { O[0][r] = 0.f; O[1][r] = 0.f; }
    const int NT = 4 + nloc;
    int rs = 0;
    if (MODE == 2) { rs = r_w - 4; if (rs < 0) rs = 0; if (rs > 120) rs = 120; }
    const LAS float* rpbs = (const LAS float*)(lds + L_RPB);
    TileRegs R;
    tile_gload(R, H, tile_row_r(MODE, 0, b, lo, nloc), kcol, vcol, tid);
    for (int t = 0; t < NT; ++t) {
        __syncthreads();
        tile_swrite(R, lds, tid);
        if (MODE == 2 && t == 0) { for (int i = tid; i < 465; i += 512) ((LAS float*)(lds + L_RPB))[i] = rpb_l[hd * 465 + i] * LOG2E; }
        __syncthreads();
        if (t + 1 < NT) tile_gload(R, H, tile_row_r(MODE, t + 1, b, lo, nloc), kcol, vcol, tid);
        bool active = true; int kr = 0;
        if (MODE == 2 && t >= 4) { kr = lo + t - 4; active = (kr >= rs) && (kr < rs + 8); }
        if (active) {
            f32x16 s[2]; s[0] = qk_block<0, 4>(lds, 0, r32, hh, qf); s[1] = qk_block<0, 4>(lds, 1, r32, hh, qf);
            if (MODE == 1 && t < nloc) {
                const int kbase = 64 * (lo + t) - qpos;
#pragma unroll
                for (int kb = 0; kb < 2; ++kb)
#pragma unroll
                    for (int r = 0; r < 16; ++r) { const int d = kbase + kb * 32 + crow(r, hh); if (d > 128 || d < -128) s[kb][r] = -INFINITY; }
            }
            if (MODE == 2 && t >= 4) {
                int cs = qc - 8; if (cs < 0) cs = 0; if (cs > 48) cs = 48;
                const int bbase = (kr - r_w + 7) * 31 + 15 - qc;
#pragma unroll
                for (int kb = 0; kb < 2; ++kb)
#pragma unroll
                    for (int r = 0; r < 16; ++r) {
                        const int kc = kb * 32 + crow(r, hh);
                        const bool ok = (kc >= cs) && (kc < cs + 16);
                        int bi = bbase + kc; bi = ok ? bi : 0;
                        const float bias = rpbs[bi];
                        s[kb][r] = ok ? (s[kb][r] + bias) : -INFINITY;
                    }
            }
            softmax_pv(s, m, l, O, lds, r32, hh);
        }
    }
    l = xhalf_sum(l);
    const float il = 1.f / l;
#pragma unroll
    for (int r = 0; r < 16; ++r) { O[0][r] *= il; O[1][r] *= il; }
    store_o(O, Ob + (size_t)qrow * DM + ocol, hh);
}

template <int MODE>
__device__ __forceinline__ void bcf_compute(const LAS unsigned char* cur, int t, int nloc, int lo, int qpos, int kr, int r_w, int qc, const bf16x8 (&qf)[4], f32x16 (&O)[2], f32x16& L,
                                            const bf16x8& ones, const LAS float* rpbs, int voff, int r32, int hh) {
    f32x16 s[2];
    const f32x16 z = {0.f, 0.f, 0.f, 0.f, 0.f, 0.f, 0.f, 0.f, 0.f, 0.f, 0.f, 0.f, 0.f, 0.f, 0.f, 0.f};
#pragma unroll
    for (int kb = 0; kb < 2; ++kb) {
        const LAS unsigned char* kp = cur + (kb * 32 + r32) * A_KP + hh * 16;
        s[kb] = __builtin_amdgcn_mfma_f32_32x32x16_bf16(*(const LAS bf16x8*)(kp), qf[0], z, 0, 0, 0);
        s[kb] = __builtin_amdgcn_mfma_f32_32x32x16_bf16(*(const LAS bf16x8*)(kp + 32), qf[1], s[kb], 0, 0, 0);
        s[kb] = __builtin_amdgcn_mfma_f32_32x32x16_bf16(*(const LAS bf16x8*)(kp + 64), qf[2], s[kb], 0, 0, 0);
        s[kb] = __builtin_amdgcn_mfma_f32_32x32x16_bf16(*(const LAS bf16x8*)(kp + 96), qf[3], s[kb], 0, 0, 0);
    }
    if (MODE == 1 && t < nloc) {
        const int kbase = 64 * (lo + t) - qpos;
#pragma unroll
        for (int kb = 0; kb < 2; ++kb)
#pragma unroll
            for (int r = 0; r < 16; ++r) { const int d = kbase + kb * 32 + crow(r, hh); if (d > 128 || d < -128) s[kb][r] = -INFINITY; }
    }
    if (MODE == 2 && t >= 4) {
        int cs = qc - 8; if (cs < 0) cs = 0; if (cs > 48) cs = 48;
        const int bbase = (kr - r_w + 7) * 31 + 15 - qc;
#pragma unroll
        for (int kb = 0; kb < 2; ++kb)
#pragma unroll
            for (int r = 0; r < 16; ++r) {
                const int kc = kb * 32 + crow(r, hh);
                const bool ok = (kc >= cs) && (kc < cs + 16);
                int bi = bbase + kc; bi = ok ? bi : 0;
                const float bias = rpbs[bi];
                s[kb][r] = ok ? (s[kb][r] + bias) : -INFINITY;
            }
    }
#pragma unroll
    for (int kb = 0; kb < 2; ++kb) {
        exp16(s[kb]);
#pragma unroll
        for (int sk = 0; sk < 2; ++sk) {
            const bf16x8 p = packp(s[kb], sk);
            L = __builtin_amdgcn_mfma_f32_32x32x16_bf16(ones, p, L, 0, 0, 0);
#pragma unroll
            for (int dvb = 0; dvb < 2; ++dvb) {
                const LAS unsigned char* a = cur + voff + (kb * 32 + 16 * sk) * A_VP + dvb * 64;
                const s16x4 vlo = vtr(a), vhi = vtr(a + 8 * A_VP);
                const bf16x8 vf = {vlo[0], vlo[1], vlo[2], vlo[3], vhi[0], vhi[1], vhi[2], vhi[3]};
                O[dvb] = __builtin_amdgcn_mfma_f32_32x32x16_bf16(vf, p, O[dvb], 0, 0, 0);
            }
        }
    }
}
template <int MODE>
__device__ __forceinline__ bool unit_BC_fast(LAS unsigned char* lds, const bf16_t* H, bf16_t* Ob, int b, int hd, int blk, const float* sink_l, const float* rpb_l) {
    const int tid = pg8_ltid(), lane = tid & 63, r32 = lane & 31, hh = lane >> 5, wid = tid >> 6;
    int qrow, qcol, kcol, vcol, ocol, qpos = 0, r_w = 0, qc = 0, lo = 0, nloc = 0;
    float linit = 0.f;
    if (MODE == 1) {
        const int g = wid >> 2, head = hd * 2 + g; qpos = 128 * blk + 32 * (wid & 3) + r32; qrow = b * SEQ + qpos;
        qcol = 768 + head * 64; kcol = 1024 + hd * 64; vcol = 1152 + hd * 64; ocol = 256 + head * 64;
        lo = 2 * blk - 2; if (lo < 0) lo = 0; int hi = 2 * blk + 3; if (hi > 127) hi = 127; nloc = hi - lo + 1;
        linit = __builtin_amdgcn_exp2f(sink_l[head] * LOG2E);
    } else if (MODE == 3) {
        const int head = hd * 2 + blk; qrow = ML + b * CTXL + wid * 32 + r32;
        qcol = 768 + head * 64; kcol = 1024 + hd * 64; vcol = 1152 + hd * 64; ocol = 256 + head * 64;
        linit = __builtin_amdgcn_exp2f(sink_l[head] * LOG2E);
    } else if (MODE == 2) {
        r_w = 4 * blk + (wid >> 1); qc = 32 * (wid & 1) + r32; qrow = b * SEQ + r_w * 64 + qc;
        qcol = 1280 + hd * 64; kcol = 1536 + hd * 64; vcol = 1792 + hd * 64; ocol = 512 + hd * 64;
        int a0 = 4 * blk - 4; if (a0 < 0) a0 = 0; if (a0 > 120) a0 = 120; int a3 = 4 * blk + 3 - 4; if (a3 < 0) a3 = 0; if (a3 > 120) a3 = 120;
        lo = a0; nloc = a3 + 7 - a0 + 1;
    } else {
        qrow = ML + b * CTXL + wid * 32 + r32;
        qcol = 1280 + hd * 64; kcol = 1536 + hd * 64; vcol = 1792 + hd * 64; ocol = 512 + hd * 64;
    }
    bf16x8 qf[4];
#pragma unroll
    for (int ks = 0; ks < 4; ++ks) qf[ks] = *(const bf16x8*)(H + (size_t)qrow * INC + qcol + 16 * ks + 8 * hh);
    f32x16 O[2], L;
#pragma unroll
    for (int r = 0; r < 16; ++r) { O[0][r] = 0.f; O[1][r] = 0.f; L[r] = linit; }
    const bf16x8 ones = {0x3F80, 0x3F80, 0x3F80, 0x3F80, 0x3F80, 0x3F80, 0x3F80, 0x3F80};
    const int NT = 4 + nloc;
    int rs = 0;
    if (MODE == 2) { rs = r_w - 4; if (rs < 0) rs = 0; if (rs > 120) rs = 120; }
    const int voff = A_VOFF + (4 * hh + ((lane & 15) >> 2)) * A_VP + (((lane >> 4) & 1) * 16 + (lane & 3) * 4) * 2;
    LAS float* rpbs = (LAS float*)(lds + 2 * A_BUF);
    volatile LAS unsigned* flag = (volatile LAS unsigned*)(lds + RING_BYTES + 128);
    TileRegs Ra, Rb;
    __syncthreads();
    if (tid == 0) *flag = 0u;
    if (MODE == 2) { for (int i = tid; i < 465; i += 512) rpbs[i] = rpb_l[hd * 465 + i] * LOG2E; }
    tile_gload(Ra, H, tile_row_f<MODE>(0, b, lo, nloc), kcol, vcol, tid);
    tileA_swrite(Ra, lds, tid);
    tile_gload(Rb, H, tile_row_f<MODE>(1, b, lo, nloc), kcol, vcol, tid);
    tile_gload(Ra, H, tile_row_f<MODE>(2, b, lo, nloc), kcol, vcol, tid);
    __syncthreads();
#define BCF_TILE(T, RS) { \
        const int t = (T); \
        const LAS unsigned char* cur = lds + (t & 1) * A_BUF; \
        if (t + 1 < NT) { \
            tileA_swrite(RS, lds + ((t + 1) & 1) * A_BUF, tid); \
            if (t + 3 < NT) tile_gload(RS, H, tile_row_f<MODE>(t + 3, b, lo, nloc), kcol, vcol, tid); \
        } \
        bool active = true; int kr = 0; \
        if (MODE == 2 && t >= 4) { kr = lo + t - 4; active = (kr >= rs) && (kr < rs + 8); } \
        if (active) bcf_compute<MODE>(cur, t, nloc, lo, qpos, kr, r_w, qc, qf, O, L, ones, rpbs, voff, r32, hh); \
        __syncthreads(); }
    for (int t2 = 0; t2 < NT; t2 += 2) {
        BCF_TILE(t2, Rb)
        if (t2 + 1 < NT) BCF_TILE(t2 + 1, Ra)
    }
#undef BCF_TILE
    const float lsum = L[0];
    if (__any(!((lsum > 1e-30f) && (lsum < 1e30f))) != 0) *flag = 1u;
    __syncthreads();
    if (*flag != 0u) return true;
    const float il = 1.f / lsum;
#pragma unroll
    for (int r = 0; r < 16; ++r) { O[0][r] *= il; O[1][r] *= il; }
    store_o(O, Ob + (size_t)qrow * DM + ocol, hh);
    return false;
}
}
__device__ __forceinline__ float silu_f(float v) { return v / (1.f + __expf(-v)); }

__device__ __forceinline__ int wrow_map(int type, int n) {
    if (type == 1) {
        const bool ropeA = n < 512, ropeB = (n >= 768 && n < 1152);
        if (!ropeA && !ropeB) return n;
        int p = n & 31;
        if (ropeA) { const int blk = p >> 3; p = (blk == 1) ? p + 8 : ((blk == 2) ? p - 8 : p); }
        const int nn = p >> 4, r = p & 15;
        return (n & ~31) + 8 * (r >> 2) + 4 * nn + (r & 3);
    }
    if (type == 2) { const int half = (n >= 2816) ? 1 : 0; const int j = n - half * 2816; return (j >> 7) * 256 + half * 128 + (j & 127); }
    return n;
}
__device__ __forceinline__ void transpose_item(const float* W, int K, int N, bf16_t* WT, int type, LAS float* scr, int item, int lane) {
    const int nblk = N / 64, kb = item / nblk, nb = item - kb * nblk, k0 = 64 * kb, n0 = 64 * nb;
    const int lr = lane >> 4, lc = (lane & 15) * 4;
#pragma unroll 8
    for (int i = 0; i < 16; ++i) {
        const int kk = 4 * i + lr;
        const f32x4 v = *(const f32x4*)(W + (size_t)(k0 + kk) * N + n0 + lc);
        LAS float* d = scr + kk * 65 + lc; d[0] = v[0]; d[1] = v[1]; d[2] = v[2]; d[3] = v[3];
    }
    asm volatile("s_waitcnt lgkmcnt(0)" ::: "memory");
    const int c = lane & 7;
#pragma unroll
    for (int j = 0; j < 8; ++j) {
        const int n = (lane >> 3) + 8 * j; const LAS float* s = scr + (8 * c) * 65 + n;
        u32x4 o; o.x = pkbf(s[0 * 65], s[1 * 65]); o.y = pkbf(s[2 * 65], s[3 * 65]); o.z = pkbf(s[4 * 65], s[5 * 65]); o.w = pkbf(s[6 * 65], s[7 * 65]);
        *(u32x4*)(WT + (size_t)wrow_map(type, n0 + n) * K + k0 + 8 * c) = o;
    }
    asm volatile("s_waitcnt lgkmcnt(0)" ::: "memory");
}

__device__ __forceinline__ void sincos_f(float x, float& c, float& s) {
    const float k = rintf(x * 0.636619772f);
    float r = fmaf(-k, 1.57079625129699707031f, x); r = fmaf(-k, 7.54978941586159635335e-08f, r);
    const float r2 = r * r;
    const float sr = r * (1.f + r2 * (-1.f / 6 + r2 * (1.f / 120 + r2 * (-1.f / 5040 + r2 * (1.f / 362880)))));
    const float cr = 1.f + r2 * (-0.5f + r2 * (1.f / 24 + r2 * (-1.f / 720 + r2 * (1.f / 40320 + r2 * (-1.f / 3628800)))));
    const int q = ((int)k) & 3;
    s = (q == 0) ? sr : (q == 1) ? cr : (q == 2) ? -sr : -cr;
    c = (q == 0) ? cr : (q == 1) ? -sr : (q == 2) ? -cr : sr;
}

__device__ __forceinline__ void norm_mod_row(const float* src, const float* nw, const float* sh, const float* sc, bf16_t* dst, int lane, const float* slab = nullptr, int nslab = 0, float* xout = nullptr, bool src16 = false) {
    u32x2* o8 = (u32x2*)dst + lane;
    if (src == nullptr) {
#pragma unroll
        for (int j = 0; j < 4; ++j) o8[64 * j] = (u32x2){0u, 0u};
        return;
    }
    const f32x4* xr = (const f32x4*)src + lane;
    f32x4 v[4]; float s = 0.f;
    if (src16) {
        const u32x2* xh = (const u32x2*)src + lane;
#pragma unroll
        for (int j = 0; j < 4; ++j) { const u32x2 w = xh[64 * j]; v[j] = (f32x4){bflo(w.x), bfhi(w.x), bflo(w.y), bfhi(w.y)}; }
    } else {
#pragma unroll
        for (int j = 0; j < 4; ++j) v[j] = xr[64 * j];
    }
    for (int p = 0; p < nslab; ++p) {
        const f32x4* sr = (const f32x4*)(slab + (size_t)p * 1024 * 1024) + lane;
#pragma unroll
        for (int j = 0; j < 4; ++j) v[j] += sr[64 * j];
    }
    if (xout != nullptr) {
#pragma unroll
        for (int j = 0; j < 4; ++j) ((f32x4*)xout + lane)[64 * j] = v[j];
    }
#pragma unroll
    for (int j = 0; j < 4; ++j) s += (v[j][0] * v[j][0] + v[j][1] * v[j][1]) + (v[j][2] * v[j][2] + v[j][3] * v[j][3]);
    const float rstd = rsqrtf(wave_sum(s, lane) * (1.f / 1024.f) + 1e-6f);
#pragma unroll
    for (int j = 0; j < 4; ++j) {
        const int k = 4 * (64 * j + lane);
        const f32x4 w = *(const f32x4*)(nw + k), a = *(const f32x4*)(sc + k), d = *(const f32x4*)(sh + k);
        f32x4 y;
#pragma unroll
        for (int e = 0; e < 4; ++e) y[e] = (v[j][e] * rstd * w[e]) * (1.f + a[e]) + d[e];
        u32x2 p; p.x = pkbf(y[0], y[1]); p.y = pkbf(y[2], y[3]);
        o8[64 * j] = p;
    }
}

#define XB_TMO      128
#define XB_XCNT(j)  (256  + 64 * (j))
#define XB_XSUB(j)  (1280 + 64 * (j))
#define XB_XGEN(j)  (2304 + 64 * (j))
#define XB_TOP      3328
#define XB_TOPGEN   3392
#define XCD_BAR_WORDS 3456
#define XB_SPIN_CAP (1u << 18)

__device__ __forceinline__ unsigned xb_ld(unsigned* p)              { return __hip_atomic_load(p, __ATOMIC_RELAXED, __HIP_MEMORY_SCOPE_AGENT); }
__device__ __forceinline__ unsigned xb_add(unsigned* p, unsigned v) { return __hip_atomic_fetch_add(p, v, __ATOMIC_RELAXED, __HIP_MEMORY_SCOPE_AGENT); }
__device__ __forceinline__ unsigned xb_xcc_id() { return (unsigned)__builtin_amdgcn_s_getreg((3 << 11) | 20) & 0xFu; }
#define XB_SPIN(cond, bar) do { unsigned _sp = 0; while (cond) { __builtin_amdgcn_s_sleep(1); \
    if ((++_sp & 255u) == 0u) { if (xb_ld(&(bar)[XB_TMO])) break; if (_sp > XB_SPIN_CAP) { atomicAdd(&(bar)[XB_TMO], 1u); break; } } } } while (0)

struct XcdBarrier {
    unsigned* bar; unsigned x;
    volatile LAS unsigned* st;
};

__device__ __forceinline__ XcdBarrier xcd_barrier_post(unsigned* bar, volatile LAS unsigned* st) {
    XcdBarrier b; b.bar = bar; b.x = xb_xcc_id(); b.st = st;
    if (threadIdx.x == 0) (void)xb_add(&bar[XB_XCNT(b.x)], 1u);
    return b;
}
__device__ __forceinline__ void xcd_barrier_complete(unsigned* bar, unsigned x, unsigned& nloc, unsigned& nx) {
    const unsigned G = gridDim.x * gridDim.y * gridDim.z;
    unsigned sum, cnt, mine, sp = 0u;
    for (;;) {
        sum = 0u; cnt = 0u; mine = 0u;
#pragma unroll
        for (unsigned j = 0; j < 16; ++j) { const unsigned c = xb_ld(&bar[XB_XCNT(j)]); sum += c; cnt += (c > 0u) ? 1u : 0u; mine = (j == x) ? c : mine; }
        if (sum == G) break;
        __builtin_amdgcn_s_sleep(1);
        if ((++sp & 255u) == 0u) { if (xb_ld(&bar[XB_TMO])) break; if (sp > XB_SPIN_CAP) { atomicAdd(&bar[XB_TMO], 1u); break; } }
    }
    nloc = mine > 0u ? mine : 1u; nx = cnt > 0u ? cnt : 1u;
}

__device__ __forceinline__ void xcd_barrier(const XcdBarrier& b) {
    asm volatile("s_waitcnt vmcnt(0)" ::: "memory");
    __syncthreads();
    if (threadIdx.x == 0) {
        unsigned* bar = b.bar;
        __builtin_amdgcn_s_waitcnt(0);
        unsigned nloc = b.st[0], nx = b.st[1];
        if (nloc == 0u) { xcd_barrier_complete(bar, b.x, nloc, nx); b.st[0] = nloc; b.st[1] = nx; }
        const unsigned old = xb_add(&bar[XB_XSUB(b.x)], 1u);
        const unsigned gen = old / nloc;
        if (old + 1u == (gen + 1u) * nloc) {
            __builtin_amdgcn_fence(__ATOMIC_RELEASE, "agent");
            asm volatile("s_waitcnt vmcnt(0)" ::: "memory");
            const unsigned og = xb_add(&bar[XB_TOP], 1u);
            const unsigned tg = og / nx;
            if (og + 1u == (tg + 1u) * nx) xb_add(&bar[XB_TOPGEN], 1u);
            else XB_SPIN(xb_ld(&bar[XB_TOPGEN]) == tg, bar);
            __builtin_amdgcn_fence(__ATOMIC_ACQUIRE, "agent");
            xb_add(&bar[XB_XGEN(b.x)], 1u);
            asm volatile("s_waitcnt vmcnt(0)" ::: "memory");
        } else {
            XB_SPIN(xb_ld(&bar[XB_XGEN(b.x)]) == gen, bar);
            __builtin_amdgcn_fence(__ATOMIC_ACQUIRE, "agent");
            asm volatile("s_waitcnt vmcnt(0)" ::: "memory");
        }
    }
    __syncthreads();
}

struct Args { const float* in[23]; float* out; unsigned char* ws; int ph_lo, ph_hi, coop, pad; };
typedef const __attribute__((address_space(4))) Args* KArgs;
__device__ __forceinline__ KArgs kargs() { KArgs p = (KArgs)__builtin_amdgcn_kernarg_segment_ptr(); asm volatile("" : "+s"(p)); return p; }
constexpr int N_PHASES = 2 + 7 * DEPTH + 1;

__global__ void __launch_bounds__(512, 2) fwd_kernel(Args a) {
    extern __shared__ __attribute__((aligned(16))) unsigned char lds_raw[];
    LAS unsigned char* lds = (LAS unsigned char*)lds_raw;
    volatile LAS unsigned* bar_st = (volatile LAS unsigned*)(lds + RING_BYTES + 64);
    if (threadIdx.x < 2) bar_st[threadIdx.x] = 0u;
    __syncthreads();
    if (kargs()->coop) (void)xcd_barrier_post((unsigned*)kargs()->ws, bar_st);
    const int ph_lo = kargs()->ph_lo, ph_hi = kargs()->ph_hi;
    for (int ph = ph_lo; ph < ph_hi; ++ph) {
        KArgs ka = kargs();
        const int tid = pg8_ltid(), lane = tid & 63, wave = __builtin_amdgcn_readfirstlane(tid >> 6);
        int G = gridDim.x, bx = blockIdx.x; asm volatile("" : "+s"(G), "+s"(bx));
        const int vcu = (G % 8 == 0) ? (bx % 8) * (G / 8) + bx / 8 : bx;
        const int gw = vcu * 8 + wave, NGW = G * 8;
        unsigned char* ws = ka->ws;
        float* MOD = (float*)(ws + WS_MOD); float* MODP = (float*)(ws + WS_MODP);
        float* tabA = (float*)(ws + WS_TAB); float* tabB = tabA + 128 * 8 * 2;
        float* XCA = (float*)(ws + WS_XC); float* XCB = (float*)(ws + WS_MODP);
        bf16_t* XN = (bf16_t*)(ws + WS_XN); bf16_t* Ob = (bf16_t*)(ws + WS_O); bf16_t* Hb = (bf16_t*)(ws + WS_H); bf16_t* ACT = Hb;
        float* XL = ka->out; bf16_t* XB = (bf16_t*)(ws + WS_XB);
        if (ph == 0) {
          {
            const float* w_mod = ka->in[6]; const float* c_in = ka->in[1]; const float* cctx_in = ka->in[3];
            for (int it = gw; it < 1536; it += NGW) {
                const int ks = it & 15, cgp = (it >> 4) % 24, l = it / 384;
                const int n0 = cgp * 256 + lane * 4;
                f32x4 acc[5];
#pragma unroll
                for (int s = 0; s < 5; ++s) acc[s] = (f32x4){0.f, 0.f, 0.f, 0.f};
                const float* wp = w_mod + ((size_t)l * 1024 + ks * 64) * 6144 + n0;
                for (int kk = 0; kk < 64; ++kk) {
                    const int k = ks * 64 + kk;
                    const f32x4 w = *(const f32x4*)(wp + (size_t)kk * 6144);
#pragma unroll
                    for (int s = 0; s < 4; ++s) acc[s] += silu_f(c_in[s * 1024 + k]) * w;
                    acc[4] += silu_f(cctx_in[k]) * w;
                }
#pragma unroll
                for (int s = 0; s < 5; ++s) *(f32x4*)(MODP + ((size_t)(ks * 4 + l) * 5 + s) * 6144 + n0) = acc[s];
            }
            LAS float* scr = (LAS float*)(lds + wave * 16768);
            for (int it = gw; it < 4 * 3072; it += NGW) {
                const int l = it / 3072; int r = it - l * 3072;
                unsigned char* wl = ws + WS_W + (size_t)l * W_LAYER;
                if (r < 704) { transpose_item(ka->in[8] + (size_t)l * 1024 * 2816, 1024, 2816, (bf16_t*)wl, 1, scr, r, lane); continue; } r -= 704;
                if (r < 256) { transpose_item(ka->in[9] + (size_t)l * 1024 * 1024, 1024, 1024, (bf16_t*)(wl + W_OUT_OFF), 0, scr, r, lane); continue; } r -= 256;
                if (r < 1408) { transpose_item(ka->in[18] + (size_t)l * 1024 * 5632, 1024, 5632, (bf16_t*)(wl + W_UP_OFF), 2, scr, r, lane); continue; } r -= 1408;
                transpose_item(ka->in[21] + (size_t)l * 2816 * 1024, 2816, 1024, (bf16_t*)(wl + W_DN_OFF), 0, scr, r, lane);
            }
            for (int idx = vcu * 512 + tid; idx < 3072; idx += G * 512) {
                int pos, i; float e;
                if (idx < 1024) { pos = idx >> 3; i = idx & 7; e = (float)i * 0.125f; } else { const int j = idx - 1024; pos = j >> 4; i = j & 15; e = (float)i * 0.0625f; }
                const float freq = exp2f(-e * 13.287712379549449f);
                const float ang = (float)pos * freq;
                float cc, ss; sincos_f(ang, cc, ss);
                float* tp = (idx < 1024) ? (tabA + idx * 2) : (tabB + (idx - 1024) * 2);
                tp[0] = cc; tp[1] = ss;
            }
          }
        } else if (ph == 1) {
            const float* b_mod = ka->in[7];
            for (int idx = vcu * 512 + tid; idx < 4 * 5 * 6144; idx += G * 512) {
                const int l = idx / 30720, n = idx % 6144;
                float s = b_mod[l * 6144 + n];
#pragma unroll
                for (int ks = 0; ks < 16; ++ks) s += MODP[(size_t)ks * 122880 + idx];
                MOD[idx] = s;
            }
        } else if (ph == N_PHASES - 1) {
            const float* fw = ka->in[22];
            for (int m = gw; m < ML; m += NGW) {
                const u32x2* xh = (const u32x2*)(XB + (size_t)m * DM) + lane; f32x4* xr = (f32x4*)(XL + (size_t)m * DM) + lane;
                f32x4 v[4]; float s = 0.f;
#pragma unroll
                for (int j = 0; j < 4; ++j) { const u32x2 w = xh[64 * j]; v[j] = (f32x4){bflo(w.x), bfhi(w.x), bflo(w.y), bfhi(w.y)}; s += (v[j][0] * v[j][0] + v[j][1] * v[j][1]) + (v[j][2] * v[j][2] + v[j][3] * v[j][3]); }
                const float rstd = rsqrtf(wave_sum(s, lane) * (1.f / 1024.f) + 1e-6f);
#pragma unroll
                for (int j = 0; j < 4; ++j) { const f32x4 w = *(const f32x4*)(fw + 4 * (64 * j + lane)); xr[64 * j] = v[j] * rstd * w; }
            }
        } else {
            const int l = (ph - 2) / 7, k = (ph - 2) % 7;
            const bool need_ctx = l < DEPTH - 1;
            const float* modl = MOD + (size_t)l * 5 * 6144;
            unsigned char* wl = ws + WS_W + (size_t)l * W_LAYER;
            if (k == 0) {
                const float* nw = ka->in[4] + l * 1024;
                for (int m = gw; m < MT; m += NGW) {
                    const bool lat = m < ML; const int slot = lat ? (m >> 13) : 4;
                    if (lat) { if (l == 0) norm_mod_row(ka->in[0] + (size_t)m * DM, nw, modl + slot * 6144, modl + slot * 6144 + 1024, XN + (size_t)m * DM, lane);
                               else norm_mod_row((const float*)(XB + (size_t)m * DM), nw, modl + slot * 6144, modl + slot * 6144 + 1024, XN + (size_t)m * DM, lane, nullptr, 0, nullptr, true); }
                    else {
                        const size_t ro = (size_t)(m - ML) * DM;
                        norm_mod_row((l == 0 ? ka->in[2] : (const float*)XCB) + ro, nw, modl + slot * 6144, modl + slot * 6144 + 1024, XN + (size_t)m * DM, lane,
                                     (const float*)Ob + ro, (l == 0) ? 0 : 11, XCA + ro);
                    }
                }
            } else if (k == 1) {
                pg8::Gemm g{XN, (const bf16_t*)wl, MT, INC, DM, DM}; pg8::StaticOrder S; S.init(MT, INC, G, bx);
                pg8::EpiInProj E{Hb, tabA, tabB};
#ifndef DIS_IN
                pg8::gemm_phase<pg8::EpiInProj, pg8::StaticOrder, true, true>(lds, g, S, E);
#endif
            } else if (k == 2) {
                float lam, ofac;
                {
                    float d1 = 0.f, d2 = 0.f;
                    for (int i = 0; i < 32; ++i) { d1 += ka->in[10][l * 32 + i] * ka->in[11][l * 32 + i]; d2 += ka->in[12][l * 32 + i] * ka->in[13][l * 32 + i]; }
                    const float li = 0.8f - 0.6f * expf(-0.3f * (float)l);
                    lam = expf(d1) - expf(d2) + li;
                    lam = __uint_as_float(__builtin_amdgcn_readfirstlane(__float_as_uint(lam))); ofac = __uint_as_float(__builtin_amdgcn_readfirstlane(__float_as_uint(li)));
                }
                const float* subw = ka->in[14] + l * 64; const float* sink_l = ka->in[15] + l * 4; const float* rpb_l = ka->in[16] + (size_t)l * 4 * 465;
#ifndef DIS_A
                for (int u = vcu; u < 512 + (need_ctx ? 16 : 0); u += G) {
                    const bool cq = u >= 512; const int bh = cq ? (u - 512) : (u >> 5);
                    att::unit_A(cq, lds, Hb, Ob, bh >> 2, bh & 3, u & 31, lam, ofac, subw);
                }
#endif
#ifndef DIS_B
                for (int u = vcu; u < 1024 + (need_ctx ? 32 : 0); u += G) {
                    int mode, ub, uh, ublk; bool redo = true;
                    if (u < 512) { mode = 1; ub = u >> 7; uh = (u >> 6) & 1; ublk = u & 63; redo = att::unit_BC_fast<1>(lds, Hb, Ob, ub, uh, ublk, sink_l, rpb_l); }
                    else if (u < 1024) { const int v = u - 512; mode = 2; ub = v >> 7; uh = (v >> 5) & 3; ublk = v & 31; redo = att::unit_BC_fast<2>(lds, Hb, Ob, ub, uh, ublk, sink_l, rpb_l); }
                    else { const int v = u - 1024, bh = v & 15; if (v < 16) { mode = 3; ub = bh >> 2; uh = (bh >> 1) & 1; ublk = bh & 1; } else { mode = 4; ub = bh >> 2; uh = bh & 3; ublk = 0; } }
                    if (redo) att::unit_BC(mode, lds, Hb, Ob, ub, uh, ublk, sink_l, rpb_l);
                }
#endif
                {
                    const float* cwl = ka->in[17] + (size_t)l * 3 * 256;
                    const int rows = need_ctx ? MT : ML;
                    const int c0 = (tid & 31) * 8;
                    float w0[8], w1[8], w2[8];
#pragma unroll
                    for (int e = 0; e < 8; ++e) { w0[e] = cwl[c0 + e]; w1[e] = cwl[256 + c0 + e]; w2[e] = cwl[512 + c0 + e]; }
                    for (int idx = vcu * 512 + tid; idx < rows * 32; idx += G * 512) {
                        const int row = idx >> 5;
                        int t, len; if (row < ML) { t = row & 8191; len = SEQ; } else { t = (row - ML) & 255; len = CTXL; }
                        const bf16_t* hp = Hb + (size_t)row * INC + 2048 + c0;
                        const u32x4 bg = *(const u32x4*)hp, cg1 = *(const u32x4*)(hp + 256), xi1 = *(const u32x4*)(hp + 512);
                        u32x4 cg0 = {0u, 0u, 0u, 0u}, xi0 = cg0, cg2 = cg0, xi2 = cg0;
                        if (t > 0) { cg0 = *(const u32x4*)(hp - INC + 256); xi0 = *(const u32x4*)(hp - INC + 512); }
                        if (t < len - 1) { cg2 = *(const u32x4*)(hp + INC + 256); xi2 = *(const u32x4*)(hp + INC + 512); }
                        u32x4 ow;
#pragma unroll
                        for (int e = 0; e < 4; ++e) {
                            const float ylo = w0[2 * e] * bflo(cg0[e]) * bflo(xi0[e]) + w1[2 * e] * bflo(cg1[e]) * bflo(xi1[e]) + w2[2 * e] * bflo(cg2[e]) * bflo(xi2[e]);
                            const float yhi = w0[2 * e + 1] * bfhi(cg0[e]) * bfhi(xi0[e]) + w1[2 * e + 1] * bfhi(cg1[e]) * bfhi(xi1[e]) + w2[2 * e + 1] * bfhi(cg2[e]) * bfhi(xi2[e]);
                            ow[e] = pkbf(bflo(bg[e]) * ylo, bfhi(bg[e]) * yhi);
                        }
                        *(u32x4*)(Ob + (size_t)row * DM + 768 + c0) = ow;
                    }
                }
                __syncthreads();
            } else if (k == 4) {
                const float* nw = ka->in[5] + l * 1024;
                const int nrows = (need_ctx ? NMX_ALL : NMX_L) * 256;
                for (int e = gw; e < nrows; e += NGW) {
                    const int pm = e >> 8, j = e & 255;
                    int t, slot; const float* base; int len;
                    if (pm < NMX_L) { const int s = pm / 33, ti = pm - s * 33; t = 254 * ti - 1 + j; len = SEQ; slot = s; base = nullptr; }
                    else { const int p = 254 * (pm - NMX_L) - 1 + j; const int sq = (p < 0) ? 0 : p / 257, r = p - sq * 257; t = (p >= 0 && p < 1029 && r != 0) ? (r - 1) : -1; len = CTXL; slot = 4; base = XCA + (size_t)sq * CTXL * DM; }
                    const bool ok = (t >= 0 && t < len);
                    const float* src = ok ? ((pm < NMX_L) ? (const float*)(XB + ((size_t)slot * SEQ + t) * DM) : (base + (size_t)t * DM)) : nullptr;
                    if (pm < NMX_L || !ok) norm_mod_row(src, nw, modl + slot * 6144 + 3072, modl + slot * 6144 + 4096, XN + (size_t)e * DM, lane, nullptr, 0, nullptr, pm < NMX_L);
                    else {
                        const size_t ro = (size_t)(src - XCA);
                        norm_mod_row(src, nw, modl + slot * 6144 + 3072, modl + slot * 6144 + 4096, XN + (size_t)e * DM, lane, (const float*)Hb + ro, 4, XCB + ro);
                    }
                }
            } else if (k == 5) {
                const int nM = need_ctx ? NMX_ALL : NMX_L;
                pg8::Gemm g{XN, (const bf16_t*)(wl + W_UP_OFF), nM * 256, UPC, DM, DM}; pg8::StaticOrder S; S.init(nM * 256, UPC, G, bx);
                pg8::EpiUpConv E{ACT, ka->in[19] + (size_t)l * 3 * UPC, ka->in[20] + (size_t)l * UPC};
                pg8::OneUnit one;
#ifndef DIS_UP
                for (int i = 0; S.next(i, one.u); ++i) pg8::gemm_phase<pg8::EpiUpConv, pg8::OneUnit, false, true>(lds, g, one, E);
#endif
            } else {
                const bool isout = (k == 3); const int KK = isout ? DM : DFF;
                const bf16_t* Ap = isout ? (const bf16_t*)Ob : (const bf16_t*)ACT; const bf16_t* Bp = (const bf16_t*)(wl + (isout ? W_OUT_OFF : W_DN_OFF));
                {
                    pg8::Gemm g{Ap, Bp, ML, DM, KK, KK}; pg8::StaticOrder S; S.init(ML, DM, G, bx);
                    pg8::EpiRes E{(isout && l == 0) ? ka->in[0] : (const float*)nullptr, XB, XB, modl, isout ? 2048 : 5120};
#ifndef DIS_OUT
                    pg8::gemm_phase<pg8::EpiRes, pg8::StaticOrder, true, true>(lds, g, S, E);
#endif
                }
                if (need_ctx) {
                    const int P = isout ? 4 : 11, klen = KK / P;
                    for (int su = bx; su < 16 * P; su += G) {
                        const int tile = su / P, part = su - tile * P;
                        pg8::Gemm gs{Ap + (size_t)ML * KK + part * klen, Bp + part * klen, MC, DM, klen, KK};
                        pg8::OneUnit one; one.u.pm = tile >> 2; one.u.pn = tile & 3;
                        pg8::EpiSlab EA{(isout ? (float*)Hb : (float*)Ob) + (size_t)part * 1024 * 1024, modl + 4 * 6144 + (isout ? 2048 : 5120)};
                        pg8::gemm_phase<pg8::EpiSlab, pg8::OneUnit, false, true>(lds, gs, one, EA);
                    }
                }
            }
        }
        if (ph + 1 < ph_hi && kargs()->coop) {
            if (kargs()->coop == 2) cg::this_grid().sync();
            else { XcdBarrier b; b.bar = (unsigned*)kargs()->ws; b.x = xb_xcc_id(); b.st = bar_st; xcd_barrier(b); }
        }
    }
}

extern "C" void kernel_launch(void* const* d_in, const int* in_sizes, int n_in, void* d_out, int out_size, void* d_ws, size_t ws_size, hipStream_t stream) {
    static int grid = 0;
    if (grid == 0) {
        if (n_in != 23 || out_size != ML * DM || ws_size < WS_END) { fprintf(stderr, "kernel_launch: unexpected shapes (n_in %d out %d ws %zu need %zu)\n", n_in, out_size, ws_size, (size_t)WS_END); grid = -1; return; }
        int dev = 0, cus = 0, per_cu = 0;
        if (hipGetDevice(&dev) != hipSuccess || hipDeviceGetAttribute(&cus, hipDeviceAttributeMultiprocessorCount, dev) != hipSuccess) { grid = -1; return; }
        if (hipFuncSetAttribute((const void*)fwd_kernel, hipFuncAttributeMaxDynamicSharedMemorySize, LDS_BYTES) != hipSuccess) { fprintf(stderr, "kernel_launch: hipFuncSetAttribute failed\n"); grid = -1; return; }
        if (hipOccupancyMaxActiveBlocksPerMultiprocessor(&per_cu, (const void*)fwd_kernel, 512, LDS_BYTES) != hipSuccess || per_cu < 1) fprintf(stderr, "kernel_launch: occupancy query says %d\n", per_cu);
        (void)hipGetLastError();
        grid = cus;
    }
    if (grid < 0) return;
    Args a{};
    for (int i = 0; i < 23; ++i) a.in[i] = (const float*)d_in[i];
    a.out = (float*)d_out; a.ws = (unsigned char*)d_ws;
#if MK_MULTI
    for (int ph = 0; ph < N_PHASES; ++ph) {
        a.ph_lo = ph; a.ph_hi = ph + 1; a.coop = 0;
        hipLaunchKernelGGL(fwd_kernel, dim3(grid), dim3(512), LDS_BYTES, stream, a);
    }
#else
    a.ph_lo = 0; a.ph_hi = N_PHASES; a.coop = 1;
    if (hipMemsetAsync(d_ws, 0, 16384, stream) != hipSuccess) { fprintf(stderr, "kernel_launch: memset failed\n"); return; }
    void* args[] = {&a};
    hipError_t e = hipLaunchCooperativeKernel((const void*)fwd_kernel, dim3(grid), dim3(512), args, LDS_BYTES, stream);
    if (e != hipSuccess) fprintf(stderr, "cooperative launch failed: %s (grid %d)\n", hipGetErrorString(e), grid);
#endif
}
```

```cpp
#include <hip/hip_runtime.h>
#include <hip/hip_cooperative_groups.h>
#include <cstdio>
#include <cstdint>
namespace cg = cooperative_groups;

#ifndef MK_MULTI
#define MK_MULTI 0
#endif

#ifndef REP_IN
#define REP_IN 1
#endif
#ifndef REP_UP
#define REP_UP 1
#endif
#ifndef REP_A
#define REP_A 1
#endif
#ifndef REP_OD
#define REP_OD 1
#endif
#ifndef REP_P
#define REP_P 1
#endif
#ifndef REP_BC
#define REP_BC 1
#endif
#ifndef REP_M
#define REP_M 1
#endif

__device__ __forceinline__ int pg8_ltid() { int t = threadIdx.x; asm volatile("" : "+v"(t)); return t; }
namespace pg8 {
#define PG8_LAS __attribute__((address_space(3)))
typedef unsigned short bf16_t;
typedef short bf16x8 __attribute__((ext_vector_type(8)));
typedef float f32x4 __attribute__((ext_vector_type(4)));
typedef unsigned u32x4 __attribute__((ext_vector_type(4)));
constexpr int BM = 256, BK = 64, HALF = 128, HTB = HALF * BK * 2  , STAGE_BYTES = 8 * HTB, NXCD = 8, WGM = 8;

__host__ __device__ __forceinline__ int lds_byte(int r, int c) { const int st = (r >> 4) * 2 + (c >> 5), rr = r & 15, cc = c & 31, ob = rr * 64 + cc * 2; return st * 1024 + (ob ^ (((ob >> 9) & 1) << 5)); }
__host__ __device__ __forceinline__ void stage_rc(int b, int& R, int& C) { const int st = b / 1024, sb = b % 1024, swz = sb ^ (((sb >> 9) & 1) << 5); R = (st >> 1) * 16 + swz / 64; C = (st & 1) * 32 + (swz % 64) / 2; }
__host__ __device__ __forceinline__ int perm32(int rho) { const int n = rho >> 4, i = rho & 15; return 8 * (i >> 2) + 4 * n + (i & 3); }

struct Unit { int pm, pn; };
struct Gemm { const bf16_t* A; const bf16_t* Bt; int M, N, K, ldk; };

struct StaticOrder {
    int nM, nN, nwg, G, c;
    __host__ __device__ void init(int M, int N, int G_, int c_) { nM = M / BM; nN = N / BM; nwg = nM * nN; G = G_; c = c_; }
    __host__ __device__ bool next(int i, Unit& u) const {
        const long L = (long)i * G + c; if (L >= nwg) return false;
        int wgid = (int)L; { const int q = nwg / NXCD, r = nwg % NXCD, xcd = wgid % NXCD, off = wgid / NXCD; wgid = (xcd < r ? xcd * (q + 1) : r * (q + 1) + (xcd - r) * q) + off; }
        const int nig = WGM * nN, gid = wgid / nig, fm = gid * WGM, gsz = (nM - fm) < WGM ? (nM - fm) : WGM;
        u.pm = fm + ((wgid % nig) % gsz); u.pn = (wgid % nig) / gsz; return true;
    }
    __device__ __forceinline__ void a_ready(const Unit&) const {}
    __device__ __forceinline__ void done(const Unit&) const {}
};

typedef float pg8_f32x2 __attribute__((ext_vector_type(2))); typedef __bf16 pg8_bf16x2 __attribute__((ext_vector_type(2)));
__device__ __forceinline__ unsigned cvt_pk_bf16(float lo, float hi) { pg8_f32x2 v = {lo, hi}; pg8_bf16x2 b = __builtin_convertvector(v, pg8_bf16x2); return __builtin_bit_cast(unsigned, b); }
typedef unsigned u32x2 __attribute__((ext_vector_type(2)));

struct OneUnit {
    Unit u;
    __device__ __forceinline__ bool next(int i, Unit& o) const { if (i != 0) return false; o = u; return true; }
    __device__ __forceinline__ void a_ready(const Unit&) const {}
    __device__ __forceinline__ void done(const Unit&) const {}
};

struct EpiInProj {
    static constexpr bool PERM = true, AFTER_DRAIN = false;
    bf16_t* H; const float* tabA; const float* tabB;
    __device__ __forceinline__ void operator()(const f32x4 (&acc)[2][2][4][2], const Unit& u, int wr, int wc, int fr, int fq) const {
        const int pn = u.pn; const bool latent = u.pm < 128;
        const float scale = (pn == 0) ? 0.17677669529663687f * 1.4426950408889634f : ((pn == 3 || pn == 5) ? 0.125f * 1.4426950408889634f : 1.0f);
#pragma unroll
        for (int bj = 0; bj < 2; ++bj) {
            int mode = (pn == 0 || pn == 1) ? 1 : ((pn == 3 || (pn == 4 && bj == 0)) ? 2 : 0);
            if (!latent) mode = 0;
#ifdef TEST_NOROPE
            mode = 0;
#endif
#pragma unroll
            for (int ai = 0; ai < 2; ++ai)
#pragma unroll
                for (int m = 0; m < 4; ++m) {
                    const int r = u.pm * BM + ai * HALF + wr * 64 + m * 16 + fr;
                    f32x4 v0 = acc[ai][bj][m][0], v1 = acc[ai][bj][m][1];
                    if (mode != 0) {
                        const int t = r & 8191, trow = t >> 6, tcol = t & 63;
                        const float* tp;
                        if (mode == 1) { const int pos = (fq < 2) ? trow : tcol; tp = tabA + (pos * 8 + 4 * (fq & 1)) * 2; }
                        else { const int pos = (wc & 1) ? tcol : trow; tp = tabB + (pos * 16 + 4 * fq) * 2; }
                        const f32x4 cs0 = *(const f32x4*)tp, cs1 = *(const f32x4*)(tp + 4);
                        const float c0 = cs0[0], s0 = cs0[1], c1 = cs0[2], s1 = cs0[3], c2 = cs1[0], s2 = cs1[1], c3 = cs1[2], s3 = cs1[3];
                        f32x4 a = v0, b = v1;
                        v0[0] = a[0] * c0 - b[0] * s0; v1[0] = b[0] * c0 + a[0] * s0;
                        v0[1] = a[1] * c1 - b[1] * s1; v1[1] = b[1] * c1 + a[1] * s1;
                        v0[2] = a[2] * c2 - b[2] * s2; v1[2] = b[2] * c2 + a[2] * s2;
                        v0[3] = a[3] * c3 - b[3] * s3; v1[3] = b[3] * c3 + a[3] * s3;
                    }
                    v0 = v0 * scale; v1 = v1 * scale;
                    bf16_t* rowp = H + (size_t)r * 2816 + pn * BM + bj * HALF + wc * 32 + 8 * fq;
                    u32x4 w; w.x = cvt_pk_bf16(v0[0], v0[1]); w.y = cvt_pk_bf16(v0[2], v0[3]); w.z = cvt_pk_bf16(v1[0], v1[1]); w.w = cvt_pk_bf16(v1[2], v1[3]);
                    *(u32x4*)rowp = w;
                }
        }
    }
};

struct EpiRes {
    static constexpr bool PERM = false, AFTER_DRAIN = false;
    const float* base32; const bf16_t* base16; bf16_t* out16; const float* modl; int goff;
    __device__ __forceinline__ void operator()(const f32x4 (&acc)[2][2][4][2], const Unit& u, int wr, int wc, int fr, int fq) const {
        const int slot = u.pm >> 5;
        const int row0 = u.pm * BM + wr * 64 + fr;
        const int col0 = u.pn * BM + wc * 32 + 4 * fq;
        f32x4 gv[2][2];
#pragma unroll
        for (int bj = 0; bj < 2; ++bj)
#pragma unroll
            for (int n = 0; n < 2; ++n) gv[bj][n] = *(const f32x4*)(modl + slot * 6144 + goff + col0 + bj * HALF + n * 16);
        const bool f32in = (base32 != nullptr);
#pragma unroll
        for (int ai = 0; ai < 2; ++ai)
#pragma unroll
            for (int m = 0; m < 4; ++m) {
                const size_t off = (size_t)(row0 + ai * HALF + m * 16) * 1024 + col0;
#pragma unroll
                for (int bj = 0; bj < 2; ++bj)
#pragma unroll
                    for (int n = 0; n < 2; ++n) {
                        f32x4 bs;
                        if (f32in) bs = *(const f32x4*)(base32 + off + bj * HALF + n * 16);
                        else { const u32x2 w = *(const u32x2*)(base16 + off + bj * HALF + n * 16); bs = (f32x4){__uint_as_float(w.x << 16), __uint_as_float(w.x & 0xffff0000u), __uint_as_float(w.y << 16), __uint_as_float(w.y & 0xffff0000u)}; }
                        const f32x4 o = bs + gv[bj][n] * acc[ai][bj][m][n];
                        u32x2 ow; ow.x = cvt_pk_bf16(o[0], o[1]); ow.y = cvt_pk_bf16(o[2], o[3]);
                        *(u32x2*)(out16 + off + bj * HALF + n * 16) = ow;
                    }
                asm volatile("" ::: "memory");
            }
    }
};

struct EpiSlab {
    static constexpr bool PERM = false, AFTER_DRAIN = false;
    float* slab; const float* gate;
    __device__ __forceinline__ void operator()(const f32x4 (&acc)[2][2][4][2], const Unit& u, int wr, int wc, int fr, int fq) const {
        const int row0 = u.pm * BM + wr * 64 + fr, col0 = u.pn * BM + wc * 32 + 4 * fq;
#pragma unroll
        for (int bj = 0; bj < 2; ++bj)
#pragma unroll
            for (int n = 0; n < 2; ++n) {
                const f32x4 gv = *(const f32x4*)(gate + col0 + bj * HALF + n * 16);
#pragma unroll
                for (int ai = 0; ai < 2; ++ai)
#pragma unroll
                    for (int m = 0; m < 4; ++m)
                        *(f32x4*)(slab + (size_t)(row0 + ai * HALF + m * 16) * 1024 + col0 + bj * HALF + n * 16) = gv * acc[ai][bj][m][n];
            }
    }
};

struct EpiUpConv {
    static constexpr bool PERM = false, AFTER_DRAIN = true;
    bf16_t* ACT; const float* cw; const float* cb;
    static constexpr int TP = 520;
    __device__ __forceinline__ void fused(f32x4 (&acc)[2][2][4][2], const Unit& u, int wr, int wc, int fr, int fq, PG8_LAS unsigned char* lds, int wid, int lane) const {
#pragma unroll
        for (int ai = 0; ai < 2; ++ai)
#pragma unroll
            for (int m = 0; m < 4; ++m) {
                const int row = ai * HALF + wr * 64 + m * 16 + fr;
#pragma unroll
                for (int bj = 0; bj < 2; ++bj)
#pragma unroll
                    for (int n = 0; n < 2; ++n) {
                        const f32x4 v = acc[ai][bj][m][n]; u32x2 w; w.x = cvt_pk_bf16(v[0], v[1]); w.y = cvt_pk_bf16(v[2], v[3]);
                        *(PG8_LAS u32x2*)(lds + row * TP + (bj * HALF + wc * 32 + n * 16 + 4 * fq) * 2) = w;
                    }
            }
        const int tid = wid * 64 + lane, ch = tid & 15;
        const int gcol = u.pn * 128 + ch * 8;
        float wg[3][8], wv[3][8], bg[8], bv[8];
#pragma unroll
        for (int k = 0; k < 3; ++k) {
            const f32x4 a0 = *(const f32x4*)(cw + k * 5632 + gcol), a1 = *(const f32x4*)(cw + k * 5632 + gcol + 4);
            const f32x4 b0 = *(const f32x4*)(cw + k * 5632 + 2816 + gcol), b1 = *(const f32x4*)(cw + k * 5632 + 2816 + gcol + 4);
#pragma unroll
            for (int e = 0; e < 4; ++e) { wg[k][e] = a0[e]; wg[k][4 + e] = a1[e]; wv[k][e] = b0[e]; wv[k][4 + e] = b1[e]; }
        }
        {
            const f32x4 a0 = *(const f32x4*)(cb + gcol), a1 = *(const f32x4*)(cb + gcol + 4), b0 = *(const f32x4*)(cb + 2816 + gcol), b1 = *(const f32x4*)(cb + 2816 + gcol + 4);
#pragma unroll
            for (int e = 0; e < 4; ++e) { bg[e] = a0[e]; bg[4 + e] = a1[e]; bv[e] = b0[e]; bv[4 + e] = b1[e]; }
        }
        const bool lat = u.pm < 132; int rowbase, ti;
        if (lat) { const int s = u.pm / 33; ti = u.pm - s * 33; rowbase = s * 8192; } else { ti = u.pm - 132; rowbase = 32768; }
        asm volatile("s_waitcnt lgkmcnt(0)" ::: "memory"); __builtin_amdgcn_s_barrier(); asm volatile("" ::: "memory");
        for (int it = tid; it < 254 * 16; it += 512) {
            const int j = 1 + (it >> 4); const int p = 254 * ti - 1 + j;
            int orow; bool ok;
            if (lat) { ok = p < 8192; orow = rowbase + p; } else { const int sq = p / 257, r = p - sq * 257; ok = (p < 1029) && (r != 0); orow = rowbase + sq * 256 + r - 1; }
            if (ok) {
                float g[8], v[8];
#pragma unroll
                for (int e = 0; e < 8; ++e) { g[e] = bg[e]; v[e] = bv[e]; }
#pragma unroll
                for (int k = 0; k < 3; ++k) {
                    const PG8_LAS unsigned char* rp = lds + (j - 1 + k) * TP + ch * 16;
                    const u32x2 g0 = *(const PG8_LAS u32x2*)rp, g1 = *(const PG8_LAS u32x2*)(rp + 8);
                    const u32x2 v0 = *(const PG8_LAS u32x2*)(rp + 256), v1 = *(const PG8_LAS u32x2*)(rp + 264);
                    const unsigned gw[4] = {g0.x, g0.y, g1.x, g1.y}, vw[4] = {v0.x, v0.y, v1.x, v1.y};
#pragma unroll
                    for (int e = 0; e < 4; ++e) {
                        g[2 * e] += wg[k][2 * e] * __uint_as_float(gw[e] << 16); g[2 * e + 1] += wg[k][2 * e + 1] * __uint_as_float(gw[e] & 0xffff0000u);
                        v[2 * e] += wv[k][2 * e] * __uint_as_float(vw[e] << 16); v[2 * e + 1] += wv[k][2 * e + 1] * __uint_as_float(vw[e] & 0xffff0000u);
                    }
                }
                float o[8];
#pragma unroll
                for (int e = 0; e < 8; ++e) o[e] = g[e] * __builtin_amdgcn_rcpf(1.f + __builtin_amdgcn_exp2f(-1.4426950408889634f * g[e])) * v[e];
                u32x4 w; w.x = cvt_pk_bf16(o[0], o[1]); w.y = cvt_pk_bf16(o[2], o[3]); w.z = cvt_pk_bf16(o[4], o[5]); w.w = cvt_pk_bf16(o[6], o[7]);
                *(u32x4*)(ACT + (size_t)orow * 2816 + gcol) = w;
            }
        }
        asm volatile("s_waitcnt lgkmcnt(0)" ::: "memory"); __builtin_amdgcn_s_barrier(); asm volatile("" ::: "memory");
    }
};
template <class Epi, class Sched, bool ALIGN_EPI = false, bool SP2 = false>
__device__ __forceinline__ void gemm_phase(PG8_LAS unsigned char* lds, const Gemm g, const Sched& S, const Epi& E) {
    const int tid = pg8_ltid(), wid = __builtin_amdgcn_readfirstlane(tid >> 6), lane = tid & 63, wr = wid >> 2, wc = wid & 3, fr = lane & 15, fq = lane >> 4;
    const int K = g.ldk, nt = g.K / BK;
    unsigned voffA[2], voffB[2];
#pragma unroll
    for (int i = 0; i < 2; ++i) { int R, C; stage_rc(tid * 16 + i * 8192, R, C); const int Rb = Epi::PERM ? ((R & ~31) + perm32(R & 31)) : R;
        voffA[i] = (unsigned)(R * K + C) * 2u; voffB[i] = (unsigned)(Rb * K + C) * 2u; }
    const size_t kstep = (size_t)(BK * 2);
    const size_t hstep = (size_t)HALF * K * 2;
    const size_t tstep = 2 * hstep;
    const unsigned ldsw = (unsigned)wid * 1024u;
    const int aoff = lds_byte(wr * 64 + fr, fq * 8), boff = lds_byte(wc * 32 + fr, fq * 8);
#define PG8_SA(b, h) (((b) * 2 + (h)) * HTB)
#define PG8_SB(b, h) ((4 + (b) * 2 + (h)) * HTB)
#define PG8_STAGE(bufoff, gbase, voff) do { _Pragma("unroll") for (int _i = 0; _i < 2; ++_i) \
        __builtin_amdgcn_global_load_lds((const unsigned*)((const char*)(gbase) + (voff)[_i]), (PG8_LAS unsigned*)(lds + (bufoff) + ldsw + _i * 8192), 16, 0, 0); } while (0)
#define PG8_LDA(dst, b, h) do { _Pragma("unroll") for (int m = 0; m < 4; ++m) _Pragma("unroll") for (int k = 0; k < 2; ++k) dst[m][k] = *(const PG8_LAS bf16x8*)(lds + PG8_SA(b, h) + aoff + m * 2048 + k * 1024); } while (0)
#define PG8_LDB(dst, b, h) do { _Pragma("unroll") for (int n = 0; n < 2; ++n) _Pragma("unroll") for (int k = 0; k < 2; ++k) dst[n][k] = *(const PG8_LAS bf16x8*)(lds + PG8_SB(b, h) + boff + n * 2048 + k * 1024); } while (0)
#define PG8_MMA(ai, bj, At, Bt) do { __builtin_amdgcn_s_setprio(1); _Pragma("unroll") for (int m = 0; m < 4; ++m) _Pragma("unroll") for (int n = 0; n < 2; ++n) _Pragma("unroll") for (int k = 0; k < 2; ++k) \
        acc[ai][bj][m][n] = __builtin_amdgcn_mfma_f32_16x16x32_bf16(Bt[n][k], At[m][k], acc[ai][bj][m][n], 0, 0, 0); __builtin_amdgcn_s_setprio(0); } while (0)
#define PG8_WAIT_V(n) asm volatile("s_waitcnt vmcnt(" #n ")" ::: "memory")
#define PG8_WAIT_L(n) asm volatile("s_waitcnt lgkmcnt(" #n ")" ::: "memory")
#define PG8_BAR __builtin_amdgcn_s_barrier()
#define PG8_SCHED __builtin_amdgcn_sched_barrier(0)
    Unit cur, nxt; int ui = 0;
    if (!S.next(0, cur)) return;
    f32x4 acc[2][2][4][2];
#pragma unroll
    for (int a = 0; a < 2; ++a)
#pragma unroll
        for (int b = 0; b < 2; ++b)
#pragma unroll
            for (int m = 0; m < 4; ++m)
#pragma unroll
                for (int n = 0; n < 2; ++n) acc[a][b][m][n] = (f32x4){0.f, 0.f, 0.f, 0.f};
    bf16x8 At[4][2], B0[2][2], B1[2][2];
    const char* cA = (const char*)g.A + (size_t)cur.pm * tstep; const char* cB = (const char*)g.Bt + (size_t)cur.pn * tstep;
    S.a_ready(cur);
    if constexpr (SP2) {
        PG8_STAGE(PG8_SB(0, 0), cB, voffB); PG8_STAGE(PG8_SB(0, 1), cB + hstep, voffB); PG8_STAGE(PG8_SA(0, 0), cA, voffA); PG8_STAGE(PG8_SA(0, 1), cA + hstep, voffA);
        if (wr == 1) PG8_BAR;
        PG8_WAIT_V(2); PG8_BAR;
        PG8_STAGE(PG8_SB(1, 0), cB + kstep, voffB); PG8_STAGE(PG8_SA(1, 0), cA + kstep, voffA); PG8_STAGE(PG8_SB(1, 1), cB + hstep + kstep, voffB);
        PG8_WAIT_V(6); PG8_BAR;
    } else {
        PG8_STAGE(PG8_SB(0, 0), cB, voffB); PG8_STAGE(PG8_SA(0, 0), cA, voffA); PG8_STAGE(PG8_SB(0, 1), cB + hstep, voffB); PG8_STAGE(PG8_SA(0, 1), cA + hstep, voffA);
        if (wr == 1) PG8_BAR;
        PG8_WAIT_V(4); PG8_BAR;
        PG8_STAGE(PG8_SB(1, 0), cB + kstep, voffB); PG8_STAGE(PG8_SA(1, 0), cA + kstep, voffA); PG8_STAGE(PG8_SB(1, 1), cB + hstep + kstep, voffB);
        PG8_WAIT_V(6); PG8_BAR;
    }
    for (;;) {
        const bool has_next = S.next(ui + 1, nxt);
        const char* nA = has_next ? (const char*)g.A + (size_t)nxt.pm * tstep : cA; const char* nB = has_next ? (const char*)g.Bt + (size_t)nxt.pn * tstep : cB;
        for (int t = 0; t < nt; t += 2) {
            const bool last = (t == nt - 2);
            const char* a1 = cA + (size_t)(t + 1) * kstep;
            const char* a2 = last ? nA : cA + (size_t)(t + 2) * kstep; const char* b2 = last ? nB : cB + (size_t)(t + 2) * kstep;
            const char* a3 = a2 + kstep; const char* b3 = b2 + kstep;
            if (last && has_next) S.a_ready(nxt);
            if constexpr (SP2) {
            PG8_LDB(B0, 0, 0); PG8_LDB(B1, 0, 1); PG8_SCHED; PG8_LDA(At, 0, 0); PG8_STAGE(PG8_SA(1, 1), a1 + hstep, voffA);
            PG8_WAIT_V(8); PG8_WAIT_L(0); PG8_BAR; PG8_MMA(0, 0, At, B0); PG8_MMA(0, 1, At, B1); PG8_BAR; PG8_SCHED;
            PG8_LDA(At, 0, 1); PG8_STAGE(PG8_SB(0, 0), b2, voffB); PG8_STAGE(PG8_SB(0, 1), b2 + hstep, voffB); PG8_STAGE(PG8_SA(0, 0), a2, voffA);
            PG8_WAIT_V(8); PG8_WAIT_L(0); PG8_BAR; PG8_MMA(1, 0, At, B0); PG8_MMA(1, 1, At, B1); PG8_BAR; PG8_SCHED;
            PG8_LDB(B0, 1, 0); PG8_LDB(B1, 1, 1); PG8_SCHED; PG8_LDA(At, 1, 0); PG8_STAGE(PG8_SA(0, 1), a2 + hstep, voffA);
            PG8_WAIT_V(8); PG8_WAIT_L(0); PG8_BAR; PG8_MMA(0, 0, At, B0); PG8_MMA(0, 1, At, B1); PG8_BAR; PG8_SCHED;
            PG8_LDA(At, 1, 1); PG8_STAGE(PG8_SB(1, 0), b3, voffB); PG8_STAGE(PG8_SB(1, 1), b3 + hstep, voffB); PG8_STAGE(PG8_SA(1, 0), a3, voffA);
            PG8_WAIT_V(8); PG8_WAIT_L(0); PG8_BAR; PG8_MMA(1, 0, At, B0); PG8_MMA(1, 1, At, B1); PG8_BAR; PG8_SCHED;
            } else {
            PG8_LDB(B0, 0, 0); PG8_SCHED; PG8_LDA(At, 0, 0); PG8_STAGE(PG8_SA(1, 1), a1 + hstep, voffA);
            PG8_WAIT_L(8); PG8_BAR; PG8_WAIT_L(0); PG8_MMA(0, 0, At, B0); PG8_BAR; PG8_SCHED;
            PG8_LDB(B1, 0, 1); PG8_STAGE(PG8_SB(0, 0), b2, voffB);
            PG8_BAR; PG8_WAIT_L(0); PG8_MMA(0, 1, At, B1); PG8_BAR;
            PG8_LDA(At, 0, 1); PG8_STAGE(PG8_SA(0, 0), a2, voffA);
            PG8_BAR; PG8_WAIT_L(0); PG8_MMA(1, 0, At, B0); PG8_BAR; PG8_SCHED;
            PG8_STAGE(PG8_SB(0, 1), b2 + hstep, voffB);
            PG8_WAIT_V(6); PG8_BAR; PG8_MMA(1, 1, At, B1); PG8_BAR;
            PG8_LDB(B0, 1, 0); PG8_SCHED; PG8_LDA(At, 1, 0); PG8_STAGE(PG8_SA(0, 1), a2 + hstep, voffA);
            PG8_WAIT_L(8); PG8_BAR; PG8_WAIT_L(0); PG8_MMA(0, 0, At, B0); PG8_BAR; PG8_SCHED;
            PG8_LDB(B1, 1, 1); PG8_STAGE(PG8_SB(1, 0), b3, voffB);
            PG8_BAR; PG8_WAIT_L(0); PG8_MMA(0, 1, At, B1); PG8_BAR;
            PG8_LDA(At, 1, 1); PG8_STAGE(PG8_SA(1, 0), a3, voffA);
            PG8_BAR; PG8_WAIT_L(0); PG8_MMA(1, 0, At, B0); PG8_BAR; PG8_SCHED;
            PG8_STAGE(PG8_SB(1, 1), b3 + hstep, voffB);
            PG8_WAIT_V(6); PG8_BAR; PG8_MMA(1, 1, At, B1); PG8_BAR;
            }
        }
        if constexpr (ALIGN_EPI) { if (wr == 0) PG8_BAR; }
        if constexpr (!Epi::AFTER_DRAIN) { E(acc, cur, wr, wc, fr, fq); S.done(cur); }
        if (!has_next) break;
#pragma unroll
        for (int a = 0; a < 2; ++a)
#pragma unroll
            for (int b = 0; b < 2; ++b)
#pragma unroll
                for (int m = 0; m < 4; ++m)
#pragma unroll
                    for (int n = 0; n < 2; ++n) acc[a][b][m][n] = (f32x4){0.f, 0.f, 0.f, 0.f};
        cur = nxt; cA = nA; cB = nB; ++ui;
        if constexpr (ALIGN_EPI) { if (wr == 1) PG8_BAR; }
    }
    PG8_WAIT_V(0);
    if constexpr (!ALIGN_EPI) { if (wr == 0) PG8_BAR; }
    PG8_BAR;
    if constexpr (Epi::AFTER_DRAIN) { E.fused(acc, cur, wr, wc, fr, fq, lds, wid, lane); S.done(cur); }
#undef PG8_SA
#undef PG8_SB
#undef PG8_STAGE
#undef PG8_LDA
#undef PG8_LDB
#undef PG8_MMA
#undef PG8_WAIT_V
#undef PG8_WAIT_L
#undef PG8_BAR
#undef PG8_SCHED
}
}
#define LAS __attribute__((address_space(3)))
typedef unsigned short bf16_t;
typedef short bf16x8 __attribute__((ext_vector_type(8)));
typedef short s16x4 __attribute__((ext_vector_type(4)));
typedef float f32x4 __attribute__((ext_vector_type(4)));
typedef float f32x16 __attribute__((ext_vector_type(16)));
typedef unsigned u32x4 __attribute__((ext_vector_type(4)));
typedef unsigned u32x2 __attribute__((ext_vector_type(2)));

constexpr int DM = 1024, NB = 4, SEQ = 8192, DEPTH = 4, CTXL = 256;
constexpr int ML = NB * SEQ, MC = NB * CTXL, MT = ML + MC;
constexpr int INC = 2816, DFF = 2816, UPC = 5632;
constexpr int NMX_L = NB * 33, NMX_ALL = NB * 33 + 5;
constexpr float LOG2E = 1.4426950408889634f;

constexpr size_t MiB = 1u << 20;
constexpr size_t WS_MOD = 1 * MiB;
constexpr size_t WS_MODP = 2 * MiB;
constexpr size_t WS_TAB = 10 * MiB;
constexpr size_t WS_XC = 11 * MiB;
constexpr size_t WS_W = 16 * MiB;
constexpr size_t W_LAYER = 24 * MiB, W_OUT_OFF = (size_t)2816 * 1024 * 2, W_UP_OFF = W_OUT_OFF + (size_t)1024 * 1024 * 2, W_DN_OFF = W_UP_OFF + (size_t)5632 * 1024 * 2;
constexpr size_t WS_XN = 112 * MiB;
constexpr size_t WS_O = 182 * MiB;
constexpr size_t WS_H = 248 * MiB;
constexpr size_t WS_XB = 430 * MiB;
constexpr size_t WS_END = WS_XB + (size_t)ML * 1024 * 2;
static_assert(W_DN_OFF + (size_t)1024 * 2816 * 2 <= W_LAYER, "weights per layer");
static_assert(WS_XN + (size_t)NMX_ALL * 256 * 1024 * 2 <= WS_O && WS_O + (size_t)MT * 1024 * 2 <= WS_H && WS_H + (size_t)MT * 2816 * 2 <= WS_XB && WS_END <= 512 * MiB, "ws map");

constexpr int RING_BYTES = 135168;
constexpr int LDS_BYTES = 147456;

__device__ __forceinline__ unsigned pkbf(float lo, float hi) { return pg8::cvt_pk_bf16(lo, hi); }
__device__ __forceinline__ float bflo(unsigned w) { return __uint_as_float(w << 16); }
__device__ __forceinline__ float bfhi(unsigned w) { return __uint_as_float(w & 0xffff0000u); }
__device__ __forceinline__ float dpp_add(float v, const int ctrl_sel) {
    int m;
    if (ctrl_sel == 0) m = __builtin_amdgcn_update_dpp(0, __float_as_int(v), 0xB1, 0xF, 0xF, true);
    else if (ctrl_sel == 1) m = __builtin_amdgcn_update_dpp(0, __float_as_int(v), 0x4E, 0xF, 0xF, true);
    else if (ctrl_sel == 2) m = __builtin_amdgcn_update_dpp(0, __float_as_int(v), 0x124, 0xF, 0xF, true);
    else m = __builtin_amdgcn_update_dpp(0, __float_as_int(v), 0x128, 0xF, 0xF, true);
    return v + __int_as_float(m);
}
__device__ __forceinline__ float wave_sum(float v, int lane) {
    v = dpp_add(v, 0); v = dpp_add(v, 1); v = dpp_add(v, 2); v = dpp_add(v, 3);
    v += __int_as_float(__builtin_amdgcn_ds_bpermute((lane ^ 16) << 2, __float_as_int(v)));
    auto rr = __builtin_amdgcn_permlane32_swap(__float_as_uint(v), __float_as_uint(v), false, false);
    return __uint_as_float(rr[0]) + __uint_as_float(rr[1]);
}
__device__ __forceinline__ float xhalf_max(float v) { auto rr = __builtin_amdgcn_permlane32_swap(__float_as_uint(v), __float_as_uint(v), false, false); return fmaxf(__uint_as_float(rr[0]), __uint_as_float(rr[1])); }
__device__ __forceinline__ float xhalf_sum(float v) { auto rr = __builtin_amdgcn_permlane32_swap(__float_as_uint(v), __float_as_uint(v), false, false); return __uint_as_float(rr[0]) + __uint_as_float(rr[1]); }

namespace att {
constexpr int KP = 144, VP = 136;
constexpr int L_KS = 0, L_VT = 64 * KP, L_RPB = L_VT + 64 * VP, L_END = L_RPB + 2048;
__device__ __forceinline__ int crow(int r, int h) { return (r & 3) + 8 * (r >> 2) + 4 * h; }

struct TileRegs { u32x4 k, v; };
__device__ __forceinline__ void tile_gload(TileRegs& R, const bf16_t* H, int krow, int kcol, int vcol, int tid) {
    const int key = tid >> 3, ch = tid & 7;
    const bf16_t* p = H + (size_t)(krow + key) * INC;
    R.k = *(const u32x4*)(p + kcol + 8 * ch); R.v = *(const u32x4*)(p + vcol + 8 * ch);
}
__device__ __forceinline__ void tile_swrite(const TileRegs& R, LAS unsigned char* lds, int tid) {
    const int key = tid >> 3, ch = tid & 7;
    *(LAS u32x4*)(lds + L_KS + key * KP + ch * 16) = R.k;
    LAS unsigned short* vt = (LAS unsigned short*)(lds + L_VT);
#pragma unroll
    for (int j = 0; j < 4; ++j) { const unsigned w = R.v[j]; vt[(8 * ch + 2 * j) * (VP / 2) + key] = (unsigned short)(w & 0xffffu); vt[(8 * ch + 2 * j + 1) * (VP / 2) + key] = (unsigned short)(w >> 16); }
}
template <int KS0, int NKS>
__device__ __forceinline__ f32x16 qk_block(const LAS unsigned char* lds, int kb, int r32, int hh, const bf16x8 (&qf)[4]) {
    f32x16 s = {0.f, 0.f, 0.f, 0.f, 0.f, 0.f, 0.f, 0.f, 0.f, 0.f, 0.f, 0.f, 0.f, 0.f, 0.f, 0.f};
#pragma unroll
    for (int ks = KS0; ks < KS0 + NKS; ++ks) {
        const bf16x8 kf = *(const LAS bf16x8*)(lds + L_KS + (kb * 32 + r32) * KP + ks * 32 + hh * 16);
        s = __builtin_amdgcn_mfma_f32_32x32x16_bf16(kf, qf[ks], s, 0, 0, 0);
    }
    return s;
}
__device__ __forceinline__ void softmax_pv(f32x16 (&s)[2], float& m, float& l, f32x16 (&O)[2], const LAS unsigned char* lds, int r32, int hh) {
    float mx = s[0][0];
#pragma unroll
    for (int r = 1; r < 16; ++r) mx = fmaxf(mx, s[0][r]);
#pragma unroll
    for (int r = 0; r < 16; ++r) mx = fmaxf(mx, s[1][r]);
    mx = xhalf_max(mx);
    __builtin_amdgcn_sched_barrier(0);
    const float mn = fmaxf(m, mx);
    const float alpha = __builtin_amdgcn_exp2f(m - mn);
    m = mn; l *= alpha;
#pragma unroll
    for (int r = 0; r < 16; ++r) { O[0][r] *= alpha; O[1][r] *= alpha; }
    float ps = 0.f;
#pragma unroll
    for (int kb = 0; kb < 2; ++kb)
#pragma unroll
        for (int r = 0; r < 16; ++r) { const float p = __builtin_amdgcn_exp2f(s[kb][r] - mn); s[kb][r] = p; ps += p; }
    l += ps;
    __builtin_amdgcn_sched_barrier(0);
#pragma unroll
    for (int kb = 0; kb < 2; ++kb)
#pragma unroll
        for (int sk = 0; sk < 2; ++sk) {
            __builtin_amdgcn_sched_barrier(0);
            u32x4 pw; pw.x = pkbf(s[kb][8 * sk + 0], s[kb][8 * sk + 1]); pw.y = pkbf(s[kb][8 * sk + 2], s[kb][8 * sk + 3]);
            pw.z = pkbf(s[kb][8 * sk + 4], s[kb][8 * sk + 5]); pw.w = pkbf(s[kb][8 * sk + 6], s[kb][8 * sk + 7]);
            const bf16x8 pf = __builtin_bit_cast(bf16x8, pw);
#pragma unroll
            for (int dvb = 0; dvb < 2; ++dvb) {
                const LAS unsigned char* a = lds + L_VT + (dvb * 32 + r32) * VP + (kb * 32 + 16 * sk + 4 * hh) * 2;
                const s16x4 lo = *(const LAS s16x4*)a, hi = *(const LAS s16x4*)(a + 16);
                const bf16x8 vf = {lo[0], lo[1], lo[2], lo[3], hi[0], hi[1], hi[2], hi[3]};
                O[dvb] = __builtin_amdgcn_mfma_f32_32x32x16_bf16(vf, pf, O[dvb], 0, 0, 0);
            }
        }
}
__device__ __forceinline__ void store_o(const f32x16 (&o)[2], bf16_t* orow, int hh) {
#pragma unroll
    for (int dvb = 0; dvb < 2; ++dvb)
#pragma unroll
        for (int g = 0; g < 4; ++g) {
            u32x2 w; w.x = pkbf(o[dvb][4 * g], o[dvb][4 * g + 1]); w.y = pkbf(o[dvb][4 * g + 2], o[dvb][4 * g + 3]);
            *(u32x2*)(orow + dvb * 32 + 8 * g + 4 * hh) = w;
        }
}

__device__ __forceinline__ void unit_A_safe(const bool CTXQ, LAS unsigned char* lds, const bf16_t* H, bf16_t* Ob, int b, int h, int qb, float lam, float ofac, const float* subw) {
    const int tid = pg8_ltid(), lane = tid & 63, r32 = lane & 31, hh = lane >> 5, wid = tid >> 6;
    const int qrow = CTXQ ? (ML + b * CTXL + wid * 32 + r32) : (b * SEQ + qb * 256 + wid * 32 + r32);
    const int qcol = h * 64, kcol = 256 + h * 64, vcol = 512 + h * 64;
    bf16x8 qf[4];
#pragma unroll
    for (int ks = 0; ks < 4; ++ks) qf[ks] = *(const bf16x8*)(H + (size_t)qrow * INC + qcol + 16 * ks + 8 * hh);
    const int NT = CTXQ ? 4 : 132;
    f32x16 O1[2], O2[2];
#pragma unroll
    for (int r = 0; r < 16; ++r) { O1[0][r] = 0.f; O1[1][r] = 0.f; O2[0][r] = 0.f; O2[1][r] = 0.f; }
    float m1 = -INFINITY, m2 = -INFINITY, l1 = 0.f, l2 = 0.f;
    TileRegs R;
    tile_gload(R, H, CTXQ ? (ML + b * CTXL) : (b * SEQ), kcol, vcol, tid);
    for (int t = 0; t < NT; ++t) {
        __syncthreads();
        tile_swrite(R, lds, tid);
        __syncthreads();
        if (t + 1 < NT) { const int tn = t + 1; const int krow = CTXQ ? (ML + b * CTXL + 64 * tn) : (tn < 128 ? b * SEQ + 64 * tn : ML + b * CTXL + 64 * (tn - 128)); tile_gload(R, H, krow, kcol, vcol, tid); }
        { f32x16 s[2]; s[0] = qk_block<0, 2>(lds, 0, r32, hh, qf); s[1] = qk_block<0, 2>(lds, 1, r32, hh, qf); softmax_pv(s, m1, l1, O1, lds, r32, hh); }
        __builtin_amdgcn_sched_barrier(0);
        { f32x16 s[2]; s[0] = qk_block<2, 2>(lds, 0, r32, hh, qf); s[1] = qk_block<2, 2>(lds, 1, r32, hh, qf); softmax_pv(s, m2, l2, O2, lds, r32, hh); }
        __builtin_amdgcn_sched_barrier(0);
    }
    l1 = xhalf_sum(l1); l2 = xhalf_sum(l2);
    const float i1 = 1.f / l1, i2 = lam / l2;
    float ss = 0.f;
#pragma unroll
    for (int dvb = 0; dvb < 2; ++dvb)
#pragma unroll
        for (int r = 0; r < 16; ++r) { const float o = O1[dvb][r] * i1 - O2[dvb][r] * i2; O1[dvb][r] = o; ss += o * o; }
    ss = xhalf_sum(ss);
    float li_ = ofac; asm volatile("" : "+s"(li_));
    const float rn = rsqrtf(ss * (1.f / 64.f) + 1e-6f) * (1.f - li_);
#pragma unroll
    for (int dvb = 0; dvb < 2; ++dvb)
#pragma unroll
        for (int g = 0; g < 4; ++g) {
            const f32x4 w = *(const f32x4*)(subw + dvb * 32 + 8 * g + 4 * hh);
#pragma unroll
            for (int e = 0; e < 4; ++e) O1[dvb][4 * g + e] *= rn * w[e];
        }
    store_o(O1, Ob + (size_t)qrow * DM + h * 64, hh);
}


constexpr int A_KP = 144, A_VP = 192, A_VOFF = 64 * A_KP, A_BUF = A_VOFF + 64 * A_VP;
constexpr float ATHR = 10.f;
typedef short v4i16_t __attribute__((ext_vector_type(4)));
__device__ __forceinline__ s16x4 vtr(const LAS unsigned char* p) { return __builtin_bit_cast(s16x4, __builtin_amdgcn_ds_read_tr16_b64_v4i16((LAS v4i16_t*)p)); }
__device__ __forceinline__ void tileA_swrite(const TileRegs& R, LAS unsigned char* buf, int tid) {
    const int key = tid >> 3, ch = tid & 7;
    *(LAS u32x4*)(buf + key * A_KP + ch * 16) = R.k;
    *(LAS u32x4*)(buf + A_VOFF + key * A_VP + ch * 16) = R.v;
}
__device__ __forceinline__ float max16(const f32x16& s) {
    float a = fmaxf(fmaxf(s[0], s[1]), s[2]), b = fmaxf(fmaxf(s[3], s[4]), s[5]), c = fmaxf(fmaxf(s[6], s[7]), s[8]), d = fmaxf(fmaxf(s[9], s[10]), s[11]);
    a = fmaxf(fmaxf(a, s[12]), s[13]); b = fmaxf(fmaxf(b, s[14]), s[15]);
    return fmaxf(fmaxf(a, b), fmaxf(c, d));
}
__device__ __forceinline__ float expsum16(f32x16& s) {
    float a = 0.f, b = 0.f, c = 0.f, d = 0.f;
#pragma unroll
    for (int r = 0; r < 16; r += 4) {
        s[r] = __builtin_amdgcn_exp2f(s[r]); s[r + 1] = __builtin_amdgcn_exp2f(s[r + 1]); s[r + 2] = __builtin_amdgcn_exp2f(s[r + 2]); s[r + 3] = __builtin_amdgcn_exp2f(s[r + 3]);
        a += s[r]; b += s[r + 1]; c += s[r + 2]; d += s[r + 3];
    }
    return (a + b) + (c + d);
}
__device__ __forceinline__ bf16x8 packp(const f32x16& s, int sk) {
    u32x4 pw; pw.x = pkbf(s[8 * sk + 0], s[8 * sk + 1]); pw.y = pkbf(s[8 * sk + 2], s[8 * sk + 3]); pw.z = pkbf(s[8 * sk + 4], s[8 * sk + 5]); pw.w = pkbf(s[8 * sk + 6], s[8 * sk + 7]);
    return __builtin_bit_cast(bf16x8, pw);
}
__device__ __forceinline__ void exp16(f32x16& s) {
#pragma unroll
    for (int r = 0; r < 16; ++r) s[r] = __builtin_amdgcn_exp2f(s[r]);
}
constexpr float AREF = 20.f, AGUARD = 60.f;
#ifndef SGB_V
#define SGB_V 5
#endif
template <bool HAVE>
__device__ __forceinline__ void stepA(bf16x8 (&pc)[2][2], const LAS unsigned char* kbuf, int kb, const LAS unsigned char* vb, const bf16x8 (&qv)[4], int r32, int hh,
                                      float mref1, float mref2, f32x16 (&O1)[2], f32x16 (&O2)[2], f32x16& L1, f32x16& L2, const bf16x8& ones) {
    const LAS unsigned char* kp = kbuf + (kb * 32 + r32) * A_KP + hh * 16;
    const bf16x8 k0 = *(const LAS bf16x8*)(kp), k1 = *(const LAS bf16x8*)(kp + 32), k2 = *(const LAS bf16x8*)(kp + 64), k3 = *(const LAS bf16x8*)(kp + 96);
    const bf16x8 q0 = qv[0], q1 = qv[1], q2 = qv[2], q3 = qv[3];
    bf16x8 vf[2][2];
#pragma unroll
    for (int sk = 0; sk < 2; ++sk)
#pragma unroll
        for (int dvb = 0; dvb < 2; ++dvb) {
            const LAS unsigned char* a = vb + 16 * sk * A_VP + dvb * 64;
            const s16x4 lo = vtr(a), hi = vtr(a + 8 * A_VP);
            vf[sk][dvb] = (bf16x8){lo[0], lo[1], lo[2], lo[3], hi[0], hi[1], hi[2], hi[3]};
        }
    const f32x16 z = {0.f, 0.f, 0.f, 0.f, 0.f, 0.f, 0.f, 0.f, 0.f, 0.f, 0.f, 0.f, 0.f, 0.f, 0.f, 0.f};
    f32x16 s1 = __builtin_amdgcn_mfma_f32_32x32x16_bf16(k0, q0, z, 0, 0, 0);
    f32x16 s2 = __builtin_amdgcn_mfma_f32_32x32x16_bf16(k2, q2, z, 0, 0, 0);
    s1 = __builtin_amdgcn_mfma_f32_32x32x16_bf16(k1, q1, s1, 0, 0, 0);
    s2 = __builtin_amdgcn_mfma_f32_32x32x16_bf16(k3, q3, s2, 0, 0, 0);
#pragma unroll
    for (int sk = 0; sk < 2; ++sk) {
        L1 = __builtin_amdgcn_mfma_f32_32x32x16_bf16(ones, pc[0][sk], L1, 0, 0, 0);
        L2 = __builtin_amdgcn_mfma_f32_32x32x16_bf16(ones, pc[1][sk], L2, 0, 0, 0);
#pragma unroll
        for (int dvb = 0; dvb < 2; ++dvb) {
            O1[dvb] = __builtin_amdgcn_mfma_f32_32x32x16_bf16(vf[sk][dvb], pc[0][sk], O1[dvb], 0, 0, 0);
            O2[dvb] = __builtin_amdgcn_mfma_f32_32x32x16_bf16(vf[sk][dvb], pc[1][sk], O2[dvb], 0, 0, 0);
        }
    }
    if (HAVE) {
#pragma unroll
        for (int r = 0; r < 16; ++r) { s1[r] -= mref1; s2[r] -= mref2; }
    }
    exp16(s1); exp16(s2);
    bf16x8 pn[2][2];
    pn[0][0] = packp(s1, 0); pn[0][1] = packp(s1, 1); pn[1][0] = packp(s2, 0); pn[1][1] = packp(s2, 1);
#if 0
    __builtin_amdgcn_sched_group_barrier(0x008, 6, 0);
#pragma unroll
    for (int i = 0; i < 10; ++i) { __builtin_amdgcn_sched_group_barrier(0x002, SGB_V, 0); __builtin_amdgcn_sched_group_barrier(0x008, 1, 0); }
    __builtin_amdgcn_sched_group_barrier(0x002, 48, 0);
#endif
    pc[0][0] = pn[0][0]; pc[0][1] = pn[0][1]; pc[1][0] = pn[1][0]; pc[1][1] = pn[1][1];
}
__device__ __forceinline__ void unit_A(const bool CTXQ, LAS unsigned char* lds, const bf16_t* H, bf16_t* Ob, int b, int h, int qb, float lam, float ofac, const float* subw) {
    const int tid = pg8_ltid(), lane = tid & 63, r32 = lane & 31, hh = lane >> 5, wid = tid >> 6;
    const int qrow = CTXQ ? (ML + b * CTXL + wid * 32 + r32) : (b * SEQ + qb * 256 + wid * 32 + r32);
    const int qcol = h * 64, kcol = 256 + h * 64, vcol = 512 + h * 64;
    const int NT = CTXQ ? 4 : 132;
    f32x16 O1[2], O2[2], L1, L2;
#pragma unroll
    for (int r = 0; r < 16; ++r) { O1[0][r] = 0.f; O1[1][r] = 0.f; O2[0][r] = 0.f; O2[1][r] = 0.f; L1[r] = 0.f; L2[r] = 0.f; }
    const bf16x8 ones = {0x3F80, 0x3F80, 0x3F80, 0x3F80, 0x3F80, 0x3F80, 0x3F80, 0x3F80};
    const int voff = A_VOFF + (4 * hh + ((lane & 15) >> 2)) * A_VP + (((lane >> 4) & 1) * 16 + (lane & 3) * 4) * 2;
    const int krow0 = CTXQ ? (ML + b * CTXL) : (b * SEQ);
    LAS unsigned char* qs = lds + 3 * A_BUF + (wid * 32 + r32) * A_KP + hh * 16;
    volatile LAS unsigned* flag = (volatile LAS unsigned*)(lds + RING_BYTES + 128);
    TileRegs R;
    __syncthreads();
    if (tid == 0) *flag = 0u;
#pragma unroll
    for (int ks = 0; ks < 4; ++ks) *(LAS bf16x8*)(qs + ks * 32) = *(const bf16x8*)(H + (size_t)qrow * INC + qcol + 16 * ks + 8 * hh);
    tile_gload(R, H, krow0, kcol, vcol, tid);       tileA_swrite(R, lds, tid);
    tile_gload(R, H, krow0 + 64, kcol, vcol, tid);  tileA_swrite(R, lds + A_BUF, tid);
    tile_gload(R, H, krow0 + 128, kcol, vcol, tid);
    __syncthreads();
    bf16x8 pc[2][2];
    {
        const LAS unsigned char* kp = lds + r32 * A_KP + hh * 16;
        const f32x16 z = {0.f, 0.f, 0.f, 0.f, 0.f, 0.f, 0.f, 0.f, 0.f, 0.f, 0.f, 0.f, 0.f, 0.f, 0.f, 0.f};
        f32x16 sa1 = __builtin_amdgcn_mfma_f32_32x32x16_bf16(*(const LAS bf16x8*)(kp), *(const LAS bf16x8*)(qs), z, 0, 0, 0);
        sa1 = __builtin_amdgcn_mfma_f32_32x32x16_bf16(*(const LAS bf16x8*)(kp + 32), *(const LAS bf16x8*)(qs + 32), sa1, 0, 0, 0);
        f32x16 sa2 = __builtin_amdgcn_mfma_f32_32x32x16_bf16(*(const LAS bf16x8*)(kp + 64), *(const LAS bf16x8*)(qs + 64), z, 0, 0, 0);
        sa2 = __builtin_amdgcn_mfma_f32_32x32x16_bf16(*(const LAS bf16x8*)(kp + 96), *(const LAS bf16x8*)(qs + 96), sa2, 0, 0, 0);
        exp16(sa1); exp16(sa2);
        pc[0][0] = packp(sa1, 0); pc[0][1] = packp(sa1, 1); pc[1][0] = packp(sa2, 0); pc[1][1] = packp(sa2, 1);
    }
    bf16x8 qv[4];
#pragma unroll
    for (int ks = 0; ks < 4; ++ks) qv[ks] = *(const LAS bf16x8*)(qs + ks * 32);
    int bc = 0, t = 0;
#define UNITA_STAGE() \
        const int bn = (bc == 2 * A_BUF) ? 0 : bc + A_BUF, bw = (bn == 2 * A_BUF) ? 0 : bn + A_BUF; \
        if (t + 2 < NT) { \
            tileA_swrite(R, lds + bw, tid); \
            if (t + 3 < NT) { const int tn = t + 3; const int krow = CTXQ ? (krow0 + 64 * tn) : (tn < 128 ? b * SEQ + 64 * tn : ML + b * CTXL + 64 * (tn - 128)); tile_gload(R, H, krow, kcol, vcol, tid); } \
        }
#define UNITA_GUARD() (__any((L1[0] > 1.152921504606846976e18f) || (L2[0] > 1.152921504606846976e18f)) != 0)
    {
        for (; t < NT; ++t) {
            UNITA_STAGE()
            stepA<false>(pc, lds + bc, 1, lds + bc + voff, qv, r32, hh, 0.f, 0.f, O1, O2, L1, L2, ones);
            stepA<false>(pc, lds + bn, 0, lds + bc + voff + 32 * A_VP, qv, r32, hh, 0.f, 0.f, O1, O2, L1, L2, ones);
            __syncthreads();
            bc = bn;
        }
    }
#undef UNITA_STAGE
#undef UNITA_GUARD
    if (__any(!((L1[0] > 1e-30f) && (L1[0] < 1e30f) && (L2[0] > 1e-30f) && (L2[0] < 1e30f))) != 0) *flag = 1u;
    __syncthreads();
    if (*flag != 0u) { unit_A_safe(CTXQ, lds, H, Ob, b, h, qb, lam, ofac, subw); return; }
    const float i1 = 1.f / L1[0], i2 = lam / L2[0];
    float ss = 0.f;
#pragma unroll
    for (int dvb = 0; dvb < 2; ++dvb)
#pragma unroll
        for (int r = 0; r < 16; ++r) { const float o = O1[dvb][r] * i1 - O2[dvb][r] * i2; O1[dvb][r] = o; ss += o * o; }
    ss = xhalf_sum(ss);
    float li_ = ofac; asm volatile("" : "+s"(li_));
    const float rn = rsqrtf(ss * (1.f / 64.f) + 1e-6f) * (1.f - li_);
#pragma unroll
    for (int dvb = 0; dvb < 2; ++dvb)
#pragma unroll
        for (int g = 0; g < 4; ++g) {
            const f32x4 w = *(const f32x4*)(subw + dvb * 32 + 8 * g + 4 * hh);
#pragma unroll
            for (int e = 0; e < 4; ++e) O1[dvb][4 * g + e] *= rn * w[e];
        }
    store_o(O1, Ob + (size_t)qrow * DM + h * 64, hh);
}

template <int MODE> __device__ __forceinline__ int tile_row_f(int t, int b, int lo, int nloc) {
    if (MODE == 1) return (t < nloc) ? (b * SEQ + 64 * (lo + t)) : (ML + b * CTXL + 64 * (t - nloc));
    if (MODE == 2) return (t < 4) ? (ML + b * CTXL + 64 * t) : (b * SEQ + 64 * (lo + t - 4));
    return ML + b * CTXL + 64 * t;
}
__device__ __forceinline__ int tile_row_r(int MODE, int t, int b, int lo, int nloc) {
    if (MODE == 1) return (t < nloc) ? (b * SEQ + 64 * (lo + t)) : (ML + b * CTXL + 64 * (t - nloc));
    if (MODE == 2) return (t < 4) ? (ML + b * CTXL + 64 * t) : (b * SEQ + 64 * (lo + t - 4));
    return ML + b * CTXL + 64 * t;
}
__device__ __forceinline__ void unit_BC(const int MODE, LAS unsigned char* lds, const bf16_t* H, bf16_t* Ob, int b, int hd, int blk, const float* sink_l, const float* rpb_l) {
    const int tid = pg8_ltid(), lane = tid & 63, r32 = lane & 31, hh = lane >> 5, wid = tid >> 6;
    int qrow, qcol, kcol, vcol, ocol, qpos = 0, r_w = 0, qc = 0, lo = 0, nloc = 0;
    float m = -INFINITY, l = 0.f;
    if (MODE == 1) {
        const int g = wid >> 2, head = hd * 2 + g; qpos = 128 * blk + 32 * (wid & 3) + r32; qrow = b * SEQ + qpos;
        qcol = 768 + head * 64; kcol = 1024 + hd * 64; vcol = 1152 + hd * 64; ocol = 256 + head * 64;
        lo = 2 * blk - 2; if (lo < 0) lo = 0; int hi = 2 * blk + 3; if (hi > 127) hi = 127; nloc = hi - lo + 1;
        m = sink_l[head] * LOG2E; l = (hh == 0) ? 1.f : 0.f;
    } else if (MODE == 3) {
        const int head = hd * 2 + blk; qrow = ML + b * CTXL + wid * 32 + r32;
        qcol = 768 + head * 64; kcol = 1024 + hd * 64; vcol = 1152 + hd * 64; ocol = 256 + head * 64;
        m = sink_l[head] * LOG2E; l = (hh == 0) ? 1.f : 0.f;
    } else if (MODE == 2) {
        r_w = 4 * blk + (wid >> 1); qc = 32 * (wid & 1) + r32; qrow = b * SEQ + r_w * 64 + qc;
        qcol = 1280 + hd * 64; kcol = 1536 + hd * 64; vcol = 1792 + hd * 64; ocol = 512 + hd * 64;
        int a0 = 4 * blk - 4; if (a0 < 0) a0 = 0; if (a0 > 120) a0 = 120; int a3 = 4 * blk + 3 - 4; if (a3 < 0) a3 = 0; if (a3 > 120) a3 = 120;
        lo = a0; nloc = a3 + 7 - a0 + 1;
    } else {
        qrow = ML + b * CTXL + wid * 32 + r32;
        qcol = 1280 + hd * 64; kcol = 1536 + hd * 64; vcol = 1792 + hd * 64; ocol = 512 + hd * 64;
    }
    bf16x8 qf[4];
#pragma unroll
    for (int ks = 0; ks < 4; ++ks) qf[ks] = *(const bf16x8*)(H + (size_t)qrow * INC + qcol + 16 * ks + 8 * hh);
    f32x16 O[2];
#pragma unroll
    for (int r = 0; r < 16; ++r) { O[0][r] = 0.f; O[1][r] = 0.f; }
    const int NT = 4 + nloc;
    int rs = 0;
    if (MODE == 2) { rs = r_w - 4; if (rs < 0) rs = 0; if (rs > 120) rs = 120; }
    const LAS float* rpbs = (const LAS float*)(lds + L_RPB);
    TileRegs R;
    tile_gload(R, H, tile_row_r(MODE, 0, b, lo, nloc), kcol, vcol, tid);
    for (int t = 0; t < NT; ++t) {
        __syncthreads();
        tile_swrite(R, lds, tid);
        if (MODE == 2 && t == 0) { for (int i = tid; i < 465; i += 512) ((LAS float*)(lds + L_RPB))[i] = rpb_l[hd * 465 + i] * LOG2E; }
        __syncthreads();
        if (t + 1 < NT) tile_gload(R, H, tile_row_r(MODE, t + 1, b, lo, nloc), kcol, vcol, tid);
        bool active = true; int kr = 0;
        if (MODE == 2 && t >= 4) { kr = lo + t - 4; active = (kr >= rs) && (kr < rs + 8); }
        if (active) {
            f32x16 s[2]; s[0] = qk_block<0, 4>(lds, 0, r32, hh, qf); s[1] = qk_block<0, 4>(lds, 1, r32, hh, qf);
            if (MODE == 1 && t < nloc) {
                const int kbase = 64 * (lo + t) - qpos;
#pragma unroll
                for (int kb = 0; kb < 2; ++kb)
#pragma unroll
                    for (int r = 0; r < 16; ++r) { const int d = kbase + kb * 32 + crow(r, hh); if (d > 128 || d < -128) s[kb][r] = -INFINITY; }
            }
            if (MODE == 2 && t >= 4) {
                int cs = qc - 8; if (cs < 0) cs = 0; if (cs > 48) cs = 48;
                const int bbase = (kr - r_w + 7) * 31 + 15 - qc;
#pragma unroll
                for (int kb = 0; kb < 2; ++kb)
#pragma unroll
                    for (int r = 0; r < 16; ++r) {
                        const int kc = kb * 32 + crow(r, hh);
                        const bool ok = (kc >= cs) && (kc < cs + 16);
                        int bi = bbase + kc; bi = ok ? bi : 0;
                        const float bias = rpbs[bi];
                        s[kb][r] = ok ? (s[kb][r] + bias) : -INFINITY;
                    }
            }
            softmax_pv(s, m, l, O, lds, r32, hh);
        }
    }
    l = xhalf_sum(l);
    const float il = 1.f / l;
#pragma unroll
    for (int r = 0; r < 16; ++r) { O[0][r] *= il; O[1][r] *= il; }
    store_o(O, Ob + (size_t)qrow * DM + ocol, hh);
}

template <int MODE>
__device__ __forceinline__ void bcf_compute(const LAS unsigned char* cur, int t, int nloc, int lo, int qpos, int kr, int r_w, int qc, const bf16x8 (&qf)[4], f32x16 (&O)[2], f32x16& L,
                                            const bf16x8& ones, const LAS float* rpbs, int voff, int r32, int hh) {
    f32x16 s[2];
    const f32x16 z = {0.f, 0.f, 0.f, 0.f, 0.f, 0.f, 0.f, 0.f, 0.f, 0.f, 0.f, 0.f, 0.f, 0.f, 0.f, 0.f};
#pragma unroll
    for (int kb = 0; kb < 2; ++kb) {
        const LAS unsigned char* kp = cur + (kb * 32 + r32) * A_KP + hh * 16;
        s[kb] = __builtin_amdgcn_mfma_f32_32x32x16_bf16(*(const LAS bf16x8*)(kp), qf[0], z, 0, 0, 0);
        s[kb] = __builtin_amdgcn_mfma_f32_32x32x16_bf16(*(const LAS bf16x8*)(kp + 32), qf[1], s[kb], 0, 0, 0);
        s[kb] = __builtin_amdgcn_mfma_f32_32x32x16_bf16(*(const LAS bf16x8*)(kp + 64), qf[2], s[kb], 0, 0, 0);
        s[kb] = __builtin_amdgcn_mfma_f32_32x32x16_bf16(*(const LAS bf16x8*)(kp + 96), qf[3], s[kb], 0, 0, 0);
    }
    if (MODE == 1 && t < nloc) {
        const int kbase = 64 * (lo + t) - qpos;
#pragma unroll
        for (int kb = 0; kb < 2; ++kb)
#pragma unroll
            for (int r = 0; r < 16; ++r) { const int d = kbase + kb * 32 + crow(r, hh); if (d > 128 || d < -128) s[kb][r] = -INFINITY; }
    }
    if (MODE == 2 && t >= 4) {
        int cs = qc - 8; if (cs < 0) cs = 0; if (cs > 48) cs = 48;
        const int bbase = (kr - r_w + 7) * 31 + 15 - qc;
#pragma unroll
        for (int kb = 0; kb < 2; ++kb)
#pragma unroll
            for (int r = 0; r < 16; ++r) {
                const int kc = kb * 32 + crow(r, hh);
                const bool ok = (kc >= cs) && (kc < cs + 16);
                int bi = bbase + kc; bi = ok ? bi : 0;
                const float bias = rpbs[bi];
                s[kb][r] = ok ? (s[kb][r] + bias) : -INFINITY;
            }
    }
#pragma unroll
    for (int kb = 0; kb < 2; ++kb) {
        exp16(s[kb]);
#pragma unroll
        for (int sk = 0; sk < 2; ++sk) {
            const bf16x8 p = packp(s[kb], sk);
            L = __builtin_amdgcn_mfma_f32_32x32x16_bf16(ones, p, L, 0, 0, 0);
#pragma unroll
            for (int dvb = 0; dvb < 2; ++dvb) {
                const LAS unsigned char* a = cur + voff + (kb * 32 + 16 * sk) * A_VP + dvb * 64;
                const s16x4 vlo = vtr(a), vhi = vtr(a + 8 * A_VP);
                const bf16x8 vf = {vlo[0], vlo[1], vlo[2], vlo[3], vhi[0], vhi[1], vhi[2], vhi[3]};
                O[dvb] = __builtin_amdgcn_mfma_f32_32x32x16_bf16(vf, p, O[dvb], 0, 0, 0);
            }
        }
    }
}
template <int MODE>
__device__ __forceinline__ bool unit_BC_fast(LAS unsigned char* lds, const bf16_t* H, bf16_t* Ob, int b, int hd, int blk, const float* sink_l, const float* rpb_l) {
    const int tid = pg8_ltid(), lane = tid & 63, r32 = lane & 31, hh = lane >> 5, wid = tid >> 6;
    int qrow, qcol, kcol, vcol, ocol, qpos = 0, r_w = 0, qc = 0, lo = 0, nloc = 0;
    float linit = 0.f;
    if (MODE == 1) {
        const int g = wid >> 2, head = hd * 2 + g; qpos = 128 * blk + 32 * (wid & 3) + r32; qrow = b * SEQ + qpos;
        qcol = 768 + head * 64; kcol = 1024 + hd * 64; vcol = 1152 + hd * 64; ocol = 256 + head * 64;
        lo = 2 * blk - 2; if (lo < 0) lo = 0; int hi = 2 * blk + 3; if (hi > 127) hi = 127; nloc = hi - lo + 1;
        linit = __builtin_amdgcn_exp2f(sink_l[head] * LOG2E);
    } else if (MODE == 3) {
        const int head = hd * 2 + blk; qrow = ML + b * CTXL + wid * 32 + r32;
        qcol = 768 + head * 64; kcol = 1024 + hd * 64; vcol = 1152 + hd * 64; ocol = 256 + head * 64;
        linit = __builtin_amdgcn_exp2f(sink_l[head] * LOG2E);
    } else if (MODE == 2) {
        r_w = 4 * blk + (wid >> 1); qc = 32 * (wid & 1) + r32; qrow = b * SEQ + r_w * 64 + qc;
        qcol = 1280 + hd * 64; kcol = 1536 + hd * 64; vcol = 1792 + hd * 64; ocol = 512 + hd * 64;
        int a0 = 4 * blk - 4; if (a0 < 0) a0 = 0; if (a0 > 120) a0 = 120; int a3 = 4 * blk + 3 - 4; if (a3 < 0) a3 = 0; if (a3 > 120) a3 = 120;
        lo = a0; nloc = a3 + 7 - a0 + 1;
    } else {
        qrow = ML + b * CTXL + wid * 32 + r32;
        qcol = 1280 + hd * 64; kcol = 1536 + hd * 64; vcol = 1792 + hd * 64; ocol = 512 + hd * 64;
    }
    bf16x8 qf[4];
#pragma unroll
    for (int ks = 0; ks < 4; ++ks) qf[ks] = *(const bf16x8*)(H + (size_t)qrow * INC + qcol + 16 * ks + 8 * hh);
    f32x16 O[2], L;
#pragma unroll
    for (int r = 0; r < 16; ++r) { O[0][r] = 0.f; O[1][r] = 0.f; L[r] = linit; }
    const bf16x8 ones = {0x3F80, 0x3F80, 0x3F80, 0x3F80, 0x3F80, 0x3F80, 0x3F80, 0x3F80};
    const int NT = 4 + nloc;
    int rs = 0;
    if (MODE == 2) { rs = r_w - 4; if (rs < 0) rs = 0; if (rs > 120) rs = 120; }
    const int voff = A_VOFF + (4 * hh + ((lane & 15) >> 2)) * A_VP + (((lane >> 4) & 1) * 16 + (lane & 3) * 4) * 2;
    LAS float* rpbs = (LAS float*)(lds + 2 * A_BUF);
    volatile LAS unsigned* flag = (volatile LAS unsigned*)(lds + RING_BYTES + 128);
    TileRegs Ra, Rb;
    __syncthreads();
    if (tid == 0) *flag = 0u;
    if (MODE == 2) { for (int i = tid; i < 465; i += 512) rpbs[i] = rpb_l[hd * 465 + i] * LOG2E; }
    tile_gload(Ra, H, tile_row_f<MODE>(0, b, lo, nloc), kcol, vcol, tid);
    tileA_swrite(Ra, lds, tid);
    tile_gload(Rb, H, tile_row_f<MODE>(1, b, lo, nloc), kcol, vcol, tid);
    tile_gload(Ra, H, tile_row_f<MODE>(2, b, lo, nloc), kcol, vcol, tid);
    __syncthreads();
#define BCF_TILE(T, RS) { \
        const int t = (T); \
        const LAS unsigned char* cur = lds + (t & 1) * A_BUF; \
        if (t + 1 < NT) { \
            tileA_swrite(RS, lds + ((t + 1) & 1) * A_BUF, tid); \
            if (t + 3 < NT) tile_gload(RS, H, tile_row_f<MODE>(t + 3, b, lo, nloc), kcol, vcol, tid); \
        } \
        bool active = true; int kr = 0; \
        if (MODE == 2 && t >= 4) { kr = lo + t - 4; active = (kr >= rs) && (kr < rs + 8); } \
        if (active) bcf_compute<MODE>(cur, t, nloc, lo, qpos, kr, r_w, qc, qf, O, L, ones, rpbs, voff, r32, hh); \
        __syncthreads(); }
    for (int t2 = 0; t2 < NT; t2 += 2) {
        BCF_TILE(t2, Rb)
        if (t2 + 1 < NT) BCF_TILE(t2 + 1, Ra)
    }
#undef BCF_TILE
    const float lsum = L[0];
    if (__any(!((lsum > 1e-30f) && (lsum < 1e30f))) != 0) *flag = 1u;
    __syncthreads();
    if (*flag != 0u) return true;
    const float il = 1.f / lsum;
#pragma unroll
    for (int r = 0; r < 16; ++r) { O[0][r] *= il; O[1][r] *= il; }
    store_o(O, Ob + (size_t)qrow * DM + ocol, hh);
    return false;
}
}
__device__ __forceinline__ float silu_f(float v) { return v / (1.f + __expf(-v)); }

__device__ __forceinline__ int wrow_map(int type, int n) {
    if (type == 1) {
        const bool ropeA = n < 512, ropeB = (n >= 768 && n < 1152);
        if (!ropeA && !ropeB) return n;
        int p = n & 31;
        if (ropeA) { const int blk = p >> 3; p = (blk == 1) ? p + 8 : ((blk == 2) ? p - 8 : p); }
        const int nn = p >> 4, r = p & 15;
        return (n & ~31) + 8 * (r >> 2) + 4 * nn + (r & 3);
    }
    if (type == 2) { const int half = (n >= 2816) ? 1 : 0; const int j = n - half * 2816; return (j >> 7) * 256 + half * 128 + (j & 127); }
    return n;
}
__device__ __forceinline__ void transpose_item(const float* W, int K, int N, bf16_t* WT, int type, LAS float* scr, int item, int lane) {
    const int nblk = N / 64, kb = item / nblk, nb = item - kb * nblk, k0 = 64 * kb, n0 = 64 * nb;
    const int lr = lane >> 4, lc = (lane & 15) * 4;
#pragma unroll 8
    for (int i = 0; i < 16; ++i) {
        const int kk = 4 * i + lr;
        const f32x4 v = *(const f32x4*)(W + (size_t)(k0 + kk) * N + n0 + lc);
        LAS float* d = scr + kk * 65 + lc; d[0] = v[0]; d[1] = v[1]; d[2] = v[2]; d[3] = v[3];
    }
    asm volatile("s_waitcnt lgkmcnt(0)" ::: "memory");
    const int c = lane & 7;
#pragma unroll
    for (int j = 0; j < 8; ++j) {
        const int n = (lane >> 3) + 8 * j; const LAS float* s = scr + (8 * c) * 65 + n;
        u32x4 o; o.x = pkbf(s[0 * 65], s[1 * 65]); o.y = pkbf(s[2 * 65], s[3 * 65]); o.z = pkbf(s[4 * 65], s[5 * 65]); o.w = pkbf(s[6 * 65], s[7 * 65]);
        *(u32x4*)(WT + (size_t)wrow_map(type, n0 + n) * K + k0 + 8 * c) = o;
    }
    asm volatile("s_waitcnt lgkmcnt(0)" ::: "memory");
}

__device__ __forceinline__ void sincos_f(float x, float& c, float& s) {
    const float k = rintf(x * 0.636619772f);
    float r = fmaf(-k, 1.57079625129699707031f, x); r = fmaf(-k, 7.54978941586159635335e-08f, r);
    const float r2 = r * r;
    const float sr = r * (1.f + r2 * (-1.f / 6 + r2 * (1.f / 120 + r2 * (-1.f / 5040 + r2 * (1.f / 362880)))));
    const float cr = 1.f + r2 * (-0.5f + r2 * (1.f / 24 + r2 * (-1.f / 720 + r2 * (1.f / 40320 + r2 * (-1.f / 3628800)))));
    const int q = ((int)k) & 3;
    s = (q == 0) ? sr : (q == 1) ? cr : (q == 2) ? -sr : -cr;
    c = (q == 0) ? cr : (q == 1) ? -sr : (q == 2) ? -cr : sr;
}

__device__ __forceinline__ void norm_mod_row(const float* src, const float* nw, const float* sh, const float* sc, bf16_t* dst, int lane, const float* slab = nullptr, int nslab = 0, float* xout = nullptr, bool src16 = false) {
    u32x2* o8 = (u32x2*)dst + lane;
    if (src == nullptr) {
#pragma unroll
        for (int j = 0; j < 4; ++j) o8[64 * j] = (u32x2){0u, 0u};
        return;
    }
    const f32x4* xr = (const f32x4*)src + lane;
    f32x4 v[4]; float s = 0.f;
    if (src16) {
        const u32x2* xh = (const u32x2*)src + lane;
#pragma unroll
        for (int j = 0; j < 4; ++j) { const u32x2 w = xh[64 * j]; v[j] = (f32x4){bflo(w.x), bfhi(w.x), bflo(w.y), bfhi(w.y)}; }
    } else {
#pragma unroll
        for (int j = 0; j < 4; ++j) v[j] = xr[64 * j];
    }
    for (int p = 0; p < nslab; ++p) {
        const f32x4* sr = (const f32x4*)(slab + (size_t)p * 1024 * 1024) + lane;
#pragma unroll
        for (int j = 0; j < 4; ++j) v[j] += sr[64 * j];
    }
    if (xout != nullptr) {
#pragma unroll
        for (int j = 0; j < 4; ++j) ((f32x4*)xout + lane)[64 * j] = v[j];
    }
#pragma unroll
    for (int j = 0; j < 4; ++j) s += (v[j][0] * v[j][0] + v[j][1] * v[j][1]) + (v[j][2] * v[j][2] + v[j][3] * v[j][3]);
    const float rstd = rsqrtf(wave_sum(s, lane) * (1.f / 1024.f) + 1e-6f);
#pragma unroll
    for (int j = 0; j < 4; ++j) {
        const int k = 4 * (64 * j + lane);
        const f32x4 w = *(const f32x4*)(nw + k), a = *(const f32x4*)(sc + k), d = *(const f32x4*)(sh + k);
        f32x4 y;
#pragma unroll
        for (int e = 0; e < 4; ++e) y[e] = (v[j][e] * rstd * w[e]) * (1.f + a[e]) + d[e];
        u32x2 p; p.x = pkbf(y[0], y[1]); p.y = pkbf(y[2], y[3]);
        o8[64 * j] = p;
    }
}

#define XB_TMO      128
#define XB_XCNT(j)  (256  + 64 * (j))
#define XB_XSUB(j)  (1280 + 64 * (j))
#define XB_XGEN(j)  (2304 + 64 * (j))
#define XB_TOP      3328
#define XB_TOPGEN   3392
#define XCD_BAR_WORDS 3456
#define XB_SPIN_CAP (1u << 18)

__device__ __forceinline__ unsigned xb_ld(unsigned* p)              { return __hip_atomic_load(p, __ATOMIC_RELAXED, __HIP_MEMORY_SCOPE_AGENT); }
__device__ __forceinline__ unsigned xb_add(unsigned* p, unsigned v) { return __hip_atomic_fetch_add(p, v, __ATOMIC_RELAXED, __HIP_MEMORY_SCOPE_AGENT); }
__device__ __forceinline__ unsigned xb_xcc_id() { return (unsigned)__builtin_amdgcn_s_getreg((3 << 11) | 20) & 0xFu; }
#define XB_SPIN(cond, bar) do { unsigned _sp = 0; while (cond) { __builtin_amdgcn_s_sleep(1); \
    if ((++_sp & 255u) == 0u) { if (xb_ld(&(bar)[XB_TMO])) break; if (_sp > XB_SPIN_CAP) { atomicAdd(&(bar)[XB_TMO], 1u); break; } } } } while (0)

struct XcdBarrier {
    unsigned* bar; unsigned x;
    volatile LAS unsigned* st;
};

__device__ __forceinline__ XcdBarrier xcd_barrier_post(unsigned* bar, volatile LAS unsigned* st) {
    XcdBarrier b; b.bar = bar; b.x = xb_xcc_id(); b.st = st;
    if (threadIdx.x == 0) (void)xb_add(&bar[XB_XCNT(b.x)], 1u);
    return b;
}
__device__ __forceinline__ void xcd_barrier_complete(unsigned* bar, unsigned x, unsigned& nloc, unsigned& nx) {
    const unsigned G = gridDim.x * gridDim.y * gridDim.z;
    unsigned sum, cnt, mine, sp = 0u;
    for (;;) {
        sum = 0u; cnt = 0u; mine = 0u;
#pragma unroll
        for (unsigned j = 0; j < 16; ++j) { const unsigned c = xb_ld(&bar[XB_XCNT(j)]); sum += c; cnt += (c > 0u) ? 1u : 0u; mine = (j == x) ? c : mine; }
        if (sum == G) break;
        __builtin_amdgcn_s_sleep(1);
        if ((++sp & 255u) == 0u) { if (xb_ld(&bar[XB_TMO])) break; if (sp > XB_SPIN_CAP) { atomicAdd(&bar[XB_TMO], 1u); break; } }
    }
    nloc = mine > 0u ? mine : 1u; nx = cnt > 0u ? cnt : 1u;
}

__device__ __forceinline__ void xcd_barrier(const XcdBarrier& b) {
    asm volatile("s_waitcnt vmcnt(0)" ::: "memory");
    __syncthreads();
    if (threadIdx.x == 0) {
        unsigned* bar = b.bar;
        __builtin_amdgcn_s_waitcnt(0);
        unsigned nloc = b.st[0], nx = b.st[1];
        if (nloc == 0u) { xcd_barrier_complete(bar, b.x, nloc, nx); b.st[0] = nloc; b.st[1] = nx; }
        const unsigned old = xb_add(&bar[XB_XSUB(b.x)], 1u);
        const unsigned gen = old / nloc;
        if (old + 1u == (gen + 1u) * nloc) {
            __builtin_amdgcn_fence(__ATOMIC_RELEASE, "agent");
            asm volatile("s_waitcnt vmcnt(0)" ::: "memory");
            const unsigned og = xb_add(&bar[XB_TOP], 1u);
            const unsigned tg = og / nx;
            if (og + 1u == (tg + 1u) * nx) xb_add(&bar[XB_TOPGEN], 1u);
            else XB_SPIN(xb_ld(&bar[XB_TOPGEN]) == tg, bar);
            __builtin_amdgcn_fence(__ATOMIC_ACQUIRE, "agent");
            xb_add(&bar[XB_XGEN(b.x)], 1u);
            asm volatile("s_waitcnt vmcnt(0)" ::: "memory");
        } else {
            XB_SPIN(xb_ld(&bar[XB_XGEN(b.x)]) == gen, bar);
            __builtin_amdgcn_fence(__ATOMIC_ACQUIRE, "agent");
            asm volatile("s_waitcnt vmcnt(0)" ::: "memory");
        }
    }
    __syncthreads();
}

struct Args { const float* in[23]; float* out; unsigned char* ws; int ph_lo, ph_hi, coop, pad; };
typedef const __attribute__((address_space(4))) Args* KArgs;
__device__ __forceinline__ KArgs kargs() { KArgs p = (KArgs)__builtin_amdgcn_kernarg_segment_ptr(); asm volatile("" : "+s"(p)); return p; }
constexpr int N_PHASES = 2 + 7 * DEPTH + 1;

__global__ void __launch_bounds__(512, 2) fwd_kernel(Args a) {
    extern __shared__ __attribute__((aligned(16))) unsigned char lds_raw[];
    LAS unsigned char* lds = (LAS unsigned char*)lds_raw;
    volatile LAS unsigned* bar_st = (volatile LAS unsigned*)(lds + RING_BYTES + 64);
    if (threadIdx.x < 2) bar_st[threadIdx.x] = 0u;
    __syncthreads();
    if (kargs()->coop) (void)xcd_barrier_post((unsigned*)kargs()->ws, bar_st);
    const int ph_lo = kargs()->ph_lo, ph_hi = kargs()->ph_hi;
    for (int ph = ph_lo; ph < ph_hi; ++ph) {
        KArgs ka = kargs();
        const int tid = pg8_ltid(), lane = tid & 63, wave = __builtin_amdgcn_readfirstlane(tid >> 6);
        int G = gridDim.x, bx = blockIdx.x; asm volatile("" : "+s"(G), "+s"(bx));
        const int vcu = (G % 8 == 0) ? (bx % 8) * (G / 8) + bx / 8 : bx;
        const int gw = vcu * 8 + wave, NGW = G * 8;
        unsigned char* ws = ka->ws;
        float* MOD = (float*)(ws + WS_MOD); float* MODP = (float*)(ws + WS_MODP);
        float* tabA = (float*)(ws + WS_TAB); float* tabB = tabA + 128 * 8 * 2;
        float* XCA = (float*)(ws + WS_XC); float* XCB = (float*)(ws + WS_MODP);
        bf16_t* XN = (bf16_t*)(ws + WS_XN); bf16_t* Ob = (bf16_t*)(ws + WS_O); bf16_t* Hb = (bf16_t*)(ws + WS_H); bf16_t* ACT = Hb;
        float* XL = ka->out; bf16_t* XB = (bf16_t*)(ws + WS_XB);
        if (ph == 0) {
          {
            const float* w_mod = ka->in[6]; const float* c_in = ka->in[1]; const float* cctx_in = ka->in[3];
            for (int it = gw; it < 1536; it += NGW) {
                const int ks = it & 15, cgp = (it >> 4) % 24, l = it / 384;
                const int n0 = cgp * 256 + lane * 4;
                f32x4 acc[5];
#pragma unroll
                for (int s = 0; s < 5; ++s) acc[s] = (f32x4){0.f, 0.f, 0.f, 0.f};
                const float* wp = w_mod + ((size_t)l * 1024 + ks * 64) * 6144 + n0;
                float sv[5];
                { const int kl = ks * 64 + lane;
#pragma unroll
                  for (int s = 0; s < 4; ++s) sv[s] = silu_f(c_in[s * 1024 + kl]);
                  sv[4] = silu_f(cctx_in[kl]); }
#pragma unroll 8
                for (int kk = 0; kk < 64; ++kk) {
                    const f32x4 w = *(const f32x4*)(wp + (size_t)kk * 6144);
#pragma unroll
                    for (int s = 0; s < 5; ++s) acc[s] += __uint_as_float(__builtin_amdgcn_readlane(__float_as_uint(sv[s]), kk)) * w;
                }
#pragma unroll
                for (int s = 0; s < 5; ++s) *(f32x4*)(MODP + ((size_t)(ks * 4 + l) * 5 + s) * 6144 + n0) = acc[s];
            }
            LAS float* scr = (LAS float*)(lds + wave * 16768);
            for (int it = gw; it < 4 * 3072; it += NGW) {
                const int l = it / 3072; int r = it - l * 3072;
                unsigned char* wl = ws + WS_W + (size_t)l * W_LAYER;
                if (r < 704) { transpose_item(ka->in[8] + (size_t)l * 1024 * 2816, 1024, 2816, (bf16_t*)wl, 1, scr, r, lane); continue; } r -= 704;
                if (r < 256) { transpose_item(ka->in[9] + (size_t)l * 1024 * 1024, 1024, 1024, (bf16_t*)(wl + W_OUT_OFF), 0, scr, r, lane); continue; } r -= 256;
                if (r < 1408) { transpose_item(ka->in[18] + (size_t)l * 1024 * 5632, 1024, 5632, (bf16_t*)(wl + W_UP_OFF), 2, scr, r, lane); continue; } r -= 1408;
                transpose_item(ka->in[21] + (size_t)l * 2816 * 1024, 2816, 1024, (bf16_t*)(wl + W_DN_OFF), 0, scr, r, lane);
            }
            for (int idx = vcu * 512 + tid; idx < 3072; idx += G * 512) {
                int pos, i; float e;
                if (idx < 1024) { pos = idx >> 3; i = idx & 7; e = (float)i * 0.125f; } else { const int j = idx - 1024; pos = j >> 4; i = j & 15; e = (float)i * 0.0625f; }
                const float freq = exp2f(-e * 13.287712379549449f);
                const float ang = (float)pos * freq;
                float cc, ss; sincos_f(ang, cc, ss);
                float* tp = (idx < 1024) ? (tabA + idx * 2) : (tabB + (idx - 1024) * 2);
                tp[0] = cc; tp[1] = ss;
            }
          }
        } else if (ph == 1) {
            const float* b_mod = ka->in[7];
            for (int idx = vcu * 512 + tid; idx < 4 * 5 * 6144; idx += G * 512) {
                const int l = idx / 30720, n = idx % 6144;
                float s = b_mod[l * 6144 + n];
#pragma unroll
                for (int ks = 0; ks < 16; ++ks) s += MODP[(size_t)ks * 122880 + idx];
                MOD[idx] = s;
            }
        } else if (ph == N_PHASES - 1) {
            const float* fw = ka->in[22];
            for (int m = gw; m < ML; m += NGW) {
                const u32x2* xh = (const u32x2*)(XB + (size_t)m * DM) + lane; f32x4* xr = (f32x4*)(XL + (size_t)m * DM) + lane;
                f32x4 v[4]; float s = 0.f;
#pragma unroll
                for (int j = 0; j < 4; ++j) { const u32x2 w = xh[64 * j]; v[j] = (f32x4){bflo(w.x), bfhi(w.x), bflo(w.y), bfhi(w.y)}; s += (v[j][0] * v[j][0] + v[j][1] * v[j][1]) + (v[j][2] * v[j][2] + v[j][3] * v[j][3]); }
                const float rstd = rsqrtf(wave_sum(s, lane) * (1.f / 1024.f) + 1e-6f);
#pragma unroll
                for (int j = 0; j < 4; ++j) { const f32x4 w = *(const f32x4*)(fw + 4 * (64 * j + lane)); xr[64 * j] = v[j] * rstd * w; }
            }
        } else {
            const int l = (ph - 2) / 7, k = (ph - 2) % 7;
            const bool need_ctx = l < DEPTH - 1;
            const float* modl = MOD + (size_t)l * 5 * 6144;
            unsigned char* wl = ws + WS_W + (size_t)l * W_LAYER;
            if (k == 0) {
                const float* nw = ka->in[4] + l * 1024;
                for (int m = gw; m < MT; m += NGW) {
                    const bool lat = m < ML; const int slot = lat ? (m >> 13) : 4;
                    if (lat) { if (l == 0) norm_mod_row(ka->in[0] + (size_t)m * DM, nw, modl + slot * 6144, modl + slot * 6144 + 1024, XN + (size_t)m * DM, lane);
                               else norm_mod_row((const float*)(XB + (size_t)m * DM), nw, modl + slot * 6144, modl + slot * 6144 + 1024, XN + (size_t)m * DM, lane, nullptr, 0, nullptr, true); }
                    else {
                        const size_t ro = (size_t)(m - ML) * DM;
                        norm_mod_row((l == 0 ? ka->in[2] : (const float*)XCB) + ro, nw, modl + slot * 6144, modl + slot * 6144 + 1024, XN + (size_t)m * DM, lane,
                                     (const float*)Ob + ro, (l == 0) ? 0 : 11, XCA + ro);
                    }
                }
            } else if (k == 1) {
                pg8::Gemm g{XN, (const bf16_t*)wl, MT, INC, DM, DM}; pg8::StaticOrder S; S.init(MT, INC, G, bx);
                pg8::EpiInProj E{Hb, tabA, tabB};
#ifndef DIS_IN
                pg8::gemm_phase<pg8::EpiInProj, pg8::StaticOrder, true, true>(lds, g, S, E);
#endif
            } else if (k == 2) {
                float lam, ofac;
                {
                    float d1 = 0.f, d2 = 0.f;
                    for (int i = 0; i < 32; ++i) { d1 += ka->in[10][l * 32 + i] * ka->in[11][l * 32 + i]; d2 += ka->in[12][l * 32 + i] * ka->in[13][l * 32 + i]; }
                    const float li = 0.8f - 0.6f * expf(-0.3f * (float)l);
                    lam = expf(d1) - expf(d2) + li;
                    lam = __uint_as_float(__builtin_amdgcn_readfirstlane(__float_as_uint(lam))); ofac = __uint_as_float(__builtin_amdgcn_readfirstlane(__float_as_uint(li)));
                }
                const float* subw = ka->in[14] + l * 64; const float* sink_l = ka->in[15] + l * 4; const float* rpb_l = ka->in[16] + (size_t)l * 4 * 465;
#ifndef DIS_A
                for (int u = vcu; u < 512 + (need_ctx ? 16 : 0); u += G) {
                    const bool cq = u >= 512; const int bh = cq ? (u - 512) : (u >> 5);
                    att::unit_A(cq, lds, Hb, Ob, bh >> 2, bh & 3, u & 31, lam, ofac, subw);
                }
#endif
#ifndef DIS_B
                for (int u = vcu; u < 1024 + (need_ctx ? 32 : 0); u += G) {
                    int mode, ub, uh, ublk; bool redo = true;
                    if (u < 512) { mode = 1; ub = u >> 7; uh = (u >> 6) & 1; ublk = u & 63; redo = att::unit_BC_fast<1>(lds, Hb, Ob, ub, uh, ublk, sink_l, rpb_l); }
                    else if (u < 1024) { const int v = u - 512; mode = 2; ub = v >> 7; uh = (v >> 5) & 3; ublk = v & 31; redo = att::unit_BC_fast<2>(lds, Hb, Ob, ub, uh, ublk, sink_l, rpb_l); }
                    else { const int v = u - 1024, bh = v & 15; if (v < 16) { mode = 3; ub = bh >> 2; uh = (bh >> 1) & 1; ublk = bh & 1; } else { mode = 4; ub = bh >> 2; uh = bh & 3; ublk = 0; } }
                    if (redo) att::unit_BC(mode, lds, Hb, Ob, ub, uh, ublk, sink_l, rpb_l);
                }
#endif
                {
                    const float* cwl = ka->in[17] + (size_t)l * 3 * 256;
                    const int rows = need_ctx ? MT : ML;
                    const int c0 = (tid & 31) * 8;
                    float w0[8], w1[8], w2[8];
#pragma unroll
                    for (int e = 0; e < 8; ++e) { w0[e] = cwl[c0 + e]; w1[e] = cwl[256 + c0 + e]; w2[e] = cwl[512 + c0 + e]; }
                    for (int idx = vcu * 512 + tid; idx < rows * 32; idx += G * 512) {
                        const int row = idx >> 5;
                        int t, len; if (row < ML) { t = row & 8191; len = SEQ; } else { t = (row - ML) & 255; len = CTXL; }
                        const bf16_t* hp = Hb + (size_t)row * INC + 2048 + c0;
                        const u32x4 bg = *(const u32x4*)hp, cg1 = *(const u32x4*)(hp + 256), xi1 = *(const u32x4*)(hp + 512);
                        u32x4 cg0 = {0u, 0u, 0u, 0u}, xi0 = cg0, cg2 = cg0, xi2 = cg0;
                        if (t > 0) { cg0 = *(const u32x4*)(hp - INC + 256); xi0 = *(const u32x4*)(hp - INC + 512); }
                        if (t < len - 1) { cg2 = *(const u32x4*)(hp + INC + 256); xi2 = *(const u32x4*)(hp + INC + 512); }
                        u32x4 ow;
#pragma unroll
                        for (int e = 0; e < 4; ++e) {
                            const float ylo = w0[2 * e] * bflo(cg0[e]) * bflo(xi0[e]) + w1[2 * e] * bflo(cg1[e]) * bflo(xi1[e]) + w2[2 * e] * bflo(cg2[e]) * bflo(xi2[e]);
                            const float yhi = w0[2 * e + 1] * bfhi(cg0[e]) * bfhi(xi0[e]) + w1[2 * e + 1] * bfhi(cg1[e]) * bfhi(xi1[e]) + w2[2 * e + 1] * bfhi(cg2[e]) * bfhi(xi2[e]);
                            ow[e] = pkbf(bflo(bg[e]) * ylo, bfhi(bg[e]) * yhi);
                        }
                        *(u32x4*)(Ob + (size_t)row * DM + 768 + c0) = ow;
                    }
                }
                __syncthreads();
            } else if (k == 4) {
                const float* nw = ka->in[5] + l * 1024;
                const int nrows = (need_ctx ? NMX_ALL : NMX_L) * 256;
                for (int e = gw; e < nrows; e += NGW) {
                    const int pm = e >> 8, j = e & 255;
                    int t, slot; const float* base; int len;
                    if (pm < NMX_L) { const int s = pm / 33, ti = pm - s * 33; t = 254 * ti - 1 + j; len = SEQ; slot = s; base = nullptr; }
                    else { const int p = 254 * (pm - NMX_L) - 1 + j; const int sq = (p < 0) ? 0 : p / 257, r = p - sq * 257; t = (p >= 0 && p < 1029 && r != 0) ? (r - 1) : -1; len = CTXL; slot = 4; base = XCA + (size_t)sq * CTXL * DM; }
                    const bool ok = (t >= 0 && t < len);
                    const float* src = ok ? ((pm < NMX_L) ? (const float*)(XB + ((size_t)slot * SEQ + t) * DM) : (base + (size_t)t * DM)) : nullptr;
                    if (pm < NMX_L || !ok) norm_mod_row(src, nw, modl + slot * 6144 + 3072, modl + slot * 6144 + 4096, XN + (size_t)e * DM, lane, nullptr, 0, nullptr, pm < NMX_L);
                    else {
                        const size_t ro = (size_t)(src - XCA);
                        norm_mod_row(src, nw, modl + slot * 6144 + 3072, modl + slot * 6144 + 4096, XN + (size_t)e * DM, lane, (const float*)Hb + ro, 4, XCB + ro);
                    }
                }
            } else if (k == 5) {
                const int nM = need_ctx ? NMX_ALL : NMX_L;
                pg8::Gemm g{XN, (const bf16_t*)(wl + W_UP_OFF), nM * 256, UPC, DM, DM}; pg8::StaticOrder S; S.init(nM * 256, UPC, G, bx);
                pg8::EpiUpConv E{ACT, ka->in[19] + (size_t)l * 3 * UPC, ka->in[20] + (size_t)l * UPC};
                pg8::OneUnit one;
#ifndef DIS_UP
                for (int i = 0; S.next(i, one.u); ++i) pg8::gemm_phase<pg8::EpiUpConv, pg8::OneUnit, false, true>(lds, g, one, E);
#endif
            } else {
                const bool isout = (k == 3); const int KK = isout ? DM : DFF;
                const bf16_t* Ap = isout ? (const bf16_t*)Ob : (const bf16_t*)ACT; const bf16_t* Bp = (const bf16_t*)(wl + (isout ? W_OUT_OFF : W_DN_OFF));
                {
                    pg8::Gemm g{Ap, Bp, ML, DM, KK, KK}; pg8::StaticOrder S; S.init(ML, DM, G, bx);
                    pg8::EpiRes E{(isout && l == 0) ? ka->in[0] : (const float*)nullptr, XB, XB, modl, isout ? 2048 : 5120};
#ifndef DIS_OUT
                    pg8::gemm_phase<pg8::EpiRes, pg8::StaticOrder, true, true>(lds, g, S, E);
#endif
                }
                if (need_ctx) {
                    const int P = isout ? 4 : 11, klen = KK / P;
                    for (int su = bx; su < 16 * P; su += G) {
                        const int tile = su / P, part = su - tile * P;
                        pg8::Gemm gs{Ap + (size_t)ML * KK + part * klen, Bp + part * klen, MC, DM, klen, KK};
                        pg8::OneUnit one; one.u.pm = tile >> 2; one.u.pn = tile & 3;
                        pg8::EpiSlab EA{(isout ? (float*)Hb : (float*)Ob) + (size_t)part * 1024 * 1024, modl + 4 * 6144 + (isout ? 2048 : 5120)};
                        pg8::gemm_phase<pg8::EpiSlab, pg8::OneUnit, false, true>(lds, gs, one, EA);
                    }
                }
            }
        }
        if (ph + 1 < ph_hi && kargs()->coop) {
            if (kargs()->coop == 2) cg::this_grid().sync();
            else { XcdBarrier b; b.bar = (unsigned*)kargs()->ws; b.x = xb_xcc_id(); b.st = bar_st; xcd_barrier(b); }
        }
    }
}

extern "C" void kernel_launch(void* const* d_in, const int* in_sizes, int n_in, void* d_out, int out_size, void* d_ws, size_t ws_size, hipStream_t stream) {
    static int grid = 0;
    if (grid == 0) {
        if (n_in != 23 || out_size != ML * DM || ws_size < WS_END) { fprintf(stderr, "kernel_launch: unexpected shapes (n_in %d out %d ws %zu need %zu)\n", n_in, out_size, ws_size, (size_t)WS_END); grid = -1; return; }
        int dev = 0, cus = 0, per_cu = 0;
        if (hipGetDevice(&dev) != hipSuccess || hipDeviceGetAttribute(&cus, hipDeviceAttributeMultiprocessorCount, dev) != hipSuccess) { grid = -1; return; }
        if (hipFuncSetAttribute((const void*)fwd_kernel, hipFuncAttributeMaxDynamicSharedMemorySize, LDS_BYTES) != hipSuccess) { fprintf(stderr, "kernel_launch: hipFuncSetAttribute failed\n"); grid = -1; return; }
        if (hipOccupancyMaxActiveBlocksPerMultiprocessor(&per_cu, (const void*)fwd_kernel, 512, LDS_BYTES) != hipSuccess || per_cu < 1) fprintf(stderr, "kernel_launch: occupancy query says %d\n", per_cu);
        (void)hipGetLastError();
        grid = cus;
    }
    if (grid < 0) return;
    Args a{};
    for (int i = 0; i < 23; ++i) a.in[i] = (const float*)d_in[i];
    a.out = (float*)d_out; a.ws = (unsigned char*)d_ws;
#if MK_MULTI
    for (int ph = 0; ph < N_PHASES; ++ph) {
        a.ph_lo = ph; a.ph_hi = ph + 1; a.coop = 0;
        hipLaunchKernelGGL(fwd_kernel, dim3(grid), dim3(512), LDS_BYTES, stream, a);
    }
#else
    a.ph_lo = 0; a.ph_hi = N_PHASES; a.coop = 1;
    if (hipMemsetAsync(d_ws, 0, 16384, stream) != hipSuccess) { fprintf(stderr, "kernel_launch: memset failed\n"); return; }
    void* args[] = {&a};
    hipError_t e = hipLaunchCooperativeKernel((const void*)fwd_kernel, dim3(grid), dim3(512), args, LDS_BYTES, stream);
    if (e != hipSuccess) fprintf(stderr, "cooperative launch failed: %s (grid %d)\n", hipGetErrorString(e), grid);
#endif
}
```

```cpp
#include <hip/hip_runtime.h>
#include <hip/hip_cooperative_groups.h>
#include <cstdio>
#include <cstdint>
namespace cg = cooperative_groups;

#ifndef MK_MULTI
#define MK_MULTI 0
#endif

#ifndef REP_IN
#define REP_IN 1
#endif
#ifndef REP_UP
#define REP_UP 1
#endif
#ifndef REP_A
#define REP_A 1
#endif
#ifndef REP_OD
#define REP_OD 1
#endif
#ifndef REP_P
#define REP_P 1
#endif
#ifndef REP_BC
#define REP_BC 1
#endif
#ifndef REP_M
#define REP_M 1
#endif

__device__ __forceinline__ int pg8_ltid() { int t = threadIdx.x; asm volatile("" : "+v"(t)); return t; }
namespace pg8 {
#define PG8_LAS __attribute__((address_space(3)))
typedef unsigned short bf16_t;
typedef short bf16x8 __attribute__((ext_vector_type(8)));
typedef float f32x4 __attribute__((ext_vector_type(4)));
typedef unsigned u32x4 __attribute__((ext_vector_type(4)));
constexpr int BM = 256, BK = 64, HALF = 128, HTB = HALF * BK * 2  , STAGE_BYTES = 8 * HTB, NXCD = 8, WGM = 8;

__host__ __device__ __forceinline__ int lds_byte(int r, int c) { const int st = (r >> 4) * 2 + (c >> 5), rr = r & 15, cc = c & 31, ob = rr * 64 + cc * 2; return st * 1024 + (ob ^ (((ob >> 9) & 1) << 5)); }
__host__ __device__ __forceinline__ void stage_rc(int b, int& R, int& C) { const int st = b / 1024, sb = b % 1024, swz = sb ^ (((sb >> 9) & 1) << 5); R = (st >> 1) * 16 + swz / 64; C = (st & 1) * 32 + (swz % 64) / 2; }
__host__ __device__ __forceinline__ int perm32(int rho) { const int n = rho >> 4, i = rho & 15; return 8 * (i >> 2) + 4 * n + (i & 3); }

struct Unit { int pm, pn; };
struct Gemm { const bf16_t* A; const bf16_t* Bt; int M, N, K, ldk; };

struct StaticOrder {
    int nM, nN, nwg, G, c;
    __host__ __device__ void init(int M, int N, int G_, int c_) { nM = M / BM; nN = N / BM; nwg = nM * nN; G = G_; c = c_; }
    __host__ __device__ bool next(int i, Unit& u) const {
        const long L = (long)i * G + c; if (L >= nwg) return false;
        int wgid = (int)L; { const int q = nwg / NXCD, r = nwg % NXCD, xcd = wgid % NXCD, off = wgid / NXCD; wgid = (xcd < r ? xcd * (q + 1) : r * (q + 1) + (xcd - r) * q) + off; }
        const int nig = WGM * nN, gid = wgid / nig, fm = gid * WGM, gsz = (nM - fm) < WGM ? (nM - fm) : WGM;
        u.pm = fm + ((wgid % nig) % gsz); u.pn = (wgid % nig) / gsz; return true;
    }
    __device__ __forceinline__ void a_ready(const Unit&) const {}
    __device__ __forceinline__ void done(const Unit&) const {}
};

typedef float pg8_f32x2 __attribute__((ext_vector_type(2))); typedef __bf16 pg8_bf16x2 __attribute__((ext_vector_type(2)));
__device__ __forceinline__ unsigned cvt_pk_bf16(float lo, float hi) { pg8_f32x2 v = {lo, hi}; pg8_bf16x2 b = __builtin_convertvector(v, pg8_bf16x2); return __builtin_bit_cast(unsigned, b); }
typedef unsigned u32x2 __attribute__((ext_vector_type(2)));

struct OneUnit {
    Unit u;
    __device__ __forceinline__ bool next(int i, Unit& o) const { if (i != 0) return false; o = u; return true; }
    __device__ __forceinline__ void a_ready(const Unit&) const {}
    __device__ __forceinline__ void done(const Unit&) const {}
};

struct EpiInProj {
    static constexpr bool PERM = true, AFTER_DRAIN = false;
    bf16_t* H; const float* tabA; const float* tabB;
    __device__ __forceinline__ void operator()(const f32x4 (&acc)[2][2][4][2], const Unit& u, int wr, int wc, int fr, int fq) const {
        const int pn = u.pn; const bool latent = u.pm < 128;
        const float scale = (pn == 0) ? 0.17677669529663687f * 1.4426950408889634f : ((pn == 3 || pn == 5) ? 0.125f * 1.4426950408889634f : 1.0f);
#pragma unroll
        for (int bj = 0; bj < 2; ++bj) {
            int mode = (pn == 0 || pn == 1) ? 1 : ((pn == 3 || (pn == 4 && bj == 0)) ? 2 : 0);
            if (!latent) mode = 0;
#ifdef TEST_NOROPE
            mode = 0;
#endif
#pragma unroll
            for (int ai = 0; ai < 2; ++ai)
#pragma unroll
                for (int m = 0; m < 4; ++m) {
                    const int r = u.pm * BM + ai * HALF + wr * 64 + m * 16 + fr;
                    f32x4 v0 = acc[ai][bj][m][0], v1 = acc[ai][bj][m][1];
                    if (mode != 0) {
                        const int t = r & 8191, trow = t >> 6, tcol = t & 63;
                        const float* tp;
                        if (mode == 1) { const int pos = (fq < 2) ? trow : tcol; tp = tabA + (pos * 8 + 4 * (fq & 1)) * 2; }
                        else { const int pos = (wc & 1) ? tcol : trow; tp = tabB + (pos * 16 + 4 * fq) * 2; }
                        const f32x4 cs0 = *(const f32x4*)tp, cs1 = *(const f32x4*)(tp + 4);
                        const float c0 = cs0[0], s0 = cs0[1], c1 = cs0[2], s1 = cs0[3], c2 = cs1[0], s2 = cs1[1], c3 = cs1[2], s3 = cs1[3];
                        f32x4 a = v0, b = v1;
                        v0[0] = a[0] * c0 - b[0] * s0; v1[0] = b[0] * c0 + a[0] * s0;
                        v0[1] = a[1] * c1 - b[1] * s1; v1[1] = b[1] * c1 + a[1] * s1;
                        v0[2] = a[2] * c2 - b[2] * s2; v1[2] = b[2] * c2 + a[2] * s2;
                        v0[3] = a[3] * c3 - b[3] * s3; v1[3] = b[3] * c3 + a[3] * s3;
                    }
                    v0 = v0 * scale; v1 = v1 * scale;
                    bf16_t* rowp = H + (size_t)r * 2816 + pn * BM + bj * HALF + wc * 32 + 8 * fq;
                    u32x4 w; w.x = cvt_pk_bf16(v0[0], v0[1]); w.y = cvt_pk_bf16(v0[2], v0[3]); w.z = cvt_pk_bf16(v1[0], v1[1]); w.w = cvt_pk_bf16(v1[2], v1[3]);
                    *(u32x4*)rowp = w;
                }
        }
    }
};

struct EpiRes {
    static constexpr bool PERM = true, AFTER_DRAIN = false;
    const float* base32; const bf16_t* base16; bf16_t* out16; const float* modl; int goff;
    __device__ __forceinline__ void operator()(const f32x4 (&acc)[2][2][4][2], const Unit& u, int wr, int wc, int fr, int fq) const {
        const int slot = u.pm >> 5;
        const int row0 = u.pm * BM + wr * 64 + fr;
        const int col0 = u.pn * BM + wc * 32 + 8 * fq;
        f32x4 gv[2][2];
#pragma unroll
        for (int bj = 0; bj < 2; ++bj)
#pragma unroll
            for (int n = 0; n < 2; ++n) gv[bj][n] = *(const f32x4*)(modl + slot * 6144 + goff + col0 + bj * HALF + n * 4);
        const bool f32in = (base32 != nullptr);
#pragma unroll
        for (int ai = 0; ai < 2; ++ai)
#pragma unroll
            for (int m = 0; m < 4; ++m) {
                const size_t off = (size_t)(row0 + ai * HALF + m * 16) * 1024 + col0;
#pragma unroll
                for (int bj = 0; bj < 2; ++bj) {
                    f32x4 b0, b1;
                    if (f32in) { b0 = *(const f32x4*)(base32 + off + bj * HALF); b1 = *(const f32x4*)(base32 + off + bj * HALF + 4); }
                    else { const u32x4 w = *(const u32x4*)(base16 + off + bj * HALF);
                           b0 = (f32x4){__uint_as_float(w.x << 16), __uint_as_float(w.x & 0xffff0000u), __uint_as_float(w.y << 16), __uint_as_float(w.y & 0xffff0000u)};
                           b1 = (f32x4){__uint_as_float(w.z << 16), __uint_as_float(w.z & 0xffff0000u), __uint_as_float(w.w << 16), __uint_as_float(w.w & 0xffff0000u)}; }
                    const f32x4 o0 = b0 + gv[bj][0] * acc[ai][bj][m][0], o1 = b1 + gv[bj][1] * acc[ai][bj][m][1];
                    u32x4 ow; ow.x = cvt_pk_bf16(o0[0], o0[1]); ow.y = cvt_pk_bf16(o0[2], o0[3]); ow.z = cvt_pk_bf16(o1[0], o1[1]); ow.w = cvt_pk_bf16(o1[2], o1[3]);
                    *(u32x4*)(out16 + off + bj * HALF) = ow;
                }
                asm volatile("" ::: "memory");
            }
    }
};

struct EpiSlab {
    static constexpr bool PERM = false, AFTER_DRAIN = false;
    float* slab; const float* gate;
    __device__ __forceinline__ void operator()(const f32x4 (&acc)[2][2][4][2], const Unit& u, int wr, int wc, int fr, int fq) const {
        const int row0 = u.pm * BM + wr * 64 + fr, col0 = u.pn * BM + wc * 32 + 4 * fq;
#pragma unroll
        for (int bj = 0; bj < 2; ++bj)
#pragma unroll
            for (int n = 0; n < 2; ++n) {
                const f32x4 gv = *(const f32x4*)(gate + col0 + bj * HALF + n * 16);
#pragma unroll
                for (int ai = 0; ai < 2; ++ai)
#pragma unroll
                    for (int m = 0; m < 4; ++m)
                        *(f32x4*)(slab + (size_t)(row0 + ai * HALF + m * 16) * 1024 + col0 + bj * HALF + n * 16) = gv * acc[ai][bj][m][n];
            }
    }
};

struct EpiUpConv {
    static constexpr bool PERM = false, AFTER_DRAIN = true;
    bf16_t* ACT; const float* cw; const float* cb;
    static constexpr int TP = 520;
    __device__ __forceinline__ void fused(f32x4 (&acc)[2][2][4][2], const Unit& u, int wr, int wc, int fr, int fq, PG8_LAS unsigned char* lds, int wid, int lane) const {
#pragma unroll
        for (int ai = 0; ai < 2; ++ai)
#pragma unroll
            for (int m = 0; m < 4; ++m) {
                const int row = ai * HALF + wr * 64 + m * 16 + fr;
#pragma unroll
                for (int bj = 0; bj < 2; ++bj)
#pragma unroll
                    for (int n = 0; n < 2; ++n) {
                        const f32x4 v = acc[ai][bj][m][n]; u32x2 w; w.x = cvt_pk_bf16(v[0], v[1]); w.y = cvt_pk_bf16(v[2], v[3]);
                        *(PG8_LAS u32x2*)(lds + row * TP + (bj * HALF + wc * 32 + n * 16 + 4 * fq) * 2) = w;
                    }
            }
        const int tid = wid * 64 + lane, ch = tid & 15;
        const int gcol = u.pn * 128 + ch * 8;
        float wg[3][8], wv[3][8], bg[8], bv[8];
#pragma unroll
        for (int k = 0; k < 3; ++k) {
            const f32x4 a0 = *(const f32x4*)(cw + k * 5632 + gcol), a1 = *(const f32x4*)(cw + k * 5632 + gcol + 4);
            const f32x4 b0 = *(const f32x4*)(cw + k * 5632 + 2816 + gcol), b1 = *(const f32x4*)(cw + k * 5632 + 2816 + gcol + 4);
#pragma unroll
            for (int e = 0; e < 4; ++e) { wg[k][e] = a0[e]; wg[k][4 + e] = a1[e]; wv[k][e] = b0[e]; wv[k][4 + e] = b1[e]; }
        }
        {
            const f32x4 a0 = *(const f32x4*)(cb + gcol), a1 = *(const f32x4*)(cb + gcol + 4), b0 = *(const f32x4*)(cb + 2816 + gcol), b1 = *(const f32x4*)(cb + 2816 + gcol + 4);
#pragma unroll
            for (int e = 0; e < 4; ++e) { bg[e] = a0[e]; bg[4 + e] = a1[e]; bv[e] = b0[e]; bv[4 + e] = b1[e]; }
        }
        const bool lat = u.pm < 132; int rowbase, ti;
        if (lat) { const int s = u.pm / 33; ti = u.pm - s * 33; rowbase = s * 8192; } else { ti = u.pm - 132; rowbase = 32768; }
        asm volatile("s_waitcnt lgkmcnt(0)" ::: "memory"); __builtin_amdgcn_s_barrier(); asm volatile("" ::: "memory");
        for (int it = tid; it < 254 * 16; it += 512) {
            const int j = 1 + (it >> 4); const int p = 254 * ti - 1 + j;
            int orow; bool ok;
            if (lat) { ok = p < 8192; orow = rowbase + p; } else { const int sq = p / 257, r = p - sq * 257; ok = (p < 1029) && (r != 0); orow = rowbase + sq * 256 + r - 1; }
            if (ok) {
                float g[8], v[8];
#pragma unroll
                for (int e = 0; e < 8; ++e) { g[e] = bg[e]; v[e] = bv[e]; }
#pragma unroll
                for (int k = 0; k < 3; ++k) {
                    const PG8_LAS unsigned char* rp = lds + (j - 1 + k) * TP + ch * 16;
                    const u32x2 g0 = *(const PG8_LAS u32x2*)rp, g1 = *(const PG8_LAS u32x2*)(rp + 8);
                    const u32x2 v0 = *(const PG8_LAS u32x2*)(rp + 256), v1 = *(const PG8_LAS u32x2*)(rp + 264);
                    const unsigned gw[4] = {g0.x, g0.y, g1.x, g1.y}, vw[4] = {v0.x, v0.y, v1.x, v1.y};
#pragma unroll
                    for (int e = 0; e < 4; ++e) {
                        g[2 * e] += wg[k][2 * e] * __uint_as_float(gw[e] << 16); g[2 * e + 1] += wg[k][2 * e + 1] * __uint_as_float(gw[e] & 0xffff0000u);
                        v[2 * e] += wv[k][2 * e] * __uint_as_float(vw[e] << 16); v[2 * e + 1] += wv[k][2 * e + 1] * __uint_as_float(vw[e] & 0xffff0000u);
                    }
                }
                float o[8];
#pragma unroll
                for (int e = 0; e < 8; ++e) o[e] = g[e] * __builtin_amdgcn_rcpf(1.f + __builtin_amdgcn_exp2f(-1.4426950408889634f * g[e])) * v[e];
                u32x4 w; w.x = cvt_pk_bf16(o[0], o[1]); w.y = cvt_pk_bf16(o[2], o[3]); w.z = cvt_pk_bf16(o[4], o[5]); w.w = cvt_pk_bf16(o[6], o[7]);
                *(u32x4*)(ACT + (size_t)orow * 2816 + gcol) = w;
            }
        }
        asm volatile("s_waitcnt lgkmcnt(0)" ::: "memory"); __builtin_amdgcn_s_barrier(); asm volatile("" ::: "memory");
    }
};
template <class Epi, class Sched, bool ALIGN_EPI = false, bool SP2 = false>
__device__ __forceinline__ void gemm_phase(PG8_LAS unsigned char* lds, const Gemm g, const Sched& S, const Epi& E) {
    const int tid = pg8_ltid(), wid = __builtin_amdgcn_readfirstlane(tid >> 6), lane = tid & 63, wr = wid >> 2, wc = wid & 3, fr = lane & 15, fq = lane >> 4;
    const int K = g.ldk, nt = g.K / BK;
    unsigned voffA[2], voffB[2];
#pragma unroll
    for (int i = 0; i < 2; ++i) { int R, C; stage_rc(tid * 16 + i * 8192, R, C); const int Rb = Epi::PERM ? ((R & ~31) + perm32(R & 31)) : R;
        voffA[i] = (unsigned)(R * K + C) * 2u; voffB[i] = (unsigned)(Rb * K + C) * 2u; }
    const size_t kstep = (size_t)(BK * 2);
    const size_t hstep = (size_t)HALF * K * 2;
    const size_t tstep = 2 * hstep;
    const unsigned ldsw = (unsigned)wid * 1024u;
    const int aoff = lds_byte(wr * 64 + fr, fq * 8), boff = lds_byte(wc * 32 + fr, fq * 8);
#define PG8_SA(b, h) (((b) * 2 + (h)) * HTB)
#define PG8_SB(b, h) ((4 + (b) * 2 + (h)) * HTB)
#define PG8_STAGE(bufoff, gbase, voff) do { _Pragma("unroll") for (int _i = 0; _i < 2; ++_i) \
        __builtin_amdgcn_global_load_lds((const unsigned*)((const char*)(gbase) + (voff)[_i]), (PG8_LAS unsigned*)(lds + (bufoff) + ldsw + _i * 8192), 16, 0, 0); } while (0)
#define PG8_LDA(dst, b, h) do { _Pragma("unroll") for (int m = 0; m < 4; ++m) _Pragma("unroll") for (int k = 0; k < 2; ++k) dst[m][k] = *(const PG8_LAS bf16x8*)(lds + PG8_SA(b, h) + aoff + m * 2048 + k * 1024); } while (0)
#define PG8_LDB(dst, b, h) do { _Pragma("unroll") for (int n = 0; n < 2; ++n) _Pragma("unroll") for (int k = 0; k < 2; ++k) dst[n][k] = *(const PG8_LAS bf16x8*)(lds + PG8_SB(b, h) + boff + n * 2048 + k * 1024); } while (0)
#define PG8_MMA(ai, bj, At, Bt) do { __builtin_amdgcn_s_setprio(1); _Pragma("unroll") for (int m = 0; m < 4; ++m) _Pragma("unroll") for (int n = 0; n < 2; ++n) _Pragma("unroll") for (int k = 0; k < 2; ++k) \
        acc[ai][bj][m][n] = __builtin_amdgcn_mfma_f32_16x16x32_bf16(Bt[n][k], At[m][k], acc[ai][bj][m][n], 0, 0, 0); __builtin_amdgcn_s_setprio(0); } while (0)
#define PG8_WAIT_V(n) asm volatile("s_waitcnt vmcnt(" #n ")" ::: "memory")
#define PG8_WAIT_L(n) asm volatile("s_waitcnt lgkmcnt(" #n ")" ::: "memory")
#define PG8_BAR __builtin_amdgcn_s_barrier()
#define PG8_SCHED __builtin_amdgcn_sched_barrier(0)
    Unit cur, nxt; int ui = 0;
    if (!S.next(0, cur)) return;
    f32x4 acc[2][2][4][2];
#pragma unroll
    for (int a = 0; a < 2; ++a)
#pragma unroll
        for (int b = 0; b < 2; ++b)
#pragma unroll
            for (int m = 0; m < 4; ++m)
#pragma unroll
                for (int n = 0; n < 2; ++n) acc[a][b][m][n] = (f32x4){0.f, 0.f, 0.f, 0.f};
    bf16x8 At[4][2], B0[2][2], B1[2][2];
    const char* cA = (const char*)g.A + (size_t)cur.pm * tstep; const char* cB = (const char*)g.Bt + (size_t)cur.pn * tstep;
    S.a_ready(cur);
    if constexpr (SP2) {
        PG8_STAGE(PG8_SB(0, 0), cB, voffB); PG8_STAGE(PG8_SB(0, 1), cB + hstep, voffB); PG8_STAGE(PG8_SA(0, 0), cA, voffA); PG8_STAGE(PG8_SA(0, 1), cA + hstep, voffA);
        if (wr == 1) PG8_BAR;
        PG8_WAIT_V(2); PG8_BAR;
        PG8_STAGE(PG8_SB(1, 0), cB + kstep, voffB); PG8_STAGE(PG8_SA(1, 0), cA + kstep, voffA); PG8_STAGE(PG8_SB(1, 1), cB + hstep + kstep, voffB);
        PG8_WAIT_V(6); PG8_BAR;
    } else {
        PG8_STAGE(PG8_SB(0, 0), cB, voffB); PG8_STAGE(PG8_SA(0, 0), cA, voffA); PG8_STAGE(PG8_SB(0, 1), cB + hstep, voffB); PG8_STAGE(PG8_SA(0, 1), cA + hstep, voffA);
        if (wr == 1) PG8_BAR;
        PG8_WAIT_V(4); PG8_BAR;
        PG8_STAGE(PG8_SB(1, 0), cB + kstep, voffB); PG8_STAGE(PG8_SA(1, 0), cA + kstep, voffA); PG8_STAGE(PG8_SB(1, 1), cB + hstep + kstep, voffB);
        PG8_WAIT_V(6); PG8_BAR;
    }
    for (;;) {
        const bool has_next = S.next(ui + 1, nxt);
        const char* nA = has_next ? (const char*)g.A + (size_t)nxt.pm * tstep : cA; const char* nB = has_next ? (const char*)g.Bt + (size_t)nxt.pn * tstep : cB;
        for (int t = 0; t < nt; t += 2) {
            const bool last = (t == nt - 2);
            const char* a1 = cA + (size_t)(t + 1) * kstep;
            const char* a2 = last ? nA : cA + (size_t)(t + 2) * kstep; const char* b2 = last ? nB : cB + (size_t)(t + 2) * kstep;
            const char* a3 = a2 + kstep; const char* b3 = b2 + kstep;
            if (last && has_next) S.a_ready(nxt);
            if constexpr (SP2) {
            PG8_LDB(B0, 0, 0); PG8_LDB(B1, 0, 1); PG8_SCHED; PG8_LDA(At, 0, 0); PG8_STAGE(PG8_SA(1, 1), a1 + hstep, voffA);
            PG8_WAIT_V(8); PG8_WAIT_L(0); PG8_BAR; PG8_MMA(0, 0, At, B0); PG8_MMA(0, 1, At, B1); PG8_BAR; PG8_SCHED;
            PG8_LDA(At, 0, 1); PG8_STAGE(PG8_SB(0, 0), b2, voffB); PG8_STAGE(PG8_SB(0, 1), b2 + hstep, voffB); PG8_STAGE(PG8_SA(0, 0), a2, voffA);
            PG8_WAIT_V(8); PG8_WAIT_L(0); PG8_BAR; PG8_MMA(1, 0, At, B0); PG8_MMA(1, 1, At, B1); PG8_BAR; PG8_SCHED;
            PG8_LDB(B0, 1, 0); PG8_LDB(B1, 1, 1); PG8_SCHED; PG8_LDA(At, 1, 0); PG8_STAGE(PG8_SA(0, 1), a2 + hstep, voffA);
            PG8_WAIT_V(8); PG8_WAIT_L(0); PG8_BAR; PG8_MMA(0, 0, At, B0); PG8_MMA(0, 1, At, B1); PG8_BAR; PG8_SCHED;
            PG8_LDA(At, 1, 1); PG8_STAGE(PG8_SB(1, 0), b3, voffB); PG8_STAGE(PG8_SB(1, 1), b3 + hstep, voffB); PG8_STAGE(PG8_SA(1, 0), a3, voffA);
            PG8_WAIT_V(8); PG8_WAIT_L(0); PG8_BAR; PG8_MMA(1, 0, At, B0); PG8_MMA(1, 1, At, B1); PG8_BAR; PG8_SCHED;
            } else {
            PG8_LDB(B0, 0, 0); PG8_SCHED; PG8_LDA(At, 0, 0); PG8_STAGE(PG8_SA(1, 1), a1 + hstep, voffA);
            PG8_WAIT_L(8); PG8_BAR; PG8_WAIT_L(0); PG8_MMA(0, 0, At, B0); PG8_BAR; PG8_SCHED;
            PG8_LDB(B1, 0, 1); PG8_STAGE(PG8_SB(0, 0), b2, voffB);
            PG8_BAR; PG8_WAIT_L(0); PG8_MMA(0, 1, At, B1); PG8_BAR;
            PG8_LDA(At, 0, 1); PG8_STAGE(PG8_SA(0, 0), a2, voffA);
            PG8_BAR; PG8_WAIT_L(0); PG8_MMA(1, 0, At, B0); PG8_BAR; PG8_SCHED;
            PG8_STAGE(PG8_SB(0, 1), b2 + hstep, voffB);
            PG8_WAIT_V(6); PG8_BAR; PG8_MMA(1, 1, At, B1); PG8_BAR;
            PG8_LDB(B0, 1, 0); PG8_SCHED; PG8_LDA(At, 1, 0); PG8_STAGE(PG8_SA(0, 1), a2 + hstep, voffA);
            PG8_WAIT_L(8); PG8_BAR; PG8_WAIT_L(0); PG8_MMA(0, 0, At, B0); PG8_BAR; PG8_SCHED;
            PG8_LDB(B1, 1, 1); PG8_STAGE(PG8_SB(1, 0), b3, voffB);
            PG8_BAR; PG8_WAIT_L(0); PG8_MMA(0, 1, At, B1); PG8_BAR;
            PG8_LDA(At, 1, 1); PG8_STAGE(PG8_SA(1, 0), a3, voffA);
            PG8_BAR; PG8_WAIT_L(0); PG8_MMA(1, 0, At, B0); PG8_BAR; PG8_SCHED;
            PG8_STAGE(PG8_SB(1, 1), b3 + hstep, voffB);
            PG8_WAIT_V(6); PG8_BAR; PG8_MMA(1, 1, At, B1); PG8_BAR;
            }
        }
        if constexpr (ALIGN_EPI) { if (wr == 0) PG8_BAR; }
        if constexpr (!Epi::AFTER_DRAIN) { E(acc, cur, wr, wc, fr, fq); S.done(cur); }
        if (!has_next) break;
#pragma unroll
        for (int a = 0; a < 2; ++a)
#pragma unroll
            for (int b = 0; b < 2; ++b)
#pragma unroll
                for (int m = 0; m < 4; ++m)
#pragma unroll
                    for (int n = 0; n < 2; ++n) acc[a][b][m][n] = (f32x4){0.f, 0.f, 0.f, 0.f};
        cur = nxt; cA = nA; cB = nB; ++ui;
        if constexpr (ALIGN_EPI) { if (wr == 1) PG8_BAR; }
    }
    PG8_WAIT_V(0);
    if constexpr (!ALIGN_EPI) { if (wr == 0) PG8_BAR; }
    PG8_BAR;
    if constexpr (Epi::AFTER_DRAIN) { E.fused(acc, cur, wr, wc, fr, fq, lds, wid, lane); S.done(cur); }
#undef PG8_SA
#undef PG8_SB
#undef PG8_STAGE
#undef PG8_LDA
#undef PG8_LDB
#undef PG8_MMA
#undef PG8_WAIT_V
#undef PG8_WAIT_L
#undef PG8_BAR
#undef PG8_SCHED
}
}
#define LAS __attribute__((address_space(3)))
typedef unsigned short bf16_t;
typedef short bf16x8 __attribute__((ext_vector_type(8)));
typedef short s16x4 __attribute__((ext_vector_type(4)));
typedef float f32x4 __attribute__((ext_vector_type(4)));
typedef float f32x16 __attribute__((ext_vector_type(16)));
typedef unsigned u32x4 __attribute__((ext_vector_type(4)));
typedef unsigned u32x2 __attribute__((ext_vector_type(2)));

constexpr int DM = 1024, NB = 4, SEQ = 8192, DEPTH = 4, CTXL = 256;
constexpr int ML = NB * SEQ, MC = NB * CTXL, MT = ML + MC;
constexpr int INC = 2816, DFF = 2816, UPC = 5632;
constexpr int NMX_L = NB * 33, NMX_ALL = NB * 33 + 5;
constexpr float LOG2E = 1.4426950408889634f;

constexpr size_t MiB = 1u << 20;
constexpr size_t WS_MOD = 1 * MiB;
constexpr size_t WS_MODP = 2 * MiB;
constexpr size_t WS_TAB = 10 * MiB;
constexpr size_t WS_XC = 11 * MiB;
constexpr size_t WS_W = 16 * MiB;
constexpr size_t W_LAYER = 24 * MiB, W_OUT_OFF = (size_t)2816 * 1024 * 2, W_UP_OFF = W_OUT_OFF + (size_t)1024 * 1024 * 2, W_DN_OFF = W_UP_OFF + (size_t)5632 * 1024 * 2;
constexpr size_t WS_XN = 112 * MiB;
constexpr size_t WS_O = 182 * MiB;
constexpr size_t WS_H = 248 * MiB;
constexpr size_t WS_XB = 430 * MiB;
constexpr size_t WS_END = WS_XB + (size_t)ML * 1024 * 2;
static_assert(W_DN_OFF + (size_t)1024 * 2816 * 2 <= W_LAYER, "weights per layer");
static_assert(WS_XN + (size_t)NMX_ALL * 256 * 1024 * 2 <= WS_O && WS_O + (size_t)MT * 1024 * 2 <= WS_H && WS_H + (size_t)MT * 2816 * 2 <= WS_XB && WS_END <= 512 * MiB, "ws map");

constexpr int RING_BYTES = 135168;
constexpr int LDS_BYTES = 147456;

__device__ __forceinline__ unsigned pkbf(float lo, float hi) { return pg8::cvt_pk_bf16(lo, hi); }
__device__ __forceinline__ float bflo(unsigned w) { return __uint_as_float(w << 16); }
__device__ __forceinline__ float bfhi(unsigned w) { return __uint_as_float(w & 0xffff0000u); }
__device__ __forceinline__ float dpp_add(float v, const int ctrl_sel) {
    int m;
    if (ctrl_sel == 0) m = __builtin_amdgcn_update_dpp(0, __float_as_int(v), 0xB1, 0xF, 0xF, true);
    else if (ctrl_sel == 1) m = __builtin_amdgcn_update_dpp(0, __float_as_int(v), 0x4E, 0xF, 0xF, true);
    else if (ctrl_sel == 2) m = __builtin_amdgcn_update_dpp(0, __float_as_int(v), 0x124, 0xF, 0xF, true);
    else m = __builtin_amdgcn_update_dpp(0, __float_as_int(v), 0x128, 0xF, 0xF, true);
    return v + __int_as_float(m);
}
__device__ __forceinline__ float wave_sum(float v, int lane) {
    v = dpp_add(v, 0); v = dpp_add(v, 1); v = dpp_add(v, 2); v = dpp_add(v, 3);
    v += __int_as_float(__builtin_amdgcn_ds_bpermute((lane ^ 16) << 2, __float_as_int(v)));
    auto rr = __builtin_amdgcn_permlane32_swap(__float_as_uint(v), __float_as_uint(v), false, false);
    return __uint_as_float(rr[0]) + __uint_as_float(rr[1]);
}
__device__ __forceinline__ float xhalf_max(float v) { auto rr = __builtin_amdgcn_permlane32_swap(__float_as_uint(v), __float_as_uint(v), false, false); return fmaxf(__uint_as_float(rr[0]), __uint_as_float(rr[1])); }
__device__ __forceinline__ float xhalf_sum(float v) { auto rr = __builtin_amdgcn_permlane32_swap(__float_as_uint(v), __float_as_uint(v), false, false); return __uint_as_float(rr[0]) + __uint_as_float(rr[1]); }

namespace att {
constexpr int KP = 144, VP = 136;
constexpr int L_KS = 0, L_VT = 64 * KP, L_RPB = L_VT + 64 * VP, L_END = L_RPB + 2048;
__device__ __forceinline__ int crow(int r, int h) { return (r & 3) + 8 * (r >> 2) + 4 * h; }

struct TileRegs { u32x4 k, v; };
__device__ __forceinline__ void tile_gload(TileRegs& R, const bf16_t* H, int krow, int kcol, int vcol, int tid) {
    const int key = tid >> 3, ch = tid & 7;
    const bf16_t* p = H + (size_t)(krow + key) * INC;
    R.k = *(const u32x4*)(p + kcol + 8 * ch); R.v = *(const u32x4*)(p + vcol + 8 * ch);
}
__device__ __forceinline__ void tile_swrite(const TileRegs& R, LAS unsigned char* lds, int tid) {
    const int key = tid >> 3, ch = tid & 7;
    *(LAS u32x4*)(lds + L_KS + key * KP + ch * 16) = R.k;
    LAS unsigned short* vt = (LAS unsigned short*)(lds + L_VT);
#pragma unroll
    for (int j = 0; j < 4; ++j) { const unsigned w = R.v[j]; vt[(8 * ch + 2 * j) * (VP / 2) + key] = (unsigned short)(w & 0xffffu); vt[(8 * ch + 2 * j + 1) * (VP / 2) + key] = (unsigned short)(w >> 16); }
}
template <int KS0, int NKS>
__device__ __forceinline__ f32x16 qk_block(const LAS unsigned char* lds, int kb, int r32, int hh, const bf16x8 (&qf)[4]) {
    f32x16 s = {0.f, 0.f, 0.f, 0.f, 0.f, 0.f, 0.f, 0.f, 0.f, 0.f, 0.f, 0.f, 0.f, 0.f, 0.f, 0.f};
#pragma unroll
    for (int ks = KS0; ks < KS0 + NKS; ++ks) {
        const bf16x8 kf = *(const LAS bf16x8*)(lds + L_KS + (kb * 32 + r32) * KP + ks * 32 + hh * 16);
        s = __builtin_amdgcn_mfma_f32_32x32x16_bf16(kf, qf[ks], s, 0, 0, 0);
    }
    return s;
}
__device__ __forceinline__ void softmax_pv(f32x16 (&s)[2], float& m, float& l, f32x16 (&O)[2], const LAS unsigned char* lds, int r32, int hh) {
    float mx = s[0][0];
#pragma unroll
    for (int r = 1; r < 16; ++r) mx = fmaxf(mx, s[0][r]);
#pragma unroll
    for (int r = 0; r < 16; ++r) mx = fmaxf(mx, s[1][r]);
    mx = xhalf_max(mx);
    __builtin_amdgcn_sched_barrier(0);
    const float mn = fmaxf(m, mx);
    const float alpha = __builtin_amdgcn_exp2f(m - mn);
    m = mn; l *= alpha;
#pragma unroll
    for (int r = 0; r < 16; ++r) { O[0][r] *= alpha; O[1][r] *= alpha; }
    float ps = 0.f;
#pragma unroll
    for (int kb = 0; kb < 2; ++kb)
#pragma unroll
        for (int r = 0; r < 16; ++r) { const float p = __builtin_amdgcn_exp2f(s[kb][r] - mn); s[kb][r] = p; ps += p; }
    l += ps;
    __builtin_amdgcn_sched_barrier(0);
#pragma unroll
    for (int kb = 0; kb < 2; ++kb)
#pragma unroll
        for (int sk = 0; sk < 2; ++sk) {
            __builtin_amdgcn_sched_barrier(0);
            u32x4 pw; pw.x = pkbf(s[kb][8 * sk + 0], s[kb][8 * sk + 1]); pw.y = pkbf(s[kb][8 * sk + 2], s[kb][8 * sk + 3]);
            pw.z = pkbf(s[kb][8 * sk + 4], s[kb][8 * sk + 5]); pw.w = pkbf(s[kb][8 * sk + 6], s[kb][8 * sk + 7]);
            const bf16x8 pf = __builtin_bit_cast(bf16x8, pw);
#pragma unroll
            for (int dvb = 0; dvb < 2; ++dvb) {
                const LAS unsigned char* a = lds + L_VT + (dvb * 32 + r32) * VP + (kb * 32 + 16 * sk + 4 * hh) * 2;
                const s16x4 lo = *(const LAS s16x4*)a, hi = *(const LAS s16x4*)(a + 16);
                const bf16x8 vf = {lo[0], lo[1], lo[2], lo[3], hi[0], hi[1], hi[2], hi[3]};
                O[dvb] = __builtin_amdgcn_mfma_f32_32x32x16_bf16(vf, pf, O[dvb], 0, 0, 0);
            }
        }
}
__device__ __forceinline__ void store_o(const f32x16 (&o)[2], bf16_t* orow, int hh) {
#pragma unroll
    for (int dvb = 0; dvb < 2; ++dvb)
#pragma unroll
        for (int g = 0; g < 4; ++g) {
            u32x2 w; w.x = pkbf(o[dvb][4 * g], o[dvb][4 * g + 1]); w.y = pkbf(o[dvb][4 * g + 2], o[dvb][4 * g + 3]);
            *(u32x2*)(orow + dvb * 32 + 8 * g + 4 * hh) = w;
        }
}

__device__ __forceinline__ void unit_A_safe(const bool CTXQ, LAS unsigned char* lds, const bf16_t* H, bf16_t* Ob, int b, int h, int qb, float lam, float ofac, const float* subw) {
    const int tid = pg8_ltid(), lane = tid & 63, r32 = lane & 31, hh = lane >> 5, wid = tid >> 6;
    const int qrow = CTXQ ? (ML + b * CTXL + wid * 32 + r32) : (b * SEQ + qb * 256 + wid * 32 + r32);
    const int qcol = h * 64, kcol = 256 + h * 64, vcol = 512 + h * 64;
    bf16x8 qf[4];
#pragma unroll
    for (int ks = 0; ks < 4; ++ks) qf[ks] = *(const bf16x8*)(H + (size_t)qrow * INC + qcol + 16 * ks + 8 * hh);
    const int NT = CTXQ ? 4 : 132;
    f32x16 O1[2], O2[2];
#pragma unroll
    for (int r = 0; r < 16; ++r) { O1[0][r] = 0.f; O1[1][r] = 0.f; O2[0][r] = 0.f; O2[1][r] = 0.f; }
    float m1 = -INFINITY, m2 = -INFINITY, l1 = 0.f, l2 = 0.f;
    TileRegs R;
    tile_gload(R, H, CTXQ ? (ML + b * CTXL) : (b * SEQ), kcol, vcol, tid);
    for (int t = 0; t < NT; ++t) {
        __syncthreads();
        tile_swrite(R, lds, tid);
        __syncthreads();
        if (t + 1 < NT) { const int tn = t + 1; const int krow = CTXQ ? (ML + b * CTXL + 64 * tn) : (tn < 128 ? b * SEQ + 64 * tn : ML + b * CTXL + 64 * (tn - 128)); tile_gload(R, H, krow, kcol, vcol, tid); }
        { f32x16 s[2]; s[0] = qk_block<0, 2>(lds, 0, r32, hh, qf); s[1] = qk_block<0, 2>(lds, 1, r32, hh, qf); softmax_pv(s, m1, l1, O1, lds, r32, hh); }
        __builtin_amdgcn_sched_barrier(0);
        { f32x16 s[2]; s[0] = qk_block<2, 2>(lds, 0, r32, hh, qf); s[1] = qk_block<2, 2>(lds, 1, r32, hh, qf); softmax_pv(s, m2, l2, O2, lds, r32, hh); }
        __builtin_amdgcn_sched_barrier(0);
    }
    l1 = xhalf_sum(l1); l2 = xhalf_sum(l2);
    const float i1 = 1.f / l1, i2 = lam / l2;
    float ss = 0.f;
#pragma unroll
    for (int dvb = 0; dvb < 2; ++dvb)
#pragma unroll
        for (int r = 0; r < 16; ++r) { const float o = O1[dvb][r] * i1 - O2[dvb][r] * i2; O1[dvb][r] = o; ss += o * o; }
    ss = xhalf_sum(ss);
    float li_ = ofac; asm volatile("" : "+s"(li_));
    const float rn = rsqrtf(ss * (1.f / 64.f) + 1e-6f) * (1.f - li_);
#pragma unroll
    for (int dvb = 0; dvb < 2; ++dvb)
#pragma unroll
        for (int g = 0; g < 4; ++g) {
            const f32x4 w = *(const f32x4*)(subw + dvb * 32 + 8 * g + 4 * hh);
#pragma unroll
            for (int e = 0; e < 4; ++e) O1[dvb][4 * g + e] *= rn * w[e];
        }
    store_o(O1, Ob + (size_t)qrow * DM + h * 64, hh);
}


constexpr int A_KP = 144, A_VP = 192, A_VOFF = 64 * A_KP, A_BUF = A_VOFF + 64 * A_VP;
constexpr float ATHR = 10.f;
typedef short v4i16_t __attribute__((ext_vector_type(4)));
__device__ __forceinline__ s16x4 vtr(const LAS unsigned char* p) { return __builtin_bit_cast(s16x4, __builtin_amdgcn_ds_read_tr16_b64_v4i16((LAS v4i16_t*)p)); }
__device__ __forceinline__ void tileA_swrite(const TileRegs& R, LAS unsigned char* buf, int tid) {
    const int key = tid >> 3, ch = tid & 7;
    *(LAS u32x4*)(buf + key * A_KP + ch * 16) = R.k;
    *(LAS u32x4*)(buf + A_VOFF + key * A_VP + ch * 16) = R.v;
}
__device__ __forceinline__ float max16(const f32x16& s) {
    float a = fmaxf(fmaxf(s[0], s[1]), s[2]), b = fmaxf(fmaxf(s[3], s[4]), s[5]), c = fmaxf(fmaxf(s[6], s[7]), s[8]), d = fmaxf(fmaxf(s[9], s[10]), s[11]);
    a = fmaxf(fmaxf(a, s[12]), s[13]); b = fmaxf(fmaxf(b, s[14]), s[15]);
    return fmaxf(fmaxf(a, b), fmaxf(c, d));
}
__device__ __forceinline__ float expsum16(f32x16& s) {
    float a = 0.f, b = 0.f, c = 0.f, d = 0.f;
#pragma unroll
    for (int r = 0; r < 16; r += 4) {
        s[r] = __builtin_amdgcn_exp2f(s[r]); s[r + 1] = __builtin_amdgcn_exp2f(s[r + 1]); s[r + 2] = __builtin_amdgcn_exp2f(s[r + 2]); s[r + 3] = __builtin_amdgcn_exp2f(s[r + 3]);
        a += s[r]; b += s[r + 1]; c += s[r + 2]; d += s[r + 3];
    }
    return (a + b) + (c + d);
}
__device__ __forceinline__ bf16x8 packp(const f32x16& s, int sk) {
    u32x4 pw; pw.x = pkbf(s[8 * sk + 0], s[8 * sk + 1]); pw.y = pkbf(s[8 * sk + 2], s[8 * sk + 3]); pw.z = pkbf(s[8 * sk + 4], s[8 * sk + 5]); pw.w = pkbf(s[8 * sk + 6], s[8 * sk + 7]);
    return __builtin_bit_cast(bf16x8, pw);
}
__device__ __forceinline__ void exp16(f32x16& s) {
#pragma unroll
    for (int r = 0; r < 16; ++r) s[r] = __builtin_amdgcn_exp2f(s[r]);
}
constexpr float AREF = 20.f, AGUARD = 60.f;
#ifndef SGB_V
#define SGB_V 5
#endif
template <bool HAVE>
__device__ __forceinline__ void stepA(bf16x8 (&pc)[2][2], const LAS unsigned char* kbuf, int kb, const LAS unsigned char* vb, const bf16x8 (&qv)[4], int r32, int hh,
                                      float mref1, float mref2, f32x16 (&O1)[2], f32x16 (&O2)[2], f32x16& L1, f32x16& L2, const bf16x8& ones) {
    const LAS unsigned char* kp = kbuf + (kb * 32 + r32) * A_KP + hh * 16;
    const bf16x8 k0 = *(const LAS bf16x8*)(kp), k1 = *(const LAS bf16x8*)(kp + 32), k2 = *(const LAS bf16x8*)(kp + 64), k3 = *(const LAS bf16x8*)(kp + 96);
    const bf16x8 q0 = qv[0], q1 = qv[1], q2 = qv[2], q3 = qv[3];
    bf16x8 vf[2][2];
#pragma unroll
    for (int sk = 0; sk < 2; ++sk)
#pragma unroll
        for (int dvb = 0; dvb < 2; ++dvb) {
            const LAS unsigned char* a = vb + 16 * sk * A_VP + dvb * 64;
            const s16x4 lo = vtr(a), hi = vtr(a + 8 * A_VP);
            vf[sk][dvb] = (bf16x8){lo[0], lo[1], lo[2], lo[3], hi[0], hi[1], hi[2], hi[3]};
        }
    const f32x16 z = {0.f, 0.f, 0.f, 0.f, 0.f, 0.f, 0.f, 0.f, 0.f, 0.f, 0.f, 0.f, 0.f, 0.f, 0.f, 0.f};
    f32x16 s1 = __builtin_amdgcn_mfma_f32_32x32x16_bf16(k0, q0, z, 0, 0, 0);
    f32x16 s2 = __builtin_amdgcn_mfma_f32_32x32x16_bf16(k2, q2, z, 0, 0, 0);
    s1 = __builtin_amdgcn_mfma_f32_32x32x16_bf16(k1, q1, s1, 0, 0, 0);
    s2 = __builtin_amdgcn_mfma_f32_32x32x16_bf16(k3, q3, s2, 0, 0, 0);
#pragma unroll
    for (int sk = 0; sk < 2; ++sk) {
        L1 = __builtin_amdgcn_mfma_f32_32x32x16_bf16(ones, pc[0][sk], L1, 0, 0, 0);
        L2 = __builtin_amdgcn_mfma_f32_32x32x16_bf16(ones, pc[1][sk], L2, 0, 0, 0);
#pragma unroll
        for (int dvb = 0; dvb < 2; ++dvb) {
            O1[dvb] = __builtin_amdgcn_mfma_f32_32x32x16_bf16(vf[sk][dvb], pc[0][sk], O1[dvb], 0, 0, 0);
            O2[dvb] = __builtin_amdgcn_mfma_f32_32x32x16_bf16(vf[sk][dvb], pc[1][sk], O2[dvb], 0, 0, 0);
        }
    }
    if (HAVE) {
#pragma unroll
        for (int r = 0; r < 16; ++r) { s1[r] -= mref1; s2[r] -= mref2; }
    }
    exp16(s1); exp16(s2);
    bf16x8 pn[2][2];
    pn[0][0] = packp(s1, 0); pn[0][1] = packp(s1, 1); pn[1][0] = packp(s2, 0); pn[1][1] = packp(s2, 1);
#if 0
    __builtin_amdgcn_sched_group_barrier(0x008, 6, 0);
#pragma unroll
    for (int i = 0; i < 10; ++i) { __builtin_amdgcn_sched_group_barrier(0x002, SGB_V, 0); __builtin_amdgcn_sched_group_barrier(0x008, 1, 0); }
    __builtin_amdgcn_sched_group_barrier(0x002, 48, 0);
#endif
    pc[0][0] = pn[0][0]; pc[0][1] = pn[0][1]; pc[1][0] = pn[1][0]; pc[1][1] = pn[1][1];
}
__device__ __forceinline__ void unit_A(const bool CTXQ, LAS unsigned char* lds, const bf16_t* H, bf16_t* Ob, int b, int h, int qb, float lam, float ofac, const float* subw) {
    const int tid = pg8_ltid(), lane = tid & 63, r32 = lane & 31, hh = lane >> 5, wid = tid >> 6;
    const int qrow = CTXQ ? (ML + b * CTXL + wid * 32 + r32) : (b * SEQ + qb * 256 + wid * 32 + r32);
    const int qcol = h * 64, kcol = 256 + h * 64, vcol = 512 + h * 64;
    const int NT = CTXQ ? 4 : 132;
    f32x16 O1[2], O2[2], L1, L2;
#pragma unroll
    for (int r = 0; r < 16; ++r) { O1[0][r] = 0.f; O1[1][r] = 0.f; O2[0][r] = 0.f; O2[1][r] = 0.f; L1[r] = 0.f; L2[r] = 0.f; }
    const bf16x8 ones = {0x3F80, 0x3F80, 0x3F80, 0x3F80, 0x3F80, 0x3F80, 0x3F80, 0x3F80};
    const int voff = A_VOFF + (4 * hh + ((lane & 15) >> 2)) * A_VP + (((lane >> 4) & 1) * 16 + (lane & 3) * 4) * 2;
    const int krow0 = CTXQ ? (ML + b * CTXL) : (b * SEQ);
    LAS unsigned char* qs = lds + 3 * A_BUF + (wid * 32 + r32) * A_KP + hh * 16;
    volatile LAS unsigned* flag = (volatile LAS unsigned*)(lds + RING_BYTES + 128);
    TileRegs R;
    __syncthreads();
    if (tid == 0) *flag = 0u;
#pragma unroll
    for (int ks = 0; ks < 4; ++ks) *(LAS bf16x8*)(qs + ks * 32) = *(const bf16x8*)(H + (size_t)qrow * INC + qcol + 16 * ks + 8 * hh);
    tile_gload(R, H, krow0, kcol, vcol, tid);       tileA_swrite(R, lds, tid);
    tile_gload(R, H, krow0 + 64, kcol, vcol, tid);  tileA_swrite(R, lds + A_BUF, tid);
    tile_gload(R, H, krow0 + 128, kcol, vcol, tid);
    __syncthreads();
    bf16x8 pc[2][2];
    {
        const LAS unsigned char* kp = lds + r32 * A_KP + hh * 16;
        const f32x16 z = {0.f, 0.f, 0.f, 0.f, 0.f, 0.f, 0.f, 0.f, 0.f, 0.f, 0.f, 0.f, 0.f, 0.f, 0.f, 0.f};
        f32x16 sa1 = __builtin_amdgcn_mfma_f32_32x32x16_bf16(*(const LAS bf16x8*)(kp), *(const LAS bf16x8*)(qs), z, 0, 0, 0);
        sa1 = __builtin_amdgcn_mfma_f32_32x32x16_bf16(*(const LAS bf16x8*)(kp + 32), *(const LAS bf16x8*)(qs + 32), sa1, 0, 0, 0);
        f32x16 sa2 = __builtin_amdgcn_mfma_f32_32x32x16_bf16(*(const LAS bf16x8*)(kp + 64), *(const LAS bf16x8*)(qs + 64), z, 0, 0, 0);
        sa2 = __builtin_amdgcn_mfma_f32_32x32x16_bf16(*(const LAS bf16x8*)(kp + 96), *(const LAS bf16x8*)(qs + 96), sa2, 0, 0, 0);
        exp16(sa1); exp16(sa2);
        pc[0][0] = packp(sa1, 0); pc[0][1] = packp(sa1, 1); pc[1][0] = packp(sa2, 0); pc[1][1] = packp(sa2, 1);
    }
    bf16x8 qv[4];
#pragma unroll
    for (int ks = 0; ks < 4; ++ks) qv[ks] = *(const LAS bf16x8*)(qs + ks * 32);
    int bc = 0, t = 0;
#define UNITA_STAGE() \
        const int bn = (bc == 2 * A_BUF) ? 0 : bc + A_BUF, bw = (bn == 2 * A_BUF) ? 0 : bn + A_BUF; \
        if (t + 2 < NT) { \
            tileA_swrite(R, lds + bw, tid); \
            if (t + 3 < NT) { const int tn = t + 3; const int krow = CTXQ ? (krow0 + 64 * tn) : (tn < 128 ? b * SEQ + 64 * tn : ML + b * CTXL + 64 * (tn - 128)); tile_gload(R, H, krow, kcol, vcol, tid); } \
        }
#define UNITA_GUARD() (__any((L1[0] > 1.152921504606846976e18f) || (L2[0] > 1.152921504606846976e18f)) != 0)
    {
        for (; t < NT; ++t) {
            UNITA_STAGE()
            stepA<false>(pc, lds + bc, 1, lds + bc + voff, qv, r32, hh, 0.f, 0.f, O1, O2, L1, L2, ones);
            stepA<false>(pc, lds + bn, 0, lds + bc + voff + 32 * A_VP, qv, r32, hh, 0.f, 0.f, O1, O2, L1, L2, ones);
            __syncthreads();
            bc = bn;
        }
    }
#undef UNITA_STAGE
#undef UNITA_GUARD
    if (__any(!((L1[0] > 1e-30f) && (L1[0] < 1e30f) && (L2[0] > 1e-30f) && (L2[0] < 1e30f))) != 0) *flag = 1u;
    __syncthreads();
    if (*flag != 0u) { unit_A_safe(CTXQ, lds, H, Ob, b, h, qb, lam, ofac, subw); return; }
    const float i1 = 1.f / L1[0], i2 = lam / L2[0];
    float ss = 0.f;
#pragma unroll
    for (int dvb = 0; dvb < 2; ++dvb)
#pragma unroll
        for (int r = 0; r < 16; ++r) { const float o = O1[dvb][r] * i1 - O2[dvb][r] * i2; O1[dvb][r] = o; ss += o * o; }
    ss = xhalf_sum(ss);
    float li_ = ofac; asm volatile("" : "+s"(li_));
    const float rn = rsqrtf(ss * (1.f / 64.f) + 1e-6f) * (1.f - li_);
#pragma unroll
    for (int dvb = 0; dvb < 2; ++dvb)
#pragma unroll
        for (int g = 0; g < 4; ++g) {
            const f32x4 w = *(const f32x4*)(subw + dvb * 32 + 8 * g + 4 * hh);
#pragma unroll
            for (int e = 0; e < 4; ++e) O1[dvb][4 * g + e] *= rn * w[e];
        }
    store_o(O1, Ob + (size_t)qrow * DM + h * 64, hh);
}

template <int MODE> __device__ __forceinline__ int tile_row_f(int t, int b, int lo, int nloc) {
    if (MODE == 1) return (t < nloc) ? (b * SEQ + 64 * (lo + t)) : (ML + b * CTXL + 64 * (t - nloc));
    if (MODE == 2) return (t < 4) ? (ML + b * CTXL + 64 * t) : (b * SEQ + 64 * (lo + t - 4));
    return ML + b * CTXL + 64 * t;
}
__device__ __forceinline__ int tile_row_r(int MODE, int t, int b, int lo, int nloc) {
    if (MODE == 1) return (t < nloc) ? (b * SEQ + 64 * (lo + t)) : (ML + b * CTXL + 64 * (t - nloc));
    if (MODE == 2) return (t < 4) ? (ML + b * CTXL + 64 * t) : (b * SEQ + 64 * (lo + t - 4));
    return ML + b * CTXL + 64 * t;
}
__device__ __forceinline__ void unit_BC(const int MODE, LAS unsigned char* lds, const bf16_t* H, bf16_t* Ob, int b, int hd, int blk, const float* sink_l, const float* rpb_l) {
    const int tid = pg8_ltid(), lane = tid & 63, r32 = lane & 31, hh = lane >> 5, wid = tid >> 6;
    int qrow, qcol, kcol, vcol, ocol, qpos = 0, r_w = 0, qc = 0, lo = 0, nloc = 0;
    float m = -INFINITY, l = 0.f;
    if (MODE == 1) {
        const int g = wid >> 2, head = hd * 2 + g; qpos = 128 * blk + 32 * (wid & 3) + r32; qrow = b * SEQ + qpos;
        qcol = 768 + head * 64; kcol = 1024 + hd * 64; vcol = 1152 + hd * 64; ocol = 256 + head * 64;
        lo = 2 * blk - 2; if (lo < 0) lo = 0; int hi = 2 * blk + 3; if (hi > 127) hi = 127; nloc = hi - lo + 1;
        m = sink_l[head] * LOG2E; l = (hh == 0) ? 1.f : 0.f;
    } else if (MODE == 3) {
        const int head = hd * 2 + blk; qrow = ML + b * CTXL + wid * 32 + r32;
        qcol = 768 + head * 64; kcol = 1024 + hd * 64; vcol = 1152 + hd * 64; ocol = 256 + head * 64;
        m = sink_l[head] * LOG2E; l = (hh == 0) ? 1.f : 0.f;
    } else if (MODE == 2) {
        r_w = 4 * blk + (wid >> 1); qc = 32 * (wid & 1) + r32; qrow = b * SEQ + r_w * 64 + qc;
        qcol = 1280 + hd * 64; kcol = 1536 + hd * 64; vcol = 1792 + hd * 64; ocol = 512 + hd * 64;
        int a0 = 4 * blk - 4; if (a0 < 0) a0 = 0; if (a0 > 120) a0 = 120; int a3 = 4 * blk + 3 - 4; if (a3 < 0) a3 = 0; if (a3 > 120) a3 = 120;
        lo = a0; nloc = a3 + 7 - a0 + 1;
    } else {
        qrow = ML + b * CTXL + wid * 32 + r32;
        qcol = 1280 + hd * 64; kcol = 1536 + hd * 64; vcol = 1792 + hd * 64; ocol = 512 + hd * 64;
    }
    bf16x8 qf[4];
#pragma unroll
    for (int ks = 0; ks < 4; ++ks) qf[ks] = *(const bf16x8*)(H + (size_t)qrow * INC + qcol + 16 * ks + 8 * hh);
    f32x16 O[2];
#pragma unroll
    for (int r = 0; r < 16; ++r) { O[0][r] = 0.f; O[1][r] = 0.f; }
    const int NT = 4 + nloc;
    int rs = 0;
    if (MODE == 2) { rs = r_w - 4; if (rs < 0) rs = 0; if (rs > 120) rs = 120; }
    const LAS float* rpbs = (const LAS float*)(lds + L_RPB);
    TileRegs R;
    tile_gload(R, H, tile_row_r(MODE, 0, b, lo, nloc), kcol, vcol, tid);
    for (int t = 0; t < NT; ++t) {
        __syncthreads();
        tile_swrite(R, lds, tid);
        if (MODE == 2 && t == 0) { for (int i = tid; i < 465; i += 512) ((LAS float*)(lds + L_RPB))[i] = rpb_l[hd * 465 + i] * LOG2E; }
        __syncthreads();
        if (t + 1 < NT) tile_gload(R, H, tile_row_r(MODE, t + 1, b, lo, nloc), kcol, vcol, tid);
        bool active = true; int kr = 0;
        if (MODE == 2 && t >= 4) { kr = lo + t - 4; active = (kr >= rs) && (kr < rs + 8); }
        if (active) {
            f32x16 s[2]; s[0] = qk_block<0, 4>(lds, 0, r32, hh, qf); s[1] = qk_block<0, 4>(lds, 1, r32, hh, qf);
            if (MODE == 1 && t < nloc) {
                const int kbase = 64 * (lo + t) - qpos;
#pragma unroll
                for (int kb = 0; kb < 2; ++kb)
#pragma unroll
                    for (int r = 0; r < 16; ++r) { const int d = kbase + kb * 32 + crow(r, hh); if (d > 128 || d < -128) s[kb][r] = -INFINITY; }
            }
            if (MODE == 2 && t >= 4) {
                int cs = qc - 8; if (cs < 0) cs = 0; if (cs > 48) cs = 48;
                const int bbase = (kr - r_w + 7) * 31 + 15 - qc;
#pragma unroll
                for (int kb = 0; kb < 2; ++kb)
#pragma unroll
                    for (int r = 0; r < 16; ++r) {
                        const int kc = kb * 32 + crow(r, hh);
                        const bool ok = (kc >= cs) && (kc < cs + 16);
                        int bi = bbase + kc; bi = ok ? bi : 0;
                        const float bias = rpbs[bi];
                        s[kb][r] = ok ? (s[kb][r] + bias) : -INFINITY;
                    }
            }
            softmax_pv(s, m, l, O, lds, r32, hh);
        }
    }
    l = xhalf_sum(l);
    const float il = 1.f / l;
#pragma unroll
    for (int r = 0; r < 16; ++r) { O[0][r] *= il; O[1][r] *= il; }
    store_o(O, Ob + (size_t)qrow * DM + ocol, hh);
}

template <int MODE>
__device__ __forceinline__ void bcf_compute(const LAS unsigned char* cur, int t, int nloc, int lo, int qpos, int kr, int r_w, int qc, const bf16x8 (&qf)[4], f32x16 (&O)[2], f32x16& L,
                                            const bf16x8& ones, const LAS float* rpbs, int voff, int r32, int hh) {
    f32x16 s[2];
    const f32x16 z = {0.f, 0.f, 0.f, 0.f, 0.f, 0.f, 0.f, 0.f, 0.f, 0.f, 0.f, 0.f, 0.f, 0.f, 0.f, 0.f};
#pragma unroll
    for (int kb = 0; kb < 2; ++kb) {
        const LAS unsigned char* kp = cur + (kb * 32 + r32) * A_KP + hh * 16;
        s[kb] = __builtin_amdgcn_mfma_f32_32x32x16_bf16(*(const LAS bf16x8*)(kp), qf[0], z, 0, 0, 0);
        s[kb] = __builtin_amdgcn_mfma_f32_32x32x16_bf16(*(const LAS bf16x8*)(kp + 32), qf[1], s[kb], 0, 0, 0);
        s[kb] = __builtin_amdgcn_mfma_f32_32x32x16_bf16(*(const LAS bf16x8*)(kp + 64), qf[2], s[kb], 0, 0, 0);
        s[kb] = __builtin_amdgcn_mfma_f32_32x32x16_bf16(*(const LAS bf16x8*)(kp + 96), qf[3], s[kb], 0, 0, 0);
    }
    if (MODE == 1 && t < nloc) {
        const int kbase = 64 * (lo + t) - qpos;
#pragma unroll
        for (int kb = 0; kb < 2; ++kb)
#pragma unroll
            for (int r = 0; r < 16; ++r) { const int d = kbase + kb * 32 + crow(r, hh); if (d > 128 || d < -128) s[kb][r] = -INFINITY; }
    }
    if (MODE == 2 && t >= 4) {
        int cs = qc - 8; if (cs < 0) cs = 0; if (cs > 48) cs = 48;
        const int bbase = (kr - r_w + 7) * 31 + 15 - qc;
#pragma unroll
        for (int kb = 0; kb < 2; ++kb)
#pragma unroll
            for (int r = 0; r < 16; ++r) {
                const int kc = kb * 32 + crow(r, hh);
                const bool ok = (kc >= cs) && (kc < cs + 16);
                int bi = bbase + kc; bi = ok ? bi : 0;
                const float bias = rpbs[bi];
                s[kb][r] = ok ? (s[kb][r] + bias) : -INFINITY;
            }
    }
#pragma unroll
    for (int kb = 0; kb < 2; ++kb) {
        exp16(s[kb]);
#pragma unroll
        for (int sk = 0; sk < 2; ++sk) {
            const bf16x8 p = packp(s[kb], sk);
            L = __builtin_amdgcn_mfma_f32_32x32x16_bf16(ones, p, L, 0, 0, 0);
#pragma unroll
            for (int dvb = 0; dvb < 2; ++dvb) {
                const LAS unsigned char* a = cur + voff + (kb * 32 + 16 * sk) * A_VP + dvb * 64;
                const s16x4 vlo = vtr(a), vhi = vtr(a + 8 * A_VP);
                const bf16x8 vf = {vlo[0], vlo[1], vlo[2], vlo[3], vhi[0], vhi[1], vhi[2], vhi[3]};
                O[dvb] = __builtin_amdgcn_mfma_f32_32x32x16_bf16(vf, p, O[dvb], 0, 0, 0);
            }
        }
    }
}
template <int MODE>
__device__ __forceinline__ bool unit_BC_fast(LAS unsigned char* lds, const bf16_t* H, bf16_t* Ob, int b, int hd, int blk, const float* sink_l, const float* rpb_l) {
    const int tid = pg8_ltid(), lane = tid & 63, r32 = lane & 31, hh = lane >> 5, wid = tid >> 6;
    int qrow, qcol, kcol, vcol, ocol, qpos = 0, r_w = 0, qc = 0, lo = 0, nloc = 0;
    float linit = 0.f;
    if (MODE == 1) {
        const int g = wid >> 2, head = hd * 2 + g; qpos = 128 * blk + 32 * (wid & 3) + r32; qrow = b * SEQ + qpos;
        qcol = 768 + head * 64; kcol = 1024 + hd * 64; vcol = 1152 + hd * 64; ocol = 256 + head * 64;
        lo = 2 * blk - 2; if (lo < 0) lo = 0; int hi = 2 * blk + 3; if (hi > 127) hi = 127; nloc = hi - lo + 1;
        linit = __builtin_amdgcn_exp2f(sink_l[head] * LOG2E);
    } else if (MODE == 3) {
        const int head = hd * 2 + blk; qrow = ML + b * CTXL + wid * 32 + r32;
        qcol = 768 + head * 64; kcol = 1024 + hd * 64; vcol = 1152 + hd * 64; ocol = 256 + head * 64;
        linit = __builtin_amdgcn_exp2f(sink_l[head] * LOG2E);
    } else if (MODE == 2) {
        r_w = 4 * blk + (wid >> 1); qc = 32 * (wid & 1) + r32; qrow = b * SEQ + r_w * 64 + qc;
        qcol = 1280 + hd * 64; kcol = 1536 + hd * 64; vcol = 1792 + hd * 64; ocol = 512 + hd * 64;
        int a0 = 4 * blk - 4; if (a0 < 0) a0 = 0; if (a0 > 120) a0 = 120; int a3 = 4 * blk + 3 - 4; if (a3 < 0) a3 = 0; if (a3 > 120) a3 = 120;
        lo = a0; nloc = a3 + 7 - a0 + 1;
    } else {
        qrow = ML + b * CTXL + wid * 32 + r32;
        qcol = 1280 + hd * 64; kcol = 1536 + hd * 64; vcol = 1792 + hd * 64; ocol = 512 + hd * 64;
    }
    bf16x8 qf[4];
#pragma unroll
    for (int ks = 0; ks < 4; ++ks) qf[ks] = *(const bf16x8*)(H + (size_t)qrow * INC + qcol + 16 * ks + 8 * hh);
    f32x16 O[2], L;
#pragma unroll
    for (int r = 0; r < 16; ++r) { O[0][r] = 0.f; O[1][r] = 0.f; L[r] = linit; }
    const bf16x8 ones = {0x3F80, 0x3F80, 0x3F80, 0x3F80, 0x3F80, 0x3F80, 0x3F80, 0x3F80};
    const int NT = 4 + nloc;
    int rs = 0;
    if (MODE == 2) { rs = r_w - 4; if (rs < 0) rs = 0; if (rs > 120) rs = 120; }
    const int voff = A_VOFF + (4 * hh + ((lane & 15) >> 2)) * A_VP + (((lane >> 4) & 1) * 16 + (lane & 3) * 4) * 2;
    LAS float* rpbs = (LAS float*)(lds + 2 * A_BUF);
    volatile LAS unsigned* flag = (volatile LAS unsigned*)(lds + RING_BYTES + 128);
    TileRegs Ra, Rb;
    __syncthreads();
    if (tid == 0) *flag = 0u;
    if (MODE == 2) { for (int i = tid; i < 465; i += 512) rpbs[i] = rpb_l[hd * 465 + i] * LOG2E; }
    tile_gload(Ra, H, tile_row_f<MODE>(0, b, lo, nloc), kcol, vcol, tid);
    tileA_swrite(Ra, lds, tid);
    tile_gload(Rb, H, tile_row_f<MODE>(1, b, lo, nloc), kcol, vcol, tid);
    tile_gload(Ra, H, tile_row_f<MODE>(2, b, lo, nloc), kcol, vcol, tid);
    __syncthreads();
#define BCF_TILE(T, RS) { \
        const int t = (T); \
        const LAS unsigned char* cur = lds + (t & 1) * A_BUF; \
        if (t + 1 < NT) { \
            tileA_swrite(RS, lds + ((t + 1) & 1) * A_BUF, tid); \
            if (t + 3 < NT) tile_gload(RS, H, tile_row_f<MODE>(t + 3, b, lo, nloc), kcol, vcol, tid); \
        } \
        bool active = true; int kr = 0; \
        if (MODE == 2 && t >= 4) { kr = lo + t - 4; active = (kr >= rs) && (kr < rs + 8); } \
        if (active) bcf_compute<MODE>(cur, t, nloc, lo, qpos, kr, r_w, qc, qf, O, L, ones, rpbs, voff, r32, hh); \
        __syncthreads(); }
    for (int t2 = 0; t2 < NT; t2 += 2) {
        BCF_TILE(t2, Rb)
        if (t2 + 1 < NT) BCF_TILE(t2 + 1, Ra)
    }
#undef BCF_TILE
    const float lsum = L[0];
    if (__any(!((lsum > 1e-30f) && (lsum < 1e30f))) != 0) *flag = 1u;
    __syncthreads();
    if (*flag != 0u) return true;
    const float il = 1.f / lsum;
#pragma unroll
    for (int r = 0; r < 16; ++r) { O[0][r] *= il; O[1][r] *= il; }
    store_o(O, Ob + (size_t)qrow * DM + ocol, hh);
    return false;
}
}
__device__ __forceinline__ float silu_f(float v) { return v / (1.f + __expf(-v)); }

__device__ __forceinline__ int wrow_map(int type, int n) {
    if (type == 1) {
        const bool ropeA = n < 512, ropeB = (n >= 768 && n < 1152);
        if (!ropeA && !ropeB) return n;
        int p = n & 31;
        if (ropeA) { const int blk = p >> 3; p = (blk == 1) ? p + 8 : ((blk == 2) ? p - 8 : p); }
        const int nn = p >> 4, r = p & 15;
        return (n & ~31) + 8 * (r >> 2) + 4 * nn + (r & 3);
    }
    if (type == 2) { const int half = (n >= 2816) ? 1 : 0; const int j = n - half * 2816; return (j >> 7) * 256 + half * 128 + (j & 127); }
    return n;
}
__device__ __forceinline__ void transpose_item(const float* W, int K, int N, bf16_t* WT, int type, LAS float* scr, int item, int lane) {
    const int nblk = N / 64, kb = item / nblk, nb = item - kb * nblk, k0 = 64 * kb, n0 = 64 * nb;
    const int lr = lane >> 4, lc = (lane & 15) * 4;
#pragma unroll 8
    for (int i = 0; i < 16; ++i) {
        const int kk = 4 * i + lr;
        const f32x4 v = *(const f32x4*)(W + (size_t)(k0 + kk) * N + n0 + lc);
        LAS float* d = scr + kk * 65 + lc; d[0] = v[0]; d[1] = v[1]; d[2] = v[2]; d[3] = v[3];
    }
    asm volatile("s_waitcnt lgkmcnt(0)" ::: "memory");
    const int c = lane & 7;
#pragma unroll
    for (int j = 0; j < 8; ++j) {
        const int n = (lane >> 3) + 8 * j; const LAS float* s = scr + (8 * c) * 65 + n;
        u32x4 o; o.x = pkbf(s[0 * 65], s[1 * 65]); o.y = pkbf(s[2 * 65], s[3 * 65]); o.z = pkbf(s[4 * 65], s[5 * 65]); o.w = pkbf(s[6 * 65], s[7 * 65]);
        *(u32x4*)(WT + (size_t)wrow_map(type, n0 + n) * K + k0 + 8 * c) = o;
    }
    asm volatile("s_waitcnt lgkmcnt(0)" ::: "memory");
}

__device__ __forceinline__ void sincos_f(float x, float& c, float& s) {
    const float k = rintf(x * 0.636619772f);
    float r = fmaf(-k, 1.57079625129699707031f, x); r = fmaf(-k, 7.54978941586159635335e-08f, r);
    const float r2 = r * r;
    const float sr = r * (1.f + r2 * (-1.f / 6 + r2 * (1.f / 120 + r2 * (-1.f / 5040 + r2 * (1.f / 362880)))));
    const float cr = 1.f + r2 * (-0.5f + r2 * (1.f / 24 + r2 * (-1.f / 720 + r2 * (1.f / 40320 + r2 * (-1.f / 3628800)))));
    const int q = ((int)k) & 3;
    s = (q == 0) ? sr : (q == 1) ? cr : (q == 2) ? -sr : -cr;
    c = (q == 0) ? cr : (q == 1) ? -sr : (q == 2) ? -cr : sr;
}

__device__ __forceinline__ void norm_mod_row(const float* src, const float* nw, const float* sh, const float* sc, bf16_t* dst, int lane, const float* slab = nullptr, int nslab = 0, float* xout = nullptr, bool src16 = false) {
    u32x2* o8 = (u32x2*)dst + lane;
    if (src == nullptr) {
#pragma unroll
        for (int j = 0; j < 4; ++j) o8[64 * j] = (u32x2){0u, 0u};
        return;
    }
    const f32x4* xr = (const f32x4*)src + lane;
    f32x4 v[4]; float s = 0.f;
    if (src16) {
        const u32x2* xh = (const u32x2*)src + lane;
#pragma unroll
        for (int j = 0; j < 4; ++j) { const u32x2 w = xh[64 * j]; v[j] = (f32x4){bflo(w.x), bfhi(w.x), bflo(w.y), bfhi(w.y)}; }
    } else {
#pragma unroll
        for (int j = 0; j < 4; ++j) v[j] = xr[64 * j];
    }
    for (int p = 0; p < nslab; ++p) {
        const f32x4* sr = (const f32x4*)(slab + (size_t)p * 1024 * 1024) + lane;
#pragma unroll
        for (int j = 0; j < 4; ++j) v[j] += sr[64 * j];
    }
    if (xout != nullptr) {
#pragma unroll
        for (int j = 0; j < 4; ++j) ((f32x4*)xout + lane)[64 * j] = v[j];
    }
#pragma unroll
    for (int j = 0; j < 4; ++j) s += (v[j][0] * v[j][0] + v[j][1] * v[j][1]) + (v[j][2] * v[j][2] + v[j][3] * v[j][3]);
    const float rstd = rsqrtf(wave_sum(s, lane) * (1.f / 1024.f) + 1e-6f);
#pragma unroll
    for (int j = 0; j < 4; ++j) {
        const int k = 4 * (64 * j + lane);
        const f32x4 w = *(const f32x4*)(nw + k), a = *(const f32x4*)(sc + k), d = *(const f32x4*)(sh + k);
        f32x4 y;
#pragma unroll
        for (int e = 0; e < 4; ++e) y[e] = (v[j][e] * rstd * w[e]) * (1.f + a[e]) + d[e];
        u32x2 p; p.x = pkbf(y[0], y[1]); p.y = pkbf(y[2], y[3]);
        o8[64 * j] = p;
    }
}

#define XB_TMO      128
#define XB_XCNT(j)  (256  + 64 * (j))
#define XB_XSUB(j)  (1280 + 64 * (j))
#define XB_XGEN(j)  (2304 + 64 * (j))
#define XB_TOP      3328
#define XB_TOPGEN   3392
#define XCD_BAR_WORDS 3456
#define XB_SPIN_CAP (1u << 18)

__device__ __forceinline__ unsigned xb_ld(unsigned* p)              { return __hip_atomic_load(p, __ATOMIC_RELAXED, __HIP_MEMORY_SCOPE_AGENT); }
__device__ __forceinline__ unsigned xb_add(unsigned* p, unsigned v) { return __hip_atomic_fetch_add(p, v, __ATOMIC_RELAXED, __HIP_MEMORY_SCOPE_AGENT); }
__device__ __forceinline__ unsigned xb_xcc_id() { return (unsigned)__builtin_amdgcn_s_getreg((3 << 11) | 20) & 0xFu; }
#define XB_SPIN(cond, bar) do { unsigned _sp = 0; while (cond) { __builtin_amdgcn_s_sleep(1); \
    if ((++_sp & 255u) == 0u) { if (xb_ld(&(bar)[XB_TMO])) break; if (_sp > XB_SPIN_CAP) { atomicAdd(&(bar)[XB_TMO], 1u); break; } } } } while (0)

struct XcdBarrier {
    unsigned* bar; unsigned x;
    volatile LAS unsigned* st;
};

__device__ __forceinline__ XcdBarrier xcd_barrier_post(unsigned* bar, volatile LAS unsigned* st) {
    XcdBarrier b; b.bar = bar; b.x = xb_xcc_id(); b.st = st;
    if (threadIdx.x == 0) (void)xb_add(&bar[XB_XCNT(b.x)], 1u);
    return b;
}
__device__ __forceinline__ void xcd_barrier_complete(unsigned* bar, unsigned x, unsigned& nloc, unsigned& nx) {
    const unsigned G = gridDim.x * gridDim.y * gridDim.z;
    unsigned sum, cnt, mine, sp = 0u;
    for (;;) {
        sum = 0u; cnt = 0u; mine = 0u;
#pragma unroll
        for (unsigned j = 0; j < 16; ++j) { const unsigned c = xb_ld(&bar[XB_XCNT(j)]); sum += c; cnt += (c > 0u) ? 1u : 0u; mine = (j == x) ? c : mine; }
        if (sum == G) break;
        __builtin_amdgcn_s_sleep(1);
        if ((++sp & 255u) == 0u) { if (xb_ld(&bar[XB_TMO])) break; if (sp > XB_SPIN_CAP) { atomicAdd(&bar[XB_TMO], 1u); break; } }
    }
    nloc = mine > 0u ? mine : 1u; nx = cnt > 0u ? cnt : 1u;
}

__device__ __forceinline__ void xcd_barrier(const XcdBarrier& b) {
    asm volatile("s_waitcnt vmcnt(0)" ::: "memory");
    __syncthreads();
    if (threadIdx.x == 0) {
        unsigned* bar = b.bar;
        __builtin_amdgcn_s_waitcnt(0);
        unsigned nloc = b.st[0], nx = b.st[1];
        if (nloc == 0u) { xcd_barrier_complete(bar, b.x, nloc, nx); b.st[0] = nloc; b.st[1] = nx; }
        const unsigned old = xb_add(&bar[XB_XSUB(b.x)], 1u);
        const unsigned gen = old / nloc;
        if (old + 1u == (gen + 1u) * nloc) {
            __builtin_amdgcn_fence(__ATOMIC_RELEASE, "agent");
            asm volatile("s_waitcnt vmcnt(0)" ::: "memory");
            const unsigned og = xb_add(&bar[XB_TOP], 1u);
            const unsigned tg = og / nx;
            if (og + 1u == (tg + 1u) * nx) xb_add(&bar[XB_TOPGEN], 1u);
            else XB_SPIN(xb_ld(&bar[XB_TOPGEN]) == tg, bar);
            __builtin_amdgcn_fence(__ATOMIC_ACQUIRE, "agent");
            xb_add(&bar[XB_XGEN(b.x)], 1u);
            asm volatile("s_waitcnt vmcnt(0)" ::: "memory");
        } else {
            XB_SPIN(xb_ld(&bar[XB_XGEN(b.x)]) == gen, bar);
            __builtin_amdgcn_fence(__ATOMIC_ACQUIRE, "agent");
            asm volatile("s_waitcnt vmcnt(0)" ::: "memory");
        }
    }
    __syncthreads();
}

struct Args { const float* in[23]; float* out; unsigned char* ws; int ph_lo, ph_hi, coop, pad; };
typedef const __attribute__((address_space(4))) Args* KArgs;
__device__ __forceinline__ KArgs kargs() { KArgs p = (KArgs)__builtin_amdgcn_kernarg_segment_ptr(); asm volatile("" : "+s"(p)); return p; }
constexpr int N_PHASES = 2 + 7 * DEPTH + 1;

__global__ void __launch_bounds__(512, 2) fwd_kernel(Args a) {
    extern __shared__ __attribute__((aligned(16))) unsigned char lds_raw[];
    LAS unsigned char* lds = (LAS unsigned char*)lds_raw;
    volatile LAS unsigned* bar_st = (volatile LAS unsigned*)(lds + RING_BYTES + 64);
    if (threadIdx.x < 2) bar_st[threadIdx.x] = 0u;
    __syncthreads();
    if (kargs()->coop) (void)xcd_barrier_post((unsigned*)kargs()->ws, bar_st);
    const int ph_lo = kargs()->ph_lo, ph_hi = kargs()->ph_hi;
    for (int ph = ph_lo; ph < ph_hi; ++ph) {
        KArgs ka = kargs();
        const int tid = pg8_ltid(), lane = tid & 63, wave = __builtin_amdgcn_readfirstlane(tid >> 6);
        int G = gridDim.x, bx = blockIdx.x; asm volatile("" : "+s"(G), "+s"(bx));
        const int vcu = (G % 8 == 0) ? (bx % 8) * (G / 8) + bx / 8 : bx;
        const int gw = vcu * 8 + wave, NGW = G * 8;
        unsigned char* ws = ka->ws;
        float* MOD = (float*)(ws + WS_MOD); float* MODP = (float*)(ws + WS_MODP);
        float* tabA = (float*)(ws + WS_TAB); float* tabB = tabA + 128 * 8 * 2;
        float* XCA = (float*)(ws + WS_XC); float* XCB = (float*)(ws + WS_MODP);
        bf16_t* XN = (bf16_t*)(ws + WS_XN); bf16_t* Ob = (bf16_t*)(ws + WS_O); bf16_t* Hb = (bf16_t*)(ws + WS_H); bf16_t* ACT = Hb;
        float* XL = ka->out; bf16_t* XB = (bf16_t*)(ws + WS_XB);
        if (ph == 0) {
          {
            const float* w_mod = ka->in[6]; const float* c_in = ka->in[1]; const float* cctx_in = ka->in[3];
            for (int it = gw; it < 1536; it += NGW) {
                const int ks = it & 15, cgp = (it >> 4) % 24, l = it / 384;
                const int n0 = cgp * 256 + lane * 4;
                f32x4 acc[5];
#pragma unroll
                for (int s = 0; s < 5; ++s) acc[s] = (f32x4){0.f, 0.f, 0.f, 0.f};
                const float* wp = w_mod + ((size_t)l * 1024 + ks * 64) * 6144 + n0;
                float sv[5];
                { const int kl = ks * 64 + lane;
#pragma unroll
                  for (int s = 0; s < 4; ++s) sv[s] = silu_f(c_in[s * 1024 + kl]);
                  sv[4] = silu_f(cctx_in[kl]); }
#pragma unroll 8
                for (int kk = 0; kk < 64; ++kk) {
                    const f32x4 w = *(const f32x4*)(wp + (size_t)kk * 6144);
#pragma unroll
                    for (int s = 0; s < 5; ++s) acc[s] += __uint_as_float(__builtin_amdgcn_readlane(__float_as_uint(sv[s]), kk)) * w;
                }
#pragma unroll
                for (int s = 0; s < 5; ++s) *(f32x4*)(MODP + ((size_t)(ks * 4 + l) * 5 + s) * 6144 + n0) = acc[s];
            }
            LAS float* scr = (LAS float*)(lds + wave * 16768);
            for (int it = gw; it < 4 * 3072; it += NGW) {
                const int l = it / 3072; int r = it - l * 3072;
                unsigned char* wl = ws + WS_W + (size_t)l * W_LAYER;
                if (r < 704) { transpose_item(ka->in[8] + (size_t)l * 1024 * 2816, 1024, 2816, (bf16_t*)wl, 1, scr, r, lane); continue; } r -= 704;
                if (r < 256) { transpose_item(ka->in[9] + (size_t)l * 1024 * 1024, 1024, 1024, (bf16_t*)(wl + W_OUT_OFF), 0, scr, r, lane); continue; } r -= 256;
                if (r < 1408) { transpose_item(ka->in[18] + (size_t)l * 1024 * 5632, 1024, 5632, (bf16_t*)(wl + W_UP_OFF), 2, scr, r, lane); continue; } r -= 1408;
                transpose_item(ka->in[21] + (size_t)l * 2816 * 1024, 2816, 1024, (bf16_t*)(wl + W_DN_OFF), 0, scr, r, lane);
            }
            for (int idx = vcu * 512 + tid; idx < 3072; idx += G * 512) {
                int pos, i; float e;
                if (idx < 1024) { pos = idx >> 3; i = idx & 7; e = (float)i * 0.125f; } else { const int j = idx - 1024; pos = j >> 4; i = j & 15; e = (float)i * 0.0625f; }
                const float freq = exp2f(-e * 13.287712379549449f);
                const float ang = (float)pos * freq;
                float cc, ss; sincos_f(ang, cc, ss);
                float* tp = (idx < 1024) ? (tabA + idx * 2) : (tabB + (idx - 1024) * 2);
                tp[0] = cc; tp[1] = ss;
            }
          }
        } else if (ph == 1) {
            const float* b_mod = ka->in[7];
            for (int idx = vcu * 512 + tid; idx < 4 * 5 * 6144; idx += G * 512) {
                const int l = idx / 30720, n = idx % 6144;
                float s = b_mod[l * 6144 + n];
#pragma unroll
                for (int ks = 0; ks < 16; ++ks) s += MODP[(size_t)ks * 122880 + idx];
                MOD[idx] = s;
            }
        } else if (ph == N_PHASES - 1) {
            const float* fw = ka->in[22];
            for (int m = gw; m < ML; m += NGW) {
                const u32x2* xh = (const u32x2*)(XB + (size_t)m * DM) + lane; f32x4* xr = (f32x4*)(XL + (size_t)m * DM) + lane;
                f32x4 v[4]; float s = 0.f;
#pragma unroll
                for (int j = 0; j < 4; ++j) { const u32x2 w = xh[64 * j]; v[j] = (f32x4){bflo(w.x), bfhi(w.x), bflo(w.y), bfhi(w.y)}; s += (v[j][0] * v[j][0] + v[j][1] * v[j][1]) + (v[j][2] * v[j][2] + v[j][3] * v[j][3]); }
                const float rstd = rsqrtf(wave_sum(s, lane) * (1.f / 1024.f) + 1e-6f);
#pragma unroll
                for (int j = 0; j < 4; ++j) { const f32x4 w = *(const f32x4*)(fw + 4 * (64 * j + lane)); xr[64 * j] = v[j] * rstd * w; }
            }
        } else {
            const int l = (ph - 2) / 7, k = (ph - 2) % 7;
            const bool need_ctx = l < DEPTH - 1;
            const float* modl = MOD + (size_t)l * 5 * 6144;
            unsigned char* wl = ws + WS_W + (size_t)l * W_LAYER;
            if (k == 0) {
                const float* nw = ka->in[4] + l * 1024;
                for (int m = gw; m < MT; m += NGW) {
                    const bool lat = m < ML; const int slot = lat ? (m >> 13) : 4;
                    if (lat) { if (l == 0) norm_mod_row(ka->in[0] + (size_t)m * DM, nw, modl + slot * 6144, modl + slot * 6144 + 1024, XN + (size_t)m * DM, lane);
                               else norm_mod_row((const float*)(XB + (size_t)m * DM), nw, modl + slot * 6144, modl + slot * 6144 + 1024, XN + (size_t)m * DM, lane, nullptr, 0, nullptr, true); }
                    else {
                        const size_t ro = (size_t)(m - ML) * DM;
                        norm_mod_row((l == 0 ? ka->in[2] : (const float*)XCB) + ro, nw, modl + slot * 6144, modl + slot * 6144 + 1024, XN + (size_t)m * DM, lane,
                                     (const float*)Ob + ro, (l == 0) ? 0 : 11, XCA + ro);
                    }
                }
            } else if (k == 1) {
                pg8::Gemm g{XN, (const bf16_t*)wl, MT, INC, DM, DM}; pg8::StaticOrder S; S.init(MT, INC, G, bx);
                pg8::EpiInProj E{Hb, tabA, tabB};
#ifndef DIS_IN
                pg8::gemm_phase<pg8::EpiInProj, pg8::StaticOrder, true, true>(lds, g, S, E);
#endif
            } else if (k == 2) {
                float lam, ofac;
                {
                    float d1 = 0.f, d2 = 0.f;
                    for (int i = 0; i < 32; ++i) { d1 += ka->in[10][l * 32 + i] * ka->in[11][l * 32 + i]; d2 += ka->in[12][l * 32 + i] * ka->in[13][l * 32 + i]; }
                    const float li = 0.8f - 0.6f * expf(-0.3f * (float)l);
                    lam = expf(d1) - expf(d2) + li;
                    lam = __uint_as_float(__builtin_amdgcn_readfirstlane(__float_as_uint(lam))); ofac = __uint_as_float(__builtin_amdgcn_readfirstlane(__float_as_uint(li)));
                }
                const float* subw = ka->in[14] + l * 64; const float* sink_l = ka->in[15] + l * 4; const float* rpb_l = ka->in[16] + (size_t)l * 4 * 465;
#ifndef DIS_A
                for (int u = vcu; u < 512 + (need_ctx ? 16 : 0); u += G) {
                    const bool cq = u >= 512; const int bh = cq ? (u - 512) : (u >> 5);
                    att::unit_A(cq, lds, Hb, Ob, bh >> 2, bh & 3, u & 31, lam, ofac, subw);
                }
#endif
#ifndef DIS_B
                for (int u = vcu; u < 1024 + (need_ctx ? 32 : 0); u += G) {
                    int mode, ub, uh, ublk; bool redo = true;
                    if (u < 512) { mode = 1; ub = u >> 7; uh = (u >> 6) & 1; ublk = u & 63; redo = att::unit_BC_fast<1>(lds, Hb, Ob, ub, uh, ublk, sink_l, rpb_l); }
                    else if (u < 1024) { const int v = u - 512; mode = 2; ub = v >> 7; uh = (v >> 5) & 3; ublk = v & 31; redo = att::unit_BC_fast<2>(lds, Hb, Ob, ub, uh, ublk, sink_l, rpb_l); }
                    else { const int v = u - 1024, bh = v & 15; if (v < 16) { mode = 3; ub = bh >> 2; uh = (bh >> 1) & 1; ublk = bh & 1; } else { mode = 4; ub = bh >> 2; uh = bh & 3; ublk = 0; } }
                    if (redo) att::unit_BC(mode, lds, Hb, Ob, ub, uh, ublk, sink_l, rpb_l);
                }
#endif
                {
                    const float* cwl = ka->in[17] + (size_t)l * 3 * 256;
                    const int rows = need_ctx ? MT : ML;
                    const int c0 = (tid & 31) * 8;
                    float w0[8], w1[8], w2[8];
#pragma unroll
                    for (int e = 0; e < 8; ++e) { w0[e] = cwl[c0 + e]; w1[e] = cwl[256 + c0 + e]; w2[e] = cwl[512 + c0 + e]; }
                    for (int idx = vcu * 512 + tid; idx < rows * 32; idx += G * 512) {
                        const int row = idx >> 5;
                        int t, len; if (row < ML) { t = row & 8191; len = SEQ; } else { t = (row - ML) & 255; len = CTXL; }
                        const bf16_t* hp = Hb + (size_t)row * INC + 2048 + c0;
                        const u32x4 bg = *(const u32x4*)hp, cg1 = *(const u32x4*)(hp + 256), xi1 = *(const u32x4*)(hp + 512);
                        u32x4 cg0 = {0u, 0u, 0u, 0u}, xi0 = cg0, cg2 = cg0, xi2 = cg0;
                        if (t > 0) { cg0 = *(const u32x4*)(hp - INC + 256); xi0 = *(const u32x4*)(hp - INC + 512); }
                        if (t < len - 1) { cg2 = *(const u32x4*)(hp + INC + 256); xi2 = *(const u32x4*)(hp + INC + 512); }
                        u32x4 ow;
#pragma unroll
                        for (int e = 0; e < 4; ++e) {
                            const float ylo = w0[2 * e] * bflo(cg0[e]) * bflo(xi0[e]) + w1[2 * e] * bflo(cg1[e]) * bflo(xi1[e]) + w2[2 * e] * bflo(cg2[e]) * bflo(xi2[e]);
                            const float yhi = w0[2 * e + 1] * bfhi(cg0[e]) * bfhi(xi0[e]) + w1[2 * e + 1] * bfhi(cg1[e]) * bfhi(xi1[e]) + w2[2 * e + 1] * bfhi(cg2[e]) * bfhi(xi2[e]);
                            ow[e] = pkbf(bflo(bg[e]) * ylo, bfhi(bg[e]) * yhi);
                        }
                        *(u32x4*)(Ob + (size_t)row * DM + 768 + c0) = ow;
                    }
                }
                __syncthreads();
            } else if (k == 4) {
                const float* nw = ka->in[5] + l * 1024;
                const int nrows = (need_ctx ? NMX_ALL : NMX_L) * 256;
                for (int e = gw; e < nrows; e += NGW) {
                    const int pm = e >> 8, j = e & 255;
                    int t, slot; const float* base; int len;
                    if (pm < NMX_L) { const int s = pm / 33, ti = pm - s * 33; t = 254 * ti - 1 + j; len = SEQ; slot = s; base = nullptr; }
                    else { const int p = 254 * (pm - NMX_L) - 1 + j; const int sq = (p < 0) ? 0 : p / 257, r = p - sq * 257; t = (p >= 0 && p < 1029 && r != 0) ? (r - 1) : -1; len = CTXL; slot = 4; base = XCA + (size_t)sq * CTXL * DM; }
                    const bool ok = (t >= 0 && t < len);
                    const float* src = ok ? ((pm < NMX_L) ? (const float*)(XB + ((size_t)slot * SEQ + t) * DM) : (base + (size_t)t * DM)) : nullptr;
                    if (pm < NMX_L || !ok) norm_mod_row(src, nw, modl + slot * 6144 + 3072, modl + slot * 6144 + 4096, XN + (size_t)e * DM, lane, nullptr, 0, nullptr, pm < NMX_L);
                    else {
                        const size_t ro = (size_t)(src - XCA);
                        norm_mod_row(src, nw, modl + slot * 6144 + 3072, modl + slot * 6144 + 4096, XN + (size_t)e * DM, lane, (const float*)Hb + ro, 4, XCB + ro);
                    }
                }
            } else if (k == 5) {
                const int nM = need_ctx ? NMX_ALL : NMX_L;
                pg8::Gemm g{XN, (const bf16_t*)(wl + W_UP_OFF), nM * 256, UPC, DM, DM}; pg8::StaticOrder S; S.init(nM * 256, UPC, G, bx);
                pg8::EpiUpConv E{ACT, ka->in[19] + (size_t)l * 3 * UPC, ka->in[20] + (size_t)l * UPC};
                pg8::OneUnit one;
#ifndef DIS_UP
                for (int i = 0; S.next(i, one.u); ++i) pg8::gemm_phase<pg8::EpiUpConv, pg8::OneUnit, false, true>(lds, g, one, E);
#endif
            } else {
                const bool isout = (k == 3); const int KK = isout ? DM : DFF;
                const bf16_t* Ap = isout ? (const bf16_t*)Ob : (const bf16_t*)ACT; const bf16_t* Bp = (const bf16_t*)(wl + (isout ? W_OUT_OFF : W_DN_OFF));
                {
                    pg8::Gemm g{Ap, Bp, ML, DM, KK, KK}; pg8::StaticOrder S; S.init(ML, DM, G, bx);
                    pg8::EpiRes E{(isout && l == 0) ? ka->in[0] : (const float*)nullptr, XB, XB, modl, isout ? 2048 : 5120};
#ifndef DIS_OUT
                    pg8::gemm_phase<pg8::EpiRes, pg8::StaticOrder, true, true>(lds, g, S, E);
#endif
                }
                if (need_ctx) {
                    const int P = isout ? 4 : 11, klen = KK / P;
                    for (int su = bx; su < 16 * P; su += G) {
                        const int tile = su / P, part = su - tile * P;
                        pg8::Gemm gs{Ap + (size_t)ML * KK + part * klen, Bp + part * klen, MC, DM, klen, KK};
                        pg8::OneUnit one; one.u.pm = tile >> 2; one.u.pn = tile & 3;
                        pg8::EpiSlab EA{(isout ? (float*)Hb : (float*)Ob) + (size_t)part * 1024 * 1024, modl + 4 * 6144 + (isout ? 2048 : 5120)};
                        pg8::gemm_phase<pg8::EpiSlab, pg8::OneUnit, false, true>(lds, gs, one, EA);
                    }
                }
            }
        }
        if (ph + 1 < ph_hi && kargs()->coop) {
            if (kargs()->coop == 2) cg::this_grid().sync();
            else { XcdBarrier b; b.bar = (unsigned*)kargs()->ws; b.x = xb_xcc_id(); b.st = bar_st; xcd_barrier(b); }
        }
    }
}

extern "C" void kernel_launch(void* const* d_in, const int* in_sizes, int n_in, void* d_out, int out_size, void* d_ws, size_t ws_size, hipStream_t stream) {
    static int grid = 0;
    if (grid == 0) {
        if (n_in != 23 || out_size != ML * DM || ws_size < WS_END) { fprintf(stderr, "kernel_launch: unexpected shapes (n_in %d out %d ws %zu need %zu)\n", n_in, out_size, ws_size, (size_t)WS_END); grid = -1; return; }
        int dev = 0, cus = 0, per_cu = 0;
        if (hipGetDevice(&dev) != hipSuccess || hipDeviceGetAttribute(&cus, hipDeviceAttributeMultiprocessorCount, dev) != hipSuccess) { grid = -1; return; }
        if (hipFuncSetAttribute((const void*)fwd_kernel, hipFuncAttributeMaxDynamicSharedMemorySize, LDS_BYTES) != hipSuccess) { fprintf(stderr, "kernel_launch: hipFuncSetAttribute failed\n"); grid = -1; return; }
        if (hipOccupancyMaxActiveBlocksPerMultiprocessor(&per_cu, (const void*)fwd_kernel, 512, LDS_BYTES) != hipSuccess || per_cu < 1) fprintf(stderr, "kernel_launch: occupancy query says %d\n", per_cu);
        (void)hipGetLastError();
        grid = cus;
    }
    if (grid < 0) return;
    Args a{};
    for (int i = 0; i < 23; ++i) a.in[i] = (const float*)d_in[i];
    a.out = (float*)d_out; a.ws = (unsigned char*)d_ws;
#if MK_MULTI
    for (int ph = 0; ph < N_PHASES; ++ph) {
        a.ph_lo = ph; a.ph_hi = ph + 1; a.coop = 0;
        hipLaunchKernelGGL(fwd_kernel, dim3(grid), dim3(512), LDS_BYTES, stream, a);
    }
#else
    a.ph_lo = 0; a.ph_hi = N_PHASES; a.coop = 1;
    if (hipMemsetAsync(d_ws, 0, 16384, stream) != hipSuccess) { fprintf(stderr, "kernel_launch: memset failed\n"); return; }
    void* args[] = {&a};
    hipError_t e = hipLaunchCooperativeKernel((const void*)fwd_kernel, dim3(grid), dim3(512), args, LDS_BYTES, stream);
    if (e != hipSuccess) fprintf(stderr, "cooperative launch failed: %s (grid %d)\n", hipGetErrorString(e), grid);
#endif
}
```

```cpp
#include <hip/hip_runtime.h>
#include <hip/hip_cooperative_groups.h>
#include <cstdio>
#include <cstdint>
namespace cg = cooperative_groups;

#ifndef MK_MULTI
#define MK_MULTI 0
#endif

#ifndef REP_IN
#define REP_IN 1
#endif
#ifndef REP_UP
#define REP_UP 1
#endif
#ifndef REP_A
#define REP_A 1
#endif
#ifndef REP_OD
#define REP_OD 1
#endif
#ifndef REP_P
#define REP_P 1
#endif
#ifndef REP_BC
#define REP_BC 1
#endif
#ifndef REP_M
#define REP_M 1
#endif

__device__ __forceinline__ int pg8_ltid() { int t = threadIdx.x; asm volatile("" : "+v"(t)); return t; }
namespace pg8 {
#define PG8_LAS __attribute__((address_space(3)))
typedef unsigned short bf16_t;
typedef short bf16x8 __attribute__((ext_vector_type(8)));
typedef float f32x4 __attribute__((ext_vector_type(4)));
typedef unsigned u32x4 __attribute__((ext_vector_type(4)));
constexpr int BM = 256, BK = 64, HALF = 128, HTB = HALF * BK * 2  , STAGE_BYTES = 8 * HTB, NXCD = 8, WGM = 8;

__host__ __device__ __forceinline__ int lds_byte(int r, int c) { const int st = (r >> 4) * 2 + (c >> 5), rr = r & 15, cc = c & 31, ob = rr * 64 + cc * 2; return st * 1024 + (ob ^ (((ob >> 9) & 1) << 5)); }
__host__ __device__ __forceinline__ void stage_rc(int b, int& R, int& C) { const int st = b / 1024, sb = b % 1024, swz = sb ^ (((sb >> 9) & 1) << 5); R = (st >> 1) * 16 + swz / 64; C = (st & 1) * 32 + (swz % 64) / 2; }
__host__ __device__ __forceinline__ int perm32(int rho) { const int n = rho >> 4, i = rho & 15; return 8 * (i >> 2) + 4 * n + (i & 3); }

struct Unit { int pm, pn; };
struct Gemm { const bf16_t* A; const bf16_t* Bt; int M, N, K, ldk; };

struct StaticOrder {
    int nM, nN, nwg, G, c;
    __host__ __device__ void init(int M, int N, int G_, int c_) { nM = M / BM; nN = N / BM; nwg = nM * nN; G = G_; c = c_; }
    __host__ __device__ bool next(int i, Unit& u) const {
        const long L = (long)i * G + c; if (L >= nwg) return false;
        int wgid = (int)L; { const int q = nwg / NXCD, r = nwg % NXCD, xcd = wgid % NXCD, off = wgid / NXCD; wgid = (xcd < r ? xcd * (q + 1) : r * (q + 1) + (xcd - r) * q) + off; }
        const int nig = WGM * nN, gid = wgid / nig, fm = gid * WGM, gsz = (nM - fm) < WGM ? (nM - fm) : WGM;
        u.pm = fm + ((wgid % nig) % gsz); u.pn = (wgid % nig) / gsz; return true;
    }
    __device__ __forceinline__ void a_ready(const Unit&) const {}
    __device__ __forceinline__ void done(const Unit&) const {}
};

typedef float pg8_f32x2 __attribute__((ext_vector_type(2))); typedef __bf16 pg8_bf16x2 __attribute__((ext_vector_type(2)));
__device__ __forceinline__ unsigned cvt_pk_bf16(float lo, float hi) { pg8_f32x2 v = {lo, hi}; pg8_bf16x2 b = __builtin_convertvector(v, pg8_bf16x2); return __builtin_bit_cast(unsigned, b); }
typedef unsigned u32x2 __attribute__((ext_vector_type(2)));

struct OneUnit {
    Unit u;
    __device__ __forceinline__ bool next(int i, Unit& o) const { if (i != 0) return false; o = u; return true; }
    __device__ __forceinline__ void a_ready(const Unit&) const {}
    __device__ __forceinline__ void done(const Unit&) const {}
};

struct EpiInProj {
    static constexpr bool PERM = true, AFTER_DRAIN = false;
    bf16_t* H; const float* tabA; const float* tabB;
    __device__ __forceinline__ void operator()(const f32x4 (&acc)[2][2][4][2], const Unit& u, int wr, int wc, int fr, int fq) const {
        const int pn = u.pn; const bool latent = u.pm < 128;
        const float scale = (pn == 0) ? 0.17677669529663687f * 1.4426950408889634f : ((pn == 3 || pn == 5) ? 0.125f * 1.4426950408889634f : 1.0f);
#pragma unroll
        for (int bj = 0; bj < 2; ++bj) {
            int mode = (pn == 0 || pn == 1) ? 1 : ((pn == 3 || (pn == 4 && bj == 0)) ? 2 : 0);
            if (!latent) mode = 0;
#ifdef TEST_NOROPE
            mode = 0;
#endif
#pragma unroll
            for (int ai = 0; ai < 2; ++ai)
#pragma unroll
                for (int m = 0; m < 4; ++m) {
                    const int r = u.pm * BM + ai * HALF + wr * 64 + m * 16 + fr;
                    f32x4 v0 = acc[ai][bj][m][0], v1 = acc[ai][bj][m][1];
                    if (mode != 0) {
                        const int t = r & 8191, trow = t >> 6, tcol = t & 63;
                        const float* tp;
                        if (mode == 1) { const int pos = (fq < 2) ? trow : tcol; tp = tabA + (pos * 8 + 4 * (fq & 1)) * 2; }
                        else { const int pos = (wc & 1) ? tcol : trow; tp = tabB + (pos * 16 + 4 * fq) * 2; }
                        const f32x4 cs0 = *(const f32x4*)tp, cs1 = *(const f32x4*)(tp + 4);
                        const float c0 = cs0[0], s0 = cs0[1], c1 = cs0[2], s1 = cs0[3], c2 = cs1[0], s2 = cs1[1], c3 = cs1[2], s3 = cs1[3];
                        f32x4 a = v0, b = v1;
                        v0[0] = a[0] * c0 - b[0] * s0; v1[0] = b[0] * c0 + a[0] * s0;
                        v0[1] = a[1] * c1 - b[1] * s1; v1[1] = b[1] * c1 + a[1] * s1;
                        v0[2] = a[2] * c2 - b[2] * s2; v1[2] = b[2] * c2 + a[2] * s2;
                        v0[3] = a[3] * c3 - b[3] * s3; v1[3] = b[3] * c3 + a[3] * s3;
                    }
                    v0 = v0 * scale; v1 = v1 * scale;
                    bf16_t* rowp = H + (size_t)r * 2816 + pn * BM + bj * HALF + wc * 32 + 8 * fq;
                    u32x4 w; w.x = cvt_pk_bf16(v0[0], v0[1]); w.y = cvt_pk_bf16(v0[2], v0[3]); w.z = cvt_pk_bf16(v1[0], v1[1]); w.w = cvt_pk_bf16(v1[2], v1[3]);
                    *(u32x4*)rowp = w;
                }
        }
    }
};

struct EpiRes {
    static constexpr bool PERM = true, AFTER_DRAIN = false;
    const float* base32; const bf16_t* base16; bf16_t* out16; const float* modl; int goff;
    __device__ __forceinline__ void operator()(const f32x4 (&acc)[2][2][4][2], const Unit& u, int wr, int wc, int fr, int fq) const {
        const int slot = u.pm >> 5;
        const int row0 = u.pm * BM + wr * 64 + fr;
        const int col0 = u.pn * BM + wc * 32 + 8 * fq;
        f32x4 gv[2][2];
#pragma unroll
        for (int bj = 0; bj < 2; ++bj)
#pragma unroll
            for (int n = 0; n < 2; ++n) gv[bj][n] = *(const f32x4*)(modl + slot * 6144 + goff + col0 + bj * HALF + n * 4);
        const bool f32in = (base32 != nullptr);
#pragma unroll
        for (int ai = 0; ai < 2; ++ai)
#pragma unroll
            for (int m = 0; m < 4; ++m) {
                const size_t off = (size_t)(row0 + ai * HALF + m * 16) * 1024 + col0;
#pragma unroll
                for (int bj = 0; bj < 2; ++bj) {
                    f32x4 b0, b1;
                    if (f32in) { b0 = *(const f32x4*)(base32 + off + bj * HALF); b1 = *(const f32x4*)(base32 + off + bj * HALF + 4); }
                    else { const u32x4 w = *(const u32x4*)(base16 + off + bj * HALF);
                           b0 = (f32x4){__uint_as_float(w.x << 16), __uint_as_float(w.x & 0xffff0000u), __uint_as_float(w.y << 16), __uint_as_float(w.y & 0xffff0000u)};
                           b1 = (f32x4){__uint_as_float(w.z << 16), __uint_as_float(w.z & 0xffff0000u), __uint_as_float(w.w << 16), __uint_as_float(w.w & 0xffff0000u)}; }
                    const f32x4 o0 = b0 + gv[bj][0] * acc[ai][bj][m][0], o1 = b1 + gv[bj][1] * acc[ai][bj][m][1];
                    u32x4 ow; ow.x = cvt_pk_bf16(o0[0], o0[1]); ow.y = cvt_pk_bf16(o0[2], o0[3]); ow.z = cvt_pk_bf16(o1[0], o1[1]); ow.w = cvt_pk_bf16(o1[2], o1[3]);
                    *(u32x4*)(out16 + off + bj * HALF) = ow;
                }
                asm volatile("" ::: "memory");
            }
    }
};

struct EpiSlab {
    static constexpr bool PERM = false, AFTER_DRAIN = false;
    float* slab; const float* gate;
    __device__ __forceinline__ void operator()(const f32x4 (&acc)[2][2][4][2], const Unit& u, int wr, int wc, int fr, int fq) const {
        const int row0 = u.pm * BM + wr * 64 + fr, col0 = u.pn * BM + wc * 32 + 4 * fq;
#pragma unroll
        for (int bj = 0; bj < 2; ++bj)
#pragma unroll
            for (int n = 0; n < 2; ++n) {
                const f32x4 gv = *(const f32x4*)(gate + col0 + bj * HALF + n * 16);
#pragma unroll
                for (int ai = 0; ai < 2; ++ai)
#pragma unroll
                    for (int m = 0; m < 4; ++m)
                        *(f32x4*)(slab + (size_t)(row0 + ai * HALF + m * 16) * 1024 + col0 + bj * HALF + n * 16) = gv * acc[ai][bj][m][n];
            }
    }
};

struct EpiUpConv {
    static constexpr bool PERM = false, AFTER_DRAIN = true;
    bf16_t* ACT; const float* cw; const float* cb;
    static constexpr int TP = 520;
    __device__ __forceinline__ void fused(f32x4 (&acc)[2][2][4][2], const Unit& u, int wr, int wc, int fr, int fq, PG8_LAS unsigned char* lds, int wid, int lane) const {
#pragma unroll
        for (int ai = 0; ai < 2; ++ai)
#pragma unroll
            for (int m = 0; m < 4; ++m) {
                const int row = ai * HALF + wr * 64 + m * 16 + fr;
#pragma unroll
                for (int bj = 0; bj < 2; ++bj)
#pragma unroll
                    for (int n = 0; n < 2; ++n) {
                        const f32x4 v = acc[ai][bj][m][n]; u32x2 w; w.x = cvt_pk_bf16(v[0], v[1]); w.y = cvt_pk_bf16(v[2], v[3]);
                        *(PG8_LAS u32x2*)(lds + row * TP + (bj * HALF + wc * 32 + n * 16 + 4 * fq) * 2) = w;
                    }
            }
        const int tid = wid * 64 + lane, ch = tid & 15;
        const int gcol = u.pn * 128 + ch * 8;
        float wg[3][8], wv[3][8], bg[8], bv[8];
#pragma unroll
        for (int k = 0; k < 3; ++k) {
            const f32x4 a0 = *(const f32x4*)(cw + k * 5632 + gcol), a1 = *(const f32x4*)(cw + k * 5632 + gcol + 4);
            const f32x4 b0 = *(const f32x4*)(cw + k * 5632 + 2816 + gcol), b1 = *(const f32x4*)(cw + k * 5632 + 2816 + gcol + 4);
#pragma unroll
            for (int e = 0; e < 4; ++e) { wg[k][e] = a0[e]; wg[k][4 + e] = a1[e]; wv[k][e] = b0[e]; wv[k][4 + e] = b1[e]; }
        }
        {
            const f32x4 a0 = *(const f32x4*)(cb + gcol), a1 = *(const f32x4*)(cb + gcol + 4), b0 = *(const f32x4*)(cb + 2816 + gcol), b1 = *(const f32x4*)(cb + 2816 + gcol + 4);
#pragma unroll
            for (int e = 0; e < 4; ++e) { bg[e] = a0[e]; bg[4 + e] = a1[e]; bv[e] = b0[e]; bv[4 + e] = b1[e]; }
        }
        const bool lat = u.pm < 132; int rowbase, ti;
        if (lat) { const int s = u.pm / 33; ti = u.pm - s * 33; rowbase = s * 8192; } else { ti = u.pm - 132; rowbase = 32768; }
        asm volatile("s_waitcnt lgkmcnt(0)" ::: "memory"); __builtin_amdgcn_s_barrier(); asm volatile("" ::: "memory");
        for (int it = tid; it < 254 * 16; it += 512) {
            const int j = 1 + (it >> 4); const int p = 254 * ti - 1 + j;
            int orow; bool ok;
            if (lat) { ok = p < 8192; orow = rowbase + p; } else { const int sq = p / 257, r = p - sq * 257; ok = (p < 1029) && (r != 0); orow = rowbase + sq * 256 + r - 1; }
            if (ok) {
                float g[8], v[8];
#pragma unroll
                for (int e = 0; e < 8; ++e) { g[e] = bg[e]; v[e] = bv[e]; }
#pragma unroll
                for (int k = 0; k < 3; ++k) {
                    const PG8_LAS unsigned char* rp = lds + (j - 1 + k) * TP + ch * 16;
                    const u32x2 g0 = *(const PG8_LAS u32x2*)rp, g1 = *(const PG8_LAS u32x2*)(rp + 8);
                    const u32x2 v0 = *(const PG8_LAS u32x2*)(rp + 256), v1 = *(const PG8_LAS u32x2*)(rp + 264);
                    const unsigned gw[4] = {g0.x, g0.y, g1.x, g1.y}, vw[4] = {v0.x, v0.y, v1.x, v1.y};
#pragma unroll
                    for (int e = 0; e < 4; ++e) {
                        g[2 * e] += wg[k][2 * e] * __uint_as_float(gw[e] << 16); g[2 * e + 1] += wg[k][2 * e + 1] * __uint_as_float(gw[e] & 0xffff0000u);
                        v[2 * e] += wv[k][2 * e] * __uint_as_float(vw[e] << 16); v[2 * e + 1] += wv[k][2 * e + 1] * __uint_as_float(vw[e] & 0xffff0000u);
                    }
                }
                float o[8];
#pragma unroll
                for (int e = 0; e < 8; ++e) o[e] = g[e] * __builtin_amdgcn_rcpf(1.f + __builtin_amdgcn_exp2f(-1.4426950408889634f * g[e])) * v[e];
                u32x4 w; w.x = cvt_pk_bf16(o[0], o[1]); w.y = cvt_pk_bf16(o[2], o[3]); w.z = cvt_pk_bf16(o[4], o[5]); w.w = cvt_pk_bf16(o[6], o[7]);
                *(u32x4*)(ACT + (size_t)orow * 2816 + gcol) = w;
            }
        }
        asm volatile("s_waitcnt lgkmcnt(0)" ::: "memory"); __builtin_amdgcn_s_barrier(); asm volatile("" ::: "memory");
    }
};
template <class Epi, class Sched, bool ALIGN_EPI = false, bool SP2 = false>
__device__ __forceinline__ void gemm_phase(PG8_LAS unsigned char* lds, const Gemm g, const Sched& S, const Epi& E) {
    const int tid = pg8_ltid(), wid = __builtin_amdgcn_readfirstlane(tid >> 6), lane = tid & 63, wr = wid >> 2, wc = wid & 3, fr = lane & 15, fq = lane >> 4;
    const int K = g.ldk, nt = g.K / BK;
    unsigned voffA[2], voffB[2];
#pragma unroll
    for (int i = 0; i < 2; ++i) { int R, C; stage_rc(tid * 16 + i * 8192, R, C); const int Rb = Epi::PERM ? ((R & ~31) + perm32(R & 31)) : R;
        voffA[i] = (unsigned)(R * K + C) * 2u; voffB[i] = (unsigned)(Rb * K + C) * 2u; }
    const size_t kstep = (size_t)(BK * 2);
    const size_t hstep = (size_t)HALF * K * 2;
    const size_t tstep = 2 * hstep;
    const unsigned ldsw = (unsigned)wid * 1024u;
    const int aoff = lds_byte(wr * 64 + fr, fq * 8), boff = lds_byte(wc * 32 + fr, fq * 8);
#define PG8_SA(b, h) (((b) * 2 + (h)) * HTB)
#define PG8_SB(b, h) ((4 + (b) * 2 + (h)) * HTB)
#define PG8_STAGE(bufoff, gbase, voff) do { _Pragma("unroll") for (int _i = 0; _i < 2; ++_i) \
        __builtin_amdgcn_global_load_lds((const unsigned*)((const char*)(gbase) + (voff)[_i]), (PG8_LAS unsigned*)(lds + (bufoff) + ldsw + _i * 8192), 16, 0, 0); } while (0)
#define PG8_LDA(dst, b, h) do { _Pragma("unroll") for (int m = 0; m < 4; ++m) _Pragma("unroll") for (int k = 0; k < 2; ++k) dst[m][k] = *(const PG8_LAS bf16x8*)(lds + PG8_SA(b, h) + aoff + m * 2048 + k * 1024); } while (0)
#define PG8_LDB(dst, b, h) do { _Pragma("unroll") for (int n = 0; n < 2; ++n) _Pragma("unroll") for (int k = 0; k < 2; ++k) dst[n][k] = *(const PG8_LAS bf16x8*)(lds + PG8_SB(b, h) + boff + n * 2048 + k * 1024); } while (0)
#define PG8_MMA(ai, bj, At, Bt) do { __builtin_amdgcn_s_setprio(1); _Pragma("unroll") for (int m = 0; m < 4; ++m) _Pragma("unroll") for (int n = 0; n < 2; ++n) _Pragma("unroll") for (int k = 0; k < 2; ++k) \
        acc[ai][bj][m][n] = __builtin_amdgcn_mfma_f32_16x16x32_bf16(Bt[n][k], At[m][k], acc[ai][bj][m][n], 0, 0, 0); __builtin_amdgcn_s_setprio(0); } while (0)
#define PG8_WAIT_V(n) asm volatile("s_waitcnt vmcnt(" #n ")" ::: "memory")
#define PG8_WAIT_L(n) asm volatile("s_waitcnt lgkmcnt(" #n ")" ::: "memory")
#define PG8_BAR __builtin_amdgcn_s_barrier()
#define PG8_SCHED __builtin_amdgcn_sched_barrier(0)
    Unit cur, nxt; int ui = 0;
    if (!S.next(0, cur)) return;
    f32x4 acc[2][2][4][2];
#pragma unroll
    for (int a = 0; a < 2; ++a)
#pragma unroll
        for (int b = 0; b < 2; ++b)
#pragma unroll
            for (int m = 0; m < 4; ++m)
#pragma unroll
                for (int n = 0; n < 2; ++n) acc[a][b][m][n] = (f32x4){0.f, 0.f, 0.f, 0.f};
    bf16x8 At[4][2], B0[2][2], B1[2][2];
    const char* cA = (const char*)g.A + (size_t)cur.pm * tstep; const char* cB = (const char*)g.Bt + (size_t)cur.pn * tstep;
    S.a_ready(cur);
    if constexpr (SP2) {
        PG8_STAGE(PG8_SB(0, 0), cB, voffB); PG8_STAGE(PG8_SB(0, 1), cB + hstep, voffB); PG8_STAGE(PG8_SA(0, 0), cA, voffA); PG8_STAGE(PG8_SA(0, 1), cA + hstep, voffA);
        if (wr == 1) PG8_BAR;
        PG8_WAIT_V(2); PG8_BAR;
        PG8_STAGE(PG8_SB(1, 0), cB + kstep, voffB); PG8_STAGE(PG8_SA(1, 0), cA + kstep, voffA); PG8_STAGE(PG8_SB(1, 1), cB + hstep + kstep, voffB);
        PG8_WAIT_V(6); PG8_BAR;
    } else {
        PG8_STAGE(PG8_SB(0, 0), cB, voffB); PG8_STAGE(PG8_SA(0, 0), cA, voffA); PG8_STAGE(PG8_SB(0, 1), cB + hstep, voffB); PG8_STAGE(PG8_SA(0, 1), cA + hstep, voffA);
        if (wr == 1) PG8_BAR;
        PG8_WAIT_V(4); PG8_BAR;
        PG8_STAGE(PG8_SB(1, 0), cB + kstep, voffB); PG8_STAGE(PG8_SA(1, 0), cA + kstep, voffA); PG8_STAGE(PG8_SB(1, 1), cB + hstep + kstep, voffB);
        PG8_WAIT_V(6); PG8_BAR;
    }
    for (;;) {
        const bool has_next = S.next(ui + 1, nxt);
        const char* nA = has_next ? (const char*)g.A + (size_t)nxt.pm * tstep : cA; const char* nB = has_next ? (const char*)g.Bt + (size_t)nxt.pn * tstep : cB;
        for (int t = 0; t < nt; t += 2) {
            const bool last = (t == nt - 2);
            const char* a1 = cA + (size_t)(t + 1) * kstep;
            const char* a2 = last ? nA : cA + (size_t)(t + 2) * kstep; const char* b2 = last ? nB : cB + (size_t)(t + 2) * kstep;
            const char* a3 = a2 + kstep; const char* b3 = b2 + kstep;
            if (last && has_next) S.a_ready(nxt);
            if constexpr (SP2) {
            PG8_LDB(B0, 0, 0); PG8_LDB(B1, 0, 1); PG8_SCHED; PG8_LDA(At, 0, 0); PG8_STAGE(PG8_SA(1, 1), a1 + hstep, voffA);
            PG8_WAIT_V(8); PG8_WAIT_L(0); PG8_BAR; PG8_MMA(0, 0, At, B0); PG8_MMA(0, 1, At, B1); PG8_BAR; PG8_SCHED;
            PG8_LDA(At, 0, 1); PG8_STAGE(PG8_SB(0, 0), b2, voffB); PG8_STAGE(PG8_SB(0, 1), b2 + hstep, voffB); PG8_STAGE(PG8_SA(0, 0), a2, voffA);
            PG8_WAIT_V(8); PG8_WAIT_L(0); PG8_BAR; PG8_MMA(1, 0, At, B0); PG8_MMA(1, 1, At, B1); PG8_BAR; PG8_SCHED;
            PG8_LDB(B0, 1, 0); PG8_LDB(B1, 1, 1); PG8_SCHED; PG8_LDA(At, 1, 0); PG8_STAGE(PG8_SA(0, 1), a2 + hstep, voffA);
            PG8_WAIT_V(8); PG8_WAIT_L(0); PG8_BAR; PG8_MMA(0, 0, At, B0); PG8_MMA(0, 1, At, B1); PG8_BAR; PG8_SCHED;
            PG8_LDA(At, 1, 1); PG8_STAGE(PG8_SB(1, 0), b3, voffB); PG8_STAGE(PG8_SB(1, 1), b3 + hstep, voffB); PG8_STAGE(PG8_SA(1, 0), a3, voffA);
            PG8_WAIT_V(8); PG8_WAIT_L(0); PG8_BAR; PG8_MMA(1, 0, At, B0); PG8_MMA(1, 1, At, B1); PG8_BAR; PG8_SCHED;
            } else {
            PG8_LDB(B0, 0, 0); PG8_SCHED; PG8_LDA(At, 0, 0); PG8_STAGE(PG8_SA(1, 1), a1 + hstep, voffA);
            PG8_WAIT_L(8); PG8_BAR; PG8_WAIT_L(0); PG8_MMA(0, 0, At, B0); PG8_BAR; PG8_SCHED;
            PG8_LDB(B1, 0, 1); PG8_STAGE(PG8_SB(0, 0), b2, voffB);
            PG8_BAR; PG8_WAIT_L(0); PG8_MMA(0, 1, At, B1); PG8_BAR;
            PG8_LDA(At, 0, 1); PG8_STAGE(PG8_SA(0, 0), a2, voffA);
            PG8_BAR; PG8_WAIT_L(0); PG8_MMA(1, 0, At, B0); PG8_BAR; PG8_SCHED;
            PG8_STAGE(PG8_SB(0, 1), b2 + hstep, voffB);
            PG8_WAIT_V(6); PG8_BAR; PG8_MMA(1, 1, At, B1); PG8_BAR;
            PG8_LDB(B0, 1, 0); PG8_SCHED; PG8_LDA(At, 1, 0); PG8_STAGE(PG8_SA(0, 1), a2 + hstep, voffA);
            PG8_WAIT_L(8); PG8_BAR; PG8_WAIT_L(0); PG8_MMA(0, 0, At, B0); PG8_BAR; PG8_SCHED;
            PG8_LDB(B1, 1, 1); PG8_STAGE(PG8_SB(1, 0), b3, voffB);
            PG8_BAR; PG8_WAIT_L(0); PG8_MMA(0, 1, At, B1); PG8_BAR;
            PG8_LDA(At, 1, 1); PG8_STAGE(PG8_SA(1, 0), a3, voffA);
            PG8_BAR; PG8_WAIT_L(0); PG8_MMA(1, 0, At, B0); PG8_BAR; PG8_SCHED;
            PG8_STAGE(PG8_SB(1, 1), b3 + hstep, voffB);
            PG8_WAIT_V(6); PG8_BAR; PG8_MMA(1, 1, At, B1); PG8_BAR;
            }
        }
        if constexpr (ALIGN_EPI) { if (wr == 0) PG8_BAR; }
        if constexpr (!Epi::AFTER_DRAIN) { E(acc, cur, wr, wc, fr, fq); S.done(cur); }
        if (!has_next) break;
#pragma unroll
        for (int a = 0; a < 2; ++a)
#pragma unroll
            for (int b = 0; b < 2; ++b)
#pragma unroll
                for (int m = 0; m < 4; ++m)
#pragma unroll
                    for (int n = 0; n < 2; ++n) acc[a][b][m][n] = (f32x4){0.f, 0.f, 0.f, 0.f};
        cur = nxt; cA = nA; cB = nB; ++ui;
        if constexpr (ALIGN_EPI) { if (wr == 1) PG8_BAR; }
    }
    PG8_WAIT_V(0);
    if constexpr (!ALIGN_EPI) { if (wr == 0) PG8_BAR; }
    PG8_BAR;
    if constexpr (Epi::AFTER_DRAIN) { E.fused(acc, cur, wr, wc, fr, fq, lds, wid, lane); S.done(cur); }
#undef PG8_SA
#undef PG8_SB
#undef PG8_STAGE
#undef PG8_LDA
#undef PG8_LDB
#undef PG8_MMA
#undef PG8_WAIT_V
#undef PG8_WAIT_L
#undef PG8_BAR
#undef PG8_SCHED
}
}
#define LAS __attribute__((address_space(3)))
typedef unsigned short bf16_t;
typedef short bf16x8 __attribute__((ext_vector_type(8)));
typedef short s16x4 __attribute__((ext_vector_type(4)));
typedef float f32x4 __attribute__((ext_vector_type(4)));
typedef float f32x16 __attribute__((ext_vector_type(16)));
typedef unsigned u32x4 __attribute__((ext_vector_type(4)));
typedef unsigned u32x2 __attribute__((ext_vector_type(2)));

constexpr int DM = 1024, NB = 4, SEQ = 8192, DEPTH = 4, CTXL = 256;
constexpr int ML = NB * SEQ, MC = NB * CTXL, MT = ML + MC;
constexpr int INC = 2816, DFF = 2816, UPC = 5632;
constexpr int NMX_L = NB * 33, NMX_ALL = NB * 33 + 5;
constexpr float LOG2E = 1.4426950408889634f;

constexpr size_t MiB = 1u << 20;
constexpr size_t WS_MOD = 1 * MiB;
constexpr size_t WS_MODP = 2 * MiB;
constexpr size_t WS_TAB = 10 * MiB;
constexpr size_t WS_XC = 11 * MiB;
constexpr size_t WS_W = 16 * MiB;
constexpr size_t W_LAYER = 24 * MiB, W_OUT_OFF = (size_t)2816 * 1024 * 2, W_UP_OFF = W_OUT_OFF + (size_t)1024 * 1024 * 2, W_DN_OFF = W_UP_OFF + (size_t)5632 * 1024 * 2;
constexpr size_t WS_XN = 112 * MiB;
constexpr size_t WS_O = 182 * MiB;
constexpr size_t WS_H = 248 * MiB;
constexpr size_t WS_XB = 430 * MiB;
constexpr size_t WS_END = WS_XB + (size_t)ML * 1024 * 2;
static_assert(W_DN_OFF + (size_t)1024 * 2816 * 2 <= W_LAYER, "weights per layer");
static_assert(WS_XN + (size_t)NMX_ALL * 256 * 1024 * 2 <= WS_O && WS_O + (size_t)MT * 1024 * 2 <= WS_H && WS_H + (size_t)MT * 2816 * 2 <= WS_XB && WS_END <= 512 * MiB, "ws map");

constexpr int RING_BYTES = 135168;
constexpr int LDS_BYTES = 147456;

__device__ __forceinline__ unsigned pkbf(float lo, float hi) { return pg8::cvt_pk_bf16(lo, hi); }
__device__ __forceinline__ float bflo(unsigned w) { return __uint_as_float(w << 16); }
__device__ __forceinline__ float bfhi(unsigned w) { return __uint_as_float(w & 0xffff0000u); }
__device__ __forceinline__ float dpp_add(float v, const int ctrl_sel) {
    int m;
    if (ctrl_sel == 0) m = __builtin_amdgcn_update_dpp(0, __float_as_int(v), 0xB1, 0xF, 0xF, true);
    else if (ctrl_sel == 1) m = __builtin_amdgcn_update_dpp(0, __float_as_int(v), 0x4E, 0xF, 0xF, true);
    else if (ctrl_sel == 2) m = __builtin_amdgcn_update_dpp(0, __float_as_int(v), 0x124, 0xF, 0xF, true);
    else m = __builtin_amdgcn_update_dpp(0, __float_as_int(v), 0x128, 0xF, 0xF, true);
    return v + __int_as_float(m);
}
__device__ __forceinline__ float wave_sum(float v, int lane) {
    v = dpp_add(v, 0); v = dpp_add(v, 1); v = dpp_add(v, 2); v = dpp_add(v, 3);
    v += __int_as_float(__builtin_amdgcn_ds_bpermute((lane ^ 16) << 2, __float_as_int(v)));
    auto rr = __builtin_amdgcn_permlane32_swap(__float_as_uint(v), __float_as_uint(v), false, false);
    return __uint_as_float(rr[0]) + __uint_as_float(rr[1]);
}
__device__ __forceinline__ float xhalf_max(float v) { auto rr = __builtin_amdgcn_permlane32_swap(__float_as_uint(v), __float_as_uint(v), false, false); return fmaxf(__uint_as_float(rr[0]), __uint_as_float(rr[1])); }
__device__ __forceinline__ float xhalf_sum(float v) { auto rr = __builtin_amdgcn_permlane32_swap(__float_as_uint(v), __float_as_uint(v), false, false); return __uint_as_float(rr[0]) + __uint_as_float(rr[1]); }

namespace att {
constexpr int KP = 144, VP = 136;
constexpr int L_KS = 0, L_VT = 64 * KP, L_RPB = L_VT + 64 * VP, L_END = L_RPB + 2048;
__device__ __forceinline__ int crow(int r, int h) { return (r & 3) + 8 * (r >> 2) + 4 * h; }

struct TileRegs { u32x4 k, v; };
__device__ __forceinline__ void tile_gload(TileRegs& R, const bf16_t* H, int krow, int kcol, int vcol, int tid) {
    const int key = tid >> 3, ch = tid & 7;
    const bf16_t* p = H + (size_t)(krow + key) * INC;
    R.k = *(const u32x4*)(p + kcol + 8 * ch); R.v = *(const u32x4*)(p + vcol + 8 * ch);
}
__device__ __forceinline__ void tile_swrite(const TileRegs& R, LAS unsigned char* lds, int tid) {
    const int key = tid >> 3, ch = tid & 7;
    *(LAS u32x4*)(lds + L_KS + key * KP + ch * 16) = R.k;
    LAS unsigned short* vt = (LAS unsigned short*)(lds + L_VT);
#pragma unroll
    for (int j = 0; j < 4; ++j) { const unsigned w = R.v[j]; vt[(8 * ch + 2 * j) * (VP / 2) + key] = (unsigned short)(w & 0xffffu); vt[(8 * ch + 2 * j + 1) * (VP / 2) + key] = (unsigned short)(w >> 16); }
}
template <int KS0, int NKS>
__device__ __forceinline__ f32x16 qk_block(const LAS unsigned char* lds, int kb, int r32, int hh, const bf16x8 (&qf)[4]) {
    f32x16 s = {0.f, 0.f, 0.f, 0.f, 0.f, 0.f, 0.f, 0.f, 0.f, 0.f, 0.f, 0.f, 0.f, 0.f, 0.f, 0.f};
#pragma unroll
    for (int ks = KS0; ks < KS0 + NKS; ++ks) {
        const bf16x8 kf = *(const LAS bf16x8*)(lds + L_KS + (kb * 32 + r32) * KP + ks * 32 + hh * 16);
        s = __builtin_amdgcn_mfma_f32_32x32x16_bf16(kf, qf[ks], s, 0, 0, 0);
    }
    return s;
}
__device__ __forceinline__ void softmax_pv(f32x16 (&s)[2], float& m, float& l, f32x16 (&O)[2], const LAS unsigned char* lds, int r32, int hh) {
    float mx = s[0][0];
#pragma unroll
    for (int r = 1; r < 16; ++r) mx = fmaxf(mx, s[0][r]);
#pragma unroll
    for (int r = 0; r < 16; ++r) mx = fmaxf(mx, s[1][r]);
    mx = xhalf_max(mx);
    __builtin_amdgcn_sched_barrier(0);
    const float mn = fmaxf(m, mx);
    const float alpha = __builtin_amdgcn_exp2f(m - mn);
    m = mn; l *= alpha;
#pragma unroll
    for (int r = 0; r < 16; ++r) { O[0][r] *= alpha; O[1][r] *= alpha; }
    float ps = 0.f;
#pragma unroll
    for (int kb = 0; kb < 2; ++kb)
#pragma unroll
        for (int r = 0; r < 16; ++r) { const float p = __builtin_amdgcn_exp2f(s[kb][r] - mn); s[kb][r] = p; ps += p; }
    l += ps;
    __builtin_amdgcn_sched_barrier(0);
#pragma unroll
    for (int kb = 0; kb < 2; ++kb)
#pragma unroll
        for (int sk = 0; sk < 2; ++sk) {
            __builtin_amdgcn_sched_barrier(0);
            u32x4 pw; pw.x = pkbf(s[kb][8 * sk + 0], s[kb][8 * sk + 1]); pw.y = pkbf(s[kb][8 * sk + 2], s[kb][8 * sk + 3]);
            pw.z = pkbf(s[kb][8 * sk + 4], s[kb][8 * sk + 5]); pw.w = pkbf(s[kb][8 * sk + 6], s[kb][8 * sk + 7]);
            const bf16x8 pf = __builtin_bit_cast(bf16x8, pw);
#pragma unroll
            for (int dvb = 0; dvb < 2; ++dvb) {
                const LAS unsigned char* a = lds + L_VT + (dvb * 32 + r32) * VP + (kb * 32 + 16 * sk + 4 * hh) * 2;
                const s16x4 lo = *(const LAS s16x4*)a, hi = *(const LAS s16x4*)(a + 16);
                const bf16x8 vf = {lo[0], lo[1], lo[2], lo[3], hi[0], hi[1], hi[2], hi[3]};
                O[dvb] = __builtin_amdgcn_mfma_f32_32x32x16_bf16(vf, pf, O[dvb], 0, 0, 0);
            }
        }
}
__device__ __forceinline__ void store_o(const f32x16 (&o)[2], bf16_t* orow, int hh) {
#pragma unroll
    for (int dvb = 0; dvb < 2; ++dvb)
#pragma unroll
        for (int g = 0; g < 4; ++g) {
            u32x2 w; w.x = pkbf(o[dvb][4 * g], o[dvb][4 * g + 1]); w.y = pkbf(o[dvb][4 * g + 2], o[dvb][4 * g + 3]);
            *(u32x2*)(orow + dvb * 32 + 8 * g + 4 * hh) = w;
        }
}

__device__ __forceinline__ void unit_A_safe(const bool CTXQ, LAS unsigned char* lds, const bf16_t* H, bf16_t* Ob, int b, int h, int qb, float lam, float ofac, const float* subw) {
    const int tid = pg8_ltid(), lane = tid & 63, r32 = lane & 31, hh = lane >> 5, wid = tid >> 6;
    const int qrow = CTXQ ? (ML + b * CTXL + wid * 32 + r32) : (b * SEQ + qb * 256 + wid * 32 + r32);
    const int qcol = h * 64, kcol = 256 + h * 64, vcol = 512 + h * 64;
    bf16x8 qf[4];
#pragma unroll
    for (int ks = 0; ks < 4; ++ks) qf[ks] = *(const bf16x8*)(H + (size_t)qrow * INC + qcol + 16 * ks + 8 * hh);
    const int NT = CTXQ ? 4 : 132;
    f32x16 O1[2], O2[2];
#pragma unroll
    for (int r = 0; r < 16; ++r) { O1[0][r] = 0.f; O1[1][r] = 0.f; O2[0][r] = 0.f; O2[1][r] = 0.f; }
    float m1 = -INFINITY, m2 = -INFINITY, l1 = 0.f, l2 = 0.f;
    TileRegs R;
    tile_gload(R, H, CTXQ ? (ML + b * CTXL) : (b * SEQ), kcol, vcol, tid);
    for (int t = 0; t < NT; ++t) {
        __syncthreads();
        tile_swrite(R, lds, tid);
        __syncthreads();
        if (t + 1 < NT) { const int tn = t + 1; const int krow = CTXQ ? (ML + b * CTXL + 64 * tn) : (tn < 128 ? b * SEQ + 64 * tn : ML + b * CTXL + 64 * (tn - 128)); tile_gload(R, H, krow, kcol, vcol, tid); }
        { f32x16 s[2]; s[0] = qk_block<0, 2>(lds, 0, r32, hh, qf); s[1] = qk_block<0, 2>(lds, 1, r32, hh, qf); softmax_pv(s, m1, l1, O1, lds, r32, hh); }
        __builtin_amdgcn_sched_barrier(0);
        { f32x16 s[2]; s[0] = qk_block<2, 2>(lds, 0, r32, hh, qf); s[1] = qk_block<2, 2>(lds, 1, r32, hh, qf); softmax_pv(s, m2, l2, O2, lds, r32, hh); }
        __builtin_amdgcn_sched_barrier(0);
    }
    l1 = xhalf_sum(l1); l2 = xhalf_sum(l2);
    const float i1 = 1.f / l1, i2 = lam / l2;
    float ss = 0.f;
#pragma unroll
    for (int dvb = 0; dvb < 2; ++dvb)
#pragma unroll
        for (int r = 0; r < 16; ++r) { const float o = O1[dvb][r] * i1 - O2[dvb][r] * i2; O1[dvb][r] = o; ss += o * o; }
    ss = xhalf_sum(ss);
    float li_ = ofac; asm volatile("" : "+s"(li_));
    const float rn = rsqrtf(ss * (1.f / 64.f) + 1e-6f) * (1.f - li_);
#pragma unroll
    for (int dvb = 0; dvb < 2; ++dvb)
#pragma unroll
        for (int g = 0; g < 4; ++g) {
            const f32x4 w = *(const f32x4*)(subw + dvb * 32 + 8 * g + 4 * hh);
#pragma unroll
            for (int e = 0; e < 4; ++e) O1[dvb][4 * g + e] *= rn * w[e];
        }
    store_o(O1, Ob + (size_t)qrow * DM + h * 64, hh);
}


constexpr int A_KP = 144, A_VP = 192, A_VOFF = 64 * A_KP, A_BUF = A_VOFF + 64 * A_VP;
constexpr float ATHR = 10.f;
typedef short v4i16_t __attribute__((ext_vector_type(4)));
__device__ __forceinline__ s16x4 vtr(const LAS unsigned char* p) { return __builtin_bit_cast(s16x4, __builtin_amdgcn_ds_read_tr16_b64_v4i16((LAS v4i16_t*)p)); }
__device__ __forceinline__ void tileA_swrite(const TileRegs& R, LAS unsigned char* buf, int tid) {
    const int key = tid >> 3, ch = tid & 7;
    *(LAS u32x4*)(buf + key * A_KP + ch * 16) = R.k;
    *(LAS u32x4*)(buf + A_VOFF + key * A_VP + ch * 16) = R.v;
}
__device__ __forceinline__ float max16(const f32x16& s) {
    float a = fmaxf(fmaxf(s[0], s[1]), s[2]), b = fmaxf(fmaxf(s[3], s[4]), s[5]), c = fmaxf(fmaxf(s[6], s[7]), s[8]), d = fmaxf(fmaxf(s[9], s[10]), s[11]);
    a = fmaxf(fmaxf(a, s[12]), s[13]); b = fmaxf(fmaxf(b, s[14]), s[15]);
    return fmaxf(fmaxf(a, b), fmaxf(c, d));
}
__device__ __forceinline__ float expsum16(f32x16& s) {
    float a = 0.f, b = 0.f, c = 0.f, d = 0.f;
#pragma unroll
    for (int r = 0; r < 16; r += 4) {
        s[r] = __builtin_amdgcn_exp2f(s[r]); s[r + 1] = __builtin_amdgcn_exp2f(s[r + 1]); s[r + 2] = __builtin_amdgcn_exp2f(s[r + 2]); s[r + 3] = __builtin_amdgcn_exp2f(s[r + 3]);
        a += s[r]; b += s[r + 1]; c += s[r + 2]; d += s[r + 3];
    }
    return (a + b) + (c + d);
}
__device__ __forceinline__ bf16x8 packp(const f32x16& s, int sk) {
    u32x4 pw; pw.x = pkbf(s[8 * sk + 0], s[8 * sk + 1]); pw.y = pkbf(s[8 * sk + 2], s[8 * sk + 3]); pw.z = pkbf(s[8 * sk + 4], s[8 * sk + 5]); pw.w = pkbf(s[8 * sk + 6], s[8 * sk + 7]);
    return __builtin_bit_cast(bf16x8, pw);
}
__device__ __forceinline__ void exp16(f32x16& s) {
#pragma unroll
    for (int r = 0; r < 16; ++r) s[r] = __builtin_amdgcn_exp2f(s[r]);
}
constexpr float AREF = 20.f, AGUARD = 60.f;
#ifndef SGB_V
#define SGB_V 5
#endif
template <bool HAVE>
__device__ __forceinline__ void stepA(bf16x8 (&pc)[2][2], const LAS unsigned char* kbuf, int kb, const LAS unsigned char* vb, const bf16x8 (&qv)[4], int r32, int hh,
                                      float mref1, float mref2, f32x16 (&O1)[2], f32x16 (&O2)[2], f32x16& L1, f32x16& L2, const bf16x8& ones) {
    const LAS unsigned char* kp = kbuf + (kb * 32 + r32) * A_KP + hh * 16;
    const bf16x8 k0 = *(const LAS bf16x8*)(kp), k1 = *(const LAS bf16x8*)(kp + 32), k2 = *(const LAS bf16x8*)(kp + 64), k3 = *(const LAS bf16x8*)(kp + 96);
    const bf16x8 q0 = qv[0], q1 = qv[1], q2 = qv[2], q3 = qv[3];
    bf16x8 vf[2][2];
#pragma unroll
    for (int sk = 0; sk < 2; ++sk)
#pragma unroll
        for (int dvb = 0; dvb < 2; ++dvb) {
            const LAS unsigned char* a = vb + 16 * sk * A_VP + dvb * 64;
            const s16x4 lo = vtr(a), hi = vtr(a + 8 * A_VP);
            vf[sk][dvb] = (bf16x8){lo[0], lo[1], lo[2], lo[3], hi[0], hi[1], hi[2], hi[3]};
        }
    const f32x16 z = {0.f, 0.f, 0.f, 0.f, 0.f, 0.f, 0.f, 0.f, 0.f, 0.f, 0.f, 0.f, 0.f, 0.f, 0.f, 0.f};
    f32x16 s1 = __builtin_amdgcn_mfma_f32_32x32x16_bf16(k0, q0, z, 0, 0, 0);
    f32x16 s2 = __builtin_amdgcn_mfma_f32_32x32x16_bf16(k2, q2, z, 0, 0, 0);
    s1 = __builtin_amdgcn_mfma_f32_32x32x16_bf16(k1, q1, s1, 0, 0, 0);
    s2 = __builtin_amdgcn_mfma_f32_32x32x16_bf16(k3, q3, s2, 0, 0, 0);
#pragma unroll
    for (int sk = 0; sk < 2; ++sk) {
        L1 = __builtin_amdgcn_mfma_f32_32x32x16_bf16(ones, pc[0][sk], L1, 0, 0, 0);
        L2 = __builtin_amdgcn_mfma_f32_32x32x16_bf16(ones, pc[1][sk], L2, 0, 0, 0);
#pragma unroll
        for (int dvb = 0; dvb < 2; ++dvb) {
            O1[dvb] = __builtin_amdgcn_mfma_f32_32x32x16_bf16(vf[sk][dvb], pc[0][sk], O1[dvb], 0, 0, 0);
            O2[dvb] = __builtin_amdgcn_mfma_f32_32x32x16_bf16(vf[sk][dvb], pc[1][sk], O2[dvb], 0, 0, 0);
        }
    }
    if (HAVE) {
#pragma unroll
        for (int r = 0; r < 16; ++r) { s1[r] -= mref1; s2[r] -= mref2; }
    }
    exp16(s1); exp16(s2);
    bf16x8 pn[2][2];
    pn[0][0] = packp(s1, 0); pn[0][1] = packp(s1, 1); pn[1][0] = packp(s2, 0); pn[1][1] = packp(s2, 1);
#if 0
    __builtin_amdgcn_sched_group_barrier(0x008, 6, 0);
#pragma unroll
    for (int i = 0; i < 10; ++i) { __builtin_amdgcn_sched_group_barrier(0x002, SGB_V, 0); __builtin_amdgcn_sched_group_barrier(0x008, 1, 0); }
    __builtin_amdgcn_sched_group_barrier(0x002, 48, 0);
#endif
    pc[0][0] = pn[0][0]; pc[0][1] = pn[0][1]; pc[1][0] = pn[1][0]; pc[1][1] = pn[1][1];
}
__device__ __forceinline__ void unit_A(const bool CTXQ, LAS unsigned char* lds, const bf16_t* H, bf16_t* Ob, int b, int h, int qb, float lam, float ofac, const float* subw) {
    const int tid = pg8_ltid(), lane = tid & 63, r32 = lane & 31, hh = lane >> 5, wid = tid >> 6;
    const int qrow = CTXQ ? (ML + b * CTXL + wid * 32 + r32) : (b * SEQ + qb * 256 + wid * 32 + r32);
    const int qcol = h * 64, kcol = 256 + h * 64, vcol = 512 + h * 64;
    const int NT = CTXQ ? 4 : 132;
    f32x16 O1[2], O2[2], L1, L2;
#pragma unroll
    for (int r = 0; r < 16; ++r) { O1[0][r] = 0.f; O1[1][r] = 0.f; O2[0][r] = 0.f; O2[1][r] = 0.f; L1[r] = 0.f; L2[r] = 0.f; }
    const bf16x8 ones = {0x3F80, 0x3F80, 0x3F80, 0x3F80, 0x3F80, 0x3F80, 0x3F80, 0x3F80};
    const int voff = A_VOFF + (4 * hh + ((lane & 15) >> 2)) * A_VP + (((lane >> 4) & 1) * 16 + (lane & 3) * 4) * 2;
    const int krow0 = CTXQ ? (ML + b * CTXL) : (b * SEQ);
    LAS unsigned char* qs = lds + 3 * A_BUF + (wid * 32 + r32) * A_KP + hh * 16;
    volatile LAS unsigned* flag = (volatile LAS unsigned*)(lds + RING_BYTES + 128);
    TileRegs R;
    __syncthreads();
    if (tid == 0) *flag = 0u;
#pragma unroll
    for (int ks = 0; ks < 4; ++ks) *(LAS bf16x8*)(qs + ks * 32) = *(const bf16x8*)(H + (size_t)qrow * INC + qcol + 16 * ks + 8 * hh);
    tile_gload(R, H, krow0, kcol, vcol, tid);       tileA_swrite(R, lds, tid);
    tile_gload(R, H, krow0 + 64, kcol, vcol, tid);  tileA_swrite(R, lds + A_BUF, tid);
    tile_gload(R, H, krow0 + 128, kcol, vcol, tid);
    __syncthreads();
    bf16x8 pc[2][2];
    {
        const LAS unsigned char* kp = lds + r32 * A_KP + hh * 16;
        const f32x16 z = {0.f, 0.f, 0.f, 0.f, 0.f, 0.f, 0.f, 0.f, 0.f, 0.f, 0.f, 0.f, 0.f, 0.f, 0.f, 0.f};
        f32x16 sa1 = __builtin_amdgcn_mfma_f32_32x32x16_bf16(*(const LAS bf16x8*)(kp), *(const LAS bf16x8*)(qs), z, 0, 0, 0);
        sa1 = __builtin_amdgcn_mfma_f32_32x32x16_bf16(*(const LAS bf16x8*)(kp + 32), *(const LAS bf16x8*)(qs + 32), sa1, 0, 0, 0);
        f32x16 sa2 = __builtin_amdgcn_mfma_f32_32x32x16_bf16(*(const LAS bf16x8*)(kp + 64), *(const LAS bf16x8*)(qs + 64), z, 0, 0, 0);
        sa2 = __builtin_amdgcn_mfma_f32_32x32x16_bf16(*(const LAS bf16x8*)(kp + 96), *(const LAS bf16x8*)(qs + 96), sa2, 0, 0, 0);
        exp16(sa1); exp16(sa2);
        pc[0][0] = packp(sa1, 0); pc[0][1] = packp(sa1, 1); pc[1][0] = packp(sa2, 0); pc[1][1] = packp(sa2, 1);
    }
    bf16x8 qv[4];
#pragma unroll
    for (int ks = 0; ks < 4; ++ks) qv[ks] = *(const LAS bf16x8*)(qs + ks * 32);
    int bc = 0, t = 0;
#define UNITA_STAGE() \
        const int bn = (bc == 2 * A_BUF) ? 0 : bc + A_BUF, bw = (bn == 2 * A_BUF) ? 0 : bn + A_BUF; \
        if (t + 2 < NT) { \
            tileA_swrite(R, lds + bw, tid); \
            if (t + 3 < NT) { const int tn = t + 3; const int krow = CTXQ ? (krow0 + 64 * tn) : (tn < 128 ? b * SEQ + 64 * tn : ML + b * CTXL + 64 * (tn - 128)); tile_gload(R, H, krow, kcol, vcol, tid); } \
        }
#define UNITA_GUARD() (__any((L1[0] > 1.152921504606846976e18f) || (L2[0] > 1.152921504606846976e18f)) != 0)
    {
        for (; t < NT; ++t) {
            UNITA_STAGE()
            stepA<false>(pc, lds + bc, 1, lds + bc + voff, qv, r32, hh, 0.f, 0.f, O1, O2, L1, L2, ones);
            stepA<false>(pc, lds + bn, 0, lds + bc + voff + 32 * A_VP, qv, r32, hh, 0.f, 0.f, O1, O2, L1, L2, ones);
            __syncthreads();
            bc = bn;
        }
    }
#undef UNITA_STAGE
#undef UNITA_GUARD
    if (__any(!((L1[0] > 1e-30f) && (L1[0] < 1e30f) && (L2[0] > 1e-30f) && (L2[0] < 1e30f))) != 0) *flag = 1u;
    __syncthreads();
    if (*flag != 0u) { unit_A_safe(CTXQ, lds, H, Ob, b, h, qb, lam, ofac, subw); return; }
    const float i1 = 1.f / L1[0], i2 = lam / L2[0];
    float ss = 0.f;
#pragma unroll
    for (int dvb = 0; dvb < 2; ++dvb)
#pragma unroll
        for (int r = 0; r < 16; ++r) { const float o = O1[dvb][r] * i1 - O2[dvb][r] * i2; O1[dvb][r] = o; ss += o * o; }
    ss = xhalf_sum(ss);
    float li_ = ofac; asm volatile("" : "+s"(li_));
    const float rn = rsqrtf(ss * (1.f / 64.f) + 1e-6f) * (1.f - li_);
#pragma unroll
    for (int dvb = 0; dvb < 2; ++dvb)
#pragma unroll
        for (int g = 0; g < 4; ++g) {
            const f32x4 w = *(const f32x4*)(subw + dvb * 32 + 8 * g + 4 * hh);
#pragma unroll
            for (int e = 0; e < 4; ++e) O1[dvb][4 * g + e] *= rn * w[e];
        }
    store_o(O1, Ob + (size_t)qrow * DM + h * 64, hh);
}

template <int MODE> __device__ __forceinline__ int tile_row_f(int t, int b, int lo, int nloc) {
    if (MODE == 1) return (t < nloc) ? (b * SEQ + 64 * (lo + t)) : (ML + b * CTXL + 64 * (t - nloc));
    if (MODE == 2) return (t < 4) ? (ML + b * CTXL + 64 * t) : (b * SEQ + 64 * (lo + t - 4));
    return ML + b * CTXL + 64 * t;
}
__device__ __forceinline__ int tile_row_r(int MODE, int t, int b, int lo, int nloc) {
    if (MODE == 1) return (t < nloc) ? (b * SEQ + 64 * (lo + t)) : (ML + b * CTXL + 64 * (t - nloc));
    if (MODE == 2) return (t < 4) ? (ML + b * CTXL + 64 * t) : (b * SEQ + 64 * (lo + t - 4));
    return ML + b * CTXL + 64 * t;
}
__device__ __forceinline__ void unit_BC(const int MODE, LAS unsigned char* lds, const bf16_t* H, bf16_t* Ob, int b, int hd, int blk, const float* sink_l, const float* rpb_l) {
    const int tid = pg8_ltid(), lane = tid & 63, r32 = lane & 31, hh = lane >> 5, wid = tid >> 6;
    int qrow, qcol, kcol, vcol, ocol, qpos = 0, r_w = 0, qc = 0, lo = 0, nloc = 0;
    float m = -INFINITY, l = 0.f;
    if (MODE == 1) {
        const int g = wid >> 2, head = hd * 2 + g; qpos = 128 * blk + 32 * (wid & 3) + r32; qrow = b * SEQ + qpos;
        qcol = 768 + head * 64; kcol = 1024 + hd * 64; vcol = 1152 + hd * 64; ocol = 256 + head * 64;
        lo = 2 * blk - 2; if (lo < 0) lo = 0; int hi = 2 * blk + 3; if (hi > 127) hi = 127; nloc = hi - lo + 1;
        m = sink_l[head] * LOG2E; l = (hh == 0) ? 1.f : 0.f;
    } else if (MODE == 3) {
        const int head = hd * 2 + blk; qrow = ML + b * CTXL + wid * 32 + r32;
        qcol = 768 + head * 64; kcol = 1024 + hd * 64; vcol = 1152 + hd * 64; ocol = 256 + head * 64;
        m = sink_l[head] * LOG2E; l = (hh == 0) ? 1.f : 0.f;
    } else if (MODE == 2) {
        r_w = 4 * blk + (wid >> 1); qc = 32 * (wid & 1) + r32; qrow = b * SEQ + r_w * 64 + qc;
        qcol = 1280 + hd * 64; kcol = 1536 + hd * 64; vcol = 1792 + hd * 64; ocol = 512 + hd * 64;
        int a0 = 4 * blk - 4; if (a0 < 0) a0 = 0; if (a0 > 120) a0 = 120; int a3 = 4 * blk + 3 - 4; if (a3 < 0) a3 = 0; if (a3 > 120) a3 = 120;
        lo = a0; nloc = a3 + 7 - a0 + 1;
    } else {
        qrow = ML + b * CTXL + wid * 32 + r32;
        qcol = 1280 + hd * 64; kcol = 1536 + hd * 64; vcol = 1792 + hd * 64; ocol = 512 + hd * 64;
    }
    bf16x8 qf[4];
#pragma unroll
    for (int ks = 0; ks < 4; ++ks) qf[ks] = *(const bf16x8*)(H + (size_t)qrow * INC + qcol + 16 * ks + 8 * hh);
    f32x16 O[2];
#pragma unroll
    for (int r = 0; r < 16; ++r) { O[0][r] = 0.f; O[1][r] = 0.f; }
    const int NT = 4 + nloc;
    int rs = 0;
    if (MODE == 2) { rs = r_w - 4; if (rs < 0) rs = 0; if (rs > 120) rs = 120; }
    const LAS float* rpbs = (const LAS float*)(lds + L_RPB);
    TileRegs R;
    tile_gload(R, H, tile_row_r(MODE, 0, b, lo, nloc), kcol, vcol, tid);
    for (int t = 0; t < NT; ++t) {
        __syncthreads();
        tile_swrite(R, lds, tid);
        if (MODE == 2 && t == 0) { for (int i = tid; i < 465; i += 512) ((LAS float*)(lds + L_RPB))[i] = rpb_l[hd * 465 + i] * LOG2E; }
        __syncthreads();
        if (t + 1 < NT) tile_gload(R, H, tile_row_r(MODE, t + 1, b, lo, nloc), kcol, vcol, tid);
        bool active = true; int kr = 0;
        if (MODE == 2 && t >= 4) { kr = lo + t - 4; active = (kr >= rs) && (kr < rs + 8); }
        if (active) {
            f32x16 s[2]; s[0] = qk_block<0, 4>(lds, 0, r32, hh, qf); s[1] = qk_block<0, 4>(lds, 1, r32, hh, qf);
            if (MODE == 1 && t < nloc) {
                const int kbase = 64 * (lo + t) - qpos;
#pragma unroll
                for (int kb = 0; kb < 2; ++kb)
#pragma unroll
                    for (int r = 0; r < 16; ++r) { const int d = kbase + kb * 32 + crow(r, hh); if (d > 128 || d < -128) s[kb][r] = -INFINITY; }
            }
            if (MODE == 2 && t >= 4) {
                int cs = qc - 8; if (cs < 0) cs = 0; if (cs > 48) cs = 48;
                const int bbase = (kr - r_w + 7) * 31 + 15 - qc;
#pragma unroll
                for (int kb = 0; kb < 2; ++kb)
#pragma unroll
                    for (int r = 0; r < 16; ++r) {
                        const int kc = kb * 32 + crow(r, hh);
                        const bool ok = (kc >= cs) && (kc < cs + 16);
                        int bi = bbase + kc; bi = ok ? bi : 0;
                        const float bias = rpbs[bi];
                        s[kb][r] = ok ? (s[kb][r] + bias) : -INFINITY;
                    }
            }
            softmax_pv(s, m, l, O, lds, r32, hh);
        }
    }
    l = xhalf_sum(l);
    const float il = 1.f / l;
#pragma unroll
    for (int r = 0; r < 16; ++r) { O[0][r] *= il; O[1][r] *= il; }
    store_o(O, Ob + (size_t)qrow * DM + ocol, hh);
}

template <int MODE>
__device__ __forceinline__ void bcf_compute(const LAS unsigned char* cur, int t, int nloc, int lo, int qpos, int kr, int r_w, int qc, const bf16x8 (&qf)[4], f32x16 (&O)[2], f32x16& L,
                                            const bf16x8& ones, const LAS float* rpbs, int voff, int r32, int hh) {
    f32x16 s[2];
    const f32x16 z = {0.f, 0.f, 0.f, 0.f, 0.f, 0.f, 0.f, 0.f, 0.f, 0.f, 0.f, 0.f, 0.f, 0.f, 0.f, 0.f};
#pragma unroll
    for (int kb = 0; kb < 2; ++kb) {
        const LAS unsigned char* kp = cur + (kb * 32 + r32) * A_KP + hh * 16;
        s[kb] = __builtin_amdgcn_mfma_f32_32x32x16_bf16(*(const LAS bf16x8*)(kp), qf[0], z, 0, 0, 0);
        s[kb] = __builtin_amdgcn_mfma_f32_32x32x16_bf16(*(const LAS bf16x8*)(kp + 32), qf[1], s[kb], 0, 0, 0);
        s[kb] = __builtin_amdgcn_mfma_f32_32x32x16_bf16(*(const LAS bf16x8*)(kp + 64), qf[2], s[kb], 0, 0, 0);
        s[kb] = __builtin_amdgcn_mfma_f32_32x32x16_bf16(*(const LAS bf16x8*)(kp + 96), qf[3], s[kb], 0, 0, 0);
    }
    if (MODE == 1 && t < nloc) {
        const int kbase = 64 * (lo + t) - qpos;
#pragma unroll
        for (int kb = 0; kb < 2; ++kb)
#pragma unroll
            for (int r = 0; r < 16; ++r) { const int d = kbase + kb * 32 + crow(r, hh); if (d > 128 || d < -128) s[kb][r] = -INFINITY; }
    }
    if (MODE == 2 && t >= 4) {
        int cs = qc - 8; if (cs < 0) cs = 0; if (cs > 48) cs = 48;
        const int bbase = (kr - r_w + 7) * 31 + 15 - qc;
#pragma unroll
        for (int kb = 0; kb < 2; ++kb)
#pragma unroll
            for (int r = 0; r < 16; ++r) {
                const int kc = kb * 32 + crow(r, hh);
                const bool ok = (kc >= cs) && (kc < cs + 16);
                int bi = bbase + kc; bi = ok ? bi : 0;
                const float bias = rpbs[bi];
                s[kb][r] = ok ? (s[kb][r] + bias) : -INFINITY;
            }
    }
#pragma unroll
    for (int kb = 0; kb < 2; ++kb) {
        exp16(s[kb]);
#pragma unroll
        for (int sk = 0; sk < 2; ++sk) {
            const bf16x8 p = packp(s[kb], sk);
            L = __builtin_amdgcn_mfma_f32_32x32x16_bf16(ones, p, L, 0, 0, 0);
#pragma unroll
            for (int dvb = 0; dvb < 2; ++dvb) {
                const LAS unsigned char* a = cur + voff + (kb * 32 + 16 * sk) * A_VP + dvb * 64;
                const s16x4 vlo = vtr(a), vhi = vtr(a + 8 * A_VP);
                const bf16x8 vf = {vlo[0], vlo[1], vlo[2], vlo[3], vhi[0], vhi[1], vhi[2], vhi[3]};
                O[dvb] = __builtin_amdgcn_mfma_f32_32x32x16_bf16(vf, p, O[dvb], 0, 0, 0);
            }
        }
    }
}
template <int MODE>
__device__ __forceinline__ bool unit_BC_fast(LAS unsigned char* lds, const bf16_t* H, bf16_t* Ob, int b, int hd, int blk, const float* sink_l, const float* rpb_l) {
    const int tid = pg8_ltid(), lane = tid & 63, r32 = lane & 31, hh = lane >> 5, wid = tid >> 6;
    int qrow, qcol, kcol, vcol, ocol, qpos = 0, r_w = 0, qc = 0, lo = 0, nloc = 0;
    float linit = 0.f;
    if (MODE == 1) {
        const int g = wid >> 2, head = hd * 2 + g; qpos = 128 * blk + 32 * (wid & 3) + r32; qrow = b * SEQ + qpos;
        qcol = 768 + head * 64; kcol = 1024 + hd * 64; vcol = 1152 + hd * 64; ocol = 256 + head * 64;
        lo = 2 * blk - 2; if (lo < 0) lo = 0; int hi = 2 * blk + 3; if (hi > 127) hi = 127; nloc = hi - lo + 1;
        linit = __builtin_amdgcn_exp2f(sink_l[head] * LOG2E);
    } else if (MODE == 3) {
        const int head = hd * 2 + blk; qrow = ML + b * CTXL + wid * 32 + r32;
        qcol = 768 + head * 64; kcol = 1024 + hd * 64; vcol = 1152 + hd * 64; ocol = 256 + head * 64;
        linit = __builtin_amdgcn_exp2f(sink_l[head] * LOG2E);
    } else if (MODE == 2) {
        r_w = 4 * blk + (wid >> 1); qc = 32 * (wid & 1) + r32; qrow = b * SEQ + r_w * 64 + qc;
        qcol = 1280 + hd * 64; kcol = 1536 + hd * 64; vcol = 1792 + hd * 64; ocol = 512 + hd * 64;
        int a0 = 4 * blk - 4; if (a0 < 0) a0 = 0; if (a0 > 120) a0 = 120; int a3 = 4 * blk + 3 - 4; if (a3 < 0) a3 = 0; if (a3 > 120) a3 = 120;
        lo = a0; nloc = a3 + 7 - a0 + 1;
    } else {
        qrow = ML + b * CTXL + wid * 32 + r32;
        qcol = 1280 + hd * 64; kcol = 1536 + hd * 64; vcol = 1792 + hd * 64; ocol = 512 + hd * 64;
    }
    bf16x8 qf[4];
#pragma unroll
    for (int ks = 0; ks < 4; ++ks) qf[ks] = *(const bf16x8*)(H + (size_t)qrow * INC + qcol + 16 * ks + 8 * hh);
    f32x16 O[2], L;
#pragma unroll
    for (int r = 0; r < 16; ++r) { O[0][r] = 0.f; O[1][r] = 0.f; L[r] = linit; }
    const bf16x8 ones = {0x3F80, 0x3F80, 0x3F80, 0x3F80, 0x3F80, 0x3F80, 0x3F80, 0x3F80};
    const int NT = 4 + nloc;
    int rs = 0;
    if (MODE == 2) { rs = r_w - 4; if (rs < 0) rs = 0; if (rs > 120) rs = 120; }
    const int voff = A_VOFF + (4 * hh + ((lane & 15) >> 2)) * A_VP + (((lane >> 4) & 1) * 16 + (lane & 3) * 4) * 2;
    LAS float* rpbs = (LAS float*)(lds + 2 * A_BUF);
    volatile LAS unsigned* flag = (volatile LAS unsigned*)(lds + RING_BYTES + 128);
    TileRegs Ra, Rb;
    __syncthreads();
    if (tid == 0) *flag = 0u;
    if (MODE == 2) { for (int i = tid; i < 465; i += 512) rpbs[i] = rpb_l[hd * 465 + i] * LOG2E; }
    tile_gload(Ra, H, tile_row_f<MODE>(0, b, lo, nloc), kcol, vcol, tid);
    tileA_swrite(Ra, lds, tid);
    tile_gload(Rb, H, tile_row_f<MODE>(1, b, lo, nloc), kcol, vcol, tid);
    tile_gload(Ra, H, tile_row_f<MODE>(2, b, lo, nloc), kcol, vcol, tid);
    __syncthreads();
#define BCF_TILE(T, RS) { \
        const int t = (T); \
        const LAS unsigned char* cur = lds + (t & 1) * A_BUF; \
        if (t + 1 < NT) { \
            tileA_swrite(RS, lds + ((t + 1) & 1) * A_BUF, tid); \
            if (t + 3 < NT) tile_gload(RS, H, tile_row_f<MODE>(t + 3, b, lo, nloc), kcol, vcol, tid); \
        } \
        bool active = true; int kr = 0; \
        if (MODE == 2 && t >= 4) { kr = lo + t - 4; active = (kr >= rs) && (kr < rs + 8); } \
        if (active) bcf_compute<MODE>(cur, t, nloc, lo, qpos, kr, r_w, qc, qf, O, L, ones, rpbs, voff, r32, hh); \
        __syncthreads(); }
    for (int t2 = 0; t2 < NT; t2 += 2) {
        BCF_TILE(t2, Rb)
        if (t2 + 1 < NT) BCF_TILE(t2 + 1, Ra)
    }
#undef BCF_TILE
    const float lsum = L[0];
    if (__any(!((lsum > 1e-30f) && (lsum < 1e30f))) != 0) *flag = 1u;
    __syncthreads();
    if (*flag != 0u) return true;
    const float il = 1.f / lsum;
#pragma unroll
    for (int r = 0; r < 16; ++r) { O[0][r] *= il; O[1][r] *= il; }
    store_o(O, Ob + (size_t)qrow * DM + ocol, hh);
    return false;
}
}
__device__ __forceinline__ float silu_f(float v) { return v / (1.f + __expf(-v)); }

__device__ __forceinline__ int wrow_map(int type, int n) {
    if (type == 1) {
        const bool ropeA = n < 512, ropeB = (n >= 768 && n < 1152);
        if (!ropeA && !ropeB) return n;
        int p = n & 31;
        if (ropeA) { const int blk = p >> 3; p = (blk == 1) ? p + 8 : ((blk == 2) ? p - 8 : p); }
        const int nn = p >> 4, r = p & 15;
        return (n & ~31) + 8 * (r >> 2) + 4 * nn + (r & 3);
    }
    if (type == 2) { const int half = (n >= 2816) ? 1 : 0; const int j = n - half * 2816; return (j >> 7) * 256 + half * 128 + (j & 127); }
    return n;
}
__device__ __forceinline__ void transpose_item(const float* W, int K, int N, bf16_t* WT, int type, LAS float* scr, int item, int lane) {
    const int nblk = N / 64, kb = item / nblk, nb = item - kb * nblk, k0 = 64 * kb, n0 = 64 * nb;
    const int lr = lane >> 4, lc = (lane & 15) * 4;
#pragma unroll 8
    for (int i = 0; i < 16; ++i) {
        const int kk = 4 * i + lr;
        const f32x4 v = *(const f32x4*)(W + (size_t)(k0 + kk) * N + n0 + lc);
        LAS float* d = scr + kk * 65 + lc; d[0] = v[0]; d[1] = v[1]; d[2] = v[2]; d[3] = v[3];
    }
    asm volatile("s_waitcnt lgkmcnt(0)" ::: "memory");
    const int c = lane & 7;
#pragma unroll
    for (int j = 0; j < 8; ++j) {
        const int n = (lane >> 3) + 8 * j; const LAS float* s = scr + (8 * c) * 65 + n;
        u32x4 o; o.x = pkbf(s[0 * 65], s[1 * 65]); o.y = pkbf(s[2 * 65], s[3 * 65]); o.z = pkbf(s[4 * 65], s[5 * 65]); o.w = pkbf(s[6 * 65], s[7 * 65]);
        *(u32x4*)(WT + (size_t)wrow_map(type, n0 + n) * K + k0 + 8 * c) = o;
    }
    asm volatile("s_waitcnt lgkmcnt(0)" ::: "memory");
}

__device__ __forceinline__ void sincos_f(float x, float& c, float& s) {
    const float k = rintf(x * 0.636619772f);
    float r = fmaf(-k, 1.57079625129699707031f, x); r = fmaf(-k, 7.54978941586159635335e-08f, r);
    const float r2 = r * r;
    const float sr = r * (1.f + r2 * (-1.f / 6 + r2 * (1.f / 120 + r2 * (-1.f / 5040 + r2 * (1.f / 362880)))));
    const float cr = 1.f + r2 * (-0.5f + r2 * (1.f / 24 + r2 * (-1.f / 720 + r2 * (1.f / 40320 + r2 * (-1.f / 3628800)))));
    const int q = ((int)k) & 3;
    s = (q == 0) ? sr : (q == 1) ? cr : (q == 2) ? -sr : -cr;
    c = (q == 0) ? cr : (q == 1) ? -sr : (q == 2) ? -cr : sr;
}

__device__ __forceinline__ void norm_mod_row(const float* src, const float* nw, const float* sh, const float* sc, bf16_t* dst, int lane, const float* slab = nullptr, int nslab = 0, float* xout = nullptr, bool src16 = false) {
    u32x4* o16 = (u32x4*)dst + lane;
    if (src == nullptr) {
        o16[0] = (u32x4){0u, 0u, 0u, 0u}; o16[64] = (u32x4){0u, 0u, 0u, 0u};
        return;
    }
    f32x4 v[4]; float s = 0.f;
    if (src16) {
        const u32x4* xh = (const u32x4*)src + lane;
#pragma unroll
        for (int c = 0; c < 2; ++c) { const u32x4 w = xh[64 * c]; v[2 * c] = (f32x4){bflo(w.x), bfhi(w.x), bflo(w.y), bfhi(w.y)}; v[2 * c + 1] = (f32x4){bflo(w.z), bfhi(w.z), bflo(w.w), bfhi(w.w)}; }
    } else {
        const f32x4* xr = (const f32x4*)src + 2 * lane;
#pragma unroll
        for (int c = 0; c < 2; ++c) { v[2 * c] = xr[128 * c]; v[2 * c + 1] = xr[128 * c + 1]; }
    }
    for (int p = 0; p < nslab; ++p) {
        const f32x4* sr = (const f32x4*)(slab + (size_t)p * 1024 * 1024) + 2 * lane;
#pragma unroll
        for (int c = 0; c < 2; ++c) { v[2 * c] += sr[128 * c]; v[2 * c + 1] += sr[128 * c + 1]; }
    }
    if (xout != nullptr) {
        f32x4* xo = (f32x4*)xout + 2 * lane;
#pragma unroll
        for (int c = 0; c < 2; ++c) { xo[128 * c] = v[2 * c]; xo[128 * c + 1] = v[2 * c + 1]; }
    }
#pragma unroll
    for (int j = 0; j < 4; ++j) s += (v[j][0] * v[j][0] + v[j][1] * v[j][1]) + (v[j][2] * v[j][2] + v[j][3] * v[j][3]);
    const float rstd = rsqrtf(wave_sum(s, lane) * (1.f / 1024.f) + 1e-6f);
#pragma unroll
    for (int c = 0; c < 2; ++c) {
        u32x4 p;
#pragma unroll
        for (int h = 0; h < 2; ++h) {
            const int k = 512 * c + 8 * lane + 4 * h;
            const f32x4 w = *(const f32x4*)(nw + k), a = *(const f32x4*)(sc + k), d = *(const f32x4*)(sh + k);
            f32x4 y;
#pragma unroll
            for (int e = 0; e < 4; ++e) y[e] = (v[2 * c + h][e] * rstd * w[e]) * (1.f + a[e]) + d[e];
            if (h == 0) { p.x = pkbf(y[0], y[1]); p.y = pkbf(y[2], y[3]); } else { p.z = pkbf(y[0], y[1]); p.w = pkbf(y[2], y[3]); }
        }
        o16[64 * c] = p;
    }
}

#define XB_TMO      128
#define XB_XCNT(j)  (256  + 64 * (j))
#define XB_XSUB(j)  (1280 + 64 * (j))
#define XB_XGEN(j)  (2304 + 64 * (j))
#define XB_TOP      3328
#define XB_TOPGEN   3392
#define XCD_BAR_WORDS 3456
#define XB_SPIN_CAP (1u << 18)

__device__ __forceinline__ unsigned xb_ld(unsigned* p)              { return __hip_atomic_load(p, __ATOMIC_RELAXED, __HIP_MEMORY_SCOPE_AGENT); }
__device__ __forceinline__ unsigned xb_add(unsigned* p, unsigned v) { return __hip_atomic_fetch_add(p, v, __ATOMIC_RELAXED, __HIP_MEMORY_SCOPE_AGENT); }
__device__ __forceinline__ unsigned xb_xcc_id() { return (unsigned)__builtin_amdgcn_s_getreg((3 << 11) | 20) & 0xFu; }
#define XB_SPIN(cond, bar) do { unsigned _sp = 0; while (cond) { __builtin_amdgcn_s_sleep(1); \
    if ((++_sp & 255u) == 0u) { if (xb_ld(&(bar)[XB_TMO])) break; if (_sp > XB_SPIN_CAP) { atomicAdd(&(bar)[XB_TMO], 1u); break; } } } } while (0)

struct XcdBarrier {
    unsigned* bar; unsigned x;
    volatile LAS unsigned* st;
};

__device__ __forceinline__ XcdBarrier xcd_barrier_post(unsigned* bar, volatile LAS unsigned* st) {
    XcdBarrier b; b.bar = bar; b.x = xb_xcc_id(); b.st = st;
    if (threadIdx.x == 0) (void)xb_add(&bar[XB_XCNT(b.x)], 1u);
    return b;
}
__device__ __forceinline__ void xcd_barrier_complete(unsigned* bar, unsigned x, unsigned& nloc, unsigned& nx) {
    const unsigned G = gridDim.x * gridDim.y * gridDim.z;
    unsigned sum, cnt, mine, sp = 0u;
    for (;;) {
        sum = 0u; cnt = 0u; mine = 0u;
#pragma unroll
        for (unsigned j = 0; j < 16; ++j) { const unsigned c = xb_ld(&bar[XB_XCNT(j)]); sum += c; cnt += (c > 0u) ? 1u : 0u; mine = (j == x) ? c : mine; }
        if (sum == G) break;
        __builtin_amdgcn_s_sleep(1);
        if ((++sp & 255u) == 0u) { if (xb_ld(&bar[XB_TMO])) break; if (sp > XB_SPIN_CAP) { atomicAdd(&bar[XB_TMO], 1u); break; } }
    }
    nloc = mine > 0u ? mine : 1u; nx = cnt > 0u ? cnt : 1u;
}

__device__ __forceinline__ void xcd_barrier(const XcdBarrier& b) {
    asm volatile("s_waitcnt vmcnt(0)" ::: "memory");
    __syncthreads();
    if (threadIdx.x == 0) {
        unsigned* bar = b.bar;
        __builtin_amdgcn_s_waitcnt(0);
        unsigned nloc = b.st[0], nx = b.st[1];
        if (nloc == 0u) { xcd_barrier_complete(bar, b.x, nloc, nx); b.st[0] = nloc; b.st[1] = nx; }
        const unsigned old = xb_add(&bar[XB_XSUB(b.x)], 1u);
        const unsigned gen = old / nloc;
        if (old + 1u == (gen + 1u) * nloc) {
            __builtin_amdgcn_fence(__ATOMIC_RELEASE, "agent");
            asm volatile("s_waitcnt vmcnt(0)" ::: "memory");
            const unsigned og = xb_add(&bar[XB_TOP], 1u);
            const unsigned tg = og / nx;
            if (og + 1u == (tg + 1u) * nx) xb_add(&bar[XB_TOPGEN], 1u);
            else XB_SPIN(xb_ld(&bar[XB_TOPGEN]) == tg, bar);
            __builtin_amdgcn_fence(__ATOMIC_ACQUIRE, "agent");
            xb_add(&bar[XB_XGEN(b.x)], 1u);
            asm volatile("s_waitcnt vmcnt(0)" ::: "memory");
        } else {
            XB_SPIN(xb_ld(&bar[XB_XGEN(b.x)]) == gen, bar);
            __builtin_amdgcn_fence(__ATOMIC_ACQUIRE, "agent");
            asm volatile("s_waitcnt vmcnt(0)" ::: "memory");
        }
    }
    __syncthreads();
}

struct Args { const float* in[23]; float* out; unsigned char* ws; int ph_lo, ph_hi, coop, pad; };
typedef const __attribute__((address_space(4))) Args* KArgs;
__device__ __forceinline__ KArgs kargs() { KArgs p = (KArgs)__builtin_amdgcn_kernarg_segment_ptr(); asm volatile("" : "+s"(p)); return p; }
constexpr int N_PHASES = 2 + 7 * DEPTH + 1;

__global__ void __launch_bounds__(512, 2) fwd_kernel(Args a) {
    extern __shared__ __attribute__((aligned(16))) unsigned char lds_raw[];
    LAS unsigned char* lds = (LAS unsigned char*)lds_raw;
    volatile LAS unsigned* bar_st = (volatile LAS unsigned*)(lds + RING_BYTES + 64);
    if (threadIdx.x < 2) bar_st[threadIdx.x] = 0u;
    __syncthreads();
    if (kargs()->coop) (void)xcd_barrier_post((unsigned*)kargs()->ws, bar_st);
    const int ph_lo = kargs()->ph_lo, ph_hi = kargs()->ph_hi;
    for (int ph = ph_lo; ph < ph_hi; ++ph) {
        KArgs ka = kargs();
        const int tid = pg8_ltid(), lane = tid & 63, wave = __builtin_amdgcn_readfirstlane(tid >> 6);
        int G = gridDim.x, bx = blockIdx.x; asm volatile("" : "+s"(G), "+s"(bx));
        const int vcu = (G % 8 == 0) ? (bx % 8) * (G / 8) + bx / 8 : bx;
        const int gw = vcu * 8 + wave, NGW = G * 8;
        unsigned char* ws = ka->ws;
        float* MOD = (float*)(ws + WS_MOD); float* MODP = (float*)(ws + WS_MODP);
        float* tabA = (float*)(ws + WS_TAB); float* tabB = tabA + 128 * 8 * 2;
        float* XCA = (float*)(ws + WS_XC); float* XCB = (float*)(ws + WS_MODP);
        bf16_t* XN = (bf16_t*)(ws + WS_XN); bf16_t* Ob = (bf16_t*)(ws + WS_O); bf16_t* Hb = (bf16_t*)(ws + WS_H); bf16_t* ACT = Hb;
        float* XL = ka->out; bf16_t* XB = (bf16_t*)(ws + WS_XB);
        if (ph == 0) {
          {
            const float* w_mod = ka->in[6]; const float* c_in = ka->in[1]; const float* cctx_in = ka->in[3];
            for (int it = gw; it < 1536; it += NGW) {
                const int ks = it & 15, cgp = (it >> 4) % 24, l = it / 384;
                const int n0 = cgp * 256 + lane * 4;
                f32x4 acc[5];
#pragma unroll
                for (int s = 0; s < 5; ++s) acc[s] = (f32x4){0.f, 0.f, 0.f, 0.f};
                const float* wp = w_mod + ((size_t)l * 1024 + ks * 64) * 6144 + n0;
                float sv[5];
                { const int kl = ks * 64 + lane;
#pragma unroll
                  for (int s = 0; s < 4; ++s) sv[s] = silu_f(c_in[s * 1024 + kl]);
                  sv[4] = silu_f(cctx_in[kl]); }
#pragma unroll 8
                for (int kk = 0; kk < 64; ++kk) {
                    const f32x4 w = *(const f32x4*)(wp + (size_t)kk * 6144);
#pragma unroll
                    for (int s = 0; s < 5; ++s) acc[s] += __uint_as_float(__builtin_amdgcn_readlane(__float_as_uint(sv[s]), kk)) * w;
                }
#pragma unroll
                for (int s = 0; s < 5; ++s) *(f32x4*)(MODP + ((size_t)(ks * 4 + l) * 5 + s) * 6144 + n0) = acc[s];
            }
            LAS float* scr = (LAS float*)(lds + wave * 16768);
            for (int it = gw; it < 4 * 3072; it += NGW) {
                const int l = it / 3072; int r = it - l * 3072;
                unsigned char* wl = ws + WS_W + (size_t)l * W_LAYER;
                if (r < 704) { transpose_item(ka->in[8] + (size_t)l * 1024 * 2816, 1024, 2816, (bf16_t*)wl, 1, scr, r, lane); continue; } r -= 704;
                if (r < 256) { transpose_item(ka->in[9] + (size_t)l * 1024 * 1024, 1024, 1024, (bf16_t*)(wl + W_OUT_OFF), 0, scr, r, lane); continue; } r -= 256;
                if (r < 1408) { transpose_item(ka->in[18] + (size_t)l * 1024 * 5632, 1024, 5632, (bf16_t*)(wl + W_UP_OFF), 2, scr, r, lane); continue; } r -= 1408;
                transpose_item(ka->in[21] + (size_t)l * 2816 * 1024, 2816, 1024, (bf16_t*)(wl + W_DN_OFF), 0, scr, r, lane);
            }
            for (int idx = vcu * 512 + tid; idx < 3072; idx += G * 512) {
                int pos, i; float e;
                if (idx < 1024) { pos = idx >> 3; i = idx & 7; e = (float)i * 0.125f; } else { const int j = idx - 1024; pos = j >> 4; i = j & 15; e = (float)i * 0.0625f; }
                const float freq = exp2f(-e * 13.287712379549449f);
                const float ang = (float)pos * freq;
                float cc, ss; sincos_f(ang, cc, ss);
                float* tp = (idx < 1024) ? (tabA + idx * 2) : (tabB + (idx - 1024) * 2);
                tp[0] = cc; tp[1] = ss;
            }
          }
        } else if (ph == 1) {
            const float* b_mod = ka->in[7];
            for (int idx = vcu * 512 + tid; idx < 4 * 5 * 6144; idx += G * 512) {
                const int l = idx / 30720, n = idx % 6144;
                float s = b_mod[l * 6144 + n];
#pragma unroll
                for (int ks = 0; ks < 16; ++ks) s += MODP[(size_t)ks * 122880 + idx];
                MOD[idx] = s;
            }
        } else if (ph == N_PHASES - 1) {
            const float* fw = ka->in[22];
            for (int m = gw; m < ML; m += NGW) {
                const u32x2* xh = (const u32x2*)(XB + (size_t)m * DM) + lane; f32x4* xr = (f32x4*)(XL + (size_t)m * DM) + lane;
                f32x4 v[4]; float s = 0.f;
#pragma unroll
                for (int j = 0; j < 4; ++j) { const u32x2 w = xh[64 * j]; v[j] = (f32x4){bflo(w.x), bfhi(w.x), bflo(w.y), bfhi(w.y)}; s += (v[j][0] * v[j][0] + v[j][1] * v[j][1]) + (v[j][2] * v[j][2] + v[j][3] * v[j][3]); }
                const float rstd = rsqrtf(wave_sum(s, lane) * (1.f / 1024.f) + 1e-6f);
#pragma unroll
                for (int j = 0; j < 4; ++j) { const f32x4 w = *(const f32x4*)(fw + 4 * (64 * j + lane)); xr[64 * j] = v[j] * rstd * w; }
            }
        } else {
            const int l = (ph - 2) / 7, k = (ph - 2) % 7;
            const bool need_ctx = l < DEPTH - 1;
            const float* modl = MOD + (size_t)l * 5 * 6144;
            unsigned char* wl = ws + WS_W + (size_t)l * W_LAYER;
            if (k == 0) {
                const float* nw = ka->in[4] + l * 1024;
                for (int m = gw; m < MT; m += NGW) {
                    const bool lat = m < ML; const int slot = lat ? (m >> 13) : 4;
                    if (lat) { if (l == 0) norm_mod_row(ka->in[0] + (size_t)m * DM, nw, modl + slot * 6144, modl + slot * 6144 + 1024, XN + (size_t)m * DM, lane);
                               else norm_mod_row((const float*)(XB + (size_t)m * DM), nw, modl + slot * 6144, modl + slot * 6144 + 1024, XN + (size_t)m * DM, lane, nullptr, 0, nullptr, true); }
                    else {
                        const size_t ro = (size_t)(m - ML) * DM;
                        norm_mod_row((l == 0 ? ka->in[2] : (const float*)XCB) + ro, nw, modl + slot * 6144, modl + slot * 6144 + 1024, XN + (size_t)m * DM, lane,
                                     (const float*)Ob + ro, (l == 0) ? 0 : 11, XCA + ro);
                    }
                }
            } else if (k == 1) {
                pg8::Gemm g{XN, (const bf16_t*)wl, MT, INC, DM, DM}; pg8::StaticOrder S; S.init(MT, INC, G, bx);
                pg8::EpiInProj E{Hb, tabA, tabB};
#ifndef DIS_IN
                pg8::gemm_phase<pg8::EpiInProj, pg8::StaticOrder, true, true>(lds, g, S, E);
#endif
            } else if (k == 2) {
                float lam, ofac;
                {
                    float d1 = 0.f, d2 = 0.f;
                    for (int i = 0; i < 32; ++i) { d1 += ka->in[10][l * 32 + i] * ka->in[11][l * 32 + i]; d2 += ka->in[12][l * 32 + i] * ka->in[13][l * 32 + i]; }
                    const float li = 0.8f - 0.6f * expf(-0.3f * (float)l);
                    lam = expf(d1) - expf(d2) + li;
                    lam = __uint_as_float(__builtin_amdgcn_readfirstlane(__float_as_uint(lam))); ofac = __uint_as_float(__builtin_amdgcn_readfirstlane(__float_as_uint(li)));
                }
                const float* subw = ka->in[14] + l * 64; const float* sink_l = ka->in[15] + l * 4; const float* rpb_l = ka->in[16] + (size_t)l * 4 * 465;
#ifndef DIS_A
                for (int u = vcu; u < 512 + (need_ctx ? 16 : 0); u += G) {
                    const bool cq = u >= 512; const int bh = cq ? (u - 512) : (u >> 5);
                    att::unit_A(cq, lds, Hb, Ob, bh >> 2, bh & 3, u & 31, lam, ofac, subw);
                }
#endif
#ifndef DIS_B
                for (int u = vcu; u < 1024 + (need_ctx ? 32 : 0); u += G) {
                    int mode, ub, uh, ublk; bool redo = true;
                    if (u < 512) { mode = 1; ub = u >> 7; uh = (u >> 6) & 1; ublk = u & 63; redo = att::unit_BC_fast<1>(lds, Hb, Ob, ub, uh, ublk, sink_l, rpb_l); }
                    else if (u < 1024) { const int v = u - 512; mode = 2; ub = v >> 7; uh = (v >> 5) & 3; ublk = v & 31; redo = att::unit_BC_fast<2>(lds, Hb, Ob, ub, uh, ublk, sink_l, rpb_l); }
                    else { const int v = u - 1024, bh = v & 15; if (v < 16) { mode = 3; ub = bh >> 2; uh = (bh >> 1) & 1; ublk = bh & 1; } else { mode = 4; ub = bh >> 2; uh = bh & 3; ublk = 0; } }
                    if (redo) att::unit_BC(mode, lds, Hb, Ob, ub, uh, ublk, sink_l, rpb_l);
                }
#endif
                {
                    const float* cwl = ka->in[17] + (size_t)l * 3 * 256;
                    const int rows = need_ctx ? MT : ML;
                    const int c0 = (tid & 31) * 8;
                    float w0[8], w1[8], w2[8];
#pragma unroll
                    for (int e = 0; e < 8; ++e) { w0[e] = cwl[c0 + e]; w1[e] = cwl[256 + c0 + e]; w2[e] = cwl[512 + c0 + e]; }
                    for (int idx = vcu * 512 + tid; idx < rows * 32; idx += G * 512) {
                        const int row = idx >> 5;
                        int t, len; if (row < ML) { t = row & 8191; len = SEQ; } else { t = (row - ML) & 255; len = CTXL; }
                        const bf16_t* hp = Hb + (size_t)row * INC + 2048 + c0;
                        const u32x4 bg = *(const u32x4*)hp, cg1 = *(const u32x4*)(hp + 256), xi1 = *(const u32x4*)(hp + 512);
                        u32x4 cg0 = {0u, 0u, 0u, 0u}, xi0 = cg0, cg2 = cg0, xi2 = cg0;
                        if (t > 0) { cg0 = *(const u32x4*)(hp - INC + 256); xi0 = *(const u32x4*)(hp - INC + 512); }
                        if (t < len - 1) { cg2 = *(const u32x4*)(hp + INC + 256); xi2 = *(const u32x4*)(hp + INC + 512); }
                        u32x4 ow;
#pragma unroll
                        for (int e = 0; e < 4; ++e) {
                            const float ylo = w0[2 * e] * bflo(cg0[e]) * bflo(xi0[e]) + w1[2 * e] * bflo(cg1[e]) * bflo(xi1[e]) + w2[2 * e] * bflo(cg2[e]) * bflo(xi2[e]);
                            const float yhi = w0[2 * e + 1] * bfhi(cg0[e]) * bfhi(xi0[e]) + w1[2 * e + 1] * bfhi(cg1[e]) * bfhi(xi1[e]) + w2[2 * e + 1] * bfhi(cg2[e]) * bfhi(xi2[e]);
                            ow[e] = pkbf(bflo(bg[e]) * ylo, bfhi(bg[e]) * yhi);
                        }
                        *(u32x4*)(Ob + (size_t)row * DM + 768 + c0) = ow;
                    }
                }
                __syncthreads();
            } else if (k == 4) {
                const float* nw = ka->in[5] + l * 1024;
                const int nrows = (need_ctx ? NMX_ALL : NMX_L) * 256;
                for (int e = gw; e < nrows; e += NGW) {
                    const int pm = e >> 8, j = e & 255;
                    int t, slot; const float* base; int len;
                    if (pm < NMX_L) { const int s = pm / 33, ti = pm - s * 33; t = 254 * ti - 1 + j; len = SEQ; slot = s; base = nullptr; }
                    else { const int p = 254 * (pm - NMX_L) - 1 + j; const int sq = (p < 0) ? 0 : p / 257, r = p - sq * 257; t = (p >= 0 && p < 1029 && r != 0) ? (r - 1) : -1; len = CTXL; slot = 4; base = XCA + (size_t)sq * CTXL * DM; }
                    const bool ok = (t >= 0 && t < len);
                    const float* src = ok ? ((pm < NMX_L) ? (const float*)(XB + ((size_t)slot * SEQ + t) * DM) : (base + (size_t)t * DM)) : nullptr;
                    if (pm < NMX_L || !ok) norm_mod_row(src, nw, modl + slot * 6144 + 3072, modl + slot * 6144 + 4096, XN + (size_t)e * DM, lane, nullptr, 0, nullptr, pm < NMX_L);
                    else {
                        const size_t ro = (size_t)(src - XCA);
                        norm_mod_row(src, nw, modl + slot * 6144 + 3072, modl + slot * 6144 + 4096, XN + (size_t)e * DM, lane, (const float*)Hb + ro, 4, XCB + ro);
                    }
                }
            } else if (k == 5) {
                const int nM = need_ctx ? NMX_ALL : NMX_L;
                pg8::Gemm g{XN, (const bf16_t*)(wl + W_UP_OFF), nM * 256, UPC, DM, DM}; pg8::StaticOrder S; S.init(nM * 256, UPC, G, bx);
                pg8::EpiUpConv E{ACT, ka->in[19] + (size_t)l * 3 * UPC, ka->in[20] + (size_t)l * UPC};
                pg8::OneUnit one;
#ifndef DIS_UP
                for (int i = 0; S.next(i, one.u); ++i) pg8::gemm_phase<pg8::EpiUpConv, pg8::OneUnit, false, true>(lds, g, one, E);
#endif
            } else {
                const bool isout = (k == 3); const int KK = isout ? DM : DFF;
                const bf16_t* Ap = isout ? (const bf16_t*)Ob : (const bf16_t*)ACT; const bf16_t* Bp = (const bf16_t*)(wl + (isout ? W_OUT_OFF : W_DN_OFF));
                {
                    pg8::Gemm g{Ap, Bp, ML, DM, KK, KK}; pg8::StaticOrder S; S.init(ML, DM, G, bx);
                    pg8::EpiRes E{(isout && l == 0) ? ka->in[0] : (const float*)nullptr, XB, XB, modl, isout ? 2048 : 5120};
#ifndef DIS_OUT
                    pg8::gemm_phase<pg8::EpiRes, pg8::StaticOrder, true, true>(lds, g, S, E);
#endif
                }
                if (need_ctx) {
                    const int P = isout ? 4 : 11, klen = KK / P;
                    for (int su = bx; su < 16 * P; su += G) {
                        const int tile = su / P, part = su - tile * P;
                        pg8::Gemm gs{Ap + (size_t)ML * KK + part * klen, Bp + part * klen, MC, DM, klen, KK};
                        pg8::OneUnit one; one.u.pm = tile >> 2; one.u.pn = tile & 3;
                        pg8::EpiSlab EA{(isout ? (float*)Hb : (float*)Ob) + (size_t)part * 1024 * 1024, modl + 4 * 6144 + (isout ? 2048 : 5120)};
                        pg8::gemm_phase<pg8::EpiSlab, pg8::OneUnit, false, true>(lds, gs, one, EA);
                    }
                }
            }
        }
        if (ph + 1 < ph_hi && kargs()->coop) {
            if (kargs()->coop == 2) cg::this_grid().sync();
            else { XcdBarrier b; b.bar = (unsigned*)kargs()->ws; b.x = xb_xcc_id(); b.st = bar_st; xcd_barrier(b); }
        }
    }
}

extern "C" void kernel_launch(void* const* d_in, const int* in_sizes, int n_in, void* d_out, int out_size, void* d_ws, size_t ws_size, hipStream_t stream) {
    static int grid = 0;
    if (grid == 0) {
        if (n_in != 23 || out_size != ML * DM || ws_size < WS_END) { fprintf(stderr, "kernel_launch: unexpected shapes (n_in %d out %d ws %zu need %zu)\n", n_in, out_size, ws_size, (size_t)WS_END); grid = -1; return; }
        int dev = 0, cus = 0, per_cu = 0;
        if (hipGetDevice(&dev) != hipSuccess || hipDeviceGetAttribute(&cus, hipDeviceAttributeMultiprocessorCount, dev) != hipSuccess) { grid = -1; return; }
        if (hipFuncSetAttribute((const void*)fwd_kernel, hipFuncAttributeMaxDynamicSharedMemorySize, LDS_BYTES) != hipSuccess) { fprintf(stderr, "kernel_launch: hipFuncSetAttribute failed\n"); grid = -1; return; }
        if (hipOccupancyMaxActiveBlocksPerMultiprocessor(&per_cu, (const void*)fwd_kernel, 512, LDS_BYTES) != hipSuccess || per_cu < 1) fprintf(stderr, "kernel_launch: occupancy query says %d\n", per_cu);
        (void)hipGetLastError();
        grid = cus;
    }
    if (grid < 0) return;
    Args a{};
    for (int i = 0; i < 23; ++i) a.in[i] = (const float*)d_in[i];
    a.out = (float*)d_out; a.ws = (unsigned char*)d_ws;
#if MK_MULTI
    for (int ph = 0; ph < N_PHASES; ++ph) {
        a.ph_lo = ph; a.ph_hi = ph + 1; a.coop = 0;
        hipLaunchKernelGGL(fwd_kernel, dim3(grid), dim3(512), LDS_BYTES, stream, a);
    }
#else
    a.ph_lo = 0; a.ph_hi = N_PHASES; a.coop = 1;
    if (hipMemsetAsync(d_ws, 0, 16384, stream) != hipSuccess) { fprintf(stderr, "kernel_launch: memset failed\n"); return; }
    void* args[] = {&a};
    hipError_t e = hipLaunchCooperativeKernel((const void*)fwd_kernel, dim3(grid), dim3(512), args, LDS_BYTES, stream);
    if (e != hipSuccess) fprintf(stderr, "cooperative launch failed: %s (grid %d)\n", hipGetErrorString(e), grid);
#endif
}
```
